# Optimizing an MI355X kernel written in HIP

```python
import jax, jax.numpy as jnp
from jax import lax
import numpy as np

D_MODEL = 2048
BATCH = 2
SEQ = 4096
DEPTH = 4
DEC_BATCH = 32
DEC_SEQ = 8
PAST_LEN = 16384
PAGE_SIZE = 128

N_HEADS = D_MODEL // 128
HEAD_DIM = 64
N_KV = N_HEADS // 4
GQA_G = N_HEADS // N_KV
WINDOW = 128
ATT_BLOCK = WINDOW
BR_W = N_HEADS * HEAD_DIM
CONV_W = BR_W
CONV_K = 31
POOL_GROUPS = 4
POOL_WINDOWS = (2, 4, 8, 16)
POOL_W = BR_W
POOL_G = POOL_W // POOL_GROUPS
POOL_PAD = max(POOL_WINDOWS) - 1
RET_HEADS = 8
RET_DK = 64
RET_DV = BR_W // RET_HEADS
RET_QK_W = RET_HEADS * RET_DK
RET_CHUNK = 128
N_BR = 4
D_FF = 4 * D_MODEL
EPS = 1e-6
Q_W = N_HEADS * HEAD_DIM
KV_W = N_KV * HEAD_DIM
SPLIT_SIZES = (Q_W, KV_W, KV_W, 2 * CONV_W, POOL_W, RET_QK_W, RET_QK_W, BR_W, BR_W, N_BR * D_MODEL)
N_IN = sum(SPLIT_SIZES)

kernel_name = 'hybrid_gated_swa_conv_pool_retention_step'


def rms_norm(x, g):
    xf = x.astype(jnp.float32)
    y = xf * lax.rsqrt(jnp.mean(xf * xf, axis=-1, keepdims=True) + EPS)
    return (y * g.astype(jnp.float32)).astype(x.dtype)


def layer_norm(x, g, b):
    xf = x.astype(jnp.float32)
    xc = xf - jnp.mean(xf, axis=-1, keepdims=True)
    var = jnp.mean(xc * xc, axis=-1, keepdims=True)
    return (xc * lax.rsqrt(var + EPS) * g.astype(jnp.float32) + b.astype(jnp.float32)).astype(x.dtype)


def alibi_slopes():
    h = jnp.arange(1, N_HEADS + 1, dtype=jnp.float32)
    return jnp.exp2(-8.0 * h / N_HEADS).reshape(N_KV, GQA_G)


def sink_attention(q, k, v, dist, valid, sinks):
    s = jnp.einsum('bnqkgd,bnskd->bnkgqs', q.astype(jnp.float32), k.astype(jnp.float32)) * (HEAD_DIM ** -0.5)
    s = s - alibi_slopes()[:, :, None, None] * dist.astype(jnp.float32)
    s = jnp.where(valid[None, :, None, None], s, -jnp.inf)
    sink = jnp.broadcast_to(sinks.astype(jnp.float32).reshape(N_KV, GQA_G, 1, 1), s.shape[:-1] + (1,))
    p = jax.nn.softmax(jnp.concatenate([s, sink], axis=-1), axis=-1)[..., :-1]
    o = jnp.einsum('bnkgqs,bnskd->bnqkgd', p, v.astype(jnp.float32))
    return o.astype(q.dtype)


def attn_prompt(q, k, v, sinks):
    B, T = q.shape[:2]
    NB = T // ATT_BLOCK
    qb = q.reshape(B, NB, ATT_BLOCK, N_KV, GQA_G, HEAD_DIM)

    def with_prev(z):
        zb = z.reshape(B, NB, ATT_BLOCK, N_KV, HEAD_DIM)
        prev = jnp.concatenate([jnp.zeros_like(zb[:, :1]), zb[:, :-1]], axis=1)
        return jnp.concatenate([prev, zb], axis=2)

    i = jnp.arange(ATT_BLOCK)[:, None]
    j = jnp.arange(2 * ATT_BLOCK)[None, :]
    dist = ATT_BLOCK + i - j
    blk = jnp.arange(NB)[:, None, None]
    valid = ((dist >= 0) & (dist <= WINDOW))[None] & ((blk > 0) | (j[None] >= ATT_BLOCK))
    o = sink_attention(qb, with_prev(k), with_prev(v), dist, valid, sinks)
    return o.reshape(B, T, Q_W)


def attn_sample(q, k, v, k_buf, v_buf, sinks):
    B, T = q.shape[:2]
    kk = jnp.concatenate([k_buf.astype(k.dtype), k], axis=1)
    vv = jnp.concatenate([v_buf.astype(v.dtype), v], axis=1)
    i = jnp.arange(T)[:, None]
    j = jnp.arange(WINDOW + T)[None, :]
    dist = WINDOW + i - j
    valid = ((dist >= 0) & (dist <= WINDOW))[None]
    o = sink_attention(q.reshape(B, 1, T, N_KV, GQA_G, HEAD_DIM), kk[:, None], vv[:, None], dist, valid, sinks)
    return o.reshape(B, T, Q_W), kk[:, -WINDOW:], vv[:, -WINDOW:]


def conv_module(a, prefix, w_dw, b_dw, g_ln, b_ln):
    u = a[..., :CONV_W] * jax.nn.sigmoid(a[..., CONV_W:])
    ext = jnp.concatenate([prefix.astype(u.dtype), u], axis=1)
    y = lax.conv_general_dilated(ext, w_dw[:, None, :].astype(ext.dtype), window_strides=(1,), padding='VALID',
                                 dimension_numbers=('NWC', 'WIO', 'NWC'), feature_group_count=CONV_W)
    y = jax.nn.silu(layer_norm(y + b_dw, g_ln, b_ln))
    return y, ext[:, -(CONV_K - 1):]


def pool_mixer(u, prefix, pos0, w_pool, s_pool):
    B, T = u.shape[:2]
    ext_in = jnp.concatenate([prefix.astype(u.dtype), u], axis=1)
    ext = ext_in.astype(jnp.float32)
    cs = jnp.concatenate([jnp.zeros((B, 1, POOL_W), jnp.float32), lax.cumsum(ext, axis=1)], axis=1)
    pos = jnp.arange(T) + pos0
    outs = []
    for g, w in enumerate(POOL_WINDOWS):
        sl = slice(g * POOL_G, (g + 1) * POOL_G)
        wsum = cs[:, POOL_PAD + 1:POOL_PAD + 1 + T, sl] - cs[:, POOL_PAD + 1 - w:POOL_PAD + 1 - w + T, sl]
        cnt = jnp.minimum(pos + 1, w).astype(jnp.float32)
        outs.append(wsum / cnt[None, :, None])
    z = (jnp.concatenate(outs, axis=-1) - ext[:, POOL_PAD:]).reshape(B, T, POOL_GROUPS, POOL_G)
    z = jnp.einsum('btgc,gcd->btgd', z, w_pool.astype(jnp.float32)).reshape(B, T, POOL_W)
    z = z * s_pool.astype(jnp.float32)
    return z.astype(u.dtype), ext_in[:, -POOL_PAD:]


def retention(q, k, v, s0):
    B, T = q.shape[:2]
    C = RET_CHUNK if T % RET_CHUNK == 0 else T
    N = T // C
    log_g = jnp.log1p(-jnp.exp2(-5.0 - jnp.arange(RET_HEADS, dtype=jnp.float32)))
    qf = q.astype(jnp.float32).reshape(B, N, C, RET_HEADS, RET_DK)
    kf = k.astype(jnp.float32).reshape(B, N, C, RET_HEADS, RET_DK) * (RET_DK ** -0.5)
    vf = v.astype(jnp.float32).reshape(B, N, C, RET_HEADS, RET_DV)
    i = jnp.arange(C, dtype=jnp.float32)
    diff = i[:, None] - i[None, :]
    decay = jnp.where(diff >= 0, jnp.exp(log_g[:, None, None] * jnp.maximum(diff, 0.0)), 0.0)
    scores = jnp.einsum('bnihd,bnjhd->bnhij', qf, kf) * decay
    inner = jnp.einsum('bnhij,bnjhv->bnihv', scores, vf)
    k_dec = kf * jnp.exp(log_g[None, :] * (C - 1 - i)[:, None])[:, :, None]
    kv = jnp.einsum('bnjhd,bnjhv->bnhdv', k_dec, vf)
    g_chunk = jnp.exp(log_g * C)[None, :, None, None]

    def step(S, kv_n):
        return g_chunk * S + kv_n, S

    s_fin, s_prev = lax.scan(step, s0.astype(jnp.float32), jnp.moveaxis(kv, 1, 0))
    s_prev = jnp.moveaxis(s_prev, 0, 1)
    cross = jnp.einsum('bnihd,bnhdv->bnihv', qf, s_prev) * jnp.exp(log_g[None, :] * (i + 1)[:, None])[:, :, None]
    return (inner + cross).reshape(B, T, RET_HEADS, RET_DV), s_fin


def head_group_norm(o, g):
    B, T = o.shape[:2]
    oc = o - jnp.mean(o, axis=-1, keepdims=True)
    var = jnp.mean(oc * oc, axis=-1, keepdims=True)
    return (oc * lax.rsqrt(var + EPS)).reshape(B, T, BR_W) * g.astype(jnp.float32)


def trunk_layer(x, c, p, cache):
    (w_ada, b_ada, g_norm1, g_norm2, w_in, g_qnorm, g_knorm, attn_sinks, w_dw, b_dw, g_conv_ln, b_conv_ln,
     w_pool, s_pool, g_ret_norm, w_br, w_out, w_mlp1, w_mlp2) = p
    B, T, _ = x.shape
    ada = (jax.nn.silu(c) @ w_ada + b_ada)[:, None, :]
    sh1, sc1, gt1, sh2, sc2, gt2 = jnp.split(ada, 6, axis=-1)
    h = rms_norm(x, g_norm1) * (1 + sc1) + sh1
    z = h @ w_in
    pts = [int(s) for s in np.cumsum(SPLIT_SIZES)[:-1]]
    q, k, v, a_conv, u_pool, rq, rk, rv, rg, gpre = jnp.split(z, pts, axis=-1)
    q = rms_norm(q.reshape(B, T, N_HEADS, HEAD_DIM), g_qnorm)
    k = rms_norm(k.reshape(B, T, N_KV, HEAD_DIM), g_knorm)
    v = v.reshape(B, T, N_KV, HEAD_DIM)
    if cache is None:
        y_att = attn_prompt(q, k, v, attn_sinks)
        k_new, v_new = k[:, -WINDOW:], v[:, -WINDOW:]
        conv_prefix = jnp.zeros((B, CONV_K - 1, CONV_W), z.dtype)
        pool_prefix = jnp.zeros((B, POOL_PAD, POOL_W), z.dtype)
        s0 = jnp.zeros((B, RET_HEADS, RET_DK, RET_DV), jnp.float32)
        pos0 = 0
    else:
        k_buf, v_buf, conv_prefix, pool_prefix, s0 = cache
        y_att, k_new, v_new = attn_sample(q, k, v, k_buf, v_buf, attn_sinks)
        pos0 = PAST_LEN
    y_conv, conv_new = conv_module(a_conv, conv_prefix, w_dw, b_dw, g_conv_ln, b_conv_ln)
    y_pool, pool_new = pool_mixer(u_pool, pool_prefix, pos0, w_pool, s_pool)
    o_ret, s_new = retention(rq.reshape(B, T, RET_HEADS, RET_DK), rk.reshape(B, T, RET_HEADS, RET_DK),
                             rv.reshape(B, T, RET_HEADS, RET_DV), s0)
    y_ret = (head_group_norm(o_ret, g_ret_norm) * jax.nn.silu(rg.astype(jnp.float32))).astype(x.dtype)
    branches = jnp.stack([y_att, y_conv, y_pool, y_ret], axis=2)
    proj = jnp.einsum('btrc,rcd->btrd', branches, w_br)
    gates = jax.nn.sigmoid(gpre.astype(jnp.float32)).reshape(B, T, N_BR, D_MODEL)
    merged = jnp.einsum('btrd,btrd->btd', gates, proj.astype(jnp.float32)).astype(x.dtype)
    x = x + gt1 * (merged @ w_out)
    h2 = rms_norm(x, g_norm2) * (1 + sc2) + sh2
    x = x + gt2 * (jnp.square(jax.nn.relu(h2 @ w_mlp1)) @ w_mlp2)
    return x, (k_new, v_new, conv_new, pool_new, s_new)


def setup_inputs(seed: int = 0) -> dict:
    key = jax.random.key(seed)
    ks = jax.random.split(key, 32)
    f32 = jnp.float32

    def nrm(k, shape, s):
        return jax.random.normal(k, shape, f32) * s

    return {
        'x_prompt': nrm(ks[0], (BATCH, SEQ, D_MODEL), 1.0),
        'x_sample': nrm(ks[1], (DEC_BATCH, DEC_SEQ, D_MODEL), 1.0),
        'c_prompt': nrm(ks[2], (BATCH, D_MODEL), 1.0),
        'c_sample': nrm(ks[3], (DEC_BATCH, D_MODEL), 1.0),
        'cache_attn_k': nrm(ks[4], (DEPTH, DEC_BATCH, WINDOW, N_KV, HEAD_DIM), 1.0),
        'cache_attn_v': nrm(ks[5], (DEPTH, DEC_BATCH, WINDOW, N_KV, HEAD_DIM), 1.0),
        'state_conv': nrm(ks[6], (DEPTH, DEC_BATCH, CONV_K - 1, CONV_W), 0.5),
        'state_pool': nrm(ks[7], (DEPTH, DEC_BATCH, POOL_PAD, POOL_W), 1.0),
        'state_ret': nrm(ks[8], (DEPTH, DEC_BATCH, RET_HEADS, RET_DK, RET_DV), 1.0),
        'w_ada': nrm(ks[9], (DEPTH, D_MODEL, 6 * D_MODEL), 0.2 * D_MODEL ** -0.5),
        'b_ada': nrm(ks[10], (DEPTH, 6 * D_MODEL), 0.02),
        'g_norm1': 1.0 + nrm(ks[11], (DEPTH, D_MODEL), 0.02),
        'g_norm2': 1.0 + nrm(ks[12], (DEPTH, D_MODEL), 0.02),
        'w_in': nrm(ks[13], (DEPTH, D_MODEL, N_IN), D_MODEL ** -0.5),
        'g_qnorm': 1.0 + nrm(ks[14], (DEPTH, HEAD_DIM), 0.02),
        'g_knorm': 1.0 + nrm(ks[15], (DEPTH, HEAD_DIM), 0.02),
        'attn_sinks': nrm(ks[16], (DEPTH, N_HEADS), 0.5),
        'w_dw': nrm(ks[17], (DEPTH, CONV_K, CONV_W), CONV_K ** -0.5),
        'b_dw': nrm(ks[18], (DEPTH, CONV_W), 0.02),
        'g_conv_ln': 1.0 + nrm(ks[19], (DEPTH, CONV_W), 0.02),
        'b_conv_ln': nrm(ks[20], (DEPTH, CONV_W), 0.02),
        'w_pool': nrm(ks[21], (DEPTH, POOL_GROUPS, POOL_G, POOL_G), POOL_G ** -0.5),
        's_pool': 1.0 + nrm(ks[22], (DEPTH, POOL_W), 0.02),
        'g_ret_norm': 1.0 + nrm(ks[23], (DEPTH, BR_W), 0.02),
        'w_br': nrm(ks[24], (DEPTH, N_BR, BR_W, D_MODEL), BR_W ** -0.5),
        'w_out': nrm(ks[25], (DEPTH, D_MODEL, D_MODEL), D_MODEL ** -0.5),
        'w_mlp1': nrm(ks[26], (DEPTH, D_MODEL, D_FF), D_MODEL ** -0.5),
        'w_mlp2': nrm(ks[27], (DEPTH, D_FF, D_MODEL), D_FF ** -0.5),
    }


def reference(x_prompt, x_sample, c_prompt, c_sample, cache_attn_k, cache_attn_v, state_conv, state_pool, state_ret,
              w_ada, b_ada, g_norm1, g_norm2, w_in, g_qnorm, g_knorm, attn_sinks, w_dw, b_dw, g_conv_ln, b_conv_ln,
              w_pool, s_pool, g_ret_norm, w_br, w_out, w_mlp1, w_mlp2):
    yp, ys = x_prompt, x_sample
    new_p = [[], [], [], [], []]
    new_s = [[], [], [], [], []]
    for l in range(DEPTH):
        p = (w_ada[l], b_ada[l], g_norm1[l], g_norm2[l], w_in[l], g_qnorm[l], g_knorm[l], attn_sinks[l], w_dw[l],
             b_dw[l], g_conv_ln[l], b_conv_ln[l], w_pool[l], s_pool[l], g_ret_norm[l], w_br[l], w_out[l],
             w_mlp1[l], w_mlp2[l])
        yp, st_p = trunk_layer(yp, c_prompt, p, None)
        ys, st_s = trunk_layer(ys, c_sample, p, (cache_attn_k[l], cache_attn_v[l], state_conv[l], state_pool[l], state_ret[l]))
        for lst, a in zip(new_p, st_p):
            lst.append(a)
        for lst, a in zip(new_s, st_s):
            lst.append(a)
    new_attn_k_prompt = jnp.stack(new_p[0])
    new_attn_v_prompt = jnp.stack(new_p[1])
    new_conv_prompt = jnp.stack(new_p[2])
    new_pool_prompt = jnp.stack(new_p[3])
    new_ret_prompt = jnp.stack(new_p[4])
    new_attn_k_sample = jnp.stack(new_s[0])
    new_attn_v_sample = jnp.stack(new_s[1])
    new_conv_sample = jnp.stack(new_s[2])
    new_pool_sample = jnp.stack(new_s[3])
    new_ret_sample = jnp.stack(new_s[4])
    return (yp, ys, new_attn_k_prompt, new_attn_v_prompt, new_conv_prompt, new_pool_prompt, new_ret_prompt,
            new_attn_k_sample, new_attn_v_sample, new_conv_sample, new_pool_sample, new_ret_sample)
```

```cpp
#ifndef HOST_TEST_ONLY
#include <hip/hip_runtime.h>
#endif
#include <cstdio>
#include <cstdint>
#include <cmath>

#ifndef MK_ONE_LAUNCH
#define MK_ONE_LAUNCH 0
#endif

#define HD __host__ __device__ __forceinline__
typedef unsigned short bf16;
HD float bf2f(bf16 b) { return __builtin_bit_cast(float, ((unsigned)b) << 16); }
HD bf16 f2bf(float f) { unsigned u = __builtin_bit_cast(unsigned, f); return (bf16)((u + 0x7fffu + ((u >> 16) & 1u)) >> 16); }

HD void ld8(const bf16* p, float* f) { const uint4 w = *(const uint4*)p;
    f[0] = __builtin_bit_cast(float, w.x << 16); f[1] = __builtin_bit_cast(float, w.x & 0xffff0000u); f[2] = __builtin_bit_cast(float, w.y << 16); f[3] = __builtin_bit_cast(float, w.y & 0xffff0000u);
    f[4] = __builtin_bit_cast(float, w.z << 16); f[5] = __builtin_bit_cast(float, w.z & 0xffff0000u); f[6] = __builtin_bit_cast(float, w.w << 16); f[7] = __builtin_bit_cast(float, w.w & 0xffff0000u); }
HD void st8(bf16* p, const float* f) { uint4 w; w.x = (unsigned)f2bf(f[0]) | ((unsigned)f2bf(f[1]) << 16); w.y = (unsigned)f2bf(f[2]) | ((unsigned)f2bf(f[3]) << 16);
    w.z = (unsigned)f2bf(f[4]) | ((unsigned)f2bf(f[5]) << 16); w.w = (unsigned)f2bf(f[6]) | ((unsigned)f2bf(f[7]) << 16); *(uint4*)p = w; }
constexpr int DM = 2048, SEQ = 4096, NBP = 2, MP = NBP * SEQ, SB = 32, ST = 8, MS = SB * ST, M = MP + MS, DEPTH = 4;
constexpr int NROWB = NBP + SB;
constexpr int NH = 16, HDIM = 64, NKV = 4, WIN = 128, BRW = 1024, CONVK = 31, CPRE = 30, PPAD = 15, RH = 8, RDK = 64, RDV = 128, DFF = 8192;
constexpr int ZW = 15872, ZQ = 0, ZK = 1024, ZV = 1280, ZCA = 1536, ZCG = 2560, ZPL = 3584, ZRQ = 4608, ZRK = 5120, ZRV = 5632, ZRG = 6656, ZGT = 7680;
constexpr int ADAW = 6 * DM;
constexpr float EPS = 1e-6f;
constexpr size_t O_YP = 0, O_YS = O_YP + (size_t)MP * DM, O_KP = O_YS + (size_t)MS * DM, O_VP = O_KP + (size_t)DEPTH * NBP * WIN * 256,
    O_CP = O_VP + (size_t)DEPTH * NBP * WIN * 256, O_PP = O_CP + (size_t)DEPTH * NBP * CPRE * BRW, O_RP = O_PP + (size_t)DEPTH * NBP * PPAD * BRW,
    O_KS = O_RP + (size_t)DEPTH * NBP * RH * RDK * RDV, O_VS = O_KS + (size_t)DEPTH * SB * WIN * 256, O_CS = O_VS + (size_t)DEPTH * SB * WIN * 256,
    O_PS = O_CS + (size_t)DEPTH * SB * CPRE * BRW, O_RS = O_PS + (size_t)DEPTH * SB * PPAD * BRW, O_END = O_RS + (size_t)DEPTH * SB * RH * RDK * RDV;
static_assert(O_END == 41394176, "output size");
enum { I_XP = 0, I_XS, I_CP, I_CS, I_CK, I_CV, I_SCONV, I_SPOOL, I_SRET, I_WADA, I_BADA, I_G1, I_G2, I_WIN, I_GQ, I_GK, I_SINK, I_WDW, I_BDW, I_GCLN, I_BCLN,
       I_WPOOL, I_SPOOLS, I_GRET, I_WBR, I_WOUT, I_WM1, I_WM2, N_IN };

HD bool row_is_s(int row) { return row >= MP; }
HD int row_cond(int row) { return row < MP ? (row >> 12) : NBP + ((row - MP) >> 3); }

#if defined(__HIP_DEVICE_COMPILE__)
#define FEXP(x) __expf(x)
#else
#define FEXP(x) expf(x)
#endif
HD float sigmoidf_(float x) { return 1.f / (1.f + FEXP(-x)); }
HD float ret_logg(int h) { const float x = __builtin_bit_cast(float, (unsigned)(127 - 5 - h) << 23); return -x * (1.f + x * (0.5f + x * (0.33333334f + x * (0.25f + x * 0.2f)))); }

HD void qknorm_item(bf16* Z, int l, int row, int slot, const float* gq, const float* gk, float* out) {
    const int col = slot < 16 ? ZQ + slot * 64 : (slot < 20 ? ZK + (slot - 16) * 64 : ZV + (slot - 20) * 64);
    bf16* p = Z + (size_t)row * ZW + col;
    float v[64];
#pragma unroll
    for (int i = 0; i < 64; i += 8) ld8(p + i, v + i);
    if (slot < 20) {
        float ss = 0.f;
#pragma unroll
        for (int i = 0; i < 64; ++i) ss += v[i] * v[i];
        const float r = 1.f / sqrtf(ss * (1.f / 64.f) + EPS);
        const float* g = (slot < 16 ? gq : gk) + l * 64;
#pragma unroll
        for (int i = 0; i < 64; ++i) v[i] = v[i] * r * g[i];
#pragma unroll
        for (int i = 0; i < 64; i += 8) st8(p + i, v + i);
    }
    if (slot >= 16) {
        const int kvh = (slot - 16) & 3; const bool isv = slot >= 20;
        float* o = nullptr;
        if (!row_is_s(row)) { const int b = row >> 12, t = row & (SEQ - 1);
            if (t >= SEQ - WIN) o = out + (isv ? O_VP : O_KP) + ((((size_t)l * NBP + b) * WIN + (t - (SEQ - WIN))) * NKV + kvh) * 64;
        } else { const int sb = (row - MP) >> 3, t = (row - MP) & 7;
            o = out + (isv ? O_VS : O_KS) + ((((size_t)l * SB + sb) * WIN + (WIN - ST + t)) * NKV + kvh) * 64; }
        if (o) {
#pragma unroll
            for (int i = 0; i < 64; ++i) o[i] = v[i];
        }
    }
}
HD void shift_item(int l, int idx, const float* ck, const float* cv, const float* sconv, const float* spool, float* out) {
    constexpr int NKVS = SB * (WIN - ST) * 64, NCV = SB * (CPRE - ST) * 256, NPL = SB * (PPAD - ST) * 256;
    const float* src; float* dst;
    if (idx < 2 * NKVS) { const bool isv = idx >= NKVS; const int i = isv ? idx - NKVS : idx; const int sb = i / ((WIN - ST) * 64), rem = i % ((WIN - ST) * 64);
        src = (isv ? cv : ck) + (((size_t)l * SB + sb) * WIN + ST) * 256 + (size_t)rem * 4; dst = out + (isv ? O_VS : O_KS) + (((size_t)l * SB + sb) * WIN) * 256 + (size_t)rem * 4;
    } else if (idx < 2 * NKVS + NCV) { const int i = idx - 2 * NKVS; const int sb = i / ((CPRE - ST) * 256), rem = i % ((CPRE - ST) * 256);
        src = sconv + (((size_t)l * SB + sb) * CPRE + ST) * BRW + (size_t)rem * 4; dst = out + O_CS + (((size_t)l * SB + sb) * CPRE) * BRW + (size_t)rem * 4;
    } else { const int i = idx - 2 * NKVS - NCV; const int sb = i / ((PPAD - ST) * 256), rem = i % ((PPAD - ST) * 256);
        src = spool + (((size_t)l * SB + sb) * PPAD + ST) * BRW + (size_t)rem * 4; dst = out + O_PS + (((size_t)l * SB + sb) * PPAD) * BRW + (size_t)rem * 4; }
    dst[0] = src[0]; dst[1] = src[1]; dst[2] = src[2]; dst[3] = src[3];
}
constexpr int N_SHIFT_ITEMS = 2 * SB * (WIN - ST) * 64 + SB * (CPRE - ST) * 256 + SB * (PPAD - ST) * 256;

HD float glu_at(const bf16* Z, int row, int c) { const bf16* p = Z + (size_t)row * ZW; return bf2f(p[ZCA + c]) * sigmoidf_(bf2f(p[ZCG + c])); }
HD void conv_item(const bf16* Z, int l, int row, int c, const float* wdw, const float* bdw, const float* sconv, float* CONVY, float* out) {
    float acc = bdw[l * BRW + c];
    const float* w = wdw + (size_t)l * CONVK * BRW + c;
    if (!row_is_s(row)) { const int b = row >> 12, t = row & (SEQ - 1);
        for (int j = 0; j < CONVK; ++j) { const int tt = t - CPRE + j; if (tt >= 0) acc += w[(size_t)j * BRW] * glu_at(Z, b * SEQ + tt, c); }
        if (t >= SEQ - CPRE) out[O_CP + (((size_t)l * NBP + b) * CPRE + (t - (SEQ - CPRE))) * BRW + c] = glu_at(Z, row, c);
    } else { const int sb = (row - MP) >> 3, t = (row - MP) & 7;
        for (int j = 0; j < CONVK; ++j) { const int tt = t - CPRE + j;
            const float u = tt >= 0 ? glu_at(Z, MP + sb * ST + tt, c) : sconv[(((size_t)l * SB + sb) * CPRE + (CPRE + tt)) * BRW + c];
            acc += w[(size_t)j * BRW] * u; }
        out[O_CS + (((size_t)l * SB + sb) * CPRE + (CPRE - ST + t)) * BRW + c] = glu_at(Z, row, c);
    }
    CONVY[(size_t)row * BRW + c] = acc;
}
HD void pool_item(const bf16* Z, int l, int row, int c, const float* spool, bf16* ZP, float* out) {
    const int g = c >> 8, w = 2 << g;
    const float u0 = bf2f(Z[(size_t)row * ZW + ZPL + c]);
    float sum = 0.f, cnt;
    if (!row_is_s(row)) { const int b = row >> 12, t = row & (SEQ - 1);
        for (int i = 0; i < w; ++i) if (t - i >= 0) sum += bf2f(Z[(size_t)(b * SEQ + t - i) * ZW + ZPL + c]);
        cnt = (float)((t + 1) < w ? (t + 1) : w);
        if (t >= SEQ - PPAD) out[O_PP + (((size_t)l * NBP + b) * PPAD + (t - (SEQ - PPAD))) * BRW + c] = u0;
    } else { const int sb = (row - MP) >> 3, t = (row - MP) & 7;
        for (int i = 0; i < w; ++i) { const int tt = t - i;
            sum += tt >= 0 ? bf2f(Z[(size_t)(MP + sb * ST + tt) * ZW + ZPL + c]) : spool[(((size_t)l * SB + sb) * PPAD + (PPAD + tt)) * BRW + c]; }
        cnt = (float)w;
        out[O_PS + (((size_t)l * SB + sb) * PPAD + (PPAD - ST + t)) * BRW + c] = u0;
    }
    ZP[(size_t)row * BRW + c] = f2bf(sum / cnt - u0);
}
HD void retkv_item(const bf16* Z, float* KV, int b, int n, int h, int d, int v4) {
    const float lg = ret_logg(h);
    float a0 = 0.f, a1 = 0.f, a2 = 0.f, a3 = 0.f;
    for (int j = 0; j < 128; ++j) { const bf16* p = Z + (size_t)(b * SEQ + n * 128 + j) * ZW;
        const float kd = bf2f(p[ZRK + h * 64 + d]) * 0.125f * FEXP(lg * (float)(127 - j));
        const bf16* pv = p + ZRV + h * 128 + v4 * 4;
        a0 += kd * bf2f(pv[0]); a1 += kd * bf2f(pv[1]); a2 += kd * bf2f(pv[2]); a3 += kd * bf2f(pv[3]); }
    float* o = KV + ((((size_t)b * 32 + n) * RH + h) * RDK + d) * RDV + v4 * 4;
    o[0] = a0; o[1] = a1; o[2] = a2; o[3] = a3;
}
HD void retstate_s_item(const bf16* Z, int l, int sb, int h, int d, int v4, const float* sret, float* out) {
    const float lg = ret_logg(h);
    const size_t so = ((((size_t)l * SB + sb) * RH + h) * RDK + d) * RDV + v4 * 4;
    const float gc = FEXP(lg * (float)ST);
    float a0 = gc * sret[so], a1 = gc * sret[so + 1], a2 = gc * sret[so + 2], a3 = gc * sret[so + 3];
    for (int j = 0; j < ST; ++j) { const bf16* p = Z + (size_t)(MP + sb * ST + j) * ZW;
        const float kd = bf2f(p[ZRK + h * 64 + d]) * 0.125f * FEXP(lg * (float)(ST - 1 - j));
        const bf16* pv = p + ZRV + h * 128 + v4 * 4;
        a0 += kd * bf2f(pv[0]); a1 += kd * bf2f(pv[1]); a2 += kd * bf2f(pv[2]); a3 += kd * bf2f(pv[3]); }
    float* o = out + O_RS + so; o[0] = a0; o[1] = a1; o[2] = a2; o[3] = a3;
}
HD void retscan_item(const float* KV, float* SPREV, int l, int b, int h, int d, int v4, float* out) {
    const float gc = FEXP(ret_logg(h) * 128.f);
    float s0 = 0.f, s1 = 0.f, s2 = 0.f, s3 = 0.f;
    for (int n = 0; n < 32; ++n) { const size_t o = ((((size_t)b * 32 + n) * RH + h) * RDK + d) * RDV + v4 * 4;
        SPREV[o] = s0; SPREV[o + 1] = s1; SPREV[o + 2] = s2; SPREV[o + 3] = s3;
        s0 = gc * s0 + KV[o]; s1 = gc * s1 + KV[o + 1]; s2 = gc * s2 + KV[o + 2]; s3 = gc * s3 + KV[o + 3]; }
    float* oo = out + O_RP + ((((size_t)l * NBP + b) * RH + h) * RDK + d) * RDV + v4 * 4;
    oo[0] = s0; oo[1] = s1; oo[2] = s2; oo[3] = s3;
}
HD void attn_item(const bf16* Z, int l, int row, int hq, const float* sinks, const float* ck, const float* cv, bf16* Y0) {
    const int kvh = hq >> 2; const float slope = exp2f(-0.5f * (float)(hq + 1));
    float q[64];
    { const bf16* p = Z + (size_t)row * ZW + ZQ + hq * 64;
#pragma unroll
      for (int i = 0; i < 64; i += 8) ld8(p + i, q + i);
#pragma unroll
      for (int i = 0; i < 64; ++i) q[i] *= 0.125f; }
    float m = sinks[l * NH + hq], lsum = 1.f;
    float o[64];
#pragma unroll
    for (int i = 0; i < 64; ++i) o[i] = 0.f;
    const bool smp = row_is_s(row);
    const int b = smp ? ((row - MP) >> 3) : (row >> 12), t = smp ? ((row - MP) & 7) : (row & (SEQ - 1));
    const int lo = smp ? t : (t - WIN > 0 ? t - WIN : 0), hi = smp ? WIN + t : t;
    for (int j = lo; j <= hi; ++j) {
        const int dist = smp ? (WIN + t - j) : (t - j);
        const bool cache = smp && j < WIN;
        const size_t zrow = (size_t)(smp ? (MP + b * ST + (j - WIN)) : (b * SEQ + j)) * ZW;
        const size_t crow = ((((size_t)l * SB + b) * WIN + j) * NKV + kvh) * 64;
        float s = 0.f;
        if (cache) { const float* kp = ck + crow;
#pragma unroll
            for (int i = 0; i < 64; ++i) s += q[i] * kp[i];
        } else { const bf16* kp = Z + zrow + ZK + kvh * 64;
#pragma unroll
            for (int i = 0; i < 64; i += 8) { float f[8]; ld8(kp + i, f);
#pragma unroll
                for (int e = 0; e < 8; ++e) s += q[i + e] * f[e]; } }
        s -= slope * (float)dist;
        if (s > m) { const float corr = FEXP(m - s); lsum *= corr;
#pragma unroll
            for (int i = 0; i < 64; ++i) o[i] *= corr;
            m = s; }
        const float p = FEXP(s - m); lsum += p;
        if (cache) { const float* vp = cv + crow;
#pragma unroll
            for (int i = 0; i < 64; ++i) o[i] += p * vp[i];
        } else { const bf16* vp = Z + zrow + ZV + kvh * 64;
#pragma unroll
            for (int i = 0; i < 64; i += 8) { float f[8]; ld8(vp + i, f);
#pragma unroll
                for (int e = 0; e < 8; ++e) o[i + e] += p * f[e]; } }
    }
    const float inv = 1.f / lsum;
    bf16* y = Y0 + (size_t)row * BRW + hq * 64;
#pragma unroll
    for (int i = 0; i < 64; ++i) o[i] *= inv;
#pragma unroll
    for (int i = 0; i < 64; i += 8) st8(y + i, o + i);
}
HD void retout_item(const bf16* Z, int l, int row, int h, const float* SPREV, const float* sret, const float* gret, float* ORAW, bf16* Y3) {
    const float lg = ret_logg(h);
    const bool smp = row_is_s(row);
    const int b = smp ? ((row - MP) >> 3) : (row >> 12), t = smp ? ((row - MP) & 7) : (row & (SEQ - 1));
    const int i = smp ? t : (t & 127), n = smp ? 0 : (t >> 7);
    const int row0 = smp ? (MP + b * ST) : (b * SEQ + n * 128);
    const float* S = smp ? sret + (((size_t)l * SB + b) * RH + h) * RDK * RDV : SPREV + (((size_t)b * 32 + n) * RH + h) * RDK * RDV;
    float q[64];
    { const bf16* p = Z + (size_t)row * ZW + ZRQ + h * 64;
#pragma unroll
      for (int d = 0; d < 64; d += 8) ld8(p + d, q + d); }
    float* oraw = ORAW + (size_t)row * BRW + h * 128;
    float sum = 0.f;
    for (int half = 0; half < 2; ++half) {
        float o[64];
#pragma unroll
        for (int v = 0; v < 64; ++v) o[v] = 0.f;
        for (int j = 0; j <= i; ++j) { const bf16* p = Z + (size_t)(row0 + j) * ZW;
            const bf16* kp = p + ZRK + h * 64; float s = 0.f;
#pragma unroll
            for (int d = 0; d < 64; d += 8) { float f[8]; ld8(kp + d, f);
#pragma unroll
                for (int e = 0; e < 8; ++e) s += q[d + e] * f[e]; }
            s *= 0.125f * FEXP(lg * (float)(i - j));
            const bf16* vp = p + ZRV + h * 128 + half * 64;
#pragma unroll
            for (int v = 0; v < 64; v += 8) { float f[8]; ld8(vp + v, f);
#pragma unroll
                for (int e = 0; e < 8; ++e) o[v + e] += s * f[e]; } }
        const float cf = FEXP(lg * (float)(i + 1));
        const bf16* qp = Z + (size_t)row * ZW + ZRQ + h * 64;
        for (int d = 0; d < 64; ++d) { const float qd = bf2f(qp[d]) * cf; const float* sp = S + (size_t)d * RDV + half * 64;
#pragma unroll
            for (int v = 0; v < 64; ++v) o[v] += qd * sp[v]; }
#pragma unroll
        for (int v = 0; v < 64; ++v) { oraw[half * 64 + v] = o[v]; sum += o[v]; }
    }
    const float mean = sum * (1.f / 128.f);
    float var = 0.f;
    for (int v = 0; v < 128; ++v) { const float d = oraw[v] - mean; var += d * d; }
    const float rstd = 1.f / sqrtf(var * (1.f / 128.f) + EPS);
    const float* g = gret + l * BRW + h * 128;
    const bf16* rg = Z + (size_t)row * ZW + ZRG + h * 128;
    bf16* y = Y3 + (size_t)row * BRW + h * 128;
    for (int v = 0; v < 128; ++v) y[v] = f2bf((oraw[v] - mean) * rstd * g[v] * bf2f(rg[v]));
}

#if !defined(HOST_TEST_ONLY)
namespace pg8 {
#define PG8_LAS __attribute__((address_space(3)))
typedef short bf16x8 __attribute__((ext_vector_type(8)));
typedef float f32x4 __attribute__((ext_vector_type(4)));
typedef float f32x2 __attribute__((ext_vector_type(2)));
typedef unsigned u32x4 __attribute__((ext_vector_type(4)));
typedef unsigned u32x2 __attribute__((ext_vector_type(2)));
constexpr int BM = 256, BK = 64, HALF = 128, HTB = HALF * BK * 2, STAGE_BYTES = 8 * HTB, NXCD = 8, WGM = 8;

__host__ __device__ __forceinline__ int lds_byte(int r, int c) { const int st = (r >> 4) * 2 + (c >> 5), rr = r & 15, cc = c & 31, ob = rr * 64 + cc * 2; return st * 1024 + (ob ^ (((ob >> 9) & 1) << 5)); }
__host__ __device__ __forceinline__ void stage_rc(int b, int& R, int& C) { const int st = b / 1024, sb = b % 1024, swz = sb ^ (((sb >> 9) & 1) << 5); R = (st >> 1) * 16 + swz / 64; C = (st & 1) * 32 + (swz % 64) / 2; }
__host__ __device__ __forceinline__ int perm32(int rho) { const int n = rho >> 4, i = rho & 15; return 8 * (i >> 2) + 4 * n + (i & 3); }

struct Unit { int pm, pn, r; const char* a; const char* b; };
struct Dims { int lda, ldb, K; };

__host__ __device__ __forceinline__ void tile_of(int L, int nM, int nN, int& pm, int& pn) {
    const int nwg = nM * nN; int wgid = L; { const int q = nwg / NXCD, r = nwg % NXCD, xcd = wgid % NXCD, off = wgid / NXCD; wgid = (xcd < r ? xcd * (q + 1) : r * (q + 1) + (xcd - r) * q) + off; }
    const int nig = WGM * nN, gid = wgid / nig, fm = gid * WGM, gsz = (nM - fm) < WGM ? (nM - fm) : WGM;
    pm = fm + ((wgid % nig) % gsz); pn = (wgid % nig) / gsz;
}
struct StaticOrder {
    int nM, nN, nwg, G, c; const char* A; const char* B; size_t ta, tb;
    __device__ __forceinline__ void init(const bf16* A_, const bf16* B_, int nM_, int nN_, int lda, int ldb, int G_, int c_) { A = (const char*)A_; B = (const char*)B_; nM = nM_; nN = nN_; nwg = nM * nN; G = G_; c = c_; ta = (size_t)BM * lda * 2; tb = (size_t)BM * ldb * 2; }
    __device__ __forceinline__ bool next(int i, Unit& u) const {
        const long L = (long)i * G + c; if (L >= nwg) return false;
        tile_of((int)L, nM, nN, u.pm, u.pn); u.r = 0; u.a = A + (size_t)u.pm * ta; u.b = B + (size_t)u.pn * tb; return true;
    }
};

__device__ __forceinline__ unsigned cvt_pk_bf16(float lo, float hi) { unsigned r; asm volatile("v_cvt_pk_bf16_f32 %0, %1, %2" : "=v"(r) : "v"(lo), "v"(hi)); return r; }

template <class Epi, class Sched, bool ALIGN_EPI = true, bool SP2 = true>
__device__ __forceinline__ void gemm_phase(PG8_LAS unsigned char* lds, const Dims g, const Sched& S, const Epi& E, const int tid) {
    const int wid = __builtin_amdgcn_readfirstlane(tid >> 6), lane = tid & 63, wr = wid >> 2, wc = wid & 3, fr = lane & 15, fq = lane >> 4;
    const int K = g.K, nt = K / BK;
    unsigned voffA[2], voffB[2];
#pragma unroll
    for (int i = 0; i < 2; ++i) { int R, C; stage_rc(tid * 16 + i * 8192, R, C); const int Rb = Epi::PERM ? ((R & ~31) + perm32(R & 31)) : R;
        voffA[i] = (unsigned)(R * g.lda + C) * 2u; voffB[i] = (unsigned)(Rb * g.ldb + C) * 2u; }
    const size_t kstep = (size_t)(BK * 2);
    const size_t hstepA = (size_t)HALF * g.lda * 2, hstepB = (size_t)HALF * g.ldb * 2;
    const unsigned ldsw = (unsigned)wid * 1024u;
    const int aoff = lds_byte(wr * 64 + fr, fq * 8), boff = lds_byte(wc * 32 + fr, fq * 8);
#define PG8_SA(b, h) (((b) * 2 + (h)) * HTB)
#define PG8_SB(b, h) ((4 + (b) * 2 + (h)) * HTB)
#define PG8_STAGE(bufoff, gbase, voff) do { _Pragma("unroll") for (int _i = 0; _i < 2; ++_i) \
        __builtin_amdgcn_global_load_lds((const unsigned*)((const char*)(gbase) + (voff)[_i]), (PG8_LAS unsigned*)(lds + (bufoff) + ldsw + _i * 8192), 16, 0, 0); } while (0)
#define PG8_LDA(dst, b, h) do { _Pragma("unroll") for (int m = 0; m < 4; ++m) _Pragma("unroll") for (int k = 0; k < 2; ++k) dst[m][k] = *(const PG8_LAS bf16x8*)(lds + PG8_SA(b, h) + aoff + m * 2048 + k * 1024); } while (0)
#define PG8_LDB(dst, b, h) do { _Pragma("unroll") for (int n = 0; n < 2; ++n) _Pragma("unroll") for (int k = 0; k < 2; ++k) dst[n][k] = *(const PG8_LAS bf16x8*)(lds + PG8_SB(b, h) + boff + n * 2048 + k * 1024); } while (0)
#define PG8_MMA(ai, bj, At, Bt) do { __builtin_amdgcn_s_setprio(1); _Pragma("unroll") for (int m = 0; m < 4; ++m) _Pragma("unroll") for (int n = 0; n < 2; ++n) _Pragma("unroll") for (int k = 0; k < 2; ++k) \
        acc[ai][bj][m][n] = __builtin_amdgcn_mfma_f32_16x16x32_bf16(Bt[n][k], At[m][k], acc[ai][bj][m][n], 0, 0, 0); __builtin_amdgcn_s_setprio(0); } while (0)
#define PG8_WAIT_V(n) asm volatile("s_waitcnt vmcnt(" #n ")" ::: "memory")
#define PG8_WAIT_L(n) asm volatile("s_waitcnt lgkmcnt(" #n ")" ::: "memory")
#define PG8_BAR __builtin_amdgcn_s_barrier()
#define PG8_SCHED __builtin_amdgcn_sched_barrier(0)
    Unit cur, nxt; int ui = 0;
    if (!S.next(0, cur)) return;
    f32x4 acc[2][2][4][2];
#pragma unroll
    for (int a = 0; a < 2; ++a)
#pragma unroll
        for (int b = 0; b < 2; ++b)
#pragma unroll
            for (int m = 0; m < 4; ++m)
#pragma unroll
                for (int n = 0; n < 2; ++n) acc[a][b][m][n] = (f32x4){0.f, 0.f, 0.f, 0.f};
    bf16x8 At[4][2], B0[2][2], B1[2][2];
    const char* cA = cur.a; const char* cB = cur.b;
    if constexpr (SP2) {
        PG8_STAGE(PG8_SB(0, 0), cB, voffB); PG8_STAGE(PG8_SB(0, 1), cB + hstepB, voffB); PG8_STAGE(PG8_SA(0, 0), cA, voffA); PG8_STAGE(PG8_SA(0, 1), cA + hstepA, voffA);
        if (wr == 1) PG8_BAR;
        PG8_WAIT_V(2); PG8_BAR;
        PG8_STAGE(PG8_SB(1, 0), cB + kstep, voffB); PG8_STAGE(PG8_SA(1, 0), cA + kstep, voffA); PG8_STAGE(PG8_SB(1, 1), cB + hstepB + kstep, voffB);
        PG8_WAIT_V(6); PG8_BAR;
    } else {
        PG8_STAGE(PG8_SB(0, 0), cB, voffB); PG8_STAGE(PG8_SA(0, 0), cA, voffA); PG8_STAGE(PG8_SB(0, 1), cB + hstepB, voffB); PG8_STAGE(PG8_SA(0, 1), cA + hstepA, voffA);
        if (wr == 1) PG8_BAR;
        PG8_WAIT_V(4); PG8_BAR;
        PG8_STAGE(PG8_SB(1, 0), cB + kstep, voffB); PG8_STAGE(PG8_SA(1, 0), cA + kstep, voffA); PG8_STAGE(PG8_SB(1, 1), cB + hstepB + kstep, voffB);
        PG8_WAIT_V(6); PG8_BAR;
    }
    for (;;) {
        const bool has_next = S.next(ui + 1, nxt);
        const char* nA = has_next ? nxt.a : cA; const char* nB = has_next ? nxt.b : cB;
        for (int t = 0; t < nt; t += 2) {
            const bool last = (t == nt - 2);
            const char* a1 = cA + (size_t)(t + 1) * kstep;
            const char* a2 = last ? nA : cA + (size_t)(t + 2) * kstep; const char* b2 = last ? nB : cB + (size_t)(t + 2) * kstep;
            const char* a3 = a2 + kstep; const char* b3 = b2 + kstep;
            if constexpr (SP2) {
            PG8_LDB(B0, 0, 0); PG8_LDB(B1, 0, 1); PG8_SCHED; PG8_LDA(At, 0, 0); PG8_STAGE(PG8_SA(1, 1), a1 + hstepA, voffA);
            PG8_WAIT_V(8); PG8_WAIT_L(0); PG8_BAR; PG8_MMA(0, 0, At, B0); PG8_MMA(0, 1, At, B1); PG8_BAR; PG8_SCHED;
            PG8_LDA(At, 0, 1); PG8_STAGE(PG8_SB(0, 0), b2, voffB); PG8_STAGE(PG8_SB(0, 1), b2 + hstepB, voffB); PG8_STAGE(PG8_SA(0, 0), a2, voffA);
            PG8_WAIT_V(8); PG8_WAIT_L(0); PG8_BAR; PG8_MMA(1, 0, At, B0); PG8_MMA(1, 1, At, B1); PG8_BAR; PG8_SCHED;
            PG8_LDB(B0, 1, 0); PG8_LDB(B1, 1, 1); PG8_SCHED; PG8_LDA(At, 1, 0); PG8_STAGE(PG8_SA(0, 1), a2 + hstepA, voffA);
            PG8_WAIT_V(8); PG8_WAIT_L(0); PG8_BAR; PG8_MMA(0, 0, At, B0); PG8_MMA(0, 1, At, B1); PG8_BAR; PG8_SCHED;
            PG8_LDA(At, 1, 1); PG8_STAGE(PG8_SB(1, 0), b3, voffB); PG8_STAGE(PG8_SB(1, 1), b3 + hstepB, voffB); PG8_STAGE(PG8_SA(1, 0), a3, voffA);
            PG8_WAIT_V(8); PG8_WAIT_L(0); PG8_BAR; PG8_MMA(1, 0, At, B0); PG8_MMA(1, 1, At, B1); PG8_BAR; PG8_SCHED;
            } else {
            PG8_LDB(B0, 0, 0); PG8_SCHED; PG8_LDA(At, 0, 0); PG8_STAGE(PG8_SA(1, 1), a1 + hstepA, voffA);
            PG8_WAIT_L(8); PG8_BAR; PG8_WAIT_L(0); PG8_MMA(0, 0, At, B0); PG8_BAR; PG8_SCHED;
            PG8_LDB(B1, 0, 1); PG8_STAGE(PG8_SB(0, 0), b2, voffB);
            PG8_BAR; PG8_WAIT_L(0); PG8_MMA(0, 1, At, B1); PG8_BAR;
            PG8_LDA(At, 0, 1); PG8_STAGE(PG8_SA(0, 0), a2, voffA);
            PG8_BAR; PG8_WAIT_L(0); PG8_MMA(1, 0, At, B0); PG8_BAR; PG8_SCHED;
            PG8_STAGE(PG8_SB(0, 1), b2 + hstepB, voffB);
            PG8_WAIT_V(6); PG8_BAR; PG8_MMA(1, 1, At, B1); PG8_BAR;
            PG8_LDB(B0, 1, 0); PG8_SCHED; PG8_LDA(At, 1, 0); PG8_STAGE(PG8_SA(0, 1), a2 + hstepA, voffA);
            PG8_WAIT_L(8); PG8_BAR; PG8_WAIT_L(0); PG8_MMA(0, 0, At, B0); PG8_BAR; PG8_SCHED;
            PG8_LDB(B1, 1, 1); PG8_STAGE(PG8_SB(1, 0), b3, voffB);
            PG8_BAR; PG8_WAIT_L(0); PG8_MMA(0, 1, At, B1); PG8_BAR;
            PG8_LDA(At, 1, 1); PG8_STAGE(PG8_SA(1, 0), a3, voffA);
            PG8_BAR; PG8_WAIT_L(0); PG8_MMA(1, 0, At, B0); PG8_BAR; PG8_SCHED;
            PG8_STAGE(PG8_SB(1, 1), b3 + hstepB, voffB);
            PG8_WAIT_V(6); PG8_BAR; PG8_MMA(1, 1, At, B1); PG8_BAR;
            }
        }
        if constexpr (ALIGN_EPI) { if (wr == 0) PG8_BAR; }
        { int ln; asm volatile("v_mbcnt_lo_u32_b32 %0, -1, 0\n\tv_mbcnt_hi_u32_b32 %0, -1, %0" : "=v"(ln)); E(acc, cur, wr, wc, ln & 15, ln >> 4); }
        if (!has_next) break;
#pragma unroll
        for (int a = 0; a < 2; ++a)
#pragma unroll
            for (int b = 0; b < 2; ++b)
#pragma unroll
                for (int m = 0; m < 4; ++m)
#pragma unroll
                    for (int n = 0; n < 2; ++n) acc[a][b][m][n] = (f32x4){0.f, 0.f, 0.f, 0.f};
        cur = nxt; cA = nA; cB = nB; ++ui;
        if constexpr (ALIGN_EPI) { if (wr == 1) PG8_BAR; }
    }
    PG8_WAIT_V(0);
    if constexpr (!ALIGN_EPI) { if (wr == 0) PG8_BAR; }
    PG8_BAR;
#undef PG8_SA
#undef PG8_SB
#undef PG8_STAGE
#undef PG8_LDA
#undef PG8_LDB
#undef PG8_MMA
#undef PG8_WAIT_V
#undef PG8_WAIT_L
#undef PG8_BAR
#undef PG8_SCHED
}

__device__ __forceinline__ float fsigmoid(float x) { return __builtin_amdgcn_rcpf(1.f + __expf(-x)); }
struct EpiZ {
    static constexpr bool PERM = true;
    bf16* Z;
    __device__ __forceinline__ void operator()(const f32x4 (&acc)[2][2][4][2], const Unit& u, int wr, int wc, int fr, int fq) const {
        const int row0 = u.pm * BM + wr * 64 + fr, col0 = u.pn * BM + wc * 32 + 8 * fq;
        const int ty = u.pn >= 30 ? 2 : (u.pn >= 26 ? 1 : 0);
#pragma unroll
        for (int ai = 0; ai < 2; ++ai)
#pragma unroll
            for (int m = 0; m < 4; ++m) { bf16* rowp = Z + (size_t)(row0 + ai * HALF + m * 16) * ZW + col0;
#pragma unroll
                for (int bj = 0; bj < 2; ++bj) { f32x4 v0 = acc[ai][bj][m][0], v1 = acc[ai][bj][m][1];
                    if (ty == 2) {
#pragma unroll
                        for (int j = 0; j < 4; ++j) { v0[j] = fsigmoid(v0[j]); v1[j] = fsigmoid(v1[j]); } }
                    else if (ty == 1) {
#pragma unroll
                        for (int j = 0; j < 4; ++j) { v0[j] = v0[j] * fsigmoid(v0[j]); v1[j] = v1[j] * fsigmoid(v1[j]); } }
                    u32x4 w; w.x = cvt_pk_bf16(v0[0], v0[1]); w.y = cvt_pk_bf16(v0[2], v0[3]); w.z = cvt_pk_bf16(v1[0], v1[1]); w.w = cvt_pk_bf16(v1[2], v1[3]);
                    *(u32x4*)(rowp + bj * HALF) = w; } }
    }
};
struct EpiMlp1 {
    static constexpr bool PERM = true;
    bf16* O;
    __device__ __forceinline__ void operator()(const f32x4 (&acc)[2][2][4][2], const Unit& u, int wr, int wc, int fr, int fq) const {
        const int row0 = u.pm * BM + wr * 64 + fr, col0 = u.pn * BM + wc * 32 + 8 * fq;
#pragma unroll
        for (int ai = 0; ai < 2; ++ai)
#pragma unroll
            for (int m = 0; m < 4; ++m) { bf16* rowp = O + (size_t)(row0 + ai * HALF + m * 16) * DFF + col0;
#pragma unroll
                for (int bj = 0; bj < 2; ++bj) { f32x4 v0 = acc[ai][bj][m][0], v1 = acc[ai][bj][m][1];
#pragma unroll
                    for (int j = 0; j < 4; ++j) { const float a = fmaxf(v0[j], 0.f), b = fmaxf(v1[j], 0.f); v0[j] = a * a; v1[j] = b * b; }
                    u32x4 w; w.x = cvt_pk_bf16(v0[0], v0[1]); w.y = cvt_pk_bf16(v0[2], v0[3]); w.z = cvt_pk_bf16(v1[0], v1[1]); w.w = cvt_pk_bf16(v1[2], v1[3]);
                    *(u32x4*)(rowp + bj * HALF) = w; } }
    }
};
struct EpiPool {
    static constexpr bool PERM = true;
    bf16* Y2; const float* spb; int l;
    __device__ __forceinline__ void operator()(const f32x4 (&acc)[2][2][4][2], const Unit& u, int wr, int wc, int fr, int fq) const {
        const int row0 = u.pm * BM + wr * 64 + fr, col0 = u.pn * BM + wc * 32 + 8 * fq;
        int le = l; asm volatile("" : "+s"(le)); const float* sp = spb + le * BRW;
        f32x4 s[2][2];
#pragma unroll
        for (int bj = 0; bj < 2; ++bj)
#pragma unroll
            for (int n = 0; n < 2; ++n) s[bj][n] = *(const f32x4*)(sp + col0 + bj * HALF + 4 * n);
#pragma unroll
        for (int ai = 0; ai < 2; ++ai)
#pragma unroll
            for (int m = 0; m < 4; ++m) { bf16* rowp = Y2 + (size_t)(row0 + ai * HALF + m * 16) * BRW + col0;
#pragma unroll
                for (int bj = 0; bj < 2; ++bj) { const f32x4 v0 = acc[ai][bj][m][0] * s[bj][0], v1 = acc[ai][bj][m][1] * s[bj][1];
                    u32x4 w; w.x = cvt_pk_bf16(v0[0], v0[1]); w.y = cvt_pk_bf16(v0[2], v0[3]); w.z = cvt_pk_bf16(v1[0], v1[1]); w.w = cvt_pk_bf16(v1[2], v1[3]);
                    *(u32x4*)(rowp + bj * HALF) = w; } }
    }
};
struct EpiAda {
    static constexpr bool PERM = false;
    float* ADA; const float* bada;
    __device__ __forceinline__ void operator()(const f32x4 (&acc)[2][2][4][2], const Unit& u, int wr, int wc, int fr, int fq) const {
        if (wr != 0) return;
        const int col0 = u.pn * BM + wc * 32 + 4 * fq;
#pragma unroll
        for (int m = 0; m < 3; ++m) { const int row = m * 16 + fr;
            if (row < NROWB) {
#pragma unroll
                for (int bj = 0; bj < 2; ++bj)
#pragma unroll
                    for (int n = 0; n < 2; ++n) { const int c = col0 + bj * HALF + n * 16; const f32x4 bv = *(const f32x4*)(bada + (size_t)u.r * ADAW + c);
                        *(f32x4*)(ADA + ((size_t)u.r * NROWB + row) * ADAW + c) = acc[0][bj][m][n] + bv; } } }
    }
};
struct EpiBr {
    static constexpr bool PERM = true;
    const bf16* Z; float* MACC; bf16* MERGED;
    __device__ __forceinline__ void operator()(const f32x4 (&acc)[2][2][4][2], const Unit& u, int wr, int wc, int fr, int fq) const {
        const int row0 = u.pm * BM + wr * 64 + fr, col0 = u.pn * BM + wc * 32 + 8 * fq;
        const int r = u.r;
#pragma unroll
        for (int ai = 0; ai < 2; ++ai)
#pragma unroll
            for (int m = 0; m < 4; ++m) { const size_t row = (size_t)(row0 + ai * HALF + m * 16);
#pragma unroll
                for (int bj = 0; bj < 2; ++bj) { const int c = col0 + bj * HALF;
                    const u32x4 gw = *(const u32x4*)(Z + row * ZW + ZGT + r * DM + c);
                    f32x4 g0, g1;
                    g0[0] = __builtin_bit_cast(float, gw.x << 16); g0[1] = __builtin_bit_cast(float, gw.x & 0xffff0000u); g0[2] = __builtin_bit_cast(float, gw.y << 16); g0[3] = __builtin_bit_cast(float, gw.y & 0xffff0000u);
                    g1[0] = __builtin_bit_cast(float, gw.z << 16); g1[1] = __builtin_bit_cast(float, gw.z & 0xffff0000u); g1[2] = __builtin_bit_cast(float, gw.w << 16); g1[3] = __builtin_bit_cast(float, gw.w & 0xffff0000u);
                    f32x4 v0 = acc[ai][bj][m][0] * g0, v1 = acc[ai][bj][m][1] * g1;
                    float* mp = MACC + row * DM + c;
                    if (r > 0) { v0 += *(const f32x4*)mp; v1 += *(const f32x4*)(mp + 4); }
                    if (r < 3) { *(f32x4*)mp = v0; *(f32x4*)(mp + 4) = v1; }
                    else { u32x4 w; w.x = cvt_pk_bf16(v0[0], v0[1]); w.y = cvt_pk_bf16(v0[2], v0[3]); w.z = cvt_pk_bf16(v1[0], v1[1]); w.w = cvt_pk_bf16(v1[2], v1[3]);
                        *(u32x4*)(MERGED + row * DM + c) = w; } } }
    }
};
struct EpiRes {
    static constexpr bool PERM = false;
    const float* baseP; const float* baseS; float* out; const float* gate;
    __device__ __forceinline__ void operator()(const f32x4 (&acc)[2][2][4][2], const Unit& u, int wr, int wc, int fr, int fq) const {
        const int rl0 = wr * 64 + fr, col0 = u.pn * BM + wc * 32 + 4 * fq;
        const bool smp = u.pm >= MP / BM;
        const float* base = smp ? baseS : baseP + (size_t)u.pm * BM * DM;
        float* o = out + (size_t)u.pm * BM * DM;
#pragma unroll
        for (int ai = 0; ai < 2; ++ai)
#pragma unroll
            for (int m = 0; m < 4; ++m) { const int rl = rl0 + ai * HALF + m * 16;
                const float* gp = gate + (size_t)(smp ? NBP + (rl >> 3) : (u.pm >> 4)) * ADAW + col0;
#pragma unroll
                for (int bj = 0; bj < 2; ++bj)
#pragma unroll
                    for (int n = 0; n < 2; ++n) { const int c = bj * HALF + n * 16;
                        const f32x4 gv = *(const f32x4*)(gp + c); const f32x4 bs = *(const f32x4*)(base + (size_t)rl * DM + col0 + c);
                        *(f32x4*)(o + (size_t)rl * DM + col0 + c) = bs + gv * acc[ai][bj][m][n]; } }
    }
};
}

constexpr int NWAVES = 8, NTHR = NWAVES * 64;
constexpr size_t MiB = 1u << 20;
constexpr size_t al1(size_t x) { return (x + MiB - 1) / MiB * MiB; }
constexpr size_t WS_CTL = 0, CTL_ZERO_BYTES = 1 * MiB;
constexpr size_t WS_WIN = WS_CTL + CTL_ZERO_BYTES;
constexpr size_t WS_WBR = WS_WIN + al1((size_t)DEPTH * ZW * DM * 2);
constexpr size_t WS_WOUT = WS_WBR + al1((size_t)DEPTH * 4 * DM * BRW * 2);
constexpr size_t WS_WM1 = WS_WOUT + al1((size_t)DEPTH * DM * DM * 2);
constexpr size_t WS_WM2 = WS_WM1 + al1((size_t)DEPTH * DFF * DM * 2);
constexpr size_t WS_WPOOL = WS_WM2 + al1((size_t)DEPTH * DFF * DM * 2);
constexpr size_t WS_WADA = WS_WPOOL + al1((size_t)DEPTH * 4 * 256 * 256 * 2);
constexpr size_t WS_SC = WS_WADA + al1((size_t)DEPTH * ADAW * DM * 2);
constexpr size_t WS_ADA = WS_SC + al1((size_t)256 * DM * 2);
constexpr size_t WS_H = WS_ADA + al1((size_t)DEPTH * NROWB * ADAW * 4);
constexpr size_t WS_Z = WS_H + al1((size_t)M * DM * 2);
constexpr size_t WS_Y = WS_Z + al1((size_t)M * ZW * 2);
constexpr size_t WS_ZP = WS_Y + al1((size_t)4 * M * BRW * 2);
constexpr size_t WS_CONVY = WS_ZP + al1((size_t)M * BRW * 2);
constexpr size_t WS_ORAW = WS_CONVY + al1((size_t)M * BRW * 4);
constexpr size_t WS_KV = WS_ORAW + al1((size_t)M * BRW * 4);
constexpr size_t WS_SPREV = WS_KV + al1((size_t)NBP * 32 * RH * RDK * RDV * 4);
constexpr size_t WS_MACC = WS_SPREV + al1((size_t)NBP * 32 * RH * RDK * RDV * 4);
constexpr size_t WS_MERGED = WS_MACC + al1((size_t)M * DM * 4);
constexpr size_t WS_X1 = WS_MERGED + al1((size_t)M * DM * 2);
constexpr size_t WS_X = WS_X1 + al1((size_t)M * DM * 4);
constexpr size_t WS_HID = WS_X + al1((size_t)M * DM * 4);
constexpr size_t WS_END = WS_HID + al1((size_t)M * DFF * 2);
constexpr int CW_BAR = 4096;
constexpr int RING_OFF = 0, RING_BYTES = 131072, LDSCTL_OFF = RING_BYTES, MISC_OFF = LDSCTL_OFF + 320, INTAB_OFF = MISC_OFF + 128, LDS_BYTES = 147456;

#define GAS __attribute__((address_space(1)))
#define LAS __attribute__((address_space(3)))
typedef unsigned v4u __attribute__((ext_vector_type(4)));
typedef float f32x4 __attribute__((ext_vector_type(4)));
typedef GAS unsigned gu32;
#define RLX_AGENT __ATOMIC_RELAXED, __HIP_MEMORY_SCOPE_AGENT
#define LDS_WAIT() asm volatile("s_waitcnt lgkmcnt(0)" ::: "memory")
__device__ __forceinline__ unsigned pk2(float lo, float hi) { return (unsigned)f2bf(lo) | ((unsigned)f2bf(hi) << 16); }

#define XB_TMO      128
#define XB_XCNT(j)  (256  + 64 * (j))
#define XB_XSUB(j)  (1280 + 64 * (j))
#define XB_XGEN(j)  (2304 + 64 * (j))
#define XB_TOP      3328
#define XB_TOPGEN   3392
#define XCD_BAR_WORDS 3456
#define XB_SPIN_CAP (1u << 18)
__device__ __forceinline__ unsigned xb_ld(unsigned* p)              { return __hip_atomic_load(p, __ATOMIC_RELAXED, __HIP_MEMORY_SCOPE_AGENT); }
__device__ __forceinline__ unsigned xb_add(unsigned* p, unsigned v) { return __hip_atomic_fetch_add(p, v, __ATOMIC_RELAXED, __HIP_MEMORY_SCOPE_AGENT); }
__device__ __forceinline__ unsigned xb_xcc_id() { return (unsigned)__builtin_amdgcn_s_getreg((3 << 11) | 20) & 0xFu; }
#define XB_SPIN(cond, bar) do { unsigned _sp = 0; while (cond) { __builtin_amdgcn_s_sleep(1); \
    if ((++_sp & 255u) == 0u) { if (xb_ld(&(bar)[XB_TMO])) break; if (_sp > XB_SPIN_CAP) { atomicAdd(&(bar)[XB_TMO], 1u); break; } } } } while (0)
struct XcdBarrier { unsigned* bar; unsigned x; volatile LAS unsigned* st; };
__device__ __forceinline__ XcdBarrier xcd_barrier_post(unsigned* bar, volatile LAS unsigned* st) {
    XcdBarrier b; b.bar = bar; b.x = xb_xcc_id(); b.st = st;
    if (threadIdx.x == 0) (void)xb_add(&bar[XB_XCNT(b.x)], 1u);
    return b;
}
__device__ __forceinline__ void xcd_barrier_complete(unsigned* bar, unsigned x, unsigned& nloc, unsigned& nx) {
    const unsigned G = gridDim.x * gridDim.y * gridDim.z;
    unsigned sum, cnt, mine, sp = 0u;
    for (;;) {
        sum = 0u; cnt = 0u; mine = 0u;
#pragma unroll
        for (unsigned j = 0; j < 16; ++j) { const unsigned c = xb_ld(&bar[XB_XCNT(j)]); sum += c; cnt += (c > 0u) ? 1u : 0u; mine = (j == x) ? c : mine; }
        if (sum == G) break;
        __builtin_amdgcn_s_sleep(1);
        if ((++sp & 255u) == 0u) { if (xb_ld(&bar[XB_TMO])) break; if (sp > XB_SPIN_CAP) { atomicAdd(&bar[XB_TMO], 1u); break; } }
    }
    nloc = mine > 0u ? mine : 1u; nx = cnt > 0u ? cnt : 1u;
}
__device__ __forceinline__ void xcd_barrier(const XcdBarrier& b) {
    asm volatile("s_waitcnt vmcnt(0)" ::: "memory");
    __syncthreads();
    if (threadIdx.x == 0) {
        unsigned* bar = b.bar;
        __builtin_amdgcn_s_waitcnt(0);
        unsigned nloc = b.st[0], nx = b.st[1];
        if (nloc == 0u) { xcd_barrier_complete(bar, b.x, nloc, nx); b.st[0] = nloc; b.st[1] = nx; }
        const unsigned old = xb_add(&bar[XB_XSUB(b.x)], 1u);
        const unsigned gen = old / nloc;
        if (old + 1u == (gen + 1u) * nloc) {
            __builtin_amdgcn_fence(__ATOMIC_RELEASE, "agent");
            asm volatile("s_waitcnt vmcnt(0)" ::: "memory");
            const unsigned og = xb_add(&bar[XB_TOP], 1u);
            const unsigned tg = og / nx;
            if (og + 1u == (tg + 1u) * nx) xb_add(&bar[XB_TOPGEN], 1u);
            else XB_SPIN(xb_ld(&bar[XB_TOPGEN]) == tg, bar);
            __builtin_amdgcn_fence(__ATOMIC_ACQUIRE, "agent");
            xb_add(&bar[XB_XGEN(b.x)], 1u);
            asm volatile("s_waitcnt vmcnt(0)" ::: "memory");
        } else {
            XB_SPIN(xb_ld(&bar[XB_XGEN(b.x)]) == gen, bar);
            __builtin_amdgcn_fence(__ATOMIC_ACQUIRE, "agent");
            asm volatile("s_waitcnt vmcnt(0)" ::: "memory");
        }
    }
    __syncthreads();
}

template <int CTRL> __device__ __forceinline__ float dpp_f(float v) { return __builtin_bit_cast(float, __builtin_amdgcn_update_dpp(0, __builtin_bit_cast(int, v), CTRL, 0xf, 0xf, false)); }
__device__ __forceinline__ float wave_sum(float v) {
    v += dpp_f<0xB1>(v);
    v += dpp_f<0x4E>(v);
    v += dpp_f<0x141>(v);
    v += dpp_f<0x140>(v);
    v += __builtin_bit_cast(float, __builtin_amdgcn_ds_swizzle(__builtin_bit_cast(int, v), 0x401F));
    return __builtin_bit_cast(float, __builtin_amdgcn_readlane(__builtin_bit_cast(int, v), 0)) + __builtin_bit_cast(float, __builtin_amdgcn_readlane(__builtin_bit_cast(int, v), 32));
}
__device__ __forceinline__ void transpose_item(const float* W, int K, int N, bf16* WT, LAS float* scr, int item, int lane) {
    const int nblk = N / 32, kb = item / nblk, nb = item % nblk, k0 = 64 * kb, n0 = 32 * nb;
#pragma unroll 8
    for (int i = 0; i < 32; ++i) { const int kk = 2 * i + (lane >> 5); scr[kk * 33 + (lane & 31)] = W[(size_t)(k0 + kk) * N + n0 + (lane & 31)]; }
    LDS_WAIT(); asm volatile("" ::: "memory");
    const int c = lane & 7;
#pragma unroll
    for (int j = 0; j < 4; ++j) { const int n = (lane >> 3) + 8 * j; const LAS float* s = scr + (8 * c) * 33 + n;
        v4u o; o.x = pk2(s[0 * 33], s[1 * 33]); o.y = pk2(s[2 * 33], s[3 * 33]); o.z = pk2(s[4 * 33], s[5 * 33]); o.w = pk2(s[6 * 33], s[7 * 33]);
        *(GAS v4u*)(WT + (size_t)(n0 + n) * K + k0 + 8 * c) = o; }
    LDS_WAIT(); asm volatile("" ::: "memory");
}
__device__ __forceinline__ void norm_row(const float* xrow, const float* g, const float* sc, const float* sh, bf16* orow, int lane) {
    f32x4 v[8]; float ss = 0.f;
#pragma unroll
    for (int j = 0; j < 8; ++j) { v[j] = ((const f32x4*)xrow)[lane + 64 * j]; ss += (v[j].x * v[j].x + v[j].y * v[j].y) + (v[j].z * v[j].z + v[j].w * v[j].w); }
    const float rstd = 1.f / sqrtf(wave_sum(ss) * (1.f / DM) + EPS);
#pragma unroll
    for (int j = 0; j < 8; ++j) { const f32x4 gv = ((const f32x4*)g)[lane + 64 * j], sv = ((const f32x4*)sc)[lane + 64 * j], hv = ((const f32x4*)sh)[lane + 64 * j];
        const f32x4 y = v[j] * rstd * gv * (sv + 1.f) + hv;
        ((unsigned long long*)orow)[lane + 64 * j] = (unsigned long long)pk2(y.x, y.y) | ((unsigned long long)pk2(y.z, y.w) << 32); }
}
__device__ __forceinline__ void convln_row(const float* yrow, const float* g, const float* bb, bf16* orow, int lane) {
    f32x4 v[4]; float s = 0.f;
#pragma unroll
    for (int j = 0; j < 4; ++j) { v[j] = ((const f32x4*)yrow)[lane + 64 * j]; s += (v[j].x + v[j].y) + (v[j].z + v[j].w); }
    const float mean = wave_sum(s) * (1.f / BRW); float q = 0.f;
#pragma unroll
    for (int j = 0; j < 4; ++j) { v[j] = v[j] - mean; q += (v[j].x * v[j].x + v[j].y * v[j].y) + (v[j].z * v[j].z + v[j].w * v[j].w); }
    const float rstd = 1.f / sqrtf(wave_sum(q) * (1.f / BRW) + EPS);
#pragma unroll
    for (int j = 0; j < 4; ++j) { const f32x4 gv = ((const f32x4*)g)[lane + 64 * j], bv = ((const f32x4*)bb)[lane + 64 * j];
        f32x4 y = v[j] * rstd * gv + bv;
        y.x = y.x * sigmoidf_(y.x); y.y = y.y * sigmoidf_(y.y); y.z = y.z * sigmoidf_(y.z); y.w = y.w * sigmoidf_(y.w);
        ((unsigned long long*)orow)[lane + 64 * j] = (unsigned long long)pk2(y.x, y.y) | ((unsigned long long)pk2(y.z, y.w) << 32); }
}

struct AdaOrder { int G, c; const char* A; const char* B;
    __device__ __forceinline__ bool next(int i, pg8::Unit& u) const { const int Lx = i * G + c; if (Lx >= DEPTH * (ADAW / 256)) return false;
        u.r = Lx / (ADAW / 256); u.pn = Lx % (ADAW / 256); u.pm = 0; u.a = A; u.b = B + ((size_t)u.r * ADAW + (size_t)u.pn * 256) * DM * 2; return true; } };
struct PoolOrder { int G, c; const char* A; const char* B;
                __device__ __forceinline__ bool next(int i, pg8::Unit& u) const { const int Lx = i * G + c; if (Lx >= (M / 256) * 4) return false;
                    u.pm = Lx >> 2; u.pn = Lx & 3; u.r = 0; u.a = A + ((size_t)u.pm * 256 * BRW + (size_t)u.pn * 256) * 2; u.b = B + (size_t)u.pn * 256 * 256 * 2; return true; } };
struct BrOrder { int G, c; const char* A; const char* B;
                __device__ __forceinline__ bool next(int i, pg8::Unit& u) const { const int tl = (i >> 2) * G + c; if (tl >= (M / 256) * (DM / 256)) return false;
                    pg8::tile_of(tl, M / 256, DM / 256, u.pm, u.pn); u.r = i & 3;
                    u.a = A + ((size_t)u.r * M + (size_t)u.pm * 256) * BRW * 2; u.b = B + ((size_t)u.r * DM + (size_t)u.pn * 256) * BRW * 2; return true; } };

__device__ __forceinline__ unsigned long long ld_ptr(volatile LAS unsigned* p) { const unsigned lo = __builtin_amdgcn_readfirstlane(p[0]), hi = __builtin_amdgcn_readfirstlane(p[1]); return ((unsigned long long)hi << 32) | lo; }
constexpr int NPL = 10;
constexpr int PH_TOTAL = 2 + DEPTH * NPL;
struct Args { const float* in[N_IN]; float* out; unsigned char* ws; int ph_lo, ph_hi; };
static_assert(sizeof(Args) == N_IN * 8 + 8 + 8 + 8, "Args has no padding");

__global__ void __launch_bounds__(NTHR, 2) fwd(Args args) {
    extern __shared__ __attribute__((aligned(16))) unsigned char lds[];
    LAS unsigned char* L0 = (LAS unsigned char*)lds;
    volatile LAS unsigned* MISC = (volatile LAS unsigned*)(L0 + MISC_OFF);
    const int G = gridDim.x, bx = blockIdx.x, wave0 = __builtin_amdgcn_readfirstlane(threadIdx.x >> 6);
    unsigned char* ws0 = args.ws;
    for (int u = threadIdx.x; u < (LDS_BYTES - LDSCTL_OFF) / 4; u += NTHR) ((LAS unsigned*)(L0 + LDSCTL_OFF))[u] = 0u;
    __syncthreads();
    if (threadIdx.x <= N_IN) ((LAS unsigned long long*)(L0 + INTAB_OFF))[threadIdx.x] = threadIdx.x < N_IN ? (unsigned long long)args.in[threadIdx.x < N_IN ? threadIdx.x : 0] : (unsigned long long)args.out;
    __syncthreads();
#if MK_ONE_LAUNCH
    XcdBarrier bar = xcd_barrier_post((unsigned*)(ws0 + WS_CTL) + CW_BAR, MISC + 8);
#define GRID_BAR() xcd_barrier(bar)
#else
#define GRID_BAR() do {} while (0)
#endif
    const int lo = args.ph_lo, hi = args.ph_hi;
#ifndef PH_MASK
#define PH_MASK 0xFFF
#endif
#define IN(k) (lo <= (k) && (k) < hi)
#define SEAM(k) do { if (IN((k) + 1)) GRID_BAR(); } while (0)
#define INP(i)  ((const float*)(GAS const float*)ld_ptr((volatile LAS unsigned*)(L + INTAB_OFF) + 2 * (i)))
#define P_OUT   ((float*)(GAS float*)ld_ptr((volatile LAS unsigned*)(L + INTAB_OFF) + 2 * N_IN))
#define WIN_T   ((bf16*)(ws + WS_WIN))
#define WBR_T   ((bf16*)(ws + WS_WBR))
#define WOUT_T  ((bf16*)(ws + WS_WOUT))
#define WM1_T   ((bf16*)(ws + WS_WM1))
#define WM2_T   ((bf16*)(ws + WS_WM2))
#define WPOOL_T ((bf16*)(ws + WS_WPOOL))
#define WADA_T  ((bf16*)(ws + WS_WADA))
#define SC      ((bf16*)(ws + WS_SC))
#define ADA     ((float*)(ws + WS_ADA))
#define H       ((bf16*)(ws + WS_H))
#define Z       ((bf16*)(ws + WS_Z))
#define Y       ((bf16*)(ws + WS_Y))
#define ZP      ((bf16*)(ws + WS_ZP))
#define CONVY   ((float*)(ws + WS_CONVY))
#define ORAW    ((float*)(ws + WS_ORAW))
#define KV      ((float*)(ws + WS_KV))
#define SPREV   ((float*)(ws + WS_SPREV))
#define MACC    ((float*)(ws + WS_MACC))
#define MERGED  ((bf16*)(ws + WS_MERGED))
#define X1      ((float*)(ws + WS_X1))
#define X       ((float*)(ws + WS_X))
#define HID     ((bf16*)(ws + WS_HID))
#define TIDS() int lane; asm volatile("v_mbcnt_lo_u32_b32 %0, -1, 0\n\tv_mbcnt_hi_u32_b32 %0, -1, %0" : "=v"(lane)); GAS unsigned char* wsg = (GAS unsigned char*)ws0; asm volatile("" : "+s"(wsg)); unsigned char* ws = (unsigned char*)wsg; LAS unsigned char* L = L0; asm volatile("" : "+s"(L)); const int wave = wave0, tid = wave0 * 64 + lane; const int gw = bx * NWAVES + wave, NGW = G * NWAVES; const int gt = bx * NTHR + tid, NGT = G * NTHR; (void)lane; (void)gw; (void)NGW; (void)gt; (void)NGT
#define LAYER_PTRS() const float* ada = ADA + (size_t)l * NROWB * ADAW; const float* xinP = l == 0 ? INP(I_XP) : X; const float* xinS = l == 0 ? INP(I_XS) : X + (size_t)MP * DM; float* xout = l == DEPTH - 1 ? P_OUT : X; (void)ada; (void)xinP; (void)xinS; (void)xout
    if ((PH_MASK >> 10 & 1) && IN(0)) { TIDS();
        LAS float* scr = (LAS float*)(L + RING_OFF + wave * 16384);
        constexpr int I_IN = (DM / 64) * (ZW / 32), I_BR = (BRW / 64) * (DM / 32), I_OUT = (DM / 64) * (DM / 32), I_M1 = (DM / 64) * (DFF / 32), I_M2 = (DFF / 64) * (DM / 32),
                      I_PL = (256 / 64) * (256 / 32), I_AD = (DM / 64) * (ADAW / 32);
        constexpr int T_IN = DEPTH * I_IN, T_BR = T_IN + DEPTH * 4 * I_BR, T_OUT = T_BR + DEPTH * I_OUT, T_M1 = T_OUT + DEPTH * I_M1, T_M2 = T_M1 + DEPTH * I_M2,
                      T_PL = T_M2 + DEPTH * 4 * I_PL, T_AD = T_PL + DEPTH * I_AD;
        for (int it = gw; it < T_AD; it += NGW) {
            if (it < T_IN) { const int mi = it / I_IN, r = it % I_IN; transpose_item(INP(I_WIN) + (size_t)mi * DM * ZW, DM, ZW, WIN_T + (size_t)mi * ZW * DM, scr, r, lane); }
            else if (it < T_BR) { const int q = it - T_IN, mi = q / I_BR, r = q % I_BR; transpose_item(INP(I_WBR) + (size_t)mi * BRW * DM, BRW, DM, WBR_T + (size_t)mi * DM * BRW, scr, r, lane); }
            else if (it < T_OUT) { const int q = it - T_BR, mi = q / I_OUT, r = q % I_OUT; transpose_item(INP(I_WOUT) + (size_t)mi * DM * DM, DM, DM, WOUT_T + (size_t)mi * DM * DM, scr, r, lane); }
            else if (it < T_M1) { const int q = it - T_OUT, mi = q / I_M1, r = q % I_M1; transpose_item(INP(I_WM1) + (size_t)mi * DM * DFF, DM, DFF, WM1_T + (size_t)mi * DFF * DM, scr, r, lane); }
            else if (it < T_M2) { const int q = it - T_M1, mi = q / I_M2, r = q % I_M2; transpose_item(INP(I_WM2) + (size_t)mi * DFF * DM, DFF, DM, WM2_T + (size_t)mi * DM * DFF, scr, r, lane); }
            else if (it < T_PL) { const int q = it - T_M2, mi = q / I_PL, r = q % I_PL; transpose_item(INP(I_WPOOL) + (size_t)mi * 256 * 256, 256, 256, WPOOL_T + (size_t)mi * 256 * 256, scr, r, lane); }
            else { const int q = it - T_PL, mi = q / I_AD, r = q % I_AD; transpose_item(INP(I_WADA) + (size_t)mi * DM * ADAW, DM, ADAW, WADA_T + (size_t)mi * ADAW * DM, scr, r, lane); }
        }
        for (int i = gt; i < 256 * DM; i += NGT) { const int r = i / DM, k = i % DM; float v = 0.f;
            if (r < NBP) v = INP(I_CP)[r * DM + k]; else if (r < NROWB) v = INP(I_CS)[(r - NBP) * DM + k];
            SC[i] = r < NROWB ? f2bf(v * sigmoidf_(v)) : (bf16)0; }
        SEAM(0);
    }
    if ((PH_MASK >> 11 & 1) && IN(1)) { TIDS();
        AdaOrder S{G, bx, (const char*)SC, (const char*)WADA_T};
        pg8::EpiAda E{ADA, INP(I_BADA)};
        pg8::gemm_phase<pg8::EpiAda, AdaOrder>(L + RING_OFF, pg8::Dims{DM, DM, DM}, S, E, tid);
        SEAM(1);
    }
    for (int l = 0; l < DEPTH; ++l) {
        const int pb = 2 + l * NPL;
        if ((PH_MASK >> 0 & 1) && IN(pb + 0)) { TIDS(); LAYER_PTRS();
            for (int row = gw; row < M; row += NGW) { const float* ar = ada + (size_t)row_cond(row) * ADAW;
                norm_row(row < MP ? xinP + (size_t)row * DM : xinS + (size_t)(row - MP) * DM, INP(I_G1) + l * DM, ar + DM, ar, H + (size_t)row * DM, lane); }
            SEAM(pb + 0);
        }
        if ((PH_MASK >> 1 & 1) && IN(pb + 1)) { TIDS(); LAYER_PTRS();
            pg8::StaticOrder S; S.init(H, WIN_T + (size_t)l * ZW * DM, M / 256, ZW / 256, DM, DM, G, bx);
            pg8::EpiZ E{Z};
            pg8::gemm_phase<pg8::EpiZ, pg8::StaticOrder>(L + RING_OFF, pg8::Dims{DM, DM, DM}, S, E, tid);
            SEAM(pb + 1);
        }
        if ((PH_MASK >> 2 & 1) && IN(pb + 2)) { TIDS(); LAYER_PTRS();
            for (int i = gt; i < M * 24; i += NGT) qknorm_item(Z, l, i / 24, i % 24, INP(I_GQ), INP(I_GK), P_OUT);
            for (int i = gt; i < N_SHIFT_ITEMS; i += NGT) shift_item(l, i, INP(I_CK), INP(I_CV), INP(I_SCONV), INP(I_SPOOL), P_OUT);
            for (int i = gt; i < M * BRW; i += NGT) conv_item(Z, l, i >> 10, i & 1023, INP(I_WDW), INP(I_BDW), INP(I_SCONV), CONVY, P_OUT);
            for (int i = gt; i < M * BRW; i += NGT) pool_item(Z, l, i >> 10, i & 1023, INP(I_SPOOL), ZP, P_OUT);
            for (int i = gt; i < NBP * 32 * RH * RDK * 32; i += NGT) { const int v4 = i & 31, d = (i >> 5) & 63, h = (i >> 11) & 7, n = (i >> 14) & 31, b = i >> 19; retkv_item(Z, KV, b, n, h, d, v4); }
            for (int i = gt; i < SB * RH * RDK * 32; i += NGT) { const int v4 = i & 31, d = (i >> 5) & 63, h = (i >> 11) & 7, sb = i >> 14; retstate_s_item(Z, l, sb, h, d, v4, INP(I_SRET), P_OUT); }
            SEAM(pb + 2);
        }
        if ((PH_MASK >> 3 & 1) && IN(pb + 3)) { TIDS(); LAYER_PTRS();
            for (int i = gt; i < M * NH; i += NGT) attn_item(Z, l, i >> 4, i & 15, INP(I_SINK), INP(I_CK), INP(I_CV), Y);
            for (int i = gt; i < NBP * RH * RDK * 32; i += NGT) { const int v4 = i & 31, d = (i >> 5) & 63, h = (i >> 11) & 7, b = i >> 14; retscan_item(KV, SPREV, l, b, h, d, v4, P_OUT); }
            for (int row = gw; row < M; row += NGW) convln_row(CONVY + (size_t)row * BRW, INP(I_GCLN) + l * BRW, INP(I_BCLN) + l * BRW, Y + (size_t)1 * M * BRW + (size_t)row * BRW, lane);
            SEAM(pb + 3);
        }
        if ((PH_MASK >> 4 & 1) && IN(pb + 4)) { TIDS(); LAYER_PTRS();
            for (int i = gt; i < M * RH; i += NGT) retout_item(Z, l, i >> 3, i & 7, SPREV, INP(I_SRET), INP(I_GRET), ORAW, Y + (size_t)3 * M * BRW);
            __syncthreads();
            PoolOrder S{G, bx, (const char*)ZP, (const char*)(WPOOL_T + (size_t)l * 4 * 256 * 256)};
            pg8::EpiPool E{Y + (size_t)2 * M * BRW, INP(I_SPOOLS), l};
            pg8::gemm_phase<pg8::EpiPool, PoolOrder>(L + RING_OFF, pg8::Dims{BRW, 256, 256}, S, E, tid);
            SEAM(pb + 4);
        }
        if ((PH_MASK >> 5 & 1) && IN(pb + 5)) { TIDS(); LAYER_PTRS();
            BrOrder S{G, bx, (const char*)Y, (const char*)(WBR_T + (size_t)l * 4 * DM * BRW)};
            pg8::EpiBr E{Z, MACC, MERGED};
            pg8::gemm_phase<pg8::EpiBr, BrOrder>(L + RING_OFF, pg8::Dims{BRW, BRW, BRW}, S, E, tid);
            SEAM(pb + 5);
        }
        if ((PH_MASK >> 6 & 1) && IN(pb + 6)) { TIDS(); LAYER_PTRS();
            pg8::StaticOrder S; S.init(MERGED, WOUT_T + (size_t)l * DM * DM, M / 256, DM / 256, DM, DM, G, bx);
            pg8::EpiRes E{xinP, xinS, X1, ada + 2 * DM};
            pg8::gemm_phase<pg8::EpiRes, pg8::StaticOrder>(L + RING_OFF, pg8::Dims{DM, DM, DM}, S, E, tid);
            SEAM(pb + 6);
        }
        if ((PH_MASK >> 7 & 1) && IN(pb + 7)) { TIDS(); LAYER_PTRS();
            for (int row = gw; row < M; row += NGW) { const float* ar = ada + (size_t)row_cond(row) * ADAW;
                norm_row(X1 + (size_t)row * DM, INP(I_G2) + l * DM, ar + 4 * DM, ar + 3 * DM, H + (size_t)row * DM, lane); }
            SEAM(pb + 7);
        }
        if ((PH_MASK >> 8 & 1) && IN(pb + 8)) { TIDS(); LAYER_PTRS();
            pg8::StaticOrder S; S.init(H, WM1_T + (size_t)l * DFF * DM, M / 256, DFF / 256, DM, DM, G, bx);
            pg8::EpiMlp1 E{HID};
            pg8::gemm_phase<pg8::EpiMlp1, pg8::StaticOrder>(L + RING_OFF, pg8::Dims{DM, DM, DM}, S, E, tid);
            SEAM(pb + 8);
        }
        if ((PH_MASK >> 9 & 1) && IN(pb + 9)) { TIDS(); LAYER_PTRS();
            pg8::StaticOrder S; S.init(HID, WM2_T + (size_t)l * DM * DFF, M / 256, DM / 256, DFF, DFF, G, bx);
            pg8::EpiRes E{X1, X1 + (size_t)MP * DM, xout, ada + 5 * DM};
            pg8::gemm_phase<pg8::EpiRes, pg8::StaticOrder>(L + RING_OFF, pg8::Dims{DFF, DFF, DFF}, S, E, tid);
            SEAM(pb + 9);
        }
    }
#undef IN
#undef SEAM
}

extern "C" void kernel_launch(void* const* d_in, const int* in_sizes, int n_in, void* d_out, int out_size, void* d_ws, size_t ws_size, hipStream_t stream) {
    static int grid = 0;
    if (grid == 0) {
        if (n_in != N_IN || (size_t)out_size != O_END || ws_size < WS_END) { fprintf(stderr, "kernel_launch: unexpected shapes: n_in %d out %d ws %zu (need %zu)\n", n_in, out_size, ws_size, (size_t)WS_END); grid = -1; return; }
        int dev = 0, cus = 0, per_cu = 0;
        if (hipGetDevice(&dev) != hipSuccess || hipDeviceGetAttribute(&cus, hipDeviceAttributeMultiprocessorCount, dev) != hipSuccess) { grid = -1; return; }
        if (hipFuncSetAttribute((const void*)fwd, hipFuncAttributeMaxDynamicSharedMemorySize, LDS_BYTES) != hipSuccess) { fprintf(stderr, "kernel_launch: hipFuncSetAttribute failed\n"); grid = -1; return; }
        if (hipOccupancyMaxActiveBlocksPerMultiprocessor(&per_cu, (const void*)fwd, NTHR, LDS_BYTES) != hipSuccess || per_cu < 1) fprintf(stderr, "kernel_launch: occupancy query says %d\n", per_cu);
        (void)hipGetLastError();
        grid = cus;
    }
    if (grid < 0) return;
    (void)hipMemsetAsync((char*)d_ws + WS_CTL, 0, CTL_ZERO_BYTES, stream);
    Args a{};
    for (int i = 0; i < N_IN; ++i) a.in[i] = (const float*)d_in[i];
    a.out = (float*)d_out; a.ws = (unsigned char*)d_ws;
#if MK_ONE_LAUNCH
    a.ph_lo = 0; a.ph_hi = PH_TOTAL;
    hipLaunchKernelGGL(fwd, dim3(grid), dim3(NTHR), LDS_BYTES, stream, a);
#else
    for (int p = 0; p < PH_TOTAL; ++p) { a.ph_lo = p; a.ph_hi = p + 1; hipLaunchKernelGGL(fwd, dim3(grid), dim3(NTHR), LDS_BYTES, stream, a); }
#endif
}
#endif
```

```cpp
#ifndef HOST_TEST_ONLY
#include <hip/hip_runtime.h>
#endif
#include <cstdio>
#include <cstdint>
#include <cmath>

#ifndef MK_ONE_LAUNCH
#define MK_ONE_LAUNCH 1
#endif

#define HD __host__ __device__ __forceinline__
typedef unsigned short bf16;
HD float bf2f(bf16 b) { return __builtin_bit_cast(float, ((unsigned)b) << 16); }
HD bf16 f2bf(float f) { unsigned u = __builtin_bit_cast(unsigned, f); return (bf16)((u + 0x7fffu + ((u >> 16) & 1u)) >> 16); }

HD void ld8(const bf16* p, float* f) { const uint4 w = *(const uint4*)p;
    f[0] = __builtin_bit_cast(float, w.x << 16); f[1] = __builtin_bit_cast(float, w.x & 0xffff0000u); f[2] = __builtin_bit_cast(float, w.y << 16); f[3] = __builtin_bit_cast(float, w.y & 0xffff0000u);
    f[4] = __builtin_bit_cast(float, w.z << 16); f[5] = __builtin_bit_cast(float, w.z & 0xffff0000u); f[6] = __builtin_bit_cast(float, w.w << 16); f[7] = __builtin_bit_cast(float, w.w & 0xffff0000u); }
HD void st8(bf16* p, const float* f) { uint4 w; w.x = (unsigned)f2bf(f[0]) | ((unsigned)f2bf(f[1]) << 16); w.y = (unsigned)f2bf(f[2]) | ((unsigned)f2bf(f[3]) << 16);
    w.z = (unsigned)f2bf(f[4]) | ((unsigned)f2bf(f[5]) << 16); w.w = (unsigned)f2bf(f[6]) | ((unsigned)f2bf(f[7]) << 16); *(uint4*)p = w; }
constexpr int DM = 2048, SEQ = 4096, NBP = 2, MP = NBP * SEQ, SB = 32, ST = 8, MS = SB * ST, M = MP + MS, DEPTH = 4;
constexpr int NROWB = NBP + SB;
constexpr int NH = 16, HDIM = 64, NKV = 4, WIN = 128, BRW = 1024, CONVK = 31, CPRE = 30, PPAD = 15, RH = 8, RDK = 64, RDV = 128, DFF = 8192;
constexpr int ZW = 15872, ZQ = 0, ZK = 1024, ZV = 1280, ZCA = 1536, ZCG = 2560, ZPL = 3584, ZRQ = 4608, ZRK = 5120, ZRV = 5632, ZRG = 6656, ZGT = 7680;
constexpr int ADAW = 6 * DM;
constexpr float EPS = 1e-6f;
constexpr size_t O_YP = 0, O_YS = O_YP + (size_t)MP * DM, O_KP = O_YS + (size_t)MS * DM, O_VP = O_KP + (size_t)DEPTH * NBP * WIN * 256,
    O_CP = O_VP + (size_t)DEPTH * NBP * WIN * 256, O_PP = O_CP + (size_t)DEPTH * NBP * CPRE * BRW, O_RP = O_PP + (size_t)DEPTH * NBP * PPAD * BRW,
    O_KS = O_RP + (size_t)DEPTH * NBP * RH * RDK * RDV, O_VS = O_KS + (size_t)DEPTH * SB * WIN * 256, O_CS = O_VS + (size_t)DEPTH * SB * WIN * 256,
    O_PS = O_CS + (size_t)DEPTH * SB * CPRE * BRW, O_RS = O_PS + (size_t)DEPTH * SB * PPAD * BRW, O_END = O_RS + (size_t)DEPTH * SB * RH * RDK * RDV;
static_assert(O_END == 41394176, "output size");
enum { I_XP = 0, I_XS, I_CP, I_CS, I_CK, I_CV, I_SCONV, I_SPOOL, I_SRET, I_WADA, I_BADA, I_G1, I_G2, I_WIN, I_GQ, I_GK, I_SINK, I_WDW, I_BDW, I_GCLN, I_BCLN,
       I_WPOOL, I_SPOOLS, I_GRET, I_WBR, I_WOUT, I_WM1, I_WM2, N_IN };

HD bool row_is_s(int row) { return row >= MP; }
HD int row_cond(int row) { return row < MP ? (row >> 12) : NBP + ((row - MP) >> 3); }

#if defined(__HIP_DEVICE_COMPILE__)
#define FEXP(x) __expf(x)
#else
#define FEXP(x) expf(x)
#endif
HD float sigmoidf_(float x) { return 1.f / (1.f + FEXP(-x)); }
HD float ret_logg(int h) { const float x = __builtin_bit_cast(float, (unsigned)(127 - 5 - h) << 23); return -x * (1.f + x * (0.5f + x * (0.33333334f + x * (0.25f + x * 0.2f)))); }

HD void qknorm_item(bf16* Z, int l, int row, int slot, const float* gq, const float* gk, float* out) {
    const int col = slot < 16 ? ZQ + slot * 64 : (slot < 20 ? ZK + (slot - 16) * 64 : ZV + (slot - 20) * 64);
    bf16* p = Z + (size_t)row * ZW + col;
    float v[64];
#pragma unroll
    for (int i = 0; i < 64; i += 8) ld8(p + i, v + i);
    if (slot < 20) {
        float ss = 0.f;
#pragma unroll
        for (int i = 0; i < 64; ++i) ss += v[i] * v[i];
        const float r = 1.f / sqrtf(ss * (1.f / 64.f) + EPS);
        const float* g = (slot < 16 ? gq : gk) + l * 64;
#pragma unroll
        for (int i = 0; i < 64; ++i) v[i] = v[i] * r * g[i];
#pragma unroll
        for (int i = 0; i < 64; i += 8) st8(p + i, v + i);
    }
    if (slot >= 16) {
        const int kvh = (slot - 16) & 3; const bool isv = slot >= 20;
        float* o = nullptr;
        if (!row_is_s(row)) { const int b = row >> 12, t = row & (SEQ - 1);
            if (t >= SEQ - WIN) o = out + (isv ? O_VP : O_KP) + ((((size_t)l * NBP + b) * WIN + (t - (SEQ - WIN))) * NKV + kvh) * 64;
        } else { const int sb = (row - MP) >> 3, t = (row - MP) & 7;
            o = out + (isv ? O_VS : O_KS) + ((((size_t)l * SB + sb) * WIN + (WIN - ST + t)) * NKV + kvh) * 64; }
        if (o) {
#pragma unroll
            for (int i = 0; i < 64; ++i) o[i] = v[i];
        }
    }
}
HD void shift_item(int l, int idx, const float* ck, const float* cv, const float* sconv, const float* spool, float* out) {
    constexpr int NKVS = SB * (WIN - ST) * 64, NCV = SB * (CPRE - ST) * 256, NPL = SB * (PPAD - ST) * 256;
    const float* src; float* dst;
    if (idx < 2 * NKVS) { const bool isv = idx >= NKVS; const int i = isv ? idx - NKVS : idx; const int sb = i / ((WIN - ST) * 64), rem = i % ((WIN - ST) * 64);
        src = (isv ? cv : ck) + (((size_t)l * SB + sb) * WIN + ST) * 256 + (size_t)rem * 4; dst = out + (isv ? O_VS : O_KS) + (((size_t)l * SB + sb) * WIN) * 256 + (size_t)rem * 4;
    } else if (idx < 2 * NKVS + NCV) { const int i = idx - 2 * NKVS; const int sb = i / ((CPRE - ST) * 256), rem = i % ((CPRE - ST) * 256);
        src = sconv + (((size_t)l * SB + sb) * CPRE + ST) * BRW + (size_t)rem * 4; dst = out + O_CS + (((size_t)l * SB + sb) * CPRE) * BRW + (size_t)rem * 4;
    } else { const int i = idx - 2 * NKVS - NCV; const int sb = i / ((PPAD - ST) * 256), rem = i % ((PPAD - ST) * 256);
        src = spool + (((size_t)l * SB + sb) * PPAD + ST) * BRW + (size_t)rem * 4; dst = out + O_PS + (((size_t)l * SB + sb) * PPAD) * BRW + (size_t)rem * 4; }
    dst[0] = src[0]; dst[1] = src[1]; dst[2] = src[2]; dst[3] = src[3];
}
constexpr int N_SHIFT_ITEMS = 2 * SB * (WIN - ST) * 64 + SB * (CPRE - ST) * 256 + SB * (PPAD - ST) * 256;

HD float glu_at(const bf16* Z, int row, int c) { const bf16* p = Z + (size_t)row * ZW; return bf2f(p[ZCA + c]) * sigmoidf_(bf2f(p[ZCG + c])); }
HD void conv_item(const bf16* Z, int l, int row, int c, const float* wdw, const float* bdw, const float* sconv, float* CONVY, float* out) {
    float acc = bdw[l * BRW + c];
    const float* w = wdw + (size_t)l * CONVK * BRW + c;
    if (!row_is_s(row)) { const int b = row >> 12, t = row & (SEQ - 1);
        for (int j = 0; j < CONVK; ++j) { const int tt = t - CPRE + j; if (tt >= 0) acc += w[(size_t)j * BRW] * glu_at(Z, b * SEQ + tt, c); }
        if (t >= SEQ - CPRE) out[O_CP + (((size_t)l * NBP + b) * CPRE + (t - (SEQ - CPRE))) * BRW + c] = glu_at(Z, row, c);
    } else { const int sb = (row - MP) >> 3, t = (row - MP) & 7;
        for (int j = 0; j < CONVK; ++j) { const int tt = t - CPRE + j;
            const float u = tt >= 0 ? glu_at(Z, MP + sb * ST + tt, c) : sconv[(((size_t)l * SB + sb) * CPRE + (CPRE + tt)) * BRW + c];
            acc += w[(size_t)j * BRW] * u; }
        out[O_CS + (((size_t)l * SB + sb) * CPRE + (CPRE - ST + t)) * BRW + c] = glu_at(Z, row, c);
    }
    CONVY[(size_t)row * BRW + c] = acc;
}
HD void pool_item(const bf16* Z, int l, int row, int c, const float* spool, bf16* ZP, float* out) {
    const int g = c >> 8, w = 2 << g;
    const float u0 = bf2f(Z[(size_t)row * ZW + ZPL + c]);
    float sum = 0.f, cnt;
    if (!row_is_s(row)) { const int b = row >> 12, t = row & (SEQ - 1);
        for (int i = 0; i < w; ++i) if (t - i >= 0) sum += bf2f(Z[(size_t)(b * SEQ + t - i) * ZW + ZPL + c]);
        cnt = (float)((t + 1) < w ? (t + 1) : w);
        if (t >= SEQ - PPAD) out[O_PP + (((size_t)l * NBP + b) * PPAD + (t - (SEQ - PPAD))) * BRW + c] = u0;
    } else { const int sb = (row - MP) >> 3, t = (row - MP) & 7;
        for (int i = 0; i < w; ++i) { const int tt = t - i;
            sum += tt >= 0 ? bf2f(Z[(size_t)(MP + sb * ST + tt) * ZW + ZPL + c]) : spool[(((size_t)l * SB + sb) * PPAD + (PPAD + tt)) * BRW + c]; }
        cnt = (float)w;
        out[O_PS + (((size_t)l * SB + sb) * PPAD + (PPAD - ST + t)) * BRW + c] = u0;
    }
    ZP[(size_t)row * BRW + c] = f2bf(sum / cnt - u0);
}
HD void retkv_item(const bf16* Z, float* KV, int b, int n, int h, int d, int v4) {
    const float lg = ret_logg(h);
    float a0 = 0.f, a1 = 0.f, a2 = 0.f, a3 = 0.f;
    for (int j = 0; j < 128; ++j) { const bf16* p = Z + (size_t)(b * SEQ + n * 128 + j) * ZW;
        const float kd = bf2f(p[ZRK + h * 64 + d]) * 0.125f * FEXP(lg * (float)(127 - j));
        const bf16* pv = p + ZRV + h * 128 + v4 * 4;
        a0 += kd * bf2f(pv[0]); a1 += kd * bf2f(pv[1]); a2 += kd * bf2f(pv[2]); a3 += kd * bf2f(pv[3]); }
    float* o = KV + ((((size_t)b * 32 + n) * RH + h) * RDK + d) * RDV + v4 * 4;
    o[0] = a0; o[1] = a1; o[2] = a2; o[3] = a3;
}
HD void retstate_s_item(const bf16* Z, int l, int sb, int h, int d, int v4, const float* sret, float* out) {
    const float lg = ret_logg(h);
    const size_t so = ((((size_t)l * SB + sb) * RH + h) * RDK + d) * RDV + v4 * 4;
    const float gc = FEXP(lg * (float)ST);
    float a0 = gc * sret[so], a1 = gc * sret[so + 1], a2 = gc * sret[so + 2], a3 = gc * sret[so + 3];
    for (int j = 0; j < ST; ++j) { const bf16* p = Z + (size_t)(MP + sb * ST + j) * ZW;
        const float kd = bf2f(p[ZRK + h * 64 + d]) * 0.125f * FEXP(lg * (float)(ST - 1 - j));
        const bf16* pv = p + ZRV + h * 128 + v4 * 4;
        a0 += kd * bf2f(pv[0]); a1 += kd * bf2f(pv[1]); a2 += kd * bf2f(pv[2]); a3 += kd * bf2f(pv[3]); }
    float* o = out + O_RS + so; o[0] = a0; o[1] = a1; o[2] = a2; o[3] = a3;
}
HD void retscan_item(const float* KV, float* SPREV, int l, int b, int h, int d, int v4, float* out) {
    const float gc = FEXP(ret_logg(h) * 128.f);
    float s0 = 0.f, s1 = 0.f, s2 = 0.f, s3 = 0.f;
    for (int n = 0; n < 32; ++n) { const size_t o = ((((size_t)b * 32 + n) * RH + h) * RDK + d) * RDV + v4 * 4;
        SPREV[o] = s0; SPREV[o + 1] = s1; SPREV[o + 2] = s2; SPREV[o + 3] = s3;
        s0 = gc * s0 + KV[o]; s1 = gc * s1 + KV[o + 1]; s2 = gc * s2 + KV[o + 2]; s3 = gc * s3 + KV[o + 3]; }
    float* oo = out + O_RP + ((((size_t)l * NBP + b) * RH + h) * RDK + d) * RDV + v4 * 4;
    oo[0] = s0; oo[1] = s1; oo[2] = s2; oo[3] = s3;
}
HD void attn_item(const bf16* Z, int l, int row, int hq, const float* sinks, const float* ck, const float* cv, bf16* Y0) {
    const int kvh = hq >> 2; const float slope = exp2f(-0.5f * (float)(hq + 1));
    float q[64];
    { const bf16* p = Z + (size_t)row * ZW + ZQ + hq * 64;
#pragma unroll
      for (int i = 0; i < 64; i += 8) ld8(p + i, q + i);
#pragma unroll
      for (int i = 0; i < 64; ++i) q[i] *= 0.125f; }
    float m = sinks[l * NH + hq], lsum = 1.f;
    float o[64];
#pragma unroll
    for (int i = 0; i < 64; ++i) o[i] = 0.f;
    const bool smp = row_is_s(row);
    const int b = smp ? ((row - MP) >> 3) : (row >> 12), t = smp ? ((row - MP) & 7) : (row & (SEQ - 1));
    const int lo = smp ? t : (t - WIN > 0 ? t - WIN : 0), hi = smp ? WIN + t : t;
    for (int j = lo; j <= hi; ++j) {
        const int dist = smp ? (WIN + t - j) : (t - j);
        const bool cache = smp && j < WIN;
        const size_t zrow = (size_t)(smp ? (MP + b * ST + (j - WIN)) : (b * SEQ + j)) * ZW;
        const size_t crow = ((((size_t)l * SB + b) * WIN + j) * NKV + kvh) * 64;
        float s = 0.f;
        if (cache) { const float* kp = ck + crow;
#pragma unroll
            for (int i = 0; i < 64; ++i) s += q[i] * kp[i];
        } else { const bf16* kp = Z + zrow + ZK + kvh * 64;
#pragma unroll
            for (int i = 0; i < 64; i += 8) { float f[8]; ld8(kp + i, f);
#pragma unroll
                for (int e = 0; e < 8; ++e) s += q[i + e] * f[e]; } }
        s -= slope * (float)dist;
        if (s > m) { const float corr = FEXP(m - s); lsum *= corr;
#pragma unroll
            for (int i = 0; i < 64; ++i) o[i] *= corr;
            m = s; }
        const float p = FEXP(s - m); lsum += p;
        if (cache) { const float* vp = cv + crow;
#pragma unroll
            for (int i = 0; i < 64; ++i) o[i] += p * vp[i];
        } else { const bf16* vp = Z + zrow + ZV + kvh * 64;
#pragma unroll
            for (int i = 0; i < 64; i += 8) { float f[8]; ld8(vp + i, f);
#pragma unroll
                for (int e = 0; e < 8; ++e) o[i + e] += p * f[e]; } }
    }
    const float inv = 1.f / lsum;
    bf16* y = Y0 + (size_t)row * BRW + hq * 64;
#pragma unroll
    for (int i = 0; i < 64; ++i) o[i] *= inv;
#pragma unroll
    for (int i = 0; i < 64; i += 8) st8(y + i, o + i);
}
HD void retout_item(const bf16* Z, int l, int row, int h, const float* SPREV, const float* sret, const float* gret, float* ORAW, bf16* Y3) {
    const float lg = ret_logg(h);
    const bool smp = row_is_s(row);
    const int b = smp ? ((row - MP) >> 3) : (row >> 12), t = smp ? ((row - MP) & 7) : (row & (SEQ - 1));
    const int i = smp ? t : (t & 127), n = smp ? 0 : (t >> 7);
    const int row0 = smp ? (MP + b * ST) : (b * SEQ + n * 128);
    const float* S = smp ? sret + (((size_t)l * SB + b) * RH + h) * RDK * RDV : SPREV + (((size_t)b * 32 + n) * RH + h) * RDK * RDV;
    float q[64];
    { const bf16* p = Z + (size_t)row * ZW + ZRQ + h * 64;
#pragma unroll
      for (int d = 0; d < 64; d += 8) ld8(p + d, q + d); }
    float* oraw = ORAW + (size_t)row * BRW + h * 128;
    float sum = 0.f;
    for (int half = 0; half < 2; ++half) {
        float o[64];
#pragma unroll
        for (int v = 0; v < 64; ++v) o[v] = 0.f;
        for (int j = 0; j <= i; ++j) { const bf16* p = Z + (size_t)(row0 + j) * ZW;
            const bf16* kp = p + ZRK + h * 64; float s = 0.f;
#pragma unroll
            for (int d = 0; d < 64; d += 8) { float f[8]; ld8(kp + d, f);
#pragma unroll
                for (int e = 0; e < 8; ++e) s += q[d + e] * f[e]; }
            s *= 0.125f * FEXP(lg * (float)(i - j));
            const bf16* vp = p + ZRV + h * 128 + half * 64;
#pragma unroll
            for (int v = 0; v < 64; v += 8) { float f[8]; ld8(vp + v, f);
#pragma unroll
                for (int e = 0; e < 8; ++e) o[v + e] += s * f[e]; } }
        const float cf = FEXP(lg * (float)(i + 1));
        const bf16* qp = Z + (size_t)row * ZW + ZRQ + h * 64;
        for (int d = 0; d < 64; ++d) { const float qd = bf2f(qp[d]) * cf; const float* sp = S + (size_t)d * RDV + half * 64;
#pragma unroll
            for (int v = 0; v < 64; ++v) o[v] += qd * sp[v]; }
#pragma unroll
        for (int v = 0; v < 64; ++v) { oraw[half * 64 + v] = o[v]; sum += o[v]; }
    }
    const float mean = sum * (1.f / 128.f);
    float var = 0.f;
    for (int v = 0; v < 128; ++v) { const float d = oraw[v] - mean; var += d * d; }
    const float rstd = 1.f / sqrtf(var * (1.f / 128.f) + EPS);
    const float* g = gret + l * BRW + h * 128;
    const bf16* rg = Z + (size_t)row * ZW + ZRG + h * 128;
    bf16* y = Y3 + (size_t)row * BRW + h * 128;
    for (int v = 0; v < 128; ++v) y[v] = f2bf((oraw[v] - mean) * rstd * g[v] * bf2f(rg[v]));
}

#if !defined(HOST_TEST_ONLY)
namespace pg8 {
#define PG8_LAS __attribute__((address_space(3)))
typedef short bf16x8 __attribute__((ext_vector_type(8)));
typedef float f32x4 __attribute__((ext_vector_type(4)));
typedef float f32x2 __attribute__((ext_vector_type(2)));
typedef unsigned u32x4 __attribute__((ext_vector_type(4)));
typedef unsigned u32x2 __attribute__((ext_vector_type(2)));
constexpr int BM = 256, BK = 64, HALF = 128, HTB = HALF * BK * 2, STAGE_BYTES = 8 * HTB, NXCD = 8, WGM = 8;

__host__ __device__ __forceinline__ int lds_byte(int r, int c) { const int st = (r >> 4) * 2 + (c >> 5), rr = r & 15, cc = c & 31, ob = rr * 64 + cc * 2; return st * 1024 + (ob ^ (((ob >> 9) & 1) << 5)); }
__host__ __device__ __forceinline__ void stage_rc(int b, int& R, int& C) { const int st = b / 1024, sb = b % 1024, swz = sb ^ (((sb >> 9) & 1) << 5); R = (st >> 1) * 16 + swz / 64; C = (st & 1) * 32 + (swz % 64) / 2; }
__host__ __device__ __forceinline__ int perm32(int rho) { const int n = rho >> 4, i = rho & 15; return 8 * (i >> 2) + 4 * n + (i & 3); }

struct Unit { int pm, pn, r; const char* a; const char* b; };
struct Dims { int lda, ldb, K; };

__host__ __device__ __forceinline__ void tile_of(int L, int nM, int nN, int& pm, int& pn) {
    const int nwg = nM * nN; int wgid = L; { const int q = nwg / NXCD, r = nwg % NXCD, xcd = wgid % NXCD, off = wgid / NXCD; wgid = (xcd < r ? xcd * (q + 1) : r * (q + 1) + (xcd - r) * q) + off; }
    const int nig = WGM * nN, gid = wgid / nig, fm = gid * WGM, gsz = (nM - fm) < WGM ? (nM - fm) : WGM;
    pm = fm + ((wgid % nig) % gsz); pn = (wgid % nig) / gsz;
}
struct StaticOrder {
    int nM, nN, nwg, G, c; const char* A; const char* B; size_t ta, tb;
    __device__ __forceinline__ void init(const bf16* A_, const bf16* B_, int nM_, int nN_, int lda, int ldb, int G_, int c_) { A = (const char*)A_; B = (const char*)B_; nM = nM_; nN = nN_; nwg = nM * nN; G = G_; c = c_; ta = (size_t)BM * lda * 2; tb = (size_t)BM * ldb * 2; }
    __device__ __forceinline__ bool next(int i, Unit& u) const {
        const long L = (long)i * G + c; if (L >= nwg) return false;
        tile_of((int)L, nM, nN, u.pm, u.pn); u.r = 0; u.a = A + (size_t)u.pm * ta; u.b = B + (size_t)u.pn * tb; return true;
    }
};

__device__ __forceinline__ unsigned cvt_pk_bf16(float lo, float hi) { unsigned r; asm volatile("v_cvt_pk_bf16_f32 %0, %1, %2" : "=v"(r) : "v"(lo), "v"(hi)); return r; }

template <class Epi, class Sched, bool ALIGN_EPI = true, bool SP2 = true>
__device__ __forceinline__ void gemm_phase(PG8_LAS unsigned char* lds, const Dims g, const Sched& S, const Epi& E, const int tid) {
    const int wid = __builtin_amdgcn_readfirstlane(tid >> 6), lane = tid & 63, wr = wid >> 2, wc = wid & 3, fr = lane & 15, fq = lane >> 4;
    const int K = g.K, nt = K / BK;
    unsigned voffA[2], voffB[2];
#pragma unroll
    for (int i = 0; i < 2; ++i) { int R, C; stage_rc(tid * 16 + i * 8192, R, C); const int Rb = Epi::PERM ? ((R & ~31) + perm32(R & 31)) : R;
        voffA[i] = (unsigned)(R * g.lda + C) * 2u; voffB[i] = (unsigned)(Rb * g.ldb + C) * 2u; }
    const size_t kstep = (size_t)(BK * 2);
    const size_t hstepA = (size_t)HALF * g.lda * 2, hstepB = (size_t)HALF * g.ldb * 2;
    const unsigned ldsw = (unsigned)wid * 1024u;
    const int aoff = lds_byte(wr * 64 + fr, fq * 8), boff = lds_byte(wc * 32 + fr, fq * 8);
#define PG8_SA(b, h) (((b) * 2 + (h)) * HTB)
#define PG8_SB(b, h) ((4 + (b) * 2 + (h)) * HTB)
#define PG8_STAGE(bufoff, gbase, voff) do { _Pragma("unroll") for (int _i = 0; _i < 2; ++_i) \
        __builtin_amdgcn_global_load_lds((const unsigned*)((const char*)(gbase) + (voff)[_i]), (PG8_LAS unsigned*)(lds + (bufoff) + ldsw + _i * 8192), 16, 0, 0); } while (0)
#define PG8_LDA(dst, b, h) do { _Pragma("unroll") for (int m = 0; m < 4; ++m) _Pragma("unroll") for (int k = 0; k < 2; ++k) dst[m][k] = *(const PG8_LAS bf16x8*)(lds + PG8_SA(b, h) + aoff + m * 2048 + k * 1024); } while (0)
#define PG8_LDB(dst, b, h) do { _Pragma("unroll") for (int n = 0; n < 2; ++n) _Pragma("unroll") for (int k = 0; k < 2; ++k) dst[n][k] = *(const PG8_LAS bf16x8*)(lds + PG8_SB(b, h) + boff + n * 2048 + k * 1024); } while (0)
#define PG8_MMA(ai, bj, At, Bt) do { __builtin_amdgcn_s_setprio(1); _Pragma("unroll") for (int m = 0; m < 4; ++m) _Pragma("unroll") for (int n = 0; n < 2; ++n) _Pragma("unroll") for (int k = 0; k < 2; ++k) \
        acc[ai][bj][m][n] = __builtin_amdgcn_mfma_f32_16x16x32_bf16(Bt[n][k], At[m][k], acc[ai][bj][m][n], 0, 0, 0); __builtin_amdgcn_s_setprio(0); } while (0)
#define PG8_WAIT_V(n) asm volatile("s_waitcnt vmcnt(" #n ")" ::: "memory")
#define PG8_WAIT_L(n) asm volatile("s_waitcnt lgkmcnt(" #n ")" ::: "memory")
#define PG8_BAR __builtin_amdgcn_s_barrier()
#define PG8_SCHED __builtin_amdgcn_sched_barrier(0)
    Unit cur, nxt; int ui = 0;
    if (!S.next(0, cur)) return;
    f32x4 acc[2][2][4][2];
#pragma unroll
    for (int a = 0; a < 2; ++a)
#pragma unroll
        for (int b = 0; b < 2; ++b)
#pragma unroll
            for (int m = 0; m < 4; ++m)
#pragma unroll
                for (int n = 0; n < 2; ++n) acc[a][b][m][n] = (f32x4){0.f, 0.f, 0.f, 0.f};
    bf16x8 At[4][2], B0[2][2], B1[2][2];
    const char* cA = cur.a; const char* cB = cur.b;
    if constexpr (SP2) {
        PG8_STAGE(PG8_SB(0, 0), cB, voffB); PG8_STAGE(PG8_SB(0, 1), cB + hstepB, voffB); PG8_STAGE(PG8_SA(0, 0), cA, voffA); PG8_STAGE(PG8_SA(0, 1), cA + hstepA, voffA);
        if (wr == 1) PG8_BAR;
        PG8_WAIT_V(2); PG8_BAR;
        PG8_STAGE(PG8_SB(1, 0), cB + kstep, voffB); PG8_STAGE(PG8_SA(1, 0), cA + kstep, voffA); PG8_STAGE(PG8_SB(1, 1), cB + hstepB + kstep, voffB);
        PG8_WAIT_V(6); PG8_BAR;
    } else {
        PG8_STAGE(PG8_SB(0, 0), cB, voffB); PG8_STAGE(PG8_SA(0, 0), cA, voffA); PG8_STAGE(PG8_SB(0, 1), cB + hstepB, voffB); PG8_STAGE(PG8_SA(0, 1), cA + hstepA, voffA);
        if (wr == 1) PG8_BAR;
        PG8_WAIT_V(4); PG8_BAR;
        PG8_STAGE(PG8_SB(1, 0), cB + kstep, voffB); PG8_STAGE(PG8_SA(1, 0), cA + kstep, voffA); PG8_STAGE(PG8_SB(1, 1), cB + hstepB + kstep, voffB);
        PG8_WAIT_V(6); PG8_BAR;
    }
    for (;;) {
        const bool has_next = S.next(ui + 1, nxt);
        const char* nA = has_next ? nxt.a : cA; const char* nB = has_next ? nxt.b : cB;
        for (int t = 0; t < nt; t += 2) {
            const bool last = (t == nt - 2);
            const char* a1 = cA + (size_t)(t + 1) * kstep;
            const char* a2 = last ? nA : cA + (size_t)(t + 2) * kstep; const char* b2 = last ? nB : cB + (size_t)(t + 2) * kstep;
            const char* a3 = a2 + kstep; const char* b3 = b2 + kstep;
            if constexpr (SP2) {
            PG8_LDB(B0, 0, 0); PG8_LDB(B1, 0, 1); PG8_SCHED; PG8_LDA(At, 0, 0); PG8_STAGE(PG8_SA(1, 1), a1 + hstepA, voffA);
            PG8_WAIT_V(8); PG8_WAIT_L(0); PG8_BAR; PG8_MMA(0, 0, At, B0); PG8_MMA(0, 1, At, B1); PG8_BAR; PG8_SCHED;
            PG8_LDA(At, 0, 1); PG8_STAGE(PG8_SB(0, 0), b2, voffB); PG8_STAGE(PG8_SB(0, 1), b2 + hstepB, voffB); PG8_STAGE(PG8_SA(0, 0), a2, voffA);
            PG8_WAIT_V(8); PG8_WAIT_L(0); PG8_BAR; PG8_MMA(1, 0, At, B0); PG8_MMA(1, 1, At, B1); PG8_BAR; PG8_SCHED;
            PG8_LDB(B0, 1, 0); PG8_LDB(B1, 1, 1); PG8_SCHED; PG8_LDA(At, 1, 0); PG8_STAGE(PG8_SA(0, 1), a2 + hstepA, voffA);
            PG8_WAIT_V(8); PG8_WAIT_L(0); PG8_BAR; PG8_MMA(0, 0, At, B0); PG8_MMA(0, 1, At, B1); PG8_BAR; PG8_SCHED;
            PG8_LDA(At, 1, 1); PG8_STAGE(PG8_SB(1, 0), b3, voffB); PG8_STAGE(PG8_SB(1, 1), b3 + hstepB, voffB); PG8_STAGE(PG8_SA(1, 0), a3, voffA);
            PG8_WAIT_V(8); PG8_WAIT_L(0); PG8_BAR; PG8_MMA(1, 0, At, B0); PG8_MMA(1, 1, At, B1); PG8_BAR; PG8_SCHED;
            } else {
            PG8_LDB(B0, 0, 0); PG8_SCHED; PG8_LDA(At, 0, 0); PG8_STAGE(PG8_SA(1, 1), a1 + hstepA, voffA);
            PG8_WAIT_L(8); PG8_BAR; PG8_WAIT_L(0); PG8_MMA(0, 0, At, B0); PG8_BAR; PG8_SCHED;
            PG8_LDB(B1, 0, 1); PG8_STAGE(PG8_SB(0, 0), b2, voffB);
            PG8_BAR; PG8_WAIT_L(0); PG8_MMA(0, 1, At, B1); PG8_BAR;
            PG8_LDA(At, 0, 1); PG8_STAGE(PG8_SA(0, 0), a2, voffA);
            PG8_BAR; PG8_WAIT_L(0); PG8_MMA(1, 0, At, B0); PG8_BAR; PG8_SCHED;
            PG8_STAGE(PG8_SB(0, 1), b2 + hstepB, voffB);
            PG8_WAIT_V(6); PG8_BAR; PG8_MMA(1, 1, At, B1); PG8_BAR;
            PG8_LDB(B0, 1, 0); PG8_SCHED; PG8_LDA(At, 1, 0); PG8_STAGE(PG8_SA(0, 1), a2 + hstepA, voffA);
            PG8_WAIT_L(8); PG8_BAR; PG8_WAIT_L(0); PG8_MMA(0, 0, At, B0); PG8_BAR; PG8_SCHED;
            PG8_LDB(B1, 1, 1); PG8_STAGE(PG8_SB(1, 0), b3, voffB);
            PG8_BAR; PG8_WAIT_L(0); PG8_MMA(0, 1, At, B1); PG8_BAR;
            PG8_LDA(At, 1, 1); PG8_STAGE(PG8_SA(1, 0), a3, voffA);
            PG8_BAR; PG8_WAIT_L(0); PG8_MMA(1, 0, At, B0); PG8_BAR; PG8_SCHED;
            PG8_STAGE(PG8_SB(1, 1), b3 + hstepB, voffB);
            PG8_WAIT_V(6); PG8_BAR; PG8_MMA(1, 1, At, B1); PG8_BAR;
            }
        }
        if constexpr (ALIGN_EPI) { if (wr == 0) PG8_BAR; }
        { int ln; asm volatile("v_mbcnt_lo_u32_b32 %0, -1, 0\n\tv_mbcnt_hi_u32_b32 %0, -1, %0" : "=v"(ln)); E(acc, cur, wr, wc, ln & 15, ln >> 4); }
        if (!has_next) break;
#pragma unroll
        for (int a = 0; a < 2; ++a)
#pragma unroll
            for (int b = 0; b < 2; ++b)
#pragma unroll
                for (int m = 0; m < 4; ++m)
#pragma unroll
                    for (int n = 0; n < 2; ++n) acc[a][b][m][n] = (f32x4){0.f, 0.f, 0.f, 0.f};
        cur = nxt; cA = nA; cB = nB; ++ui;
        if constexpr (ALIGN_EPI) { if (wr == 1) PG8_BAR; }
    }
    PG8_WAIT_V(0);
    if constexpr (!ALIGN_EPI) { if (wr == 0) PG8_BAR; }
    PG8_BAR;
#undef PG8_SA
#undef PG8_SB
#undef PG8_STAGE
#undef PG8_LDA
#undef PG8_LDB
#undef PG8_MMA
#undef PG8_WAIT_V
#undef PG8_WAIT_L
#undef PG8_BAR
#undef PG8_SCHED
}

__device__ __forceinline__ float fsigmoid(float x) { return __builtin_amdgcn_rcpf(1.f + __expf(-x)); }
struct EpiZ {
    static constexpr bool PERM = true;
    bf16* Z;
    __device__ __forceinline__ void operator()(const f32x4 (&acc)[2][2][4][2], const Unit& u, int wr, int wc, int fr, int fq) const {
        const int row0 = u.pm * BM + wr * 64 + fr, col0 = u.pn * BM + wc * 32 + 8 * fq;
        const int ty = u.pn >= 30 ? 2 : (u.pn >= 26 ? 1 : 0);
#pragma unroll
        for (int ai = 0; ai < 2; ++ai)
#pragma unroll
            for (int m = 0; m < 4; ++m) { bf16* rowp = Z + (size_t)(row0 + ai * HALF + m * 16) * ZW + col0;
#pragma unroll
                for (int bj = 0; bj < 2; ++bj) { f32x4 v0 = acc[ai][bj][m][0], v1 = acc[ai][bj][m][1];
                    if (ty == 2) {
#pragma unroll
                        for (int j = 0; j < 4; ++j) { v0[j] = fsigmoid(v0[j]); v1[j] = fsigmoid(v1[j]); } }
                    else if (ty == 1) {
#pragma unroll
                        for (int j = 0; j < 4; ++j) { v0[j] = v0[j] * fsigmoid(v0[j]); v1[j] = v1[j] * fsigmoid(v1[j]); } }
                    u32x4 w; w.x = cvt_pk_bf16(v0[0], v0[1]); w.y = cvt_pk_bf16(v0[2], v0[3]); w.z = cvt_pk_bf16(v1[0], v1[1]); w.w = cvt_pk_bf16(v1[2], v1[3]);
                    *(u32x4*)(rowp + bj * HALF) = w; } }
    }
};
struct EpiMlp1 {
    static constexpr bool PERM = true;
    bf16* O;
    __device__ __forceinline__ void operator()(const f32x4 (&acc)[2][2][4][2], const Unit& u, int wr, int wc, int fr, int fq) const {
        const int row0 = u.pm * BM + wr * 64 + fr, col0 = u.pn * BM + wc * 32 + 8 * fq;
#pragma unroll
        for (int ai = 0; ai < 2; ++ai)
#pragma unroll
            for (int m = 0; m < 4; ++m) { bf16* rowp = O + (size_t)(row0 + ai * HALF + m * 16) * DFF + col0;
#pragma unroll
                for (int bj = 0; bj < 2; ++bj) { f32x4 v0 = acc[ai][bj][m][0], v1 = acc[ai][bj][m][1];
#pragma unroll
                    for (int j = 0; j < 4; ++j) { const float a = fmaxf(v0[j], 0.f), b = fmaxf(v1[j], 0.f); v0[j] = a * a; v1[j] = b * b; }
                    u32x4 w; w.x = cvt_pk_bf16(v0[0], v0[1]); w.y = cvt_pk_bf16(v0[2], v0[3]); w.z = cvt_pk_bf16(v1[0], v1[1]); w.w = cvt_pk_bf16(v1[2], v1[3]);
                    *(u32x4*)(rowp + bj * HALF) = w; } }
    }
};
struct EpiPool {
    static constexpr bool PERM = true;
    bf16* Y2; const float* spb; int l;
    __device__ __forceinline__ void operator()(const f32x4 (&acc)[2][2][4][2], const Unit& u, int wr, int wc, int fr, int fq) const {
        const int row0 = u.pm * BM + wr * 64 + fr, col0 = u.pn * BM + wc * 32 + 8 * fq;
        int le = l; asm volatile("" : "+s"(le)); const float* sp = spb + le * BRW;
        f32x4 s[2][2];
#pragma unroll
        for (int bj = 0; bj < 2; ++bj)
#pragma unroll
            for (int n = 0; n < 2; ++n) s[bj][n] = *(const f32x4*)(sp + col0 + bj * HALF + 4 * n);
#pragma unroll
        for (int ai = 0; ai < 2; ++ai)
#pragma unroll
            for (int m = 0; m < 4; ++m) { bf16* rowp = Y2 + (size_t)(row0 + ai * HALF + m * 16) * BRW + col0;
#pragma unroll
                for (int bj = 0; bj < 2; ++bj) { const f32x4 v0 = acc[ai][bj][m][0] * s[bj][0], v1 = acc[ai][bj][m][1] * s[bj][1];
                    u32x4 w; w.x = cvt_pk_bf16(v0[0], v0[1]); w.y = cvt_pk_bf16(v0[2], v0[3]); w.z = cvt_pk_bf16(v1[0], v1[1]); w.w = cvt_pk_bf16(v1[2], v1[3]);
                    *(u32x4*)(rowp + bj * HALF) = w; } }
    }
};
struct EpiAda {
    static constexpr bool PERM = false;
    float* ADA; const float* bada;
    __device__ __forceinline__ void operator()(const f32x4 (&acc)[2][2][4][2], const Unit& u, int wr, int wc, int fr, int fq) const {
        if (wr != 0) return;
        const int col0 = u.pn * BM + wc * 32 + 4 * fq;
#pragma unroll
        for (int m = 0; m < 3; ++m) { const int row = m * 16 + fr;
            if (row < NROWB) {
#pragma unroll
                for (int bj = 0; bj < 2; ++bj)
#pragma unroll
                    for (int n = 0; n < 2; ++n) { const int c = col0 + bj * HALF + n * 16; const f32x4 bv = *(const f32x4*)(bada + (size_t)u.r * ADAW + c);
                        *(f32x4*)(ADA + ((size_t)u.r * NROWB + row) * ADAW + c) = acc[0][bj][m][n] + bv; } } }
    }
};
struct EpiBr {
    static constexpr bool PERM = true;
    const bf16* Z; float* MACC; bf16* MERGED;
    __device__ __forceinline__ void operator()(const f32x4 (&acc)[2][2][4][2], const Unit& u, int wr, int wc, int fr, int fq) const {
        const int row0 = u.pm * BM + wr * 64 + fr, col0 = u.pn * BM + wc * 32 + 8 * fq;
        const int r = u.r;
#pragma unroll
        for (int ai = 0; ai < 2; ++ai)
#pragma unroll
            for (int m = 0; m < 4; ++m) { const size_t row = (size_t)(row0 + ai * HALF + m * 16);
#pragma unroll
                for (int bj = 0; bj < 2; ++bj) { const int c = col0 + bj * HALF;
                    const u32x4 gw = *(const u32x4*)(Z + row * ZW + ZGT + r * DM + c);
                    f32x4 g0, g1;
                    g0[0] = __builtin_bit_cast(float, gw.x << 16); g0[1] = __builtin_bit_cast(float, gw.x & 0xffff0000u); g0[2] = __builtin_bit_cast(float, gw.y << 16); g0[3] = __builtin_bit_cast(float, gw.y & 0xffff0000u);
                    g1[0] = __builtin_bit_cast(float, gw.z << 16); g1[1] = __builtin_bit_cast(float, gw.z & 0xffff0000u); g1[2] = __builtin_bit_cast(float, gw.w << 16); g1[3] = __builtin_bit_cast(float, gw.w & 0xffff0000u);
                    f32x4 v0 = acc[ai][bj][m][0] * g0, v1 = acc[ai][bj][m][1] * g1;
                    float* mp = MACC + row * DM + c;
                    if (r > 0) { v0 += *(const f32x4*)mp; v1 += *(const f32x4*)(mp + 4); }
                    if (r < 3) { *(f32x4*)mp = v0; *(f32x4*)(mp + 4) = v1; }
                    else { u32x4 w; w.x = cvt_pk_bf16(v0[0], v0[1]); w.y = cvt_pk_bf16(v0[2], v0[3]); w.z = cvt_pk_bf16(v1[0], v1[1]); w.w = cvt_pk_bf16(v1[2], v1[3]);
                        *(u32x4*)(MERGED + row * DM + c) = w; } } }
    }
};
struct EpiRes {
    static constexpr bool PERM = false;
    const float* baseP; const float* baseS; float* out; const float* gate;
    __device__ __forceinline__ void operator()(const f32x4 (&acc)[2][2][4][2], const Unit& u, int wr, int wc, int fr, int fq) const {
        const int rl0 = wr * 64 + fr, col0 = u.pn * BM + wc * 32 + 4 * fq;
        const bool smp = u.pm >= MP / BM;
        const float* base = smp ? baseS : baseP + (size_t)u.pm * BM * DM;
        float* o = out + (size_t)u.pm * BM * DM;
#pragma unroll
        for (int ai = 0; ai < 2; ++ai)
#pragma unroll
            for (int m = 0; m < 4; ++m) { const int rl = rl0 + ai * HALF + m * 16;
                const float* gp = gate + (size_t)(smp ? NBP + (rl >> 3) : (u.pm >> 4)) * ADAW + col0;
#pragma unroll
                for (int bj = 0; bj < 2; ++bj)
#pragma unroll
                    for (int n = 0; n < 2; ++n) { const int c = bj * HALF + n * 16;
                        const f32x4 gv = *(const f32x4*)(gp + c); const f32x4 bs = *(const f32x4*)(base + (size_t)rl * DM + col0 + c);
                        *(f32x4*)(o + (size_t)rl * DM + col0 + c) = bs + gv * acc[ai][bj][m][n]; } }
    }
};
}

constexpr int NWAVES = 8, NTHR = NWAVES * 64;
constexpr size_t MiB = 1u << 20;
constexpr size_t al1(size_t x) { return (x + MiB - 1) / MiB * MiB; }
constexpr size_t WS_CTL = 0, CTL_ZERO_BYTES = 1 * MiB;
constexpr size_t WS_WIN = WS_CTL + CTL_ZERO_BYTES;
constexpr size_t WS_WBR = WS_WIN + al1((size_t)DEPTH * ZW * DM * 2);
constexpr size_t WS_WOUT = WS_WBR + al1((size_t)DEPTH * 4 * DM * BRW * 2);
constexpr size_t WS_WM1 = WS_WOUT + al1((size_t)DEPTH * DM * DM * 2);
constexpr size_t WS_WM2 = WS_WM1 + al1((size_t)DEPTH * DFF * DM * 2);
constexpr size_t WS_WPOOL = WS_WM2 + al1((size_t)DEPTH * DFF * DM * 2);
constexpr size_t WS_WADA = WS_WPOOL + al1((size_t)DEPTH * 4 * 256 * 256 * 2);
constexpr size_t WS_SC = WS_WADA + al1((size_t)DEPTH * ADAW * DM * 2);
constexpr size_t WS_ADA = WS_SC + al1((size_t)256 * DM * 2);
constexpr size_t WS_H = WS_ADA + al1((size_t)DEPTH * NROWB * ADAW * 4);
constexpr size_t WS_Z = WS_H + al1((size_t)M * DM * 2);
constexpr size_t WS_Y = WS_Z + al1((size_t)M * ZW * 2);
constexpr size_t WS_ZP = WS_Y + al1((size_t)4 * M * BRW * 2);
constexpr size_t WS_CONVY = WS_ZP + al1((size_t)M * BRW * 2);
constexpr size_t WS_ORAW = WS_CONVY + al1((size_t)M * BRW * 4);
constexpr size_t WS_KV = WS_ORAW + al1((size_t)M * BRW * 4);
constexpr size_t WS_SPREV = WS_KV + al1((size_t)NBP * 32 * RH * RDK * RDV * 4);
constexpr size_t WS_MACC = WS_SPREV + al1((size_t)NBP * 32 * RH * RDK * RDV * 4);
constexpr size_t WS_MERGED = WS_MACC + al1((size_t)M * DM * 4);
constexpr size_t WS_X1 = WS_MERGED + al1((size_t)M * DM * 2);
constexpr size_t WS_X = WS_X1 + al1((size_t)M * DM * 4);
constexpr size_t WS_HID = WS_X + al1((size_t)M * DM * 4);
constexpr size_t WS_END = WS_HID + al1((size_t)M * DFF * 2);
constexpr int CW_BAR = 4096;
constexpr int RING_OFF = 0, RING_BYTES = 131072, LDSCTL_OFF = RING_BYTES, MISC_OFF = LDSCTL_OFF + 320, INTAB_OFF = MISC_OFF + 128, LDS_BYTES = 147456;

#define GAS __attribute__((address_space(1)))
#define LAS __attribute__((address_space(3)))
typedef unsigned v4u __attribute__((ext_vector_type(4)));
typedef float f32x4 __attribute__((ext_vector_type(4)));
typedef GAS unsigned gu32;
#define RLX_AGENT __ATOMIC_RELAXED, __HIP_MEMORY_SCOPE_AGENT
#define LDS_WAIT() asm volatile("s_waitcnt lgkmcnt(0)" ::: "memory")
__device__ __forceinline__ unsigned pk2(float lo, float hi) { return (unsigned)f2bf(lo) | ((unsigned)f2bf(hi) << 16); }

#define XB_TMO      128
#define XB_XCNT(j)  (256  + 64 * (j))
#define XB_XSUB(j)  (1280 + 64 * (j))
#define XB_XGEN(j)  (2304 + 64 * (j))
#define XB_TOP      3328
#define XB_TOPGEN   3392
#define XCD_BAR_WORDS 3456
#define XB_SPIN_CAP (1u << 18)
__device__ __forceinline__ unsigned xb_ld(unsigned* p)              { return __hip_atomic_load(p, __ATOMIC_RELAXED, __HIP_MEMORY_SCOPE_AGENT); }
__device__ __forceinline__ unsigned xb_add(unsigned* p, unsigned v) { return __hip_atomic_fetch_add(p, v, __ATOMIC_RELAXED, __HIP_MEMORY_SCOPE_AGENT); }
__device__ __forceinline__ unsigned xb_xcc_id() { return (unsigned)__builtin_amdgcn_s_getreg((3 << 11) | 20) & 0xFu; }
#define XB_SPIN(cond, bar) do { unsigned _sp = 0; while (cond) { __builtin_amdgcn_s_sleep(1); \
    if ((++_sp & 255u) == 0u) { if (xb_ld(&(bar)[XB_TMO])) break; if (_sp > XB_SPIN_CAP) { atomicAdd(&(bar)[XB_TMO], 1u); break; } } } } while (0)
struct XcdBarrier { unsigned* bar; unsigned x; volatile LAS unsigned* st; };
__device__ __forceinline__ XcdBarrier xcd_barrier_post(unsigned* bar, volatile LAS unsigned* st) {
    XcdBarrier b; b.bar = bar; b.x = xb_xcc_id(); b.st = st;
    if (threadIdx.x == 0) (void)xb_add(&bar[XB_XCNT(b.x)], 1u);
    return b;
}
__device__ __forceinline__ void xcd_barrier_complete(unsigned* bar, unsigned x, unsigned& nloc, unsigned& nx) {
    const unsigned G = gridDim.x * gridDim.y * gridDim.z;
    unsigned sum, cnt, mine, sp = 0u;
    for (;;) {
        sum = 0u; cnt = 0u; mine = 0u;
#pragma unroll
        for (unsigned j = 0; j < 16; ++j) { const unsigned c = xb_ld(&bar[XB_XCNT(j)]); sum += c; cnt += (c > 0u) ? 1u : 0u; mine = (j == x) ? c : mine; }
        if (sum == G) break;
        __builtin_amdgcn_s_sleep(1);
        if ((++sp & 255u) == 0u) { if (xb_ld(&bar[XB_TMO])) break; if (sp > XB_SPIN_CAP) { atomicAdd(&bar[XB_TMO], 1u); break; } }
    }
    nloc = mine > 0u ? mine : 1u; nx = cnt > 0u ? cnt : 1u;
}
__device__ __forceinline__ void xcd_barrier(const XcdBarrier& b) {
    asm volatile("s_waitcnt vmcnt(0)" ::: "memory");
    __syncthreads();
    if (threadIdx.x == 0) {
        unsigned* bar = b.bar;
        __builtin_amdgcn_s_waitcnt(0);
        unsigned nloc = b.st[0], nx = b.st[1];
        if (nloc == 0u) { xcd_barrier_complete(bar, b.x, nloc, nx); b.st[0] = nloc; b.st[1] = nx; }
        const unsigned old = xb_add(&bar[XB_XSUB(b.x)], 1u);
        const unsigned gen = old / nloc;
        if (old + 1u == (gen + 1u) * nloc) {
            __builtin_amdgcn_fence(__ATOMIC_RELEASE, "agent");
            asm volatile("s_waitcnt vmcnt(0)" ::: "memory");
            const unsigned og = xb_add(&bar[XB_TOP], 1u);
            const unsigned tg = og / nx;
            if (og + 1u == (tg + 1u) * nx) xb_add(&bar[XB_TOPGEN], 1u);
            else XB_SPIN(xb_ld(&bar[XB_TOPGEN]) == tg, bar);
            __builtin_amdgcn_fence(__ATOMIC_ACQUIRE, "agent");
            xb_add(&bar[XB_XGEN(b.x)], 1u);
            asm volatile("s_waitcnt vmcnt(0)" ::: "memory");
        } else {
            XB_SPIN(xb_ld(&bar[XB_XGEN(b.x)]) == gen, bar);
            __builtin_amdgcn_fence(__ATOMIC_ACQUIRE, "agent");
            asm volatile("s_waitcnt vmcnt(0)" ::: "memory");
        }
    }
    __syncthreads();
}

template <int CTRL> __device__ __forceinline__ float dpp_f(float v) { return __builtin_bit_cast(float, __builtin_amdgcn_update_dpp(0, __builtin_bit_cast(int, v), CTRL, 0xf, 0xf, false)); }
__device__ __forceinline__ float wave_sum(float v) {
    v += dpp_f<0xB1>(v);
    v += dpp_f<0x4E>(v);
    v += dpp_f<0x141>(v);
    v += dpp_f<0x140>(v);
    v += __builtin_bit_cast(float, __builtin_amdgcn_ds_swizzle(__builtin_bit_cast(int, v), 0x401F));
    return __builtin_bit_cast(float, __builtin_amdgcn_readlane(__builtin_bit_cast(int, v), 0)) + __builtin_bit_cast(float, __builtin_amdgcn_readlane(__builtin_bit_cast(int, v), 32));
}
__device__ __forceinline__ void transpose_item(const float* W, int K, int N, bf16* WT, LAS float* scr, int item, int lane) {
    const int nblk = N / 32, kb = item / nblk, nb = item % nblk, k0 = 64 * kb, n0 = 32 * nb;
#pragma unroll 8
    for (int i = 0; i < 32; ++i) { const int kk = 2 * i + (lane >> 5); scr[kk * 33 + (lane & 31)] = W[(size_t)(k0 + kk) * N + n0 + (lane & 31)]; }
    LDS_WAIT(); asm volatile("" ::: "memory");
    const int c = lane & 7;
#pragma unroll
    for (int j = 0; j < 4; ++j) { const int n = (lane >> 3) + 8 * j; const LAS float* s = scr + (8 * c) * 33 + n;
        v4u o; o.x = pk2(s[0 * 33], s[1 * 33]); o.y = pk2(s[2 * 33], s[3 * 33]); o.z = pk2(s[4 * 33], s[5 * 33]); o.w = pk2(s[6 * 33], s[7 * 33]);
        *(GAS v4u*)(WT + (size_t)(n0 + n) * K + k0 + 8 * c) = o; }
    LDS_WAIT(); asm volatile("" ::: "memory");
}
__device__ __forceinline__ void norm_row(const float* xrow, const float* g, const float* sc, const float* sh, bf16* orow, int lane) {
    f32x4 v[8]; float ss = 0.f;
#pragma unroll
    for (int j = 0; j < 8; ++j) { v[j] = ((const f32x4*)xrow)[lane + 64 * j]; ss += (v[j].x * v[j].x + v[j].y * v[j].y) + (v[j].z * v[j].z + v[j].w * v[j].w); }
    const float rstd = 1.f / sqrtf(wave_sum(ss) * (1.f / DM) + EPS);
#pragma unroll
    for (int j = 0; j < 8; ++j) { const f32x4 gv = ((const f32x4*)g)[lane + 64 * j], sv = ((const f32x4*)sc)[lane + 64 * j], hv = ((const f32x4*)sh)[lane + 64 * j];
        const f32x4 y = v[j] * rstd * gv * (sv + 1.f) + hv;
        ((unsigned long long*)orow)[lane + 64 * j] = (unsigned long long)pk2(y.x, y.y) | ((unsigned long long)pk2(y.z, y.w) << 32); }
}
__device__ __forceinline__ void convln_row(const float* yrow, const float* g, const float* bb, bf16* orow, int lane) {
    f32x4 v[4]; float s = 0.f;
#pragma unroll
    for (int j = 0; j < 4; ++j) { v[j] = ((const f32x4*)yrow)[lane + 64 * j]; s += (v[j].x + v[j].y) + (v[j].z + v[j].w); }
    const float mean = wave_sum(s) * (1.f / BRW); float q = 0.f;
#pragma unroll
    for (int j = 0; j < 4; ++j) { v[j] = v[j] - mean; q += (v[j].x * v[j].x + v[j].y * v[j].y) + (v[j].z * v[j].z + v[j].w * v[j].w); }
    const float rstd = 1.f / sqrtf(wave_sum(q) * (1.f / BRW) + EPS);
#pragma unroll
    for (int j = 0; j < 4; ++j) { const f32x4 gv = ((const f32x4*)g)[lane + 64 * j], bv = ((const f32x4*)bb)[lane + 64 * j];
        f32x4 y = v[j] * rstd * gv + bv;
        y.x = y.x * sigmoidf_(y.x); y.y = y.y * sigmoidf_(y.y); y.z = y.z * sigmoidf_(y.z); y.w = y.w * sigmoidf_(y.w);
        ((unsigned long long*)orow)[lane + 64 * j] = (unsigned long long)pk2(y.x, y.y) | ((unsigned long long)pk2(y.z, y.w) << 32); }
}

struct AdaOrder { int G, c; const char* A; const char* B;
    __device__ __forceinline__ bool next(int i, pg8::Unit& u) const { const int Lx = i * G + c; if (Lx >= DEPTH * (ADAW / 256)) return false;
        u.r = Lx / (ADAW / 256); u.pn = Lx % (ADAW / 256); u.pm = 0; u.a = A; u.b = B + ((size_t)u.r * ADAW + (size_t)u.pn * 256) * DM * 2; return true; } };
struct PoolOrder { int G, c; const char* A; const char* B;
                __device__ __forceinline__ bool next(int i, pg8::Unit& u) const { const int Lx = i * G + c; if (Lx >= (M / 256) * 4) return false;
                    u.pm = Lx >> 2; u.pn = Lx & 3; u.r = 0; u.a = A + ((size_t)u.pm * 256 * BRW + (size_t)u.pn * 256) * 2; u.b = B + (size_t)u.pn * 256 * 256 * 2; return true; } };
struct BrOrder { int G, c; const char* A; const char* B;
                __device__ __forceinline__ bool next(int i, pg8::Unit& u) const { const int tl = (i >> 2) * G + c; if (tl >= (M / 256) * (DM / 256)) return false;
                    pg8::tile_of(tl, M / 256, DM / 256, u.pm, u.pn); u.r = i & 3;
                    u.a = A + ((size_t)u.r * M + (size_t)u.pm * 256) * BRW * 2; u.b = B + ((size_t)u.r * DM + (size_t)u.pn * 256) * BRW * 2; return true; } };

__device__ __forceinline__ unsigned long long ld_ptr(volatile LAS unsigned* p) { const unsigned lo = __builtin_amdgcn_readfirstlane(p[0]), hi = __builtin_amdgcn_readfirstlane(p[1]); return ((unsigned long long)hi << 32) | lo; }
constexpr int NPL = 10;
constexpr int PH_TOTAL = 2 + DEPTH * NPL;
struct Args { const float* in[N_IN]; float* out; unsigned char* ws; int ph_lo, ph_hi; };
static_assert(sizeof(Args) == N_IN * 8 + 8 + 8 + 8, "Args has no padding");

__global__ void __launch_bounds__(NTHR, 2) fwd(Args args) {
    extern __shared__ __attribute__((aligned(16))) unsigned char lds[];
    LAS unsigned char* L0 = (LAS unsigned char*)lds;
    volatile LAS unsigned* MISC = (volatile LAS unsigned*)(L0 + MISC_OFF);
    const int G = gridDim.x, bx = blockIdx.x, wave0 = __builtin_amdgcn_readfirstlane(threadIdx.x >> 6);
    unsigned char* ws0 = args.ws;
    for (int u = threadIdx.x; u < (LDS_BYTES - LDSCTL_OFF) / 4; u += NTHR) ((LAS unsigned*)(L0 + LDSCTL_OFF))[u] = 0u;
    __syncthreads();
    if (threadIdx.x <= N_IN) ((LAS unsigned long long*)(L0 + INTAB_OFF))[threadIdx.x] = threadIdx.x < N_IN ? (unsigned long long)args.in[threadIdx.x < N_IN ? threadIdx.x : 0] : (unsigned long long)args.out;
    __syncthreads();
#if MK_ONE_LAUNCH
    XcdBarrier bar = xcd_barrier_post((unsigned*)(ws0 + WS_CTL) + CW_BAR, MISC + 8);
#define GRID_BAR() xcd_barrier(bar)
#else
#define GRID_BAR() do {} while (0)
#endif
    const int lo = args.ph_lo, hi = args.ph_hi;
#ifndef PH_MASK
#define PH_MASK 0xFFF
#endif
#define IN(k) (lo <= (k) && (k) < hi)
#define SEAM(k) do { if (IN((k) + 1)) GRID_BAR(); } while (0)
#define INP(i)  ((const float*)(GAS const float*)ld_ptr((volatile LAS unsigned*)(L + INTAB_OFF) + 2 * (i)))
#define P_OUT   ((float*)(GAS float*)ld_ptr((volatile LAS unsigned*)(L + INTAB_OFF) + 2 * N_IN))
#define WIN_T   ((bf16*)(ws + WS_WIN))
#define WBR_T   ((bf16*)(ws + WS_WBR))
#define WOUT_T  ((bf16*)(ws + WS_WOUT))
#define WM1_T   ((bf16*)(ws + WS_WM1))
#define WM2_T   ((bf16*)(ws + WS_WM2))
#define WPOOL_T ((bf16*)(ws + WS_WPOOL))
#define WADA_T  ((bf16*)(ws + WS_WADA))
#define SC      ((bf16*)(ws + WS_SC))
#define ADA     ((float*)(ws + WS_ADA))
#define H       ((bf16*)(ws + WS_H))
#define Z       ((bf16*)(ws + WS_Z))
#define Y       ((bf16*)(ws + WS_Y))
#define ZP      ((bf16*)(ws + WS_ZP))
#define CONVY   ((float*)(ws + WS_CONVY))
#define ORAW    ((float*)(ws + WS_ORAW))
#define KV      ((float*)(ws + WS_KV))
#define SPREV   ((float*)(ws + WS_SPREV))
#define MACC    ((float*)(ws + WS_MACC))
#define MERGED  ((bf16*)(ws + WS_MERGED))
#define X1      ((float*)(ws + WS_X1))
#define X       ((float*)(ws + WS_X))
#define HID     ((bf16*)(ws + WS_HID))
#define TIDS() int lane; asm volatile("v_mbcnt_lo_u32_b32 %0, -1, 0\n\tv_mbcnt_hi_u32_b32 %0, -1, %0" : "=v"(lane)); GAS unsigned char* wsg = (GAS unsigned char*)ws0; asm volatile("" : "+s"(wsg)); unsigned char* ws = (unsigned char*)wsg; LAS unsigned char* L = L0; asm volatile("" : "+s"(L)); const int wave = wave0, tid = wave0 * 64 + lane; const int gw = bx * NWAVES + wave, NGW = G * NWAVES; const int gt = bx * NTHR + tid, NGT = G * NTHR; (void)lane; (void)gw; (void)NGW; (void)gt; (void)NGT
#define LAYER_PTRS() const float* ada = ADA + (size_t)l * NROWB * ADAW; const float* xinP = l == 0 ? INP(I_XP) : X; const float* xinS = l == 0 ? INP(I_XS) : X + (size_t)MP * DM; float* xout = l == DEPTH - 1 ? P_OUT : X; (void)ada; (void)xinP; (void)xinS; (void)xout
    if ((PH_MASK >> 10 & 1) && IN(0)) { TIDS();
        LAS float* scr = (LAS float*)(L + RING_OFF + wave * 16384);
        constexpr int I_IN = (DM / 64) * (ZW / 32), I_BR = (BRW / 64) * (DM / 32), I_OUT = (DM / 64) * (DM / 32), I_M1 = (DM / 64) * (DFF / 32), I_M2 = (DFF / 64) * (DM / 32),
                      I_PL = (256 / 64) * (256 / 32), I_AD = (DM / 64) * (ADAW / 32);
        constexpr int T_IN = DEPTH * I_IN, T_BR = T_IN + DEPTH * 4 * I_BR, T_OUT = T_BR + DEPTH * I_OUT, T_M1 = T_OUT + DEPTH * I_M1, T_M2 = T_M1 + DEPTH * I_M2,
                      T_PL = T_M2 + DEPTH * 4 * I_PL, T_AD = T_PL + DEPTH * I_AD;
        for (int it = gw; it < T_AD; it += NGW) {
            if (it < T_IN) { const int mi = it / I_IN, r = it % I_IN; transpose_item(INP(I_WIN) + (size_t)mi * DM * ZW, DM, ZW, WIN_T + (size_t)mi * ZW * DM, scr, r, lane); }
            else if (it < T_BR) { const int q = it - T_IN, mi = q / I_BR, r = q % I_BR; transpose_item(INP(I_WBR) + (size_t)mi * BRW * DM, BRW, DM, WBR_T + (size_t)mi * DM * BRW, scr, r, lane); }
            else if (it < T_OUT) { const int q = it - T_BR, mi = q / I_OUT, r = q % I_OUT; transpose_item(INP(I_WOUT) + (size_t)mi * DM * DM, DM, DM, WOUT_T + (size_t)mi * DM * DM, scr, r, lane); }
            else if (it < T_M1) { const int q = it - T_OUT, mi = q / I_M1, r = q % I_M1; transpose_item(INP(I_WM1) + (size_t)mi * DM * DFF, DM, DFF, WM1_T + (size_t)mi * DFF * DM, scr, r, lane); }
            else if (it < T_M2) { const int q = it - T_M1, mi = q / I_M2, r = q % I_M2; transpose_item(INP(I_WM2) + (size_t)mi * DFF * DM, DFF, DM, WM2_T + (size_t)mi * DM * DFF, scr, r, lane); }
            else if (it < T_PL) { const int q = it - T_M2, mi = q / I_PL, r = q % I_PL; transpose_item(INP(I_WPOOL) + (size_t)mi * 256 * 256, 256, 256, WPOOL_T + (size_t)mi * 256 * 256, scr, r, lane); }
            else { const int q = it - T_PL, mi = q / I_AD, r = q % I_AD; transpose_item(INP(I_WADA) + (size_t)mi * DM * ADAW, DM, ADAW, WADA_T + (size_t)mi * ADAW * DM, scr, r, lane); }
        }
        for (int i = gt; i < 256 * DM; i += NGT) { const int r = i / DM, k = i % DM; float v = 0.f;
            if (r < NBP) v = INP(I_CP)[r * DM + k]; else if (r < NROWB) v = INP(I_CS)[(r - NBP) * DM + k];
            SC[i] = r < NROWB ? f2bf(v * sigmoidf_(v)) : (bf16)0; }
        SEAM(0);
    }
    if ((PH_MASK >> 11 & 1) && IN(1)) { TIDS();
        AdaOrder S{G, bx, (const char*)SC, (const char*)WADA_T};
        pg8::EpiAda E{ADA, INP(I_BADA)};
        pg8::gemm_phase<pg8::EpiAda, AdaOrder>(L + RING_OFF, pg8::Dims{DM, DM, DM}, S, E, tid);
        SEAM(1);
    }
    for (int l = 0; l < DEPTH; ++l) {
        const int pb = 2 + l * NPL;
        if ((PH_MASK >> 0 & 1) && IN(pb + 0)) { TIDS(); LAYER_PTRS();
            for (int row = gw; row < M; row += NGW) { const float* ar = ada + (size_t)row_cond(row) * ADAW;
                norm_row(row < MP ? xinP + (size_t)row * DM : xinS + (size_t)(row - MP) * DM, INP(I_G1) + l * DM, ar + DM, ar, H + (size_t)row * DM, lane); }
            SEAM(pb + 0);
        }
        if ((PH_MASK >> 1 & 1) && IN(pb + 1)) { TIDS(); LAYER_PTRS();
            pg8::StaticOrder S; S.init(H, WIN_T + (size_t)l * ZW * DM, M / 256, ZW / 256, DM, DM, G, bx);
            pg8::EpiZ E{Z};
            pg8::gemm_phase<pg8::EpiZ, pg8::StaticOrder>(L + RING_OFF, pg8::Dims{DM, DM, DM}, S, E, tid);
            SEAM(pb + 1);
        }
        if ((PH_MASK >> 2 & 1) && IN(pb + 2)) { TIDS(); LAYER_PTRS();
            for (int i = gt; i < M * 24; i += NGT) qknorm_item(Z, l, i / 24, i % 24, INP(I_GQ), INP(I_GK), P_OUT);
            for (int i = gt; i < N_SHIFT_ITEMS; i += NGT) shift_item(l, i, INP(I_CK), INP(I_CV), INP(I_SCONV), INP(I_SPOOL), P_OUT);
            for (int i = gt; i < M * BRW; i += NGT) conv_item(Z, l, i >> 10, i & 1023, INP(I_WDW), INP(I_BDW), INP(I_SCONV), CONVY, P_OUT);
            for (int i = gt; i < M * BRW; i += NGT) pool_item(Z, l, i >> 10, i & 1023, INP(I_SPOOL), ZP, P_OUT);
            for (int i = gt; i < NBP * 32 * RH * RDK * 32; i += NGT) { const int v4 = i & 31, d = (i >> 5) & 63, h = (i >> 11) & 7, n = (i >> 14) & 31, b = i >> 19; retkv_item(Z, KV, b, n, h, d, v4); }
            for (int i = gt; i < SB * RH * RDK * 32; i += NGT) { const int v4 = i & 31, d = (i >> 5) & 63, h = (i >> 11) & 7, sb = i >> 14; retstate_s_item(Z, l, sb, h, d, v4, INP(I_SRET), P_OUT); }
            SEAM(pb + 2);
        }
        if ((PH_MASK >> 3 & 1) && IN(pb + 3)) { TIDS(); LAYER_PTRS();
            for (int i = gt; i < M * NH; i += NGT) attn_item(Z, l, i >> 4, i & 15, INP(I_SINK), INP(I_CK), INP(I_CV), Y);
            for (int i = gt; i < NBP * RH * RDK * 32; i += NGT) { const int v4 = i & 31, d = (i >> 5) & 63, h = (i >> 11) & 7, b = i >> 14; retscan_item(KV, SPREV, l, b, h, d, v4, P_OUT); }
            for (int row = gw; row < M; row += NGW) convln_row(CONVY + (size_t)row * BRW, INP(I_GCLN) + l * BRW, INP(I_BCLN) + l * BRW, Y + (size_t)1 * M * BRW + (size_t)row * BRW, lane);
            SEAM(pb + 3);
        }
        if ((PH_MASK >> 4 & 1) && IN(pb + 4)) { TIDS(); LAYER_PTRS();
            for (int i = gt; i < M * RH; i += NGT) retout_item(Z, l, i >> 3, i & 7, SPREV, INP(I_SRET), INP(I_GRET), ORAW, Y + (size_t)3 * M * BRW);
            __syncthreads();
            PoolOrder S{G, bx, (const char*)ZP, (const char*)(WPOOL_T + (size_t)l * 4 * 256 * 256)};
            pg8::EpiPool E{Y + (size_t)2 * M * BRW, INP(I_SPOOLS), l};
            pg8::gemm_phase<pg8::EpiPool, PoolOrder>(L + RING_OFF, pg8::Dims{BRW, 256, 256}, S, E, tid);
            SEAM(pb + 4);
        }
        if ((PH_MASK >> 5 & 1) && IN(pb + 5)) { TIDS(); LAYER_PTRS();
            BrOrder S{G, bx, (const char*)Y, (const char*)(WBR_T + (size_t)l * 4 * DM * BRW)};
            pg8::EpiBr E{Z, MACC, MERGED};
            pg8::gemm_phase<pg8::EpiBr, BrOrder>(L + RING_OFF, pg8::Dims{BRW, BRW, BRW}, S, E, tid);
            SEAM(pb + 5);
        }
        if ((PH_MASK >> 6 & 1) && IN(pb + 6)) { TIDS(); LAYER_PTRS();
            pg8::StaticOrder S; S.init(MERGED, WOUT_T + (size_t)l * DM * DM, M / 256, DM / 256, DM, DM, G, bx);
            pg8::EpiRes E{xinP, xinS, X1, ada + 2 * DM};
            pg8::gemm_phase<pg8::EpiRes, pg8::StaticOrder>(L + RING_OFF, pg8::Dims{DM, DM, DM}, S, E, tid);
            SEAM(pb + 6);
        }
        if ((PH_MASK >> 7 & 1) && IN(pb + 7)) { TIDS(); LAYER_PTRS();
            for (int row = gw; row < M; row += NGW) { const float* ar = ada + (size_t)row_cond(row) * ADAW;
                norm_row(X1 + (size_t)row * DM, INP(I_G2) + l * DM, ar + 4 * DM, ar + 3 * DM, H + (size_t)row * DM, lane); }
            SEAM(pb + 7);
        }
        if ((PH_MASK >> 8 & 1) && IN(pb + 8)) { TIDS(); LAYER_PTRS();
            pg8::StaticOrder S; S.init(H, WM1_T + (size_t)l * DFF * DM, M / 256, DFF / 256, DM, DM, G, bx);
            pg8::EpiMlp1 E{HID};
            pg8::gemm_phase<pg8::EpiMlp1, pg8::StaticOrder>(L + RING_OFF, pg8::Dims{DM, DM, DM}, S, E, tid);
            SEAM(pb + 8);
        }
        if ((PH_MASK >> 9 & 1) && IN(pb + 9)) { TIDS(); LAYER_PTRS();
            pg8::StaticOrder S; S.init(HID, WM2_T + (size_t)l * DM * DFF, M / 256, DM / 256, DFF, DFF, G, bx);
            pg8::EpiRes E{X1, X1 + (size_t)MP * DM, xout, ada + 5 * DM};
            pg8::gemm_phase<pg8::EpiRes, pg8::StaticOrder>(L + RING_OFF, pg8::Dims{DFF, DFF, DFF}, S, E, tid);
            SEAM(pb + 9);
        }
    }
#undef IN
#undef SEAM
}

extern "C" void kernel_launch(void* const* d_in, const int* in_sizes, int n_in, void* d_out, int out_size, void* d_ws, size_t ws_size, hipStream_t stream) {
    static int grid = 0;
    if (grid == 0) {
        if (n_in != N_IN || (size_t)out_size != O_END || ws_size < WS_END) { fprintf(stderr, "kernel_launch: unexpected shapes: n_in %d out %d ws %zu (need %zu)\n", n_in, out_size, ws_size, (size_t)WS_END); grid = -1; return; }
        int dev = 0, cus = 0, per_cu = 0;
        if (hipGetDevice(&dev) != hipSuccess || hipDeviceGetAttribute(&cus, hipDeviceAttributeMultiprocessorCount, dev) != hipSuccess) { grid = -1; return; }
        if (hipFuncSetAttribute((const void*)fwd, hipFuncAttributeMaxDynamicSharedMemorySize, LDS_BYTES) != hipSuccess) { fprintf(stderr, "kernel_launch: hipFuncSetAttribute failed\n"); grid = -1; return; }
        if (hipOccupancyMaxActiveBlocksPerMultiprocessor(&per_cu, (const void*)fwd, NTHR, LDS_BYTES) != hipSuccess || per_cu < 1) fprintf(stderr, "kernel_launch: occupancy query says %d\n", per_cu);
        (void)hipGetLastError();
        grid = cus;
    }
    if (grid < 0) return;
    (void)hipMemsetAsync((char*)d_ws + WS_CTL, 0, CTL_ZERO_BYTES, stream);
    Args a{};
    for (int i = 0; i < N_IN; ++i) a.in[i] = (const float*)d_in[i];
    a.out = (float*)d_out; a.ws = (unsigned char*)d_ws;
#if MK_ONE_LAUNCH
    a.ph_lo = 0; a.ph_hi = PH_TOTAL;
    hipLaunchKernelGGL(fwd, dim3(grid), dim3(NTHR), LDS_BYTES, stream, a);
#else
    for (int p = 0; p < PH_TOTAL; ++p) { a.ph_lo = p; a.ph_hi = p + 1; hipLaunchKernelGGL(fwd, dim3(grid), dim3(NTHR), LDS_BYTES, stream, a); }
#endif
}
#endif
```

```cpp
#ifndef HOST_TEST_ONLY
#include <hip/hip_runtime.h>
#endif
#include <cstdio>
#include <cstdint>
#include <cmath>

#ifndef MK_ONE_LAUNCH
#define MK_ONE_LAUNCH 1
#endif

#define HD __host__ __device__ __forceinline__
typedef unsigned short bf16;
HD float bf2f(bf16 b) { return __builtin_bit_cast(float, ((unsigned)b) << 16); }
HD bf16 f2bf(float f) { unsigned u = __builtin_bit_cast(unsigned, f); return (bf16)((u + 0x7fffu + ((u >> 16) & 1u)) >> 16); }

HD void ld8(const bf16* p, float* f) { const uint4 w = *(const uint4*)p;
    f[0] = __builtin_bit_cast(float, w.x << 16); f[1] = __builtin_bit_cast(float, w.x & 0xffff0000u); f[2] = __builtin_bit_cast(float, w.y << 16); f[3] = __builtin_bit_cast(float, w.y & 0xffff0000u);
    f[4] = __builtin_bit_cast(float, w.z << 16); f[5] = __builtin_bit_cast(float, w.z & 0xffff0000u); f[6] = __builtin_bit_cast(float, w.w << 16); f[7] = __builtin_bit_cast(float, w.w & 0xffff0000u); }
HD void st8(bf16* p, const float* f) { uint4 w; w.x = (unsigned)f2bf(f[0]) | ((unsigned)f2bf(f[1]) << 16); w.y = (unsigned)f2bf(f[2]) | ((unsigned)f2bf(f[3]) << 16);
    w.z = (unsigned)f2bf(f[4]) | ((unsigned)f2bf(f[5]) << 16); w.w = (unsigned)f2bf(f[6]) | ((unsigned)f2bf(f[7]) << 16); *(uint4*)p = w; }
constexpr int DM = 2048, SEQ = 4096, NBP = 2, MP = NBP * SEQ, SB = 32, ST = 8, MS = SB * ST, M = MP + MS, DEPTH = 4;
constexpr int NROWB = NBP + SB;
constexpr int NH = 16, HDIM = 64, NKV = 4, WIN = 128, BRW = 1024, CONVK = 31, CPRE = 30, PPAD = 15, RH = 8, RDK = 64, RDV = 128, DFF = 8192;
constexpr int ZW = 15872, ZQ = 0, ZK = 1024, ZV = 1280, ZCA = 1536, ZCG = 2560, ZPL = 3584, ZRQ = 4608, ZRK = 5120, ZRV = 5632, ZRG = 6656, ZGT = 7680;
constexpr int ADAW = 6 * DM;
constexpr float EPS = 1e-6f;
constexpr size_t O_YP = 0, O_YS = O_YP + (size_t)MP * DM, O_KP = O_YS + (size_t)MS * DM, O_VP = O_KP + (size_t)DEPTH * NBP * WIN * 256,
    O_CP = O_VP + (size_t)DEPTH * NBP * WIN * 256, O_PP = O_CP + (size_t)DEPTH * NBP * CPRE * BRW, O_RP = O_PP + (size_t)DEPTH * NBP * PPAD * BRW,
    O_KS = O_RP + (size_t)DEPTH * NBP * RH * RDK * RDV, O_VS = O_KS + (size_t)DEPTH * SB * WIN * 256, O_CS = O_VS + (size_t)DEPTH * SB * WIN * 256,
    O_PS = O_CS + (size_t)DEPTH * SB * CPRE * BRW, O_RS = O_PS + (size_t)DEPTH * SB * PPAD * BRW, O_END = O_RS + (size_t)DEPTH * SB * RH * RDK * RDV;
static_assert(O_END == 41394176, "output size");
enum { I_XP = 0, I_XS, I_CP, I_CS, I_CK, I_CV, I_SCONV, I_SPOOL, I_SRET, I_WADA, I_BADA, I_G1, I_G2, I_WIN, I_GQ, I_GK, I_SINK, I_WDW, I_BDW, I_GCLN, I_BCLN,
       I_WPOOL, I_SPOOLS, I_GRET, I_WBR, I_WOUT, I_WM1, I_WM2, N_IN };

HD bool row_is_s(int row) { return row >= MP; }
HD int row_cond(int row) { return row < MP ? (row >> 12) : NBP + ((row - MP) >> 3); }

#if defined(__HIP_DEVICE_COMPILE__)
#define FEXP(x) __expf(x)
#else
#define FEXP(x) expf(x)
#endif
HD float sigmoidf_(float x) { return 1.f / (1.f + FEXP(-x)); }
HD float ret_logg(int h) { const float x = __builtin_bit_cast(float, (unsigned)(127 - 5 - h) << 23); return -x * (1.f + x * (0.5f + x * (0.33333334f + x * (0.25f + x * 0.2f)))); }

HD void qknorm_item(bf16* Z, int l, int row, int slot, const float* gq, const float* gk, float* out) {
    const int col = slot < 16 ? ZQ + slot * 64 : (slot < 20 ? ZK + (slot - 16) * 64 : ZV + (slot - 20) * 64);
    bf16* p = Z + (size_t)row * ZW + col;
    float v[64];
#pragma unroll
    for (int i = 0; i < 64; i += 8) ld8(p + i, v + i);
    if (slot < 20) {
        float ss = 0.f;
#pragma unroll
        for (int i = 0; i < 64; ++i) ss += v[i] * v[i];
        const float r = 1.f / sqrtf(ss * (1.f / 64.f) + EPS);
        const float* g = (slot < 16 ? gq : gk) + l * 64;
#pragma unroll
        for (int i = 0; i < 64; ++i) v[i] = v[i] * r * g[i];
#pragma unroll
        for (int i = 0; i < 64; i += 8) st8(p + i, v + i);
    }
    if (slot >= 16) {
        const int kvh = (slot - 16) & 3; const bool isv = slot >= 20;
        float* o = nullptr;
        if (!row_is_s(row)) { const int b = row >> 12, t = row & (SEQ - 1);
            if (t >= SEQ - WIN) o = out + (isv ? O_VP : O_KP) + ((((size_t)l * NBP + b) * WIN + (t - (SEQ - WIN))) * NKV + kvh) * 64;
        } else { const int sb = (row - MP) >> 3, t = (row - MP) & 7;
            o = out + (isv ? O_VS : O_KS) + ((((size_t)l * SB + sb) * WIN + (WIN - ST + t)) * NKV + kvh) * 64; }
        if (o) {
#pragma unroll
            for (int i = 0; i < 64; ++i) o[i] = v[i];
        }
    }
}
HD void shift_item(int l, int idx, const float* ck, const float* cv, const float* sconv, const float* spool, float* out) {
    constexpr int NKVS = SB * (WIN - ST) * 64, NCV = SB * (CPRE - ST) * 256, NPL = SB * (PPAD - ST) * 256;
    const float* src; float* dst;
    if (idx < 2 * NKVS) { const bool isv = idx >= NKVS; const int i = isv ? idx - NKVS : idx; const int sb = i / ((WIN - ST) * 64), rem = i % ((WIN - ST) * 64);
        src = (isv ? cv : ck) + (((size_t)l * SB + sb) * WIN + ST) * 256 + (size_t)rem * 4; dst = out + (isv ? O_VS : O_KS) + (((size_t)l * SB + sb) * WIN) * 256 + (size_t)rem * 4;
    } else if (idx < 2 * NKVS + NCV) { const int i = idx - 2 * NKVS; const int sb = i / ((CPRE - ST) * 256), rem = i % ((CPRE - ST) * 256);
        src = sconv + (((size_t)l * SB + sb) * CPRE + ST) * BRW + (size_t)rem * 4; dst = out + O_CS + (((size_t)l * SB + sb) * CPRE) * BRW + (size_t)rem * 4;
    } else { const int i = idx - 2 * NKVS - NCV; const int sb = i / ((PPAD - ST) * 256), rem = i % ((PPAD - ST) * 256);
        src = spool + (((size_t)l * SB + sb) * PPAD + ST) * BRW + (size_t)rem * 4; dst = out + O_PS + (((size_t)l * SB + sb) * PPAD) * BRW + (size_t)rem * 4; }
    dst[0] = src[0]; dst[1] = src[1]; dst[2] = src[2]; dst[3] = src[3];
}
constexpr int N_SHIFT_ITEMS = 2 * SB * (WIN - ST) * 64 + SB * (CPRE - ST) * 256 + SB * (PPAD - ST) * 256;

HD float glu_at(const bf16* Z, int row, int c) { const bf16* p = Z + (size_t)row * ZW; return bf2f(p[ZCA + c]) * sigmoidf_(bf2f(p[ZCG + c])); }
HD void conv_item(const bf16* Z, int l, int row, int c, const float* wdw, const float* bdw, const float* sconv, float* CONVY, float* out) {
    float acc = bdw[l * BRW + c];
    const float* w = wdw + (size_t)l * CONVK * BRW + c;
    if (!row_is_s(row)) { const int b = row >> 12, t = row & (SEQ - 1);
        for (int j = 0; j < CONVK; ++j) { const int tt = t - CPRE + j; if (tt >= 0) acc += w[(size_t)j * BRW] * glu_at(Z, b * SEQ + tt, c); }
        if (t >= SEQ - CPRE) out[O_CP + (((size_t)l * NBP + b) * CPRE + (t - (SEQ - CPRE))) * BRW + c] = glu_at(Z, row, c);
    } else { const int sb = (row - MP) >> 3, t = (row - MP) & 7;
        for (int j = 0; j < CONVK; ++j) { const int tt = t - CPRE + j;
            const float u = tt >= 0 ? glu_at(Z, MP + sb * ST + tt, c) : sconv[(((size_t)l * SB + sb) * CPRE + (CPRE + tt)) * BRW + c];
            acc += w[(size_t)j * BRW] * u; }
        out[O_CS + (((size_t)l * SB + sb) * CPRE + (CPRE - ST + t)) * BRW + c] = glu_at(Z, row, c);
    }
    CONVY[(size_t)row * BRW + c] = acc;
}
HD void pool_item(const bf16* Z, int l, int row, int c, const float* spool, bf16* ZP, float* out) {
    const int g = c >> 8, w = 2 << g;
    const float u0 = bf2f(Z[(size_t)row * ZW + ZPL + c]);
    float sum = 0.f, cnt;
    if (!row_is_s(row)) { const int b = row >> 12, t = row & (SEQ - 1);
        for (int i = 0; i < w; ++i) if (t - i >= 0) sum += bf2f(Z[(size_t)(b * SEQ + t - i) * ZW + ZPL + c]);
        cnt = (float)((t + 1) < w ? (t + 1) : w);
        if (t >= SEQ - PPAD) out[O_PP + (((size_t)l * NBP + b) * PPAD + (t - (SEQ - PPAD))) * BRW + c] = u0;
    } else { const int sb = (row - MP) >> 3, t = (row - MP) & 7;
        for (int i = 0; i < w; ++i) { const int tt = t - i;
            sum += tt >= 0 ? bf2f(Z[(size_t)(MP + sb * ST + tt) * ZW + ZPL + c]) : spool[(((size_t)l * SB + sb) * PPAD + (PPAD + tt)) * BRW + c]; }
        cnt = (float)w;
        out[O_PS + (((size_t)l * SB + sb) * PPAD + (PPAD - ST + t)) * BRW + c] = u0;
    }
    ZP[(size_t)row * BRW + c] = f2bf(sum / cnt - u0);
}
HD void retkv_item(const bf16* Z, float* KV, int b, int n, int h, int d, int v4) {
    const float lg = ret_logg(h);
    float a0 = 0.f, a1 = 0.f, a2 = 0.f, a3 = 0.f;
    for (int j = 0; j < 128; ++j) { const bf16* p = Z + (size_t)(b * SEQ + n * 128 + j) * ZW;
        const float kd = bf2f(p[ZRK + h * 64 + d]) * 0.125f * FEXP(lg * (float)(127 - j));
        const bf16* pv = p + ZRV + h * 128 + v4 * 4;
        a0 += kd * bf2f(pv[0]); a1 += kd * bf2f(pv[1]); a2 += kd * bf2f(pv[2]); a3 += kd * bf2f(pv[3]); }
    float* o = KV + ((((size_t)b * 32 + n) * RH + h) * RDK + d) * RDV + v4 * 4;
    o[0] = a0; o[1] = a1; o[2] = a2; o[3] = a3;
}
HD void retstate_s_item(const bf16* Z, int l, int sb, int h, int d, int v4, const float* sret, float* out) {
    const float lg = ret_logg(h);
    const size_t so = ((((size_t)l * SB + sb) * RH + h) * RDK + d) * RDV + v4 * 4;
    const float gc = FEXP(lg * (float)ST);
    float a0 = gc * sret[so], a1 = gc * sret[so + 1], a2 = gc * sret[so + 2], a3 = gc * sret[so + 3];
    for (int j = 0; j < ST; ++j) { const bf16* p = Z + (size_t)(MP + sb * ST + j) * ZW;
        const float kd = bf2f(p[ZRK + h * 64 + d]) * 0.125f * FEXP(lg * (float)(ST - 1 - j));
        const bf16* pv = p + ZRV + h * 128 + v4 * 4;
        a0 += kd * bf2f(pv[0]); a1 += kd * bf2f(pv[1]); a2 += kd * bf2f(pv[2]); a3 += kd * bf2f(pv[3]); }
    float* o = out + O_RS + so; o[0] = a0; o[1] = a1; o[2] = a2; o[3] = a3;
}
HD void retscan_item(const float* KV, float* SPREV, int l, int b, int h, int d, int v4, float* out) {
    const float gc = FEXP(ret_logg(h) * 128.f);
    float s0 = 0.f, s1 = 0.f, s2 = 0.f, s3 = 0.f;
    for (int n = 0; n < 32; ++n) { const size_t o = ((((size_t)b * 32 + n) * RH + h) * RDK + d) * RDV + v4 * 4;
        SPREV[o] = s0; SPREV[o + 1] = s1; SPREV[o + 2] = s2; SPREV[o + 3] = s3;
        s0 = gc * s0 + KV[o]; s1 = gc * s1 + KV[o + 1]; s2 = gc * s2 + KV[o + 2]; s3 = gc * s3 + KV[o + 3]; }
    float* oo = out + O_RP + ((((size_t)l * NBP + b) * RH + h) * RDK + d) * RDV + v4 * 4;
    oo[0] = s0; oo[1] = s1; oo[2] = s2; oo[3] = s3;
}
HD void attn_item(const bf16* Z, int l, int row, int hq, const float* sinks, const float* ck, const float* cv, bf16* Y0) {
    const int kvh = hq >> 2; const float slope = exp2f(-0.5f * (float)(hq + 1));
    float q[64];
    { const bf16* p = Z + (size_t)row * ZW + ZQ + hq * 64;
#pragma unroll
      for (int i = 0; i < 64; i += 8) ld8(p + i, q + i);
#pragma unroll
      for (int i = 0; i < 64; ++i) q[i] *= 0.125f; }
    float m = sinks[l * NH + hq], lsum = 1.f;
    float o[64];
#pragma unroll
    for (int i = 0; i < 64; ++i) o[i] = 0.f;
    const bool smp = row_is_s(row);
    const int b = smp ? ((row - MP) >> 3) : (row >> 12), t = smp ? ((row - MP) & 7) : (row & (SEQ - 1));
    const int lo = smp ? t : (t - WIN > 0 ? t - WIN : 0), hi = smp ? WIN + t : t;
    for (int j = lo; j <= hi; ++j) {
        const int dist = smp ? (WIN + t - j) : (t - j);
        const bool cache = smp && j < WIN;
        const size_t zrow = (size_t)(smp ? (MP + b * ST + (j - WIN)) : (b * SEQ + j)) * ZW;
        const size_t crow = ((((size_t)l * SB + b) * WIN + j) * NKV + kvh) * 64;
        float s = 0.f;
        if (cache) { const float* kp = ck + crow;
#pragma unroll
            for (int i = 0; i < 64; ++i) s += q[i] * kp[i];
        } else { const bf16* kp = Z + zrow + ZK + kvh * 64;
#pragma unroll
            for (int i = 0; i < 64; i += 8) { float f[8]; ld8(kp + i, f);
#pragma unroll
                for (int e = 0; e < 8; ++e) s += q[i + e] * f[e]; } }
        s -= slope * (float)dist;
        if (s > m) { const float corr = FEXP(m - s); lsum *= corr;
#pragma unroll
            for (int i = 0; i < 64; ++i) o[i] *= corr;
            m = s; }
        const float p = FEXP(s - m); lsum += p;
        if (cache) { const float* vp = cv + crow;
#pragma unroll
            for (int i = 0; i < 64; ++i) o[i] += p * vp[i];
        } else { const bf16* vp = Z + zrow + ZV + kvh * 64;
#pragma unroll
            for (int i = 0; i < 64; i += 8) { float f[8]; ld8(vp + i, f);
#pragma unroll
                for (int e = 0; e < 8; ++e) o[i + e] += p * f[e]; } }
    }
    const float inv = 1.f / lsum;
    bf16* y = Y0 + (size_t)row * BRW + hq * 64;
#pragma unroll
    for (int i = 0; i < 64; ++i) o[i] *= inv;
#pragma unroll
    for (int i = 0; i < 64; i += 8) st8(y + i, o + i);
}
HD void retout_item(const bf16* Z, int l, int row, int h, const float* SPREV, const float* sret, const float* gret, float* ORAW, bf16* Y3) {
    const float lg = ret_logg(h);
    const bool smp = row_is_s(row);
    const int b = smp ? ((row - MP) >> 3) : (row >> 12), t = smp ? ((row - MP) & 7) : (row & (SEQ - 1));
    const int i = smp ? t : (t & 127), n = smp ? 0 : (t >> 7);
    const int row0 = smp ? (MP + b * ST) : (b * SEQ + n * 128);
    const float* S = smp ? sret + (((size_t)l * SB + b) * RH + h) * RDK * RDV : SPREV + (((size_t)b * 32 + n) * RH + h) * RDK * RDV;
    float q[64];
    { const bf16* p = Z + (size_t)row * ZW + ZRQ + h * 64;
#pragma unroll
      for (int d = 0; d < 64; d += 8) ld8(p + d, q + d); }
    float* oraw = ORAW + (size_t)row * BRW + h * 128;
    float sum = 0.f;
    for (int half = 0; half < 2; ++half) {
        float o[64];
#pragma unroll
        for (int v = 0; v < 64; ++v) o[v] = 0.f;
        for (int j = 0; j <= i; ++j) { const bf16* p = Z + (size_t)(row0 + j) * ZW;
            const bf16* kp = p + ZRK + h * 64; float s = 0.f;
#pragma unroll
            for (int d = 0; d < 64; d += 8) { float f[8]; ld8(kp + d, f);
#pragma unroll
                for (int e = 0; e < 8; ++e) s += q[d + e] * f[e]; }
            s *= 0.125f * FEXP(lg * (float)(i - j));
            const bf16* vp = p + ZRV + h * 128 + half * 64;
#pragma unroll
            for (int v = 0; v < 64; v += 8) { float f[8]; ld8(vp + v, f);
#pragma unroll
                for (int e = 0; e < 8; ++e) o[v + e] += s * f[e]; } }
        const float cf = FEXP(lg * (float)(i + 1));
        const bf16* qp = Z + (size_t)row * ZW + ZRQ + h * 64;
        for (int d = 0; d < 64; ++d) { const float qd = bf2f(qp[d]) * cf; const float* sp = S + (size_t)d * RDV + half * 64;
#pragma unroll
            for (int v = 0; v < 64; ++v) o[v] += qd * sp[v]; }
#pragma unroll
        for (int v = 0; v < 64; ++v) { oraw[half * 64 + v] = o[v]; sum += o[v]; }
    }
    const float mean = sum * (1.f / 128.f);
    float var = 0.f;
    for (int v = 0; v < 128; ++v) { const float d = oraw[v] - mean; var += d * d; }
    const float rstd = 1.f / sqrtf(var * (1.f / 128.f) + EPS);
    const float* g = gret + l * BRW + h * 128;
    const bf16* rg = Z + (size_t)row * ZW + ZRG + h * 128;
    bf16* y = Y3 + (size_t)row * BRW + h * 128;
    for (int v = 0; v < 128; ++v) y[v] = f2bf((oraw[v] - mean) * rstd * g[v] * bf2f(rg[v]));
}

#if !defined(HOST_TEST_ONLY)
namespace pg8 {
#define PG8_LAS __attribute__((address_space(3)))
typedef short bf16x8 __attribute__((ext_vector_type(8)));
typedef float f32x4 __attribute__((ext_vector_type(4)));
typedef float f32x2 __attribute__((ext_vector_type(2)));
typedef unsigned u32x4 __attribute__((ext_vector_type(4)));
typedef unsigned u32x2 __attribute__((ext_vector_type(2)));
constexpr int BM = 256, BK = 64, HALF = 128, HTB = HALF * BK * 2, STAGE_BYTES = 8 * HTB, NXCD = 8, WGM = 8;

__host__ __device__ __forceinline__ int lds_byte(int r, int c) { const int st = (r >> 4) * 2 + (c >> 5), rr = r & 15, cc = c & 31, ob = rr * 64 + cc * 2; return st * 1024 + (ob ^ (((ob >> 9) & 1) << 5)); }
__host__ __device__ __forceinline__ void stage_rc(int b, int& R, int& C) { const int st = b / 1024, sb = b % 1024, swz = sb ^ (((sb >> 9) & 1) << 5); R = (st >> 1) * 16 + swz / 64; C = (st & 1) * 32 + (swz % 64) / 2; }
__host__ __device__ __forceinline__ int perm32(int rho) { const int n = rho >> 4, i = rho & 15; return 8 * (i >> 2) + 4 * n + (i & 3); }

struct Unit { int pm, pn, r; const char* a; const char* b; };
struct Dims { int lda, ldb, K; };

__host__ __device__ __forceinline__ void tile_of(int L, int nM, int nN, int& pm, int& pn) {
    const int nwg = nM * nN; int wgid = L; { const int q = nwg / NXCD, r = nwg % NXCD, xcd = wgid % NXCD, off = wgid / NXCD; wgid = (xcd < r ? xcd * (q + 1) : r * (q + 1) + (xcd - r) * q) + off; }
    const int nig = WGM * nN, gid = wgid / nig, fm = gid * WGM, gsz = (nM - fm) < WGM ? (nM - fm) : WGM;
    pm = fm + ((wgid % nig) % gsz); pn = (wgid % nig) / gsz;
}
struct StaticOrder {
    int nM, nN, nwg, G, c; const char* A; const char* B; size_t ta, tb;
    __device__ __forceinline__ void init(const bf16* A_, const bf16* B_, int nM_, int nN_, int lda, int ldb, int G_, int c_) { A = (const char*)A_; B = (const char*)B_; nM = nM_; nN = nN_; nwg = nM * nN; G = G_; c = c_; ta = (size_t)BM * lda * 2; tb = (size_t)BM * ldb * 2; }
    __device__ __forceinline__ bool next(int i, Unit& u) const {
        const long L = (long)i * G + c; if (L >= nwg) return false;
        tile_of((int)L, nM, nN, u.pm, u.pn); u.r = 0; u.a = A + (size_t)u.pm * ta; u.b = B + (size_t)u.pn * tb; return true;
    }
};

__device__ __forceinline__ unsigned cvt_pk_bf16(float lo, float hi) { unsigned r; asm volatile("v_cvt_pk_bf16_f32 %0, %1, %2" : "=v"(r) : "v"(lo), "v"(hi)); return r; }

template <class Epi, class Sched, bool ALIGN_EPI = true, bool SP2 = true>
__device__ __forceinline__ void gemm_phase(PG8_LAS unsigned char* lds, const Dims g, const Sched& S, const Epi& E, const int tid) {
    const int wid = __builtin_amdgcn_readfirstlane(tid >> 6), lane = tid & 63, wr = wid >> 2, wc = wid & 3, fr = lane & 15, fq = lane >> 4;
    const int K = g.K, nt = K / BK;
    unsigned voffA[2], voffB[2];
#pragma unroll
    for (int i = 0; i < 2; ++i) { int R, C; stage_rc(tid * 16 + i * 8192, R, C); const int Rb = Epi::PERM ? ((R & ~31) + perm32(R & 31)) : R;
        voffA[i] = (unsigned)(R * g.lda + C) * 2u; voffB[i] = (unsigned)(Rb * g.ldb + C) * 2u; }
    const size_t kstep = (size_t)(BK * 2);
    const size_t hstepA = (size_t)HALF * g.lda * 2, hstepB = (size_t)HALF * g.ldb * 2;
    const unsigned ldsw = (unsigned)wid * 1024u;
    const int aoff = lds_byte(wr * 64 + fr, fq * 8), boff = lds_byte(wc * 32 + fr, fq * 8);
#define PG8_SA(b, h) (((b) * 2 + (h)) * HTB)
#define PG8_SB(b, h) ((4 + (b) * 2 + (h)) * HTB)
#define PG8_STAGE(bufoff, gbase, voff) do { _Pragma("unroll") for (int _i = 0; _i < 2; ++_i) \
        __builtin_amdgcn_global_load_lds((const unsigned*)((const char*)(gbase) + (voff)[_i]), (PG8_LAS unsigned*)(lds + (bufoff) + ldsw + _i * 8192), 16, 0, 0); } while (0)
#define PG8_LDA(dst, b, h) do { _Pragma("unroll") for (int m = 0; m < 4; ++m) _Pragma("unroll") for (int k = 0; k < 2; ++k) dst[m][k] = *(const PG8_LAS bf16x8*)(lds + PG8_SA(b, h) + aoff + m * 2048 + k * 1024); } while (0)
#define PG8_LDB(dst, b, h) do { _Pragma("unroll") for (int n = 0; n < 2; ++n) _Pragma("unroll") for (int k = 0; k < 2; ++k) dst[n][k] = *(const PG8_LAS bf16x8*)(lds + PG8_SB(b, h) + boff + n * 2048 + k * 1024); } while (0)
#define PG8_MMA(ai, bj, At, Bt) do { __builtin_amdgcn_s_setprio(1); _Pragma("unroll") for (int m = 0; m < 4; ++m) _Pragma("unroll") for (int n = 0; n < 2; ++n) _Pragma("unroll") for (int k = 0; k < 2; ++k) \
        acc[ai][bj][m][n] = __builtin_amdgcn_mfma_f32_16x16x32_bf16(Bt[n][k], At[m][k], acc[ai][bj][m][n], 0, 0, 0); __builtin_amdgcn_s_setprio(0); } while (0)
#define PG8_WAIT_V(n) asm volatile("s_waitcnt vmcnt(" #n ")" ::: "memory")
#define PG8_WAIT_L(n) asm volatile("s_waitcnt lgkmcnt(" #n ")" ::: "memory")
#define PG8_BAR __builtin_amdgcn_s_barrier()
#define PG8_SCHED __builtin_amdgcn_sched_barrier(0)
    Unit cur, nxt; int ui = 0;
    if (!S.next(0, cur)) return;
    f32x4 acc[2][2][4][2];
#pragma unroll
    for (int a = 0; a < 2; ++a)
#pragma unroll
        for (int b = 0; b < 2; ++b)
#pragma unroll
            for (int m = 0; m < 4; ++m)
#pragma unroll
                for (int n = 0; n < 2; ++n) acc[a][b][m][n] = (f32x4){0.f, 0.f, 0.f, 0.f};
    bf16x8 At[4][2], B0[2][2], B1[2][2];
    const char* cA = cur.a; const char* cB = cur.b;
    if constexpr (SP2) {
        PG8_STAGE(PG8_SB(0, 0), cB, voffB); PG8_STAGE(PG8_SB(0, 1), cB + hstepB, voffB); PG8_STAGE(PG8_SA(0, 0), cA, voffA); PG8_STAGE(PG8_SA(0, 1), cA + hstepA, voffA);
        if (wr == 1) PG8_BAR;
        PG8_WAIT_V(2); PG8_BAR;
        PG8_STAGE(PG8_SB(1, 0), cB + kstep, voffB); PG8_STAGE(PG8_SA(1, 0), cA + kstep, voffA); PG8_STAGE(PG8_SB(1, 1), cB + hstepB + kstep, voffB);
        PG8_WAIT_V(6); PG8_BAR;
    } else {
        PG8_STAGE(PG8_SB(0, 0), cB, voffB); PG8_STAGE(PG8_SA(0, 0), cA, voffA); PG8_STAGE(PG8_SB(0, 1), cB + hstepB, voffB); PG8_STAGE(PG8_SA(0, 1), cA + hstepA, voffA);
        if (wr == 1) PG8_BAR;
        PG8_WAIT_V(4); PG8_BAR;
        PG8_STAGE(PG8_SB(1, 0), cB + kstep, voffB); PG8_STAGE(PG8_SA(1, 0), cA + kstep, voffA); PG8_STAGE(PG8_SB(1, 1), cB + hstepB + kstep, voffB);
        PG8_WAIT_V(6); PG8_BAR;
    }
    for (;;) {
        const bool has_next = S.next(ui + 1, nxt);
        const char* nA = has_next ? nxt.a : cA; const char* nB = has_next ? nxt.b : cB;
        for (int t = 0; t < nt; t += 2) {
            const bool last = (t == nt - 2);
            const char* a1 = cA + (size_t)(t + 1) * kstep;
            const char* a2 = last ? nA : cA + (size_t)(t + 2) * kstep; const char* b2 = last ? nB : cB + (size_t)(t + 2) * kstep;
            const char* a3 = a2 + kstep; const char* b3 = b2 + kstep;
            if constexpr (SP2) {
            PG8_LDB(B0, 0, 0); PG8_LDB(B1, 0, 1); PG8_SCHED; PG8_LDA(At, 0, 0); PG8_STAGE(PG8_SA(1, 1), a1 + hstepA, voffA);
            PG8_WAIT_V(8); PG8_WAIT_L(0); PG8_BAR; PG8_MMA(0, 0, At, B0); PG8_MMA(0, 1, At, B1); PG8_BAR; PG8_SCHED;
            PG8_LDA(At, 0, 1); PG8_STAGE(PG8_SB(0, 0), b2, voffB); PG8_STAGE(PG8_SB(0, 1), b2 + hstepB, voffB); PG8_STAGE(PG8_SA(0, 0), a2, voffA);
            PG8_WAIT_V(8); PG8_WAIT_L(0); PG8_BAR; PG8_MMA(1, 0, At, B0); PG8_MMA(1, 1, At, B1); PG8_BAR; PG8_SCHED;
            PG8_LDB(B0, 1, 0); PG8_LDB(B1, 1, 1); PG8_SCHED; PG8_LDA(At, 1, 0); PG8_STAGE(PG8_SA(0, 1), a2 + hstepA, voffA);
            PG8_WAIT_V(8); PG8_WAIT_L(0); PG8_BAR; PG8_MMA(0, 0, At, B0); PG8_MMA(0, 1, At, B1); PG8_BAR; PG8_SCHED;
            PG8_LDA(At, 1, 1); PG8_STAGE(PG8_SB(1, 0), b3, voffB); PG8_STAGE(PG8_SB(1, 1), b3 + hstepB, voffB); PG8_STAGE(PG8_SA(1, 0), a3, voffA);
            PG8_WAIT_V(8); PG8_WAIT_L(0); PG8_BAR; PG8_MMA(1, 0, At, B0); PG8_MMA(1, 1, At, B1); PG8_BAR; PG8_SCHED;
            } else {
            PG8_LDB(B0, 0, 0); PG8_SCHED; PG8_LDA(At, 0, 0); PG8_STAGE(PG8_SA(1, 1), a1 + hstepA, voffA);
            PG8_WAIT_L(8); PG8_BAR; PG8_WAIT_L(0); PG8_MMA(0, 0, At, B0); PG8_BAR; PG8_SCHED;
            PG8_LDB(B1, 0, 1); PG8_STAGE(PG8_SB(0, 0), b2, voffB);
            PG8_BAR; PG8_WAIT_L(0); PG8_MMA(0, 1, At, B1); PG8_BAR;
            PG8_LDA(At, 0, 1); PG8_STAGE(PG8_SA(0, 0), a2, voffA);
            PG8_BAR; PG8_WAIT_L(0); PG8_MMA(1, 0, At, B0); PG8_BAR; PG8_SCHED;
            PG8_STAGE(PG8_SB(0, 1), b2 + hstepB, voffB);
            PG8_WAIT_V(6); PG8_BAR; PG8_MMA(1, 1, At, B1); PG8_BAR;
            PG8_LDB(B0, 1, 0); PG8_SCHED; PG8_LDA(At, 1, 0); PG8_STAGE(PG8_SA(0, 1), a2 + hstepA, voffA);
            PG8_WAIT_L(8); PG8_BAR; PG8_WAIT_L(0); PG8_MMA(0, 0, At, B0); PG8_BAR; PG8_SCHED;
            PG8_LDB(B1, 1, 1); PG8_STAGE(PG8_SB(1, 0), b3, voffB);
            PG8_BAR; PG8_WAIT_L(0); PG8_MMA(0, 1, At, B1); PG8_BAR;
            PG8_LDA(At, 1, 1); PG8_STAGE(PG8_SA(1, 0), a3, voffA);
            PG8_BAR; PG8_WAIT_L(0); PG8_MMA(1, 0, At, B0); PG8_BAR; PG8_SCHED;
            PG8_STAGE(PG8_SB(1, 1), b3 + hstepB, voffB);
            PG8_WAIT_V(6); PG8_BAR; PG8_MMA(1, 1, At, B1); PG8_BAR;
            }
        }
        if constexpr (ALIGN_EPI) { if (wr == 0) PG8_BAR; }
        { int ln; asm volatile("v_mbcnt_lo_u32_b32 %0, -1, 0\n\tv_mbcnt_hi_u32_b32 %0, -1, %0" : "=v"(ln)); E(acc, cur, wr, wc, ln & 15, ln >> 4); }
        if (!has_next) break;
#pragma unroll
        for (int a = 0; a < 2; ++a)
#pragma unroll
            for (int b = 0; b < 2; ++b)
#pragma unroll
                for (int m = 0; m < 4; ++m)
#pragma unroll
                    for (int n = 0; n < 2; ++n) acc[a][b][m][n] = (f32x4){0.f, 0.f, 0.f, 0.f};
        cur = nxt; cA = nA; cB = nB; ++ui;
        if constexpr (ALIGN_EPI) { if (wr == 1) PG8_BAR; }
    }
    PG8_WAIT_V(0);
    if constexpr (!ALIGN_EPI) { if (wr == 0) PG8_BAR; }
    PG8_BAR;
#undef PG8_SA
#undef PG8_SB
#undef PG8_STAGE
#undef PG8_LDA
#undef PG8_LDB
#undef PG8_MMA
#undef PG8_WAIT_V
#undef PG8_WAIT_L
#undef PG8_BAR
#undef PG8_SCHED
}

__device__ __forceinline__ float fsigmoid(float x) { return __builtin_amdgcn_rcpf(1.f + __expf(-x)); }
struct EpiZ {
    static constexpr bool PERM = true;
    bf16* Z;
    __device__ __forceinline__ void operator()(const f32x4 (&acc)[2][2][4][2], const Unit& u, int wr, int wc, int fr, int fq) const {
        const int row0 = u.pm * BM + wr * 64 + fr, col0 = u.pn * BM + wc * 32 + 8 * fq;
        const int ty = u.pn >= 30 ? 2 : (u.pn >= 26 ? 1 : 0);
#pragma unroll
        for (int ai = 0; ai < 2; ++ai)
#pragma unroll
            for (int m = 0; m < 4; ++m) { bf16* rowp = Z + (size_t)(row0 + ai * HALF + m * 16) * ZW + col0;
#pragma unroll
                for (int bj = 0; bj < 2; ++bj) { f32x4 v0 = acc[ai][bj][m][0], v1 = acc[ai][bj][m][1];
                    if (ty == 2) {
#pragma unroll
                        for (int j = 0; j < 4; ++j) { v0[j] = fsigmoid(v0[j]); v1[j] = fsigmoid(v1[j]); } }
                    else if (ty == 1) {
#pragma unroll
                        for (int j = 0; j < 4; ++j) { v0[j] = v0[j] * fsigmoid(v0[j]); v1[j] = v1[j] * fsigmoid(v1[j]); } }
                    u32x4 w; w.x = cvt_pk_bf16(v0[0], v0[1]); w.y = cvt_pk_bf16(v0[2], v0[3]); w.z = cvt_pk_bf16(v1[0], v1[1]); w.w = cvt_pk_bf16(v1[2], v1[3]);
                    *(u32x4*)(rowp + bj * HALF) = w; } }
    }
};
struct EpiMlp1 {
    static constexpr bool PERM = true;
    bf16* O;
    __device__ __forceinline__ void operator()(const f32x4 (&acc)[2][2][4][2], const Unit& u, int wr, int wc, int fr, int fq) const {
        const int row0 = u.pm * BM + wr * 64 + fr, col0 = u.pn * BM + wc * 32 + 8 * fq;
#pragma unroll
        for (int ai = 0; ai < 2; ++ai)
#pragma unroll
            for (int m = 0; m < 4; ++m) { bf16* rowp = O + (size_t)(row0 + ai * HALF + m * 16) * DFF + col0;
#pragma unroll
                for (int bj = 0; bj < 2; ++bj) { f32x4 v0 = acc[ai][bj][m][0], v1 = acc[ai][bj][m][1];
#pragma unroll
                    for (int j = 0; j < 4; ++j) { const float a = fmaxf(v0[j], 0.f), b = fmaxf(v1[j], 0.f); v0[j] = a * a; v1[j] = b * b; }
                    u32x4 w; w.x = cvt_pk_bf16(v0[0], v0[1]); w.y = cvt_pk_bf16(v0[2], v0[3]); w.z = cvt_pk_bf16(v1[0], v1[1]); w.w = cvt_pk_bf16(v1[2], v1[3]);
                    *(u32x4*)(rowp + bj * HALF) = w; } }
    }
};
struct EpiPool {
    static constexpr bool PERM = true;
    bf16* Y2; const float* spb; int l;
    __device__ __forceinline__ void operator()(const f32x4 (&acc)[2][2][4][2], const Unit& u, int wr, int wc, int fr, int fq) const {
        const int row0 = u.pm * BM + wr * 64 + fr, col0 = u.pn * BM + wc * 32 + 8 * fq;
        int le = l; asm volatile("" : "+s"(le)); const float* sp = spb + le * BRW;
        f32x4 s[2][2];
#pragma unroll
        for (int bj = 0; bj < 2; ++bj)
#pragma unroll
            for (int n = 0; n < 2; ++n) s[bj][n] = *(const f32x4*)(sp + col0 + bj * HALF + 4 * n);
#pragma unroll
        for (int ai = 0; ai < 2; ++ai)
#pragma unroll
            for (int m = 0; m < 4; ++m) { bf16* rowp = Y2 + (size_t)(row0 + ai * HALF + m * 16) * BRW + col0;
#pragma unroll
                for (int bj = 0; bj < 2; ++bj) { const f32x4 v0 = acc[ai][bj][m][0] * s[bj][0], v1 = acc[ai][bj][m][1] * s[bj][1];
                    u32x4 w; w.x = cvt_pk_bf16(v0[0], v0[1]); w.y = cvt_pk_bf16(v0[2], v0[3]); w.z = cvt_pk_bf16(v1[0], v1[1]); w.w = cvt_pk_bf16(v1[2], v1[3]);
                    *(u32x4*)(rowp + bj * HALF) = w; } }
    }
};
struct EpiAda {
    static constexpr bool PERM = false;
    float* ADA; const float* bada;
    __device__ __forceinline__ void operator()(const f32x4 (&acc)[2][2][4][2], const Unit& u, int wr, int wc, int fr, int fq) const {
        if (wr != 0) return;
        const int col0 = u.pn * BM + wc * 32 + 4 * fq;
#pragma unroll
        for (int m = 0; m < 3; ++m) { const int row = m * 16 + fr;
            if (row < NROWB) {
#pragma unroll
                for (int bj = 0; bj < 2; ++bj)
#pragma unroll
                    for (int n = 0; n < 2; ++n) { const int c = col0 + bj * HALF + n * 16; const f32x4 bv = *(const f32x4*)(bada + (size_t)u.r * ADAW + c);
                        *(f32x4*)(ADA + ((size_t)u.r * NROWB + row) * ADAW + c) = acc[0][bj][m][n] + bv; } } }
    }
};
struct EpiBr {
    static constexpr bool PERM = true;
    const bf16* Z; float* MACC; bf16* MERGED;
    __device__ __forceinline__ void operator()(const f32x4 (&acc)[2][2][4][2], const Unit& u, int wr, int wc, int fr, int fq) const {
        const int row0 = u.pm * BM + wr * 64 + fr, col0 = u.pn * BM + wc * 32 + 8 * fq;
        const int r = u.r;
#pragma unroll
        for (int ai = 0; ai < 2; ++ai)
#pragma unroll
            for (int m = 0; m < 4; ++m) { const size_t row = (size_t)(row0 + ai * HALF + m * 16);
#pragma unroll
                for (int bj = 0; bj < 2; ++bj) { const int c = col0 + bj * HALF;
                    const u32x4 gw = *(const u32x4*)(Z + row * ZW + ZGT + r * DM + c);
                    f32x4 g0, g1;
                    g0[0] = __builtin_bit_cast(float, gw.x << 16); g0[1] = __builtin_bit_cast(float, gw.x & 0xffff0000u); g0[2] = __builtin_bit_cast(float, gw.y << 16); g0[3] = __builtin_bit_cast(float, gw.y & 0xffff0000u);
                    g1[0] = __builtin_bit_cast(float, gw.z << 16); g1[1] = __builtin_bit_cast(float, gw.z & 0xffff0000u); g1[2] = __builtin_bit_cast(float, gw.w << 16); g1[3] = __builtin_bit_cast(float, gw.w & 0xffff0000u);
                    f32x4 v0 = acc[ai][bj][m][0] * g0, v1 = acc[ai][bj][m][1] * g1;
                    float* mp = MACC + row * DM + c;
                    if (r > 0) { v0 += *(const f32x4*)mp; v1 += *(const f32x4*)(mp + 4); }
                    if (r < 3) { *(f32x4*)mp = v0; *(f32x4*)(mp + 4) = v1; }
                    else { u32x4 w; w.x = cvt_pk_bf16(v0[0], v0[1]); w.y = cvt_pk_bf16(v0[2], v0[3]); w.z = cvt_pk_bf16(v1[0], v1[1]); w.w = cvt_pk_bf16(v1[2], v1[3]);
                        *(u32x4*)(MERGED + row * DM + c) = w; } } }
    }
};
struct EpiRes {
    static constexpr bool PERM = false;
    const float* baseP; const float* baseS; float* out; const float* gate;
    __device__ __forceinline__ void operator()(const f32x4 (&acc)[2][2][4][2], const Unit& u, int wr, int wc, int fr, int fq) const {
        const int rl0 = wr * 64 + fr, col0 = u.pn * BM + wc * 32 + 4 * fq;
        const bool smp = u.pm >= MP / BM;
        const float* base = smp ? baseS : baseP + (size_t)u.pm * BM * DM;
        float* o = out + (size_t)u.pm * BM * DM;
#pragma unroll
        for (int ai = 0; ai < 2; ++ai)
#pragma unroll
            for (int m = 0; m < 4; ++m) { const int rl = rl0 + ai * HALF + m * 16;
                const float* gp = gate + (size_t)(smp ? NBP + (rl >> 3) : (u.pm >> 4)) * ADAW + col0;
#pragma unroll
                for (int bj = 0; bj < 2; ++bj)
#pragma unroll
                    for (int n = 0; n < 2; ++n) { const int c = bj * HALF + n * 16;
                        const f32x4 gv = *(const f32x4*)(gp + c); const f32x4 bs = *(const f32x4*)(base + (size_t)rl * DM + col0 + c);
                        *(f32x4*)(o + (size_t)rl * DM + col0 + c) = bs + gv * acc[ai][bj][m][n]; } }
    }
};
}

constexpr int NWAVES = 8, NTHR = NWAVES * 64;
constexpr size_t MiB = 1u << 20;
constexpr size_t al1(size_t x) { return (x + MiB - 1) / MiB * MiB; }
constexpr size_t WS_CTL = 0, CTL_ZERO_BYTES = 1 * MiB;
constexpr size_t WS_WIN = WS_CTL + CTL_ZERO_BYTES;
constexpr size_t WS_WBR = WS_WIN + al1((size_t)DEPTH * ZW * DM * 2);
constexpr size_t WS_WOUT = WS_WBR + al1((size_t)DEPTH * 4 * DM * BRW * 2);
constexpr size_t WS_WM1 = WS_WOUT + al1((size_t)DEPTH * DM * DM * 2);
constexpr size_t WS_WM2 = WS_WM1 + al1((size_t)DEPTH * DFF * DM * 2);
constexpr size_t WS_WPOOL = WS_WM2 + al1((size_t)DEPTH * DFF * DM * 2);
constexpr size_t WS_WADA = WS_WPOOL + al1((size_t)DEPTH * 4 * 256 * 256 * 2);
constexpr size_t WS_SC = WS_WADA + al1((size_t)DEPTH * ADAW * DM * 2);
constexpr size_t WS_ADA = WS_SC + al1((size_t)256 * DM * 2);
constexpr size_t WS_H = WS_ADA + al1((size_t)DEPTH * NROWB * ADAW * 4);
constexpr size_t WS_Z = WS_H + al1((size_t)M * DM * 2);
constexpr size_t WS_Y = WS_Z + al1((size_t)M * ZW * 2);
constexpr size_t WS_ZP = WS_Y + al1((size_t)4 * M * BRW * 2);
constexpr size_t WS_CONVY = WS_ZP + al1((size_t)M * BRW * 2);
constexpr size_t WS_ORAW = WS_CONVY + al1((size_t)M * BRW * 4);
constexpr size_t WS_KV = WS_ORAW + al1((size_t)M * BRW * 4);
constexpr size_t WS_SPREV = WS_KV + al1((size_t)NBP * 32 * RH * RDK * RDV * 4);
constexpr size_t WS_MACC = WS_SPREV + al1((size_t)NBP * 32 * RH * RDK * RDV * 4);
constexpr size_t WS_MERGED = WS_MACC + al1((size_t)M * DM * 4);
constexpr size_t WS_X1 = WS_MERGED + al1((size_t)M * DM * 2);
constexpr size_t WS_X = WS_X1 + al1((size_t)M * DM * 4);
constexpr size_t WS_HID = WS_X + al1((size_t)M * DM * 4);
constexpr size_t WS_END = WS_HID + al1((size_t)M * DFF * 2);
constexpr int CW_BAR = 4096;
constexpr int RING_OFF = 0, RING_BYTES = 131072, LDSCTL_OFF = RING_BYTES, MISC_OFF = LDSCTL_OFF + 320, INTAB_OFF = MISC_OFF + 128, LDS_BYTES = 147456;

#define GAS __attribute__((address_space(1)))
#define LAS __attribute__((address_space(3)))
typedef unsigned v4u __attribute__((ext_vector_type(4)));
typedef float f32x4 __attribute__((ext_vector_type(4)));
typedef GAS unsigned gu32;
#define RLX_AGENT __ATOMIC_RELAXED, __HIP_MEMORY_SCOPE_AGENT
#define LDS_WAIT() asm volatile("s_waitcnt lgkmcnt(0)" ::: "memory")
__device__ __forceinline__ unsigned pk2(float lo, float hi) { return (unsigned)f2bf(lo) | ((unsigned)f2bf(hi) << 16); }

#define XB_TMO      128
#define XB_XCNT(j)  (256  + 64 * (j))
#define XB_XSUB(j)  (1280 + 64 * (j))
#define XB_XGEN(j)  (2304 + 64 * (j))
#define XB_TOP      3328
#define XB_TOPGEN   3392
#define XCD_BAR_WORDS 3456
#define XB_SPIN_CAP (1u << 18)
__device__ __forceinline__ unsigned xb_ld(unsigned* p)              { return __hip_atomic_load(p, __ATOMIC_RELAXED, __HIP_MEMORY_SCOPE_AGENT); }
__device__ __forceinline__ unsigned xb_add(unsigned* p, unsigned v) { return __hip_atomic_fetch_add(p, v, __ATOMIC_RELAXED, __HIP_MEMORY_SCOPE_AGENT); }
__device__ __forceinline__ unsigned xb_xcc_id() { return (unsigned)__builtin_amdgcn_s_getreg((3 << 11) | 20) & 0xFu; }
#define XB_SPIN(cond, bar) do { unsigned _sp = 0; while (cond) { __builtin_amdgcn_s_sleep(1); \
    if ((++_sp & 255u) == 0u) { if (xb_ld(&(bar)[XB_TMO])) break; if (_sp > XB_SPIN_CAP) { atomicAdd(&(bar)[XB_TMO], 1u); break; } } } } while (0)
struct XcdBarrier { unsigned* bar; unsigned x; volatile LAS unsigned* st; };
__device__ __forceinline__ XcdBarrier xcd_barrier_post(unsigned* bar, volatile LAS unsigned* st) {
    XcdBarrier b; b.bar = bar; b.x = xb_xcc_id(); b.st = st;
    if (threadIdx.x == 0) (void)xb_add(&bar[XB_XCNT(b.x)], 1u);
    return b;
}
__device__ __forceinline__ void xcd_barrier_complete(unsigned* bar, unsigned x, unsigned& nloc, unsigned& nx) {
    const unsigned G = gridDim.x * gridDim.y * gridDim.z;
    unsigned sum, cnt, mine, sp = 0u;
    for (;;) {
        sum = 0u; cnt = 0u; mine = 0u;
#pragma unroll
        for (unsigned j = 0; j < 16; ++j) { const unsigned c = xb_ld(&bar[XB_XCNT(j)]); sum += c; cnt += (c > 0u) ? 1u : 0u; mine = (j == x) ? c : mine; }
        if (sum == G) break;
        __builtin_amdgcn_s_sleep(1);
        if ((++sp & 255u) == 0u) { if (xb_ld(&bar[XB_TMO])) break; if (sp > XB_SPIN_CAP) { atomicAdd(&bar[XB_TMO], 1u); break; } }
    }
    nloc = mine > 0u ? mine : 1u; nx = cnt > 0u ? cnt : 1u;
}
__device__ __forceinline__ void xcd_barrier(const XcdBarrier& b) {
    asm volatile("s_waitcnt vmcnt(0)" ::: "memory");
    __syncthreads();
    if (threadIdx.x == 0) {
        unsigned* bar = b.bar;
        __builtin_amdgcn_s_waitcnt(0);
        unsigned nloc = b.st[0], nx = b.st[1];
        if (nloc == 0u) { xcd_barrier_complete(bar, b.x, nloc, nx); b.st[0] = nloc; b.st[1] = nx; }
        const unsigned old = xb_add(&bar[XB_XSUB(b.x)], 1u);
        const unsigned gen = old / nloc;
        if (old + 1u == (gen + 1u) * nloc) {
            __builtin_amdgcn_fence(__ATOMIC_RELEASE, "agent");
            asm volatile("s_waitcnt vmcnt(0)" ::: "memory");
            const unsigned og = xb_add(&bar[XB_TOP], 1u);
            const unsigned tg = og / nx;
            if (og + 1u == (tg + 1u) * nx) xb_add(&bar[XB_TOPGEN], 1u);
            else XB_SPIN(xb_ld(&bar[XB_TOPGEN]) == tg, bar);
            __builtin_amdgcn_fence(__ATOMIC_ACQUIRE, "agent");
            xb_add(&bar[XB_XGEN(b.x)], 1u);
            asm volatile("s_waitcnt vmcnt(0)" ::: "memory");
        } else {
            XB_SPIN(xb_ld(&bar[XB_XGEN(b.x)]) == gen, bar);
            __builtin_amdgcn_fence(__ATOMIC_ACQUIRE, "agent");
            asm volatile("s_waitcnt vmcnt(0)" ::: "memory");
        }
    }
    __syncthreads();
}

template <int CTRL> __device__ __forceinline__ float dpp_f(float v) { return __builtin_bit_cast(float, __builtin_amdgcn_update_dpp(0, __builtin_bit_cast(int, v), CTRL, 0xf, 0xf, false)); }
__device__ __forceinline__ float wave_sum(float v) {
    v += dpp_f<0xB1>(v);
    v += dpp_f<0x4E>(v);
    v += dpp_f<0x141>(v);
    v += dpp_f<0x140>(v);
    v += __builtin_bit_cast(float, __builtin_amdgcn_ds_swizzle(__builtin_bit_cast(int, v), 0x401F));
    return __builtin_bit_cast(float, __builtin_amdgcn_readlane(__builtin_bit_cast(int, v), 0)) + __builtin_bit_cast(float, __builtin_amdgcn_readlane(__builtin_bit_cast(int, v), 32));
}
__device__ __forceinline__ void transpose_item(const float* W, int K, int N, bf16* WT, LAS float* scr, int item, int lane) {
    const int nblk = N / 32, kb = item / nblk, nb = item % nblk, k0 = 64 * kb, n0 = 32 * nb;
#pragma unroll 8
    for (int i = 0; i < 32; ++i) { const int kk = 2 * i + (lane >> 5); scr[kk * 33 + (lane & 31)] = W[(size_t)(k0 + kk) * N + n0 + (lane & 31)]; }
    LDS_WAIT(); asm volatile("" ::: "memory");
    const int c = lane & 7;
#pragma unroll
    for (int j = 0; j < 4; ++j) { const int n = (lane >> 3) + 8 * j; const LAS float* s = scr + (8 * c) * 33 + n;
        v4u o; o.x = pk2(s[0 * 33], s[1 * 33]); o.y = pk2(s[2 * 33], s[3 * 33]); o.z = pk2(s[4 * 33], s[5 * 33]); o.w = pk2(s[6 * 33], s[7 * 33]);
        *(GAS v4u*)(WT + (size_t)(n0 + n) * K + k0 + 8 * c) = o; }
    LDS_WAIT(); asm volatile("" ::: "memory");
}
__device__ __forceinline__ void norm_row(const float* xrow, const float* g, const float* sc, const float* sh, bf16* orow, int lane) {
    f32x4 v[8]; float ss = 0.f;
#pragma unroll
    for (int j = 0; j < 8; ++j) { v[j] = ((const f32x4*)xrow)[lane + 64 * j]; ss += (v[j].x * v[j].x + v[j].y * v[j].y) + (v[j].z * v[j].z + v[j].w * v[j].w); }
    const float rstd = 1.f / sqrtf(wave_sum(ss) * (1.f / DM) + EPS);
#pragma unroll
    for (int j = 0; j < 8; ++j) { const f32x4 gv = ((const f32x4*)g)[lane + 64 * j], sv = ((const f32x4*)sc)[lane + 64 * j], hv = ((const f32x4*)sh)[lane + 64 * j];
        const f32x4 y = v[j] * rstd * gv * (sv + 1.f) + hv;
        ((unsigned long long*)orow)[lane + 64 * j] = (unsigned long long)pk2(y.x, y.y) | ((unsigned long long)pk2(y.z, y.w) << 32); }
}
__device__ __forceinline__ void convln_row(const float* yrow, const float* g, const float* bb, bf16* orow, int lane) {
    f32x4 v[4]; float s = 0.f;
#pragma unroll
    for (int j = 0; j < 4; ++j) { v[j] = ((const f32x4*)yrow)[lane + 64 * j]; s += (v[j].x + v[j].y) + (v[j].z + v[j].w); }
    const float mean = wave_sum(s) * (1.f / BRW); float q = 0.f;
#pragma unroll
    for (int j = 0; j < 4; ++j) { v[j] = v[j] - mean; q += (v[j].x * v[j].x + v[j].y * v[j].y) + (v[j].z * v[j].z + v[j].w * v[j].w); }
    const float rstd = 1.f / sqrtf(wave_sum(q) * (1.f / BRW) + EPS);
#pragma unroll
    for (int j = 0; j < 4; ++j) { const f32x4 gv = ((const f32x4*)g)[lane + 64 * j], bv = ((const f32x4*)bb)[lane + 64 * j];
        f32x4 y = v[j] * rstd * gv + bv;
        y.x = y.x * sigmoidf_(y.x); y.y = y.y * sigmoidf_(y.y); y.z = y.z * sigmoidf_(y.z); y.w = y.w * sigmoidf_(y.w);
        ((unsigned long long*)orow)[lane + 64 * j] = (unsigned long long)pk2(y.x, y.y) | ((unsigned long long)pk2(y.z, y.w) << 32); }
}


namespace att {
typedef short bf16x8 __attribute__((ext_vector_type(8)));
typedef short s16x4 __attribute__((ext_vector_type(4)));
typedef float f32x4 __attribute__((ext_vector_type(4)));
typedef float f32x2_t __attribute__((ext_vector_type(2))); typedef __bf16 bf16x2_t __attribute__((ext_vector_type(2)));
constexpr int KP = 144, NROWS = 272, K_OFF = 0, V_OFF = NROWS * KP, LDS_NEED = 2 * NROWS * KP;
__device__ __forceinline__ unsigned cvtpk(float lo, float hi) { f32x2_t v = {lo, hi}; bf16x2_t b = __builtin_convertvector(v, bf16x2_t); return __builtin_bit_cast(unsigned, b); }
__device__ __forceinline__ float red4_max(float v) {
    v = fmaxf(v, __builtin_bit_cast(float, __builtin_amdgcn_ds_swizzle(__builtin_bit_cast(int, v), 0x401F)));
    unsigned x = __builtin_bit_cast(unsigned, v), y = x; asm volatile("" : "+v"(y));
    auto rr = __builtin_amdgcn_permlane32_swap(x, y, false, false); const unsigned r0 = rr[0], r1 = rr[1];
    return fmaxf(__builtin_bit_cast(float, r0), __builtin_bit_cast(float, r1)); }
__device__ __forceinline__ float red4_sum(float v) {
    v += __builtin_bit_cast(float, __builtin_amdgcn_ds_swizzle(__builtin_bit_cast(int, v), 0x401F));
    unsigned x = __builtin_bit_cast(unsigned, v), y = x; asm volatile("" : "+v"(y));
    auto rr = __builtin_amdgcn_permlane32_swap(x, y, false, false); const unsigned r0 = rr[0], r1 = rr[1];
    return __builtin_bit_cast(float, r0) + __builtin_bit_cast(float, r1); }
__device__ __forceinline__ s16x4 vtr(const LAS unsigned char* p) { typedef short v4i16_t __attribute__((ext_vector_type(4))); return __builtin_bit_cast(s16x4, __builtin_amdgcn_ds_read_tr16_b64_v4i16((LAS v4i16_t*)p)); }

__device__ __forceinline__ void tile16(const bf16* Zq, int qmask, int hq, const LAS unsigned char* Ks, const LAS unsigned char* Vs, int kbase, int wpos0, float slope2, float sink2, bf16* Yq, int nst, int lane) {
    const int c = lane & 15, g = lane >> 4;
    const bf16* qp = Zq + (size_t)(c & qmask) * ZW + ZQ + hq * 64 + 8 * g;
    const bf16x8 qf0 = *(const bf16x8*)qp, qf1 = *(const bf16x8*)(qp + 32);
    f32x4 st[9];
#pragma unroll
    for (int kt = 0; kt < 9; ++kt) { const LAS unsigned char* kp = Ks + (kbase + 16 * kt + c) * KP + 16 * g;
        const bf16x8 k0 = *(const LAS bf16x8*)kp, k1 = *(const LAS bf16x8*)(kp + 64);
        f32x4 a = {0.f, 0.f, 0.f, 0.f};
        a = __builtin_amdgcn_mfma_f32_16x16x32_bf16(k0, qf0, a, 0, 0, 0); a = __builtin_amdgcn_mfma_f32_16x16x32_bf16(k1, qf1, a, 0, 0, 0); st[kt] = a; }
    float SC2 = 0.125f * 1.4426950408889634f; asm volatile("" : "+v"(SC2));
    const int dbase = 128 + c - 4 * g;
    float m = sink2;
#pragma unroll
    for (int kt = 0; kt < 9; ++kt)
#pragma unroll
        for (int r = 0; r < 4; ++r) { const int dist = dbase - r - 16 * kt, kk = 16 * kt + 4 * g + r; const bool ok = (unsigned)dist <= 128u && (wpos0 + kk) >= 0;
            const float sv = ok ? st[kt][r] * SC2 - slope2 * (float)dist : -INFINITY; st[kt][r] = sv; m = fmaxf(m, sv); }
    m = red4_max(m);
    float sum = 0.f;
#pragma unroll
    for (int kt = 0; kt < 9; ++kt)
#pragma unroll
        for (int r = 0; r < 4; ++r) { const float p = __builtin_amdgcn_exp2f(st[kt][r] - m); st[kt][r] = p; sum += p; }
    sum = red4_sum(sum) + __builtin_amdgcn_exp2f(sink2 - m);
    const float inv = 1.f / sum;
    bf16x8 pf[5];
#pragma unroll
    for (int k = 0; k < 5; ++k) { unsigned w0 = cvtpk(st[2 * k][0] * inv, st[2 * k][1] * inv), w1 = cvtpk(st[2 * k][2] * inv, st[2 * k][3] * inv), w2 = 0u, w3 = 0u;
        if (k < 4) { w2 = cvtpk(st[2 * k + 1][0] * inv, st[2 * k + 1][1] * inv); w3 = cvtpk(st[2 * k + 1][2] * inv, st[2 * k + 1][3] * inv); }
        typedef unsigned u32x4_t __attribute__((ext_vector_type(4))); const u32x4_t w = {w0, w1, w2, w3}; pf[k] = __builtin_bit_cast(bf16x8, w); }
    f32x4 o[4];
#pragma unroll
    for (int dt = 0; dt < 4; ++dt) o[dt] = (f32x4){0.f, 0.f, 0.f, 0.f};
    const LAS unsigned char* vb = Vs + (kbase + 4 * g + (c >> 2)) * KP + 8 * (c & 3);
#pragma unroll
    for (int k = 0; k < 5; ++k)
#pragma unroll
        for (int dt = 0; dt < 4; ++dt) { const s16x4 lo = vtr(vb + (32 * k) * KP + 32 * dt), hi = vtr(vb + (32 * k + 16) * KP + 32 * dt);
            const bf16x8 b = {lo[0], lo[1], lo[2], lo[3], hi[0], hi[1], hi[2], hi[3]};
            o[dt] = __builtin_amdgcn_mfma_f32_16x16x32_bf16(pf[k], b, o[dt], 0, 0, 0); }
#pragma unroll
    for (int r = 0; r < 4; ++r) if (4 * g + r < nst) {
#pragma unroll
        for (int dt = 0; dt < 4; ++dt) Yq[(size_t)(4 * g + r) * BRW + 16 * dt + c] = f2bf(o[dt][r]); }
}
typedef unsigned u32x4_t __attribute__((ext_vector_type(4)));
__device__ __forceinline__ u32x4_t pack8(const float* f) { u32x4_t w; w.x = cvtpk(f[0], f[1]); w.y = cvtpk(f[2], f[3]); w.z = cvtpk(f[4], f[5]); w.w = cvtpk(f[6], f[7]); return w; }
__device__ __forceinline__ void phase(LAS unsigned char* lds, const bf16* Z, int l, const float* sinks, const float* ck, const float* cv, bf16* Y0, int bx, int G, int tid, int lane, int wave) {
    LAS unsigned char* Ks = lds + K_OFF; LAS unsigned char* Vs = lds + V_OFF;
    const u32x4_t zero4 = {0u, 0u, 0u, 0u};
    for (int it = bx; it < NBP * 32 * NKV + SB * NKV; it += G) {
        const int kvh = it & 3;
        if (it < NBP * 32 * NKV) {
            const int b = it >> 7, qb = (it >> 2) & 31;
#pragma unroll
            for (int i = 0; i < 4; ++i) { const int p = tid + NTHR * i, sr = p >> 3, cc = p & 7; const int pos = 128 * (qb - 1) + sr;
                u32x4_t kq = zero4, vq = zero4;
                if (pos >= 0) { const bf16* zr = Z + (size_t)(b * SEQ + pos) * ZW + kvh * 64 + cc * 8; kq = *(const u32x4_t*)(zr + ZK); vq = *(const u32x4_t*)(zr + ZV); }
                *(LAS u32x4_t*)(Ks + sr * KP + cc * 16) = kq; *(LAS u32x4_t*)(Vs + sr * KP + cc * 16) = vq; }
            if (tid < 128) { const int sr = 256 + (tid >> 3), cc = tid & 7; *(LAS u32x4_t*)(Ks + sr * KP + cc * 16) = zero4; *(LAS u32x4_t*)(Vs + sr * KP + cc * 16) = zero4; }
            __syncthreads();
            const int hq = kvh * 4 + (wave >> 1), qh = wave & 1;
            const float slope2 = exp2f(-0.5f * (float)(hq + 1)) * 1.4426950408889634f, sink2 = sinks[l * NH + hq] * 1.4426950408889634f;
#pragma unroll 1
            for (int qt = 0; qt < 4; ++qt) { const int t1 = 64 * qh + 16 * qt; const size_t qrow0 = (size_t)b * SEQ + 128 * qb + t1;
                tile16(Z + qrow0 * ZW, 15, hq, Ks, Vs, t1, 128 * qb + t1 - 128, slope2, sink2, Y0 + qrow0 * BRW + hq * 64, 16, lane); }
        } else {
            const int sb = (it - NBP * 32 * NKV) >> 2;
#pragma unroll
            for (int i = 0; i < 3; ++i) { const int p = tid + NTHR * i, sr = p >> 3, cc = p & 7;
                if (sr < 160) { u32x4_t kq = zero4, vq = zero4;
                    if (sr < WIN) { const size_t o = ((((size_t)l * SB + sb) * WIN + sr) * NKV + kvh) * 64 + cc * 8; float f[8];
#pragma unroll
                        for (int e = 0; e < 8; ++e) f[e] = ck[o + e];
                        kq = pack8(f);
#pragma unroll
                        for (int e = 0; e < 8; ++e) f[e] = cv[o + e];
                        vq = pack8(f);
                    } else if (sr < WIN + ST) { const bf16* zr = Z + (size_t)(MP + sb * ST + (sr - WIN)) * ZW + kvh * 64 + cc * 8; kq = *(const u32x4_t*)(zr + ZK); vq = *(const u32x4_t*)(zr + ZV); }
                    *(LAS u32x4_t*)(Ks + sr * KP + cc * 16) = kq; *(LAS u32x4_t*)(Vs + sr * KP + cc * 16) = vq; } }
            __syncthreads();
            if (wave < 4) { const int hq = kvh * 4 + wave;
                const float slope2 = exp2f(-0.5f * (float)(hq + 1)) * 1.4426950408889634f, sink2 = sinks[l * NH + hq] * 1.4426950408889634f;
                const size_t qrow0 = (size_t)MP + sb * ST;
                tile16(Z + qrow0 * ZW, 7, hq, Ks, Vs, 0, 0, slope2, sink2, Y0 + qrow0 * BRW + hq * 64, ST, lane); }
        }
        __syncthreads();
    }
}
}

namespace ret {
using att::bf16x8; using att::s16x4; using att::f32x4; using att::u32x4_t; using att::vtr; using att::cvtpk; using att::pack8;
constexpr int KP = 144, VP = 288, K_OFF = 0, V_OFF = 128 * KP, S_OFF = V_OFF + 128 * VP, LDS_NEED = S_OFF + 64 * VP;
template <int CTRL> __device__ __forceinline__ float dppf(float v) { return __builtin_bit_cast(float, __builtin_amdgcn_update_dpp(0, __builtin_bit_cast(int, v), CTRL, 0xf, 0xf, false)); }
__device__ __forceinline__ float sum16(float v) { v += dppf<0xB1>(v); v += dppf<0x4E>(v); v += dppf<0x141>(v); v += dppf<0x140>(v); return v; }
__device__ __forceinline__ void out_phase(LAS unsigned char* lds, const bf16* Z, int l, const float* SPREV, const float* gret, bf16* Y3, int bx, int G, int tid, int lane, int wave) {
    LAS unsigned char* Ks = lds + K_OFF; LAS unsigned char* Vs = lds + V_OFF; LAS unsigned char* Ss = lds + S_OFF;
    const int c = lane & 15, g = lane >> 4;
    for (int it = bx; it < NBP * 32 * RH; it += G) {
        const int b = it >> 8, n = (it >> 3) & 31, h = it & 7; const size_t row0 = (size_t)b * SEQ + n * 128;
#pragma unroll
        for (int i = 0; i < 2; ++i) { const int p = tid + NTHR * i, j = p >> 3, cc = p & 7; *(LAS u32x4_t*)(Ks + j * KP + cc * 16) = *(const u32x4_t*)(Z + (row0 + j) * ZW + ZRK + h * 64 + cc * 8); }
#pragma unroll
        for (int i = 0; i < 4; ++i) { const int p = tid + NTHR * i, j = p >> 4, cc = p & 15; *(LAS u32x4_t*)(Vs + j * VP + cc * 16) = *(const u32x4_t*)(Z + (row0 + j) * ZW + ZRV + h * 128 + cc * 8); }
#pragma unroll
        for (int i = 0; i < 2; ++i) { const int p = tid + NTHR * i, d = p >> 4, cc = p & 15; const float* sp = SPREV + ((((size_t)b * 32 + n) * RH + h) * RDK + d) * RDV + cc * 8; float f[8];
#pragma unroll
            for (int e = 0; e < 8; ++e) f[e] = sp[e];
            *(LAS u32x4_t*)(Ss + d * VP + cc * 16) = pack8(f); }
        __syncthreads();
        const int w = wave; const float lg2 = ret_logg(h) * 1.4426950408889634f;
        const bf16* qp = Z + (row0 + 16 * w + c) * ZW + ZRQ + h * 64 + 8 * g;
        const bf16x8 qf0 = *(const bf16x8*)qp, qf1 = *(const bf16x8*)(qp + 32);
        f32x4 o[8];
#pragma unroll
        for (int vt = 0; vt < 8; ++vt) o[vt] = (f32x4){0.f, 0.f, 0.f, 0.f};
#pragma unroll
        for (int ks = 0; ks < 2; ++ks) { const LAS unsigned char* sb = Ss + (32 * ks + 8 * g + (c >> 2)) * VP + 8 * (c & 3);
#pragma unroll
            for (int vt = 0; vt < 8; ++vt) { const s16x4 lo = vtr(sb + 32 * vt), hi = vtr(sb + 4 * VP + 32 * vt); const bf16x8 bb = {lo[0], lo[1], lo[2], lo[3], hi[0], hi[1], hi[2], hi[3]};
                o[vt] = __builtin_amdgcn_mfma_f32_16x16x32_bf16(ks ? qf1 : qf0, bb, o[vt], 0, 0, 0); } }
#pragma unroll
        for (int r = 0; r < 4; ++r) { const float cf = __builtin_amdgcn_exp2f(lg2 * (float)(16 * w + 4 * g + r + 1));
#pragma unroll
            for (int vt = 0; vt < 8; ++vt) o[vt][r] *= cf; }
        for (int ks = 0; ks <= (w >> 1); ++ks) {
            f32x4 st[2];
#pragma unroll
            for (int t = 0; t < 2; ++t) { const int jt = 2 * ks + t; f32x4 a = {0.f, 0.f, 0.f, 0.f};
                if (jt <= w) { const LAS unsigned char* kp = Ks + (16 * jt + c) * KP + 16 * g; const bf16x8 k0 = *(const LAS bf16x8*)kp, k1 = *(const LAS bf16x8*)(kp + 64);
                    a = __builtin_amdgcn_mfma_f32_16x16x32_bf16(k0, qf0, a, 0, 0, 0); a = __builtin_amdgcn_mfma_f32_16x16x32_bf16(k1, qf1, a, 0, 0, 0);
#pragma unroll
                    for (int r = 0; r < 4; ++r) { const int dij = (16 * w + c) - (16 * jt + 4 * g + r); a[r] = dij >= 0 ? a[r] * 0.125f * __builtin_amdgcn_exp2f(lg2 * (float)dij) : 0.f; } }
                st[t] = a; }
            const u32x4_t pw = {cvtpk(st[0][0], st[0][1]), cvtpk(st[0][2], st[0][3]), cvtpk(st[1][0], st[1][1]), cvtpk(st[1][2], st[1][3])}; const bf16x8 pf = __builtin_bit_cast(bf16x8, pw);
            const LAS unsigned char* vb = Vs + (32 * ks + 4 * g + (c >> 2)) * VP + 8 * (c & 3);
#pragma unroll
            for (int vt = 0; vt < 8; ++vt) { const s16x4 lo = vtr(vb + 32 * vt), hi = vtr(vb + 16 * VP + 32 * vt); const bf16x8 bb = {lo[0], lo[1], lo[2], lo[3], hi[0], hi[1], hi[2], hi[3]};
                o[vt] = __builtin_amdgcn_mfma_f32_16x16x32_bf16(pf, bb, o[vt], 0, 0, 0); }
        }
        float mean[4], rstd[4];
#pragma unroll
        for (int r = 0; r < 4; ++r) { float sm = 0.f;
#pragma unroll
            for (int vt = 0; vt < 8; ++vt) sm += o[vt][r];
            mean[r] = sum16(sm) * (1.f / 128.f); float q = 0.f;
#pragma unroll
            for (int vt = 0; vt < 8; ++vt) { const float dd = o[vt][r] - mean[r]; q += dd * dd; }
            rstd[r] = 1.f / sqrtf(sum16(q) * (1.f / 128.f) + EPS); }
        const float* gp = gret + l * BRW + h * 128 + c;
#pragma unroll
        for (int r = 0; r < 4; ++r) { const size_t row = row0 + 16 * w + 4 * g + r; const bf16* rg = Z + row * ZW + ZRG + h * 128 + c; bf16* y = Y3 + row * BRW + h * 128 + c;
#pragma unroll
            for (int vt = 0; vt < 8; ++vt) y[16 * vt] = f2bf((o[vt][r] - mean[r]) * rstd[r] * gp[16 * vt] * bf2f(rg[16 * vt])); }
        __syncthreads();
    }
}

__device__ __forceinline__ void kv_phase(LAS unsigned char* lds, const bf16* Z, float* KV, int bx, int G, int tid, int lane, int wave) {
    LAS unsigned char* Ks = lds + K_OFF; LAS unsigned char* Vs = lds + V_OFF;
    const int c = lane & 15, g = lane >> 4;
    for (int it = bx; it < NBP * 32 * RH; it += G) {
        const int b = it >> 8, n = (it >> 3) & 31, h = it & 7; const size_t row0 = (size_t)b * SEQ + n * 128;
        const float lg2 = ret_logg(h) * 1.4426950408889634f;
#pragma unroll
        for (int i = 0; i < 2; ++i) { const int p = tid + NTHR * i, j = p >> 3, cc = p & 7; float f[8]; ld8(Z + (row0 + j) * ZW + ZRK + h * 64 + cc * 8, f);
            const float sc = 0.125f * __builtin_amdgcn_exp2f(lg2 * (float)(127 - j));
#pragma unroll
            for (int e = 0; e < 8; ++e) f[e] *= sc;
            *(LAS u32x4_t*)(Ks + j * KP + cc * 16) = pack8(f); }
#pragma unroll
        for (int i = 0; i < 4; ++i) { const int p = tid + NTHR * i, j = p >> 4, cc = p & 15; *(LAS u32x4_t*)(Vs + j * VP + cc * 16) = *(const u32x4_t*)(Z + (row0 + j) * ZW + ZRV + h * 128 + cc * 8); }
        __syncthreads();
        const int dt = wave & 3, vt0 = (wave >> 2) * 4;
        f32x4 acc[4];
#pragma unroll
        for (int t = 0; t < 4; ++t) acc[t] = (f32x4){0.f, 0.f, 0.f, 0.f};
#pragma unroll
        for (int ks = 0; ks < 4; ++ks) { const LAS unsigned char* ka = Ks + (32 * ks + 8 * g + (c >> 2)) * KP + 32 * dt + 8 * (c & 3);
            const s16x4 alo = vtr(ka), ahi = vtr(ka + 4 * KP); const bf16x8 af = {alo[0], alo[1], alo[2], alo[3], ahi[0], ahi[1], ahi[2], ahi[3]};
            const LAS unsigned char* vb = Vs + (32 * ks + 8 * g + (c >> 2)) * VP + 8 * (c & 3);
#pragma unroll
            for (int t = 0; t < 4; ++t) { const s16x4 lo = vtr(vb + 32 * (vt0 + t)), hi = vtr(vb + 4 * VP + 32 * (vt0 + t)); const bf16x8 bb = {lo[0], lo[1], lo[2], lo[3], hi[0], hi[1], hi[2], hi[3]};
                acc[t] = __builtin_amdgcn_mfma_f32_16x16x32_bf16(af, bb, acc[t], 0, 0, 0); } }
        float* kvp = KV + ((((size_t)b * 32 + n) * RH + h) * RDK + 16 * dt + 4 * g) * RDV + c;
#pragma unroll
        for (int r = 0; r < 4; ++r)
#pragma unroll
            for (int t = 0; t < 4; ++t) kvp[(size_t)r * RDV + 16 * (vt0 + t)] = acc[t][r];
        __syncthreads();
    }
}
}

namespace mixl {
using att::u32x4_t; using att::f32x4;
template <int CTRL> __device__ __forceinline__ float dppf(float v) { return __builtin_bit_cast(float, __builtin_amdgcn_update_dpp(0, __builtin_bit_cast(int, v), CTRL, 0xf, 0xf, false)); }
__device__ __forceinline__ float sum8(float v) { v += dppf<0xB1>(v); v += dppf<0x4E>(v); v += dppf<0x141>(v); return v; }
__device__ __forceinline__ void qknorm_phase(bf16* Z, int l, const float* gq, const float* gk, float* out, int gw, int NGW, int lane) {
    float g8q[8], g8k[8];
#pragma unroll
    for (int e = 0; e < 8; ++e) { g8q[e] = gq[l * 64 + (lane & 7) * 8 + e]; g8k[e] = gk[l * 64 + (lane & 7) * 8 + e]; }
    for (int row = gw; row < M; row += NGW) {
        bf16* zr = Z + (size_t)row * ZW;
#pragma unroll
        for (int p = 0; p < 2; ++p) { bf16* qp = zr + ZQ + p * 512 + lane * 8; float f[8]; ld8(qp, f); float ss = 0.f;
#pragma unroll
            for (int e = 0; e < 8; ++e) ss += f[e] * f[e];
            const float r = 1.f / sqrtf(sum8(ss) * (1.f / 64.f) + EPS);
#pragma unroll
            for (int e = 0; e < 8; ++e) f[e] = f[e] * r * g8q[e];
            st8(qp, f); }
        bf16* kvp = zr + ZK + lane * 8; float f[8]; ld8(kvp, f); float ss = 0.f;
#pragma unroll
        for (int e = 0; e < 8; ++e) ss += f[e] * f[e];
        const float r = 1.f / sqrtf(sum8(ss) * (1.f / 64.f) + EPS);
        if (lane < 32) {
#pragma unroll
            for (int e = 0; e < 8; ++e) f[e] = f[e] * r * g8k[e];
            st8(kvp, f); }
        float* o = nullptr;
        if (row < MP) { const int b = row >> 12, t = row & (SEQ - 1); if (t >= SEQ - WIN) o = out + (lane < 32 ? O_KP : O_VP) + (((size_t)l * NBP + b) * WIN + (t - (SEQ - WIN))) * 256 + (lane & 31) * 8; }
        else { const int sb = (row - MP) >> 3, t = (row - MP) & 7; o = out + (lane < 32 ? O_KS : O_VS) + (((size_t)l * SB + sb) * WIN + (WIN - ST + t)) * 256 + (lane & 31) * 8; }
        if (o) { *(f32x4*)o = (f32x4){f[0], f[1], f[2], f[3]}; *(f32x4*)(o + 4) = (f32x4){f[4], f[5], f[6], f[7]}; }
    }
}
constexpr int CV_RB = 64, CV_CB = 128, CV_UR = CV_RB + CPRE;
__device__ __forceinline__ void conv_phase(LAS unsigned char* lds, const bf16* Z, int l, const float* wdw, const float* bdw, const float* sconv, float* CONVY, float* out, int bx, int G, int tid) {
    LAS float* U = (LAS float*)lds;
    constexpr int NPI = (MP / CV_RB) * 8, NSI = SB * 8;
    for (int it = bx; it < NPI + NSI; it += G) {
        const bool smp = it >= NPI; const int cb = it & 7;
        const int b = smp ? (it - NPI) >> 3 : (it >> 3) >> 6, t0 = smp ? 0 : ((it >> 3) & 63) * CV_RB, nrows = smp ? ST : CV_RB;
        const size_t rowb = smp ? (size_t)MP + b * ST : (size_t)b * SEQ;
#pragma unroll 1
        for (int p = tid; p < (nrows + CPRE) * 16; p += NTHR) { const int ur = p >> 4, c8 = p & 15, tt = t0 - CPRE + ur; float u[8];
            if (tt >= 0) { float a[8], gg[8]; const bf16* zp = Z + (rowb + tt) * ZW + cb * CV_CB + c8 * 8; ld8(zp + ZCA, a); ld8(zp + ZCG, gg);
#pragma unroll
                for (int e = 0; e < 8; ++e) u[e] = a[e] * sigmoidf_(gg[e]);
                if (ur >= CPRE) { float* o = nullptr;
                    if (!smp) { if (tt >= SEQ - CPRE) o = out + O_CP + (((size_t)l * NBP + b) * CPRE + (tt - (SEQ - CPRE))) * BRW + cb * CV_CB + c8 * 8; }
                    else o = out + O_CS + (((size_t)l * SB + b) * CPRE + (CPRE - ST + tt)) * BRW + cb * CV_CB + c8 * 8;
                    if (o) { *(f32x4*)o = (f32x4){u[0], u[1], u[2], u[3]}; *(f32x4*)(o + 4) = (f32x4){u[4], u[5], u[6], u[7]}; } }
            } else if (smp) { const float* sp = sconv + (((size_t)l * SB + b) * CPRE + (CPRE + tt)) * BRW + cb * CV_CB + c8 * 8;
#pragma unroll
                for (int e = 0; e < 8; ++e) u[e] = sp[e];
            } else {
#pragma unroll
                for (int e = 0; e < 8; ++e) u[e] = 0.f; }
            *(LAS f32x4*)(U + ur * CV_CB + c8 * 8) = (f32x4){u[0], u[1], u[2], u[3]}; *(LAS f32x4*)(U + ur * CV_CB + c8 * 8 + 4) = (f32x4){u[4], u[5], u[6], u[7]}; }
        __syncthreads();
        const int c = tid & 127, r0 = (tid >> 7) * 16;
        if (r0 < nrows) {
            const int ch = cb * CV_CB + c; float w[CONVK];
#pragma unroll
            for (int j = 0; j < CONVK; ++j) w[j] = wdw[((size_t)l * CONVK + j) * BRW + ch];
            const float bias = bdw[l * BRW + ch];
            float u[16 + CPRE];
#pragma unroll
            for (int k = 0; k < 16 + CPRE; ++k) u[k] = U[(r0 + k) * CV_CB + c];
#pragma unroll
            for (int r = 0; r < 16; ++r) { float acc = bias;
#pragma unroll
                for (int j = 0; j < CONVK; ++j) acc += w[j] * u[r + j];
                if (r0 + r < nrows) CONVY[(rowb + t0 + r0 + r) * BRW + ch] = acc; }
        }
        __syncthreads();
    }
}
__device__ __forceinline__ void pool_phase(const bf16* Z, int l, const float* spool, bf16* ZP, float* out, int gt, int NGT) {
    constexpr int NPG = MP / 16, NG = NPG + SB;
    for (int i = gt; i < NG * 128; i += NGT) { const int grp = i >> 7, c8 = i & 127, cch = c8 * 8, w = 2 << (cch >> 8);
        const bool smp = grp >= NPG; const int b = smp ? grp - NPG : grp >> 8, t0 = smp ? 0 : (grp & 255) * 16, nrows = smp ? ST : 16;
        const size_t rowb = smp ? (size_t)MP + b * ST : (size_t)b * SEQ;
        float S[8];
#pragma unroll
        for (int e = 0; e < 8; ++e) S[e] = 0.f;
        for (int k = 1; k < w; ++k) { const int tt = t0 - k; float f[8];
            if (tt >= 0) ld8(Z + (rowb + tt) * ZW + ZPL + cch, f);
            else if (smp) { const float* sp = spool + (((size_t)l * SB + b) * PPAD + (PPAD + tt)) * BRW + cch;
#pragma unroll
                for (int e = 0; e < 8; ++e) f[e] = sp[e]; }
            else {
#pragma unroll
                for (int e = 0; e < 8; ++e) f[e] = 0.f; }
#pragma unroll
            for (int e = 0; e < 8; ++e) S[e] += f[e]; }
        for (int r = 0; r < nrows; ++r) { const int t = t0 + r; float u[8], o[8]; ld8(Z + (rowb + t) * ZW + ZPL + cch, u);
            const float inv = 1.f / (smp ? (float)w : (float)((t + 1) < w ? (t + 1) : w));
#pragma unroll
            for (int e = 0; e < 8; ++e) { S[e] += u[e]; o[e] = S[e] * inv - u[e]; }
            st8(ZP + (rowb + t) * BRW + cch, o);
            float* so = nullptr;
            if (!smp) { if (t >= SEQ - PPAD) so = out + O_PP + (((size_t)l * NBP + b) * PPAD + (t - (SEQ - PPAD))) * BRW + cch; }
            else so = out + O_PS + (((size_t)l * SB + b) * PPAD + (PPAD - ST + t)) * BRW + cch;
            if (so) { *(f32x4*)so = (f32x4){u[0], u[1], u[2], u[3]}; *(f32x4*)(so + 4) = (f32x4){u[4], u[5], u[6], u[7]}; }
            const int tt = t - w + 1; float f[8];
            if (tt >= 0) ld8(Z + (rowb + tt) * ZW + ZPL + cch, f);
            else if (smp) { const float* sp = spool + (((size_t)l * SB + b) * PPAD + (PPAD + tt)) * BRW + cch;
#pragma unroll
                for (int e = 0; e < 8; ++e) f[e] = sp[e]; }
            else {
#pragma unroll
                for (int e = 0; e < 8; ++e) f[e] = 0.f; }
#pragma unroll
            for (int e = 0; e < 8; ++e) S[e] -= f[e]; }
    }
}
__device__ __forceinline__ void retout_s_phase(const bf16* Z, int l, const float* sret, const float* gret, bf16* Y3, int gw, int NGW, int lane) {
    for (int it = gw; it < MS * RH; it += NGW) { int h = __builtin_amdgcn_readfirstlane(it & 7); asm volatile("" : "+s"(h));
        const int rs = it >> 3, sb = rs >> 3, i = rs & 7; const size_t row = (size_t)MP + rs, row0 = (size_t)MP + sb * ST;
        const float lg = ret_logg(h);
        const bf16* qp = Z + row * ZW + ZRQ + h * 64;
        const float* S = sret + (((size_t)l * SB + sb) * RH + h) * RDK * RDV;
        float o0 = 0.f, o1 = 0.f;
        for (int d = 0; d < 64; ++d) { const float qd = bf2f(qp[d]); o0 += qd * S[(size_t)d * RDV + lane]; o1 += qd * S[(size_t)d * RDV + lane + 64]; }
        const float cf = FEXP(lg * (float)(i + 1)); o0 *= cf; o1 *= cf;
        const float ql = bf2f(qp[lane]);
        for (int j = 0; j <= i; ++j) { const bf16* zj = Z + (row0 + j) * ZW; const float sc = wave_sum(ql * bf2f(zj[ZRK + h * 64 + lane])) * 0.125f * FEXP(lg * (float)(i - j));
            o0 += sc * bf2f(zj[ZRV + h * 128 + lane]); o1 += sc * bf2f(zj[ZRV + h * 128 + lane + 64]); }
        const float mean = wave_sum(o0 + o1) * (1.f / 128.f); const float d0 = o0 - mean, d1 = o1 - mean;
        const float rstd = 1.f / sqrtf(wave_sum(d0 * d0 + d1 * d1) * (1.f / 128.f) + EPS);
        const float* g = gret + l * BRW + h * 128; const bf16* rg = Z + row * ZW + ZRG + h * 128; bf16* y = Y3 + row * BRW + h * 128;
        y[lane] = f2bf(d0 * rstd * g[lane] * bf2f(rg[lane])); y[lane + 64] = f2bf(d1 * rstd * g[lane + 64] * bf2f(rg[lane + 64]));
    }
}
}
struct AdaOrder { int G, c; const char* A; const char* B;
    __device__ __forceinline__ bool next(int i, pg8::Unit& u) const { const int Lx = i * G + c; if (Lx >= DEPTH * (ADAW / 256)) return false;
        u.r = Lx / (ADAW / 256); u.pn = Lx % (ADAW / 256); u.pm = 0; u.a = A; u.b = B + ((size_t)u.r * ADAW + (size_t)u.pn * 256) * DM * 2; return true; } };
struct PoolOrder { int G, c; const char* A; const char* B;
                __device__ __forceinline__ bool next(int i, pg8::Unit& u) const { const int Lx = i * G + c; if (Lx >= (M / 256) * 4) return false;
                    u.pm = Lx >> 2; u.pn = Lx & 3; u.r = 0; u.a = A + ((size_t)u.pm * 256 * BRW + (size_t)u.pn * 256) * 2; u.b = B + (size_t)u.pn * 256 * 256 * 2; return true; } };
struct BrOrder { int G, c; const char* A; const char* B;
                __device__ __forceinline__ bool next(int i, pg8::Unit& u) const { const int tl = (i >> 2) * G + c; if (tl >= (M / 256) * (DM / 256)) return false;
                    pg8::tile_of(tl, M / 256, DM / 256, u.pm, u.pn); u.r = i & 3;
                    u.a = A + ((size_t)u.r * M + (size_t)u.pm * 256) * BRW * 2; u.b = B + ((size_t)u.r * DM + (size_t)u.pn * 256) * BRW * 2; return true; } };

__device__ __forceinline__ unsigned long long ld_ptr(volatile LAS unsigned* p) { const unsigned lo = __builtin_amdgcn_readfirstlane(p[0]), hi = __builtin_amdgcn_readfirstlane(p[1]); return ((unsigned long long)hi << 32) | lo; }
constexpr int NPL = 10;
constexpr int PH_TOTAL = 2 + DEPTH * NPL;
struct Args { const float* in[N_IN]; float* out; unsigned char* ws; int ph_lo, ph_hi; };
static_assert(sizeof(Args) == N_IN * 8 + 8 + 8 + 8, "Args has no padding");

__global__ void __launch_bounds__(NTHR, 2) fwd(Args args) {
    extern __shared__ __attribute__((aligned(16))) unsigned char lds[];
    LAS unsigned char* L0 = (LAS unsigned char*)lds;
    volatile LAS unsigned* MISC = (volatile LAS unsigned*)(L0 + MISC_OFF);
    const int G = gridDim.x, bx = blockIdx.x, wave0 = __builtin_amdgcn_readfirstlane(threadIdx.x >> 6);
    unsigned char* ws0 = args.ws;
    for (int u = threadIdx.x; u < (LDS_BYTES - LDSCTL_OFF) / 4; u += NTHR) ((LAS unsigned*)(L0 + LDSCTL_OFF))[u] = 0u;
    __syncthreads();
    if (threadIdx.x <= N_IN) ((LAS unsigned long long*)(L0 + INTAB_OFF))[threadIdx.x] = threadIdx.x < N_IN ? (unsigned long long)args.in[threadIdx.x < N_IN ? threadIdx.x : 0] : (unsigned long long)args.out;
    __syncthreads();
#if MK_ONE_LAUNCH
    XcdBarrier bar = xcd_barrier_post((unsigned*)(ws0 + WS_CTL) + CW_BAR, MISC + 8);
#define GRID_BAR() xcd_barrier(bar)
#else
#define GRID_BAR() do {} while (0)
#endif
    const int lo = args.ph_lo, hi = args.ph_hi;
#ifndef PH_MASK
#define PH_MASK 0xFFF
#endif
#define IN(k) (lo <= (k) && (k) < hi)
#define SEAM(k) do { if (IN((k) + 1)) GRID_BAR(); } while (0)
#define INP(i)  ((const float*)(GAS const float*)ld_ptr((volatile LAS unsigned*)(L + INTAB_OFF) + 2 * (i)))
#define P_OUT   ((float*)(GAS float*)ld_ptr((volatile LAS unsigned*)(L + INTAB_OFF) + 2 * N_IN))
#define WIN_T   ((bf16*)(ws + WS_WIN))
#define WBR_T   ((bf16*)(ws + WS_WBR))
#define WOUT_T  ((bf16*)(ws + WS_WOUT))
#define WM1_T   ((bf16*)(ws + WS_WM1))
#define WM2_T   ((bf16*)(ws + WS_WM2))
#define WPOOL_T ((bf16*)(ws + WS_WPOOL))
#define WADA_T  ((bf16*)(ws + WS_WADA))
#define SC      ((bf16*)(ws + WS_SC))
#define ADA     ((float*)(ws + WS_ADA))
#define H       ((bf16*)(ws + WS_H))
#define Z       ((bf16*)(ws + WS_Z))
#define Y       ((bf16*)(ws + WS_Y))
#define ZP      ((bf16*)(ws + WS_ZP))
#define CONVY   ((float*)(ws + WS_CONVY))
#define ORAW    ((float*)(ws + WS_ORAW))
#define KV      ((float*)(ws + WS_KV))
#define SPREV   ((float*)(ws + WS_SPREV))
#define MACC    ((float*)(ws + WS_MACC))
#define MERGED  ((bf16*)(ws + WS_MERGED))
#define X1      ((float*)(ws + WS_X1))
#define X       ((float*)(ws + WS_X))
#define HID     ((bf16*)(ws + WS_HID))
#define TIDS() int lane; asm volatile("v_mbcnt_lo_u32_b32 %0, -1, 0\n\tv_mbcnt_hi_u32_b32 %0, -1, %0" : "=v"(lane)); GAS unsigned char* wsg = (GAS unsigned char*)ws0; asm volatile("" : "+s"(wsg)); unsigned char* ws = (unsigned char*)wsg; LAS unsigned char* L = L0; asm volatile("" : "+s"(L)); const int wave = wave0, tid = wave0 * 64 + lane; const int gw = bx * NWAVES + wave, NGW = G * NWAVES; const int gt = bx * NTHR + tid, NGT = G * NTHR; (void)lane; (void)gw; (void)NGW; (void)gt; (void)NGT
#define LAYER_PTRS() const float* ada = ADA + (size_t)l * NROWB * ADAW; const float* xinP = l == 0 ? INP(I_XP) : X; const float* xinS = l == 0 ? INP(I_XS) : X + (size_t)MP * DM; float* xout = l == DEPTH - 1 ? P_OUT : X; (void)ada; (void)xinP; (void)xinS; (void)xout
    if ((PH_MASK >> 10 & 1) && IN(0)) { TIDS();
        LAS float* scr = (LAS float*)(L + RING_OFF + wave * 16384);
        constexpr int I_IN = (DM / 64) * (ZW / 32), I_BR = (BRW / 64) * (DM / 32), I_OUT = (DM / 64) * (DM / 32), I_M1 = (DM / 64) * (DFF / 32), I_M2 = (DFF / 64) * (DM / 32),
                      I_PL = (256 / 64) * (256 / 32), I_AD = (DM / 64) * (ADAW / 32);
        constexpr int T_IN = DEPTH * I_IN, T_BR = T_IN + DEPTH * 4 * I_BR, T_OUT = T_BR + DEPTH * I_OUT, T_M1 = T_OUT + DEPTH * I_M1, T_M2 = T_M1 + DEPTH * I_M2,
                      T_PL = T_M2 + DEPTH * 4 * I_PL, T_AD = T_PL + DEPTH * I_AD;
        for (int it = gw; it < T_AD; it += NGW) {
            if (it < T_IN) { const int mi = it / I_IN, r = it % I_IN; transpose_item(INP(I_WIN) + (size_t)mi * DM * ZW, DM, ZW, WIN_T + (size_t)mi * ZW * DM, scr, r, lane); }
            else if (it < T_BR) { const int q = it - T_IN, mi = q / I_BR, r = q % I_BR; transpose_item(INP(I_WBR) + (size_t)mi * BRW * DM, BRW, DM, WBR_T + (size_t)mi * DM * BRW, scr, r, lane); }
            else if (it < T_OUT) { const int q = it - T_BR, mi = q / I_OUT, r = q % I_OUT; transpose_item(INP(I_WOUT) + (size_t)mi * DM * DM, DM, DM, WOUT_T + (size_t)mi * DM * DM, scr, r, lane); }
            else if (it < T_M1) { const int q = it - T_OUT, mi = q / I_M1, r = q % I_M1; transpose_item(INP(I_WM1) + (size_t)mi * DM * DFF, DM, DFF, WM1_T + (size_t)mi * DFF * DM, scr, r, lane); }
            else if (it < T_M2) { const int q = it - T_M1, mi = q / I_M2, r = q % I_M2; transpose_item(INP(I_WM2) + (size_t)mi * DFF * DM, DFF, DM, WM2_T + (size_t)mi * DM * DFF, scr, r, lane); }
            else if (it < T_PL) { const int q = it - T_M2, mi = q / I_PL, r = q % I_PL; transpose_item(INP(I_WPOOL) + (size_t)mi * 256 * 256, 256, 256, WPOOL_T + (size_t)mi * 256 * 256, scr, r, lane); }
            else { const int q = it - T_PL, mi = q / I_AD, r = q % I_AD; transpose_item(INP(I_WADA) + (size_t)mi * DM * ADAW, DM, ADAW, WADA_T + (size_t)mi * ADAW * DM, scr, r, lane); }
        }
        for (int i = gt; i < 256 * DM; i += NGT) { const int r = i / DM, k = i % DM; float v = 0.f;
            if (r < NBP) v = INP(I_CP)[r * DM + k]; else if (r < NROWB) v = INP(I_CS)[(r - NBP) * DM + k];
            SC[i] = r < NROWB ? f2bf(v * sigmoidf_(v)) : (bf16)0; }
        SEAM(0);
    }
    if ((PH_MASK >> 11 & 1) && IN(1)) { TIDS();
        AdaOrder S{G, bx, (const char*)SC, (const char*)WADA_T};
        pg8::EpiAda E{ADA, INP(I_BADA)};
        pg8::gemm_phase<pg8::EpiAda, AdaOrder>(L + RING_OFF, pg8::Dims{DM, DM, DM}, S, E, tid);
        SEAM(1);
    }
    for (int l = 0; l < DEPTH; ++l) {
        const int pb = 2 + l * NPL;
        if ((PH_MASK >> 0 & 1) && IN(pb + 0)) { TIDS(); LAYER_PTRS();
            for (int row = gw; row < M; row += NGW) { const float* ar = ada + (size_t)row_cond(row) * ADAW;
                norm_row(row < MP ? xinP + (size_t)row * DM : xinS + (size_t)(row - MP) * DM, INP(I_G1) + l * DM, ar + DM, ar, H + (size_t)row * DM, lane); }
            SEAM(pb + 0);
        }
        if ((PH_MASK >> 1 & 1) && IN(pb + 1)) { TIDS(); LAYER_PTRS();
            pg8::StaticOrder S; S.init(H, WIN_T + (size_t)l * ZW * DM, M / 256, ZW / 256, DM, DM, G, bx);
            pg8::EpiZ E{Z};
            pg8::gemm_phase<pg8::EpiZ, pg8::StaticOrder>(L + RING_OFF, pg8::Dims{DM, DM, DM}, S, E, tid);
            SEAM(pb + 1);
        }
        if ((PH_MASK >> 2 & 1) && IN(pb + 2)) { TIDS(); LAYER_PTRS();
            mixl::qknorm_phase(Z, l, INP(I_GQ), INP(I_GK), P_OUT, gw, NGW, lane);
            for (int i = gt; i < N_SHIFT_ITEMS; i += NGT) shift_item(l, i, INP(I_CK), INP(I_CV), INP(I_SCONV), INP(I_SPOOL), P_OUT);
            mixl::conv_phase(L + RING_OFF, Z, l, INP(I_WDW), INP(I_BDW), INP(I_SCONV), CONVY, P_OUT, bx, G, tid);
            mixl::pool_phase(Z, l, INP(I_SPOOL), ZP, P_OUT, gt, NGT);
            ret::kv_phase(L + RING_OFF, Z, KV, bx, G, tid, lane, wave);
            for (int i = gt; i < SB * RH * RDK * 32; i += NGT) { const int v4 = i & 31, d = (i >> 5) & 63, h = (i >> 11) & 7, sb = i >> 14; retstate_s_item(Z, l, sb, h, d, v4, INP(I_SRET), P_OUT); }
            SEAM(pb + 2);
        }
        if ((PH_MASK >> 3 & 1) && IN(pb + 3)) { TIDS(); LAYER_PTRS();
            att::phase(L + RING_OFF, Z, l, INP(I_SINK), INP(I_CK), INP(I_CV), Y, bx, G, tid, lane, wave);
            for (int i = gt; i < NBP * RH * RDK * 32; i += NGT) { const int v4 = i & 31, d = (i >> 5) & 63, h = (i >> 11) & 7, b = i >> 14; retscan_item(KV, SPREV, l, b, h, d, v4, P_OUT); }
            for (int row = gw; row < M; row += NGW) convln_row(CONVY + (size_t)row * BRW, INP(I_GCLN) + l * BRW, INP(I_BCLN) + l * BRW, Y + (size_t)1 * M * BRW + (size_t)row * BRW, lane);
            SEAM(pb + 3);
        }
        if ((PH_MASK >> 4 & 1) && IN(pb + 4)) { TIDS(); LAYER_PTRS();
            mixl::retout_s_phase(Z, l, INP(I_SRET), INP(I_GRET), Y + (size_t)3 * M * BRW, gw, NGW, lane);
            ret::out_phase(L + RING_OFF, Z, l, SPREV, INP(I_GRET), Y + (size_t)3 * M * BRW, bx, G, tid, lane, wave);
            PoolOrder S{G, bx, (const char*)ZP, (const char*)(WPOOL_T + (size_t)l * 4 * 256 * 256)};
            pg8::EpiPool E{Y + (size_t)2 * M * BRW, INP(I_SPOOLS), l};
            pg8::gemm_phase<pg8::EpiPool, PoolOrder>(L + RING_OFF, pg8::Dims{BRW, 256, 256}, S, E, tid);
            SEAM(pb + 4);
        }
        if ((PH_MASK >> 5 & 1) && IN(pb + 5)) { TIDS(); LAYER_PTRS();
            BrOrder S{G, bx, (const char*)Y, (const char*)(WBR_T + (size_t)l * 4 * DM * BRW)};
            pg8::EpiBr E{Z, MACC, MERGED};
            pg8::gemm_phase<pg8::EpiBr, BrOrder>(L + RING_OFF, pg8::Dims{BRW, BRW, BRW}, S, E, tid);
            SEAM(pb + 5);
        }
        if ((PH_MASK >> 6 & 1) && IN(pb + 6)) { TIDS(); LAYER_PTRS();
            pg8::StaticOrder S; S.init(MERGED, WOUT_T + (size_t)l * DM * DM, M / 256, DM / 256, DM, DM, G, bx);
            pg8::EpiRes E{xinP, xinS, X1, ada + 2 * DM};
            pg8::gemm_phase<pg8::EpiRes, pg8::StaticOrder>(L + RING_OFF, pg8::Dims{DM, DM, DM}, S, E, tid);
            SEAM(pb + 6);
        }
        if ((PH_MASK >> 7 & 1) && IN(pb + 7)) { TIDS(); LAYER_PTRS();
            for (int row = gw; row < M; row += NGW) { const float* ar = ada + (size_t)row_cond(row) * ADAW;
                norm_row(X1 + (size_t)row * DM, INP(I_G2) + l * DM, ar + 4 * DM, ar + 3 * DM, H + (size_t)row * DM, lane); }
            SEAM(pb + 7);
        }
        if ((PH_MASK >> 8 & 1) && IN(pb + 8)) { TIDS(); LAYER_PTRS();
            pg8::StaticOrder S; S.init(H, WM1_T + (size_t)l * DFF * DM, M / 256, DFF / 256, DM, DM, G, bx);
            pg8::EpiMlp1 E{HID};
            pg8::gemm_phase<pg8::EpiMlp1, pg8::StaticOrder>(L + RING_OFF, pg8::Dims{DM, DM, DM}, S, E, tid);
            SEAM(pb + 8);
        }
        if ((PH_MASK >> 9 & 1) && IN(pb + 9)) { TIDS(); LAYER_PTRS();
            pg8::StaticOrder S; S.init(HID, WM2_T + (size_t)l * DM * DFF, M / 256, DM / 256, DFF, DFF, G, bx);
            pg8::EpiRes E{X1, X1 + (size_t)MP * DM, xout, ada + 5 * DM};
            pg8::gemm_phase<pg8::EpiRes, pg8::StaticOrder>(L + RING_OFF, pg8::Dims{DFF, DFF, DFF}, S, E, tid);
            SEAM(pb + 9);
        }
    }
#undef IN
#undef SEAM
}

extern "C" void kernel_launch(void* const* d_in, const int* in_sizes, int n_in, void* d_out, int out_size, void* d_ws, size_t ws_size, hipStream_t stream) {
    static int grid = 0;
    if (grid == 0) {
        if (n_in != N_IN || (size_t)out_size != O_END || ws_size < WS_END) { fprintf(stderr, "kernel_launch: unexpected shapes: n_in %d out %d ws %zu (need %zu)\n", n_in, out_size, ws_size, (size_t)WS_END); grid = -1; return; }
        int dev = 0, cus = 0, per_cu = 0;
        if (hipGetDevice(&dev) != hipSuccess || hipDeviceGetAttribute(&cus, hipDeviceAttributeMultiprocessorCount, dev) != hipSuccess) { grid = -1; return; }
        if (hipFuncSetAttribute((const void*)fwd, hipFuncAttributeMaxDynamicSharedMemorySize, LDS_BYTES) != hipSuccess) { fprintf(stderr, "kernel_launch: hipFuncSetAttribute failed\n"); grid = -1; return; }
        if (hipOccupancyMaxActiveBlocksPerMultiprocessor(&per_cu, (const void*)fwd, NTHR, LDS_BYTES) != hipSuccess || per_cu < 1) fprintf(stderr, "kernel_launch: occupancy query says %d\n", per_cu);
        (void)hipGetLastError();
        grid = cus;
    }
    if (grid < 0) return;
    (void)hipMemsetAsync((char*)d_ws + WS_CTL, 0, CTL_ZERO_BYTES, stream);
    Args a{};
    for (int i = 0; i < N_IN; ++i) a.in[i] = (const float*)d_in[i];
    a.out = (float*)d_out; a.ws = (unsigned char*)d_ws;
#if MK_ONE_LAUNCH
    a.ph_lo = 0; a.ph_hi = PH_TOTAL;
    hipLaunchKernelGGL(fwd, dim3(grid), dim3(NTHR), LDS_BYTES, stream, a);
#else
    for (int p = 0; p < PH_TOTAL; ++p) { a.ph_lo = p; a.ph_hi = p + 1; hipLaunchKernelGGL(fwd, dim3(grid), dim3(NTHR), LDS_BYTES, stream, a); }
#endif
}
#endif
```

```cpp
#ifndef HOST_TEST_ONLY
#include <hip/hip_runtime.h>
#endif
#include <cstdio>
#include <cstdint>
#include <cmath>

#ifndef MK_ONE_LAUNCH
#define MK_ONE_LAUNCH 1
#endif

#define HD __host__ __device__ __forceinline__
typedef unsigned short bf16;
HD float bf2f(bf16 b) { return __builtin_bit_cast(float, ((unsigned)b) << 16); }
HD bf16 f2bf(float f) { unsigned u = __builtin_bit_cast(unsigned, f); return (bf16)((u + 0x7fffu + ((u >> 16) & 1u)) >> 16); }

HD void ld8(const bf16* p, float* f) { const uint4 w = *(const uint4*)p;
    f[0] = __builtin_bit_cast(float, w.x << 16); f[1] = __builtin_bit_cast(float, w.x & 0xffff0000u); f[2] = __builtin_bit_cast(float, w.y << 16); f[3] = __builtin_bit_cast(float, w.y & 0xffff0000u);
    f[4] = __builtin_bit_cast(float, w.z << 16); f[5] = __builtin_bit_cast(float, w.z & 0xffff0000u); f[6] = __builtin_bit_cast(float, w.w << 16); f[7] = __builtin_bit_cast(float, w.w & 0xffff0000u); }
HD void st8(bf16* p, const float* f) { uint4 w; w.x = (unsigned)f2bf(f[0]) | ((unsigned)f2bf(f[1]) << 16); w.y = (unsigned)f2bf(f[2]) | ((unsigned)f2bf(f[3]) << 16);
    w.z = (unsigned)f2bf(f[4]) | ((unsigned)f2bf(f[5]) << 16); w.w = (unsigned)f2bf(f[6]) | ((unsigned)f2bf(f[7]) << 16); *(uint4*)p = w; }
constexpr int DM = 2048, SEQ = 4096, NBP = 2, MP = NBP * SEQ, SB = 32, ST = 8, MS = SB * ST, M = MP + MS, DEPTH = 4;
constexpr int NROWB = NBP + SB;
constexpr int NH = 16, HDIM = 64, NKV = 4, WIN = 128, BRW = 1024, CONVK = 31, CPRE = 30, PPAD = 15, RH = 8, RDK = 64, RDV = 128, DFF = 8192;
constexpr int ZW = 15872, ZQ = 0, ZK = 1024, ZV = 1280, ZCA = 1536, ZCG = 2560, ZPL = 3584, ZRQ = 4608, ZRK = 5120, ZRV = 5632, ZRG = 6656, ZGT = 7680;
constexpr int ADAW = 6 * DM;
constexpr float EPS = 1e-6f;
constexpr size_t O_YP = 0, O_YS = O_YP + (size_t)MP * DM, O_KP = O_YS + (size_t)MS * DM, O_VP = O_KP + (size_t)DEPTH * NBP * WIN * 256,
    O_CP = O_VP + (size_t)DEPTH * NBP * WIN * 256, O_PP = O_CP + (size_t)DEPTH * NBP * CPRE * BRW, O_RP = O_PP + (size_t)DEPTH * NBP * PPAD * BRW,
    O_KS = O_RP + (size_t)DEPTH * NBP * RH * RDK * RDV, O_VS = O_KS + (size_t)DEPTH * SB * WIN * 256, O_CS = O_VS + (size_t)DEPTH * SB * WIN * 256,
    O_PS = O_CS + (size_t)DEPTH * SB * CPRE * BRW, O_RS = O_PS + (size_t)DEPTH * SB * PPAD * BRW, O_END = O_RS + (size_t)DEPTH * SB * RH * RDK * RDV;
static_assert(O_END == 41394176, "output size");
enum { I_XP = 0, I_XS, I_CP, I_CS, I_CK, I_CV, I_SCONV, I_SPOOL, I_SRET, I_WADA, I_BADA, I_G1, I_G2, I_WIN, I_GQ, I_GK, I_SINK, I_WDW, I_BDW, I_GCLN, I_BCLN,
       I_WPOOL, I_SPOOLS, I_GRET, I_WBR, I_WOUT, I_WM1, I_WM2, N_IN };

HD bool row_is_s(int row) { return row >= MP; }
HD int row_cond(int row) { return row < MP ? (row >> 12) : NBP + ((row - MP) >> 3); }

#if defined(__HIP_DEVICE_COMPILE__)
#define FEXP(x) __expf(x)
#else
#define FEXP(x) expf(x)
#endif
#if defined(__HIP_DEVICE_COMPILE__)
HD float sigmoidf_(float x) { return __builtin_amdgcn_rcpf(1.f + __expf(-x)); }
#else
HD float sigmoidf_(float x) { return 1.f / (1.f + FEXP(-x)); }
#endif
HD float ret_logg(int h) { const float x = __builtin_bit_cast(float, (unsigned)(127 - 5 - h) << 23); return -x * (1.f + x * (0.5f + x * (0.33333334f + x * (0.25f + x * 0.2f)))); }

HD void qknorm_item(bf16* Z, int l, int row, int slot, const float* gq, const float* gk, float* out) {
    const int col = slot < 16 ? ZQ + slot * 64 : (slot < 20 ? ZK + (slot - 16) * 64 : ZV + (slot - 20) * 64);
    bf16* p = Z + (size_t)row * ZW + col;
    float v[64];
#pragma unroll
    for (int i = 0; i < 64; i += 8) ld8(p + i, v + i);
    if (slot < 20) {
        float ss = 0.f;
#pragma unroll
        for (int i = 0; i < 64; ++i) ss += v[i] * v[i];
        const float r = 1.f / sqrtf(ss * (1.f / 64.f) + EPS);
        const float* g = (slot < 16 ? gq : gk) + l * 64;
#pragma unroll
        for (int i = 0; i < 64; ++i) v[i] = v[i] * r * g[i];
#pragma unroll
        for (int i = 0; i < 64; i += 8) st8(p + i, v + i);
    }
    if (slot >= 16) {
        const int kvh = (slot - 16) & 3; const bool isv = slot >= 20;
        float* o = nullptr;
        if (!row_is_s(row)) { const int b = row >> 12, t = row & (SEQ - 1);
            if (t >= SEQ - WIN) o = out + (isv ? O_VP : O_KP) + ((((size_t)l * NBP + b) * WIN + (t - (SEQ - WIN))) * NKV + kvh) * 64;
        } else { const int sb = (row - MP) >> 3, t = (row - MP) & 7;
            o = out + (isv ? O_VS : O_KS) + ((((size_t)l * SB + sb) * WIN + (WIN - ST + t)) * NKV + kvh) * 64; }
        if (o) {
#pragma unroll
            for (int i = 0; i < 64; ++i) o[i] = v[i];
        }
    }
}
HD void shift_item(int l, int idx, const float* ck, const float* cv, const float* sconv, const float* spool, float* out) {
    constexpr int NKVS = SB * (WIN - ST) * 64, NCV = SB * (CPRE - ST) * 256, NPL = SB * (PPAD - ST) * 256;
    const float* src; float* dst;
    if (idx < 2 * NKVS) { const bool isv = idx >= NKVS; const int i = isv ? idx - NKVS : idx; const int sb = i / ((WIN - ST) * 64), rem = i % ((WIN - ST) * 64);
        src = (isv ? cv : ck) + (((size_t)l * SB + sb) * WIN + ST) * 256 + (size_t)rem * 4; dst = out + (isv ? O_VS : O_KS) + (((size_t)l * SB + sb) * WIN) * 256 + (size_t)rem * 4;
    } else if (idx < 2 * NKVS + NCV) { const int i = idx - 2 * NKVS; const int sb = i / ((CPRE - ST) * 256), rem = i % ((CPRE - ST) * 256);
        src = sconv + (((size_t)l * SB + sb) * CPRE + ST) * BRW + (size_t)rem * 4; dst = out + O_CS + (((size_t)l * SB + sb) * CPRE) * BRW + (size_t)rem * 4;
    } else { const int i = idx - 2 * NKVS - NCV; const int sb = i / ((PPAD - ST) * 256), rem = i % ((PPAD - ST) * 256);
        src = spool + (((size_t)l * SB + sb) * PPAD + ST) * BRW + (size_t)rem * 4; dst = out + O_PS + (((size_t)l * SB + sb) * PPAD) * BRW + (size_t)rem * 4; }
    dst[0] = src[0]; dst[1] = src[1]; dst[2] = src[2]; dst[3] = src[3];
}
constexpr int N_SHIFT_ITEMS = 2 * SB * (WIN - ST) * 64 + SB * (CPRE - ST) * 256 + SB * (PPAD - ST) * 256;

HD float glu_at(const bf16* Z, int row, int c) { const bf16* p = Z + (size_t)row * ZW; return bf2f(p[ZCA + c]) * sigmoidf_(bf2f(p[ZCG + c])); }
HD void conv_item(const bf16* Z, int l, int row, int c, const float* wdw, const float* bdw, const float* sconv, float* CONVY, float* out) {
    float acc = bdw[l * BRW + c];
    const float* w = wdw + (size_t)l * CONVK * BRW + c;
    if (!row_is_s(row)) { const int b = row >> 12, t = row & (SEQ - 1);
        for (int j = 0; j < CONVK; ++j) { const int tt = t - CPRE + j; if (tt >= 0) acc += w[(size_t)j * BRW] * glu_at(Z, b * SEQ + tt, c); }
        if (t >= SEQ - CPRE) out[O_CP + (((size_t)l * NBP + b) * CPRE + (t - (SEQ - CPRE))) * BRW + c] = glu_at(Z, row, c);
    } else { const int sb = (row - MP) >> 3, t = (row - MP) & 7;
        for (int j = 0; j < CONVK; ++j) { const int tt = t - CPRE + j;
            const float u = tt >= 0 ? glu_at(Z, MP + sb * ST + tt, c) : sconv[(((size_t)l * SB + sb) * CPRE + (CPRE + tt)) * BRW + c];
            acc += w[(size_t)j * BRW] * u; }
        out[O_CS + (((size_t)l * SB + sb) * CPRE + (CPRE - ST + t)) * BRW + c] = glu_at(Z, row, c);
    }
    CONVY[(size_t)row * BRW + c] = acc;
}
HD void pool_item(const bf16* Z, int l, int row, int c, const float* spool, bf16* ZP, float* out) {
    const int g = c >> 8, w = 2 << g;
    const float u0 = bf2f(Z[(size_t)row * ZW + ZPL + c]);
    float sum = 0.f, cnt;
    if (!row_is_s(row)) { const int b = row >> 12, t = row & (SEQ - 1);
        for (int i = 0; i < w; ++i) if (t - i >= 0) sum += bf2f(Z[(size_t)(b * SEQ + t - i) * ZW + ZPL + c]);
        cnt = (float)((t + 1) < w ? (t + 1) : w);
        if (t >= SEQ - PPAD) out[O_PP + (((size_t)l * NBP + b) * PPAD + (t - (SEQ - PPAD))) * BRW + c] = u0;
    } else { const int sb = (row - MP) >> 3, t = (row - MP) & 7;
        for (int i = 0; i < w; ++i) { const int tt = t - i;
            sum += tt >= 0 ? bf2f(Z[(size_t)(MP + sb * ST + tt) * ZW + ZPL + c]) : spool[(((size_t)l * SB + sb) * PPAD + (PPAD + tt)) * BRW + c]; }
        cnt = (float)w;
        out[O_PS + (((size_t)l * SB + sb) * PPAD + (PPAD - ST + t)) * BRW + c] = u0;
    }
    ZP[(size_t)row * BRW + c] = f2bf(sum / cnt - u0);
}
HD void retkv_item(const bf16* Z, float* KV, int b, int n, int h, int d, int v4) {
    const float lg = ret_logg(h);
    float a0 = 0.f, a1 = 0.f, a2 = 0.f, a3 = 0.f;
    for (int j = 0; j < 128; ++j) { const bf16* p = Z + (size_t)(b * SEQ + n * 128 + j) * ZW;
        const float kd = bf2f(p[ZRK + h * 64 + d]) * 0.125f * FEXP(lg * (float)(127 - j));
        const bf16* pv = p + ZRV + h * 128 + v4 * 4;
        a0 += kd * bf2f(pv[0]); a1 += kd * bf2f(pv[1]); a2 += kd * bf2f(pv[2]); a3 += kd * bf2f(pv[3]); }
    float* o = KV + ((((size_t)b * 32 + n) * RH + h) * RDK + d) * RDV + v4 * 4;
    o[0] = a0; o[1] = a1; o[2] = a2; o[3] = a3;
}
HD void retstate_s_item(const bf16* Z, int l, int sb, int h, int d, int v4, const float* sret, float* out) {
    const float lg = ret_logg(h);
    const size_t so = ((((size_t)l * SB + sb) * RH + h) * RDK + d) * RDV + v4 * 4;
    const float gc = FEXP(lg * (float)ST);
    float a0 = gc * sret[so], a1 = gc * sret[so + 1], a2 = gc * sret[so + 2], a3 = gc * sret[so + 3];
#pragma unroll
    for (int j = 0; j < ST; ++j) { const bf16* p = Z + (size_t)(MP + sb * ST + j) * ZW;
        const float kd = bf2f(p[ZRK + h * 64 + d]) * 0.125f * FEXP(lg * (float)(ST - 1 - j));
        const bf16* pv = p + ZRV + h * 128 + v4 * 4;
        a0 += kd * bf2f(pv[0]); a1 += kd * bf2f(pv[1]); a2 += kd * bf2f(pv[2]); a3 += kd * bf2f(pv[3]); }
    float* o = out + O_RS + so; o[0] = a0; o[1] = a1; o[2] = a2; o[3] = a3;
}
HD void retscan_item(const float* KV, float* SPREV, int l, int b, int h, int d, int v4, float* out) {
    const float gc = FEXP(ret_logg(h) * 128.f);
    float s0 = 0.f, s1 = 0.f, s2 = 0.f, s3 = 0.f;
    for (int n = 0; n < 32; ++n) { const size_t o = ((((size_t)b * 32 + n) * RH + h) * RDK + d) * RDV + v4 * 4;
        SPREV[o] = s0; SPREV[o + 1] = s1; SPREV[o + 2] = s2; SPREV[o + 3] = s3;
        s0 = gc * s0 + KV[o]; s1 = gc * s1 + KV[o + 1]; s2 = gc * s2 + KV[o + 2]; s3 = gc * s3 + KV[o + 3]; }
    float* oo = out + O_RP + ((((size_t)l * NBP + b) * RH + h) * RDK + d) * RDV + v4 * 4;
    oo[0] = s0; oo[1] = s1; oo[2] = s2; oo[3] = s3;
}
HD void attn_item(const bf16* Z, int l, int row, int hq, const float* sinks, const float* ck, const float* cv, bf16* Y0) {
    const int kvh = hq >> 2; const float slope = exp2f(-0.5f * (float)(hq + 1));
    float q[64];
    { const bf16* p = Z + (size_t)row * ZW + ZQ + hq * 64;
#pragma unroll
      for (int i = 0; i < 64; i += 8) ld8(p + i, q + i);
#pragma unroll
      for (int i = 0; i < 64; ++i) q[i] *= 0.125f; }
    float m = sinks[l * NH + hq], lsum = 1.f;
    float o[64];
#pragma unroll
    for (int i = 0; i < 64; ++i) o[i] = 0.f;
    const bool smp = row_is_s(row);
    const int b = smp ? ((row - MP) >> 3) : (row >> 12), t = smp ? ((row - MP) & 7) : (row & (SEQ - 1));
    const int lo = smp ? t : (t - WIN > 0 ? t - WIN : 0), hi = smp ? WIN + t : t;
    for (int j = lo; j <= hi; ++j) {
        const int dist = smp ? (WIN + t - j) : (t - j);
        const bool cache = smp && j < WIN;
        const size_t zrow = (size_t)(smp ? (MP + b * ST + (j - WIN)) : (b * SEQ + j)) * ZW;
        const size_t crow = ((((size_t)l * SB + b) * WIN + j) * NKV + kvh) * 64;
        float s = 0.f;
        if (cache) { const float* kp = ck + crow;
#pragma unroll
            for (int i = 0; i < 64; ++i) s += q[i] * kp[i];
        } else { const bf16* kp = Z + zrow + ZK + kvh * 64;
#pragma unroll
            for (int i = 0; i < 64; i += 8) { float f[8]; ld8(kp + i, f);
#pragma unroll
                for (int e = 0; e < 8; ++e) s += q[i + e] * f[e]; } }
        s -= slope * (float)dist;
        if (s > m) { const float corr = FEXP(m - s); lsum *= corr;
#pragma unroll
            for (int i = 0; i < 64; ++i) o[i] *= corr;
            m = s; }
        const float p = FEXP(s - m); lsum += p;
        if (cache) { const float* vp = cv + crow;
#pragma unroll
            for (int i = 0; i < 64; ++i) o[i] += p * vp[i];
        } else { const bf16* vp = Z + zrow + ZV + kvh * 64;
#pragma unroll
            for (int i = 0; i < 64; i += 8) { float f[8]; ld8(vp + i, f);
#pragma unroll
                for (int e = 0; e < 8; ++e) o[i + e] += p * f[e]; } }
    }
    const float inv = 1.f / lsum;
    bf16* y = Y0 + (size_t)row * BRW + hq * 64;
#pragma unroll
    for (int i = 0; i < 64; ++i) o[i] *= inv;
#pragma unroll
    for (int i = 0; i < 64; i += 8) st8(y + i, o + i);
}
HD void retout_item(const bf16* Z, int l, int row, int h, const float* SPREV, const float* sret, const float* gret, float* ORAW, bf16* Y3) {
    const float lg = ret_logg(h);
    const bool smp = row_is_s(row);
    const int b = smp ? ((row - MP) >> 3) : (row >> 12), t = smp ? ((row - MP) & 7) : (row & (SEQ - 1));
    const int i = smp ? t : (t & 127), n = smp ? 0 : (t >> 7);
    const int row0 = smp ? (MP + b * ST) : (b * SEQ + n * 128);
    const float* S = smp ? sret + (((size_t)l * SB + b) * RH + h) * RDK * RDV : SPREV + (((size_t)b * 32 + n) * RH + h) * RDK * RDV;
    float q[64];
    { const bf16* p = Z + (size_t)row * ZW + ZRQ + h * 64;
#pragma unroll
      for (int d = 0; d < 64; d += 8) ld8(p + d, q + d); }
    float* oraw = ORAW + (size_t)row * BRW + h * 128;
    float sum = 0.f;
    for (int half = 0; half < 2; ++half) {
        float o[64];
#pragma unroll
        for (int v = 0; v < 64; ++v) o[v] = 0.f;
        for (int j = 0; j <= i; ++j) { const bf16* p = Z + (size_t)(row0 + j) * ZW;
            const bf16* kp = p + ZRK + h * 64; float s = 0.f;
#pragma unroll
            for (int d = 0; d < 64; d += 8) { float f[8]; ld8(kp + d, f);
#pragma unroll
                for (int e = 0; e < 8; ++e) s += q[d + e] * f[e]; }
            s *= 0.125f * FEXP(lg * (float)(i - j));
            const bf16* vp = p + ZRV + h * 128 + half * 64;
#pragma unroll
            for (int v = 0; v < 64; v += 8) { float f[8]; ld8(vp + v, f);
#pragma unroll
                for (int e = 0; e < 8; ++e) o[v + e] += s * f[e]; } }
        const float cf = FEXP(lg * (float)(i + 1));
        const bf16* qp = Z + (size_t)row * ZW + ZRQ + h * 64;
        for (int d = 0; d < 64; ++d) { const float qd = bf2f(qp[d]) * cf; const float* sp = S + (size_t)d * RDV + half * 64;
#pragma unroll
            for (int v = 0; v < 64; ++v) o[v] += qd * sp[v]; }
#pragma unroll
        for (int v = 0; v < 64; ++v) { oraw[half * 64 + v] = o[v]; sum += o[v]; }
    }
    const float mean = sum * (1.f / 128.f);
    float var = 0.f;
    for (int v = 0; v < 128; ++v) { const float d = oraw[v] - mean; var += d * d; }
    const float rstd = 1.f / sqrtf(var * (1.f / 128.f) + EPS);
    const float* g = gret + l * BRW + h * 128;
    const bf16* rg = Z + (size_t)row * ZW + ZRG + h * 128;
    bf16* y = Y3 + (size_t)row * BRW + h * 128;
    for (int v = 0; v < 128; ++v) y[v] = f2bf((oraw[v] - mean) * rstd * g[v] * bf2f(rg[v]));
}

#if !defined(HOST_TEST_ONLY)
namespace pg8 {
#define PG8_LAS __attribute__((address_space(3)))
typedef short bf16x8 __attribute__((ext_vector_type(8)));
typedef float f32x4 __attribute__((ext_vector_type(4)));
typedef float f32x2 __attribute__((ext_vector_type(2)));
typedef unsigned u32x4 __attribute__((ext_vector_type(4)));
typedef unsigned u32x2 __attribute__((ext_vector_type(2)));
constexpr int BM = 256, BK = 64, HALF = 128, HTB = HALF * BK * 2, STAGE_BYTES = 8 * HTB, NXCD = 8, WGM = 8;

__host__ __device__ __forceinline__ int lds_byte(int r, int c) { const int st = (r >> 4) * 2 + (c >> 5), rr = r & 15, cc = c & 31, ob = rr * 64 + cc * 2; return st * 1024 + (ob ^ (((ob >> 9) & 1) << 5)); }
__host__ __device__ __forceinline__ void stage_rc(int b, int& R, int& C) { const int st = b / 1024, sb = b % 1024, swz = sb ^ (((sb >> 9) & 1) << 5); R = (st >> 1) * 16 + swz / 64; C = (st & 1) * 32 + (swz % 64) / 2; }
__host__ __device__ __forceinline__ int perm32(int rho) { const int n = rho >> 4, i = rho & 15; return 8 * (i >> 2) + 4 * n + (i & 3); }

struct Unit { int pm, pn, r, ks, nt; const char* a; const char* b; };
struct Dims { int lda, ldb, K; };

__host__ __device__ __forceinline__ void tile_of(int L, int nM, int nN, int& pm, int& pn) {
    const int nwg = nM * nN; int wgid = L; { const int q = nwg / NXCD, r = nwg % NXCD, xcd = wgid % NXCD, off = wgid / NXCD; wgid = (xcd < r ? xcd * (q + 1) : r * (q + 1) + (xcd - r) * q) + off; }
    const int nig = WGM * nN, gid = wgid / nig, fm = gid * WGM, gsz = (nM - fm) < WGM ? (nM - fm) : WGM;
    pm = fm + ((wgid % nig) % gsz); pn = (wgid % nig) / gsz;
}
struct StaticOrder {
    int nM, nN, nwg, G, c, nt; const char* A; const char* B; size_t ta, tb;
    __device__ __forceinline__ void init(const bf16* A_, const bf16* B_, int nM_, int nN_, int lda, int ldb, int K, int G_, int c_) { A = (const char*)A_; B = (const char*)B_; nM = nM_; nN = nN_; nwg = nM * nN; G = G_; c = c_; nt = K / BK; ta = (size_t)BM * lda * 2; tb = (size_t)BM * ldb * 2; }
    __device__ __forceinline__ bool next(int i, Unit& u) const {
        const long L = (long)i * G + c; if (L >= nwg) return false;
        tile_of((int)L, nM, nN, u.pm, u.pn); u.r = 0; u.ks = 0; u.nt = nt; u.a = A + (size_t)u.pm * ta; u.b = B + (size_t)u.pn * tb; return true;
    }
};


struct SplitOrder {
    int nN, G, c, RPT, ntP, KS, ntS; const char* A; const char* B; size_t ta, tb, sAr, sBr;
    __device__ __forceinline__ bool next(int i, Unit& u) const {
        const int nP = (MP / BM) * nN, Pc = c < nP ? (nP - c + G - 1) / G : 0;
        if (i < Pc * RPT) { const int tl = (i / RPT) * G + c; tile_of(tl, MP / BM, nN, u.pm, u.pn); u.r = i % RPT; u.ks = 0; u.nt = ntP;
            u.a = A + (size_t)u.r * sAr + (size_t)u.pm * ta; u.b = B + (size_t)u.r * sBr + (size_t)u.pn * tb; return true; }
        const int su = (i - Pc * RPT) * G + c; if (su >= nN * RPT * KS) return false;
        u.pm = MP / BM; u.pn = su / (RPT * KS); u.r = (su / KS) % RPT; u.ks = su % KS; u.nt = ntS;
        u.a = A + (size_t)u.r * sAr + (size_t)u.pm * ta + (size_t)u.ks * ntS * (BK * 2); u.b = B + (size_t)u.r * sBr + (size_t)u.pn * tb + (size_t)u.ks * ntS * (BK * 2); return true;
    }
};

__device__ __forceinline__ unsigned cvt_pk_bf16(float lo, float hi) { unsigned r; asm volatile("v_cvt_pk_bf16_f32 %0, %1, %2" : "=v"(r) : "v"(lo), "v"(hi)); return r; }

template <class Epi, class Sched, bool ALIGN_EPI = true, bool SP2 = true>
__device__ __forceinline__ void gemm_phase(PG8_LAS unsigned char* lds, const Dims g, const Sched& S, const Epi& E, const int tid) {
    const int wid = __builtin_amdgcn_readfirstlane(tid >> 6), lane = tid & 63, wr = wid >> 2, wc = wid & 3, fr = lane & 15, fq = lane >> 4;
    unsigned voffA[2], voffB[2];
#pragma unroll
    for (int i = 0; i < 2; ++i) { int R, C; stage_rc(tid * 16 + i * 8192, R, C); const int Rb = Epi::PERM ? ((R & ~31) + perm32(R & 31)) : R;
        voffA[i] = (unsigned)(R * g.lda + C) * 2u; voffB[i] = (unsigned)(Rb * g.ldb + C) * 2u; }
    const size_t kstep = (size_t)(BK * 2);
    const size_t hstepA = (size_t)HALF * g.lda * 2, hstepB = (size_t)HALF * g.ldb * 2;
    const unsigned ldsw = (unsigned)wid * 1024u;
    const int aoff = lds_byte(wr * 64 + fr, fq * 8), boff = lds_byte(wc * 32 + fr, fq * 8);
#define PG8_SA(b, h) (((b) * 2 + (h)) * HTB)
#define PG8_SB(b, h) ((4 + (b) * 2 + (h)) * HTB)
#define PG8_STAGE(bufoff, gbase, voff) do { _Pragma("unroll") for (int _i = 0; _i < 2; ++_i) \
        __builtin_amdgcn_global_load_lds((const unsigned*)((const char*)(gbase) + (voff)[_i]), (PG8_LAS unsigned*)(lds + (bufoff) + ldsw + _i * 8192), 16, 0, 0); } while (0)
#define PG8_LDA(dst, b, h) do { _Pragma("unroll") for (int m = 0; m < 4; ++m) _Pragma("unroll") for (int k = 0; k < 2; ++k) dst[m][k] = *(const PG8_LAS bf16x8*)(lds + PG8_SA(b, h) + aoff + m * 2048 + k * 1024); } while (0)
#define PG8_LDB(dst, b, h) do { _Pragma("unroll") for (int n = 0; n < 2; ++n) _Pragma("unroll") for (int k = 0; k < 2; ++k) dst[n][k] = *(const PG8_LAS bf16x8*)(lds + PG8_SB(b, h) + boff + n * 2048 + k * 1024); } while (0)
#define PG8_MMA(ai, bj, At, Bt) do { __builtin_amdgcn_s_setprio(1); _Pragma("unroll") for (int m = 0; m < 4; ++m) _Pragma("unroll") for (int n = 0; n < 2; ++n) _Pragma("unroll") for (int k = 0; k < 2; ++k) \
        acc[ai][bj][m][n] = __builtin_amdgcn_mfma_f32_16x16x32_bf16(Bt[n][k], At[m][k], acc[ai][bj][m][n], 0, 0, 0); __builtin_amdgcn_s_setprio(0); } while (0)
#define PG8_WAIT_V(n) asm volatile("s_waitcnt vmcnt(" #n ")" ::: "memory")
#define PG8_WAIT_L(n) asm volatile("s_waitcnt lgkmcnt(" #n ")" ::: "memory")
#define PG8_BAR __builtin_amdgcn_s_barrier()
#define PG8_SCHED __builtin_amdgcn_sched_barrier(0)
    Unit cur, nxt; int ui = 0;
    if (!S.next(0, cur)) return;
    f32x4 acc[2][2][4][2];
#pragma unroll
    for (int a = 0; a < 2; ++a)
#pragma unroll
        for (int b = 0; b < 2; ++b)
#pragma unroll
            for (int m = 0; m < 4; ++m)
#pragma unroll
                for (int n = 0; n < 2; ++n) acc[a][b][m][n] = (f32x4){0.f, 0.f, 0.f, 0.f};
    bf16x8 At[4][2], B0[2][2], B1[2][2];
    const char* cA = cur.a; const char* cB = cur.b;
    if constexpr (SP2) {
        PG8_STAGE(PG8_SB(0, 0), cB, voffB); PG8_STAGE(PG8_SB(0, 1), cB + hstepB, voffB); PG8_STAGE(PG8_SA(0, 0), cA, voffA); PG8_STAGE(PG8_SA(0, 1), cA + hstepA, voffA);
        if (wr == 1) PG8_BAR;
        PG8_WAIT_V(2); PG8_BAR;
        PG8_STAGE(PG8_SB(1, 0), cB + kstep, voffB); PG8_STAGE(PG8_SA(1, 0), cA + kstep, voffA); PG8_STAGE(PG8_SB(1, 1), cB + hstepB + kstep, voffB);
        PG8_WAIT_V(6); PG8_BAR;
    } else {
        PG8_STAGE(PG8_SB(0, 0), cB, voffB); PG8_STAGE(PG8_SA(0, 0), cA, voffA); PG8_STAGE(PG8_SB(0, 1), cB + hstepB, voffB); PG8_STAGE(PG8_SA(0, 1), cA + hstepA, voffA);
        if (wr == 1) PG8_BAR;
        PG8_WAIT_V(4); PG8_BAR;
        PG8_STAGE(PG8_SB(1, 0), cB + kstep, voffB); PG8_STAGE(PG8_SA(1, 0), cA + kstep, voffA); PG8_STAGE(PG8_SB(1, 1), cB + hstepB + kstep, voffB);
        PG8_WAIT_V(6); PG8_BAR;
    }
    for (;;) {
        const bool has_next = S.next(ui + 1, nxt);
        const char* nA = has_next ? nxt.a : cA; const char* nB = has_next ? nxt.b : cB;
        const int nt = cur.nt;
        for (int t = 0; t < nt; t += 2) {
            const bool last = (t == nt - 2);
            const char* a1 = cA + (size_t)(t + 1) * kstep;
            const char* a2 = last ? nA : cA + (size_t)(t + 2) * kstep; const char* b2 = last ? nB : cB + (size_t)(t + 2) * kstep;
            const char* a3 = a2 + kstep; const char* b3 = b2 + kstep;
            if constexpr (SP2) {
            PG8_LDB(B0, 0, 0); PG8_LDB(B1, 0, 1); PG8_SCHED; PG8_LDA(At, 0, 0); PG8_STAGE(PG8_SA(1, 1), a1 + hstepA, voffA);
            PG8_WAIT_V(8); PG8_WAIT_L(0); PG8_BAR; PG8_MMA(0, 0, At, B0); PG8_MMA(0, 1, At, B1); PG8_BAR; PG8_SCHED;
            PG8_LDA(At, 0, 1); PG8_STAGE(PG8_SB(0, 0), b2, voffB); PG8_STAGE(PG8_SB(0, 1), b2 + hstepB, voffB); PG8_STAGE(PG8_SA(0, 0), a2, voffA);
            PG8_WAIT_V(8); PG8_WAIT_L(0); PG8_BAR; PG8_MMA(1, 0, At, B0); PG8_MMA(1, 1, At, B1); PG8_BAR; PG8_SCHED;
            PG8_LDB(B0, 1, 0); PG8_LDB(B1, 1, 1); PG8_SCHED; PG8_LDA(At, 1, 0); PG8_STAGE(PG8_SA(0, 1), a2 + hstepA, voffA);
            PG8_WAIT_V(8); PG8_WAIT_L(0); PG8_BAR; PG8_MMA(0, 0, At, B0); PG8_MMA(0, 1, At, B1); PG8_BAR; PG8_SCHED;
            PG8_LDA(At, 1, 1); PG8_STAGE(PG8_SB(1, 0), b3, voffB); PG8_STAGE(PG8_SB(1, 1), b3 + hstepB, voffB); PG8_STAGE(PG8_SA(1, 0), a3, voffA);
            PG8_WAIT_V(8); PG8_WAIT_L(0); PG8_BAR; PG8_MMA(1, 0, At, B0); PG8_MMA(1, 1, At, B1); PG8_BAR; PG8_SCHED;
            } else {
            PG8_LDB(B0, 0, 0); PG8_SCHED; PG8_LDA(At, 0, 0); PG8_STAGE(PG8_SA(1, 1), a1 + hstepA, voffA);
            PG8_WAIT_L(8); PG8_BAR; PG8_WAIT_L(0); PG8_MMA(0, 0, At, B0); PG8_BAR; PG8_SCHED;
            PG8_LDB(B1, 0, 1); PG8_STAGE(PG8_SB(0, 0), b2, voffB);
            PG8_BAR; PG8_WAIT_L(0); PG8_MMA(0, 1, At, B1); PG8_BAR;
            PG8_LDA(At, 0, 1); PG8_STAGE(PG8_SA(0, 0), a2, voffA);
            PG8_BAR; PG8_WAIT_L(0); PG8_MMA(1, 0, At, B0); PG8_BAR; PG8_SCHED;
            PG8_STAGE(PG8_SB(0, 1), b2 + hstepB, voffB);
            PG8_WAIT_V(6); PG8_BAR; PG8_MMA(1, 1, At, B1); PG8_BAR;
            PG8_LDB(B0, 1, 0); PG8_SCHED; PG8_LDA(At, 1, 0); PG8_STAGE(PG8_SA(0, 1), a2 + hstepA, voffA);
            PG8_WAIT_L(8); PG8_BAR; PG8_WAIT_L(0); PG8_MMA(0, 0, At, B0); PG8_BAR; PG8_SCHED;
            PG8_LDB(B1, 1, 1); PG8_STAGE(PG8_SB(1, 0), b3, voffB);
            PG8_BAR; PG8_WAIT_L(0); PG8_MMA(0, 1, At, B1); PG8_BAR;
            PG8_LDA(At, 1, 1); PG8_STAGE(PG8_SA(1, 0), a3, voffA);
            PG8_BAR; PG8_WAIT_L(0); PG8_MMA(1, 0, At, B0); PG8_BAR; PG8_SCHED;
            PG8_STAGE(PG8_SB(1, 1), b3 + hstepB, voffB);
            PG8_WAIT_V(6); PG8_BAR; PG8_MMA(1, 1, At, B1); PG8_BAR;
            }
        }
        if constexpr (ALIGN_EPI) { if (wr == 0) PG8_BAR; }
        bool keep; { int ln; asm volatile("v_mbcnt_lo_u32_b32 %0, -1, 0\n\tv_mbcnt_hi_u32_b32 %0, -1, %0" : "=v"(ln)); keep = E(acc, cur, wr, wc, ln & 15, ln >> 4); }
        if (!has_next) break;
        if (!keep)
#pragma unroll
        for (int a = 0; a < 2; ++a)
#pragma unroll
            for (int b = 0; b < 2; ++b)
#pragma unroll
                for (int m = 0; m < 4; ++m)
#pragma unroll
                    for (int n = 0; n < 2; ++n) acc[a][b][m][n] = (f32x4){0.f, 0.f, 0.f, 0.f};
        cur = nxt; cA = nA; cB = nB; ++ui;
        if constexpr (ALIGN_EPI) { if (wr == 1) PG8_BAR; }
    }
    PG8_WAIT_V(0);
    if constexpr (!ALIGN_EPI) { if (wr == 0) PG8_BAR; }
    PG8_BAR;
#undef PG8_SA
#undef PG8_SB
#undef PG8_STAGE
#undef PG8_LDA
#undef PG8_LDB
#undef PG8_MMA
#undef PG8_WAIT_V
#undef PG8_WAIT_L
#undef PG8_BAR
#undef PG8_SCHED
}

__device__ __forceinline__ float fsigmoid(float x) { return __builtin_amdgcn_rcpf(1.f + __expf(-x)); }
struct EpiZ {
    static constexpr bool PERM = true;
    bf16* Z;
    __device__ __forceinline__ bool operator()(f32x4 (&acc)[2][2][4][2], const Unit& u, int wr, int wc, int fr, int fq) const {
        const int row0 = u.pm * BM + wr * 64 + fr, col0 = u.pn * BM + wc * 32 + 8 * fq;
        const int ty = u.pn >= 30 ? 2 : (u.pn >= 26 ? 1 : 0);
#pragma unroll
        for (int ai = 0; ai < 2; ++ai)
#pragma unroll
            for (int m = 0; m < 4; ++m) { bf16* rowp = Z + (size_t)(row0 + ai * HALF + m * 16) * ZW + col0;
#pragma unroll
                for (int bj = 0; bj < 2; ++bj) { f32x4 v0 = acc[ai][bj][m][0], v1 = acc[ai][bj][m][1];
                    if (ty == 2) {
#pragma unroll
                        for (int j = 0; j < 4; ++j) { v0[j] = fsigmoid(v0[j]); v1[j] = fsigmoid(v1[j]); } }
                    else if (ty == 1) {
#pragma unroll
                        for (int j = 0; j < 4; ++j) { v0[j] = v0[j] * fsigmoid(v0[j]); v1[j] = v1[j] * fsigmoid(v1[j]); } }
                    u32x4 w; w.x = cvt_pk_bf16(v0[0], v0[1]); w.y = cvt_pk_bf16(v0[2], v0[3]); w.z = cvt_pk_bf16(v1[0], v1[1]); w.w = cvt_pk_bf16(v1[2], v1[3]);
                    *(u32x4*)(rowp + bj * HALF) = w; } }
        return false;
    }
};
struct EpiMlp1 {
    static constexpr bool PERM = true;
    bf16* O; float* SLAB;
    __device__ __forceinline__ bool operator()(f32x4 (&acc)[2][2][4][2], const Unit& u, int wr, int wc, int fr, int fq) const {
        const int row0 = u.pm * BM + wr * 64 + fr, col0 = u.pn * BM + wc * 32 + 8 * fq;
        if (u.pm == MP / BM) { float* sl = SLAB + ((size_t)u.ks * BM + wr * 64 + fr) * DFF + col0;
#pragma unroll
            for (int ai = 0; ai < 2; ++ai)
#pragma unroll
                for (int m = 0; m < 4; ++m)
#pragma unroll
                    for (int bj = 0; bj < 2; ++bj) { float* p = sl + (size_t)(ai * HALF + m * 16) * DFF + bj * HALF; *(f32x4*)p = acc[ai][bj][m][0]; *(f32x4*)(p + 4) = acc[ai][bj][m][1]; }
            return false; }
#pragma unroll
        for (int ai = 0; ai < 2; ++ai)
#pragma unroll
            for (int m = 0; m < 4; ++m) { bf16* rowp = O + (size_t)(row0 + ai * HALF + m * 16) * DFF + col0;
#pragma unroll
                for (int bj = 0; bj < 2; ++bj) { f32x4 v0 = acc[ai][bj][m][0], v1 = acc[ai][bj][m][1];
#pragma unroll
                    for (int j = 0; j < 4; ++j) { const float a = fmaxf(v0[j], 0.f), b = fmaxf(v1[j], 0.f); v0[j] = a * a; v1[j] = b * b; }
                    u32x4 w; w.x = cvt_pk_bf16(v0[0], v0[1]); w.y = cvt_pk_bf16(v0[2], v0[3]); w.z = cvt_pk_bf16(v1[0], v1[1]); w.w = cvt_pk_bf16(v1[2], v1[3]);
                    *(u32x4*)(rowp + bj * HALF) = w; } }
        return false;
    }
};
struct EpiPool {
    static constexpr bool PERM = true;
    bf16* Y2; const float* spb; int l;
    __device__ __forceinline__ bool operator()(f32x4 (&acc)[2][2][4][2], const Unit& u, int wr, int wc, int fr, int fq) const {
        const int row0 = u.pm * BM + wr * 64 + fr, col0 = u.pn * BM + wc * 32 + 8 * fq;
        int le = l; asm volatile("" : "+s"(le)); const float* sp = spb + le * BRW;
        f32x4 s[2][2];
#pragma unroll
        for (int bj = 0; bj < 2; ++bj)
#pragma unroll
            for (int n = 0; n < 2; ++n) s[bj][n] = *(const f32x4*)(sp + col0 + bj * HALF + 4 * n);
#pragma unroll
        for (int ai = 0; ai < 2; ++ai)
#pragma unroll
            for (int m = 0; m < 4; ++m) { bf16* rowp = Y2 + (size_t)(row0 + ai * HALF + m * 16) * BRW + col0;
#pragma unroll
                for (int bj = 0; bj < 2; ++bj) { const f32x4 v0 = acc[ai][bj][m][0] * s[bj][0], v1 = acc[ai][bj][m][1] * s[bj][1];
                    u32x4 w; w.x = cvt_pk_bf16(v0[0], v0[1]); w.y = cvt_pk_bf16(v0[2], v0[3]); w.z = cvt_pk_bf16(v1[0], v1[1]); w.w = cvt_pk_bf16(v1[2], v1[3]);
                    *(u32x4*)(rowp + bj * HALF) = w; } }
        return false;
    }
};
struct EpiAda {
    static constexpr bool PERM = false;
    float* ADA; const float* bada;
    __device__ __forceinline__ bool operator()(f32x4 (&acc)[2][2][4][2], const Unit& u, int wr, int wc, int fr, int fq) const {
        if (wr != 0) return false;
        const int col0 = u.pn * BM + wc * 32 + 4 * fq;
#pragma unroll
        for (int m = 0; m < 3; ++m) { const int row = m * 16 + fr;
            if (row < NROWB) {
#pragma unroll
                for (int bj = 0; bj < 2; ++bj)
#pragma unroll
                    for (int n = 0; n < 2; ++n) { const int c = col0 + bj * HALF + n * 16; const f32x4 bv = *(const f32x4*)(bada + (size_t)u.r * ADAW + c);
                        *(f32x4*)(ADA + ((size_t)u.r * NROWB + row) * ADAW + c) = acc[0][bj][m][n] + bv; } } }
        return false;
    }
};
struct EpiBr {
    static constexpr bool PERM = true;
    const bf16* Z; bf16* MERGED; float* SLAB; int KS;
    static __device__ __forceinline__ void unp8(const u32x4 gw, f32x4& g0, f32x4& g1) { const float T = 8.6736174e-19f;
        g0[0] = fmaxf(__builtin_bit_cast(float, gw.x << 16), T); g0[1] = fmaxf(__builtin_bit_cast(float, gw.x & 0xffff0000u), T); g0[2] = fmaxf(__builtin_bit_cast(float, gw.y << 16), T); g0[3] = fmaxf(__builtin_bit_cast(float, gw.y & 0xffff0000u), T);
        g1[0] = fmaxf(__builtin_bit_cast(float, gw.z << 16), T); g1[1] = fmaxf(__builtin_bit_cast(float, gw.z & 0xffff0000u), T); g1[2] = fmaxf(__builtin_bit_cast(float, gw.w << 16), T); g1[3] = fmaxf(__builtin_bit_cast(float, gw.w & 0xffff0000u), T); }
    __device__ __forceinline__ bool operator()(f32x4 (&acc)[2][2][4][2], const Unit& u, int wr, int wc, int fr, int fq) const {
        const int row0 = u.pm * BM + wr * 64 + fr, col0 = u.pn * BM + wc * 32 + 8 * fq;
        const int r = u.r; const bool smp = u.pm == MP / BM;
        const bf16* gbase = Z + (size_t)row0 * ZW + ZGT + r * DM + col0;
#pragma unroll
        for (int ai = 0; ai < 2; ++ai) {
            u32x4 ga[4][2], gb[4][2];
#pragma unroll
            for (int m = 0; m < 4; ++m)
#pragma unroll
                for (int bj = 0; bj < 2; ++bj) { const bf16* gp = gbase + (size_t)(ai * HALF + m * 16) * ZW + bj * HALF; ga[m][bj] = *(const u32x4*)gp; gb[m][bj] = *(const u32x4*)(gp + DM); }
            asm volatile("" ::: "memory");
#pragma unroll
            for (int m = 0; m < 4; ++m)
#pragma unroll
                for (int bj = 0; bj < 2; ++bj) { const size_t row = (size_t)(row0 + ai * HALF + m * 16); const int c = col0 + bj * HALF;
                    f32x4 g0, g1; unp8(ga[m][bj], g0, g1);
                    if (smp) { float* sp = SLAB + ((size_t)(r * KS + u.ks) * BM + (row - MP)) * DM + c; *(f32x4*)sp = acc[ai][bj][m][0] * g0; *(f32x4*)(sp + 4) = acc[ai][bj][m][1] * g1; }
                    else if (r < 3) { f32x4 n0, n1; unp8(gb[m][bj], n0, n1);
#pragma unroll
                        for (int j = 0; j < 4; ++j) { acc[ai][bj][m][0][j] *= g0[j] * __builtin_amdgcn_rcpf(n0[j]); acc[ai][bj][m][1][j] *= g1[j] * __builtin_amdgcn_rcpf(n1[j]); } }
                    else { const f32x4 v0 = acc[ai][bj][m][0] * g0, v1 = acc[ai][bj][m][1] * g1;
                        u32x4 w; w.x = cvt_pk_bf16(v0[0], v0[1]); w.y = cvt_pk_bf16(v0[2], v0[3]); w.z = cvt_pk_bf16(v1[0], v1[1]); w.w = cvt_pk_bf16(v1[2], v1[3]);
                        *(u32x4*)(MERGED + row * DM + c) = w; } }
        }
        return !smp && r < 3;
    }
};
struct EpiRes {
    static constexpr bool PERM = false;
    const float* baseP; const float* baseS; float* out; const float* gate; float* SLAB;
    __device__ __forceinline__ bool operator()(f32x4 (&acc)[2][2][4][2], const Unit& u, int wr, int wc, int fr, int fq) const {
        const int rl0 = wr * 64 + fr, col0 = u.pn * BM + wc * 32 + 4 * fq;
        const bool smp = u.pm >= MP / BM;
        if (smp) { float* sl = SLAB + ((size_t)u.ks * BM + rl0) * DM + col0;
#pragma unroll
            for (int ai = 0; ai < 2; ++ai)
#pragma unroll
                for (int m = 0; m < 4; ++m)
#pragma unroll
                    for (int bj = 0; bj < 2; ++bj)
#pragma unroll
                        for (int n = 0; n < 2; ++n) *(f32x4*)(sl + (size_t)(ai * HALF + m * 16) * DM + bj * HALF + n * 16) = acc[ai][bj][m][n];
            return false; }
        const float* base = baseP + (size_t)u.pm * BM * DM + (size_t)rl0 * DM + col0;
        float* o = out + (size_t)u.pm * BM * DM + (size_t)rl0 * DM + col0;
        const float* gp = gate + (size_t)(u.pm >> 4) * ADAW + col0;
        f32x4 gv[2][2];
#pragma unroll
        for (int bj = 0; bj < 2; ++bj)
#pragma unroll
            for (int n = 0; n < 2; ++n) gv[bj][n] = *(const f32x4*)(gp + bj * HALF + n * 16);
#pragma unroll
        for (int ai = 0; ai < 2; ++ai) {
            f32x4 bs[4][2][2];
#pragma unroll
            for (int m = 0; m < 4; ++m)
#pragma unroll
                for (int bj = 0; bj < 2; ++bj)
#pragma unroll
                    for (int n = 0; n < 2; ++n) bs[m][bj][n] = *(const f32x4*)(base + (size_t)(ai * HALF + m * 16) * DM + bj * HALF + n * 16);
            asm volatile("" ::: "memory");
#pragma unroll
            for (int m = 0; m < 4; ++m)
#pragma unroll
                for (int bj = 0; bj < 2; ++bj)
#pragma unroll
                    for (int n = 0; n < 2; ++n) *(f32x4*)(o + (size_t)(ai * HALF + m * 16) * DM + bj * HALF + n * 16) = bs[m][bj][n] + gv[bj][n] * acc[ai][bj][m][n];
        }
        return false;
    }
};
}

constexpr int NWAVES = 8, NTHR = NWAVES * 64;
constexpr size_t MiB = 1u << 20;
constexpr size_t al1(size_t x) { return (x + MiB - 1) / MiB * MiB; }
constexpr size_t WS_CTL = 0, CTL_ZERO_BYTES = 1 * MiB;
constexpr size_t WS_WIN = WS_CTL + CTL_ZERO_BYTES;
constexpr size_t WS_WBR = WS_WIN + al1((size_t)DEPTH * ZW * DM * 2);
constexpr size_t WS_WOUT = WS_WBR + al1((size_t)DEPTH * 4 * DM * BRW * 2);
constexpr size_t WS_WM1 = WS_WOUT + al1((size_t)DEPTH * DM * DM * 2);
constexpr size_t WS_WM2 = WS_WM1 + al1((size_t)DEPTH * DFF * DM * 2);
constexpr size_t WS_WPOOL = WS_WM2 + al1((size_t)DEPTH * DFF * DM * 2);
constexpr size_t WS_WADA = WS_WPOOL + al1((size_t)DEPTH * 4 * 256 * 256 * 2);
constexpr size_t WS_SC = WS_WADA + al1((size_t)DEPTH * ADAW * DM * 2);
constexpr size_t WS_ADA = WS_SC + al1((size_t)256 * DM * 2);
constexpr size_t WS_H = WS_ADA + al1((size_t)DEPTH * NROWB * ADAW * 4);
constexpr size_t WS_Z = WS_H + al1((size_t)M * DM * 2);
constexpr size_t WS_Y = WS_Z + al1((size_t)M * ZW * 2);
constexpr size_t WS_ZP = WS_Y + al1((size_t)4 * M * BRW * 2);
constexpr size_t WS_CONVY = WS_ZP + al1((size_t)M * BRW * 2);
constexpr size_t WS_ORAW = WS_CONVY + al1((size_t)M * BRW * 4);
constexpr size_t WS_KV = WS_ORAW + al1((size_t)M * BRW * 4);
constexpr size_t WS_SPREV = WS_KV + al1((size_t)NBP * 32 * RH * RDK * RDV * 4);
constexpr size_t WS_MACC = WS_SPREV + al1((size_t)NBP * 32 * RH * RDK * RDV * 4);
constexpr size_t WS_MERGED = WS_MACC + al1((size_t)M * DM * 4);
constexpr size_t WS_X1 = WS_MERGED + al1((size_t)M * DM * 2);
constexpr size_t WS_X = WS_X1 + al1((size_t)M * DM * 4);
constexpr size_t WS_HID = WS_X + al1((size_t)M * DM * 4);
constexpr size_t WS_SLAB = WS_HID + al1((size_t)M * DFF * 2);
constexpr size_t WS_END = WS_SLAB + al1((size_t)16 * MS * DM * 4);
constexpr int CW_BAR = 4096;
constexpr int RING_OFF = 0, RING_BYTES = 131072, LDSCTL_OFF = RING_BYTES, MISC_OFF = LDSCTL_OFF + 320, INTAB_OFF = MISC_OFF + 128, LDS_BYTES = 147456;

#define GAS __attribute__((address_space(1)))
#define LAS __attribute__((address_space(3)))
typedef unsigned v4u __attribute__((ext_vector_type(4)));
typedef float f32x4 __attribute__((ext_vector_type(4)));
typedef GAS unsigned gu32;
#define RLX_AGENT __ATOMIC_RELAXED, __HIP_MEMORY_SCOPE_AGENT
#define LDS_WAIT() asm volatile("s_waitcnt lgkmcnt(0)" ::: "memory")
__device__ __forceinline__ unsigned pk2(float lo, float hi) { return (unsigned)f2bf(lo) | ((unsigned)f2bf(hi) << 16); }

#define XB_TMO      128
#define XB_XCNT(j)  (256  + 64 * (j))
#define XB_XSUB(j)  (1280 + 64 * (j))
#define XB_XGEN(j)  (2304 + 64 * (j))
#define XB_TOP      3328
#define XB_TOPGEN   3392
#define XCD_BAR_WORDS 3456
#define XB_SPIN_CAP (1u << 18)
__device__ __forceinline__ unsigned xb_ld(unsigned* p)              { return __hip_atomic_load(p, __ATOMIC_RELAXED, __HIP_MEMORY_SCOPE_AGENT); }
__device__ __forceinline__ unsigned xb_add(unsigned* p, unsigned v) { return __hip_atomic_fetch_add(p, v, __ATOMIC_RELAXED, __HIP_MEMORY_SCOPE_AGENT); }
__device__ __forceinline__ unsigned xb_xcc_id() { return (unsigned)__builtin_amdgcn_s_getreg((3 << 11) | 20) & 0xFu; }
#define XB_SPIN(cond, bar) do { unsigned _sp = 0; while (cond) { __builtin_amdgcn_s_sleep(1); \
    if ((++_sp & 255u) == 0u) { if (xb_ld(&(bar)[XB_TMO])) break; if (_sp > XB_SPIN_CAP) { atomicAdd(&(bar)[XB_TMO], 1u); break; } } } } while (0)
struct XcdBarrier { unsigned* bar; unsigned x; volatile LAS unsigned* st; };
__device__ __forceinline__ XcdBarrier xcd_barrier_post(unsigned* bar, volatile LAS unsigned* st) {
    XcdBarrier b; b.bar = bar; b.x = xb_xcc_id(); b.st = st;
    if (threadIdx.x == 0) (void)xb_add(&bar[XB_XCNT(b.x)], 1u);
    return b;
}
__device__ __forceinline__ void xcd_barrier_complete(unsigned* bar, unsigned x, unsigned& nloc, unsigned& nx) {
    const unsigned G = gridDim.x * gridDim.y * gridDim.z;
    unsigned sum, cnt, mine, sp = 0u;
    for (;;) {
        sum = 0u; cnt = 0u; mine = 0u;
#pragma unroll
        for (unsigned j = 0; j < 16; ++j) { const unsigned c = xb_ld(&bar[XB_XCNT(j)]); sum += c; cnt += (c > 0u) ? 1u : 0u; mine = (j == x) ? c : mine; }
        if (sum == G) break;
        __builtin_amdgcn_s_sleep(1);
        if ((++sp & 255u) == 0u) { if (xb_ld(&bar[XB_TMO])) break; if (sp > XB_SPIN_CAP) { atomicAdd(&bar[XB_TMO], 1u); break; } }
    }
    nloc = mine > 0u ? mine : 1u; nx = cnt > 0u ? cnt : 1u;
}
__device__ __forceinline__ void xcd_barrier(const XcdBarrier& b) {
    asm volatile("s_waitcnt vmcnt(0)" ::: "memory");
    __syncthreads();
    if (threadIdx.x == 0) {
        unsigned* bar = b.bar;
        __builtin_amdgcn_s_waitcnt(0);
        unsigned nloc = b.st[0], nx = b.st[1];
        if (nloc == 0u) { xcd_barrier_complete(bar, b.x, nloc, nx); b.st[0] = nloc; b.st[1] = nx; }
        const unsigned old = xb_add(&bar[XB_XSUB(b.x)], 1u);
        const unsigned gen = old / nloc;
        if (old + 1u == (gen + 1u) * nloc) {
            __builtin_amdgcn_fence(__ATOMIC_RELEASE, "agent");
            asm volatile("s_waitcnt vmcnt(0)" ::: "memory");
            const unsigned og = xb_add(&bar[XB_TOP], 1u);
            const unsigned tg = og / nx;
            if (og + 1u == (tg + 1u) * nx) xb_add(&bar[XB_TOPGEN], 1u);
            else XB_SPIN(xb_ld(&bar[XB_TOPGEN]) == tg, bar);
            __builtin_amdgcn_fence(__ATOMIC_ACQUIRE, "agent");
            xb_add(&bar[XB_XGEN(b.x)], 1u);
            asm volatile("s_waitcnt vmcnt(0)" ::: "memory");
        } else {
            XB_SPIN(xb_ld(&bar[XB_XGEN(b.x)]) == gen, bar);
            __builtin_amdgcn_fence(__ATOMIC_ACQUIRE, "agent");
            asm volatile("s_waitcnt vmcnt(0)" ::: "memory");
        }
    }
    __syncthreads();
}

template <int CTRL> __device__ __forceinline__ float dpp_f(float v) { return __builtin_bit_cast(float, __builtin_amdgcn_update_dpp(0, __builtin_bit_cast(int, v), CTRL, 0xf, 0xf, false)); }
__device__ __forceinline__ float wave_sum(float v) {
    v += dpp_f<0xB1>(v);
    v += dpp_f<0x4E>(v);
    v += dpp_f<0x141>(v);
    v += dpp_f<0x140>(v);
    v += __builtin_bit_cast(float, __builtin_amdgcn_ds_swizzle(__builtin_bit_cast(int, v), 0x401F));
    return __builtin_bit_cast(float, __builtin_amdgcn_readlane(__builtin_bit_cast(int, v), 0)) + __builtin_bit_cast(float, __builtin_amdgcn_readlane(__builtin_bit_cast(int, v), 32));
}
__device__ __forceinline__ void transpose_item(const float* W, int K, int N, bf16* WT, LAS float* scr, int item, int lane) {
    const int nblk = N / 32, kb = item / nblk, nb = item % nblk, k0 = 64 * kb, n0 = 32 * nb;
#pragma unroll 8
    for (int i = 0; i < 32; ++i) { const int kk = 2 * i + (lane >> 5); scr[kk * 33 + (lane & 31)] = __builtin_nontemporal_load(&W[(size_t)(k0 + kk) * N + n0 + (lane & 31)]); }
    LDS_WAIT(); asm volatile("" ::: "memory");
    const int c = lane & 7;
#pragma unroll
    for (int j = 0; j < 4; ++j) { const int n = (lane >> 3) + 8 * j; const LAS float* s = scr + (8 * c) * 33 + n;
        v4u o; o.x = pk2(s[0 * 33], s[1 * 33]); o.y = pk2(s[2 * 33], s[3 * 33]); o.z = pk2(s[4 * 33], s[5 * 33]); o.w = pk2(s[6 * 33], s[7 * 33]);
        *(GAS v4u*)(WT + (size_t)(n0 + n) * K + k0 + 8 * c) = o; }
    LDS_WAIT(); asm volatile("" ::: "memory");
}
__device__ __forceinline__ void load_mod(const float* g, const float* sc, const float* shp, f32x4 (&gm)[8], f32x4 (&sh)[8], int lane) {
#pragma unroll
    for (int j = 0; j < 8; ++j) { gm[j] = ((const f32x4*)g)[lane + 64 * j] * (((const f32x4*)sc)[lane + 64 * j] + 1.f); sh[j] = ((const f32x4*)shp)[lane + 64 * j]; }
}
__device__ __forceinline__ void norm_store(const f32x4 (&v)[8], float ss, const f32x4 (&gm)[8], const f32x4 (&sh)[8], bf16* orow, int lane) {
    const float rstd = 1.f / sqrtf(wave_sum(ss) * (1.f / DM) + EPS);
#pragma unroll
    for (int j = 0; j < 8; ++j) { const f32x4 y = v[j] * rstd * gm[j] + sh[j];
        ((unsigned long long*)orow)[lane + 64 * j] = (unsigned long long)pk2(y.x, y.y) | ((unsigned long long)pk2(y.z, y.w) << 32); }
}
__device__ __forceinline__ void norm_row2(const float* xa, const float* xb, const f32x4 (&gm)[8], const f32x4 (&sh)[8], bf16* oa, bf16* ob, int lane) {
    f32x4 va[8], vb[8]; float sa = 0.f, sb = 0.f;
#pragma unroll
    for (int j = 0; j < 8; ++j) { va[j] = ((const f32x4*)xa)[lane + 64 * j]; vb[j] = ((const f32x4*)xb)[lane + 64 * j]; }
#pragma unroll
    for (int j = 0; j < 8; ++j) { sa += (va[j].x * va[j].x + va[j].y * va[j].y) + (va[j].z * va[j].z + va[j].w * va[j].w); sb += (vb[j].x * vb[j].x + vb[j].y * vb[j].y) + (vb[j].z * vb[j].z + vb[j].w * vb[j].w); }
    norm_store(va, sa, gm, sh, oa, lane); norm_store(vb, sb, gm, sh, ob, lane);
}
__device__ __forceinline__ void norm_row(const float* xrow, const f32x4 (&gm)[8], const f32x4 (&sh)[8], bf16* orow, int lane) {
    f32x4 v[8]; float ss = 0.f;
#pragma unroll
    for (int j = 0; j < 8; ++j) { v[j] = ((const f32x4*)xrow)[lane + 64 * j]; ss += (v[j].x * v[j].x + v[j].y * v[j].y) + (v[j].z * v[j].z + v[j].w * v[j].w); }
    norm_store(v, ss, gm, sh, orow, lane);
}
template <int NP> __device__ __forceinline__ void norm_row_block(const float* base, const float* gate, const float* slab, size_t ps, float* xdst, const float* g, const float* sc, const float* shp, bf16* orow, LAS float* red, int tid, int wave) {
    f32x4 v = ((const f32x4*)base)[tid];
    if (NP > 0) { f32x4 pv[NP > 0 ? NP : 1];
#pragma unroll
        for (int p = 0; p < NP; ++p) pv[p] = ((const f32x4*)(slab + (size_t)p * ps))[tid];
        f32x4 a = pv[0];
#pragma unroll
        for (int p = 1; p < NP; ++p) a += pv[p];
        v += ((const f32x4*)gate)[tid] * a; ((f32x4*)xdst)[tid] = v; }
    const float ws = wave_sum((v.x * v.x + v.y * v.y) + (v.z * v.z + v.w * v.w));
    if ((tid & 63) == 0) red[wave] = ws;
    __syncthreads();
    float ss = 0.f;
#pragma unroll
    for (int w = 0; w < NWAVES; ++w) ss += red[w];
    const float rstd = 1.f / sqrtf(ss * (1.f / DM) + EPS);
    const f32x4 y = v * rstd * ((const f32x4*)g)[tid] * (((const f32x4*)sc)[tid] + 1.f) + ((const f32x4*)shp)[tid];
    ((unsigned long long*)orow)[tid] = (unsigned long long)pk2(y.x, y.y) | ((unsigned long long)pk2(y.z, y.w) << 32);
    __syncthreads();
}
__device__ __forceinline__ void convln_row(const float* yrow, const f32x4 (&gv4)[4], const f32x4 (&bv4)[4], bf16* orow, int lane) {
    f32x4 v[4]; float s = 0.f;
#pragma unroll
    for (int j = 0; j < 4; ++j) { v[j] = ((const f32x4*)yrow)[lane + 64 * j]; s += (v[j].x + v[j].y) + (v[j].z + v[j].w); }
    const float mean = wave_sum(s) * (1.f / BRW); float q = 0.f;
#pragma unroll
    for (int j = 0; j < 4; ++j) { v[j] = v[j] - mean; q += (v[j].x * v[j].x + v[j].y * v[j].y) + (v[j].z * v[j].z + v[j].w * v[j].w); }
    const float rstd = 1.f / sqrtf(wave_sum(q) * (1.f / BRW) + EPS);
#pragma unroll
    for (int j = 0; j < 4; ++j) { f32x4 y = v[j] * rstd * gv4[j] + bv4[j];
        y.x = y.x * sigmoidf_(y.x); y.y = y.y * sigmoidf_(y.y); y.z = y.z * sigmoidf_(y.z); y.w = y.w * sigmoidf_(y.w);
        ((unsigned long long*)orow)[lane + 64 * j] = (unsigned long long)pk2(y.x, y.y) | ((unsigned long long)pk2(y.z, y.w) << 32); }
}


namespace att {
typedef short bf16x8 __attribute__((ext_vector_type(8)));
typedef short s16x4 __attribute__((ext_vector_type(4)));
typedef float f32x4 __attribute__((ext_vector_type(4)));
typedef float f32x2_t __attribute__((ext_vector_type(2))); typedef __bf16 bf16x2_t __attribute__((ext_vector_type(2)));
constexpr int KP = 144, NROWS = 272, K_OFF = 0, V_OFF = NROWS * KP, LDS_NEED = 2 * NROWS * KP;
__device__ __forceinline__ unsigned cvtpk(float lo, float hi) { f32x2_t v = {lo, hi}; bf16x2_t b = __builtin_convertvector(v, bf16x2_t); return __builtin_bit_cast(unsigned, b); }
__device__ __forceinline__ float red4_max(float v) {
    v = fmaxf(v, __builtin_bit_cast(float, __builtin_amdgcn_ds_swizzle(__builtin_bit_cast(int, v), 0x401F)));
    unsigned x = __builtin_bit_cast(unsigned, v), y = x; asm volatile("" : "+v"(y));
    auto rr = __builtin_amdgcn_permlane32_swap(x, y, false, false); const unsigned r0 = rr[0], r1 = rr[1];
    return fmaxf(__builtin_bit_cast(float, r0), __builtin_bit_cast(float, r1)); }
__device__ __forceinline__ float red4_sum(float v) {
    v += __builtin_bit_cast(float, __builtin_amdgcn_ds_swizzle(__builtin_bit_cast(int, v), 0x401F));
    unsigned x = __builtin_bit_cast(unsigned, v), y = x; asm volatile("" : "+v"(y));
    auto rr = __builtin_amdgcn_permlane32_swap(x, y, false, false); const unsigned r0 = rr[0], r1 = rr[1];
    return __builtin_bit_cast(float, r0) + __builtin_bit_cast(float, r1); }
__device__ __forceinline__ s16x4 vtr(const LAS unsigned char* p) { typedef short v4i16_t __attribute__((ext_vector_type(4))); return __builtin_bit_cast(s16x4, __builtin_amdgcn_ds_read_tr16_b64_v4i16((LAS v4i16_t*)p)); }

__device__ __forceinline__ void tile16(const bf16x8 qf0, const bf16x8 qf1, const LAS unsigned char* Ks, const LAS unsigned char* Vs, int kbase, int wpos0, float slope2, float sink2, bf16* Yq, int nst, int lane) {
    const int c = lane & 15, g = lane >> 4;
    f32x4 st[9];
#pragma unroll
    for (int kt = 0; kt < 9; ++kt) { const LAS unsigned char* kp = Ks + (kbase + 16 * kt + c) * KP + 16 * g;
        const bf16x8 k0 = *(const LAS bf16x8*)kp, k1 = *(const LAS bf16x8*)(kp + 64);
        f32x4 a = {0.f, 0.f, 0.f, 0.f};
        a = __builtin_amdgcn_mfma_f32_16x16x32_bf16(k0, qf0, a, 0, 0, 0); a = __builtin_amdgcn_mfma_f32_16x16x32_bf16(k1, qf1, a, 0, 0, 0); st[kt] = a; }
    float SC2 = 0.125f * 1.4426950408889634f; asm volatile("" : "+v"(SC2));
    const int dbase = 128 + c - 4 * g;
    float m = sink2;
#pragma unroll
    for (int kt = 0; kt < 9; ++kt)
#pragma unroll
        for (int r = 0; r < 4; ++r) { const int dist = dbase - r - 16 * kt, kk = 16 * kt + 4 * g + r; const bool ok = (unsigned)dist <= 128u && (wpos0 + kk) >= 0;
            const float sv = ok ? st[kt][r] * SC2 - slope2 * (float)dist : -INFINITY; st[kt][r] = sv; m = fmaxf(m, sv); }
    m = red4_max(m);
    float sum = 0.f;
#pragma unroll
    for (int kt = 0; kt < 9; ++kt)
#pragma unroll
        for (int r = 0; r < 4; ++r) { const float p = __builtin_amdgcn_exp2f(st[kt][r] - m); st[kt][r] = p; sum += p; }
    sum = red4_sum(sum) + __builtin_amdgcn_exp2f(sink2 - m);
    const float inv = 1.f / sum;
    bf16x8 pf[5];
#pragma unroll
    for (int k = 0; k < 5; ++k) { unsigned w0 = cvtpk(st[2 * k][0] * inv, st[2 * k][1] * inv), w1 = cvtpk(st[2 * k][2] * inv, st[2 * k][3] * inv), w2 = 0u, w3 = 0u;
        if (k < 4) { w2 = cvtpk(st[2 * k + 1][0] * inv, st[2 * k + 1][1] * inv); w3 = cvtpk(st[2 * k + 1][2] * inv, st[2 * k + 1][3] * inv); }
        typedef unsigned u32x4_t __attribute__((ext_vector_type(4))); const u32x4_t w = {w0, w1, w2, w3}; pf[k] = __builtin_bit_cast(bf16x8, w); }
    f32x4 o[4];
#pragma unroll
    for (int dt = 0; dt < 4; ++dt) o[dt] = (f32x4){0.f, 0.f, 0.f, 0.f};
    const LAS unsigned char* vb = Vs + (kbase + 4 * g + (c >> 2)) * KP + 8 * (c & 3);
#pragma unroll
    for (int k = 0; k < 5; ++k)
#pragma unroll
        for (int dt = 0; dt < 4; ++dt) { const s16x4 lo = vtr(vb + (32 * k) * KP + 32 * dt), hi = vtr(vb + (32 * k + 16) * KP + 32 * dt);
            const bf16x8 b = {lo[0], lo[1], lo[2], lo[3], hi[0], hi[1], hi[2], hi[3]};
            o[dt] = __builtin_amdgcn_mfma_f32_16x16x32_bf16(pf[k], b, o[dt], 0, 0, 0); }
#pragma unroll
    for (int r = 0; r < 4; ++r) if (4 * g + r < nst) {
#pragma unroll
        for (int dt = 0; dt < 4; ++dt) Yq[(size_t)(4 * g + r) * BRW + 16 * dt + c] = f2bf(o[dt][r]); }
}
typedef unsigned u32x4_t __attribute__((ext_vector_type(4)));
__device__ __forceinline__ u32x4_t pack8(const float* f) { u32x4_t w; w.x = cvtpk(f[0], f[1]); w.y = cvtpk(f[2], f[3]); w.z = cvtpk(f[4], f[5]); w.w = cvtpk(f[6], f[7]); return w; }
__device__ __forceinline__ void phase(LAS unsigned char* lds, const bf16* Z, int l, const float* sinks, const float* ck, const float* cv, bf16* Y0, int bx, int G, int tid, int lane, int wave) {
    LAS unsigned char* Ks = lds + K_OFF; LAS unsigned char* Vs = lds + V_OFF;
    const u32x4_t zero4 = {0u, 0u, 0u, 0u};
    for (int it = bx; it < NBP * 32 * NKV + SB * NKV; it += G) {
        const int kvh = it & 3;
        if (it < NBP * 32 * NKV) {
            const int b = it >> 7, qb = (it >> 2) & 31;
#pragma unroll
            for (int i = 0; i < 4; ++i) { const int p = tid + NTHR * i, sr = p >> 3, cc = p & 7; const int pos = 128 * (qb - 1) + sr;
                u32x4_t kq = zero4, vq = zero4;
                if (pos >= 0) { const bf16* zr = Z + (size_t)(b * SEQ + pos) * ZW + kvh * 64 + cc * 8; kq = *(const u32x4_t*)(zr + ZK); vq = *(const u32x4_t*)(zr + ZV); }
                *(LAS u32x4_t*)(Ks + sr * KP + cc * 16) = kq; *(LAS u32x4_t*)(Vs + sr * KP + cc * 16) = vq; }
            if (tid < 128) { const int sr = 256 + (tid >> 3), cc = tid & 7; *(LAS u32x4_t*)(Ks + sr * KP + cc * 16) = zero4; *(LAS u32x4_t*)(Vs + sr * KP + cc * 16) = zero4; }
            __syncthreads();
            const int hq = kvh * 4 + (wave >> 1), qh = wave & 1;
            const float slope2 = exp2f(-0.5f * (float)(hq + 1)) * 1.4426950408889634f, sink2 = sinks[l * NH + hq] * 1.4426950408889634f;
            const bf16* qp0 = Z + ((size_t)b * SEQ + 128 * qb + 64 * qh + (lane & 15)) * ZW + ZQ + hq * 64 + 8 * (lane >> 4);
            bf16x8 qc0 = *(const bf16x8*)qp0, qc1 = *(const bf16x8*)(qp0 + 32);
#pragma unroll 1
            for (int qt = 0; qt < 4; ++qt) { const int t1 = 64 * qh + 16 * qt; const size_t qrow0 = (size_t)b * SEQ + 128 * qb + t1;
                const bf16* qpn = qp0 + (size_t)(16 * (qt < 3 ? qt + 1 : 3)) * ZW; const bf16x8 qn0 = *(const bf16x8*)qpn, qn1 = *(const bf16x8*)(qpn + 32);
                tile16(qc0, qc1, Ks, Vs, t1, 128 * qb + t1 - 128, slope2, sink2, Y0 + qrow0 * BRW + hq * 64, 16, lane);
                qc0 = qn0; qc1 = qn1; }
        } else {
            const int sb = (it - NBP * 32 * NKV) >> 2;
#pragma unroll
            for (int i = 0; i < 3; ++i) { const int p = tid + NTHR * i, sr = p >> 3, cc = p & 7;
                if (sr < 160) { u32x4_t kq = zero4, vq = zero4;
                    if (sr < WIN) { const size_t o = ((((size_t)l * SB + sb) * WIN + sr) * NKV + kvh) * 64 + cc * 8; float f[8];
#pragma unroll
                        for (int e = 0; e < 8; ++e) f[e] = ck[o + e];
                        kq = pack8(f);
#pragma unroll
                        for (int e = 0; e < 8; ++e) f[e] = cv[o + e];
                        vq = pack8(f);
                    } else if (sr < WIN + ST) { const bf16* zr = Z + (size_t)(MP + sb * ST + (sr - WIN)) * ZW + kvh * 64 + cc * 8; kq = *(const u32x4_t*)(zr + ZK); vq = *(const u32x4_t*)(zr + ZV); }
                    *(LAS u32x4_t*)(Ks + sr * KP + cc * 16) = kq; *(LAS u32x4_t*)(Vs + sr * KP + cc * 16) = vq; } }
            __syncthreads();
            if (wave < 4) { const int hq = kvh * 4 + wave;
                const float slope2 = exp2f(-0.5f * (float)(hq + 1)) * 1.4426950408889634f, sink2 = sinks[l * NH + hq] * 1.4426950408889634f;
                const size_t qrow0 = (size_t)MP + sb * ST; const bf16* qp = Z + (qrow0 + (lane & 7)) * ZW + ZQ + hq * 64 + 8 * (lane >> 4);
                tile16(*(const bf16x8*)qp, *(const bf16x8*)(qp + 32), Ks, Vs, 0, 0, slope2, sink2, Y0 + qrow0 * BRW + hq * 64, ST, lane); }
        }
        __syncthreads();
    }
}
}

namespace ret {
using att::bf16x8; using att::s16x4; using att::f32x4; using att::u32x4_t; using att::vtr; using att::cvtpk; using att::pack8;
constexpr int KP = 144, VP = 288, K_OFF = 0, V_OFF = 128 * KP, S_OFF = V_OFF + 128 * VP, LDS_NEED = S_OFF + 64 * VP;
template <int CTRL> __device__ __forceinline__ float dppf(float v) { return __builtin_bit_cast(float, __builtin_amdgcn_update_dpp(0, __builtin_bit_cast(int, v), CTRL, 0xf, 0xf, false)); }
__device__ __forceinline__ float sum16(float v) { v += dppf<0xB1>(v); v += dppf<0x4E>(v); v += dppf<0x141>(v); v += dppf<0x140>(v); return v; }
__device__ __forceinline__ void out_phase(LAS unsigned char* lds, const bf16* Z, int l, const float* SPREV, const float* gret, bf16* Y3, int bx, int G, int tid, int lane, int wave) {
    LAS unsigned char* Ks = lds + K_OFF; LAS unsigned char* Vs = lds + V_OFF; LAS unsigned char* Ss = lds + S_OFF;
    const int c = lane & 15, g = lane >> 4;
    for (int it = bx; it < NBP * 32 * RH; it += G) {
        const int b = it >> 8, n = (it >> 3) & 31, h = it & 7; const size_t row0 = (size_t)b * SEQ + n * 128;
#pragma unroll
        for (int i = 0; i < 2; ++i) { const int p = tid + NTHR * i, j = p >> 3, cc = p & 7; *(LAS u32x4_t*)(Ks + j * KP + cc * 16) = *(const u32x4_t*)(Z + (row0 + j) * ZW + ZRK + h * 64 + cc * 8); }
#pragma unroll
        for (int i = 0; i < 4; ++i) { const int p = tid + NTHR * i, j = p >> 4, cc = p & 15; *(LAS u32x4_t*)(Vs + j * VP + cc * 16) = *(const u32x4_t*)(Z + (row0 + j) * ZW + ZRV + h * 128 + cc * 8); }
#pragma unroll
        for (int i = 0; i < 2; ++i) { const int p = tid + NTHR * i, d = p >> 4, cc = p & 15; const float* sp = SPREV + ((((size_t)b * 32 + n) * RH + h) * RDK + d) * RDV + cc * 8; float f[8];
#pragma unroll
            for (int e = 0; e < 8; ++e) f[e] = sp[e];
            *(LAS u32x4_t*)(Ss + d * VP + cc * 16) = pack8(f); }
        __syncthreads();
        const int w = wave; const float lg2 = ret_logg(h) * 1.4426950408889634f;
        const bf16* qp = Z + (row0 + 16 * w + c) * ZW + ZRQ + h * 64 + 8 * g;
        const bf16x8 qf0 = *(const bf16x8*)qp, qf1 = *(const bf16x8*)(qp + 32);
        f32x4 o[8];
#pragma unroll
        for (int vt = 0; vt < 8; ++vt) o[vt] = (f32x4){0.f, 0.f, 0.f, 0.f};
#pragma unroll
        for (int ks = 0; ks < 2; ++ks) { const LAS unsigned char* sb = Ss + (32 * ks + 8 * g + (c >> 2)) * VP + 8 * (c & 3);
#pragma unroll
            for (int vt = 0; vt < 8; ++vt) { const s16x4 lo = vtr(sb + 32 * vt), hi = vtr(sb + 4 * VP + 32 * vt); const bf16x8 bb = {lo[0], lo[1], lo[2], lo[3], hi[0], hi[1], hi[2], hi[3]};
                o[vt] = __builtin_amdgcn_mfma_f32_16x16x32_bf16(ks ? qf1 : qf0, bb, o[vt], 0, 0, 0); } }
#pragma unroll
        for (int r = 0; r < 4; ++r) { const float cf = __builtin_amdgcn_exp2f(lg2 * (float)(16 * w + 4 * g + r + 1));
#pragma unroll
            for (int vt = 0; vt < 8; ++vt) o[vt][r] *= cf; }
        for (int ks = 0; ks <= (w >> 1); ++ks) {
            f32x4 st[2];
#pragma unroll
            for (int t = 0; t < 2; ++t) { const int jt = 2 * ks + t; f32x4 a = {0.f, 0.f, 0.f, 0.f};
                if (jt <= w) { const LAS unsigned char* kp = Ks + (16 * jt + c) * KP + 16 * g; const bf16x8 k0 = *(const LAS bf16x8*)kp, k1 = *(const LAS bf16x8*)(kp + 64);
                    a = __builtin_amdgcn_mfma_f32_16x16x32_bf16(k0, qf0, a, 0, 0, 0); a = __builtin_amdgcn_mfma_f32_16x16x32_bf16(k1, qf1, a, 0, 0, 0);
#pragma unroll
                    for (int r = 0; r < 4; ++r) { const int dij = (16 * w + c) - (16 * jt + 4 * g + r); a[r] = dij >= 0 ? a[r] * 0.125f * __builtin_amdgcn_exp2f(lg2 * (float)dij) : 0.f; } }
                st[t] = a; }
            const u32x4_t pw = {cvtpk(st[0][0], st[0][1]), cvtpk(st[0][2], st[0][3]), cvtpk(st[1][0], st[1][1]), cvtpk(st[1][2], st[1][3])}; const bf16x8 pf = __builtin_bit_cast(bf16x8, pw);
            const LAS unsigned char* vb = Vs + (32 * ks + 4 * g + (c >> 2)) * VP + 8 * (c & 3);
#pragma unroll
            for (int vt = 0; vt < 8; ++vt) { const s16x4 lo = vtr(vb + 32 * vt), hi = vtr(vb + 16 * VP + 32 * vt); const bf16x8 bb = {lo[0], lo[1], lo[2], lo[3], hi[0], hi[1], hi[2], hi[3]};
                o[vt] = __builtin_amdgcn_mfma_f32_16x16x32_bf16(pf, bb, o[vt], 0, 0, 0); }
        }
        float mean[4], rstd[4];
#pragma unroll
        for (int r = 0; r < 4; ++r) { float sm = 0.f;
#pragma unroll
            for (int vt = 0; vt < 8; ++vt) sm += o[vt][r];
            mean[r] = sum16(sm) * (1.f / 128.f); float q = 0.f;
#pragma unroll
            for (int vt = 0; vt < 8; ++vt) { const float dd = o[vt][r] - mean[r]; q += dd * dd; }
            rstd[r] = 1.f / sqrtf(sum16(q) * (1.f / 128.f) + EPS); }
        const float* gp = gret + l * BRW + h * 128 + c;
        float gv[8]; bf16 rgv[4][8];
#pragma unroll
        for (int vt = 0; vt < 8; ++vt) gv[vt] = gp[16 * vt];
#pragma unroll
        for (int r = 0; r < 4; ++r) { const bf16* rg = Z + (row0 + 16 * w + 4 * g + r) * ZW + ZRG + h * 128 + c;
#pragma unroll
            for (int vt = 0; vt < 8; ++vt) rgv[r][vt] = rg[16 * vt]; }
        asm volatile("" ::: "memory");
#pragma unroll
        for (int r = 0; r < 4; ++r) { bf16* y = Y3 + (row0 + 16 * w + 4 * g + r) * BRW + h * 128 + c;
#pragma unroll
            for (int vt = 0; vt < 8; ++vt) y[16 * vt] = f2bf((o[vt][r] - mean[r]) * rstd[r] * gv[vt] * bf2f(rgv[r][vt])); }
        __syncthreads();
    }
}

__device__ __forceinline__ void kv_phase(LAS unsigned char* lds, const bf16* Z, float* KV, int bx, int G, int tid, int lane, int wave) {
    LAS unsigned char* Ks = lds + K_OFF; LAS unsigned char* Vs = lds + V_OFF;
    const int c = lane & 15, g = lane >> 4;
    for (int it = bx; it < NBP * 32 * RH; it += G) {
        const int b = it >> 8, n = (it >> 3) & 31, h = it & 7; const size_t row0 = (size_t)b * SEQ + n * 128;
        const float lg2 = ret_logg(h) * 1.4426950408889634f;
#pragma unroll
        for (int i = 0; i < 2; ++i) { const int p = tid + NTHR * i, j = p >> 3, cc = p & 7; float f[8]; ld8(Z + (row0 + j) * ZW + ZRK + h * 64 + cc * 8, f);
            const float sc = 0.125f * __builtin_amdgcn_exp2f(lg2 * (float)(127 - j));
#pragma unroll
            for (int e = 0; e < 8; ++e) f[e] *= sc;
            *(LAS u32x4_t*)(Ks + j * KP + cc * 16) = pack8(f); }
#pragma unroll
        for (int i = 0; i < 4; ++i) { const int p = tid + NTHR * i, j = p >> 4, cc = p & 15; *(LAS u32x4_t*)(Vs + j * VP + cc * 16) = *(const u32x4_t*)(Z + (row0 + j) * ZW + ZRV + h * 128 + cc * 8); }
        __syncthreads();
        const int dt = wave & 3, vt0 = (wave >> 2) * 4;
        f32x4 acc[4];
#pragma unroll
        for (int t = 0; t < 4; ++t) acc[t] = (f32x4){0.f, 0.f, 0.f, 0.f};
#pragma unroll
        for (int ks = 0; ks < 4; ++ks) { const LAS unsigned char* ka = Ks + (32 * ks + 8 * g + (c >> 2)) * KP + 32 * dt + 8 * (c & 3);
            const s16x4 alo = vtr(ka), ahi = vtr(ka + 4 * KP); const bf16x8 af = {alo[0], alo[1], alo[2], alo[3], ahi[0], ahi[1], ahi[2], ahi[3]};
            const LAS unsigned char* vb = Vs + (32 * ks + 8 * g + (c >> 2)) * VP + 8 * (c & 3);
#pragma unroll
            for (int t = 0; t < 4; ++t) { const s16x4 lo = vtr(vb + 32 * (vt0 + t)), hi = vtr(vb + 4 * VP + 32 * (vt0 + t)); const bf16x8 bb = {lo[0], lo[1], lo[2], lo[3], hi[0], hi[1], hi[2], hi[3]};
                acc[t] = __builtin_amdgcn_mfma_f32_16x16x32_bf16(af, bb, acc[t], 0, 0, 0); } }
        float* kvp = KV + ((((size_t)b * 32 + n) * RH + h) * RDK + 16 * dt + 4 * g) * RDV + c;
#pragma unroll
        for (int r = 0; r < 4; ++r)
#pragma unroll
            for (int t = 0; t < 4; ++t) kvp[(size_t)r * RDV + 16 * (vt0 + t)] = acc[t][r];
        __syncthreads();
    }
}
}

namespace mixl {
using att::u32x4_t; using att::f32x4;
template <int CTRL> __device__ __forceinline__ float dppf(float v) { return __builtin_bit_cast(float, __builtin_amdgcn_update_dpp(0, __builtin_bit_cast(int, v), CTRL, 0xf, 0xf, false)); }
__device__ __forceinline__ float sum8(float v) { v += dppf<0xB1>(v); v += dppf<0x4E>(v); v += dppf<0x141>(v); return v; }
struct QkRow { float q0[8], q1[8], kv[8]; };
__device__ __forceinline__ void qk_load(const bf16* zr, QkRow& R, int lane) { ld8(zr + ZQ + lane * 8, R.q0); ld8(zr + ZQ + 512 + lane * 8, R.q1); ld8(zr + ZK + lane * 8, R.kv); }
__device__ __forceinline__ void qk_finish(bf16* zr, int row, int l, QkRow& R, const float (&g8q)[8], const float (&g8k)[8], float* out, int lane) {
    float s0 = 0.f, s1 = 0.f, s2 = 0.f;
#pragma unroll
    for (int e = 0; e < 8; ++e) { s0 += R.q0[e] * R.q0[e]; s1 += R.q1[e] * R.q1[e]; s2 += R.kv[e] * R.kv[e]; }
    const float r0 = 1.f / sqrtf(sum8(s0) * (1.f / 64.f) + EPS), r1 = 1.f / sqrtf(sum8(s1) * (1.f / 64.f) + EPS), r2 = 1.f / sqrtf(sum8(s2) * (1.f / 64.f) + EPS);
#pragma unroll
    for (int e = 0; e < 8; ++e) { R.q0[e] *= r0 * g8q[e]; R.q1[e] *= r1 * g8q[e]; if (lane < 32) R.kv[e] *= r2 * g8k[e]; }
    st8(zr + ZQ + lane * 8, R.q0); st8(zr + ZQ + 512 + lane * 8, R.q1);
    if (lane < 32) st8(zr + ZK + lane * 8, R.kv);
    float* o = nullptr;
    if (row < MP) { const int b = row >> 12, t = row & (SEQ - 1); if (t >= SEQ - WIN) o = out + (lane < 32 ? O_KP : O_VP) + (((size_t)l * NBP + b) * WIN + (t - (SEQ - WIN))) * 256 + (lane & 31) * 8; }
    else { const int sb = (row - MP) >> 3, t = (row - MP) & 7; o = out + (lane < 32 ? O_KS : O_VS) + (((size_t)l * SB + sb) * WIN + (WIN - ST + t)) * 256 + (lane & 31) * 8; }
    if (o) { *(f32x4*)o = (f32x4){R.kv[0], R.kv[1], R.kv[2], R.kv[3]}; *(f32x4*)(o + 4) = (f32x4){R.kv[4], R.kv[5], R.kv[6], R.kv[7]}; }
}
__device__ __forceinline__ void qknorm_phase(bf16* Z, int l, const float* gq, const float* gk, float* out, int gw, int NGW, int lane) {
    float g8q[8], g8k[8];
#pragma unroll
    for (int e = 0; e < 8; ++e) { g8q[e] = gq[l * 64 + (lane & 7) * 8 + e]; g8k[e] = gk[l * 64 + (lane & 7) * 8 + e]; }
    for (int row = gw; row < M; row += 2 * NGW) { const int rowb = row + NGW; const bool two = rowb < M;
        bf16* za = Z + (size_t)row * ZW; bf16* zb = Z + (size_t)(two ? rowb : row) * ZW;
        QkRow A, B; qk_load(za, A, lane); qk_load(zb, B, lane);
        asm volatile("" ::: "memory");
        qk_finish(za, row, l, A, g8q, g8k, out, lane);
        if (two) qk_finish(zb, rowb, l, B, g8q, g8k, out, lane);
    }
}
constexpr int CV_RB = 64, CV_CB = 128, CV_UR = CV_RB + CPRE, CV_NPI = (MP / CV_RB) * 8, CV_NSI = SB * 8;
struct CvItem { bool smp; int cb, b, t0, nrows; size_t rowb; };
__device__ __forceinline__ CvItem cv_item(int it) { CvItem I; I.smp = it >= CV_NPI; I.cb = it & 7; I.b = I.smp ? (it - CV_NPI) >> 3 : (it >> 3) >> 6; I.t0 = I.smp ? 0 : ((it >> 3) & 63) * CV_RB; I.nrows = I.smp ? ST : CV_RB;
    I.rowb = I.smp ? (size_t)MP + I.b * ST : (size_t)I.b * SEQ; return I; }
__device__ __forceinline__ void cv_fetch(const bf16* Z, int l, const float* sconv, const CvItem& I, u32x4_t (&raw)[3][2], int tid) {
#pragma unroll
    for (int i = 0; i < 3; ++i) { const int p = tid + NTHR * i, ur = p >> 4, c8 = p & 15, tt = I.t0 - CPRE + ur; raw[i][0] = (u32x4_t){0u, 0u, 0u, 0u}; raw[i][1] = raw[i][0];
        if (ur < I.nrows + CPRE) {
            if (tt >= 0) { const bf16* zp = Z + (I.rowb + tt) * ZW + I.cb * CV_CB + c8 * 8; raw[i][0] = *(const u32x4_t*)(zp + ZCA); raw[i][1] = *(const u32x4_t*)(zp + ZCG); }
            else if (I.smp) { const float* sp = sconv + (((size_t)l * SB + I.b) * CPRE + (CPRE + tt)) * BRW + I.cb * CV_CB + c8 * 8; raw[i][0] = *(const u32x4_t*)sp; raw[i][1] = *(const u32x4_t*)(sp + 4); } } }
}
__device__ __forceinline__ void conv_phase(LAS unsigned char* lds, const bf16* Z, int l, const float* wdw, const float* bdw, const float* sconv, float* CONVY, float* out, int bx, int G, int tid) {
    LAS float* U = (LAS float*)lds;
    auto unp = [](const u32x4_t w, float* f) { f[0] = __builtin_bit_cast(float, w.x << 16); f[1] = __builtin_bit_cast(float, w.x & 0xffff0000u); f[2] = __builtin_bit_cast(float, w.y << 16); f[3] = __builtin_bit_cast(float, w.y & 0xffff0000u);
        f[4] = __builtin_bit_cast(float, w.z << 16); f[5] = __builtin_bit_cast(float, w.z & 0xffff0000u); f[6] = __builtin_bit_cast(float, w.w << 16); f[7] = __builtin_bit_cast(float, w.w & 0xffff0000u); };
    u32x4_t raw[3][2];
    if (bx < CV_NPI + CV_NSI) { const CvItem I0 = cv_item(bx); cv_fetch(Z, l, sconv, I0, raw, tid); }
    for (int it = bx; it < CV_NPI + CV_NSI; it += G) {
        const CvItem I = cv_item(it);
        const int c = tid & 127, r0 = (tid >> 7) * 16, ch = I.cb * CV_CB + c; float w[CONVK];
#pragma unroll
        for (int j = 0; j < CONVK; ++j) w[j] = wdw[((size_t)l * CONVK + j) * BRW + ch];
        const float bias = bdw[l * BRW + ch];
#pragma unroll
        for (int i = 0; i < 3; ++i) { const int p = tid + NTHR * i, ur = p >> 4, c8 = p & 15, tt = I.t0 - CPRE + ur; float u[8];
            if (ur < I.nrows + CPRE) {
                if (tt >= 0) { float av[8], gg[8]; unp(raw[i][0], av); unp(raw[i][1], gg);
#pragma unroll
                    for (int e = 0; e < 8; ++e) u[e] = av[e] * sigmoidf_(gg[e]);
                    if (ur >= CPRE) { float* o = nullptr;
                        if (!I.smp) { if (tt >= SEQ - CPRE) o = out + O_CP + (((size_t)l * NBP + I.b) * CPRE + (tt - (SEQ - CPRE))) * BRW + I.cb * CV_CB + c8 * 8; }
                        else o = out + O_CS + (((size_t)l * SB + I.b) * CPRE + (CPRE - ST + tt)) * BRW + I.cb * CV_CB + c8 * 8;
                        if (o) { *(f32x4*)o = (f32x4){u[0], u[1], u[2], u[3]}; *(f32x4*)(o + 4) = (f32x4){u[4], u[5], u[6], u[7]}; } }
                } else {
                    const unsigned r0_ = raw[i][0].x, r1_ = raw[i][0].y, r2_ = raw[i][0].z, r3_ = raw[i][0].w, r4_ = raw[i][1].x, r5_ = raw[i][1].y, r6_ = raw[i][1].z, r7_ = raw[i][1].w;
                    u[0] = __builtin_bit_cast(float, r0_); u[1] = __builtin_bit_cast(float, r1_); u[2] = __builtin_bit_cast(float, r2_); u[3] = __builtin_bit_cast(float, r3_);
                    u[4] = __builtin_bit_cast(float, r4_); u[5] = __builtin_bit_cast(float, r5_); u[6] = __builtin_bit_cast(float, r6_); u[7] = __builtin_bit_cast(float, r7_); }
                *(LAS f32x4*)(U + ur * CV_CB + c8 * 8) = (f32x4){u[0], u[1], u[2], u[3]}; *(LAS f32x4*)(U + ur * CV_CB + c8 * 8 + 4) = (f32x4){u[4], u[5], u[6], u[7]}; } }
        __syncthreads();
        if (it + G < CV_NPI + CV_NSI) { const CvItem In = cv_item(it + G); cv_fetch(Z, l, sconv, In, raw, tid); }
        if (r0 < I.nrows) {
            float u[16 + CPRE];
#pragma unroll
            for (int k = 0; k < 16 + CPRE; ++k) u[k] = U[(r0 + k) * CV_CB + c];
#pragma unroll
            for (int r = 0; r < 16; ++r) { float acc = bias;
#pragma unroll
                for (int j = 0; j < CONVK; ++j) acc += w[j] * u[r + j];
                if (r0 + r < I.nrows) CONVY[(I.rowb + I.t0 + r0 + r) * BRW + ch] = acc; }
        }
        __syncthreads();
    }
}

constexpr int CF_RB = 32, CF_UP = 2064  , CF_NPI = MP / CF_RB, CF_NSI = SB, CF_RED = RING_BYTES + 2048;
__device__ __forceinline__ void convln_phase(LAS unsigned char* L, const bf16* Z, int l, const float* wdw, const float* bdw, const float* gln, const float* bln, const float* sconv, bf16* Y1, float* out, int bx, int G, int tid, int wave) {
    LAS unsigned char* Ut = L + RING_OFF; LAS float* RA = (LAS float*)(L + CF_RED); LAS float* RB = RA + 16 * 8;
    auto unp = [](const u32x4_t w, float* f) { f[0] = __builtin_bit_cast(float, w.x << 16); f[1] = __builtin_bit_cast(float, w.x & 0xffff0000u); f[2] = __builtin_bit_cast(float, w.y << 16); f[3] = __builtin_bit_cast(float, w.y & 0xffff0000u);
        f[4] = __builtin_bit_cast(float, w.z << 16); f[5] = __builtin_bit_cast(float, w.z & 0xffff0000u); f[6] = __builtin_bit_cast(float, w.w << 16); f[7] = __builtin_bit_cast(float, w.w & 0xffff0000u); };
    const int c0 = 2 * tid;
    for (int it = bx; it < CF_NPI + CF_NSI; it += G) {
        const bool smp = it >= CF_NPI; const int b = smp ? it - CF_NPI : it >> 7, t0 = smp ? 0 : (it & 127) * CF_RB, nrows = smp ? ST : CF_RB, nst = nrows + CPRE;
        const size_t rowb = smp ? (size_t)MP + b * ST : (size_t)b * SEQ;
#pragma unroll 1
        for (int i0 = 0; i0 < 16; i0 += 4) { u32x4_t ra[4], rg[4];
#pragma unroll
            for (int k = 0; k < 4; ++k) { const int p = tid + NTHR * (i0 + k), ur = p >> 7, c8 = p & 127, tt = t0 - CPRE + ur; ra[k] = (u32x4_t){0u, 0u, 0u, 0u}; rg[k] = ra[k];
                if (ur < nst) { if (tt >= 0) { const bf16* zp = Z + (rowb + tt) * ZW + c8 * 8; ra[k] = *(const u32x4_t*)(zp + ZCA); rg[k] = *(const u32x4_t*)(zp + ZCG); }
                    else if (smp) { const float* sp = sconv + (((size_t)l * SB + b) * CPRE + (CPRE + tt)) * BRW + c8 * 8; ra[k] = *(const u32x4_t*)sp; rg[k] = *(const u32x4_t*)(sp + 4); } } }
            asm volatile("" ::: "memory");
#pragma unroll
            for (int k = 0; k < 4; ++k) { const int p = tid + NTHR * (i0 + k), ur = p >> 7, c8 = p & 127, tt = t0 - CPRE + ur; float u[8];
                if (ur < nst) {
                    if (tt >= 0) { float av[8], gg[8]; unp(ra[k], av); unp(rg[k], gg);
#pragma unroll
                        for (int e = 0; e < 8; ++e) u[e] = av[e] * sigmoidf_(gg[e]);
                        if (ur >= CPRE) { float* o = nullptr;
                            if (!smp) { if (tt >= SEQ - CPRE) o = out + O_CP + (((size_t)l * NBP + b) * CPRE + (tt - (SEQ - CPRE))) * BRW + c8 * 8; }
                            else o = out + O_CS + (((size_t)l * SB + b) * CPRE + (CPRE - ST + tt)) * BRW + c8 * 8;
                            if (o) { *(f32x4*)o = (f32x4){u[0], u[1], u[2], u[3]}; *(f32x4*)(o + 4) = (f32x4){u[4], u[5], u[6], u[7]}; } }
                    } else { const unsigned r0_ = ra[k].x, r1_ = ra[k].y, r2_ = ra[k].z, r3_ = ra[k].w, r4_ = rg[k].x, r5_ = rg[k].y, r6_ = rg[k].z, r7_ = rg[k].w;
                        u[0] = __builtin_bit_cast(float, r0_); u[1] = __builtin_bit_cast(float, r1_); u[2] = __builtin_bit_cast(float, r2_); u[3] = __builtin_bit_cast(float, r3_);
                        u[4] = __builtin_bit_cast(float, r4_); u[5] = __builtin_bit_cast(float, r5_); u[6] = __builtin_bit_cast(float, r6_); u[7] = __builtin_bit_cast(float, r7_); }
                    u32x4_t w; w.x = pk2(u[0], u[1]); w.y = pk2(u[2], u[3]); w.z = pk2(u[4], u[5]); w.w = pk2(u[6], u[7]);
                    *(LAS u32x4_t*)(Ut + ur * CF_UP + c8 * 16) = w; } } }
        float w0[CONVK], w1[CONVK];
#pragma unroll
        for (int j = 0; j < CONVK; ++j) { const float2 wv = *(const float2*)(wdw + ((size_t)l * CONVK + j) * BRW + c0); w0[j] = wv.x; w1[j] = wv.y; }
        const float2 bias = *(const float2*)(bdw + l * BRW + c0), gv = *(const float2*)(gln + l * BRW + c0), bv = *(const float2*)(bln + l * BRW + c0);
        __syncthreads();
#pragma unroll 1
        for (int hf = 0; hf < 4; ++hf) { const int r0 = 8 * hf; if (r0 >= nrows) break;
            float u0[8 + CPRE], u1[8 + CPRE];
#pragma unroll
            for (int k = 0; k < 8 + CPRE; ++k) { const unsigned w = *(const LAS unsigned*)(Ut + (r0 + k) * CF_UP + tid * 4); u0[k] = __builtin_bit_cast(float, w << 16); u1[k] = __builtin_bit_cast(float, w & 0xffff0000u); }
            float y0[8], y1[8];
#pragma unroll
            for (int r = 0; r < 8; ++r) { float a0 = bias.x, a1 = bias.y;
#pragma unroll
                for (int j = 0; j < CONVK; ++j) { a0 += w0[j] * u0[r + j]; a1 += w1[j] * u1[r + j]; }
                y0[r] = a0; y1[r] = a1; }
#pragma unroll
            for (int r = 0; r < 8; ++r) { const float sm = wave_sum(y0[r] + y1[r]); if ((tid & 63) == 0) RA[r * 8 + wave] = sm; }
            __syncthreads();
#pragma unroll
            for (int r = 0; r < 8; ++r) { float sm = 0.f;
#pragma unroll
                for (int w = 0; w < 8; ++w) sm += RA[r * 8 + w];
                const float mean = sm * (1.f / BRW); y0[r] -= mean; y1[r] -= mean;
                const float q = wave_sum(y0[r] * y0[r] + y1[r] * y1[r]); if ((tid & 63) == 0) RB[r * 8 + wave] = q; }
            __syncthreads();
#pragma unroll
            for (int r = 0; r < 8; ++r) { float q = 0.f;
#pragma unroll
                for (int w = 0; w < 8; ++w) q += RB[r * 8 + w];
                const float rstd = 1.f / sqrtf(q * (1.f / BRW) + EPS);
                float v0 = y0[r] * rstd * gv.x + bv.x, v1 = y1[r] * rstd * gv.y + bv.y; v0 *= sigmoidf_(v0); v1 *= sigmoidf_(v1);
                if (r0 + r < nrows) *(unsigned*)(Y1 + (rowb + t0 + r0 + r) * BRW + c0) = pk2(v0, v1); }
        }
        __syncthreads();
    }
}
template <int W> __device__ __forceinline__ void pool_run(const bf16* Z, int l, int b, int t0, int cch, bf16* ZP, float* out) {
    const size_t rowb = (size_t)b * SEQ; u32x4_t rw[23];
#pragma unroll
    for (int k = 16 - W; k < 23; ++k) { const int tt = t0 - 15 + k; rw[k] = (u32x4_t){0u, 0u, 0u, 0u}; if (tt >= 0) rw[k] = *(const u32x4_t*)(Z + (rowb + tt) * ZW + ZPL + cch); }
    float S[8];
#pragma unroll
    for (int e = 0; e < 8; ++e) S[e] = 0.f;
    auto unp = [](const u32x4_t w, float* f) { f[0] = __builtin_bit_cast(float, w.x << 16); f[1] = __builtin_bit_cast(float, w.x & 0xffff0000u); f[2] = __builtin_bit_cast(float, w.y << 16); f[3] = __builtin_bit_cast(float, w.y & 0xffff0000u);
        f[4] = __builtin_bit_cast(float, w.z << 16); f[5] = __builtin_bit_cast(float, w.z & 0xffff0000u); f[6] = __builtin_bit_cast(float, w.w << 16); f[7] = __builtin_bit_cast(float, w.w & 0xffff0000u); };
#pragma unroll
    for (int k = 16 - W; k < 15; ++k) { float f[8]; unp(rw[k], f);
#pragma unroll
        for (int e = 0; e < 8; ++e) S[e] += f[e]; }
#pragma unroll
    for (int r = 0; r < 8; ++r) { const int t = t0 + r; float u[8], o[8], f[8]; unp(rw[15 + r], u);
        const float inv = 1.f / (float)((t + 1) < W ? (t + 1) : W);
#pragma unroll
        for (int e = 0; e < 8; ++e) { S[e] += u[e]; o[e] = S[e] * inv - u[e]; }
        st8(ZP + (rowb + t) * BRW + cch, o);
        if (t >= SEQ - PPAD) { float* so = out + O_PP + (((size_t)l * NBP + b) * PPAD + (t - (SEQ - PPAD))) * BRW + cch; *(f32x4*)so = (f32x4){u[0], u[1], u[2], u[3]}; *(f32x4*)(so + 4) = (f32x4){u[4], u[5], u[6], u[7]}; }
        unp(rw[15 + r - W + 1], f);
#pragma unroll
        for (int e = 0; e < 8; ++e) S[e] -= f[e]; }
}
template <int W> __device__ __forceinline__ void pool_run_s(const bf16* Z, int l, int b, int cch, const float* spool, bf16* ZP, float* out) {
    const size_t rowb = (size_t)MP + b * ST; const float* sp = spool + (((size_t)l * SB + b) * PPAD) * BRW + cch;
    f32x4 pf[W - 1][2]; u32x4_t rw[ST];
#pragma unroll
    for (int k = 0; k < W - 1; ++k) { pf[k][0] = *(const f32x4*)(sp + (size_t)(PPAD - (W - 1) + k) * BRW); pf[k][1] = *(const f32x4*)(sp + (size_t)(PPAD - (W - 1) + k) * BRW + 4); }
#pragma unroll
    for (int t = 0; t < ST; ++t) rw[t] = *(const u32x4_t*)(Z + (rowb + t) * ZW + ZPL + cch);
    auto unp = [](const u32x4_t w, float* f) { f[0] = __builtin_bit_cast(float, w.x << 16); f[1] = __builtin_bit_cast(float, w.x & 0xffff0000u); f[2] = __builtin_bit_cast(float, w.y << 16); f[3] = __builtin_bit_cast(float, w.y & 0xffff0000u);
        f[4] = __builtin_bit_cast(float, w.z << 16); f[5] = __builtin_bit_cast(float, w.z & 0xffff0000u); f[6] = __builtin_bit_cast(float, w.w << 16); f[7] = __builtin_bit_cast(float, w.w & 0xffff0000u); };
    float S[8];
#pragma unroll
    for (int e = 0; e < 8; ++e) S[e] = 0.f;
#pragma unroll
    for (int k = 0; k < W - 1; ++k) { S[0] += pf[k][0].x; S[1] += pf[k][0].y; S[2] += pf[k][0].z; S[3] += pf[k][0].w; S[4] += pf[k][1].x; S[5] += pf[k][1].y; S[6] += pf[k][1].z; S[7] += pf[k][1].w; }
    const float inv = 1.f / (float)W;
#pragma unroll
    for (int t = 0; t < ST; ++t) { float u[8], o[8], f[8]; unp(rw[t], u);
#pragma unroll
        for (int e = 0; e < 8; ++e) { S[e] += u[e]; o[e] = S[e] * inv - u[e]; }
        st8(ZP + (rowb + t) * BRW + cch, o);
        float* so = out + O_PS + (((size_t)l * SB + b) * PPAD + (PPAD - ST + t)) * BRW + cch; *(f32x4*)so = (f32x4){u[0], u[1], u[2], u[3]}; *(f32x4*)(so + 4) = (f32x4){u[4], u[5], u[6], u[7]};
        const int tt = t - W + 1;
        if (tt >= 0) unp(rw[tt >= 0 ? tt : 0], f);
        else { const int k = tt + W - 1 >= 0 ? tt + W - 1 : 0; f[0] = pf[k][0].x; f[1] = pf[k][0].y; f[2] = pf[k][0].z; f[3] = pf[k][0].w; f[4] = pf[k][1].x; f[5] = pf[k][1].y; f[6] = pf[k][1].z; f[7] = pf[k][1].w; }
#pragma unroll
        for (int e = 0; e < 8; ++e) S[e] -= f[e]; }
}
__device__ __forceinline__ void pool_phase(const bf16* Z, int l, const float* spool, bf16* ZP, float* out, int gw, int NGW, int lane, int gt, int NGT) {
    for (int wi = gw; wi < (MP / 8 / 2) * 4; wi += NGW) { const int cg = wi & 3, grp = (wi >> 2) * 2 + (lane >> 5), cch = (cg * 32 + (lane & 31)) * 8, b = grp >> 9, t0 = (grp & 511) * 8;
        if (cg == 0) pool_run<2>(Z, l, b, t0, cch, ZP, out); else if (cg == 1) pool_run<4>(Z, l, b, t0, cch, ZP, out); else if (cg == 2) pool_run<8>(Z, l, b, t0, cch, ZP, out); else pool_run<16>(Z, l, b, t0, cch, ZP, out); }
    for (int wi = gw; wi < (SB / 2) * 4; wi += NGW) { const int cg = wi & 3, b = (wi >> 2) * 2 + (lane >> 5), cch = (cg * 32 + (lane & 31)) * 8;
        if (cg == 0) pool_run_s<2>(Z, l, b, cch, spool, ZP, out); else if (cg == 1) pool_run_s<4>(Z, l, b, cch, spool, ZP, out); else if (cg == 2) pool_run_s<8>(Z, l, b, cch, spool, ZP, out); else pool_run_s<16>(Z, l, b, cch, spool, ZP, out); }
}
__device__ __forceinline__ void retout_s_phase(const bf16* Z, int l, const float* sret, const float* gret, bf16* Y3, int gw, int NGW, int lane) {
    for (int it = gw; it < MS * RH; it += NGW) { int h = __builtin_amdgcn_readfirstlane(it & 7); asm volatile("" : "+s"(h));
        const int rs = it >> 3, sb = rs >> 3, i = rs & 7; const size_t row = (size_t)MP + rs, row0 = (size_t)MP + sb * ST;
        const float lg = ret_logg(h);
        const bf16* qp = Z + row * ZW + ZRQ + h * 64;
        const float* S = sret + (((size_t)l * SB + sb) * RH + h) * RDK * RDV;
        float o0 = 0.f, o1 = 0.f;
#pragma unroll 16
        for (int d = 0; d < 64; ++d) { const float qd = bf2f(qp[d]); o0 += qd * S[(size_t)d * RDV + lane]; o1 += qd * S[(size_t)d * RDV + lane + 64]; }
        const float cf = FEXP(lg * (float)(i + 1)); o0 *= cf; o1 *= cf;
        const float ql = bf2f(qp[lane]);
        for (int j = 0; j <= i; ++j) { const bf16* zj = Z + (row0 + j) * ZW; const float sc = wave_sum(ql * bf2f(zj[ZRK + h * 64 + lane])) * 0.125f * FEXP(lg * (float)(i - j));
            o0 += sc * bf2f(zj[ZRV + h * 128 + lane]); o1 += sc * bf2f(zj[ZRV + h * 128 + lane + 64]); }
        const float mean = wave_sum(o0 + o1) * (1.f / 128.f); const float d0 = o0 - mean, d1 = o1 - mean;
        const float rstd = 1.f / sqrtf(wave_sum(d0 * d0 + d1 * d1) * (1.f / 128.f) + EPS);
        const float* g = gret + l * BRW + h * 128; const bf16* rg = Z + row * ZW + ZRG + h * 128; bf16* y = Y3 + row * BRW + h * 128;
        y[lane] = f2bf(d0 * rstd * g[lane] * bf2f(rg[lane])); y[lane + 64] = f2bf(d1 * rstd * g[lane + 64] * bf2f(rg[lane + 64]));
    }
}
}
struct AdaOrder { int G, c; const char* A; const char* B;
    __device__ __forceinline__ bool next(int i, pg8::Unit& u) const { const int Lx = i * G + c; if (Lx >= DEPTH * (ADAW / 256)) return false;
        u.r = Lx / (ADAW / 256); u.pn = Lx % (ADAW / 256); u.pm = 0; u.ks = 0; u.nt = DM / 64; u.a = A; u.b = B + ((size_t)u.r * ADAW + (size_t)u.pn * 256) * DM * 2; return true; } };
struct PoolOrder { int G, c; const char* A; const char* B;
                __device__ __forceinline__ bool next(int i, pg8::Unit& u) const { const int Lx = i * G + c; if (Lx >= (M / 256) * 4) return false;
                    u.pm = Lx >> 2; u.pn = Lx & 3; u.r = 0; u.ks = 0; u.nt = 256 / 64; u.a = A + ((size_t)u.pm * 256 * BRW + (size_t)u.pn * 256) * 2; u.b = B + (size_t)u.pn * 256 * 256 * 2; return true; } };
__device__ __forceinline__ unsigned long long ld_ptr(volatile LAS unsigned* p) { const unsigned lo = __builtin_amdgcn_readfirstlane(p[0]), hi = __builtin_amdgcn_readfirstlane(p[1]); return ((unsigned long long)hi << 32) | lo; }
constexpr int NPL = 12;
constexpr int PH_TOTAL = 2 + DEPTH * NPL + 1;
constexpr int KS_BR = 2, KS_OUT = 8, KS_M1 = 4, KS_M2 = 16;
struct Args { const float* in[N_IN]; float* out; unsigned char* ws; int ph_lo, ph_hi; };
static_assert(sizeof(Args) == N_IN * 8 + 8 + 8 + 8, "Args has no padding");

__global__ void __launch_bounds__(NTHR, 2) fwd(Args args) {
    extern __shared__ __attribute__((aligned(16))) unsigned char lds[];
    LAS unsigned char* L0 = (LAS unsigned char*)lds;
    volatile LAS unsigned* MISC = (volatile LAS unsigned*)(L0 + MISC_OFF);
    const int G = gridDim.x, bx = blockIdx.x, wave0 = __builtin_amdgcn_readfirstlane(threadIdx.x >> 6);
    unsigned char* ws0 = args.ws;
    for (int u = threadIdx.x; u < (LDS_BYTES - LDSCTL_OFF) / 4; u += NTHR) ((LAS unsigned*)(L0 + LDSCTL_OFF))[u] = 0u;
    __syncthreads();
    if (threadIdx.x <= N_IN) ((LAS unsigned long long*)(L0 + INTAB_OFF))[threadIdx.x] = threadIdx.x < N_IN ? (unsigned long long)args.in[threadIdx.x < N_IN ? threadIdx.x : 0] : (unsigned long long)args.out;
    __syncthreads();
#if MK_ONE_LAUNCH
    XcdBarrier bar = xcd_barrier_post((unsigned*)(ws0 + WS_CTL) + CW_BAR, MISC + 8);
#define GRID_BAR() xcd_barrier(bar)
#else
#define GRID_BAR() do {} while (0)
#endif
    const int lo = args.ph_lo, hi = args.ph_hi;
#ifndef PH_MASK
#define PH_MASK 0x7FFF
#endif
#ifndef PROBE_MASK
#define PROBE_MASK 0
#endif
#define PROBE_BEGIN(bit) unsigned long long pr_t0 = 0; if ((PROBE_MASK >> (bit)) & 1) pr_t0 = __builtin_amdgcn_s_memrealtime()
#define PROBE_END(bit) do { if ((PROBE_MASK >> (bit)) & 1) { __syncthreads(); const unsigned long long t1 = __builtin_amdgcn_s_memrealtime(); while (__builtin_amdgcn_s_memrealtime() - t1 < t1 - pr_t0) __builtin_amdgcn_s_sleep(8); } } while (0)
#define IN(k) (lo <= (k) && (k) < hi)
#define SEAM(k) do { if (IN((k) + 1)) GRID_BAR(); } while (0)
#define INP(i)  ((const float*)(GAS const float*)ld_ptr((volatile LAS unsigned*)(L + INTAB_OFF) + 2 * (i)))
#define P_OUT   ((float*)(GAS float*)ld_ptr((volatile LAS unsigned*)(L + INTAB_OFF) + 2 * N_IN))
#define WIN_T   ((bf16*)(ws + WS_WIN))
#define WBR_T   ((bf16*)(ws + WS_WBR))
#define WOUT_T  ((bf16*)(ws + WS_WOUT))
#define WM1_T   ((bf16*)(ws + WS_WM1))
#define WM2_T   ((bf16*)(ws + WS_WM2))
#define WPOOL_T ((bf16*)(ws + WS_WPOOL))
#define WADA_T  ((bf16*)(ws + WS_WADA))
#define SC      ((bf16*)(ws + WS_SC))
#define ADA     ((float*)(ws + WS_ADA))
#define H       ((bf16*)(ws + WS_H))
#define Z       ((bf16*)(ws + WS_Z))
#define Y       ((bf16*)(ws + WS_Y))
#define ZP      ((bf16*)(ws + WS_ZP))
#define CONVY   ((float*)(ws + WS_CONVY))
#define ORAW    ((float*)(ws + WS_ORAW))
#define KV      ((float*)(ws + WS_KV))
#define SPREV   ((float*)(ws + WS_SPREV))
#define MACC    ((float*)(ws + WS_MACC))
#define MERGED  ((bf16*)(ws + WS_MERGED))
#define X1      ((float*)(ws + WS_X1))
#define X       ((float*)(ws + WS_X))
#define HID     ((bf16*)(ws + WS_HID))
#define SLAB    ((float*)(ws + WS_SLAB))
#define TIDS() int lane; asm volatile("v_mbcnt_lo_u32_b32 %0, -1, 0\n\tv_mbcnt_hi_u32_b32 %0, -1, %0" : "=v"(lane)); GAS unsigned char* wsg = (GAS unsigned char*)ws0; asm volatile("" : "+s"(wsg)); unsigned char* ws = (unsigned char*)wsg; LAS unsigned char* L = L0; asm volatile("" : "+s"(L)); const int wave = wave0, tid = wave0 * 64 + lane; const int gw = bx * NWAVES + wave, NGW = G * NWAVES; const int gt = bx * NTHR + tid, NGT = G * NTHR; (void)lane; (void)gw; (void)NGW; (void)gt; (void)NGT
#define LAYER_PTRS() const float* ada = ADA + (size_t)l * NROWB * ADAW; const float* xinP = l == 0 ? INP(I_XP) : X; const float* xinS = l == 0 ? INP(I_XS) : X + (size_t)MP * DM; float* xout = l == DEPTH - 1 ? P_OUT : X; (void)ada; (void)xinP; (void)xinS; (void)xout
    if ((PH_MASK >> 12 & 1) && IN(0)) { TIDS(); PROBE_BEGIN(12);
        LAS float* scr = (LAS float*)(L + RING_OFF + wave * 16384);
        constexpr int I_IN = (DM / 64) * (ZW / 32), I_BR = (BRW / 64) * (DM / 32), I_OUT = (DM / 64) * (DM / 32), I_M1 = (DM / 64) * (DFF / 32), I_M2 = (DFF / 64) * (DM / 32),
                      I_PL = (256 / 64) * (256 / 32), I_AD = (DM / 64) * (ADAW / 32);
        constexpr int T_IN = DEPTH * I_IN, T_BR = T_IN + DEPTH * 4 * I_BR, T_OUT = T_BR + DEPTH * I_OUT, T_M1 = T_OUT + DEPTH * I_M1, T_M2 = T_M1 + DEPTH * I_M2,
                      T_PL = T_M2 + DEPTH * 4 * I_PL, T_AD = T_PL + DEPTH * I_AD;
        for (int it = gw; it < T_AD; it += NGW) {
            if (it < T_IN) { const int mi = it / I_IN, r = it % I_IN; transpose_item(INP(I_WIN) + (size_t)mi * DM * ZW, DM, ZW, WIN_T + (size_t)mi * ZW * DM, scr, r, lane); }
            else if (it < T_BR) { const int q = it - T_IN, mi = q / I_BR, r = q % I_BR; transpose_item(INP(I_WBR) + (size_t)mi * BRW * DM, BRW, DM, WBR_T + (size_t)mi * DM * BRW, scr, r, lane); }
            else if (it < T_OUT) { const int q = it - T_BR, mi = q / I_OUT, r = q % I_OUT; transpose_item(INP(I_WOUT) + (size_t)mi * DM * DM, DM, DM, WOUT_T + (size_t)mi * DM * DM, scr, r, lane); }
            else if (it < T_M1) { const int q = it - T_OUT, mi = q / I_M1, r = q % I_M1; transpose_item(INP(I_WM1) + (size_t)mi * DM * DFF, DM, DFF, WM1_T + (size_t)mi * DFF * DM, scr, r, lane); }
            else if (it < T_M2) { const int q = it - T_M1, mi = q / I_M2, r = q % I_M2; transpose_item(INP(I_WM2) + (size_t)mi * DFF * DM, DFF, DM, WM2_T + (size_t)mi * DM * DFF, scr, r, lane); }
            else if (it < T_PL) { const int q = it - T_M2, mi = q / I_PL, r = q % I_PL; transpose_item(INP(I_WPOOL) + (size_t)mi * 256 * 256, 256, 256, WPOOL_T + (size_t)mi * 256 * 256, scr, r, lane); }
            else { const int q = it - T_PL, mi = q / I_AD, r = q % I_AD; transpose_item(INP(I_WADA) + (size_t)mi * DM * ADAW, DM, ADAW, WADA_T + (size_t)mi * ADAW * DM, scr, r, lane); }
        }
        for (int i = gt; i < 256 * DM; i += NGT) { const int r = i / DM, k = i % DM; float v = 0.f;
            if (r < NBP) v = INP(I_CP)[r * DM + k]; else if (r < NROWB) v = INP(I_CS)[(r - NBP) * DM + k];
            SC[i] = r < NROWB ? f2bf(v * sigmoidf_(v)) : (bf16)0; }
        PROBE_END(12); SEAM(0);
    }
    if ((PH_MASK >> 13 & 1) && IN(1)) { TIDS(); PROBE_BEGIN(13);
        AdaOrder S{G, bx, (const char*)SC, (const char*)WADA_T};
        pg8::EpiAda E{ADA, INP(I_BADA)};
        pg8::gemm_phase<pg8::EpiAda, AdaOrder>(L + RING_OFF, pg8::Dims{DM, DM, DM}, S, E, tid);
        PROBE_END(13); SEAM(1);
    }
    for (int l = 0; l < DEPTH; ++l) {
        const int pb = 2 + l * NPL;
        if ((PH_MASK >> 0 & 1) && IN(pb + 0)) { TIDS(); LAYER_PTRS(); PROBE_BEGIN(0);
            for (int rs = bx; rs < MS; rs += G) { const int row = MP + rs; const float* ar = ada + (size_t)row_cond(row) * ADAW;
                if (l == 0) norm_row_block<0>(xinS + (size_t)rs * DM, nullptr, nullptr, 0, nullptr, INP(I_G1) + l * DM, ar + DM, ar, H + (size_t)row * DM, (LAS float*)(L + RING_OFF), tid, wave);
                else norm_row_block<KS_M2>(X1 + (size_t)row * DM, ar - (size_t)NROWB * ADAW + 5 * DM, SLAB + (size_t)rs * DM, (size_t)MS * DM, X + (size_t)row * DM, INP(I_G1) + l * DM, ar + DM, ar, H + (size_t)row * DM, (LAS float*)(L + RING_OFF), tid, wave); }
            f32x4 gm[8], shv[8]; int curc = row_cond(gw < MP ? gw : 0); { const float* ar = ada + (size_t)curc * ADAW; load_mod(INP(I_G1) + l * DM, ar + DM, ar, gm, shv, lane); }
            for (int row = gw; row < MP; row += 2 * NGW) { const int rowb = row + NGW; const bool pair = rowb < MP && row_cond(rowb) == row_cond(row);
                for (int k = 0; k < 2; ++k) { const int r = k ? rowb : row; if (k && (pair || rowb >= MP)) break; const int cond = row_cond(r); const float* ar = ada + (size_t)cond * ADAW;
                    if (cond != curc) { load_mod(INP(I_G1) + l * DM, ar + DM, ar, gm, shv, lane); curc = cond; }
                    if (pair) norm_row2(xinP + (size_t)row * DM, xinP + (size_t)rowb * DM, gm, shv, H + (size_t)row * DM, H + (size_t)rowb * DM, lane);
                    else norm_row(xinP + (size_t)r * DM, gm, shv, H + (size_t)r * DM, lane); } }
            PROBE_END(0); SEAM(pb + 0);
        }
        if ((PH_MASK >> 1 & 1) && IN(pb + 1)) { TIDS(); LAYER_PTRS(); PROBE_BEGIN(1);
            pg8::StaticOrder S; S.init(H, WIN_T + (size_t)l * ZW * DM, M / 256, ZW / 256, DM, DM, DM, G, bx);
            pg8::EpiZ E{Z};
            pg8::gemm_phase<pg8::EpiZ, pg8::StaticOrder>(L + RING_OFF, pg8::Dims{DM, DM, DM}, S, E, tid);
            PROBE_END(1); SEAM(pb + 1);
        }
        if ((PH_MASK >> 2 & 1) && IN(pb + 2)) { TIDS(); LAYER_PTRS(); PROBE_BEGIN(2);
            mixl::qknorm_phase(Z, l, INP(I_GQ), INP(I_GK), P_OUT, gw, NGW, lane);
            for (int i = gt; i < N_SHIFT_ITEMS; i += NGT) shift_item(l, i, INP(I_CK), INP(I_CV), INP(I_SCONV), INP(I_SPOOL), P_OUT);
            mixl::convln_phase(L, Z, l, INP(I_WDW), INP(I_BDW), INP(I_GCLN), INP(I_BCLN), INP(I_SCONV), Y + (size_t)1 * M * BRW, P_OUT, bx, G, tid, wave);
            mixl::pool_phase(Z, l, INP(I_SPOOL), ZP, P_OUT, gw, NGW, lane, gt, NGT);
            ret::kv_phase(L + RING_OFF, Z, KV, bx, G, tid, lane, wave);
            for (int i = gt; i < SB * RH * RDK * 32; i += NGT) { const int v4 = i & 31, d = (i >> 5) & 63, h = (i >> 11) & 7, sb = i >> 14; retstate_s_item(Z, l, sb, h, d, v4, INP(I_SRET), P_OUT); }
            PROBE_END(2); SEAM(pb + 2);
        }
        if ((PH_MASK >> 3 & 1) && IN(pb + 3)) { TIDS(); LAYER_PTRS(); PROBE_BEGIN(3);
            att::phase(L + RING_OFF, Z, l, INP(I_SINK), INP(I_CK), INP(I_CV), Y, bx, G, tid, lane, wave);
            for (int i = gt; i < NBP * RH * RDK * 32; i += NGT) { const int v4 = i & 31, d = (i >> 5) & 63, b = i >> 14; int h = (i >> 11) & 7;
                const size_t o0 = (((size_t)b * 32 * RH + h) * RDK + d) * RDV + v4 * 4, cs = (size_t)RH * RDK * RDV; f32x4 kvv[32];
#pragma unroll
                for (int n = 0; n < 32; ++n) kvv[n] = *(const f32x4*)(KV + o0 + n * cs);
                const float gc = FEXP(ret_logg(h) * 128.f); float z0 = 0.f; asm volatile("" : "+v"(z0)); f32x4 sacc = {z0, z0, z0, z0};
#pragma unroll
                for (int n = 0; n < 32; ++n) { *(f32x4*)(SPREV + o0 + n * cs) = sacc; sacc = sacc * gc + kvv[n]; }
                *(f32x4*)(P_OUT + O_RP + ((((size_t)l * NBP + b) * RH + h) * RDK + d) * RDV + v4 * 4) = sacc; }
            PROBE_END(3); SEAM(pb + 3);
        }
        if ((PH_MASK >> 4 & 1) && IN(pb + 4)) { TIDS(); LAYER_PTRS(); PROBE_BEGIN(4);
            mixl::retout_s_phase(Z, l, INP(I_SRET), INP(I_GRET), Y + (size_t)3 * M * BRW, gw, NGW, lane);
            ret::out_phase(L + RING_OFF, Z, l, SPREV, INP(I_GRET), Y + (size_t)3 * M * BRW, bx, G, tid, lane, wave);
            PoolOrder S{G, bx, (const char*)ZP, (const char*)(WPOOL_T + (size_t)l * 4 * 256 * 256)};
            pg8::EpiPool E{Y + (size_t)2 * M * BRW, INP(I_SPOOLS), l};
            pg8::gemm_phase<pg8::EpiPool, PoolOrder>(L + RING_OFF, pg8::Dims{BRW, 256, 256}, S, E, tid);
            PROBE_END(4); SEAM(pb + 4);
        }
        if ((PH_MASK >> 5 & 1) && IN(pb + 5)) { TIDS(); LAYER_PTRS(); PROBE_BEGIN(5);
            pg8::SplitOrder S{DM / 256, G, bx, 4, BRW / 64, KS_BR, BRW / 64 / KS_BR, (const char*)Y, (const char*)(WBR_T + (size_t)l * 4 * DM * BRW), (size_t)256 * BRW * 2, (size_t)256 * BRW * 2, (size_t)M * BRW * 2, (size_t)DM * BRW * 2};
            pg8::EpiBr E{Z, MERGED, SLAB, KS_BR};
            pg8::gemm_phase<pg8::EpiBr, pg8::SplitOrder>(L + RING_OFF, pg8::Dims{BRW, BRW, BRW}, S, E, tid);
            PROBE_END(5); SEAM(pb + 5);
        }
        if ((PH_MASK >> 6 & 1) && IN(pb + 6)) { TIDS(); LAYER_PTRS(); PROBE_BEGIN(6);
            for (int i = gt; i < MS * DM / 8; i += NGT) { float a[8];
#pragma unroll
                for (int e = 0; e < 8; ++e) a[e] = 0.f;
#pragma unroll
                for (int p = 0; p < 4 * KS_BR; ++p) { const f32x4 v0 = *(const f32x4*)(SLAB + (size_t)p * MS * DM + (size_t)i * 8), v1 = *(const f32x4*)(SLAB + (size_t)p * MS * DM + (size_t)i * 8 + 4);
                    a[0] += v0.x; a[1] += v0.y; a[2] += v0.z; a[3] += v0.w; a[4] += v1.x; a[5] += v1.y; a[6] += v1.z; a[7] += v1.w; }
                st8(MERGED + (size_t)MP * DM + (size_t)i * 8, a); }
            PROBE_END(6); SEAM(pb + 6);
        }
        if ((PH_MASK >> 7 & 1) && IN(pb + 7)) { TIDS(); LAYER_PTRS(); PROBE_BEGIN(7);
            pg8::SplitOrder S{DM / 256, G, bx, 1, DM / 64, KS_OUT, DM / 64 / KS_OUT, (const char*)MERGED, (const char*)(WOUT_T + (size_t)l * DM * DM), (size_t)256 * DM * 2, (size_t)256 * DM * 2, 0, 0};
            pg8::EpiRes E{xinP, xinS, X1, ada + 2 * DM, SLAB};
            pg8::gemm_phase<pg8::EpiRes, pg8::SplitOrder>(L + RING_OFF, pg8::Dims{DM, DM, DM}, S, E, tid);
            PROBE_END(7); SEAM(pb + 7);
        }
        if ((PH_MASK >> 8 & 1) && IN(pb + 8)) { TIDS(); LAYER_PTRS(); PROBE_BEGIN(8);
            for (int rs = bx; rs < MS; rs += G) { const int row = MP + rs; const float* ar = ada + (size_t)row_cond(row) * ADAW;
                norm_row_block<KS_OUT>(xinS + (size_t)rs * DM, ar + 2 * DM, SLAB + (size_t)rs * DM, (size_t)MS * DM, X1 + (size_t)row * DM, INP(I_G2) + l * DM, ar + 4 * DM, ar + 3 * DM, H + (size_t)row * DM, (LAS float*)(L + RING_OFF), tid, wave); }
            f32x4 gm[8], shv[8]; int curc = row_cond(gw < MP ? gw : 0); { const float* ar = ada + (size_t)curc * ADAW; load_mod(INP(I_G2) + l * DM, ar + 4 * DM, ar + 3 * DM, gm, shv, lane); }
            for (int row = gw; row < MP; row += 2 * NGW) { const int rowb = row + NGW; const bool pair = rowb < MP && row_cond(rowb) == row_cond(row);
                for (int k = 0; k < 2; ++k) { const int r = k ? rowb : row; if (k && (pair || rowb >= MP)) break; const int cond = row_cond(r); const float* ar = ada + (size_t)cond * ADAW;
                    if (cond != curc) { load_mod(INP(I_G2) + l * DM, ar + 4 * DM, ar + 3 * DM, gm, shv, lane); curc = cond; }
                    if (pair) norm_row2(X1 + (size_t)row * DM, X1 + (size_t)rowb * DM, gm, shv, H + (size_t)row * DM, H + (size_t)rowb * DM, lane);
                    else norm_row(X1 + (size_t)r * DM, gm, shv, H + (size_t)r * DM, lane); } }
            PROBE_END(8); SEAM(pb + 8);
        }
        if ((PH_MASK >> 9 & 1) && IN(pb + 9)) { TIDS(); LAYER_PTRS(); PROBE_BEGIN(9);
            pg8::SplitOrder S{DFF / 256, G, bx, 1, DM / 64, KS_M1, DM / 64 / KS_M1, (const char*)H, (const char*)(WM1_T + (size_t)l * DFF * DM), (size_t)256 * DM * 2, (size_t)256 * DM * 2, 0, 0};
            pg8::EpiMlp1 E{HID, SLAB};
            pg8::gemm_phase<pg8::EpiMlp1, pg8::SplitOrder>(L + RING_OFF, pg8::Dims{DM, DM, DM}, S, E, tid);
            PROBE_END(9); SEAM(pb + 9);
        }
        if ((PH_MASK >> 10 & 1) && IN(pb + 10)) { TIDS(); LAYER_PTRS(); PROBE_BEGIN(10);
            for (int i = gt; i < MS * DFF / 8; i += NGT) { float a[8];
#pragma unroll
                for (int e = 0; e < 8; ++e) a[e] = 0.f;
#pragma unroll
                for (int p = 0; p < KS_M1; ++p) { const f32x4 v0 = *(const f32x4*)(SLAB + (size_t)p * MS * DFF + (size_t)i * 8), v1 = *(const f32x4*)(SLAB + (size_t)p * MS * DFF + (size_t)i * 8 + 4);
                    a[0] += v0.x; a[1] += v0.y; a[2] += v0.z; a[3] += v0.w; a[4] += v1.x; a[5] += v1.y; a[6] += v1.z; a[7] += v1.w; }
#pragma unroll
                for (int e = 0; e < 8; ++e) { const float t = fmaxf(a[e], 0.f); a[e] = t * t; }
                st8(HID + (size_t)MP * DFF + (size_t)i * 8, a); }
            PROBE_END(10); SEAM(pb + 10);
        }
        if ((PH_MASK >> 11 & 1) && IN(pb + 11)) { TIDS(); LAYER_PTRS(); PROBE_BEGIN(11);
            pg8::SplitOrder S{DM / 256, G, bx, 1, DFF / 64, KS_M2, DFF / 64 / KS_M2, (const char*)HID, (const char*)(WM2_T + (size_t)l * DM * DFF), (size_t)256 * DFF * 2, (size_t)256 * DFF * 2, 0, 0};
            pg8::EpiRes E{X1, X1 + (size_t)MP * DM, xout, ada + 5 * DM, SLAB};
            pg8::gemm_phase<pg8::EpiRes, pg8::SplitOrder>(L + RING_OFF, pg8::Dims{DFF, DFF, DFF}, S, E, tid);
            PROBE_END(11); SEAM(pb + 11);
        }
    }
    if ((PH_MASK >> 14 & 1) && IN(PH_TOTAL - 1)) { TIDS(); PROBE_BEGIN(14);
        const float* ada = ADA + (size_t)(DEPTH - 1) * NROWB * ADAW; float* yo = P_OUT + O_YS;
        for (int i = gt; i < MS * DM / 4; i += NGT) { const int row = i / (DM / 4), c4 = i % (DM / 4); const float* gp = ada + (size_t)(NBP + (row >> 3)) * ADAW + 5 * DM;
            f32x4 a = {0.f, 0.f, 0.f, 0.f};
#pragma unroll
            for (int p = 0; p < KS_M2; ++p) a += *(const f32x4*)(SLAB + (size_t)p * MS * DM + (size_t)i * 4);
            *(f32x4*)(yo + (size_t)i * 4) = *(const f32x4*)(X1 + (size_t)(MP + row) * DM + c4 * 4) + *(const f32x4*)(gp + c4 * 4) * a; }
        PROBE_END(14);
    }
#undef IN
#undef SEAM
}

extern "C" void kernel_launch(void* const* d_in, const int* in_sizes, int n_in, void* d_out, int out_size, void* d_ws, size_t ws_size, hipStream_t stream) {
    static int grid = 0;
    if (grid == 0) {
        if (n_in != N_IN || (size_t)out_size != O_END || ws_size < WS_END) { fprintf(stderr, "kernel_launch: unexpected shapes: n_in %d out %d ws %zu (need %zu)\n", n_in, out_size, ws_size, (size_t)WS_END); grid = -1; return; }
        int dev = 0, cus = 0, per_cu = 0;
        if (hipGetDevice(&dev) != hipSuccess || hipDeviceGetAttribute(&cus, hipDeviceAttributeMultiprocessorCount, dev) != hipSuccess) { grid = -1; return; }
        if (hipFuncSetAttribute((const void*)fwd, hipFuncAttributeMaxDynamicSharedMemorySize, LDS_BYTES) != hipSuccess) { fprintf(stderr, "kernel_launch: hipFuncSetAttribute failed\n"); grid = -1; return; }
        if (hipOccupancyMaxActiveBlocksPerMultiprocessor(&per_cu, (const void*)fwd, NTHR, LDS_BYTES) != hipSuccess || per_cu < 1) fprintf(stderr, "kernel_launch: occupancy query says %d\n", per_cu);
        (void)hipGetLastError();
        grid = cus;
    }
    if (grid < 0) return;
    (void)hipMemsetAsync((char*)d_ws + WS_CTL, 0, CTL_ZERO_BYTES, stream);
    Args a{};
    for (int i = 0; i < N_IN; ++i) a.in[i] = (const float*)d_in[i];
    a.out = (float*)d_out; a.ws = (unsigned char*)d_ws;
#if MK_ONE_LAUNCH
    a.ph_lo = 0; a.ph_hi = PH_TOTAL;
    hipLaunchKernelGGL(fwd, dim3(grid), dim3(NTHR), LDS_BYTES, stream, a);
#else
    for (int p = 0; p < PH_TOTAL; ++p) { a.ph_lo = p; a.ph_hi = p + 1; hipLaunchKernelGGL(fwd, dim3(grid), dim3(NTHR), LDS_BYTES, stream, a); }
#endif
}
#endif
```

```cpp
#ifndef HOST_TEST_ONLY
#include <hip/hip_runtime.h>
#endif
#include <cstdio>
#include <cstdint>
#include <cmath>

#ifndef MK_ONE_LAUNCH
#define MK_ONE_LAUNCH 1
#endif

#define HD __host__ __device__ __forceinline__
typedef unsigned short bf16;
HD float bf2f(bf16 b) { return __builtin_bit_cast(float, ((unsigned)b) << 16); }
HD bf16 f2bf(float f) { unsigned u = __builtin_bit_cast(unsigned, f); return (bf16)((u + 0x7fffu + ((u >> 16) & 1u)) >> 16); }

HD void ld8(const bf16* p, float* f) { const uint4 w = *(const uint4*)p;
    f[0] = __builtin_bit_cast(float, w.x << 16); f[1] = __builtin_bit_cast(float, w.x & 0xffff0000u); f[2] = __builtin_bit_cast(float, w.y << 16); f[3] = __builtin_bit_cast(float, w.y & 0xffff0000u);
    f[4] = __builtin_bit_cast(float, w.z << 16); f[5] = __builtin_bit_cast(float, w.z & 0xffff0000u); f[6] = __builtin_bit_cast(float, w.w << 16); f[7] = __builtin_bit_cast(float, w.w & 0xffff0000u); }
HD void st8(bf16* p, const float* f) { uint4 w; w.x = (unsigned)f2bf(f[0]) | ((unsigned)f2bf(f[1]) << 16); w.y = (unsigned)f2bf(f[2]) | ((unsigned)f2bf(f[3]) << 16);
    w.z = (unsigned)f2bf(f[4]) | ((unsigned)f2bf(f[5]) << 16); w.w = (unsigned)f2bf(f[6]) | ((unsigned)f2bf(f[7]) << 16); *(uint4*)p = w; }
constexpr int DM = 2048, SEQ = 4096, NBP = 2, MP = NBP * SEQ, SB = 32, ST = 8, MS = SB * ST, M = MP + MS, DEPTH = 4;
constexpr int NROWB = NBP + SB;
constexpr int NH = 16, HDIM = 64, NKV = 4, WIN = 128, BRW = 1024, CONVK = 31, CPRE = 30, PPAD = 15, RH = 8, RDK = 64, RDV = 128, DFF = 8192;
constexpr int ZW = 15872, ZQ = 0, ZK = 1024, ZV = 1280, ZCA = 1536, ZCG = 2560, ZPL = 3584, ZRQ = 4608, ZRK = 5120, ZRV = 5632, ZRG = 6656, ZGT = 7680;
constexpr int ADAW = 6 * DM;
constexpr float EPS = 1e-6f;
constexpr size_t O_YP = 0, O_YS = O_YP + (size_t)MP * DM, O_KP = O_YS + (size_t)MS * DM, O_VP = O_KP + (size_t)DEPTH * NBP * WIN * 256,
    O_CP = O_VP + (size_t)DEPTH * NBP * WIN * 256, O_PP = O_CP + (size_t)DEPTH * NBP * CPRE * BRW, O_RP = O_PP + (size_t)DEPTH * NBP * PPAD * BRW,
    O_KS = O_RP + (size_t)DEPTH * NBP * RH * RDK * RDV, O_VS = O_KS + (size_t)DEPTH * SB * WIN * 256, O_CS = O_VS + (size_t)DEPTH * SB * WIN * 256,
    O_PS = O_CS + (size_t)DEPTH * SB * CPRE * BRW, O_RS = O_PS + (size_t)DEPTH * SB * PPAD * BRW, O_END = O_RS + (size_t)DEPTH * SB * RH * RDK * RDV;
static_assert(O_END == 41394176, "output size");
enum { I_XP = 0, I_XS, I_CP, I_CS, I_CK, I_CV, I_SCONV, I_SPOOL, I_SRET, I_WADA, I_BADA, I_G1, I_G2, I_WIN, I_GQ, I_GK, I_SINK, I_WDW, I_BDW, I_GCLN, I_BCLN,
       I_WPOOL, I_SPOOLS, I_GRET, I_WBR, I_WOUT, I_WM1, I_WM2, N_IN };

HD bool row_is_s(int row) { return row >= MP; }
HD int row_cond(int row) { return row < MP ? (row >> 12) : NBP + ((row - MP) >> 3); }

#if defined(__HIP_DEVICE_COMPILE__)
#define FEXP(x) __expf(x)
#else
#define FEXP(x) expf(x)
#endif
#if defined(__HIP_DEVICE_COMPILE__)
HD float sigmoidf_(float x) { return __builtin_amdgcn_rcpf(1.f + __expf(-x)); }
#else
HD float sigmoidf_(float x) { return 1.f / (1.f + FEXP(-x)); }
#endif
HD float ret_logg(int h) { const float x = __builtin_bit_cast(float, (unsigned)(127 - 5 - h) << 23); return -x * (1.f + x * (0.5f + x * (0.33333334f + x * (0.25f + x * 0.2f)))); }

HD void qknorm_item(bf16* Z, int l, int row, int slot, const float* gq, const float* gk, float* out) {
    const int col = slot < 16 ? ZQ + slot * 64 : (slot < 20 ? ZK + (slot - 16) * 64 : ZV + (slot - 20) * 64);
    bf16* p = Z + (size_t)row * ZW + col;
    float v[64];
#pragma unroll
    for (int i = 0; i < 64; i += 8) ld8(p + i, v + i);
    if (slot < 20) {
        float ss = 0.f;
#pragma unroll
        for (int i = 0; i < 64; ++i) ss += v[i] * v[i];
        const float r = 1.f / sqrtf(ss * (1.f / 64.f) + EPS);
        const float* g = (slot < 16 ? gq : gk) + l * 64;
#pragma unroll
        for (int i = 0; i < 64; ++i) v[i] = v[i] * r * g[i];
#pragma unroll
        for (int i = 0; i < 64; i += 8) st8(p + i, v + i);
    }
    if (slot >= 16) {
        const int kvh = (slot - 16) & 3; const bool isv = slot >= 20;
        float* o = nullptr;
        if (!row_is_s(row)) { const int b = row >> 12, t = row & (SEQ - 1);
            if (t >= SEQ - WIN) o = out + (isv ? O_VP : O_KP) + ((((size_t)l * NBP + b) * WIN + (t - (SEQ - WIN))) * NKV + kvh) * 64;
        } else { const int sb = (row - MP) >> 3, t = (row - MP) & 7;
            o = out + (isv ? O_VS : O_KS) + ((((size_t)l * SB + sb) * WIN + (WIN - ST + t)) * NKV + kvh) * 64; }
        if (o) {
#pragma unroll
            for (int i = 0; i < 64; ++i) o[i] = v[i];
        }
    }
}
HD void shift_item(int l, int idx, const float* ck, const float* cv, const float* sconv, const float* spool, float* out) {
    constexpr int NKVS = SB * (WIN - ST) * 64, NCV = SB * (CPRE - ST) * 256, NPL = SB * (PPAD - ST) * 256;
    const float* src; float* dst;
    if (idx < 2 * NKVS) { const bool isv = idx >= NKVS; const int i = isv ? idx - NKVS : idx; const int sb = i / ((WIN - ST) * 64), rem = i % ((WIN - ST) * 64);
        src = (isv ? cv : ck) + (((size_t)l * SB + sb) * WIN + ST) * 256 + (size_t)rem * 4; dst = out + (isv ? O_VS : O_KS) + (((size_t)l * SB + sb) * WIN) * 256 + (size_t)rem * 4;
    } else if (idx < 2 * NKVS + NCV) { const int i = idx - 2 * NKVS; const int sb = i / ((CPRE - ST) * 256), rem = i % ((CPRE - ST) * 256);
        src = sconv + (((size_t)l * SB + sb) * CPRE + ST) * BRW + (size_t)rem * 4; dst = out + O_CS + (((size_t)l * SB + sb) * CPRE) * BRW + (size_t)rem * 4;
    } else { const int i = idx - 2 * NKVS - NCV; const int sb = i / ((PPAD - ST) * 256), rem = i % ((PPAD - ST) * 256);
        src = spool + (((size_t)l * SB + sb) * PPAD + ST) * BRW + (size_t)rem * 4; dst = out + O_PS + (((size_t)l * SB + sb) * PPAD) * BRW + (size_t)rem * 4; }
    dst[0] = src[0]; dst[1] = src[1]; dst[2] = src[2]; dst[3] = src[3];
}
constexpr int N_SHIFT_ITEMS = 2 * SB * (WIN - ST) * 64 + SB * (CPRE - ST) * 256 + SB * (PPAD - ST) * 256;

HD float glu_at(const bf16* Z, int row, int c) { const bf16* p = Z + (size_t)row * ZW; return bf2f(p[ZCA + c]) * sigmoidf_(bf2f(p[ZCG + c])); }
HD void conv_item(const bf16* Z, int l, int row, int c, const float* wdw, const float* bdw, const float* sconv, float* CONVY, float* out) {
    float acc = bdw[l * BRW + c];
    const float* w = wdw + (size_t)l * CONVK * BRW + c;
    if (!row_is_s(row)) { const int b = row >> 12, t = row & (SEQ - 1);
        for (int j = 0; j < CONVK; ++j) { const int tt = t - CPRE + j; if (tt >= 0) acc += w[(size_t)j * BRW] * glu_at(Z, b * SEQ + tt, c); }
        if (t >= SEQ - CPRE) out[O_CP + (((size_t)l * NBP + b) * CPRE + (t - (SEQ - CPRE))) * BRW + c] = glu_at(Z, row, c);
    } else { const int sb = (row - MP) >> 3, t = (row - MP) & 7;
        for (int j = 0; j < CONVK; ++j) { const int tt = t - CPRE + j;
            const float u = tt >= 0 ? glu_at(Z, MP + sb * ST + tt, c) : sconv[(((size_t)l * SB + sb) * CPRE + (CPRE + tt)) * BRW + c];
            acc += w[(size_t)j * BRW] * u; }
        out[O_CS + (((size_t)l * SB + sb) * CPRE + (CPRE - ST + t)) * BRW + c] = glu_at(Z, row, c);
    }
    CONVY[(size_t)row * BRW + c] = acc;
}
HD void pool_item(const bf16* Z, int l, int row, int c, const float* spool, bf16* ZP, float* out) {
    const int g = c >> 8, w = 2 << g;
    const float u0 = bf2f(Z[(size_t)row * ZW + ZPL + c]);
    float sum = 0.f, cnt;
    if (!row_is_s(row)) { const int b = row >> 12, t = row & (SEQ - 1);
        for (int i = 0; i < w; ++i) if (t - i >= 0) sum += bf2f(Z[(size_t)(b * SEQ + t - i) * ZW + ZPL + c]);
        cnt = (float)((t + 1) < w ? (t + 1) : w);
        if (t >= SEQ - PPAD) out[O_PP + (((size_t)l * NBP + b) * PPAD + (t - (SEQ - PPAD))) * BRW + c] = u0;
    } else { const int sb = (row - MP) >> 3, t = (row - MP) & 7;
        for (int i = 0; i < w; ++i) { const int tt = t - i;
            sum += tt >= 0 ? bf2f(Z[(size_t)(MP + sb * ST + tt) * ZW + ZPL + c]) : spool[(((size_t)l * SB + sb) * PPAD + (PPAD + tt)) * BRW + c]; }
        cnt = (float)w;
        out[O_PS + (((size_t)l * SB + sb) * PPAD + (PPAD - ST + t)) * BRW + c] = u0;
    }
    ZP[(size_t)row * BRW + c] = f2bf(sum / cnt - u0);
}
HD void retkv_item(const bf16* Z, float* KV, int b, int n, int h, int d, int v4) {
    const float lg = ret_logg(h);
    float a0 = 0.f, a1 = 0.f, a2 = 0.f, a3 = 0.f;
    for (int j = 0; j < 128; ++j) { const bf16* p = Z + (size_t)(b * SEQ + n * 128 + j) * ZW;
        const float kd = bf2f(p[ZRK + h * 64 + d]) * 0.125f * FEXP(lg * (float)(127 - j));
        const bf16* pv = p + ZRV + h * 128 + v4 * 4;
        a0 += kd * bf2f(pv[0]); a1 += kd * bf2f(pv[1]); a2 += kd * bf2f(pv[2]); a3 += kd * bf2f(pv[3]); }
    float* o = KV + ((((size_t)b * 32 + n) * RH + h) * RDK + d) * RDV + v4 * 4;
    o[0] = a0; o[1] = a1; o[2] = a2; o[3] = a3;
}
HD void retstate_s_item(const bf16* Z, int l, int sb, int h, int d, int v4, const float* sret, float* out) {
    const float lg = ret_logg(h);
    const size_t so = ((((size_t)l * SB + sb) * RH + h) * RDK + d) * RDV + v4 * 4;
    const float gc = FEXP(lg * (float)ST);
    float a0 = gc * sret[so], a1 = gc * sret[so + 1], a2 = gc * sret[so + 2], a3 = gc * sret[so + 3];
#pragma unroll
    for (int j = 0; j < ST; ++j) { const bf16* p = Z + (size_t)(MP + sb * ST + j) * ZW;
        const float kd = bf2f(p[ZRK + h * 64 + d]) * 0.125f * FEXP(lg * (float)(ST - 1 - j));
        const bf16* pv = p + ZRV + h * 128 + v4 * 4;
        a0 += kd * bf2f(pv[0]); a1 += kd * bf2f(pv[1]); a2 += kd * bf2f(pv[2]); a3 += kd * bf2f(pv[3]); }
    float* o = out + O_RS + so; o[0] = a0; o[1] = a1; o[2] = a2; o[3] = a3;
}
HD void retscan_item(const float* KV, float* SPREV, int l, int b, int h, int d, int v4, float* out) {
    const float gc = FEXP(ret_logg(h) * 128.f);
    float s0 = 0.f, s1 = 0.f, s2 = 0.f, s3 = 0.f;
    for (int n = 0; n < 32; ++n) { const size_t o = ((((size_t)b * 32 + n) * RH + h) * RDK + d) * RDV + v4 * 4;
        SPREV[o] = s0; SPREV[o + 1] = s1; SPREV[o + 2] = s2; SPREV[o + 3] = s3;
        s0 = gc * s0 + KV[o]; s1 = gc * s1 + KV[o + 1]; s2 = gc * s2 + KV[o + 2]; s3 = gc * s3 + KV[o + 3]; }
    float* oo = out + O_RP + ((((size_t)l * NBP + b) * RH + h) * RDK + d) * RDV + v4 * 4;
    oo[0] = s0; oo[1] = s1; oo[2] = s2; oo[3] = s3;
}
HD void attn_item(const bf16* Z, int l, int row, int hq, const float* sinks, const float* ck, const float* cv, bf16* Y0) {
    const int kvh = hq >> 2; const float slope = exp2f(-0.5f * (float)(hq + 1));
    float q[64];
    { const bf16* p = Z + (size_t)row * ZW + ZQ + hq * 64;
#pragma unroll
      for (int i = 0; i < 64; i += 8) ld8(p + i, q + i);
#pragma unroll
      for (int i = 0; i < 64; ++i) q[i] *= 0.125f; }
    float m = sinks[l * NH + hq], lsum = 1.f;
    float o[64];
#pragma unroll
    for (int i = 0; i < 64; ++i) o[i] = 0.f;
    const bool smp = row_is_s(row);
    const int b = smp ? ((row - MP) >> 3) : (row >> 12), t = smp ? ((row - MP) & 7) : (row & (SEQ - 1));
    const int lo = smp ? t : (t - WIN > 0 ? t - WIN : 0), hi = smp ? WIN + t : t;
    for (int j = lo; j <= hi; ++j) {
        const int dist = smp ? (WIN + t - j) : (t - j);
        const bool cache = smp && j < WIN;
        const size_t zrow = (size_t)(smp ? (MP + b * ST + (j - WIN)) : (b * SEQ + j)) * ZW;
        const size_t crow = ((((size_t)l * SB + b) * WIN + j) * NKV + kvh) * 64;
        float s = 0.f;
        if (cache) { const float* kp = ck + crow;
#pragma unroll
            for (int i = 0; i < 64; ++i) s += q[i] * kp[i];
        } else { const bf16* kp = Z + zrow + ZK + kvh * 64;
#pragma unroll
            for (int i = 0; i < 64; i += 8) { float f[8]; ld8(kp + i, f);
#pragma unroll
                for (int e = 0; e < 8; ++e) s += q[i + e] * f[e]; } }
        s -= slope * (float)dist;
        if (s > m) { const float corr = FEXP(m - s); lsum *= corr;
#pragma unroll
            for (int i = 0; i < 64; ++i) o[i] *= corr;
            m = s; }
        const float p = FEXP(s - m); lsum += p;
        if (cache) { const float* vp = cv + crow;
#pragma unroll
            for (int i = 0; i < 64; ++i) o[i] += p * vp[i];
        } else { const bf16* vp = Z + zrow + ZV + kvh * 64;
#pragma unroll
            for (int i = 0; i < 64; i += 8) { float f[8]; ld8(vp + i, f);
#pragma unroll
                for (int e = 0; e < 8; ++e) o[i + e] += p * f[e]; } }
    }
    const float inv = 1.f / lsum;
    bf16* y = Y0 + (size_t)row * BRW + hq * 64;
#pragma unroll
    for (int i = 0; i < 64; ++i) o[i] *= inv;
#pragma unroll
    for (int i = 0; i < 64; i += 8) st8(y + i, o + i);
}
HD void retout_item(const bf16* Z, int l, int row, int h, const float* SPREV, const float* sret, const float* gret, float* ORAW, bf16* Y3) {
    const float lg = ret_logg(h);
    const bool smp = row_is_s(row);
    const int b = smp ? ((row - MP) >> 3) : (row >> 12), t = smp ? ((row - MP) & 7) : (row & (SEQ - 1));
    const int i = smp ? t : (t & 127), n = smp ? 0 : (t >> 7);
    const int row0 = smp ? (MP + b * ST) : (b * SEQ + n * 128);
    const float* S = smp ? sret + (((size_t)l * SB + b) * RH + h) * RDK * RDV : SPREV + (((size_t)b * 32 + n) * RH + h) * RDK * RDV;
    float q[64];
    { const bf16* p = Z + (size_t)row * ZW + ZRQ + h * 64;
#pragma unroll
      for (int d = 0; d < 64; d += 8) ld8(p + d, q + d); }
    float* oraw = ORAW + (size_t)row * BRW + h * 128;
    float sum = 0.f;
    for (int half = 0; half < 2; ++half) {
        float o[64];
#pragma unroll
        for (int v = 0; v < 64; ++v) o[v] = 0.f;
        for (int j = 0; j <= i; ++j) { const bf16* p = Z + (size_t)(row0 + j) * ZW;
            const bf16* kp = p + ZRK + h * 64; float s = 0.f;
#pragma unroll
            for (int d = 0; d < 64; d += 8) { float f[8]; ld8(kp + d, f);
#pragma unroll
                for (int e = 0; e < 8; ++e) s += q[d + e] * f[e]; }
            s *= 0.125f * FEXP(lg * (float)(i - j));
            const bf16* vp = p + ZRV + h * 128 + half * 64;
#pragma unroll
            for (int v = 0; v < 64; v += 8) { float f[8]; ld8(vp + v, f);
#pragma unroll
                for (int e = 0; e < 8; ++e) o[v + e] += s * f[e]; } }
        const float cf = FEXP(lg * (float)(i + 1));
        const bf16* qp = Z + (size_t)row * ZW + ZRQ + h * 64;
        for (int d = 0; d < 64; ++d) { const float qd = bf2f(qp[d]) * cf; const float* sp = S + (size_t)d * RDV + half * 64;
#pragma unroll
            for (int v = 0; v < 64; ++v) o[v] += qd * sp[v]; }
#pragma unroll
        for (int v = 0; v < 64; ++v) { oraw[half * 64 + v] = o[v]; sum += o[v]; }
    }
    const float mean = sum * (1.f / 128.f);
    float var = 0.f;
    for (int v = 0; v < 128; ++v) { const float d = oraw[v] - mean; var += d * d; }
    const float rstd = 1.f / sqrtf(var * (1.f / 128.f) + EPS);
    const float* g = gret + l * BRW + h * 128;
    const bf16* rg = Z + (size_t)row * ZW + ZRG + h * 128;
    bf16* y = Y3 + (size_t)row * BRW + h * 128;
    for (int v = 0; v < 128; ++v) y[v] = f2bf((oraw[v] - mean) * rstd * g[v] * bf2f(rg[v]));
}

#if !defined(HOST_TEST_ONLY)
namespace pg8 {
#define PG8_LAS __attribute__((address_space(3)))
typedef short bf16x8 __attribute__((ext_vector_type(8)));
typedef float f32x4 __attribute__((ext_vector_type(4)));
typedef float f32x2 __attribute__((ext_vector_type(2)));
typedef unsigned u32x4 __attribute__((ext_vector_type(4)));
typedef unsigned u32x2 __attribute__((ext_vector_type(2)));
constexpr int BM = 256, BK = 64, HALF = 128, HTB = HALF * BK * 2, STAGE_BYTES = 8 * HTB, NXCD = 8, WGM = 8;

__host__ __device__ __forceinline__ int lds_byte(int r, int c) { const int st = (r >> 4) * 2 + (c >> 5), rr = r & 15, cc = c & 31, ob = rr * 64 + cc * 2; return st * 1024 + (ob ^ (((ob >> 9) & 1) << 5)); }
__host__ __device__ __forceinline__ void stage_rc(int b, int& R, int& C) { const int st = b / 1024, sb = b % 1024, swz = sb ^ (((sb >> 9) & 1) << 5); R = (st >> 1) * 16 + swz / 64; C = (st & 1) * 32 + (swz % 64) / 2; }
__host__ __device__ __forceinline__ int perm32(int rho) { const int n = rho >> 4, i = rho & 15; return 8 * (i >> 2) + 4 * n + (i & 3); }

struct Unit { int pm, pn, r, ks, nt; const char* a; const char* b; };
struct Dims { int lda, ldb, K; };

__host__ __device__ __forceinline__ void tile_of(int L, int nM, int nN, int& pm, int& pn) {
    const int nwg = nM * nN; int wgid = L; { const int q = nwg / NXCD, r = nwg % NXCD, xcd = wgid % NXCD, off = wgid / NXCD; wgid = (xcd < r ? xcd * (q + 1) : r * (q + 1) + (xcd - r) * q) + off; }
    const int nig = WGM * nN, gid = wgid / nig, fm = gid * WGM, gsz = (nM - fm) < WGM ? (nM - fm) : WGM;
    pm = fm + ((wgid % nig) % gsz); pn = (wgid % nig) / gsz;
}
struct StaticOrder {
    int nM, nN, nwg, G, c, nt; const char* A; const char* B; size_t ta, tb;
    __device__ __forceinline__ void init(const bf16* A_, const bf16* B_, int nM_, int nN_, int lda, int ldb, int K, int G_, int c_) { A = (const char*)A_; B = (const char*)B_; nM = nM_; nN = nN_; nwg = nM * nN; G = G_; c = c_; nt = K / BK; ta = (size_t)BM * lda * 2; tb = (size_t)BM * ldb * 2; }
    __device__ __forceinline__ bool next(int i, Unit& u) const {
        const long L = (long)i * G + c; if (L >= nwg) return false;
        tile_of((int)L, nM, nN, u.pm, u.pn); u.r = 0; u.ks = 0; u.nt = nt; u.a = A + (size_t)u.pm * ta; u.b = B + (size_t)u.pn * tb; return true;
    }
};


struct SplitOrder {
    int nN, G, c, RPT, ntP, KS, ntS; const char* A; const char* B; size_t ta, tb, sAr, sBr;
    __device__ __forceinline__ bool next(int i, Unit& u) const {
        const int nP = (MP / BM) * nN, Pc = c < nP ? (nP - c + G - 1) / G : 0;
        if (i < Pc * RPT) { const int tl = (i / RPT) * G + c; tile_of(tl, MP / BM, nN, u.pm, u.pn); u.r = i % RPT; u.ks = 0; u.nt = ntP;
            u.a = A + (size_t)u.r * sAr + (size_t)u.pm * ta; u.b = B + (size_t)u.r * sBr + (size_t)u.pn * tb; return true; }
        const int su = (i - Pc * RPT) * G + c; if (su >= nN * RPT * KS) return false;
        u.pm = MP / BM; u.pn = su / (RPT * KS); u.r = (su / KS) % RPT; u.ks = su % KS; u.nt = ntS;
        u.a = A + (size_t)u.r * sAr + (size_t)u.pm * ta + (size_t)u.ks * ntS * (BK * 2); u.b = B + (size_t)u.r * sBr + (size_t)u.pn * tb + (size_t)u.ks * ntS * (BK * 2); return true;
    }
};

__device__ __forceinline__ unsigned cvt_pk_bf16(float lo, float hi) { unsigned r; asm volatile("v_cvt_pk_bf16_f32 %0, %1, %2" : "=v"(r) : "v"(lo), "v"(hi)); return r; }

template <class Epi, class Sched, bool ALIGN_EPI = true, bool SP2 = true>
__device__ __forceinline__ void gemm_phase(PG8_LAS unsigned char* lds, const Dims g, const Sched& S, const Epi& E, const int tid) {
    const int wid = __builtin_amdgcn_readfirstlane(tid >> 6), lane = tid & 63, wr = wid >> 2, wc = wid & 3, fr = lane & 15, fq = lane >> 4;
    unsigned voffA[2], voffB[2];
#pragma unroll
    for (int i = 0; i < 2; ++i) { int R, C; stage_rc(tid * 16 + i * 8192, R, C); const int Rb = Epi::PERM ? ((R & ~31) + perm32(R & 31)) : R;
        voffA[i] = (unsigned)(R * g.lda + C) * 2u; voffB[i] = (unsigned)(Rb * g.ldb + C) * 2u; }
    const size_t kstep = (size_t)(BK * 2);
    const size_t hstepA = (size_t)HALF * g.lda * 2, hstepB = (size_t)HALF * g.ldb * 2;
    const unsigned ldsw = (unsigned)wid * 1024u;
    const int aoff = lds_byte(wr * 64 + fr, fq * 8), boff = lds_byte(wc * 32 + fr, fq * 8);
#define PG8_SA(b, h) (((b) * 2 + (h)) * HTB)
#define PG8_SB(b, h) ((4 + (b) * 2 + (h)) * HTB)
#define PG8_STAGE(bufoff, gbase, voff) do { _Pragma("unroll") for (int _i = 0; _i < 2; ++_i) \
        __builtin_amdgcn_global_load_lds((const unsigned*)((const char*)(gbase) + (voff)[_i]), (PG8_LAS unsigned*)(lds + (bufoff) + ldsw + _i * 8192), 16, 0, 0); } while (0)
#define PG8_LDA(dst, b, h) do { _Pragma("unroll") for (int m = 0; m < 4; ++m) _Pragma("unroll") for (int k = 0; k < 2; ++k) dst[m][k] = *(const PG8_LAS bf16x8*)(lds + PG8_SA(b, h) + aoff + m * 2048 + k * 1024); } while (0)
#define PG8_LDB(dst, b, h) do { _Pragma("unroll") for (int n = 0; n < 2; ++n) _Pragma("unroll") for (int k = 0; k < 2; ++k) dst[n][k] = *(const PG8_LAS bf16x8*)(lds + PG8_SB(b, h) + boff + n * 2048 + k * 1024); } while (0)
#define PG8_MMA(ai, bj, At, Bt) do { __builtin_amdgcn_s_setprio(1); _Pragma("unroll") for (int m = 0; m < 4; ++m) _Pragma("unroll") for (int n = 0; n < 2; ++n) _Pragma("unroll") for (int k = 0; k < 2; ++k) \
        acc[ai][bj][m][n] = __builtin_amdgcn_mfma_f32_16x16x32_bf16(Bt[n][k], At[m][k], acc[ai][bj][m][n], 0, 0, 0); __builtin_amdgcn_s_setprio(0); } while (0)
#define PG8_WAIT_V(n) asm volatile("s_waitcnt vmcnt(" #n ")" ::: "memory")
#define PG8_WAIT_L(n) asm volatile("s_waitcnt lgkmcnt(" #n ")" ::: "memory")
#define PG8_BAR __builtin_amdgcn_s_barrier()
#define PG8_SCHED __builtin_amdgcn_sched_barrier(0)
    Unit cur, nxt; int ui = 0;
    if (!S.next(0, cur)) return;
    f32x4 acc[2][2][4][2];
#pragma unroll
    for (int a = 0; a < 2; ++a)
#pragma unroll
        for (int b = 0; b < 2; ++b)
#pragma unroll
            for (int m = 0; m < 4; ++m)
#pragma unroll
                for (int n = 0; n < 2; ++n) acc[a][b][m][n] = (f32x4){0.f, 0.f, 0.f, 0.f};
    bf16x8 At[4][2], B0[2][2], B1[2][2];
    const char* cA = cur.a; const char* cB = cur.b;
    if constexpr (SP2) {
        PG8_STAGE(PG8_SB(0, 0), cB, voffB); PG8_STAGE(PG8_SB(0, 1), cB + hstepB, voffB); PG8_STAGE(PG8_SA(0, 0), cA, voffA); PG8_STAGE(PG8_SA(0, 1), cA + hstepA, voffA);
        if (wr == 1) PG8_BAR;
        PG8_WAIT_V(2); PG8_BAR;
        PG8_STAGE(PG8_SB(1, 0), cB + kstep, voffB); PG8_STAGE(PG8_SA(1, 0), cA + kstep, voffA); PG8_STAGE(PG8_SB(1, 1), cB + hstepB + kstep, voffB);
        PG8_WAIT_V(6); PG8_BAR;
    } else {
        PG8_STAGE(PG8_SB(0, 0), cB, voffB); PG8_STAGE(PG8_SA(0, 0), cA, voffA); PG8_STAGE(PG8_SB(0, 1), cB + hstepB, voffB); PG8_STAGE(PG8_SA(0, 1), cA + hstepA, voffA);
        if (wr == 1) PG8_BAR;
        PG8_WAIT_V(4); PG8_BAR;
        PG8_STAGE(PG8_SB(1, 0), cB + kstep, voffB); PG8_STAGE(PG8_SA(1, 0), cA + kstep, voffA); PG8_STAGE(PG8_SB(1, 1), cB + hstepB + kstep, voffB);
        PG8_WAIT_V(6); PG8_BAR;
    }
    for (;;) {
        const bool has_next = S.next(ui + 1, nxt);
        const char* nA = has_next ? nxt.a : cA; const char* nB = has_next ? nxt.b : cB;
        const int nt = cur.nt;
        for (int t = 0; t < nt; t += 2) {
            const bool last = (t == nt - 2);
            const char* a1 = cA + (size_t)(t + 1) * kstep;
            const char* a2 = last ? nA : cA + (size_t)(t + 2) * kstep; const char* b2 = last ? nB : cB + (size_t)(t + 2) * kstep;
            const char* a3 = a2 + kstep; const char* b3 = b2 + kstep;
            if constexpr (SP2) {
            PG8_LDB(B0, 0, 0); PG8_LDB(B1, 0, 1); PG8_SCHED; PG8_LDA(At, 0, 0); PG8_STAGE(PG8_SA(1, 1), a1 + hstepA, voffA);
            PG8_WAIT_V(8); PG8_WAIT_L(0); PG8_BAR; PG8_MMA(0, 0, At, B0); PG8_MMA(0, 1, At, B1); PG8_BAR; PG8_SCHED;
            PG8_LDA(At, 0, 1); PG8_STAGE(PG8_SB(0, 0), b2, voffB); PG8_STAGE(PG8_SB(0, 1), b2 + hstepB, voffB); PG8_STAGE(PG8_SA(0, 0), a2, voffA);
            PG8_WAIT_V(8); PG8_WAIT_L(0); PG8_BAR; PG8_MMA(1, 0, At, B0); PG8_MMA(1, 1, At, B1); PG8_BAR; PG8_SCHED;
            PG8_LDB(B0, 1, 0); PG8_LDB(B1, 1, 1); PG8_SCHED; PG8_LDA(At, 1, 0); PG8_STAGE(PG8_SA(0, 1), a2 + hstepA, voffA);
            PG8_WAIT_V(8); PG8_WAIT_L(0); PG8_BAR; PG8_MMA(0, 0, At, B0); PG8_MMA(0, 1, At, B1); PG8_BAR; PG8_SCHED;
            PG8_LDA(At, 1, 1); PG8_STAGE(PG8_SB(1, 0), b3, voffB); PG8_STAGE(PG8_SB(1, 1), b3 + hstepB, voffB); PG8_STAGE(PG8_SA(1, 0), a3, voffA);
            PG8_WAIT_V(8); PG8_WAIT_L(0); PG8_BAR; PG8_MMA(1, 0, At, B0); PG8_MMA(1, 1, At, B1); PG8_BAR; PG8_SCHED;
            } else {
            PG8_LDB(B0, 0, 0); PG8_SCHED; PG8_LDA(At, 0, 0); PG8_STAGE(PG8_SA(1, 1), a1 + hstepA, voffA);
            PG8_WAIT_L(8); PG8_BAR; PG8_WAIT_L(0); PG8_MMA(0, 0, At, B0); PG8_BAR; PG8_SCHED;
            PG8_LDB(B1, 0, 1); PG8_STAGE(PG8_SB(0, 0), b2, voffB);
            PG8_BAR; PG8_WAIT_L(0); PG8_MMA(0, 1, At, B1); PG8_BAR;
            PG8_LDA(At, 0, 1); PG8_STAGE(PG8_SA(0, 0), a2, voffA);
            PG8_BAR; PG8_WAIT_L(0); PG8_MMA(1, 0, At, B0); PG8_BAR; PG8_SCHED;
            PG8_STAGE(PG8_SB(0, 1), b2 + hstepB, voffB);
            PG8_WAIT_V(6); PG8_BAR; PG8_MMA(1, 1, At, B1); PG8_BAR;
            PG8_LDB(B0, 1, 0); PG8_SCHED; PG8_LDA(At, 1, 0); PG8_STAGE(PG8_SA(0, 1), a2 + hstepA, voffA);
            PG8_WAIT_L(8); PG8_BAR; PG8_WAIT_L(0); PG8_MMA(0, 0, At, B0); PG8_BAR; PG8_SCHED;
            PG8_LDB(B1, 1, 1); PG8_STAGE(PG8_SB(1, 0), b3, voffB);
            PG8_BAR; PG8_WAIT_L(0); PG8_MMA(0, 1, At, B1); PG8_BAR;
            PG8_LDA(At, 1, 1); PG8_STAGE(PG8_SA(1, 0), a3, voffA);
            PG8_BAR; PG8_WAIT_L(0); PG8_MMA(1, 0, At, B0); PG8_BAR; PG8_SCHED;
            PG8_STAGE(PG8_SB(1, 1), b3 + hstepB, voffB);
            PG8_WAIT_V(6); PG8_BAR; PG8_MMA(1, 1, At, B1); PG8_BAR;
            }
        }
        if constexpr (ALIGN_EPI) { if (wr == 0) PG8_BAR; }
        bool keep; { int ln; asm volatile("v_mbcnt_lo_u32_b32 %0, -1, 0\n\tv_mbcnt_hi_u32_b32 %0, -1, %0" : "=v"(ln)); keep = E(acc, cur, wr, wc, ln & 15, ln >> 4); }
        if (!has_next) break;
        if (!keep)
#pragma unroll
        for (int a = 0; a < 2; ++a)
#pragma unroll
            for (int b = 0; b < 2; ++b)
#pragma unroll
                for (int m = 0; m < 4; ++m)
#pragma unroll
                    for (int n = 0; n < 2; ++n) acc[a][b][m][n] = (f32x4){0.f, 0.f, 0.f, 0.f};
        cur = nxt; cA = nA; cB = nB; ++ui;
        if constexpr (ALIGN_EPI) { if (wr == 1) PG8_BAR; }
    }
    PG8_WAIT_V(0);
    if constexpr (!ALIGN_EPI) { if (wr == 0) PG8_BAR; }
    PG8_BAR;
#undef PG8_SA
#undef PG8_SB
#undef PG8_STAGE
#undef PG8_LDA
#undef PG8_LDB
#undef PG8_MMA
#undef PG8_WAIT_V
#undef PG8_WAIT_L
#undef PG8_BAR
#undef PG8_SCHED
}

__device__ __forceinline__ float fsigmoid(float x) { return __builtin_amdgcn_rcpf(1.f + __expf(-x)); }
struct EpiZ {
    static constexpr bool PERM = true;
    bf16* Z;
    __device__ __forceinline__ bool operator()(f32x4 (&acc)[2][2][4][2], const Unit& u, int wr, int wc, int fr, int fq) const {
        const int row0 = u.pm * BM + wr * 64 + fr, col0 = u.pn * BM + wc * 32 + 8 * fq;
        const int ty = u.pn >= 30 ? 2 : (u.pn >= 26 ? 1 : 0);
#pragma unroll
        for (int ai = 0; ai < 2; ++ai)
#pragma unroll
            for (int m = 0; m < 4; ++m) { bf16* rowp = Z + (size_t)(row0 + ai * HALF + m * 16) * ZW + col0;
#pragma unroll
                for (int bj = 0; bj < 2; ++bj) { f32x4 v0 = acc[ai][bj][m][0], v1 = acc[ai][bj][m][1];
                    if (ty == 2) {
#pragma unroll
                        for (int j = 0; j < 4; ++j) { v0[j] = fsigmoid(v0[j]); v1[j] = fsigmoid(v1[j]); } }
                    else if (ty == 1) {
#pragma unroll
                        for (int j = 0; j < 4; ++j) { v0[j] = v0[j] * fsigmoid(v0[j]); v1[j] = v1[j] * fsigmoid(v1[j]); } }
                    u32x4 w; w.x = cvt_pk_bf16(v0[0], v0[1]); w.y = cvt_pk_bf16(v0[2], v0[3]); w.z = cvt_pk_bf16(v1[0], v1[1]); w.w = cvt_pk_bf16(v1[2], v1[3]);
                    *(u32x4*)(rowp + bj * HALF) = w; } }
        return false;
    }
};
struct EpiMlp1 {
    static constexpr bool PERM = true;
    bf16* O; float* SLAB;
    __device__ __forceinline__ bool operator()(f32x4 (&acc)[2][2][4][2], const Unit& u, int wr, int wc, int fr, int fq) const {
        const int row0 = u.pm * BM + wr * 64 + fr, col0 = u.pn * BM + wc * 32 + 8 * fq;
        if (u.pm == MP / BM) { float* sl = SLAB + ((size_t)u.ks * BM + wr * 64 + fr) * DFF + col0;
#pragma unroll
            for (int ai = 0; ai < 2; ++ai)
#pragma unroll
                for (int m = 0; m < 4; ++m)
#pragma unroll
                    for (int bj = 0; bj < 2; ++bj) { float* p = sl + (size_t)(ai * HALF + m * 16) * DFF + bj * HALF; *(f32x4*)p = acc[ai][bj][m][0]; *(f32x4*)(p + 4) = acc[ai][bj][m][1]; }
            return false; }
#pragma unroll
        for (int ai = 0; ai < 2; ++ai)
#pragma unroll
            for (int m = 0; m < 4; ++m) { bf16* rowp = O + (size_t)(row0 + ai * HALF + m * 16) * DFF + col0;
#pragma unroll
                for (int bj = 0; bj < 2; ++bj) { f32x4 v0 = acc[ai][bj][m][0], v1 = acc[ai][bj][m][1];
#pragma unroll
                    for (int j = 0; j < 4; ++j) { const float a = fmaxf(v0[j], 0.f), b = fmaxf(v1[j], 0.f); v0[j] = a * a; v1[j] = b * b; }
                    u32x4 w; w.x = cvt_pk_bf16(v0[0], v0[1]); w.y = cvt_pk_bf16(v0[2], v0[3]); w.z = cvt_pk_bf16(v1[0], v1[1]); w.w = cvt_pk_bf16(v1[2], v1[3]);
                    *(u32x4*)(rowp + bj * HALF) = w; } }
        return false;
    }
};
struct EpiPool {
    static constexpr bool PERM = true;
    bf16* Y2; const float* spb; int l;
    __device__ __forceinline__ bool operator()(f32x4 (&acc)[2][2][4][2], const Unit& u, int wr, int wc, int fr, int fq) const {
        const int row0 = u.pm * BM + wr * 64 + fr, col0 = u.pn * BM + wc * 32 + 8 * fq;
        int le = l; asm volatile("" : "+s"(le)); const float* sp = spb + le * BRW;
        f32x4 s[2][2];
#pragma unroll
        for (int bj = 0; bj < 2; ++bj)
#pragma unroll
            for (int n = 0; n < 2; ++n) s[bj][n] = *(const f32x4*)(sp + col0 + bj * HALF + 4 * n);
#pragma unroll
        for (int ai = 0; ai < 2; ++ai)
#pragma unroll
            for (int m = 0; m < 4; ++m) { bf16* rowp = Y2 + (size_t)(row0 + ai * HALF + m * 16) * BRW + col0;
#pragma unroll
                for (int bj = 0; bj < 2; ++bj) { const f32x4 v0 = acc[ai][bj][m][0] * s[bj][0], v1 = acc[ai][bj][m][1] * s[bj][1];
                    u32x4 w; w.x = cvt_pk_bf16(v0[0], v0[1]); w.y = cvt_pk_bf16(v0[2], v0[3]); w.z = cvt_pk_bf16(v1[0], v1[1]); w.w = cvt_pk_bf16(v1[2], v1[3]);
                    *(u32x4*)(rowp + bj * HALF) = w; } }
        return false;
    }
};
struct EpiAda {
    static constexpr bool PERM = false;
    float* ADA; const float* bada;
    __device__ __forceinline__ bool operator()(f32x4 (&acc)[2][2][4][2], const Unit& u, int wr, int wc, int fr, int fq) const {
        if (wr != 0) return false;
        const int col0 = u.pn * BM + wc * 32 + 4 * fq;
#pragma unroll
        for (int m = 0; m < 3; ++m) { const int row = m * 16 + fr;
            if (row < NROWB) {
#pragma unroll
                for (int bj = 0; bj < 2; ++bj)
#pragma unroll
                    for (int n = 0; n < 2; ++n) { const int c = col0 + bj * HALF + n * 16; const f32x4 bv = *(const f32x4*)(bada + (size_t)u.r * ADAW + c);
                        *(f32x4*)(ADA + ((size_t)u.r * NROWB + row) * ADAW + c) = acc[0][bj][m][n] + bv; } } }
        return false;
    }
};
struct EpiBr {
    static constexpr bool PERM = true;
    const bf16* Z; bf16* MERGED; float* SLAB; int KS;
    static __device__ __forceinline__ void unp8(const u32x4 gw, f32x4& g0, f32x4& g1) { const float T = 8.6736174e-19f;
        g0[0] = fmaxf(__builtin_bit_cast(float, gw.x << 16), T); g0[1] = fmaxf(__builtin_bit_cast(float, gw.x & 0xffff0000u), T); g0[2] = fmaxf(__builtin_bit_cast(float, gw.y << 16), T); g0[3] = fmaxf(__builtin_bit_cast(float, gw.y & 0xffff0000u), T);
        g1[0] = fmaxf(__builtin_bit_cast(float, gw.z << 16), T); g1[1] = fmaxf(__builtin_bit_cast(float, gw.z & 0xffff0000u), T); g1[2] = fmaxf(__builtin_bit_cast(float, gw.w << 16), T); g1[3] = fmaxf(__builtin_bit_cast(float, gw.w & 0xffff0000u), T); }
    __device__ __forceinline__ bool operator()(f32x4 (&acc)[2][2][4][2], const Unit& u, int wr, int wc, int fr, int fq) const {
        const int row0 = u.pm * BM + wr * 64 + fr, col0 = u.pn * BM + wc * 32 + 8 * fq;
        const int r = u.r; const bool smp = u.pm == MP / BM;
        const bf16* gbase = Z + (size_t)row0 * ZW + ZGT + r * DM + col0;
#pragma unroll
        for (int ai = 0; ai < 2; ++ai) {
            u32x4 ga[4][2], gb[4][2];
#pragma unroll
            for (int m = 0; m < 4; ++m)
#pragma unroll
                for (int bj = 0; bj < 2; ++bj) { const bf16* gp = gbase + (size_t)(ai * HALF + m * 16) * ZW + bj * HALF; ga[m][bj] = *(const u32x4*)gp; gb[m][bj] = *(const u32x4*)(gp + DM); }
            asm volatile("" ::: "memory");
#pragma unroll
            for (int m = 0; m < 4; ++m)
#pragma unroll
                for (int bj = 0; bj < 2; ++bj) { const size_t row = (size_t)(row0 + ai * HALF + m * 16); const int c = col0 + bj * HALF;
                    f32x4 g0, g1; unp8(ga[m][bj], g0, g1);
                    if (smp) { float* sp = SLAB + ((size_t)(r * KS + u.ks) * BM + (row - MP)) * DM + c; *(f32x4*)sp = acc[ai][bj][m][0] * g0; *(f32x4*)(sp + 4) = acc[ai][bj][m][1] * g1; }
                    else if (r < 3) { f32x4 n0, n1; unp8(gb[m][bj], n0, n1);
#pragma unroll
                        for (int j = 0; j < 4; ++j) { acc[ai][bj][m][0][j] *= g0[j] * __builtin_amdgcn_rcpf(n0[j]); acc[ai][bj][m][1][j] *= g1[j] * __builtin_amdgcn_rcpf(n1[j]); } }
                    else { const f32x4 v0 = acc[ai][bj][m][0] * g0, v1 = acc[ai][bj][m][1] * g1;
                        u32x4 w; w.x = cvt_pk_bf16(v0[0], v0[1]); w.y = cvt_pk_bf16(v0[2], v0[3]); w.z = cvt_pk_bf16(v1[0], v1[1]); w.w = cvt_pk_bf16(v1[2], v1[3]);
                        *(u32x4*)(MERGED + row * DM + c) = w; } }
        }
        return !smp && r < 3;
    }
};
struct EpiRes {
    static constexpr bool PERM = false;
    const float* baseP; const float* baseS; float* out; const float* gate; float* SLAB;
    __device__ __forceinline__ bool operator()(f32x4 (&acc)[2][2][4][2], const Unit& u, int wr, int wc, int fr, int fq) const {
        const int rl0 = wr * 64 + fr, col0 = u.pn * BM + wc * 32 + 4 * fq;
        const bool smp = u.pm >= MP / BM;
        if (smp) { float* sl = SLAB + ((size_t)u.ks * BM + rl0) * DM + col0;
#pragma unroll
            for (int ai = 0; ai < 2; ++ai)
#pragma unroll
                for (int m = 0; m < 4; ++m)
#pragma unroll
                    for (int bj = 0; bj < 2; ++bj)
#pragma unroll
                        for (int n = 0; n < 2; ++n) *(f32x4*)(sl + (size_t)(ai * HALF + m * 16) * DM + bj * HALF + n * 16) = acc[ai][bj][m][n];
            return false; }
        const float* base = baseP + (size_t)u.pm * BM * DM + (size_t)rl0 * DM + col0;
        float* o = out + (size_t)u.pm * BM * DM + (size_t)rl0 * DM + col0;
        const float* gp = gate + (size_t)(u.pm >> 4) * ADAW + col0;
        f32x4 gv[2][2];
#pragma unroll
        for (int bj = 0; bj < 2; ++bj)
#pragma unroll
            for (int n = 0; n < 2; ++n) gv[bj][n] = *(const f32x4*)(gp + bj * HALF + n * 16);
#pragma unroll
        for (int ai = 0; ai < 2; ++ai) {
            f32x4 bs[4][2][2];
#pragma unroll
            for (int m = 0; m < 4; ++m)
#pragma unroll
                for (int bj = 0; bj < 2; ++bj)
#pragma unroll
                    for (int n = 0; n < 2; ++n) bs[m][bj][n] = *(const f32x4*)(base + (size_t)(ai * HALF + m * 16) * DM + bj * HALF + n * 16);
            asm volatile("" ::: "memory");
#pragma unroll
            for (int m = 0; m < 4; ++m)
#pragma unroll
                for (int bj = 0; bj < 2; ++bj)
#pragma unroll
                    for (int n = 0; n < 2; ++n) *(f32x4*)(o + (size_t)(ai * HALF + m * 16) * DM + bj * HALF + n * 16) = bs[m][bj][n] + gv[bj][n] * acc[ai][bj][m][n];
        }
        return false;
    }
};
}

constexpr int NWAVES = 8, NTHR = NWAVES * 64;
constexpr size_t MiB = 1u << 20;
constexpr size_t al1(size_t x) { return (x + MiB - 1) / MiB * MiB; }
constexpr size_t WS_CTL = 0, CTL_ZERO_BYTES = 1 * MiB;
constexpr size_t WS_WIN = WS_CTL + CTL_ZERO_BYTES;
constexpr size_t WS_WBR = WS_WIN + al1((size_t)DEPTH * ZW * DM * 2);
constexpr size_t WS_WOUT = WS_WBR + al1((size_t)DEPTH * 4 * DM * BRW * 2);
constexpr size_t WS_WM1 = WS_WOUT + al1((size_t)DEPTH * DM * DM * 2);
constexpr size_t WS_WM2 = WS_WM1 + al1((size_t)DEPTH * DFF * DM * 2);
constexpr size_t WS_WPOOL = WS_WM2 + al1((size_t)DEPTH * DFF * DM * 2);
constexpr size_t WS_WADA = WS_WPOOL + al1((size_t)DEPTH * 4 * 256 * 256 * 2);
constexpr size_t WS_SC = WS_WADA + al1((size_t)DEPTH * ADAW * DM * 2);
constexpr size_t WS_ADA = WS_SC + al1((size_t)256 * DM * 2);
constexpr size_t WS_H = WS_ADA + al1((size_t)DEPTH * NROWB * ADAW * 4);
constexpr size_t WS_Z = WS_H + al1((size_t)M * DM * 2);
constexpr size_t WS_Y = WS_Z + al1((size_t)M * ZW * 2);
constexpr size_t WS_ZP = WS_Y + al1((size_t)4 * M * BRW * 2);
constexpr size_t WS_CONVY = WS_ZP + al1((size_t)M * BRW * 2);
constexpr size_t WS_ORAW = WS_CONVY + al1((size_t)M * BRW * 4);
constexpr size_t WS_KV = WS_ORAW + al1((size_t)M * BRW * 4);
constexpr size_t WS_SPREV = WS_KV + al1((size_t)NBP * 32 * RH * RDK * RDV * 4);
constexpr size_t WS_MACC = WS_SPREV + al1((size_t)NBP * 32 * RH * RDK * RDV * 4);
constexpr size_t WS_MERGED = WS_MACC + al1((size_t)M * DM * 4);
constexpr size_t WS_X1 = WS_MERGED + al1((size_t)M * DM * 2);
constexpr size_t WS_X = WS_X1 + al1((size_t)M * DM * 4);
constexpr size_t WS_HID = WS_X + al1((size_t)M * DM * 4);
constexpr size_t WS_SLAB = WS_HID + al1((size_t)M * DFF * 2);
constexpr size_t WS_END = WS_SLAB + al1((size_t)16 * MS * DM * 4);
constexpr int CW_BAR = 4096;
constexpr int RING_OFF = 0, RING_BYTES = 131072, LDSCTL_OFF = RING_BYTES, MISC_OFF = LDSCTL_OFF + 320, INTAB_OFF = MISC_OFF + 128, LDS_BYTES = 147456;

#define GAS __attribute__((address_space(1)))
#define LAS __attribute__((address_space(3)))
typedef unsigned v4u __attribute__((ext_vector_type(4)));
typedef float f32x4 __attribute__((ext_vector_type(4)));
typedef GAS unsigned gu32;
#define RLX_AGENT __ATOMIC_RELAXED, __HIP_MEMORY_SCOPE_AGENT
#define LDS_WAIT() asm volatile("s_waitcnt lgkmcnt(0)" ::: "memory")
__device__ __forceinline__ unsigned pk2(float lo, float hi) { return (unsigned)f2bf(lo) | ((unsigned)f2bf(hi) << 16); }

#define XB_TMO      128
#define XB_XCNT(j)  (256  + 64 * (j))
#define XB_XSUB(j)  (1280 + 64 * (j))
#define XB_XGEN(j)  (2304 + 64 * (j))
#define XB_TOP      3328
#define XB_TOPGEN   3392
#define XCD_BAR_WORDS 3456
#define XB_SPIN_CAP (1u << 18)
__device__ __forceinline__ unsigned xb_ld(unsigned* p)              { return __hip_atomic_load(p, __ATOMIC_RELAXED, __HIP_MEMORY_SCOPE_AGENT); }
__device__ __forceinline__ unsigned xb_add(unsigned* p, unsigned v) { return __hip_atomic_fetch_add(p, v, __ATOMIC_RELAXED, __HIP_MEMORY_SCOPE_AGENT); }
__device__ __forceinline__ unsigned xb_xcc_id() { return (unsigned)__builtin_amdgcn_s_getreg((3 << 11) | 20) & 0xFu; }
#define XB_SPIN(cond, bar) do { unsigned _sp = 0; while (cond) { __builtin_amdgcn_s_sleep(1); \
    if ((++_sp & 255u) == 0u) { if (xb_ld(&(bar)[XB_TMO])) break; if (_sp > XB_SPIN_CAP) { atomicAdd(&(bar)[XB_TMO], 1u); break; } } } } while (0)
struct XcdBarrier { unsigned* bar; unsigned x; volatile LAS unsigned* st; };
__device__ __forceinline__ XcdBarrier xcd_barrier_post(unsigned* bar, volatile LAS unsigned* st) {
    XcdBarrier b; b.bar = bar; b.x = xb_xcc_id(); b.st = st;
    if (threadIdx.x == 0) (void)xb_add(&bar[XB_XCNT(b.x)], 1u);
    return b;
}
__device__ __forceinline__ void xcd_barrier_complete(unsigned* bar, unsigned x, unsigned& nloc, unsigned& nx) {
    const unsigned G = gridDim.x * gridDim.y * gridDim.z;
    unsigned sum, cnt, mine, sp = 0u;
    for (;;) {
        sum = 0u; cnt = 0u; mine = 0u;
#pragma unroll
        for (unsigned j = 0; j < 16; ++j) { const unsigned c = xb_ld(&bar[XB_XCNT(j)]); sum += c; cnt += (c > 0u) ? 1u : 0u; mine = (j == x) ? c : mine; }
        if (sum == G) break;
        __builtin_amdgcn_s_sleep(1);
        if ((++sp & 255u) == 0u) { if (xb_ld(&bar[XB_TMO])) break; if (sp > XB_SPIN_CAP) { atomicAdd(&bar[XB_TMO], 1u); break; } }
    }
    nloc = mine > 0u ? mine : 1u; nx = cnt > 0u ? cnt : 1u;
}
__device__ __forceinline__ void xcd_barrier(const XcdBarrier& b) {
    asm volatile("s_waitcnt vmcnt(0)" ::: "memory");
    __syncthreads();
    if (threadIdx.x == 0) {
        unsigned* bar = b.bar;
        __builtin_amdgcn_s_waitcnt(0);
        unsigned nloc = b.st[0], nx = b.st[1];
        if (nloc == 0u) { xcd_barrier_complete(bar, b.x, nloc, nx); b.st[0] = nloc; b.st[1] = nx; }
        const unsigned old = xb_add(&bar[XB_XSUB(b.x)], 1u);
        const unsigned gen = old / nloc;
        if (old + 1u == (gen + 1u) * nloc) {
            __builtin_amdgcn_fence(__ATOMIC_RELEASE, "agent");
            asm volatile("s_waitcnt vmcnt(0)" ::: "memory");
            const unsigned og = xb_add(&bar[XB_TOP], 1u);
            const unsigned tg = og / nx;
            if (og + 1u == (tg + 1u) * nx) xb_add(&bar[XB_TOPGEN], 1u);
            else XB_SPIN(xb_ld(&bar[XB_TOPGEN]) == tg, bar);
            __builtin_amdgcn_fence(__ATOMIC_ACQUIRE, "agent");
            xb_add(&bar[XB_XGEN(b.x)], 1u);
            asm volatile("s_waitcnt vmcnt(0)" ::: "memory");
        } else {
            XB_SPIN(xb_ld(&bar[XB_XGEN(b.x)]) == gen, bar);
            __builtin_amdgcn_fence(__ATOMIC_ACQUIRE, "agent");
            asm volatile("s_waitcnt vmcnt(0)" ::: "memory");
        }
    }
    __syncthreads();
}

template <int CTRL> __device__ __forceinline__ float dpp_f(float v) { return __builtin_bit_cast(float, __builtin_amdgcn_update_dpp(0, __builtin_bit_cast(int, v), CTRL, 0xf, 0xf, false)); }
__device__ __forceinline__ float wave_sum(float v) {
    v += dpp_f<0xB1>(v);
    v += dpp_f<0x4E>(v);
    v += dpp_f<0x141>(v);
    v += dpp_f<0x140>(v);
    v += __builtin_bit_cast(float, __builtin_amdgcn_ds_swizzle(__builtin_bit_cast(int, v), 0x401F));
    return __builtin_bit_cast(float, __builtin_amdgcn_readlane(__builtin_bit_cast(int, v), 0)) + __builtin_bit_cast(float, __builtin_amdgcn_readlane(__builtin_bit_cast(int, v), 32));
}
typedef float tr_f32x4 __attribute__((ext_vector_type(4)));
#define TR_LOAD(V, P) _Pragma("unroll") for (int j = 0; j < 8; ++j) V[j] = __builtin_nontemporal_load((const GAS tr_f32x4*)((P) + (size_t)j * N))
#define TR_STORE(V, Q) _Pragma("unroll") for (int i = 0; i < 4; ++i) { v4u o; o.x = pk2(V[0][i], V[1][i]); o.y = pk2(V[2][i], V[3][i]); o.z = pk2(V[4][i], V[5][i]); o.w = pk2(V[6][i], V[7][i]); *(GAS v4u*)((Q) + (size_t)i * K) = o; }
template <int K, int N>
__device__ __forceinline__ void transpose_run(const float* W, bf16* T, int nmat, int gw, int NGW, int lane) {
    constexpr int NB = N / 32, IPM = (K / 64) * NB; const int total = nmat * IPM;
    const unsigned lo_p = (unsigned)(8 * (lane >> 3)) * N + 4 * (lane & 7), lo_q = (unsigned)(4 * (lane & 7)) * K + 8 * (lane >> 3);
    auto addr = [&](int it, const float*& p, bf16*& q) { it = it < total ? it : total - 1; const int mi = it / IPM, r = it % IPM, kb = r / NB, nb = r % NB;
        p = W + ((size_t)mi * K * N + (size_t)(64 * kb) * N + 32 * nb) + lo_p;
        q = T + ((size_t)mi * K * N + (size_t)(32 * nb) * K + 64 * kb) + lo_q; };
    int it = gw; if (it >= total) return;
    tr_f32x4 va[8], vb[8]; const float *pa, *pb; bf16 *qa, *qb;
    addr(it, pa, qa); TR_LOAD(va, pa);
    for (;;) {
        const int i1 = it + NGW; addr(i1, pb, qb); TR_LOAD(vb, pb);
        asm volatile("" ::: "memory"); TR_STORE(va, qa); asm volatile("" ::: "memory");
        if (i1 >= total) break;
        const int i2 = i1 + NGW; addr(i2, pa, qa); TR_LOAD(va, pa);
        asm volatile("" ::: "memory"); TR_STORE(vb, qb); asm volatile("" ::: "memory");
        if (i2 >= total) break;
        it = i2; }
}
__device__ __forceinline__ void load_mod(const float* g, const float* sc, const float* shp, f32x4 (&gm)[8], f32x4 (&sh)[8], int lane) {
#pragma unroll
    for (int j = 0; j < 8; ++j) { gm[j] = ((const f32x4*)g)[lane + 64 * j] * (((const f32x4*)sc)[lane + 64 * j] + 1.f); sh[j] = ((const f32x4*)shp)[lane + 64 * j]; }
}
__device__ __forceinline__ void norm_store(const f32x4 (&v)[8], float ss, const f32x4 (&gm)[8], const f32x4 (&sh)[8], bf16* orow, int lane) {
    const float rstd = 1.f / sqrtf(wave_sum(ss) * (1.f / DM) + EPS);
#pragma unroll
    for (int j = 0; j < 8; ++j) { const f32x4 y = v[j] * rstd * gm[j] + sh[j];
        ((unsigned long long*)orow)[lane + 64 * j] = (unsigned long long)pk2(y.x, y.y) | ((unsigned long long)pk2(y.z, y.w) << 32); }
}
__device__ __forceinline__ void norm_row2(const float* xa, const float* xb, const f32x4 (&gm)[8], const f32x4 (&sh)[8], bf16* oa, bf16* ob, int lane) {
    f32x4 va[8], vb[8]; float sa = 0.f, sb = 0.f;
#pragma unroll
    for (int j = 0; j < 8; ++j) { va[j] = ((const f32x4*)xa)[lane + 64 * j]; vb[j] = ((const f32x4*)xb)[lane + 64 * j]; }
#pragma unroll
    for (int j = 0; j < 8; ++j) { sa += (va[j].x * va[j].x + va[j].y * va[j].y) + (va[j].z * va[j].z + va[j].w * va[j].w); sb += (vb[j].x * vb[j].x + vb[j].y * vb[j].y) + (vb[j].z * vb[j].z + vb[j].w * vb[j].w); }
    norm_store(va, sa, gm, sh, oa, lane); norm_store(vb, sb, gm, sh, ob, lane);
}
__device__ __forceinline__ void norm_row(const float* xrow, const f32x4 (&gm)[8], const f32x4 (&sh)[8], bf16* orow, int lane) {
    f32x4 v[8]; float ss = 0.f;
#pragma unroll
    for (int j = 0; j < 8; ++j) { v[j] = ((const f32x4*)xrow)[lane + 64 * j]; ss += (v[j].x * v[j].x + v[j].y * v[j].y) + (v[j].z * v[j].z + v[j].w * v[j].w); }
    norm_store(v, ss, gm, sh, orow, lane);
}
template <int NP> __device__ __forceinline__ void norm_row_block(const float* base, const float* gate, const float* slab, size_t ps, float* xdst, const float* g, const float* sc, const float* shp, bf16* orow, LAS float* red, int tid, int wave) {
    f32x4 v = ((const f32x4*)base)[tid];
    if (NP > 0) { f32x4 pv[NP > 0 ? NP : 1];
#pragma unroll
        for (int p = 0; p < NP; ++p) pv[p] = ((const f32x4*)(slab + (size_t)p * ps))[tid];
        f32x4 a = pv[0];
#pragma unroll
        for (int p = 1; p < NP; ++p) a += pv[p];
        v += ((const f32x4*)gate)[tid] * a; ((f32x4*)xdst)[tid] = v; }
    const float ws = wave_sum((v.x * v.x + v.y * v.y) + (v.z * v.z + v.w * v.w));
    if ((tid & 63) == 0) red[wave] = ws;
    __syncthreads();
    float ss = 0.f;
#pragma unroll
    for (int w = 0; w < NWAVES; ++w) ss += red[w];
    const float rstd = 1.f / sqrtf(ss * (1.f / DM) + EPS);
    const f32x4 y = v * rstd * ((const f32x4*)g)[tid] * (((const f32x4*)sc)[tid] + 1.f) + ((const f32x4*)shp)[tid];
    ((unsigned long long*)orow)[tid] = (unsigned long long)pk2(y.x, y.y) | ((unsigned long long)pk2(y.z, y.w) << 32);
    __syncthreads();
}
__device__ __forceinline__ void convln_row(const float* yrow, const f32x4 (&gv4)[4], const f32x4 (&bv4)[4], bf16* orow, int lane) {
    f32x4 v[4]; float s = 0.f;
#pragma unroll
    for (int j = 0; j < 4; ++j) { v[j] = ((const f32x4*)yrow)[lane + 64 * j]; s += (v[j].x + v[j].y) + (v[j].z + v[j].w); }
    const float mean = wave_sum(s) * (1.f / BRW); float q = 0.f;
#pragma unroll
    for (int j = 0; j < 4; ++j) { v[j] = v[j] - mean; q += (v[j].x * v[j].x + v[j].y * v[j].y) + (v[j].z * v[j].z + v[j].w * v[j].w); }
    const float rstd = 1.f / sqrtf(wave_sum(q) * (1.f / BRW) + EPS);
#pragma unroll
    for (int j = 0; j < 4; ++j) { f32x4 y = v[j] * rstd * gv4[j] + bv4[j];
        y.x = y.x * sigmoidf_(y.x); y.y = y.y * sigmoidf_(y.y); y.z = y.z * sigmoidf_(y.z); y.w = y.w * sigmoidf_(y.w);
        ((unsigned long long*)orow)[lane + 64 * j] = (unsigned long long)pk2(y.x, y.y) | ((unsigned long long)pk2(y.z, y.w) << 32); }
}


namespace att {
typedef short bf16x8 __attribute__((ext_vector_type(8)));
typedef short s16x4 __attribute__((ext_vector_type(4)));
typedef float f32x4 __attribute__((ext_vector_type(4)));
typedef float f32x2_t __attribute__((ext_vector_type(2))); typedef __bf16 bf16x2_t __attribute__((ext_vector_type(2)));
constexpr int KP = 144, NROWS = 272, K_OFF = 0, V_OFF = NROWS * KP, LDS_NEED = 2 * NROWS * KP;
__device__ __forceinline__ unsigned cvtpk(float lo, float hi) { f32x2_t v = {lo, hi}; bf16x2_t b = __builtin_convertvector(v, bf16x2_t); return __builtin_bit_cast(unsigned, b); }
__device__ __forceinline__ float red4_max(float v) {
    v = fmaxf(v, __builtin_bit_cast(float, __builtin_amdgcn_ds_swizzle(__builtin_bit_cast(int, v), 0x401F)));
    unsigned x = __builtin_bit_cast(unsigned, v), y = x; asm volatile("" : "+v"(y));
    auto rr = __builtin_amdgcn_permlane32_swap(x, y, false, false); const unsigned r0 = rr[0], r1 = rr[1];
    return fmaxf(__builtin_bit_cast(float, r0), __builtin_bit_cast(float, r1)); }
__device__ __forceinline__ float red4_sum(float v) {
    v += __builtin_bit_cast(float, __builtin_amdgcn_ds_swizzle(__builtin_bit_cast(int, v), 0x401F));
    unsigned x = __builtin_bit_cast(unsigned, v), y = x; asm volatile("" : "+v"(y));
    auto rr = __builtin_amdgcn_permlane32_swap(x, y, false, false); const unsigned r0 = rr[0], r1 = rr[1];
    return __builtin_bit_cast(float, r0) + __builtin_bit_cast(float, r1); }
__device__ __forceinline__ s16x4 vtr(const LAS unsigned char* p) { typedef short v4i16_t __attribute__((ext_vector_type(4))); return __builtin_bit_cast(s16x4, __builtin_amdgcn_ds_read_tr16_b64_v4i16((LAS v4i16_t*)p)); }

__device__ __forceinline__ void tile16(const bf16x8 qf0, const bf16x8 qf1, const LAS unsigned char* Ks, const LAS unsigned char* Vs, int kbase, int wpos0, float slope2, float sink2, bf16* Yq, int nst, int lane) {
    const int c = lane & 15, g = lane >> 4;
    f32x4 st[9];
#pragma unroll
    for (int kt = 0; kt < 9; ++kt) { const LAS unsigned char* kp = Ks + (kbase + 16 * kt + c) * KP + 16 * g;
        const bf16x8 k0 = *(const LAS bf16x8*)kp, k1 = *(const LAS bf16x8*)(kp + 64);
        f32x4 a = {0.f, 0.f, 0.f, 0.f};
        a = __builtin_amdgcn_mfma_f32_16x16x32_bf16(k0, qf0, a, 0, 0, 0); a = __builtin_amdgcn_mfma_f32_16x16x32_bf16(k1, qf1, a, 0, 0, 0); st[kt] = a; }
    float SC2 = 0.125f * 1.4426950408889634f; asm volatile("" : "+v"(SC2));
    const int dbase = 128 + c - 4 * g;
    float m = sink2;
#pragma unroll
    for (int kt = 0; kt < 9; ++kt)
#pragma unroll
        for (int r = 0; r < 4; ++r) { const int dist = dbase - r - 16 * kt, kk = 16 * kt + 4 * g + r; const bool ok = (unsigned)dist <= 128u && (wpos0 + kk) >= 0;
            const float sv = ok ? st[kt][r] * SC2 - slope2 * (float)dist : -INFINITY; st[kt][r] = sv; m = fmaxf(m, sv); }
    m = red4_max(m);
    float sum = 0.f;
#pragma unroll
    for (int kt = 0; kt < 9; ++kt)
#pragma unroll
        for (int r = 0; r < 4; ++r) { const float p = __builtin_amdgcn_exp2f(st[kt][r] - m); st[kt][r] = p; sum += p; }
    sum = red4_sum(sum) + __builtin_amdgcn_exp2f(sink2 - m);
    const float inv = 1.f / sum;
    bf16x8 pf[5];
#pragma unroll
    for (int k = 0; k < 5; ++k) { unsigned w0 = cvtpk(st[2 * k][0] * inv, st[2 * k][1] * inv), w1 = cvtpk(st[2 * k][2] * inv, st[2 * k][3] * inv), w2 = 0u, w3 = 0u;
        if (k < 4) { w2 = cvtpk(st[2 * k + 1][0] * inv, st[2 * k + 1][1] * inv); w3 = cvtpk(st[2 * k + 1][2] * inv, st[2 * k + 1][3] * inv); }
        typedef unsigned u32x4_t __attribute__((ext_vector_type(4))); const u32x4_t w = {w0, w1, w2, w3}; pf[k] = __builtin_bit_cast(bf16x8, w); }
    f32x4 o[4];
#pragma unroll
    for (int dt = 0; dt < 4; ++dt) o[dt] = (f32x4){0.f, 0.f, 0.f, 0.f};
    const LAS unsigned char* vb = Vs + (kbase + 4 * g + (c >> 2)) * KP + 8 * (c & 3);
#pragma unroll
    for (int k = 0; k < 5; ++k)
#pragma unroll
        for (int dt = 0; dt < 4; ++dt) { const s16x4 lo = vtr(vb + (32 * k) * KP + 32 * dt), hi = vtr(vb + (32 * k + 16) * KP + 32 * dt);
            const bf16x8 b = {lo[0], lo[1], lo[2], lo[3], hi[0], hi[1], hi[2], hi[3]};
            o[dt] = __builtin_amdgcn_mfma_f32_16x16x32_bf16(pf[k], b, o[dt], 0, 0, 0); }
#pragma unroll
    for (int r = 0; r < 4; ++r) if (4 * g + r < nst) {
#pragma unroll
        for (int dt = 0; dt < 4; ++dt) Yq[(size_t)(4 * g + r) * BRW + 16 * dt + c] = f2bf(o[dt][r]); }
}
typedef unsigned u32x4_t __attribute__((ext_vector_type(4)));
__device__ __forceinline__ u32x4_t pack8(const float* f) { u32x4_t w; w.x = cvtpk(f[0], f[1]); w.y = cvtpk(f[2], f[3]); w.z = cvtpk(f[4], f[5]); w.w = cvtpk(f[6], f[7]); return w; }
__device__ __forceinline__ void phase(LAS unsigned char* lds, const bf16* Z, int l, const float* sinks, const float* ck, const float* cv, bf16* Y0, int bx, int G, int tid, int lane, int wave) {
    LAS unsigned char* Ks = lds + K_OFF; LAS unsigned char* Vs = lds + V_OFF;
    const u32x4_t zero4 = {0u, 0u, 0u, 0u};
    for (int it = bx; it < NBP * 32 * NKV + SB * NKV; it += G) {
        const int kvh = it & 3;
        if (it < NBP * 32 * NKV) {
            const int b = it >> 7, qb = (it >> 2) & 31;
#pragma unroll
            for (int i = 0; i < 4; ++i) { const int p = tid + NTHR * i, sr = p >> 3, cc = p & 7; const int pos = 128 * (qb - 1) + sr;
                u32x4_t kq = zero4, vq = zero4;
                if (pos >= 0) { const bf16* zr = Z + (size_t)(b * SEQ + pos) * ZW + kvh * 64 + cc * 8; kq = *(const u32x4_t*)(zr + ZK); vq = *(const u32x4_t*)(zr + ZV); }
                *(LAS u32x4_t*)(Ks + sr * KP + cc * 16) = kq; *(LAS u32x4_t*)(Vs + sr * KP + cc * 16) = vq; }
            if (tid < 128) { const int sr = 256 + (tid >> 3), cc = tid & 7; *(LAS u32x4_t*)(Ks + sr * KP + cc * 16) = zero4; *(LAS u32x4_t*)(Vs + sr * KP + cc * 16) = zero4; }
            __syncthreads();
            const int hq = kvh * 4 + (wave >> 1), qh = wave & 1;
            const float slope2 = exp2f(-0.5f * (float)(hq + 1)) * 1.4426950408889634f, sink2 = sinks[l * NH + hq] * 1.4426950408889634f;
            const bf16* qp0 = Z + ((size_t)b * SEQ + 128 * qb + 64 * qh + (lane & 15)) * ZW + ZQ + hq * 64 + 8 * (lane >> 4);
            bf16x8 qc0 = *(const bf16x8*)qp0, qc1 = *(const bf16x8*)(qp0 + 32);
#pragma unroll 1
            for (int qt = 0; qt < 4; ++qt) { const int t1 = 64 * qh + 16 * qt; const size_t qrow0 = (size_t)b * SEQ + 128 * qb + t1;
                const bf16* qpn = qp0 + (size_t)(16 * (qt < 3 ? qt + 1 : 3)) * ZW; const bf16x8 qn0 = *(const bf16x8*)qpn, qn1 = *(const bf16x8*)(qpn + 32);
                tile16(qc0, qc1, Ks, Vs, t1, 128 * qb + t1 - 128, slope2, sink2, Y0 + qrow0 * BRW + hq * 64, 16, lane);
                qc0 = qn0; qc1 = qn1; }
        } else {
            const int sb = (it - NBP * 32 * NKV) >> 2;
#pragma unroll
            for (int i = 0; i < 3; ++i) { const int p = tid + NTHR * i, sr = p >> 3, cc = p & 7;
                if (sr < 160) { u32x4_t kq = zero4, vq = zero4;
                    if (sr < WIN) { const size_t o = ((((size_t)l * SB + sb) * WIN + sr) * NKV + kvh) * 64 + cc * 8; float f[8];
#pragma unroll
                        for (int e = 0; e < 8; ++e) f[e] = ck[o + e];
                        kq = pack8(f);
#pragma unroll
                        for (int e = 0; e < 8; ++e) f[e] = cv[o + e];
                        vq = pack8(f);
                    } else if (sr < WIN + ST) { const bf16* zr = Z + (size_t)(MP + sb * ST + (sr - WIN)) * ZW + kvh * 64 + cc * 8; kq = *(const u32x4_t*)(zr + ZK); vq = *(const u32x4_t*)(zr + ZV); }
                    *(LAS u32x4_t*)(Ks + sr * KP + cc * 16) = kq; *(LAS u32x4_t*)(Vs + sr * KP + cc * 16) = vq; } }
            __syncthreads();
            if (wave < 4) { const int hq = kvh * 4 + wave;
                const float slope2 = exp2f(-0.5f * (float)(hq + 1)) * 1.4426950408889634f, sink2 = sinks[l * NH + hq] * 1.4426950408889634f;
                const size_t qrow0 = (size_t)MP + sb * ST; const bf16* qp = Z + (qrow0 + (lane & 7)) * ZW + ZQ + hq * 64 + 8 * (lane >> 4);
                tile16(*(const bf16x8*)qp, *(const bf16x8*)(qp + 32), Ks, Vs, 0, 0, slope2, sink2, Y0 + qrow0 * BRW + hq * 64, ST, lane); }
        }
        __syncthreads();
    }
}
}

namespace adad {
using att::bf16x8; using att::f32x4; using att::cvtpk;
constexpr int NSTRIP = ADAW / 64, RW = 576, A2_OFF = 8 * RW * 16, A2_WAVE = 3 * 512;
#define ADA_LOAD(V, S) _Pragma("unroll") for (int j = 0; j < 8; ++j) V[j] = __builtin_nontemporal_load((const GAS f32x4*)(wp + (size_t)(32 * (S) + j) * ADAW))
__device__ __forceinline__ v4u silu8(f32x4 x0, f32x4 x1) { v4u o;
    o.x = cvtpk(x0.x * sigmoidf_(x0.x), x0.y * sigmoidf_(x0.y)); o.y = cvtpk(x0.z * sigmoidf_(x0.z), x0.w * sigmoidf_(x0.w));
    o.z = cvtpk(x1.x * sigmoidf_(x1.x), x1.y * sigmoidf_(x1.y)); o.w = cvtpk(x1.z * sigmoidf_(x1.z), x1.w * sigmoidf_(x1.w)); return o; }
__device__ __forceinline__ const GAS float* crow(const float* cp, const float* cs, int row) { return row < NBP ? (const GAS float*)cp + (size_t)row * DM : (const GAS float*)cs + (size_t)(row - NBP) * DM; }
__device__ __forceinline__ void phase(const float* cp, const float* cs, const float* wada, const float* bada, float* ADA, LAS unsigned char* lds, int bx, int G, int wave, int lane, int tid) {
    const int kl = 256 * wave + 8 * (lane >> 4);
    bf16x8 af[2][8];
#pragma unroll
    for (int mb = 0; mb < 2; ++mb) { const GAS float* src = crow(cp, cs, 16 * mb + (lane & 15)) + kl;
#pragma unroll
        for (int s = 0; s < 8; ++s) af[mb][s] = __builtin_bit_cast(bf16x8, silu8(*(const GAS f32x4*)(src + 32 * s), *(const GAS f32x4*)(src + 32 * s + 4))); }
    LAS unsigned char* a2 = lds + A2_OFF + wave * A2_WAVE;
    {   const GAS float* src = crow(cp, cs, 32 + (lane >> 5)) + 256 * wave + 8 * (lane & 31);
        *(LAS v4u*)(a2 + (lane >> 5) * 512 + (lane & 31) * 16) = silu8(*(const GAS f32x4*)src, *(const GAS f32x4*)(src + 4));
        if (lane < 32) { v4u z = {0u, 0u, 0u, 0u}; *(LAS v4u*)(a2 + 2 * 512 + lane * 16) = z; }
        LDS_WAIT(); asm volatile("" ::: "memory"); }
    const LAS unsigned char* a2r = a2 + ((lane & 15) < 2 ? (lane & 15) : 2) * 512 + (lane >> 4) * 16;
    LAS f32x4* red = (LAS f32x4*)lds;
    for (int g = bx; g < DEPTH * NSTRIP; g += G) { const int l = g / NSTRIP, n0 = 64 * (g % NSTRIP);
        const GAS float* wp = (const GAS float*)wada + (size_t)l * DM * ADAW + (size_t)kl * ADAW + n0 + 4 * (lane & 15);
        f32x4 acc[3][4];
#pragma unroll
        for (int mb = 0; mb < 3; ++mb)
#pragma unroll
            for (int i = 0; i < 4; ++i) acc[mb][i] = f32x4{0.f, 0.f, 0.f, 0.f};
        f32x4 v0[8], v1[8];
        ADA_LOAD(v0, 0);
#pragma unroll
        for (int s = 0; s < 8; ++s) {
            if (s < 7) { if (s & 1) { ADA_LOAD(v0, s + 1); } else { ADA_LOAD(v1, s + 1); } }
            asm volatile("" ::: "memory");
            const bf16x8 a2f = *(const LAS bf16x8*)(a2r + 64 * s);
#pragma unroll
            for (int i = 0; i < 4; ++i) { v4u w;
                if (s & 1) { w.x = cvtpk(v1[0][i], v1[1][i]); w.y = cvtpk(v1[2][i], v1[3][i]); w.z = cvtpk(v1[4][i], v1[5][i]); w.w = cvtpk(v1[6][i], v1[7][i]); }
                else       { w.x = cvtpk(v0[0][i], v0[1][i]); w.y = cvtpk(v0[2][i], v0[3][i]); w.z = cvtpk(v0[4][i], v0[5][i]); w.w = cvtpk(v0[6][i], v0[7][i]); }
                const bf16x8 bfr = __builtin_bit_cast(bf16x8, w);
                acc[0][i] = __builtin_amdgcn_mfma_f32_16x16x32_bf16(af[0][s], bfr, acc[0][i], 0, 0, 0);
                acc[1][i] = __builtin_amdgcn_mfma_f32_16x16x32_bf16(af[1][s], bfr, acc[1][i], 0, 0, 0);
                acc[2][i] = __builtin_amdgcn_mfma_f32_16x16x32_bf16(a2f, bfr, acc[2][i], 0, 0, 0); }
            asm volatile("" ::: "memory"); }
        LAS f32x4* rw = red + wave * RW;
#pragma unroll
        for (int mb = 0; mb < 2; ++mb)
#pragma unroll
            for (int i = 0; i < 4; ++i) rw[(mb * 4 + i) * 64 + lane] = acc[mb][i];
        if (lane < 16) {
#pragma unroll
            for (int i = 0; i < 4; ++i) rw[512 + i * 16 + lane] = acc[2][i]; }
        __syncthreads();
        for (int e = tid; e < RW; e += NTHR) { f32x4 t = red[e];
#pragma unroll
            for (int w = 1; w < 8; ++w) t += red[w * RW + e];
            int row0, col;
            if (e < 512) { const int mbi = e >> 6, ln = e & 63; row0 = 16 * (mbi >> 2) + 4 * (ln >> 4); col = n0 + 4 * (ln & 15) + (mbi & 3); }
            else { const int q = e - 512; row0 = 32; col = n0 + 4 * (q & 15) + (q >> 4); }
            const float bv = *((const GAS float*)bada + (size_t)l * ADAW + col);
            GAS float* o = (GAS float*)ADA + ((size_t)l * NROWB + row0) * ADAW + col;
            o[0] = t.x + bv; o[ADAW] = t.y + bv;
            if (row0 < 32) { o[2 * (size_t)ADAW] = t.z + bv; o[3 * (size_t)ADAW] = t.w + bv; } }
        __syncthreads(); }
}
}

namespace ret {
using att::bf16x8; using att::s16x4; using att::f32x4; using att::u32x4_t; using att::vtr; using att::cvtpk; using att::pack8;
constexpr int KP = 144, VP = 288, K_OFF = 0, V_OFF = 128 * KP, S_OFF = V_OFF + 128 * VP, LDS_NEED = S_OFF + 64 * VP;
template <int CTRL> __device__ __forceinline__ float dppf(float v) { return __builtin_bit_cast(float, __builtin_amdgcn_update_dpp(0, __builtin_bit_cast(int, v), CTRL, 0xf, 0xf, false)); }
__device__ __forceinline__ float sum16(float v) { v += dppf<0xB1>(v); v += dppf<0x4E>(v); v += dppf<0x141>(v); v += dppf<0x140>(v); return v; }
__device__ __forceinline__ void out_phase(LAS unsigned char* lds, const bf16* Z, int l, const float* SPREV, const float* gret, bf16* Y3, int bx, int G, int tid, int lane, int wave) {
    LAS unsigned char* Ks = lds + K_OFF; LAS unsigned char* Vs = lds + V_OFF; LAS unsigned char* Ss = lds + S_OFF;
    const int c = lane & 15, g = lane >> 4;
    for (int it = bx; it < NBP * 32 * RH; it += G) {
        const int b = it >> 8, n = (it >> 3) & 31, h = it & 7; const size_t row0 = (size_t)b * SEQ + n * 128;
#pragma unroll
        for (int i = 0; i < 2; ++i) { const int p = tid + NTHR * i, j = p >> 3, cc = p & 7; *(LAS u32x4_t*)(Ks + j * KP + cc * 16) = *(const u32x4_t*)(Z + (row0 + j) * ZW + ZRK + h * 64 + cc * 8); }
#pragma unroll
        for (int i = 0; i < 4; ++i) { const int p = tid + NTHR * i, j = p >> 4, cc = p & 15; *(LAS u32x4_t*)(Vs + j * VP + cc * 16) = *(const u32x4_t*)(Z + (row0 + j) * ZW + ZRV + h * 128 + cc * 8); }
#pragma unroll
        for (int i = 0; i < 2; ++i) { const int p = tid + NTHR * i, d = p >> 4, cc = p & 15; const float* sp = SPREV + ((((size_t)b * 32 + n) * RH + h) * RDK + d) * RDV + cc * 8; float f[8];
#pragma unroll
            for (int e = 0; e < 8; ++e) f[e] = sp[e];
            *(LAS u32x4_t*)(Ss + d * VP + cc * 16) = pack8(f); }
        __syncthreads();
        const int w = wave; const float lg2 = ret_logg(h) * 1.4426950408889634f;
        const bf16* qp = Z + (row0 + 16 * w + c) * ZW + ZRQ + h * 64 + 8 * g;
        const bf16x8 qf0 = *(const bf16x8*)qp, qf1 = *(const bf16x8*)(qp + 32);
        f32x4 o[8];
#pragma unroll
        for (int vt = 0; vt < 8; ++vt) o[vt] = (f32x4){0.f, 0.f, 0.f, 0.f};
#pragma unroll
        for (int ks = 0; ks < 2; ++ks) { const LAS unsigned char* sb = Ss + (32 * ks + 8 * g + (c >> 2)) * VP + 8 * (c & 3);
#pragma unroll
            for (int vt = 0; vt < 8; ++vt) { const s16x4 lo = vtr(sb + 32 * vt), hi = vtr(sb + 4 * VP + 32 * vt); const bf16x8 bb = {lo[0], lo[1], lo[2], lo[3], hi[0], hi[1], hi[2], hi[3]};
                o[vt] = __builtin_amdgcn_mfma_f32_16x16x32_bf16(ks ? qf1 : qf0, bb, o[vt], 0, 0, 0); } }
#pragma unroll
        for (int r = 0; r < 4; ++r) { const float cf = __builtin_amdgcn_exp2f(lg2 * (float)(16 * w + 4 * g + r + 1));
#pragma unroll
            for (int vt = 0; vt < 8; ++vt) o[vt][r] *= cf; }
        for (int ks = 0; ks <= (w >> 1); ++ks) {
            f32x4 st[2];
#pragma unroll
            for (int t = 0; t < 2; ++t) { const int jt = 2 * ks + t; f32x4 a = {0.f, 0.f, 0.f, 0.f};
                if (jt <= w) { const LAS unsigned char* kp = Ks + (16 * jt + c) * KP + 16 * g; const bf16x8 k0 = *(const LAS bf16x8*)kp, k1 = *(const LAS bf16x8*)(kp + 64);
                    a = __builtin_amdgcn_mfma_f32_16x16x32_bf16(k0, qf0, a, 0, 0, 0); a = __builtin_amdgcn_mfma_f32_16x16x32_bf16(k1, qf1, a, 0, 0, 0);
#pragma unroll
                    for (int r = 0; r < 4; ++r) { const int dij = (16 * w + c) - (16 * jt + 4 * g + r); a[r] = dij >= 0 ? a[r] * 0.125f * __builtin_amdgcn_exp2f(lg2 * (float)dij) : 0.f; } }
                st[t] = a; }
            const u32x4_t pw = {cvtpk(st[0][0], st[0][1]), cvtpk(st[0][2], st[0][3]), cvtpk(st[1][0], st[1][1]), cvtpk(st[1][2], st[1][3])}; const bf16x8 pf = __builtin_bit_cast(bf16x8, pw);
            const LAS unsigned char* vb = Vs + (32 * ks + 4 * g + (c >> 2)) * VP + 8 * (c & 3);
#pragma unroll
            for (int vt = 0; vt < 8; ++vt) { const s16x4 lo = vtr(vb + 32 * vt), hi = vtr(vb + 16 * VP + 32 * vt); const bf16x8 bb = {lo[0], lo[1], lo[2], lo[3], hi[0], hi[1], hi[2], hi[3]};
                o[vt] = __builtin_amdgcn_mfma_f32_16x16x32_bf16(pf, bb, o[vt], 0, 0, 0); }
        }
        float mean[4], rstd[4];
#pragma unroll
        for (int r = 0; r < 4; ++r) { float sm = 0.f;
#pragma unroll
            for (int vt = 0; vt < 8; ++vt) sm += o[vt][r];
            mean[r] = sum16(sm) * (1.f / 128.f); float q = 0.f;
#pragma unroll
            for (int vt = 0; vt < 8; ++vt) { const float dd = o[vt][r] - mean[r]; q += dd * dd; }
            rstd[r] = 1.f / sqrtf(sum16(q) * (1.f / 128.f) + EPS); }
        const float* gp = gret + l * BRW + h * 128 + c;
        float gv[8]; bf16 rgv[4][8];
#pragma unroll
        for (int vt = 0; vt < 8; ++vt) gv[vt] = gp[16 * vt];
#pragma unroll
        for (int r = 0; r < 4; ++r) { const bf16* rg = Z + (row0 + 16 * w + 4 * g + r) * ZW + ZRG + h * 128 + c;
#pragma unroll
            for (int vt = 0; vt < 8; ++vt) rgv[r][vt] = rg[16 * vt]; }
        asm volatile("" ::: "memory");
#pragma unroll
        for (int r = 0; r < 4; ++r) { bf16* y = Y3 + (row0 + 16 * w + 4 * g + r) * BRW + h * 128 + c;
#pragma unroll
            for (int vt = 0; vt < 8; ++vt) y[16 * vt] = f2bf((o[vt][r] - mean[r]) * rstd[r] * gv[vt] * bf2f(rgv[r][vt])); }
        __syncthreads();
    }
}

__device__ __forceinline__ void kv_phase(LAS unsigned char* lds, const bf16* Z, float* KV, int bx, int G, int tid, int lane, int wave) {
    LAS unsigned char* Ks = lds + K_OFF; LAS unsigned char* Vs = lds + V_OFF;
    const int c = lane & 15, g = lane >> 4;
    for (int it = bx; it < NBP * 32 * RH; it += G) {
        const int b = it >> 8, n = (it >> 3) & 31, h = it & 7; const size_t row0 = (size_t)b * SEQ + n * 128;
        const float lg2 = ret_logg(h) * 1.4426950408889634f;
#pragma unroll
        for (int i = 0; i < 2; ++i) { const int p = tid + NTHR * i, j = p >> 3, cc = p & 7; float f[8]; ld8(Z + (row0 + j) * ZW + ZRK + h * 64 + cc * 8, f);
            const float sc = 0.125f * __builtin_amdgcn_exp2f(lg2 * (float)(127 - j));
#pragma unroll
            for (int e = 0; e < 8; ++e) f[e] *= sc;
            *(LAS u32x4_t*)(Ks + j * KP + cc * 16) = pack8(f); }
#pragma unroll
        for (int i = 0; i < 4; ++i) { const int p = tid + NTHR * i, j = p >> 4, cc = p & 15; *(LAS u32x4_t*)(Vs + j * VP + cc * 16) = *(const u32x4_t*)(Z + (row0 + j) * ZW + ZRV + h * 128 + cc * 8); }
        __syncthreads();
        const int dt = wave & 3, vt0 = (wave >> 2) * 4;
        f32x4 acc[4];
#pragma unroll
        for (int t = 0; t < 4; ++t) acc[t] = (f32x4){0.f, 0.f, 0.f, 0.f};
#pragma unroll
        for (int ks = 0; ks < 4; ++ks) { const LAS unsigned char* ka = Ks + (32 * ks + 8 * g + (c >> 2)) * KP + 32 * dt + 8 * (c & 3);
            const s16x4 alo = vtr(ka), ahi = vtr(ka + 4 * KP); const bf16x8 af = {alo[0], alo[1], alo[2], alo[3], ahi[0], ahi[1], ahi[2], ahi[3]};
            const LAS unsigned char* vb = Vs + (32 * ks + 8 * g + (c >> 2)) * VP + 8 * (c & 3);
#pragma unroll
            for (int t = 0; t < 4; ++t) { const s16x4 lo = vtr(vb + 32 * (vt0 + t)), hi = vtr(vb + 4 * VP + 32 * (vt0 + t)); const bf16x8 bb = {lo[0], lo[1], lo[2], lo[3], hi[0], hi[1], hi[2], hi[3]};
                acc[t] = __builtin_amdgcn_mfma_f32_16x16x32_bf16(af, bb, acc[t], 0, 0, 0); } }
        float* kvp = KV + ((((size_t)b * 32 + n) * RH + h) * RDK + 16 * dt + 4 * g) * RDV + c;
#pragma unroll
        for (int r = 0; r < 4; ++r)
#pragma unroll
            for (int t = 0; t < 4; ++t) kvp[(size_t)r * RDV + 16 * (vt0 + t)] = acc[t][r];
        __syncthreads();
    }
}
}

namespace mixl {
using att::u32x4_t; using att::f32x4;
template <int CTRL> __device__ __forceinline__ float dppf(float v) { return __builtin_bit_cast(float, __builtin_amdgcn_update_dpp(0, __builtin_bit_cast(int, v), CTRL, 0xf, 0xf, false)); }
__device__ __forceinline__ float sum8(float v) { v += dppf<0xB1>(v); v += dppf<0x4E>(v); v += dppf<0x141>(v); return v; }
struct QkRow { float q0[8], q1[8], kv[8]; };
__device__ __forceinline__ void qk_load(const bf16* zr, QkRow& R, int lane) { ld8(zr + ZQ + lane * 8, R.q0); ld8(zr + ZQ + 512 + lane * 8, R.q1); ld8(zr + ZK + lane * 8, R.kv); }
__device__ __forceinline__ void qk_finish(bf16* zr, int row, int l, QkRow& R, const float (&g8q)[8], const float (&g8k)[8], float* out, int lane) {
    float s0 = 0.f, s1 = 0.f, s2 = 0.f;
#pragma unroll
    for (int e = 0; e < 8; ++e) { s0 += R.q0[e] * R.q0[e]; s1 += R.q1[e] * R.q1[e]; s2 += R.kv[e] * R.kv[e]; }
    const float r0 = 1.f / sqrtf(sum8(s0) * (1.f / 64.f) + EPS), r1 = 1.f / sqrtf(sum8(s1) * (1.f / 64.f) + EPS), r2 = 1.f / sqrtf(sum8(s2) * (1.f / 64.f) + EPS);
#pragma unroll
    for (int e = 0; e < 8; ++e) { R.q0[e] *= r0 * g8q[e]; R.q1[e] *= r1 * g8q[e]; if (lane < 32) R.kv[e] *= r2 * g8k[e]; }
    st8(zr + ZQ + lane * 8, R.q0); st8(zr + ZQ + 512 + lane * 8, R.q1);
    if (lane < 32) st8(zr + ZK + lane * 8, R.kv);
    float* o = nullptr;
    if (row < MP) { const int b = row >> 12, t = row & (SEQ - 1); if (t >= SEQ - WIN) o = out + (lane < 32 ? O_KP : O_VP) + (((size_t)l * NBP + b) * WIN + (t - (SEQ - WIN))) * 256 + (lane & 31) * 8; }
    else { const int sb = (row - MP) >> 3, t = (row - MP) & 7; o = out + (lane < 32 ? O_KS : O_VS) + (((size_t)l * SB + sb) * WIN + (WIN - ST + t)) * 256 + (lane & 31) * 8; }
    if (o) { *(f32x4*)o = (f32x4){R.kv[0], R.kv[1], R.kv[2], R.kv[3]}; *(f32x4*)(o + 4) = (f32x4){R.kv[4], R.kv[5], R.kv[6], R.kv[7]}; }
}
__device__ __forceinline__ void qknorm_phase(bf16* Z, int l, const float* gq, const float* gk, float* out, int gw, int NGW, int lane) {
    float g8q[8], g8k[8];
#pragma unroll
    for (int e = 0; e < 8; ++e) { g8q[e] = gq[l * 64 + (lane & 7) * 8 + e]; g8k[e] = gk[l * 64 + (lane & 7) * 8 + e]; }
    for (int row = gw; row < M; row += 2 * NGW) { const int rowb = row + NGW; const bool two = rowb < M;
        bf16* za = Z + (size_t)row * ZW; bf16* zb = Z + (size_t)(two ? rowb : row) * ZW;
        QkRow A, B; qk_load(za, A, lane); qk_load(zb, B, lane);
        asm volatile("" ::: "memory");
        qk_finish(za, row, l, A, g8q, g8k, out, lane);
        if (two) qk_finish(zb, rowb, l, B, g8q, g8k, out, lane);
    }
}
constexpr int CV_RB = 64, CV_CB = 128, CV_UR = CV_RB + CPRE, CV_NPI = (MP / CV_RB) * 8, CV_NSI = SB * 8;
struct CvItem { bool smp; int cb, b, t0, nrows; size_t rowb; };
__device__ __forceinline__ CvItem cv_item(int it) { CvItem I; I.smp = it >= CV_NPI; I.cb = it & 7; I.b = I.smp ? (it - CV_NPI) >> 3 : (it >> 3) >> 6; I.t0 = I.smp ? 0 : ((it >> 3) & 63) * CV_RB; I.nrows = I.smp ? ST : CV_RB;
    I.rowb = I.smp ? (size_t)MP + I.b * ST : (size_t)I.b * SEQ; return I; }
__device__ __forceinline__ void cv_fetch(const bf16* Z, int l, const float* sconv, const CvItem& I, u32x4_t (&raw)[3][2], int tid) {
#pragma unroll
    for (int i = 0; i < 3; ++i) { const int p = tid + NTHR * i, ur = p >> 4, c8 = p & 15, tt = I.t0 - CPRE + ur; raw[i][0] = (u32x4_t){0u, 0u, 0u, 0u}; raw[i][1] = raw[i][0];
        if (ur < I.nrows + CPRE) {
            if (tt >= 0) { const bf16* zp = Z + (I.rowb + tt) * ZW + I.cb * CV_CB + c8 * 8; raw[i][0] = *(const u32x4_t*)(zp + ZCA); raw[i][1] = *(const u32x4_t*)(zp + ZCG); }
            else if (I.smp) { const float* sp = sconv + (((size_t)l * SB + I.b) * CPRE + (CPRE + tt)) * BRW + I.cb * CV_CB + c8 * 8; raw[i][0] = *(const u32x4_t*)sp; raw[i][1] = *(const u32x4_t*)(sp + 4); } } }
}
__device__ __forceinline__ void conv_phase(LAS unsigned char* lds, const bf16* Z, int l, const float* wdw, const float* bdw, const float* sconv, float* CONVY, float* out, int bx, int G, int tid) {
    LAS float* U = (LAS float*)lds;
    auto unp = [](const u32x4_t w, float* f) { f[0] = __builtin_bit_cast(float, w.x << 16); f[1] = __builtin_bit_cast(float, w.x & 0xffff0000u); f[2] = __builtin_bit_cast(float, w.y << 16); f[3] = __builtin_bit_cast(float, w.y & 0xffff0000u);
        f[4] = __builtin_bit_cast(float, w.z << 16); f[5] = __builtin_bit_cast(float, w.z & 0xffff0000u); f[6] = __builtin_bit_cast(float, w.w << 16); f[7] = __builtin_bit_cast(float, w.w & 0xffff0000u); };
    u32x4_t raw[3][2];
    if (bx < CV_NPI + CV_NSI) { const CvItem I0 = cv_item(bx); cv_fetch(Z, l, sconv, I0, raw, tid); }
    for (int it = bx; it < CV_NPI + CV_NSI; it += G) {
        const CvItem I = cv_item(it);
        const int c = tid & 127, r0 = (tid >> 7) * 16, ch = I.cb * CV_CB + c; float w[CONVK];
#pragma unroll
        for (int j = 0; j < CONVK; ++j) w[j] = wdw[((size_t)l * CONVK + j) * BRW + ch];
        const float bias = bdw[l * BRW + ch];
#pragma unroll
        for (int i = 0; i < 3; ++i) { const int p = tid + NTHR * i, ur = p >> 4, c8 = p & 15, tt = I.t0 - CPRE + ur; float u[8];
            if (ur < I.nrows + CPRE) {
                if (tt >= 0) { float av[8], gg[8]; unp(raw[i][0], av); unp(raw[i][1], gg);
#pragma unroll
                    for (int e = 0; e < 8; ++e) u[e] = av[e] * sigmoidf_(gg[e]);
                    if (ur >= CPRE) { float* o = nullptr;
                        if (!I.smp) { if (tt >= SEQ - CPRE) o = out + O_CP + (((size_t)l * NBP + I.b) * CPRE + (tt - (SEQ - CPRE))) * BRW + I.cb * CV_CB + c8 * 8; }
                        else o = out + O_CS + (((size_t)l * SB + I.b) * CPRE + (CPRE - ST + tt)) * BRW + I.cb * CV_CB + c8 * 8;
                        if (o) { *(f32x4*)o = (f32x4){u[0], u[1], u[2], u[3]}; *(f32x4*)(o + 4) = (f32x4){u[4], u[5], u[6], u[7]}; } }
                } else {
                    const unsigned r0_ = raw[i][0].x, r1_ = raw[i][0].y, r2_ = raw[i][0].z, r3_ = raw[i][0].w, r4_ = raw[i][1].x, r5_ = raw[i][1].y, r6_ = raw[i][1].z, r7_ = raw[i][1].w;
                    u[0] = __builtin_bit_cast(float, r0_); u[1] = __builtin_bit_cast(float, r1_); u[2] = __builtin_bit_cast(float, r2_); u[3] = __builtin_bit_cast(float, r3_);
                    u[4] = __builtin_bit_cast(float, r4_); u[5] = __builtin_bit_cast(float, r5_); u[6] = __builtin_bit_cast(float, r6_); u[7] = __builtin_bit_cast(float, r7_); }
                *(LAS f32x4*)(U + ur * CV_CB + c8 * 8) = (f32x4){u[0], u[1], u[2], u[3]}; *(LAS f32x4*)(U + ur * CV_CB + c8 * 8 + 4) = (f32x4){u[4], u[5], u[6], u[7]}; } }
        __syncthreads();
        if (it + G < CV_NPI + CV_NSI) { const CvItem In = cv_item(it + G); cv_fetch(Z, l, sconv, In, raw, tid); }
        if (r0 < I.nrows) {
            float u[16 + CPRE];
#pragma unroll
            for (int k = 0; k < 16 + CPRE; ++k) u[k] = U[(r0 + k) * CV_CB + c];
#pragma unroll
            for (int r = 0; r < 16; ++r) { float acc = bias;
#pragma unroll
                for (int j = 0; j < CONVK; ++j) acc += w[j] * u[r + j];
                if (r0 + r < I.nrows) CONVY[(I.rowb + I.t0 + r0 + r) * BRW + ch] = acc; }
        }
        __syncthreads();
    }
}
template <int W> __device__ __forceinline__ void pool_run(const bf16* Z, int l, int b, int t0, int cch, bf16* ZP, float* out) {
    const size_t rowb = (size_t)b * SEQ; u32x4_t rw[23];
#pragma unroll
    for (int k = 16 - W; k < 23; ++k) { const int tt = t0 - 15 + k; rw[k] = (u32x4_t){0u, 0u, 0u, 0u}; if (tt >= 0) rw[k] = *(const u32x4_t*)(Z + (rowb + tt) * ZW + ZPL + cch); }
    float S[8];
#pragma unroll
    for (int e = 0; e < 8; ++e) S[e] = 0.f;
    auto unp = [](const u32x4_t w, float* f) { f[0] = __builtin_bit_cast(float, w.x << 16); f[1] = __builtin_bit_cast(float, w.x & 0xffff0000u); f[2] = __builtin_bit_cast(float, w.y << 16); f[3] = __builtin_bit_cast(float, w.y & 0xffff0000u);
        f[4] = __builtin_bit_cast(float, w.z << 16); f[5] = __builtin_bit_cast(float, w.z & 0xffff0000u); f[6] = __builtin_bit_cast(float, w.w << 16); f[7] = __builtin_bit_cast(float, w.w & 0xffff0000u); };
#pragma unroll
    for (int k = 16 - W; k < 15; ++k) { float f[8]; unp(rw[k], f);
#pragma unroll
        for (int e = 0; e < 8; ++e) S[e] += f[e]; }
#pragma unroll
    for (int r = 0; r < 8; ++r) { const int t = t0 + r; float u[8], o[8], f[8]; unp(rw[15 + r], u);
        const float inv = 1.f / (float)((t + 1) < W ? (t + 1) : W);
#pragma unroll
        for (int e = 0; e < 8; ++e) { S[e] += u[e]; o[e] = S[e] * inv - u[e]; }
        st8(ZP + (rowb + t) * BRW + cch, o);
        if (t >= SEQ - PPAD) { float* so = out + O_PP + (((size_t)l * NBP + b) * PPAD + (t - (SEQ - PPAD))) * BRW + cch; *(f32x4*)so = (f32x4){u[0], u[1], u[2], u[3]}; *(f32x4*)(so + 4) = (f32x4){u[4], u[5], u[6], u[7]}; }
        unp(rw[15 + r - W + 1], f);
#pragma unroll
        for (int e = 0; e < 8; ++e) S[e] -= f[e]; }
}
template <int W> __device__ __forceinline__ void pool_run_s(const bf16* Z, int l, int b, int cch, const float* spool, bf16* ZP, float* out) {
    const size_t rowb = (size_t)MP + b * ST; const float* sp = spool + (((size_t)l * SB + b) * PPAD) * BRW + cch;
    f32x4 pf[W - 1][2]; u32x4_t rw[ST];
#pragma unroll
    for (int k = 0; k < W - 1; ++k) { pf[k][0] = *(const f32x4*)(sp + (size_t)(PPAD - (W - 1) + k) * BRW); pf[k][1] = *(const f32x4*)(sp + (size_t)(PPAD - (W - 1) + k) * BRW + 4); }
#pragma unroll
    for (int t = 0; t < ST; ++t) rw[t] = *(const u32x4_t*)(Z + (rowb + t) * ZW + ZPL + cch);
    auto unp = [](const u32x4_t w, float* f) { f[0] = __builtin_bit_cast(float, w.x << 16); f[1] = __builtin_bit_cast(float, w.x & 0xffff0000u); f[2] = __builtin_bit_cast(float, w.y << 16); f[3] = __builtin_bit_cast(float, w.y & 0xffff0000u);
        f[4] = __builtin_bit_cast(float, w.z << 16); f[5] = __builtin_bit_cast(float, w.z & 0xffff0000u); f[6] = __builtin_bit_cast(float, w.w << 16); f[7] = __builtin_bit_cast(float, w.w & 0xffff0000u); };
    float S[8];
#pragma unroll
    for (int e = 0; e < 8; ++e) S[e] = 0.f;
#pragma unroll
    for (int k = 0; k < W - 1; ++k) { S[0] += pf[k][0].x; S[1] += pf[k][0].y; S[2] += pf[k][0].z; S[3] += pf[k][0].w; S[4] += pf[k][1].x; S[5] += pf[k][1].y; S[6] += pf[k][1].z; S[7] += pf[k][1].w; }
    const float inv = 1.f / (float)W;
#pragma unroll
    for (int t = 0; t < ST; ++t) { float u[8], o[8], f[8]; unp(rw[t], u);
#pragma unroll
        for (int e = 0; e < 8; ++e) { S[e] += u[e]; o[e] = S[e] * inv - u[e]; }
        st8(ZP + (rowb + t) * BRW + cch, o);
        float* so = out + O_PS + (((size_t)l * SB + b) * PPAD + (PPAD - ST + t)) * BRW + cch; *(f32x4*)so = (f32x4){u[0], u[1], u[2], u[3]}; *(f32x4*)(so + 4) = (f32x4){u[4], u[5], u[6], u[7]};
        const int tt = t - W + 1;
        if (tt >= 0) unp(rw[tt >= 0 ? tt : 0], f);
        else { const int k = tt + W - 1 >= 0 ? tt + W - 1 : 0; f[0] = pf[k][0].x; f[1] = pf[k][0].y; f[2] = pf[k][0].z; f[3] = pf[k][0].w; f[4] = pf[k][1].x; f[5] = pf[k][1].y; f[6] = pf[k][1].z; f[7] = pf[k][1].w; }
#pragma unroll
        for (int e = 0; e < 8; ++e) S[e] -= f[e]; }
}
__device__ __forceinline__ void pool_phase(const bf16* Z, int l, const float* spool, bf16* ZP, float* out, int gw, int NGW, int lane, int gt, int NGT) {
    for (int wi = gw; wi < (MP / 8 / 2) * 4; wi += NGW) { const int cg = wi & 3, grp = (wi >> 2) * 2 + (lane >> 5), cch = (cg * 32 + (lane & 31)) * 8, b = grp >> 9, t0 = (grp & 511) * 8;
        if (cg == 0) pool_run<2>(Z, l, b, t0, cch, ZP, out); else if (cg == 1) pool_run<4>(Z, l, b, t0, cch, ZP, out); else if (cg == 2) pool_run<8>(Z, l, b, t0, cch, ZP, out); else pool_run<16>(Z, l, b, t0, cch, ZP, out); }
    for (int wi = gw; wi < (SB / 2) * 4; wi += NGW) { const int cg = wi & 3, b = (wi >> 2) * 2 + (lane >> 5), cch = (cg * 32 + (lane & 31)) * 8;
        if (cg == 0) pool_run_s<2>(Z, l, b, cch, spool, ZP, out); else if (cg == 1) pool_run_s<4>(Z, l, b, cch, spool, ZP, out); else if (cg == 2) pool_run_s<8>(Z, l, b, cch, spool, ZP, out); else pool_run_s<16>(Z, l, b, cch, spool, ZP, out); }
}
__device__ __forceinline__ void retout_s_phase(const bf16* Z, int l, const float* sret, const float* gret, bf16* Y3, int gw, int NGW, int lane) {
    for (int it = gw; it < MS * RH; it += NGW) { int h = __builtin_amdgcn_readfirstlane(it & 7); asm volatile("" : "+s"(h));
        const int rs = it >> 3, sb = rs >> 3, i = rs & 7; const size_t row = (size_t)MP + rs, row0 = (size_t)MP + sb * ST;
        const float lg = ret_logg(h);
        const bf16* qp = Z + row * ZW + ZRQ + h * 64;
        const float* S = sret + (((size_t)l * SB + sb) * RH + h) * RDK * RDV;
        float o0 = 0.f, o1 = 0.f;
#pragma unroll 16
        for (int d = 0; d < 64; ++d) { const float qd = bf2f(qp[d]); o0 += qd * S[(size_t)d * RDV + lane]; o1 += qd * S[(size_t)d * RDV + lane + 64]; }
        const float cf = FEXP(lg * (float)(i + 1)); o0 *= cf; o1 *= cf;
        const float ql = bf2f(qp[lane]);
        for (int j = 0; j <= i; ++j) { const bf16* zj = Z + (row0 + j) * ZW; const float sc = wave_sum(ql * bf2f(zj[ZRK + h * 64 + lane])) * 0.125f * FEXP(lg * (float)(i - j));
            o0 += sc * bf2f(zj[ZRV + h * 128 + lane]); o1 += sc * bf2f(zj[ZRV + h * 128 + lane + 64]); }
        const float mean = wave_sum(o0 + o1) * (1.f / 128.f); const float d0 = o0 - mean, d1 = o1 - mean;
        const float rstd = 1.f / sqrtf(wave_sum(d0 * d0 + d1 * d1) * (1.f / 128.f) + EPS);
        const float* g = gret + l * BRW + h * 128; const bf16* rg = Z + row * ZW + ZRG + h * 128; bf16* y = Y3 + row * BRW + h * 128;
        y[lane] = f2bf(d0 * rstd * g[lane] * bf2f(rg[lane])); y[lane + 64] = f2bf(d1 * rstd * g[lane + 64] * bf2f(rg[lane + 64]));
    }
}
}
struct AdaOrder { int G, c; const char* A; const char* B;
    __device__ __forceinline__ bool next(int i, pg8::Unit& u) const { const int Lx = i * G + c; if (Lx >= DEPTH * (ADAW / 256)) return false;
        u.r = Lx / (ADAW / 256); u.pn = Lx % (ADAW / 256); u.pm = 0; u.ks = 0; u.nt = DM / 64; u.a = A; u.b = B + ((size_t)u.r * ADAW + (size_t)u.pn * 256) * DM * 2; return true; } };
struct PoolOrder { int G, c; const char* A; const char* B;
                __device__ __forceinline__ bool next(int i, pg8::Unit& u) const { const int Lx = i * G + c; if (Lx >= (M / 256) * 4) return false;
                    u.pm = Lx >> 2; u.pn = Lx & 3; u.r = 0; u.ks = 0; u.nt = 256 / 64; u.a = A + ((size_t)u.pm * 256 * BRW + (size_t)u.pn * 256) * 2; u.b = B + (size_t)u.pn * 256 * 256 * 2; return true; } };
__device__ __forceinline__ unsigned long long ld_ptr(volatile LAS unsigned* p) { const unsigned lo = __builtin_amdgcn_readfirstlane(p[0]), hi = __builtin_amdgcn_readfirstlane(p[1]); return ((unsigned long long)hi << 32) | lo; }
constexpr int NPL = 12;
constexpr int PH_TOTAL = 2 + DEPTH * NPL + 1;
constexpr int KS_BR = 2, KS_OUT = 8, KS_M1 = 4, KS_M2 = 16;
struct Args { const float* in[N_IN]; float* out; unsigned char* ws; int ph_lo, ph_hi; };
static_assert(sizeof(Args) == N_IN * 8 + 8 + 8 + 8, "Args has no padding");

__global__ void __launch_bounds__(NTHR, 2) fwd(Args args) {
    extern __shared__ __attribute__((aligned(16))) unsigned char lds[];
    LAS unsigned char* L0 = (LAS unsigned char*)lds;
    volatile LAS unsigned* MISC = (volatile LAS unsigned*)(L0 + MISC_OFF);
    const int G = gridDim.x, bx = blockIdx.x, wave0 = __builtin_amdgcn_readfirstlane(threadIdx.x >> 6);
    unsigned char* ws0 = args.ws;
    for (int u = threadIdx.x; u < (LDS_BYTES - LDSCTL_OFF) / 4; u += NTHR) ((LAS unsigned*)(L0 + LDSCTL_OFF))[u] = 0u;
    __syncthreads();
    if (threadIdx.x <= N_IN) ((LAS unsigned long long*)(L0 + INTAB_OFF))[threadIdx.x] = threadIdx.x < N_IN ? (unsigned long long)args.in[threadIdx.x < N_IN ? threadIdx.x : 0] : (unsigned long long)args.out;
    __syncthreads();
#if MK_ONE_LAUNCH
    XcdBarrier bar = xcd_barrier_post((unsigned*)(ws0 + WS_CTL) + CW_BAR, MISC + 8);
#define GRID_BAR() xcd_barrier(bar)
#else
#define GRID_BAR() do {} while (0)
#endif
    const int lo = args.ph_lo, hi = args.ph_hi;
#ifndef PH_MASK
#define PH_MASK 0x7FFF
#endif
#ifndef PROBE_MASK
#define PROBE_MASK 0
#endif
#define PROBE_BEGIN(bit) unsigned long long pr_t0 = 0; if ((PROBE_MASK >> (bit)) & 1) pr_t0 = __builtin_amdgcn_s_memrealtime()
#define PROBE_END(bit) do { if ((PROBE_MASK >> (bit)) & 1) { __syncthreads(); const unsigned long long t1 = __builtin_amdgcn_s_memrealtime(); while (__builtin_amdgcn_s_memrealtime() - t1 < t1 - pr_t0) __builtin_amdgcn_s_sleep(8); } } while (0)
#define IN(k) (lo <= (k) && (k) < hi)
#define SEAM(k) do { if (IN((k) + 1)) GRID_BAR(); } while (0)
#define INP(i)  ((const float*)(GAS const float*)ld_ptr((volatile LAS unsigned*)(L + INTAB_OFF) + 2 * (i)))
#define P_OUT   ((float*)(GAS float*)ld_ptr((volatile LAS unsigned*)(L + INTAB_OFF) + 2 * N_IN))
#define WIN_T   ((bf16*)(ws + WS_WIN))
#define WBR_T   ((bf16*)(ws + WS_WBR))
#define WOUT_T  ((bf16*)(ws + WS_WOUT))
#define WM1_T   ((bf16*)(ws + WS_WM1))
#define WM2_T   ((bf16*)(ws + WS_WM2))
#define WPOOL_T ((bf16*)(ws + WS_WPOOL))
#define WADA_T  ((bf16*)(ws + WS_WADA))
#define SC      ((bf16*)(ws + WS_SC))
#define ADA     ((float*)(ws + WS_ADA))
#define H       ((bf16*)(ws + WS_H))
#define Z       ((bf16*)(ws + WS_Z))
#define Y       ((bf16*)(ws + WS_Y))
#define ZP      ((bf16*)(ws + WS_ZP))
#define CONVY   ((float*)(ws + WS_CONVY))
#define ORAW    ((float*)(ws + WS_ORAW))
#define KV      ((float*)(ws + WS_KV))
#define SPREV   ((float*)(ws + WS_SPREV))
#define MACC    ((float*)(ws + WS_MACC))
#define MERGED  ((bf16*)(ws + WS_MERGED))
#define X1      ((float*)(ws + WS_X1))
#define X       ((float*)(ws + WS_X))
#define HID     ((bf16*)(ws + WS_HID))
#define SLAB    ((float*)(ws + WS_SLAB))
#define TIDS() int lane; asm volatile("v_mbcnt_lo_u32_b32 %0, -1, 0\n\tv_mbcnt_hi_u32_b32 %0, -1, %0" : "=v"(lane)); GAS unsigned char* wsg = (GAS unsigned char*)ws0; asm volatile("" : "+s"(wsg)); unsigned char* ws = (unsigned char*)wsg; LAS unsigned char* L = L0; asm volatile("" : "+s"(L)); const int wave = wave0, tid = wave0 * 64 + lane; const int gw = bx * NWAVES + wave, NGW = G * NWAVES; const int gt = bx * NTHR + tid, NGT = G * NTHR; (void)lane; (void)gw; (void)NGW; (void)gt; (void)NGT
#define LAYER_PTRS() const float* ada = ADA + (size_t)l * NROWB * ADAW; const float* xinP = l == 0 ? INP(I_XP) : X; const float* xinS = l == 0 ? INP(I_XS) : X + (size_t)MP * DM; float* xout = l == DEPTH - 1 ? P_OUT : X; (void)ada; (void)xinP; (void)xinS; (void)xout
    if ((PH_MASK >> 12 & 1) && IN(0)) { TIDS(); PROBE_BEGIN(12);
        transpose_run<DM, ZW>(INP(I_WIN), WIN_T, DEPTH, gw, NGW, lane);
        transpose_run<BRW, DM>(INP(I_WBR), WBR_T, DEPTH * 4, gw, NGW, lane);
        transpose_run<DM, DM>(INP(I_WOUT), WOUT_T, DEPTH, gw, NGW, lane);
        transpose_run<DM, DFF>(INP(I_WM1), WM1_T, DEPTH, gw, NGW, lane);
        transpose_run<DFF, DM>(INP(I_WM2), WM2_T, DEPTH, gw, NGW, lane);
        transpose_run<256, 256>(INP(I_WPOOL), WPOOL_T, DEPTH * 4, gw, NGW, lane);
        adad::phase(INP(I_CP), INP(I_CS), INP(I_WADA), INP(I_BADA), ADA, L + RING_OFF, bx, G, wave, lane, tid);
        PROBE_END(12); SEAM(0);
    }
    for (int l = 0; l < DEPTH; ++l) {
        const int pb = 2 + l * NPL;
        if ((PH_MASK >> 0 & 1) && IN(pb + 0)) { TIDS(); LAYER_PTRS(); PROBE_BEGIN(0);
            for (int rs = bx; rs < MS; rs += G) { const int row = MP + rs; const float* ar = ada + (size_t)row_cond(row) * ADAW;
                if (l == 0) norm_row_block<0>(xinS + (size_t)rs * DM, nullptr, nullptr, 0, nullptr, INP(I_G1) + l * DM, ar + DM, ar, H + (size_t)row * DM, (LAS float*)(L + RING_OFF), tid, wave);
                else norm_row_block<KS_M2>(X1 + (size_t)row * DM, ar - (size_t)NROWB * ADAW + 5 * DM, SLAB + (size_t)rs * DM, (size_t)MS * DM, X + (size_t)row * DM, INP(I_G1) + l * DM, ar + DM, ar, H + (size_t)row * DM, (LAS float*)(L + RING_OFF), tid, wave); }
            f32x4 gm[8], shv[8]; int curc = row_cond(gw < MP ? gw : 0); { const float* ar = ada + (size_t)curc * ADAW; load_mod(INP(I_G1) + l * DM, ar + DM, ar, gm, shv, lane); }
            for (int row = gw; row < MP; row += 2 * NGW) { const int rowb = row + NGW; const bool pair = rowb < MP && row_cond(rowb) == row_cond(row);
                for (int k = 0; k < 2; ++k) { const int r = k ? rowb : row; if (k && (pair || rowb >= MP)) break; const int cond = row_cond(r); const float* ar = ada + (size_t)cond * ADAW;
                    if (cond != curc) { load_mod(INP(I_G1) + l * DM, ar + DM, ar, gm, shv, lane); curc = cond; }
                    if (pair) norm_row2(xinP + (size_t)row * DM, xinP + (size_t)rowb * DM, gm, shv, H + (size_t)row * DM, H + (size_t)rowb * DM, lane);
                    else norm_row(xinP + (size_t)r * DM, gm, shv, H + (size_t)r * DM, lane); } }
            PROBE_END(0); SEAM(pb + 0);
        }
        if ((PH_MASK >> 1 & 1) && IN(pb + 1)) { TIDS(); LAYER_PTRS(); PROBE_BEGIN(1);
            pg8::StaticOrder S; S.init(H, WIN_T + (size_t)l * ZW * DM, M / 256, ZW / 256, DM, DM, DM, G, bx);
            pg8::EpiZ E{Z};
            pg8::gemm_phase<pg8::EpiZ, pg8::StaticOrder>(L + RING_OFF, pg8::Dims{DM, DM, DM}, S, E, tid);
            PROBE_END(1); SEAM(pb + 1);
        }
        if ((PH_MASK >> 2 & 1) && IN(pb + 2)) { TIDS(); LAYER_PTRS(); PROBE_BEGIN(2);
            mixl::qknorm_phase(Z, l, INP(I_GQ), INP(I_GK), P_OUT, gw, NGW, lane);
            for (int i = gt; i < N_SHIFT_ITEMS; i += NGT) shift_item(l, i, INP(I_CK), INP(I_CV), INP(I_SCONV), INP(I_SPOOL), P_OUT);
            mixl::conv_phase(L + RING_OFF, Z, l, INP(I_WDW), INP(I_BDW), INP(I_SCONV), CONVY, P_OUT, bx, G, tid);
            mixl::pool_phase(Z, l, INP(I_SPOOL), ZP, P_OUT, gw, NGW, lane, gt, NGT);
            ret::kv_phase(L + RING_OFF, Z, KV, bx, G, tid, lane, wave);
            for (int i = gt; i < SB * RH * RDK * 32; i += NGT) { const int v4 = i & 31, d = (i >> 5) & 63, h = (i >> 11) & 7, sb = i >> 14; retstate_s_item(Z, l, sb, h, d, v4, INP(I_SRET), P_OUT); }
            PROBE_END(2); SEAM(pb + 2);
        }
        if ((PH_MASK >> 3 & 1) && IN(pb + 3)) { TIDS(); LAYER_PTRS(); PROBE_BEGIN(3);
            att::phase(L + RING_OFF, Z, l, INP(I_SINK), INP(I_CK), INP(I_CV), Y, bx, G, tid, lane, wave);
            for (int i = gt; i < NBP * RH * RDK * 32; i += NGT) { const int v4 = i & 31, d = (i >> 5) & 63, b = i >> 14; int h = (i >> 11) & 7;
                const size_t o0 = (((size_t)b * 32 * RH + h) * RDK + d) * RDV + v4 * 4, cs = (size_t)RH * RDK * RDV; f32x4 kvv[32];
#pragma unroll
                for (int n = 0; n < 32; ++n) kvv[n] = *(const f32x4*)(KV + o0 + n * cs);
                const float gc = FEXP(ret_logg(h) * 128.f); float z0 = 0.f; asm volatile("" : "+v"(z0)); f32x4 sacc = {z0, z0, z0, z0};
#pragma unroll
                for (int n = 0; n < 32; ++n) { *(f32x4*)(SPREV + o0 + n * cs) = sacc; sacc = sacc * gc + kvv[n]; }
                *(f32x4*)(P_OUT + O_RP + ((((size_t)l * NBP + b) * RH + h) * RDK + d) * RDV + v4 * 4) = sacc; }
            { f32x4 gv4[4], bv4[4];
#pragma unroll
              for (int j = 0; j < 4; ++j) { gv4[j] = ((const f32x4*)(INP(I_GCLN) + l * BRW))[lane + 64 * j]; bv4[j] = ((const f32x4*)(INP(I_BCLN) + l * BRW))[lane + 64 * j]; }
              for (int row = gw; row < M; row += NGW) convln_row(CONVY + (size_t)row * BRW, gv4, bv4, Y + (size_t)1 * M * BRW + (size_t)row * BRW, lane); }
            PROBE_END(3); SEAM(pb + 3);
        }
        if ((PH_MASK >> 4 & 1) && IN(pb + 4)) { TIDS(); LAYER_PTRS(); PROBE_BEGIN(4);
            mixl::retout_s_phase(Z, l, INP(I_SRET), INP(I_GRET), Y + (size_t)3 * M * BRW, gw, NGW, lane);
            ret::out_phase(L + RING_OFF, Z, l, SPREV, INP(I_GRET), Y + (size_t)3 * M * BRW, bx, G, tid, lane, wave);
            PoolOrder S{G, bx, (const char*)ZP, (const char*)(WPOOL_T + (size_t)l * 4 * 256 * 256)};
            pg8::EpiPool E{Y + (size_t)2 * M * BRW, INP(I_SPOOLS), l};
            pg8::gemm_phase<pg8::EpiPool, PoolOrder>(L + RING_OFF, pg8::Dims{BRW, 256, 256}, S, E, tid);
            PROBE_END(4); SEAM(pb + 4);
        }
        if ((PH_MASK >> 5 & 1) && IN(pb + 5)) { TIDS(); LAYER_PTRS(); PROBE_BEGIN(5);
            pg8::SplitOrder S{DM / 256, G, bx, 4, BRW / 64, KS_BR, BRW / 64 / KS_BR, (const char*)Y, (const char*)(WBR_T + (size_t)l * 4 * DM * BRW), (size_t)256 * BRW * 2, (size_t)256 * BRW * 2, (size_t)M * BRW * 2, (size_t)DM * BRW * 2};
            pg8::EpiBr E{Z, MERGED, SLAB, KS_BR};
            pg8::gemm_phase<pg8::EpiBr, pg8::SplitOrder>(L + RING_OFF, pg8::Dims{BRW, BRW, BRW}, S, E, tid);
            PROBE_END(5); SEAM(pb + 5);
        }
        if ((PH_MASK >> 6 & 1) && IN(pb + 6)) { TIDS(); LAYER_PTRS(); PROBE_BEGIN(6);
            for (int i = gt; i < MS * DM / 8; i += NGT) { float a[8];
#pragma unroll
                for (int e = 0; e < 8; ++e) a[e] = 0.f;
#pragma unroll
                for (int p = 0; p < 4 * KS_BR; ++p) { const f32x4 v0 = *(const f32x4*)(SLAB + (size_t)p * MS * DM + (size_t)i * 8), v1 = *(const f32x4*)(SLAB + (size_t)p * MS * DM + (size_t)i * 8 + 4);
                    a[0] += v0.x; a[1] += v0.y; a[2] += v0.z; a[3] += v0.w; a[4] += v1.x; a[5] += v1.y; a[6] += v1.z; a[7] += v1.w; }
                st8(MERGED + (size_t)MP * DM + (size_t)i * 8, a); }
            PROBE_END(6); SEAM(pb + 6);
        }
        if ((PH_MASK >> 7 & 1) && IN(pb + 7)) { TIDS(); LAYER_PTRS(); PROBE_BEGIN(7);
            pg8::SplitOrder S{DM / 256, G, bx, 1, DM / 64, KS_OUT, DM / 64 / KS_OUT, (const char*)MERGED, (const char*)(WOUT_T + (size_t)l * DM * DM), (size_t)256 * DM * 2, (size_t)256 * DM * 2, 0, 0};
            pg8::EpiRes E{xinP, xinS, X1, ada + 2 * DM, SLAB};
            pg8::gemm_phase<pg8::EpiRes, pg8::SplitOrder>(L + RING_OFF, pg8::Dims{DM, DM, DM}, S, E, tid);
            PROBE_END(7); SEAM(pb + 7);
        }
        if ((PH_MASK >> 8 & 1) && IN(pb + 8)) { TIDS(); LAYER_PTRS(); PROBE_BEGIN(8);
            for (int rs = bx; rs < MS; rs += G) { const int row = MP + rs; const float* ar = ada + (size_t)row_cond(row) * ADAW;
                norm_row_block<KS_OUT>(xinS + (size_t)rs * DM, ar + 2 * DM, SLAB + (size_t)rs * DM, (size_t)MS * DM, X1 + (size_t)row * DM, INP(I_G2) + l * DM, ar + 4 * DM, ar + 3 * DM, H + (size_t)row * DM, (LAS float*)(L + RING_OFF), tid, wave); }
            f32x4 gm[8], shv[8]; int curc = row_cond(gw < MP ? gw : 0); { const float* ar = ada + (size_t)curc * ADAW; load_mod(INP(I_G2) + l * DM, ar + 4 * DM, ar + 3 * DM, gm, shv, lane); }
            for (int row = gw; row < MP; row += 2 * NGW) { const int rowb = row + NGW; const bool pair = rowb < MP && row_cond(rowb) == row_cond(row);
                for (int k = 0; k < 2; ++k) { const int r = k ? rowb : row; if (k && (pair || rowb >= MP)) break; const int cond = row_cond(r); const float* ar = ada + (size_t)cond * ADAW;
                    if (cond != curc) { load_mod(INP(I_G2) + l * DM, ar + 4 * DM, ar + 3 * DM, gm, shv, lane); curc = cond; }
                    if (pair) norm_row2(X1 + (size_t)row * DM, X1 + (size_t)rowb * DM, gm, shv, H + (size_t)row * DM, H + (size_t)rowb * DM, lane);
                    else norm_row(X1 + (size_t)r * DM, gm, shv, H + (size_t)r * DM, lane); } }
            PROBE_END(8); SEAM(pb + 8);
        }
        if ((PH_MASK >> 9 & 1) && IN(pb + 9)) { TIDS(); LAYER_PTRS(); PROBE_BEGIN(9);
            pg8::SplitOrder S{DFF / 256, G, bx, 1, DM / 64, KS_M1, DM / 64 / KS_M1, (const char*)H, (const char*)(WM1_T + (size_t)l * DFF * DM), (size_t)256 * DM * 2, (size_t)256 * DM * 2, 0, 0};
            pg8::EpiMlp1 E{HID, SLAB};
            pg8::gemm_phase<pg8::EpiMlp1, pg8::SplitOrder>(L + RING_OFF, pg8::Dims{DM, DM, DM}, S, E, tid);
            PROBE_END(9); SEAM(pb + 9);
        }
        if ((PH_MASK >> 10 & 1) && IN(pb + 10)) { TIDS(); LAYER_PTRS(); PROBE_BEGIN(10);
            for (int i = gt; i < MS * DFF / 8; i += NGT) { float a[8];
#pragma unroll
                for (int e = 0; e < 8; ++e) a[e] = 0.f;
#pragma unroll
                for (int p = 0; p < KS_M1; ++p) { const f32x4 v0 = *(const f32x4*)(SLAB + (size_t)p * MS * DFF + (size_t)i * 8), v1 = *(const f32x4*)(SLAB + (size_t)p * MS * DFF + (size_t)i * 8 + 4);
                    a[0] += v0.x; a[1] += v0.y; a[2] += v0.z; a[3] += v0.w; a[4] += v1.x; a[5] += v1.y; a[6] += v1.z; a[7] += v1.w; }
#pragma unroll
                for (int e = 0; e < 8; ++e) { const float t = fmaxf(a[e], 0.f); a[e] = t * t; }
                st8(HID + (size_t)MP * DFF + (size_t)i * 8, a); }
            PROBE_END(10); SEAM(pb + 10);
        }
        if ((PH_MASK >> 11 & 1) && IN(pb + 11)) { TIDS(); LAYER_PTRS(); PROBE_BEGIN(11);
            pg8::SplitOrder S{DM / 256, G, bx, 1, DFF / 64, KS_M2, DFF / 64 / KS_M2, (const char*)HID, (const char*)(WM2_T + (size_t)l * DM * DFF), (size_t)256 * DFF * 2, (size_t)256 * DFF * 2, 0, 0};
            pg8::EpiRes E{X1, X1 + (size_t)MP * DM, xout, ada + 5 * DM, SLAB};
            pg8::gemm_phase<pg8::EpiRes, pg8::SplitOrder>(L + RING_OFF, pg8::Dims{DFF, DFF, DFF}, S, E, tid);
            PROBE_END(11); SEAM(pb + 11);
        }
    }
    if ((PH_MASK >> 14 & 1) && IN(PH_TOTAL - 1)) { TIDS(); PROBE_BEGIN(14);
        const float* ada = ADA + (size_t)(DEPTH - 1) * NROWB * ADAW; float* yo = P_OUT + O_YS;
        for (int i = gt; i < MS * DM / 4; i += NGT) { const int row = i / (DM / 4), c4 = i % (DM / 4); const float* gp = ada + (size_t)(NBP + (row >> 3)) * ADAW + 5 * DM;
            f32x4 a = {0.f, 0.f, 0.f, 0.f};
#pragma unroll
            for (int p = 0; p < KS_M2; ++p) a += *(const f32x4*)(SLAB + (size_t)p * MS * DM + (size_t)i * 4);
            *(f32x4*)(yo + (size_t)i * 4) = *(const f32x4*)(X1 + (size_t)(MP + row) * DM + c4 * 4) + *(const f32x4*)(gp + c4 * 4) * a; }
        PROBE_END(14);
    }
#undef IN
#undef SEAM
}

extern "C" void kernel_launch(void* const* d_in, const int* in_sizes, int n_in, void* d_out, int out_size, void* d_ws, size_t ws_size, hipStream_t stream) {
    static int grid = 0;
    if (grid == 0) {
        if (n_in != N_IN || (size_t)out_size != O_END || ws_size < WS_END) { fprintf(stderr, "kernel_launch: unexpected shapes: n_in %d out %d ws %zu (need %zu)\n", n_in, out_size, ws_size, (size_t)WS_END); grid = -1; return; }
        int dev = 0, cus = 0, per_cu = 0;
        if (hipGetDevice(&dev) != hipSuccess || hipDeviceGetAttribute(&cus, hipDeviceAttributeMultiprocessorCount, dev) != hipSuccess) { grid = -1; return; }
        if (hipFuncSetAttribute((const void*)fwd, hipFuncAttributeMaxDynamicSharedMemorySize, LDS_BYTES) != hipSuccess) { fprintf(stderr, "kernel_launch: hipFuncSetAttribute failed\n"); grid = -1; return; }
        if (hipOccupancyMaxActiveBlocksPerMultiprocessor(&per_cu, (const void*)fwd, NTHR, LDS_BYTES) != hipSuccess || per_cu < 1) fprintf(stderr, "kernel_launch: occupancy query says %d\n", per_cu);
        (void)hipGetLastError();
        grid = cus;
    }
    if (grid < 0) return;
    (void)hipMemsetAsync((char*)d_ws + WS_CTL, 0, CTL_ZERO_BYTES, stream);
    Args a{};
    for (int i = 0; i < N_IN; ++i) a.in[i] = (const float*)d_in[i];
    a.out = (float*)d_out; a.ws = (unsigned char*)d_ws;
#if MK_ONE_LAUNCH
    a.ph_lo = 0; a.ph_hi = PH_TOTAL;
    hipLaunchKernelGGL(fwd, dim3(grid), dim3(NTHR), LDS_BYTES, stream, a);
#else
    for (int p = 0; p < PH_TOTAL; ++p) { a.ph_lo = p; a.ph_hi = p + 1; hipLaunchKernelGGL(fwd, dim3(grid), dim3(NTHR), LDS_BYTES, stream, a); }
#endif
}
#endif
```

```cpp
#ifndef HOST_TEST_ONLY
#include <hip/hip_runtime.h>
#endif
#include <cstdio>
#include <cstdint>
#include <cmath>

#ifndef MK_ONE_LAUNCH
#define MK_ONE_LAUNCH 1
#endif

#define HD __host__ __device__ __forceinline__
typedef unsigned short bf16;
HD float bf2f(bf16 b) { return __builtin_bit_cast(float, ((unsigned)b) << 16); }
HD bf16 f2bf(float f) { unsigned u = __builtin_bit_cast(unsigned, f); return (bf16)((u + 0x7fffu + ((u >> 16) & 1u)) >> 16); }

HD void ld8(const bf16* p, float* f) { const uint4 w = *(const uint4*)p;
    f[0] = __builtin_bit_cast(float, w.x << 16); f[1] = __builtin_bit_cast(float, w.x & 0xffff0000u); f[2] = __builtin_bit_cast(float, w.y << 16); f[3] = __builtin_bit_cast(float, w.y & 0xffff0000u);
    f[4] = __builtin_bit_cast(float, w.z << 16); f[5] = __builtin_bit_cast(float, w.z & 0xffff0000u); f[6] = __builtin_bit_cast(float, w.w << 16); f[7] = __builtin_bit_cast(float, w.w & 0xffff0000u); }
HD void st8(bf16* p, const float* f) { uint4 w; w.x = (unsigned)f2bf(f[0]) | ((unsigned)f2bf(f[1]) << 16); w.y = (unsigned)f2bf(f[2]) | ((unsigned)f2bf(f[3]) << 16);
    w.z = (unsigned)f2bf(f[4]) | ((unsigned)f2bf(f[5]) << 16); w.w = (unsigned)f2bf(f[6]) | ((unsigned)f2bf(f[7]) << 16); *(uint4*)p = w; }
constexpr int DM = 2048, SEQ = 4096, NBP = 2, MP = NBP * SEQ, SB = 32, ST = 8, MS = SB * ST, M = MP + MS, DEPTH = 4;
constexpr int NROWB = NBP + SB;
constexpr int NH = 16, HDIM = 64, NKV = 4, WIN = 128, BRW = 1024, CONVK = 31, CPRE = 30, PPAD = 15, RH = 8, RDK = 64, RDV = 128, DFF = 8192;
constexpr int ZW = 15872, ZQ = 0, ZK = 1024, ZV = 1280, ZCA = 1536, ZCG = 2560, ZPL = 3584, ZRQ = 4608, ZRK = 5120, ZRV = 5632, ZRG = 6656, ZGT = 7680;
constexpr int ADAW = 6 * DM;
constexpr float EPS = 1e-6f;
constexpr size_t O_YP = 0, O_YS = O_YP + (size_t)MP * DM, O_KP = O_YS + (size_t)MS * DM, O_VP = O_KP + (size_t)DEPTH * NBP * WIN * 256,
    O_CP = O_VP + (size_t)DEPTH * NBP * WIN * 256, O_PP = O_CP + (size_t)DEPTH * NBP * CPRE * BRW, O_RP = O_PP + (size_t)DEPTH * NBP * PPAD * BRW,
    O_KS = O_RP + (size_t)DEPTH * NBP * RH * RDK * RDV, O_VS = O_KS + (size_t)DEPTH * SB * WIN * 256, O_CS = O_VS + (size_t)DEPTH * SB * WIN * 256,
    O_PS = O_CS + (size_t)DEPTH * SB * CPRE * BRW, O_RS = O_PS + (size_t)DEPTH * SB * PPAD * BRW, O_END = O_RS + (size_t)DEPTH * SB * RH * RDK * RDV;
static_assert(O_END == 41394176, "output size");
enum { I_XP = 0, I_XS, I_CP, I_CS, I_CK, I_CV, I_SCONV, I_SPOOL, I_SRET, I_WADA, I_BADA, I_G1, I_G2, I_WIN, I_GQ, I_GK, I_SINK, I_WDW, I_BDW, I_GCLN, I_BCLN,
       I_WPOOL, I_SPOOLS, I_GRET, I_WBR, I_WOUT, I_WM1, I_WM2, N_IN };

HD bool row_is_s(int row) { return row >= MP; }
HD int row_cond(int row) { return row < MP ? (row >> 12) : NBP + ((row - MP) >> 3); }

#if defined(__HIP_DEVICE_COMPILE__)
#define FEXP(x) __expf(x)
#else
#define FEXP(x) expf(x)
#endif
#if defined(__HIP_DEVICE_COMPILE__)
HD float sigmoidf_(float x) { return __builtin_amdgcn_rcpf(1.f + __expf(-x)); }
#else
HD float sigmoidf_(float x) { return 1.f / (1.f + FEXP(-x)); }
#endif
HD float ret_logg(int h) { const float x = __builtin_bit_cast(float, (unsigned)(127 - 5 - h) << 23); return -x * (1.f + x * (0.5f + x * (0.33333334f + x * (0.25f + x * 0.2f)))); }

HD void qknorm_item(bf16* Z, int l, int row, int slot, const float* gq, const float* gk, float* out) {
    const int col = slot < 16 ? ZQ + slot * 64 : (slot < 20 ? ZK + (slot - 16) * 64 : ZV + (slot - 20) * 64);
    bf16* p = Z + (size_t)row * ZW + col;
    float v[64];
#pragma unroll
    for (int i = 0; i < 64; i += 8) ld8(p + i, v + i);
    if (slot < 20) {
        float ss = 0.f;
#pragma unroll
        for (int i = 0; i < 64; ++i) ss += v[i] * v[i];
        const float r = 1.f / sqrtf(ss * (1.f / 64.f) + EPS);
        const float* g = (slot < 16 ? gq : gk) + l * 64;
#pragma unroll
        for (int i = 0; i < 64; ++i) v[i] = v[i] * r * g[i];
#pragma unroll
        for (int i = 0; i < 64; i += 8) st8(p + i, v + i);
    }
    if (slot >= 16) {
        const int kvh = (slot - 16) & 3; const bool isv = slot >= 20;
        float* o = nullptr;
        if (!row_is_s(row)) { const int b = row >> 12, t = row & (SEQ - 1);
            if (t >= SEQ - WIN) o = out + (isv ? O_VP : O_KP) + ((((size_t)l * NBP + b) * WIN + (t - (SEQ - WIN))) * NKV + kvh) * 64;
        } else { const int sb = (row - MP) >> 3, t = (row - MP) & 7;
            o = out + (isv ? O_VS : O_KS) + ((((size_t)l * SB + sb) * WIN + (WIN - ST + t)) * NKV + kvh) * 64; }
        if (o) {
#pragma unroll
            for (int i = 0; i < 64; ++i) o[i] = v[i];
        }
    }
}
HD void shift_item(int l, int idx, const float* ck, const float* cv, const float* sconv, const float* spool, float* out) {
    constexpr int NKVS = SB * (WIN - ST) * 64, NCV = SB * (CPRE - ST) * 256, NPL = SB * (PPAD - ST) * 256;
    const float* src; float* dst;
    if (idx < 2 * NKVS) { const bool isv = idx >= NKVS; const int i = isv ? idx - NKVS : idx; const int sb = i / ((WIN - ST) * 64), rem = i % ((WIN - ST) * 64);
        src = (isv ? cv : ck) + (((size_t)l * SB + sb) * WIN + ST) * 256 + (size_t)rem * 4; dst = out + (isv ? O_VS : O_KS) + (((size_t)l * SB + sb) * WIN) * 256 + (size_t)rem * 4;
    } else if (idx < 2 * NKVS + NCV) { const int i = idx - 2 * NKVS; const int sb = i / ((CPRE - ST) * 256), rem = i % ((CPRE - ST) * 256);
        src = sconv + (((size_t)l * SB + sb) * CPRE + ST) * BRW + (size_t)rem * 4; dst = out + O_CS + (((size_t)l * SB + sb) * CPRE) * BRW + (size_t)rem * 4;
    } else { const int i = idx - 2 * NKVS - NCV; const int sb = i / ((PPAD - ST) * 256), rem = i % ((PPAD - ST) * 256);
        src = spool + (((size_t)l * SB + sb) * PPAD + ST) * BRW + (size_t)rem * 4; dst = out + O_PS + (((size_t)l * SB + sb) * PPAD) * BRW + (size_t)rem * 4; }
    dst[0] = src[0]; dst[1] = src[1]; dst[2] = src[2]; dst[3] = src[3];
}
constexpr int N_SHIFT_ITEMS = 2 * SB * (WIN - ST) * 64 + SB * (CPRE - ST) * 256 + SB * (PPAD - ST) * 256;

HD float glu_at(const bf16* Z, int row, int c) { const bf16* p = Z + (size_t)row * ZW; return bf2f(p[ZCA + c]) * sigmoidf_(bf2f(p[ZCG + c])); }
HD void conv_item(const bf16* Z, int l, int row, int c, const float* wdw, const float* bdw, const float* sconv, float* CONVY, float* out) {
    float acc = bdw[l * BRW + c];
    const float* w = wdw + (size_t)l * CONVK * BRW + c;
    if (!row_is_s(row)) { const int b = row >> 12, t = row & (SEQ - 1);
        for (int j = 0; j < CONVK; ++j) { const int tt = t - CPRE + j; if (tt >= 0) acc += w[(size_t)j * BRW] * glu_at(Z, b * SEQ + tt, c); }
        if (t >= SEQ - CPRE) out[O_CP + (((size_t)l * NBP + b) * CPRE + (t - (SEQ - CPRE))) * BRW + c] = glu_at(Z, row, c);
    } else { const int sb = (row - MP) >> 3, t = (row - MP) & 7;
        for (int j = 0; j < CONVK; ++j) { const int tt = t - CPRE + j;
            const float u = tt >= 0 ? glu_at(Z, MP + sb * ST + tt, c) : sconv[(((size_t)l * SB + sb) * CPRE + (CPRE + tt)) * BRW + c];
            acc += w[(size_t)j * BRW] * u; }
        out[O_CS + (((size_t)l * SB + sb) * CPRE + (CPRE - ST + t)) * BRW + c] = glu_at(Z, row, c);
    }
    CONVY[(size_t)row * BRW + c] = acc;
}
HD void pool_item(const bf16* Z, int l, int row, int c, const float* spool, bf16* ZP, float* out) {
    const int g = c >> 8, w = 2 << g;
    const float u0 = bf2f(Z[(size_t)row * ZW + ZPL + c]);
    float sum = 0.f, cnt;
    if (!row_is_s(row)) { const int b = row >> 12, t = row & (SEQ - 1);
        for (int i = 0; i < w; ++i) if (t - i >= 0) sum += bf2f(Z[(size_t)(b * SEQ + t - i) * ZW + ZPL + c]);
        cnt = (float)((t + 1) < w ? (t + 1) : w);
        if (t >= SEQ - PPAD) out[O_PP + (((size_t)l * NBP + b) * PPAD + (t - (SEQ - PPAD))) * BRW + c] = u0;
    } else { const int sb = (row - MP) >> 3, t = (row - MP) & 7;
        for (int i = 0; i < w; ++i) { const int tt = t - i;
            sum += tt >= 0 ? bf2f(Z[(size_t)(MP + sb * ST + tt) * ZW + ZPL + c]) : spool[(((size_t)l * SB + sb) * PPAD + (PPAD + tt)) * BRW + c]; }
        cnt = (float)w;
        out[O_PS + (((size_t)l * SB + sb) * PPAD + (PPAD - ST + t)) * BRW + c] = u0;
    }
    ZP[(size_t)row * BRW + c] = f2bf(sum / cnt - u0);
}
HD void retkv_item(const bf16* Z, float* KV, int b, int n, int h, int d, int v4) {
    const float lg = ret_logg(h);
    float a0 = 0.f, a1 = 0.f, a2 = 0.f, a3 = 0.f;
    for (int j = 0; j < 128; ++j) { const bf16* p = Z + (size_t)(b * SEQ + n * 128 + j) * ZW;
        const float kd = bf2f(p[ZRK + h * 64 + d]) * 0.125f * FEXP(lg * (float)(127 - j));
        const bf16* pv = p + ZRV + h * 128 + v4 * 4;
        a0 += kd * bf2f(pv[0]); a1 += kd * bf2f(pv[1]); a2 += kd * bf2f(pv[2]); a3 += kd * bf2f(pv[3]); }
    float* o = KV + ((((size_t)b * 32 + n) * RH + h) * RDK + d) * RDV + v4 * 4;
    o[0] = a0; o[1] = a1; o[2] = a2; o[3] = a3;
}
HD void retstate_s_item(const bf16* Z, int l, int sb, int h, int d, int v4, const float* sret, float* out) {
    const float lg = ret_logg(h);
    const size_t so = ((((size_t)l * SB + sb) * RH + h) * RDK + d) * RDV + v4 * 4;
    const float gc = FEXP(lg * (float)ST);
    float a0 = gc * sret[so], a1 = gc * sret[so + 1], a2 = gc * sret[so + 2], a3 = gc * sret[so + 3];
#pragma unroll
    for (int j = 0; j < ST; ++j) { const bf16* p = Z + (size_t)(MP + sb * ST + j) * ZW;
        const float kd = bf2f(p[ZRK + h * 64 + d]) * 0.125f * FEXP(lg * (float)(ST - 1 - j));
        const bf16* pv = p + ZRV + h * 128 + v4 * 4;
        a0 += kd * bf2f(pv[0]); a1 += kd * bf2f(pv[1]); a2 += kd * bf2f(pv[2]); a3 += kd * bf2f(pv[3]); }
    float* o = out + O_RS + so; o[0] = a0; o[1] = a1; o[2] = a2; o[3] = a3;
}
HD void retscan_item(const float* KV, float* SPREV, int l, int b, int h, int d, int v4, float* out) {
    const float gc = FEXP(ret_logg(h) * 128.f);
    float s0 = 0.f, s1 = 0.f, s2 = 0.f, s3 = 0.f;
    for (int n = 0; n < 32; ++n) { const size_t o = ((((size_t)b * 32 + n) * RH + h) * RDK + d) * RDV + v4 * 4;
        SPREV[o] = s0; SPREV[o + 1] = s1; SPREV[o + 2] = s2; SPREV[o + 3] = s3;
        s0 = gc * s0 + KV[o]; s1 = gc * s1 + KV[o + 1]; s2 = gc * s2 + KV[o + 2]; s3 = gc * s3 + KV[o + 3]; }
    float* oo = out + O_RP + ((((size_t)l * NBP + b) * RH + h) * RDK + d) * RDV + v4 * 4;
    oo[0] = s0; oo[1] = s1; oo[2] = s2; oo[3] = s3;
}
HD void attn_item(const bf16* Z, int l, int row, int hq, const float* sinks, const float* ck, const float* cv, bf16* Y0) {
    const int kvh = hq >> 2; const float slope = exp2f(-0.5f * (float)(hq + 1));
    float q[64];
    { const bf16* p = Z + (size_t)row * ZW + ZQ + hq * 64;
#pragma unroll
      for (int i = 0; i < 64; i += 8) ld8(p + i, q + i);
#pragma unroll
      for (int i = 0; i < 64; ++i) q[i] *= 0.125f; }
    float m = sinks[l * NH + hq], lsum = 1.f;
    float o[64];
#pragma unroll
    for (int i = 0; i < 64; ++i) o[i] = 0.f;
    const bool smp = row_is_s(row);
    const int b = smp ? ((row - MP) >> 3) : (row >> 12), t = smp ? ((row - MP) & 7) : (row & (SEQ - 1));
    const int lo = smp ? t : (t - WIN > 0 ? t - WIN : 0), hi = smp ? WIN + t : t;
    for (int j = lo; j <= hi; ++j) {
        const int dist = smp ? (WIN + t - j) : (t - j);
        const bool cache = smp && j < WIN;
        const size_t zrow = (size_t)(smp ? (MP + b * ST + (j - WIN)) : (b * SEQ + j)) * ZW;
        const size_t crow = ((((size_t)l * SB + b) * WIN + j) * NKV + kvh) * 64;
        float s = 0.f;
        if (cache) { const float* kp = ck + crow;
#pragma unroll
            for (int i = 0; i < 64; ++i) s += q[i] * kp[i];
        } else { const bf16* kp = Z + zrow + ZK + kvh * 64;
#pragma unroll
            for (int i = 0; i < 64; i += 8) { float f[8]; ld8(kp + i, f);
#pragma unroll
                for (int e = 0; e < 8; ++e) s += q[i + e] * f[e]; } }
        s -= slope * (float)dist;
        if (s > m) { const float corr = FEXP(m - s); lsum *= corr;
#pragma unroll
            for (int i = 0; i < 64; ++i) o[i] *= corr;
            m = s; }
        const float p = FEXP(s - m); lsum += p;
        if (cache) { const float* vp = cv + crow;
#pragma unroll
            for (int i = 0; i < 64; ++i) o[i] += p * vp[i];
        } else { const bf16* vp = Z + zrow + ZV + kvh * 64;
#pragma unroll
            for (int i = 0; i < 64; i += 8) { float f[8]; ld8(vp + i, f);
#pragma unroll
                for (int e = 0; e < 8; ++e) o[i + e] += p * f[e]; } }
    }
    const float inv = 1.f / lsum;
    bf16* y = Y0 + (size_t)row * BRW + hq * 64;
#pragma unroll
    for (int i = 0; i < 64; ++i) o[i] *= inv;
#pragma unroll
    for (int i = 0; i < 64; i += 8) st8(y + i, o + i);
}
HD void retout_item(const bf16* Z, int l, int row, int h, const float* SPREV, const float* sret, const float* gret, float* ORAW, bf16* Y3) {
    const float lg = ret_logg(h);
    const bool smp = row_is_s(row);
    const int b = smp ? ((row - MP) >> 3) : (row >> 12), t = smp ? ((row - MP) & 7) : (row & (SEQ - 1));
    const int i = smp ? t : (t & 127), n = smp ? 0 : (t >> 7);
    const int row0 = smp ? (MP + b * ST) : (b * SEQ + n * 128);
    const float* S = smp ? sret + (((size_t)l * SB + b) * RH + h) * RDK * RDV : SPREV + (((size_t)b * 32 + n) * RH + h) * RDK * RDV;
    float q[64];
    { const bf16* p = Z + (size_t)row * ZW + ZRQ + h * 64;
#pragma unroll
      for (int d = 0; d < 64; d += 8) ld8(p + d, q + d); }
    float* oraw = ORAW + (size_t)row * BRW + h * 128;
    float sum = 0.f;
    for (int half = 0; half < 2; ++half) {
        float o[64];
#pragma unroll
        for (int v = 0; v < 64; ++v) o[v] = 0.f;
        for (int j = 0; j <= i; ++j) { const bf16* p = Z + (size_t)(row0 + j) * ZW;
            const bf16* kp = p + ZRK + h * 64; float s = 0.f;
#pragma unroll
            for (int d = 0; d < 64; d += 8) { float f[8]; ld8(kp + d, f);
#pragma unroll
                for (int e = 0; e < 8; ++e) s += q[d + e] * f[e]; }
            s *= 0.125f * FEXP(lg * (float)(i - j));
            const bf16* vp = p + ZRV + h * 128 + half * 64;
#pragma unroll
            for (int v = 0; v < 64; v += 8) { float f[8]; ld8(vp + v, f);
#pragma unroll
                for (int e = 0; e < 8; ++e) o[v + e] += s * f[e]; } }
        const float cf = FEXP(lg * (float)(i + 1));
        const bf16* qp = Z + (size_t)row * ZW + ZRQ + h * 64;
        for (int d = 0; d < 64; ++d) { const float qd = bf2f(qp[d]) * cf; const float* sp = S + (size_t)d * RDV + half * 64;
#pragma unroll
            for (int v = 0; v < 64; ++v) o[v] += qd * sp[v]; }
#pragma unroll
        for (int v = 0; v < 64; ++v) { oraw[half * 64 + v] = o[v]; sum += o[v]; }
    }
    const float mean = sum * (1.f / 128.f);
    float var = 0.f;
    for (int v = 0; v < 128; ++v) { const float d = oraw[v] - mean; var += d * d; }
    const float rstd = 1.f / sqrtf(var * (1.f / 128.f) + EPS);
    const float* g = gret + l * BRW + h * 128;
    const bf16* rg = Z + (size_t)row * ZW + ZRG + h * 128;
    bf16* y = Y3 + (size_t)row * BRW + h * 128;
    for (int v = 0; v < 128; ++v) y[v] = f2bf((oraw[v] - mean) * rstd * g[v] * bf2f(rg[v]));
}

#if !defined(HOST_TEST_ONLY)
namespace pg8 {
#define PG8_LAS __attribute__((address_space(3)))
typedef short bf16x8 __attribute__((ext_vector_type(8)));
typedef float f32x4 __attribute__((ext_vector_type(4)));
typedef float f32x2 __attribute__((ext_vector_type(2)));
typedef unsigned u32x4 __attribute__((ext_vector_type(4)));
typedef unsigned u32x2 __attribute__((ext_vector_type(2)));
constexpr int BM = 256, BK = 64, HALF = 128, HTB = HALF * BK * 2, STAGE_BYTES = 8 * HTB, NXCD = 8, WGM = 8;

__host__ __device__ __forceinline__ int lds_byte(int r, int c) { const int st = (r >> 4) * 2 + (c >> 5), rr = r & 15, cc = c & 31, ob = rr * 64 + cc * 2; return st * 1024 + (ob ^ (((ob >> 9) & 1) << 5)); }
__host__ __device__ __forceinline__ void stage_rc(int b, int& R, int& C) { const int st = b / 1024, sb = b % 1024, swz = sb ^ (((sb >> 9) & 1) << 5); R = (st >> 1) * 16 + swz / 64; C = (st & 1) * 32 + (swz % 64) / 2; }
__host__ __device__ __forceinline__ int perm32(int rho) { const int n = rho >> 4, i = rho & 15; return 8 * (i >> 2) + 4 * n + (i & 3); }

struct Unit { int pm, pn, r, ks, nt; const char* a; const char* b; };
struct Dims { int lda, ldb, K; };

__host__ __device__ __forceinline__ void tile_of(int L, int nM, int nN, int& pm, int& pn) {
    const int nwg = nM * nN; int wgid = L; { const int q = nwg / NXCD, r = nwg % NXCD, xcd = wgid % NXCD, off = wgid / NXCD; wgid = (xcd < r ? xcd * (q + 1) : r * (q + 1) + (xcd - r) * q) + off; }
    const int nig = WGM * nN, gid = wgid / nig, fm = gid * WGM, gsz = (nM - fm) < WGM ? (nM - fm) : WGM;
    pm = fm + ((wgid % nig) % gsz); pn = (wgid % nig) / gsz;
}
struct StaticOrder {
    int nM, nN, nwg, G, c, nt; const char* A; const char* B; size_t ta, tb;
    __device__ __forceinline__ void init(const bf16* A_, const bf16* B_, int nM_, int nN_, int lda, int ldb, int K, int G_, int c_) { A = (const char*)A_; B = (const char*)B_; nM = nM_; nN = nN_; nwg = nM * nN; G = G_; c = c_; nt = K / BK; ta = (size_t)BM * lda * 2; tb = (size_t)BM * ldb * 2; }
    __device__ __forceinline__ bool next(int i, Unit& u) const {
        const long L = (long)i * G + c; if (L >= nwg) return false;
        tile_of((int)L, nM, nN, u.pm, u.pn); u.r = 0; u.ks = 0; u.nt = nt; u.a = A + (size_t)u.pm * ta; u.b = B + (size_t)u.pn * tb; return true;
    }
};


struct SplitOrder {
    int nN, G, c, RPT, ntP, KS, ntS; const char* A; const char* B; size_t ta, tb, sAr, sBr;
    __device__ __forceinline__ bool next(int i, Unit& u) const {
        const int nP = (MP / BM) * nN, Pc = c < nP ? (nP - c + G - 1) / G : 0;
        if (i < Pc * RPT) { const int tl = (i / RPT) * G + c; tile_of(tl, MP / BM, nN, u.pm, u.pn); u.r = i % RPT; u.ks = 0; u.nt = ntP;
            u.a = A + (size_t)u.r * sAr + (size_t)u.pm * ta; u.b = B + (size_t)u.r * sBr + (size_t)u.pn * tb; return true; }
        const int su = (i - Pc * RPT) * G + c; if (su >= nN * RPT * KS) return false;
        u.pm = MP / BM; u.pn = su / (RPT * KS); u.r = (su / KS) % RPT; u.ks = su % KS; u.nt = ntS;
        u.a = A + (size_t)u.r * sAr + (size_t)u.pm * ta + (size_t)u.ks * ntS * (BK * 2); u.b = B + (size_t)u.r * sBr + (size_t)u.pn * tb + (size_t)u.ks * ntS * (BK * 2); return true;
    }
};

__device__ __forceinline__ unsigned cvt_pk_bf16(float lo, float hi) { unsigned r; asm volatile("v_cvt_pk_bf16_f32 %0, %1, %2" : "=v"(r) : "v"(lo), "v"(hi)); return r; }

template <class Epi, class Sched, bool ALIGN_EPI = true, bool SP2 = true>
__device__ __forceinline__ void gemm_phase(PG8_LAS unsigned char* lds, const Dims g, const Sched& S, const Epi& E, const int tid) {
    const int wid = __builtin_amdgcn_readfirstlane(tid >> 6), lane = tid & 63, wr = wid >> 2, wc = wid & 3, fr = lane & 15, fq = lane >> 4;
    unsigned voffA[2], voffB[2];
#pragma unroll
    for (int i = 0; i < 2; ++i) { int R, C; stage_rc(tid * 16 + i * 8192, R, C); const int Rb = Epi::PERM ? ((R & ~31) + perm32(R & 31)) : R;
        voffA[i] = (unsigned)(R * g.lda + C) * 2u; voffB[i] = (unsigned)(Rb * g.ldb + C) * 2u; }
    const size_t kstep = (size_t)(BK * 2);
    const size_t hstepA = (size_t)HALF * g.lda * 2, hstepB = (size_t)HALF * g.ldb * 2;
    const unsigned ldsw = (unsigned)wid * 1024u;
    const int aoff = lds_byte(wr * 64 + fr, fq * 8), boff = lds_byte(wc * 32 + fr, fq * 8);
#define PG8_SA(b, h) (((b) * 2 + (h)) * HTB)
#define PG8_SB(b, h) ((4 + (b) * 2 + (h)) * HTB)
#define PG8_STAGE(bufoff, gbase, voff) do { _Pragma("unroll") for (int _i = 0; _i < 2; ++_i) \
        __builtin_amdgcn_global_load_lds((const unsigned*)((const char*)(gbase) + (voff)[_i]), (PG8_LAS unsigned*)(lds + (bufoff) + ldsw + _i * 8192), 16, 0, 0); } while (0)
#define PG8_LDA(dst, b, h) do { _Pragma("unroll") for (int m = 0; m < 4; ++m) _Pragma("unroll") for (int k = 0; k < 2; ++k) dst[m][k] = *(const PG8_LAS bf16x8*)(lds + PG8_SA(b, h) + aoff + m * 2048 + k * 1024); } while (0)
#define PG8_LDB(dst, b, h) do { _Pragma("unroll") for (int n = 0; n < 2; ++n) _Pragma("unroll") for (int k = 0; k < 2; ++k) dst[n][k] = *(const PG8_LAS bf16x8*)(lds + PG8_SB(b, h) + boff + n * 2048 + k * 1024); } while (0)
#define PG8_MMA(ai, bj, At, Bt) do { __builtin_amdgcn_s_setprio(1); _Pragma("unroll") for (int m = 0; m < 4; ++m) _Pragma("unroll") for (int n = 0; n < 2; ++n) _Pragma("unroll") for (int k = 0; k < 2; ++k) \
        acc[ai][bj][m][n] = __builtin_amdgcn_mfma_f32_16x16x32_bf16(Bt[n][k], At[m][k], acc[ai][bj][m][n], 0, 0, 0); __builtin_amdgcn_s_setprio(0); } while (0)
#define PG8_WAIT_V(n) asm volatile("s_waitcnt vmcnt(" #n ")" ::: "memory")
#define PG8_WAIT_L(n) asm volatile("s_waitcnt lgkmcnt(" #n ")" ::: "memory")
#define PG8_BAR __builtin_amdgcn_s_barrier()
#define PG8_SCHED __builtin_amdgcn_sched_barrier(0)
    Unit cur, nxt; int ui = 0;
    if (!S.next(0, cur)) return;
    f32x4 acc[2][2][4][2];
#pragma unroll
    for (int a = 0; a < 2; ++a)
#pragma unroll
        for (int b = 0; b < 2; ++b)
#pragma unroll
            for (int m = 0; m < 4; ++m)
#pragma unroll
                for (int n = 0; n < 2; ++n) acc[a][b][m][n] = (f32x4){0.f, 0.f, 0.f, 0.f};
    bf16x8 At[4][2], B0[2][2], B1[2][2];
    const char* cA = cur.a; const char* cB = cur.b;
    if constexpr (SP2) {
        PG8_STAGE(PG8_SB(0, 0), cB, voffB); PG8_STAGE(PG8_SB(0, 1), cB + hstepB, voffB); PG8_STAGE(PG8_SA(0, 0), cA, voffA); PG8_STAGE(PG8_SA(0, 1), cA + hstepA, voffA);
        if (wr == 1) PG8_BAR;
        PG8_WAIT_V(2); PG8_BAR;
        PG8_STAGE(PG8_SB(1, 0), cB + kstep, voffB); PG8_STAGE(PG8_SA(1, 0), cA + kstep, voffA); PG8_STAGE(PG8_SB(1, 1), cB + hstepB + kstep, voffB);
        PG8_WAIT_V(6); PG8_BAR;
    } else {
        PG8_STAGE(PG8_SB(0, 0), cB, voffB); PG8_STAGE(PG8_SA(0, 0), cA, voffA); PG8_STAGE(PG8_SB(0, 1), cB + hstepB, voffB); PG8_STAGE(PG8_SA(0, 1), cA + hstepA, voffA);
        if (wr == 1) PG8_BAR;
        PG8_WAIT_V(4); PG8_BAR;
        PG8_STAGE(PG8_SB(1, 0), cB + kstep, voffB); PG8_STAGE(PG8_SA(1, 0), cA + kstep, voffA); PG8_STAGE(PG8_SB(1, 1), cB + hstepB + kstep, voffB);
        PG8_WAIT_V(6); PG8_BAR;
    }
    for (;;) {
        const bool has_next = S.next(ui + 1, nxt);
        const char* nA = has_next ? nxt.a : cA; const char* nB = has_next ? nxt.b : cB;
        const int nt = cur.nt;
        for (int t = 0; t < nt; t += 2) {
            const bool last = (t == nt - 2);
            const char* a1 = cA + (size_t)(t + 1) * kstep;
            const char* a2 = last ? nA : cA + (size_t)(t + 2) * kstep; const char* b2 = last ? nB : cB + (size_t)(t + 2) * kstep;
            const char* a3 = a2 + kstep; const char* b3 = b2 + kstep;
            if constexpr (SP2) {
            PG8_LDB(B0, 0, 0); PG8_LDB(B1, 0, 1); PG8_SCHED; PG8_LDA(At, 0, 0); PG8_STAGE(PG8_SA(1, 1), a1 + hstepA, voffA);
            PG8_WAIT_V(8); PG8_WAIT_L(0); PG8_BAR; PG8_MMA(0, 0, At, B0); PG8_MMA(0, 1, At, B1); PG8_BAR; PG8_SCHED;
            PG8_LDA(At, 0, 1); PG8_STAGE(PG8_SB(0, 0), b2, voffB); PG8_STAGE(PG8_SB(0, 1), b2 + hstepB, voffB); PG8_STAGE(PG8_SA(0, 0), a2, voffA);
            PG8_WAIT_V(8); PG8_WAIT_L(0); PG8_BAR; PG8_MMA(1, 0, At, B0); PG8_MMA(1, 1, At, B1); PG8_BAR; PG8_SCHED;
            PG8_LDB(B0, 1, 0); PG8_LDB(B1, 1, 1); PG8_SCHED; PG8_LDA(At, 1, 0); PG8_STAGE(PG8_SA(0, 1), a2 + hstepA, voffA);
            PG8_WAIT_V(8); PG8_WAIT_L(0); PG8_BAR; PG8_MMA(0, 0, At, B0); PG8_MMA(0, 1, At, B1); PG8_BAR; PG8_SCHED;
            PG8_LDA(At, 1, 1); PG8_STAGE(PG8_SB(1, 0), b3, voffB); PG8_STAGE(PG8_SB(1, 1), b3 + hstepB, voffB); PG8_STAGE(PG8_SA(1, 0), a3, voffA);
            PG8_WAIT_V(8); PG8_WAIT_L(0); PG8_BAR; PG8_MMA(1, 0, At, B0); PG8_MMA(1, 1, At, B1); PG8_BAR; PG8_SCHED;
            } else {
            PG8_LDB(B0, 0, 0); PG8_SCHED; PG8_LDA(At, 0, 0); PG8_STAGE(PG8_SA(1, 1), a1 + hstepA, voffA);
            PG8_WAIT_L(8); PG8_BAR; PG8_WAIT_L(0); PG8_MMA(0, 0, At, B0); PG8_BAR; PG8_SCHED;
            PG8_LDB(B1, 0, 1); PG8_STAGE(PG8_SB(0, 0), b2, voffB);
            PG8_BAR; PG8_WAIT_L(0); PG8_MMA(0, 1, At, B1); PG8_BAR;
            PG8_LDA(At, 0, 1); PG8_STAGE(PG8_SA(0, 0), a2, voffA);
            PG8_BAR; PG8_WAIT_L(0); PG8_MMA(1, 0, At, B0); PG8_BAR; PG8_SCHED;
            PG8_STAGE(PG8_SB(0, 1), b2 + hstepB, voffB);
            PG8_WAIT_V(6); PG8_BAR; PG8_MMA(1, 1, At, B1); PG8_BAR;
            PG8_LDB(B0, 1, 0); PG8_SCHED; PG8_LDA(At, 1, 0); PG8_STAGE(PG8_SA(0, 1), a2 + hstepA, voffA);
            PG8_WAIT_L(8); PG8_BAR; PG8_WAIT_L(0); PG8_MMA(0, 0, At, B0); PG8_BAR; PG8_SCHED;
            PG8_LDB(B1, 1, 1); PG8_STAGE(PG8_SB(1, 0), b3, voffB);
            PG8_BAR; PG8_WAIT_L(0); PG8_MMA(0, 1, At, B1); PG8_BAR;
            PG8_LDA(At, 1, 1); PG8_STAGE(PG8_SA(1, 0), a3, voffA);
            PG8_BAR; PG8_WAIT_L(0); PG8_MMA(1, 0, At, B0); PG8_BAR; PG8_SCHED;
            PG8_STAGE(PG8_SB(1, 1), b3 + hstepB, voffB);
            PG8_WAIT_V(6); PG8_BAR; PG8_MMA(1, 1, At, B1); PG8_BAR;
            }
        }
        if constexpr (ALIGN_EPI) { if (wr == 0) PG8_BAR; }
        bool keep; { int ln; asm volatile("v_mbcnt_lo_u32_b32 %0, -1, 0\n\tv_mbcnt_hi_u32_b32 %0, -1, %0" : "=v"(ln)); keep = E(acc, cur, wr, wc, ln & 15, ln >> 4); }
        if (!has_next) break;
        if (!keep)
#pragma unroll
        for (int a = 0; a < 2; ++a)
#pragma unroll
            for (int b = 0; b < 2; ++b)
#pragma unroll
                for (int m = 0; m < 4; ++m)
#pragma unroll
                    for (int n = 0; n < 2; ++n) acc[a][b][m][n] = (f32x4){0.f, 0.f, 0.f, 0.f};
        cur = nxt; cA = nA; cB = nB; ++ui;
        if constexpr (ALIGN_EPI) { if (wr == 1) PG8_BAR; }
    }
    PG8_WAIT_V(0);
    if constexpr (!ALIGN_EPI) { if (wr == 0) PG8_BAR; }
    PG8_BAR;
#undef PG8_SA
#undef PG8_SB
#undef PG8_STAGE
#undef PG8_LDA
#undef PG8_LDB
#undef PG8_MMA
#undef PG8_WAIT_V
#undef PG8_WAIT_L
#undef PG8_BAR
#undef PG8_SCHED
}

__device__ __forceinline__ float fsigmoid(float x) { return __builtin_amdgcn_rcpf(1.f + __expf(-x)); }
struct EpiZ {
    static constexpr bool PERM = true;
    bf16* Z;
    __device__ __forceinline__ bool operator()(f32x4 (&acc)[2][2][4][2], const Unit& u, int wr, int wc, int fr, int fq) const {
        const int row0 = u.pm * BM + wr * 64 + fr, col0 = u.pn * BM + wc * 32 + 8 * fq;
        const int ty = u.pn >= 30 ? 2 : (u.pn >= 26 ? 1 : 0);
        if (u.pn >= 6 && u.pn < 14) {
            const int colg = ZCA + (u.pn - 6) * 128 + wc * 32 + 8 * fq;
#pragma unroll
            for (int ai = 0; ai < 2; ++ai)
#pragma unroll
                for (int m = 0; m < 4; ++m) { f32x4 a0 = acc[ai][0][m][0], a1 = acc[ai][0][m][1]; const f32x4 g0 = acc[ai][1][m][0], g1 = acc[ai][1][m][1];
#pragma unroll
                    for (int j = 0; j < 4; ++j) { a0[j] = a0[j] * fsigmoid(g0[j]); a1[j] = a1[j] * fsigmoid(g1[j]); }
                    u32x4 w; w.x = cvt_pk_bf16(a0[0], a0[1]); w.y = cvt_pk_bf16(a0[2], a0[3]); w.z = cvt_pk_bf16(a1[0], a1[1]); w.w = cvt_pk_bf16(a1[2], a1[3]);
                    *(u32x4*)(Z + (size_t)(row0 + ai * HALF + m * 16) * ZW + colg) = w; }
            return false;
        }
#pragma unroll
        for (int ai = 0; ai < 2; ++ai)
#pragma unroll
            for (int m = 0; m < 4; ++m) { bf16* rowp = Z + (size_t)(row0 + ai * HALF + m * 16) * ZW + col0;
#pragma unroll
                for (int bj = 0; bj < 2; ++bj) { f32x4 v0 = acc[ai][bj][m][0], v1 = acc[ai][bj][m][1];
                    if (ty == 2) {
#pragma unroll
                        for (int j = 0; j < 4; ++j) { v0[j] = fsigmoid(v0[j]); v1[j] = fsigmoid(v1[j]); } }
                    else if (ty == 1) {
#pragma unroll
                        for (int j = 0; j < 4; ++j) { v0[j] = v0[j] * fsigmoid(v0[j]); v1[j] = v1[j] * fsigmoid(v1[j]); } }
                    u32x4 w; w.x = cvt_pk_bf16(v0[0], v0[1]); w.y = cvt_pk_bf16(v0[2], v0[3]); w.z = cvt_pk_bf16(v1[0], v1[1]); w.w = cvt_pk_bf16(v1[2], v1[3]);
                    *(u32x4*)(rowp + bj * HALF) = w; } }
        return false;
    }
};
struct EpiMlp1 {
    static constexpr bool PERM = true;
    bf16* O; float* SLAB;
    __device__ __forceinline__ bool operator()(f32x4 (&acc)[2][2][4][2], const Unit& u, int wr, int wc, int fr, int fq) const {
        const int row0 = u.pm * BM + wr * 64 + fr, col0 = u.pn * BM + wc * 32 + 8 * fq;
        if (u.pm == MP / BM) { float* sl = SLAB + ((size_t)u.ks * BM + wr * 64 + fr) * DFF + col0;
#pragma unroll
            for (int ai = 0; ai < 2; ++ai)
#pragma unroll
                for (int m = 0; m < 4; ++m)
#pragma unroll
                    for (int bj = 0; bj < 2; ++bj) { float* p = sl + (size_t)(ai * HALF + m * 16) * DFF + bj * HALF; *(f32x4*)p = acc[ai][bj][m][0]; *(f32x4*)(p + 4) = acc[ai][bj][m][1]; }
            return false; }
#pragma unroll
        for (int ai = 0; ai < 2; ++ai)
#pragma unroll
            for (int m = 0; m < 4; ++m) { bf16* rowp = O + (size_t)(row0 + ai * HALF + m * 16) * DFF + col0;
#pragma unroll
                for (int bj = 0; bj < 2; ++bj) { f32x4 v0 = acc[ai][bj][m][0], v1 = acc[ai][bj][m][1];
#pragma unroll
                    for (int j = 0; j < 4; ++j) { const float a = fmaxf(v0[j], 0.f), b = fmaxf(v1[j], 0.f); v0[j] = a * a; v1[j] = b * b; }
                    u32x4 w; w.x = cvt_pk_bf16(v0[0], v0[1]); w.y = cvt_pk_bf16(v0[2], v0[3]); w.z = cvt_pk_bf16(v1[0], v1[1]); w.w = cvt_pk_bf16(v1[2], v1[3]);
                    *(u32x4*)(rowp + bj * HALF) = w; } }
        return false;
    }
};
struct EpiPool {
    static constexpr bool PERM = true;
    bf16* Y2; const float* spb; int l;
    __device__ __forceinline__ bool operator()(f32x4 (&acc)[2][2][4][2], const Unit& u, int wr, int wc, int fr, int fq) const {
        const int row0 = u.pm * BM + wr * 64 + fr, col0 = u.pn * BM + wc * 32 + 8 * fq;
        int le = l; asm volatile("" : "+s"(le)); const float* sp = spb + le * BRW;
        f32x4 s[2][2];
#pragma unroll
        for (int bj = 0; bj < 2; ++bj)
#pragma unroll
            for (int n = 0; n < 2; ++n) s[bj][n] = *(const f32x4*)(sp + col0 + bj * HALF + 4 * n);
#pragma unroll
        for (int ai = 0; ai < 2; ++ai)
#pragma unroll
            for (int m = 0; m < 4; ++m) { bf16* rowp = Y2 + (size_t)(row0 + ai * HALF + m * 16) * BRW + col0;
#pragma unroll
                for (int bj = 0; bj < 2; ++bj) { const f32x4 v0 = acc[ai][bj][m][0] * s[bj][0], v1 = acc[ai][bj][m][1] * s[bj][1];
                    u32x4 w; w.x = cvt_pk_bf16(v0[0], v0[1]); w.y = cvt_pk_bf16(v0[2], v0[3]); w.z = cvt_pk_bf16(v1[0], v1[1]); w.w = cvt_pk_bf16(v1[2], v1[3]);
                    *(u32x4*)(rowp + bj * HALF) = w; } }
        return false;
    }
};
struct EpiAda {
    static constexpr bool PERM = false;
    float* ADA; const float* bada;
    __device__ __forceinline__ bool operator()(f32x4 (&acc)[2][2][4][2], const Unit& u, int wr, int wc, int fr, int fq) const {
        if (wr != 0) return false;
        const int col0 = u.pn * BM + wc * 32 + 4 * fq;
#pragma unroll
        for (int m = 0; m < 3; ++m) { const int row = m * 16 + fr;
            if (row < NROWB) {
#pragma unroll
                for (int bj = 0; bj < 2; ++bj)
#pragma unroll
                    for (int n = 0; n < 2; ++n) { const int c = col0 + bj * HALF + n * 16; const f32x4 bv = *(const f32x4*)(bada + (size_t)u.r * ADAW + c);
                        *(f32x4*)(ADA + ((size_t)u.r * NROWB + row) * ADAW + c) = acc[0][bj][m][n] + bv; } } }
        return false;
    }
};
struct EpiBr {
    static constexpr bool PERM = true;
    const bf16* Z; bf16* MERGED; float* SLAB; int KS;
    static __device__ __forceinline__ void unp8(const u32x4 gw, f32x4& g0, f32x4& g1) { const float T = 8.6736174e-19f;
        g0[0] = fmaxf(__builtin_bit_cast(float, gw.x << 16), T); g0[1] = fmaxf(__builtin_bit_cast(float, gw.x & 0xffff0000u), T); g0[2] = fmaxf(__builtin_bit_cast(float, gw.y << 16), T); g0[3] = fmaxf(__builtin_bit_cast(float, gw.y & 0xffff0000u), T);
        g1[0] = fmaxf(__builtin_bit_cast(float, gw.z << 16), T); g1[1] = fmaxf(__builtin_bit_cast(float, gw.z & 0xffff0000u), T); g1[2] = fmaxf(__builtin_bit_cast(float, gw.w << 16), T); g1[3] = fmaxf(__builtin_bit_cast(float, gw.w & 0xffff0000u), T); }
    __device__ __forceinline__ bool operator()(f32x4 (&acc)[2][2][4][2], const Unit& u, int wr, int wc, int fr, int fq) const {
        const int row0 = u.pm * BM + wr * 64 + fr, col0 = u.pn * BM + wc * 32 + 8 * fq;
        const int r = u.r; const bool smp = u.pm == MP / BM;
        const bf16* gbase = Z + (size_t)row0 * ZW + ZGT + r * DM + col0;
#pragma unroll
        for (int ai = 0; ai < 2; ++ai) {
            u32x4 ga[4][2], gb[4][2];
#pragma unroll
            for (int m = 0; m < 4; ++m)
#pragma unroll
                for (int bj = 0; bj < 2; ++bj) { const bf16* gp = gbase + (size_t)(ai * HALF + m * 16) * ZW + bj * HALF; ga[m][bj] = *(const u32x4*)gp; gb[m][bj] = *(const u32x4*)(gp + DM); }
            asm volatile("" ::: "memory");
#pragma unroll
            for (int m = 0; m < 4; ++m)
#pragma unroll
                for (int bj = 0; bj < 2; ++bj) { const size_t row = (size_t)(row0 + ai * HALF + m * 16); const int c = col0 + bj * HALF;
                    f32x4 g0, g1; unp8(ga[m][bj], g0, g1);
                    if (smp) { float* sp = SLAB + ((size_t)(r * KS + u.ks) * BM + (row - MP)) * DM + c; *(f32x4*)sp = acc[ai][bj][m][0] * g0; *(f32x4*)(sp + 4) = acc[ai][bj][m][1] * g1; }
                    else if (r < 3) { f32x4 n0, n1; unp8(gb[m][bj], n0, n1);
#pragma unroll
                        for (int j = 0; j < 4; ++j) { acc[ai][bj][m][0][j] *= g0[j] * __builtin_amdgcn_rcpf(n0[j]); acc[ai][bj][m][1][j] *= g1[j] * __builtin_amdgcn_rcpf(n1[j]); } }
                    else { const f32x4 v0 = acc[ai][bj][m][0] * g0, v1 = acc[ai][bj][m][1] * g1;
                        u32x4 w; w.x = cvt_pk_bf16(v0[0], v0[1]); w.y = cvt_pk_bf16(v0[2], v0[3]); w.z = cvt_pk_bf16(v1[0], v1[1]); w.w = cvt_pk_bf16(v1[2], v1[3]);
                        *(u32x4*)(MERGED + row * DM + c) = w; } }
        }
        return !smp && r < 3;
    }
};
struct EpiRes {
    static constexpr bool PERM = false;
    const float* baseP; const float* baseS; float* out; const float* gate; float* SLAB;
    __device__ __forceinline__ bool operator()(f32x4 (&acc)[2][2][4][2], const Unit& u, int wr, int wc, int fr, int fq) const {
        const int rl0 = wr * 64 + fr, col0 = u.pn * BM + wc * 32 + 4 * fq;
        const bool smp = u.pm >= MP / BM;
        if (smp) { float* sl = SLAB + ((size_t)u.ks * BM + rl0) * DM + col0;
#pragma unroll
            for (int ai = 0; ai < 2; ++ai)
#pragma unroll
                for (int m = 0; m < 4; ++m)
#pragma unroll
                    for (int bj = 0; bj < 2; ++bj)
#pragma unroll
                        for (int n = 0; n < 2; ++n) *(f32x4*)(sl + (size_t)(ai * HALF + m * 16) * DM + bj * HALF + n * 16) = acc[ai][bj][m][n];
            return false; }
        const float* base = baseP + (size_t)u.pm * BM * DM + (size_t)rl0 * DM + col0;
        float* o = out + (size_t)u.pm * BM * DM + (size_t)rl0 * DM + col0;
        const float* gp = gate + (size_t)(u.pm >> 4) * ADAW + col0;
        f32x4 gv[2][2];
#pragma unroll
        for (int bj = 0; bj < 2; ++bj)
#pragma unroll
            for (int n = 0; n < 2; ++n) gv[bj][n] = *(const f32x4*)(gp + bj * HALF + n * 16);
#pragma unroll
        for (int ai = 0; ai < 2; ++ai) {
            f32x4 bs[4][2][2];
#pragma unroll
            for (int m = 0; m < 4; ++m)
#pragma unroll
                for (int bj = 0; bj < 2; ++bj)
#pragma unroll
                    for (int n = 0; n < 2; ++n) bs[m][bj][n] = *(const f32x4*)(base + (size_t)(ai * HALF + m * 16) * DM + bj * HALF + n * 16);
            asm volatile("" ::: "memory");
#pragma unroll
            for (int m = 0; m < 4; ++m)
#pragma unroll
                for (int bj = 0; bj < 2; ++bj)
#pragma unroll
                    for (int n = 0; n < 2; ++n) *(f32x4*)(o + (size_t)(ai * HALF + m * 16) * DM + bj * HALF + n * 16) = bs[m][bj][n] + gv[bj][n] * acc[ai][bj][m][n];
        }
        return false;
    }
};
}

constexpr int NWAVES = 8, NTHR = NWAVES * 64;
constexpr size_t MiB = 1u << 20;
constexpr size_t al1(size_t x) { return (x + MiB - 1) / MiB * MiB; }
constexpr size_t WS_CTL = 0, CTL_ZERO_BYTES = 1 * MiB;
constexpr size_t WS_WIN = WS_CTL + CTL_ZERO_BYTES;
constexpr size_t WS_WBR = WS_WIN + al1((size_t)DEPTH * ZW * DM * 2);
constexpr size_t WS_WOUT = WS_WBR + al1((size_t)DEPTH * 4 * DM * BRW * 2);
constexpr size_t WS_WM1 = WS_WOUT + al1((size_t)DEPTH * DM * DM * 2);
constexpr size_t WS_WM2 = WS_WM1 + al1((size_t)DEPTH * DFF * DM * 2);
constexpr size_t WS_WPOOL = WS_WM2 + al1((size_t)DEPTH * DFF * DM * 2);
constexpr size_t WS_WADA = WS_WPOOL + al1((size_t)DEPTH * 4 * 256 * 256 * 2);
constexpr size_t WS_SC = WS_WADA + al1((size_t)DEPTH * ADAW * DM * 2);
constexpr size_t WS_ADA = WS_SC + al1((size_t)256 * DM * 2);
constexpr size_t WS_H = WS_ADA + al1((size_t)DEPTH * NROWB * ADAW * 4);
constexpr size_t WS_Z = WS_H + al1((size_t)M * DM * 2);
constexpr size_t WS_Y = WS_Z + al1((size_t)M * ZW * 2);
constexpr size_t WS_ZP = WS_Y + al1((size_t)4 * M * BRW * 2);
constexpr size_t WS_CONVY = WS_ZP + al1((size_t)M * BRW * 2);
constexpr size_t WS_ORAW = WS_CONVY + al1((size_t)M * BRW * 4);
constexpr size_t WS_KV = WS_ORAW + al1((size_t)M * BRW * 4);
constexpr size_t WS_SPREV = WS_KV + al1((size_t)NBP * 32 * RH * RDK * RDV * 4);
constexpr size_t WS_MACC = WS_SPREV + al1((size_t)NBP * 32 * RH * RDK * RDV * 4);
constexpr size_t WS_MERGED = WS_MACC + al1((size_t)M * DM * 4);
constexpr size_t WS_X1 = WS_MERGED + al1((size_t)M * DM * 2);
constexpr size_t WS_X = WS_X1 + al1((size_t)M * DM * 4);
constexpr size_t WS_HID = WS_X + al1((size_t)M * DM * 4);
constexpr size_t WS_SLAB = WS_HID + al1((size_t)M * DFF * 2);
constexpr size_t WS_END = WS_SLAB + al1((size_t)16 * MS * DM * 4);
constexpr int CW_BAR = 4096;
constexpr int RING_OFF = 0, RING_BYTES = 131072, LDSCTL_OFF = RING_BYTES, MISC_OFF = LDSCTL_OFF + 320, INTAB_OFF = MISC_OFF + 128, LDS_BYTES = 147456;

#define GAS __attribute__((address_space(1)))
#define LAS __attribute__((address_space(3)))
typedef unsigned v4u __attribute__((ext_vector_type(4)));
typedef float f32x4 __attribute__((ext_vector_type(4)));
typedef GAS unsigned gu32;
#define RLX_AGENT __ATOMIC_RELAXED, __HIP_MEMORY_SCOPE_AGENT
#define LDS_WAIT() asm volatile("s_waitcnt lgkmcnt(0)" ::: "memory")
__device__ __forceinline__ unsigned pk2(float lo, float hi) { return (unsigned)f2bf(lo) | ((unsigned)f2bf(hi) << 16); }

#define XB_TMO      128
#define XB_XCNT(j)  (256  + 64 * (j))
#define XB_XSUB(j)  (1280 + 64 * (j))
#define XB_XGEN(j)  (2304 + 64 * (j))
#define XB_TOP      3328
#define XB_TOPGEN   3392
#define XCD_BAR_WORDS 3456
#define XB_SPIN_CAP (1u << 18)
__device__ __forceinline__ unsigned xb_ld(unsigned* p)              { return __hip_atomic_load(p, __ATOMIC_RELAXED, __HIP_MEMORY_SCOPE_AGENT); }
__device__ __forceinline__ unsigned xb_add(unsigned* p, unsigned v) { return __hip_atomic_fetch_add(p, v, __ATOMIC_RELAXED, __HIP_MEMORY_SCOPE_AGENT); }
__device__ __forceinline__ unsigned xb_xcc_id() { return (unsigned)__builtin_amdgcn_s_getreg((3 << 11) | 20) & 0xFu; }
#define XB_SPIN(cond, bar) do { unsigned _sp = 0; while (cond) { __builtin_amdgcn_s_sleep(1); \
    if ((++_sp & 255u) == 0u) { if (xb_ld(&(bar)[XB_TMO])) break; if (_sp > XB_SPIN_CAP) { atomicAdd(&(bar)[XB_TMO], 1u); break; } } } } while (0)
struct XcdBarrier { unsigned* bar; unsigned x; volatile LAS unsigned* st; };
__device__ __forceinline__ XcdBarrier xcd_barrier_post(unsigned* bar, volatile LAS unsigned* st) {
    XcdBarrier b; b.bar = bar; b.x = xb_xcc_id(); b.st = st;
    if (threadIdx.x == 0) (void)xb_add(&bar[XB_XCNT(b.x)], 1u);
    return b;
}
__device__ __forceinline__ void xcd_barrier_complete(unsigned* bar, unsigned x, unsigned& nloc, unsigned& nx) {
    const unsigned G = gridDim.x * gridDim.y * gridDim.z;
    unsigned sum, cnt, mine, sp = 0u;
    for (;;) {
        sum = 0u; cnt = 0u; mine = 0u;
#pragma unroll
        for (unsigned j = 0; j < 16; ++j) { const unsigned c = xb_ld(&bar[XB_XCNT(j)]); sum += c; cnt += (c > 0u) ? 1u : 0u; mine = (j == x) ? c : mine; }
        if (sum == G) break;
        __builtin_amdgcn_s_sleep(1);
        if ((++sp & 255u) == 0u) { if (xb_ld(&bar[XB_TMO])) break; if (sp > XB_SPIN_CAP) { atomicAdd(&bar[XB_TMO], 1u); break; } }
    }
    nloc = mine > 0u ? mine : 1u; nx = cnt > 0u ? cnt : 1u;
}
__device__ __forceinline__ void xcd_barrier(const XcdBarrier& b) {
    asm volatile("s_waitcnt vmcnt(0)" ::: "memory");
    __syncthreads();
    if (threadIdx.x == 0) {
        unsigned* bar = b.bar;
        __builtin_amdgcn_s_waitcnt(0);
        unsigned nloc = b.st[0], nx = b.st[1];
        if (nloc == 0u) { xcd_barrier_complete(bar, b.x, nloc, nx); b.st[0] = nloc; b.st[1] = nx; }
        const unsigned old = xb_add(&bar[XB_XSUB(b.x)], 1u);
        const unsigned gen = old / nloc;
        if (old + 1u == (gen + 1u) * nloc) {
            __builtin_amdgcn_fence(__ATOMIC_RELEASE, "agent");
            asm volatile("s_waitcnt vmcnt(0)" ::: "memory");
            const unsigned og = xb_add(&bar[XB_TOP], 1u);
            const unsigned tg = og / nx;
            if (og + 1u == (tg + 1u) * nx) xb_add(&bar[XB_TOPGEN], 1u);
            else XB_SPIN(xb_ld(&bar[XB_TOPGEN]) == tg, bar);
            __builtin_amdgcn_fence(__ATOMIC_ACQUIRE, "agent");
            xb_add(&bar[XB_XGEN(b.x)], 1u);
            asm volatile("s_waitcnt vmcnt(0)" ::: "memory");
        } else {
            XB_SPIN(xb_ld(&bar[XB_XGEN(b.x)]) == gen, bar);
            __builtin_amdgcn_fence(__ATOMIC_ACQUIRE, "agent");
            asm volatile("s_waitcnt vmcnt(0)" ::: "memory");
        }
    }
    __syncthreads();
}

template <int CTRL> __device__ __forceinline__ float dpp_f(float v) { return __builtin_bit_cast(float, __builtin_amdgcn_update_dpp(0, __builtin_bit_cast(int, v), CTRL, 0xf, 0xf, false)); }
__device__ __forceinline__ float wave_sum(float v) {
    v += dpp_f<0xB1>(v);
    v += dpp_f<0x4E>(v);
    v += dpp_f<0x141>(v);
    v += dpp_f<0x140>(v);
    v += __builtin_bit_cast(float, __builtin_amdgcn_ds_swizzle(__builtin_bit_cast(int, v), 0x401F));
    return __builtin_bit_cast(float, __builtin_amdgcn_readlane(__builtin_bit_cast(int, v), 0)) + __builtin_bit_cast(float, __builtin_amdgcn_readlane(__builtin_bit_cast(int, v), 32));
}
typedef float tr_f32x4 __attribute__((ext_vector_type(4)));
#define TR_LOAD(V, P) _Pragma("unroll") for (int j = 0; j < 8; ++j) V[j] = __builtin_nontemporal_load((const GAS tr_f32x4*)((P) + (size_t)j * N))
#define TR_STORE(V, Q) _Pragma("unroll") for (int i = 0; i < 4; ++i) { v4u o; o.x = pk2(V[0][i], V[1][i]); o.y = pk2(V[2][i], V[3][i]); o.z = pk2(V[4][i], V[5][i]); o.w = pk2(V[6][i], V[7][i]); __builtin_nontemporal_store(o, (GAS v4u*)((Q) + (size_t)i * K)); }
template <int K, int N, bool GLUPERM = false>
__device__ __forceinline__ void transpose_run(const float* W, bf16* T, int nmat, int gw, int NGW, int lane) {
    constexpr int NB = N / 32, IPM = (K / 64) * NB; const int total = nmat * IPM;
    const unsigned lo_p = (unsigned)(8 * (lane >> 3)) * N + 4 * (lane & 7), lo_q = (unsigned)(4 * (lane & 7)) * K + 8 * (lane >> 3);
    auto addr = [&](int it, const float*& p, bf16*& q) { it = it < total ? it : total - 1; const int mi = it / IPM, r = it % IPM, kb = r / NB, nb = r % NB;
        p = W + ((size_t)mi * K * N + (size_t)(64 * kb) * N + 32 * nb) + lo_p;
        int n0 = 32 * nb;
        if (GLUPERM) { if (n0 >= ZCA && n0 < ZCA + BRW) { const int c = n0 - ZCA; n0 = ZCA + 256 * (c >> 7) + (c & 127); } else if (n0 >= ZCG && n0 < ZCG + BRW) { const int c = n0 - ZCG; n0 = ZCA + 256 * (c >> 7) + 128 + (c & 127); } }
        q = T + ((size_t)mi * K * N + (size_t)n0 * K + 64 * kb) + lo_q; };
    int it = gw; if (it >= total) return;
    tr_f32x4 va[8], vb[8]; const float *pa, *pb; bf16 *qa, *qb;
    addr(it, pa, qa); TR_LOAD(va, pa);
    for (;;) {
        const int i1 = it + NGW; addr(i1, pb, qb); TR_LOAD(vb, pb);
        asm volatile("" ::: "memory"); TR_STORE(va, qa); asm volatile("" ::: "memory");
        if (i1 >= total) break;
        const int i2 = i1 + NGW; addr(i2, pa, qa); TR_LOAD(va, pa);
        asm volatile("" ::: "memory"); TR_STORE(vb, qb); asm volatile("" ::: "memory");
        if (i2 >= total) break;
        it = i2; }
}
__device__ __forceinline__ void load_mod(const float* g, const float* sc, const float* shp, f32x4 (&gm)[8], f32x4 (&sh)[8], int lane) {
#pragma unroll
    for (int j = 0; j < 8; ++j) { gm[j] = ((const f32x4*)g)[lane + 64 * j] * (((const f32x4*)sc)[lane + 64 * j] + 1.f); sh[j] = ((const f32x4*)shp)[lane + 64 * j]; }
}
__device__ __forceinline__ void norm_store(const f32x4 (&v)[8], float ss, const f32x4 (&gm)[8], const f32x4 (&sh)[8], bf16* orow, int lane) {
    const float rstd = 1.f / sqrtf(wave_sum(ss) * (1.f / DM) + EPS);
#pragma unroll
    for (int j = 0; j < 8; ++j) { const f32x4 y = v[j] * rstd * gm[j] + sh[j];
        ((unsigned long long*)orow)[lane + 64 * j] = (unsigned long long)pk2(y.x, y.y) | ((unsigned long long)pk2(y.z, y.w) << 32); }
}
__device__ __forceinline__ void norm_row2(const float* xa, const float* xb, const f32x4 (&gm)[8], const f32x4 (&sh)[8], bf16* oa, bf16* ob, int lane) {
    f32x4 va[8], vb[8]; float sa = 0.f, sb = 0.f;
#pragma unroll
    for (int j = 0; j < 8; ++j) { va[j] = ((const f32x4*)xa)[lane + 64 * j]; vb[j] = ((const f32x4*)xb)[lane + 64 * j]; }
#pragma unroll
    for (int j = 0; j < 8; ++j) { sa += (va[j].x * va[j].x + va[j].y * va[j].y) + (va[j].z * va[j].z + va[j].w * va[j].w); sb += (vb[j].x * vb[j].x + vb[j].y * vb[j].y) + (vb[j].z * vb[j].z + vb[j].w * vb[j].w); }
    norm_store(va, sa, gm, sh, oa, lane); norm_store(vb, sb, gm, sh, ob, lane);
}
__device__ __forceinline__ void norm_row(const float* xrow, const f32x4 (&gm)[8], const f32x4 (&sh)[8], bf16* orow, int lane) {
    f32x4 v[8]; float ss = 0.f;
#pragma unroll
    for (int j = 0; j < 8; ++j) { v[j] = ((const f32x4*)xrow)[lane + 64 * j]; ss += (v[j].x * v[j].x + v[j].y * v[j].y) + (v[j].z * v[j].z + v[j].w * v[j].w); }
    norm_store(v, ss, gm, sh, orow, lane);
}
template <int NP> __device__ __forceinline__ void norm_row_block(const float* base, const float* gate, const float* slab, size_t ps, float* xdst, const float* g, const float* sc, const float* shp, bf16* orow, LAS float* red, int tid, int wave) {
    f32x4 v = ((const f32x4*)base)[tid];
    if (NP > 0) { f32x4 pv[NP > 0 ? NP : 1];
#pragma unroll
        for (int p = 0; p < NP; ++p) pv[p] = ((const f32x4*)(slab + (size_t)p * ps))[tid];
        f32x4 a = pv[0];
#pragma unroll
        for (int p = 1; p < NP; ++p) a += pv[p];
        v += ((const f32x4*)gate)[tid] * a; ((f32x4*)xdst)[tid] = v; }
    const float ws = wave_sum((v.x * v.x + v.y * v.y) + (v.z * v.z + v.w * v.w));
    if ((tid & 63) == 0) red[wave] = ws;
    __syncthreads();
    float ss = 0.f;
#pragma unroll
    for (int w = 0; w < NWAVES; ++w) ss += red[w];
    const float rstd = 1.f / sqrtf(ss * (1.f / DM) + EPS);
    const f32x4 y = v * rstd * ((const f32x4*)g)[tid] * (((const f32x4*)sc)[tid] + 1.f) + ((const f32x4*)shp)[tid];
    ((unsigned long long*)orow)[tid] = (unsigned long long)pk2(y.x, y.y) | ((unsigned long long)pk2(y.z, y.w) << 32);
    __syncthreads();
}
__device__ __forceinline__ void convln_row(const float* yrow, const f32x4 (&gv4)[4], const f32x4 (&bv4)[4], bf16* orow, int lane) {
    f32x4 v[4]; float s = 0.f;
#pragma unroll
    for (int j = 0; j < 4; ++j) { v[j] = ((const f32x4*)yrow)[lane + 64 * j]; s += (v[j].x + v[j].y) + (v[j].z + v[j].w); }
    const float mean = wave_sum(s) * (1.f / BRW); float q = 0.f;
#pragma unroll
    for (int j = 0; j < 4; ++j) { v[j] = v[j] - mean; q += (v[j].x * v[j].x + v[j].y * v[j].y) + (v[j].z * v[j].z + v[j].w * v[j].w); }
    const float rstd = 1.f / sqrtf(wave_sum(q) * (1.f / BRW) + EPS);
#pragma unroll
    for (int j = 0; j < 4; ++j) { f32x4 y = v[j] * rstd * gv4[j] + bv4[j];
        y.x = y.x * sigmoidf_(y.x); y.y = y.y * sigmoidf_(y.y); y.z = y.z * sigmoidf_(y.z); y.w = y.w * sigmoidf_(y.w);
        ((unsigned long long*)orow)[lane + 64 * j] = (unsigned long long)pk2(y.x, y.y) | ((unsigned long long)pk2(y.z, y.w) << 32); }
}


namespace att {
typedef short bf16x8 __attribute__((ext_vector_type(8)));
typedef short s16x4 __attribute__((ext_vector_type(4)));
typedef float f32x4 __attribute__((ext_vector_type(4)));
typedef float f32x2_t __attribute__((ext_vector_type(2))); typedef __bf16 bf16x2_t __attribute__((ext_vector_type(2)));
constexpr int KP = 144, NROWS = 272, K_OFF = 0, V_OFF = NROWS * KP, LDS_NEED = 2 * NROWS * KP;
__device__ __forceinline__ unsigned cvtpk(float lo, float hi) { f32x2_t v = {lo, hi}; bf16x2_t b = __builtin_convertvector(v, bf16x2_t); return __builtin_bit_cast(unsigned, b); }
__device__ __forceinline__ float red4_max(float v) {
    v = fmaxf(v, __builtin_bit_cast(float, __builtin_amdgcn_ds_swizzle(__builtin_bit_cast(int, v), 0x401F)));
    unsigned x = __builtin_bit_cast(unsigned, v), y = x; asm volatile("" : "+v"(y));
    auto rr = __builtin_amdgcn_permlane32_swap(x, y, false, false); const unsigned r0 = rr[0], r1 = rr[1];
    return fmaxf(__builtin_bit_cast(float, r0), __builtin_bit_cast(float, r1)); }
__device__ __forceinline__ float red4_sum(float v) {
    v += __builtin_bit_cast(float, __builtin_amdgcn_ds_swizzle(__builtin_bit_cast(int, v), 0x401F));
    unsigned x = __builtin_bit_cast(unsigned, v), y = x; asm volatile("" : "+v"(y));
    auto rr = __builtin_amdgcn_permlane32_swap(x, y, false, false); const unsigned r0 = rr[0], r1 = rr[1];
    return __builtin_bit_cast(float, r0) + __builtin_bit_cast(float, r1); }
__device__ __forceinline__ s16x4 vtr(const LAS unsigned char* p) { typedef short v4i16_t __attribute__((ext_vector_type(4))); return __builtin_bit_cast(s16x4, __builtin_amdgcn_ds_read_tr16_b64_v4i16((LAS v4i16_t*)p)); }

__device__ __forceinline__ void tile16(const bf16x8 qf0, const bf16x8 qf1, const LAS unsigned char* Ks, const LAS unsigned char* Vs, int kbase, int wpos0, float slope2, float sink2, bf16* Yq, int nst, int lane) {
    const int c = lane & 15, g = lane >> 4;
    f32x4 st[9];
#pragma unroll
    for (int kt = 0; kt < 9; ++kt) { const LAS unsigned char* kp = Ks + (kbase + 16 * kt + c) * KP + 16 * g;
        const bf16x8 k0 = *(const LAS bf16x8*)kp, k1 = *(const LAS bf16x8*)(kp + 64);
        f32x4 a = {0.f, 0.f, 0.f, 0.f};
        a = __builtin_amdgcn_mfma_f32_16x16x32_bf16(k0, qf0, a, 0, 0, 0); a = __builtin_amdgcn_mfma_f32_16x16x32_bf16(k1, qf1, a, 0, 0, 0); st[kt] = a; }
    float SC2 = 0.125f * 1.4426950408889634f; asm volatile("" : "+v"(SC2));
    const int dbase = 128 + c - 4 * g;
    float m = sink2;
#pragma unroll
    for (int kt = 0; kt < 9; ++kt)
#pragma unroll
        for (int r = 0; r < 4; ++r) { const int dist = dbase - r - 16 * kt, kk = 16 * kt + 4 * g + r; const bool ok = (unsigned)dist <= 128u && (wpos0 + kk) >= 0;
            const float sv = ok ? st[kt][r] * SC2 - slope2 * (float)dist : -INFINITY; st[kt][r] = sv; m = fmaxf(m, sv); }
    m = red4_max(m);
    float sum = 0.f;
#pragma unroll
    for (int kt = 0; kt < 9; ++kt)
#pragma unroll
        for (int r = 0; r < 4; ++r) { const float p = __builtin_amdgcn_exp2f(st[kt][r] - m); st[kt][r] = p; sum += p; }
    sum = red4_sum(sum) + __builtin_amdgcn_exp2f(sink2 - m);
    const float inv = 1.f / sum;
    bf16x8 pf[5];
#pragma unroll
    for (int k = 0; k < 5; ++k) { unsigned w0 = cvtpk(st[2 * k][0] * inv, st[2 * k][1] * inv), w1 = cvtpk(st[2 * k][2] * inv, st[2 * k][3] * inv), w2 = 0u, w3 = 0u;
        if (k < 4) { w2 = cvtpk(st[2 * k + 1][0] * inv, st[2 * k + 1][1] * inv); w3 = cvtpk(st[2 * k + 1][2] * inv, st[2 * k + 1][3] * inv); }
        typedef unsigned u32x4_t __attribute__((ext_vector_type(4))); const u32x4_t w = {w0, w1, w2, w3}; pf[k] = __builtin_bit_cast(bf16x8, w); }
    f32x4 o[4];
#pragma unroll
    for (int dt = 0; dt < 4; ++dt) o[dt] = (f32x4){0.f, 0.f, 0.f, 0.f};
    const LAS unsigned char* vb = Vs + (kbase + 4 * g + (c >> 2)) * KP + 8 * (c & 3);
#pragma unroll
    for (int k = 0; k < 5; ++k)
#pragma unroll
        for (int dt = 0; dt < 4; ++dt) { const s16x4 lo = vtr(vb + (32 * k) * KP + 32 * dt), hi = vtr(vb + (32 * k + 16) * KP + 32 * dt);
            const bf16x8 b = {lo[0], lo[1], lo[2], lo[3], hi[0], hi[1], hi[2], hi[3]};
            o[dt] = __builtin_amdgcn_mfma_f32_16x16x32_bf16(pf[k], b, o[dt], 0, 0, 0); }
#pragma unroll
    for (int r = 0; r < 4; ++r) if (4 * g + r < nst) {
#pragma unroll
        for (int dt = 0; dt < 4; ++dt) Yq[(size_t)(4 * g + r) * BRW + 16 * dt + c] = f2bf(o[dt][r]); }
}
typedef unsigned u32x4_t __attribute__((ext_vector_type(4)));
__device__ __forceinline__ u32x4_t pack8(const float* f) { u32x4_t w; w.x = cvtpk(f[0], f[1]); w.y = cvtpk(f[2], f[3]); w.z = cvtpk(f[4], f[5]); w.w = cvtpk(f[6], f[7]); return w; }
__device__ __forceinline__ void phase(LAS unsigned char* lds, const bf16* Z, int l, const float* sinks, const float* ck, const float* cv, bf16* Y0, int bx, int G, int tid, int lane, int wave) {
    LAS unsigned char* Ks = lds + K_OFF; LAS unsigned char* Vs = lds + V_OFF;
    const u32x4_t zero4 = {0u, 0u, 0u, 0u};
    for (int it = bx; it < NBP * 32 * NKV + SB * NKV; it += G) {
        const int kvh = it & 3;
        if (it < NBP * 32 * NKV) {
            const int b = it >> 7, qb = (it >> 2) & 31;
#pragma unroll
            for (int i = 0; i < 4; ++i) { const int p = tid + NTHR * i, sr = p >> 3, cc = p & 7; const int pos = 128 * (qb - 1) + sr;
                u32x4_t kq = zero4, vq = zero4;
                if (pos >= 0) { const bf16* zr = Z + (size_t)(b * SEQ + pos) * ZW + kvh * 64 + cc * 8; kq = *(const u32x4_t*)(zr + ZK); vq = *(const u32x4_t*)(zr + ZV); }
                *(LAS u32x4_t*)(Ks + sr * KP + cc * 16) = kq; *(LAS u32x4_t*)(Vs + sr * KP + cc * 16) = vq; }
            if (tid < 128) { const int sr = 256 + (tid >> 3), cc = tid & 7; *(LAS u32x4_t*)(Ks + sr * KP + cc * 16) = zero4; *(LAS u32x4_t*)(Vs + sr * KP + cc * 16) = zero4; }
            __syncthreads();
            const int hq = kvh * 4 + (wave >> 1), qh = wave & 1;
            const float slope2 = exp2f(-0.5f * (float)(hq + 1)) * 1.4426950408889634f, sink2 = sinks[l * NH + hq] * 1.4426950408889634f;
            const bf16* qp0 = Z + ((size_t)b * SEQ + 128 * qb + 64 * qh + (lane & 15)) * ZW + ZQ + hq * 64 + 8 * (lane >> 4);
            bf16x8 qc0 = *(const bf16x8*)qp0, qc1 = *(const bf16x8*)(qp0 + 32);
#pragma unroll 1
            for (int qt = 0; qt < 4; ++qt) { const int t1 = 64 * qh + 16 * qt; const size_t qrow0 = (size_t)b * SEQ + 128 * qb + t1;
                const bf16* qpn = qp0 + (size_t)(16 * (qt < 3 ? qt + 1 : 3)) * ZW; const bf16x8 qn0 = *(const bf16x8*)qpn, qn1 = *(const bf16x8*)(qpn + 32);
                tile16(qc0, qc1, Ks, Vs, t1, 128 * qb + t1 - 128, slope2, sink2, Y0 + qrow0 * BRW + hq * 64, 16, lane);
                qc0 = qn0; qc1 = qn1; }
        } else {
            const int sb = (it - NBP * 32 * NKV) >> 2;
#pragma unroll
            for (int i = 0; i < 3; ++i) { const int p = tid + NTHR * i, sr = p >> 3, cc = p & 7;
                if (sr < 160) { u32x4_t kq = zero4, vq = zero4;
                    if (sr < WIN) { const size_t o = ((((size_t)l * SB + sb) * WIN + sr) * NKV + kvh) * 64 + cc * 8; float f[8];
#pragma unroll
                        for (int e = 0; e < 8; ++e) f[e] = ck[o + e];
                        kq = pack8(f);
#pragma unroll
                        for (int e = 0; e < 8; ++e) f[e] = cv[o + e];
                        vq = pack8(f);
                    } else if (sr < WIN + ST) { const bf16* zr = Z + (size_t)(MP + sb * ST + (sr - WIN)) * ZW + kvh * 64 + cc * 8; kq = *(const u32x4_t*)(zr + ZK); vq = *(const u32x4_t*)(zr + ZV); }
                    *(LAS u32x4_t*)(Ks + sr * KP + cc * 16) = kq; *(LAS u32x4_t*)(Vs + sr * KP + cc * 16) = vq; } }
            __syncthreads();
            if (wave < 4) { const int hq = kvh * 4 + wave;
                const float slope2 = exp2f(-0.5f * (float)(hq + 1)) * 1.4426950408889634f, sink2 = sinks[l * NH + hq] * 1.4426950408889634f;
                const size_t qrow0 = (size_t)MP + sb * ST; const bf16* qp = Z + (qrow0 + (lane & 7)) * ZW + ZQ + hq * 64 + 8 * (lane >> 4);
                tile16(*(const bf16x8*)qp, *(const bf16x8*)(qp + 32), Ks, Vs, 0, 0, slope2, sink2, Y0 + qrow0 * BRW + hq * 64, ST, lane); }
        }
        __syncthreads();
    }
}
}

namespace adad {
using att::bf16x8; using att::f32x4; using att::cvtpk;
constexpr int NSTRIP = ADAW / 64, RW = 576, A2_OFF = 8 * RW * 16, A2_WAVE = 3 * 512;
#define ADA_LOAD(V, S) _Pragma("unroll") for (int j = 0; j < 8; ++j) V[j] = __builtin_nontemporal_load((const GAS f32x4*)(wp + (size_t)(32 * (S) + j) * ADAW))
__device__ __forceinline__ v4u silu8(f32x4 x0, f32x4 x1) { v4u o;
    o.x = cvtpk(x0.x * sigmoidf_(x0.x), x0.y * sigmoidf_(x0.y)); o.y = cvtpk(x0.z * sigmoidf_(x0.z), x0.w * sigmoidf_(x0.w));
    o.z = cvtpk(x1.x * sigmoidf_(x1.x), x1.y * sigmoidf_(x1.y)); o.w = cvtpk(x1.z * sigmoidf_(x1.z), x1.w * sigmoidf_(x1.w)); return o; }
__device__ __forceinline__ const GAS float* crow(const float* cp, const float* cs, int row) { return row < NBP ? (const GAS float*)cp + (size_t)row * DM : (const GAS float*)cs + (size_t)(row - NBP) * DM; }
__device__ __forceinline__ void phase(const float* cp, const float* cs, const float* wada, const float* bada, float* ADA, LAS unsigned char* lds, int bx, int G, int wave, int lane, int tid) {
    const int kl = 256 * wave + 8 * (lane >> 4);
    bf16x8 af[2][8];
#pragma unroll
    for (int mb = 0; mb < 2; ++mb) { const GAS float* src = crow(cp, cs, 16 * mb + (lane & 15)) + kl;
#pragma unroll
        for (int s = 0; s < 8; ++s) af[mb][s] = __builtin_bit_cast(bf16x8, silu8(*(const GAS f32x4*)(src + 32 * s), *(const GAS f32x4*)(src + 32 * s + 4))); }
    LAS unsigned char* a2 = lds + A2_OFF + wave * A2_WAVE;
    {   const GAS float* src = crow(cp, cs, 32 + (lane >> 5)) + 256 * wave + 8 * (lane & 31);
        *(LAS v4u*)(a2 + (lane >> 5) * 512 + (lane & 31) * 16) = silu8(*(const GAS f32x4*)src, *(const GAS f32x4*)(src + 4));
        if (lane < 32) { v4u z = {0u, 0u, 0u, 0u}; *(LAS v4u*)(a2 + 2 * 512 + lane * 16) = z; }
        LDS_WAIT(); asm volatile("" ::: "memory"); }
    const LAS unsigned char* a2r = a2 + ((lane & 15) < 2 ? (lane & 15) : 2) * 512 + (lane >> 4) * 16;
    LAS f32x4* red = (LAS f32x4*)lds;
    for (int g = bx; g < DEPTH * NSTRIP; g += G) { const int l = g / NSTRIP, n0 = 64 * (g % NSTRIP);
        const GAS float* wp = (const GAS float*)wada + (size_t)l * DM * ADAW + (size_t)kl * ADAW + n0 + 4 * (lane & 15);
        f32x4 acc[3][4];
#pragma unroll
        for (int mb = 0; mb < 3; ++mb)
#pragma unroll
            for (int i = 0; i < 4; ++i) acc[mb][i] = f32x4{0.f, 0.f, 0.f, 0.f};
        f32x4 v0[8], v1[8];
        ADA_LOAD(v0, 0);
#pragma unroll
        for (int s = 0; s < 8; ++s) {
            if (s < 7) { if (s & 1) { ADA_LOAD(v0, s + 1); } else { ADA_LOAD(v1, s + 1); } }
            asm volatile("" ::: "memory");
            const bf16x8 a2f = *(const LAS bf16x8*)(a2r + 64 * s);
#pragma unroll
            for (int i = 0; i < 4; ++i) { v4u w;
                if (s & 1) { w.x = cvtpk(v1[0][i], v1[1][i]); w.y = cvtpk(v1[2][i], v1[3][i]); w.z = cvtpk(v1[4][i], v1[5][i]); w.w = cvtpk(v1[6][i], v1[7][i]); }
                else       { w.x = cvtpk(v0[0][i], v0[1][i]); w.y = cvtpk(v0[2][i], v0[3][i]); w.z = cvtpk(v0[4][i], v0[5][i]); w.w = cvtpk(v0[6][i], v0[7][i]); }
                const bf16x8 bfr = __builtin_bit_cast(bf16x8, w);
                acc[0][i] = __builtin_amdgcn_mfma_f32_16x16x32_bf16(af[0][s], bfr, acc[0][i], 0, 0, 0);
                acc[1][i] = __builtin_amdgcn_mfma_f32_16x16x32_bf16(af[1][s], bfr, acc[1][i], 0, 0, 0);
                acc[2][i] = __builtin_amdgcn_mfma_f32_16x16x32_bf16(a2f, bfr, acc[2][i], 0, 0, 0); }
            asm volatile("" ::: "memory"); }
        LAS f32x4* rw = red + wave * RW;
#pragma unroll
        for (int mb = 0; mb < 2; ++mb)
#pragma unroll
            for (int i = 0; i < 4; ++i) rw[(mb * 4 + i) * 64 + lane] = acc[mb][i];
        if (lane < 16) {
#pragma unroll
            for (int i = 0; i < 4; ++i) rw[512 + i * 16 + lane] = acc[2][i]; }
        __syncthreads();
        for (int e = tid; e < RW; e += NTHR) { f32x4 t = red[e];
#pragma unroll
            for (int w = 1; w < 8; ++w) t += red[w * RW + e];
            int row0, col;
            if (e < 512) { const int mbi = e >> 6, ln = e & 63; row0 = 16 * (mbi >> 2) + 4 * (ln >> 4); col = n0 + 4 * (ln & 15) + (mbi & 3); }
            else { const int q = e - 512; row0 = 32; col = n0 + 4 * (q & 15) + (q >> 4); }
            const float bv = *((const GAS float*)bada + (size_t)l * ADAW + col);
            GAS float* o = (GAS float*)ADA + ((size_t)l * NROWB + row0) * ADAW + col;
            o[0] = t.x + bv; o[ADAW] = t.y + bv;
            if (row0 < 32) { o[2 * (size_t)ADAW] = t.z + bv; o[3 * (size_t)ADAW] = t.w + bv; } }
        __syncthreads(); }
}
}

namespace ret {
using att::bf16x8; using att::s16x4; using att::f32x4; using att::u32x4_t; using att::vtr; using att::cvtpk; using att::pack8;
constexpr int KP = 144, VP = 288, K_OFF = 0, V_OFF = 128 * KP, S_OFF = V_OFF + 128 * VP, LDS_NEED = S_OFF + 64 * VP;
template <int CTRL> __device__ __forceinline__ float dppf(float v) { return __builtin_bit_cast(float, __builtin_amdgcn_update_dpp(0, __builtin_bit_cast(int, v), CTRL, 0xf, 0xf, false)); }
__device__ __forceinline__ float sum16(float v) { v += dppf<0xB1>(v); v += dppf<0x4E>(v); v += dppf<0x141>(v); v += dppf<0x140>(v); return v; }
__device__ __forceinline__ void out_phase(LAS unsigned char* lds, const bf16* Z, int l, const float* SPREV, const float* gret, bf16* Y3, int bx, int G, int tid, int lane, int wave) {
    LAS unsigned char* Ks = lds + K_OFF; LAS unsigned char* Vs = lds + V_OFF; LAS unsigned char* Ss = lds + S_OFF;
    const int c = lane & 15, g = lane >> 4;
    for (int it = bx; it < NBP * 32 * RH; it += G) {
        const int b = it >> 8, n = (it >> 3) & 31, h = it & 7; const size_t row0 = (size_t)b * SEQ + n * 128;
#pragma unroll
        for (int i = 0; i < 2; ++i) { const int p = tid + NTHR * i, j = p >> 3, cc = p & 7; *(LAS u32x4_t*)(Ks + j * KP + cc * 16) = *(const u32x4_t*)(Z + (row0 + j) * ZW + ZRK + h * 64 + cc * 8); }
#pragma unroll
        for (int i = 0; i < 4; ++i) { const int p = tid + NTHR * i, j = p >> 4, cc = p & 15; *(LAS u32x4_t*)(Vs + j * VP + cc * 16) = *(const u32x4_t*)(Z + (row0 + j) * ZW + ZRV + h * 128 + cc * 8); }
#pragma unroll
        for (int i = 0; i < 2; ++i) { const int p = tid + NTHR * i, d = p >> 4, cc = p & 15; const float* sp = SPREV + ((((size_t)b * 32 + n) * RH + h) * RDK + d) * RDV + cc * 8; float f[8];
#pragma unroll
            for (int e = 0; e < 8; ++e) f[e] = sp[e];
            *(LAS u32x4_t*)(Ss + d * VP + cc * 16) = pack8(f); }
        __syncthreads();
        const int w = wave; const float lg2 = ret_logg(h) * 1.4426950408889634f;
        const bf16* qp = Z + (row0 + 16 * w + c) * ZW + ZRQ + h * 64 + 8 * g;
        const bf16x8 qf0 = *(const bf16x8*)qp, qf1 = *(const bf16x8*)(qp + 32);
        f32x4 o[8];
#pragma unroll
        for (int vt = 0; vt < 8; ++vt) o[vt] = (f32x4){0.f, 0.f, 0.f, 0.f};
#pragma unroll
        for (int ks = 0; ks < 2; ++ks) { const LAS unsigned char* sb = Ss + (32 * ks + 8 * g + (c >> 2)) * VP + 8 * (c & 3);
#pragma unroll
            for (int vt = 0; vt < 8; ++vt) { const s16x4 lo = vtr(sb + 32 * vt), hi = vtr(sb + 4 * VP + 32 * vt); const bf16x8 bb = {lo[0], lo[1], lo[2], lo[3], hi[0], hi[1], hi[2], hi[3]};
                o[vt] = __builtin_amdgcn_mfma_f32_16x16x32_bf16(ks ? qf1 : qf0, bb, o[vt], 0, 0, 0); } }
#pragma unroll
        for (int r = 0; r < 4; ++r) { const float cf = __builtin_amdgcn_exp2f(lg2 * (float)(16 * w + 4 * g + r + 1));
#pragma unroll
            for (int vt = 0; vt < 8; ++vt) o[vt][r] *= cf; }
        for (int ks = 0; ks <= (w >> 1); ++ks) {
            f32x4 st[2];
#pragma unroll
            for (int t = 0; t < 2; ++t) { const int jt = 2 * ks + t; f32x4 a = {0.f, 0.f, 0.f, 0.f};
                if (jt <= w) { const LAS unsigned char* kp = Ks + (16 * jt + c) * KP + 16 * g; const bf16x8 k0 = *(const LAS bf16x8*)kp, k1 = *(const LAS bf16x8*)(kp + 64);
                    a = __builtin_amdgcn_mfma_f32_16x16x32_bf16(k0, qf0, a, 0, 0, 0); a = __builtin_amdgcn_mfma_f32_16x16x32_bf16(k1, qf1, a, 0, 0, 0);
#pragma unroll
                    for (int r = 0; r < 4; ++r) { const int dij = (16 * w + c) - (16 * jt + 4 * g + r); a[r] = dij >= 0 ? a[r] * 0.125f * __builtin_amdgcn_exp2f(lg2 * (float)dij) : 0.f; } }
                st[t] = a; }
            const u32x4_t pw = {cvtpk(st[0][0], st[0][1]), cvtpk(st[0][2], st[0][3]), cvtpk(st[1][0], st[1][1]), cvtpk(st[1][2], st[1][3])}; const bf16x8 pf = __builtin_bit_cast(bf16x8, pw);
            const LAS unsigned char* vb = Vs + (32 * ks + 4 * g + (c >> 2)) * VP + 8 * (c & 3);
#pragma unroll
            for (int vt = 0; vt < 8; ++vt) { const s16x4 lo = vtr(vb + 32 * vt), hi = vtr(vb + 16 * VP + 32 * vt); const bf16x8 bb = {lo[0], lo[1], lo[2], lo[3], hi[0], hi[1], hi[2], hi[3]};
                o[vt] = __builtin_amdgcn_mfma_f32_16x16x32_bf16(pf, bb, o[vt], 0, 0, 0); }
        }
        float mean[4], rstd[4];
#pragma unroll
        for (int r = 0; r < 4; ++r) { float sm = 0.f;
#pragma unroll
            for (int vt = 0; vt < 8; ++vt) sm += o[vt][r];
            mean[r] = sum16(sm) * (1.f / 128.f); float q = 0.f;
#pragma unroll
            for (int vt = 0; vt < 8; ++vt) { const float dd = o[vt][r] - mean[r]; q += dd * dd; }
            rstd[r] = 1.f / sqrtf(sum16(q) * (1.f / 128.f) + EPS); }
        const float* gp = gret + l * BRW + h * 128 + c;
        float gv[8]; bf16 rgv[4][8];
#pragma unroll
        for (int vt = 0; vt < 8; ++vt) gv[vt] = gp[16 * vt];
#pragma unroll
        for (int r = 0; r < 4; ++r) { const bf16* rg = Z + (row0 + 16 * w + 4 * g + r) * ZW + ZRG + h * 128 + c;
#pragma unroll
            for (int vt = 0; vt < 8; ++vt) rgv[r][vt] = rg[16 * vt]; }
        asm volatile("" ::: "memory");
#pragma unroll
        for (int r = 0; r < 4; ++r) { bf16* y = Y3 + (row0 + 16 * w + 4 * g + r) * BRW + h * 128 + c;
#pragma unroll
            for (int vt = 0; vt < 8; ++vt) y[16 * vt] = f2bf((o[vt][r] - mean[r]) * rstd[r] * gv[vt] * bf2f(rgv[r][vt])); }
        __syncthreads();
    }
}

__device__ __forceinline__ void kv_phase(LAS unsigned char* lds, const bf16* Z, float* KV, int bx, int G, int tid, int lane, int wave) {
    LAS unsigned char* Ks = lds + K_OFF; LAS unsigned char* Vs = lds + V_OFF;
    const int c = lane & 15, g = lane >> 4;
    for (int it = bx; it < NBP * 32 * RH; it += G) {
        const int b = it >> 8, n = (it >> 3) & 31, h = it & 7; const size_t row0 = (size_t)b * SEQ + n * 128;
        const float lg2 = ret_logg(h) * 1.4426950408889634f;
#pragma unroll
        for (int i = 0; i < 2; ++i) { const int p = tid + NTHR * i, j = p >> 3, cc = p & 7; float f[8]; ld8(Z + (row0 + j) * ZW + ZRK + h * 64 + cc * 8, f);
            const float sc = 0.125f * __builtin_amdgcn_exp2f(lg2 * (float)(127 - j));
#pragma unroll
            for (int e = 0; e < 8; ++e) f[e] *= sc;
            *(LAS u32x4_t*)(Ks + j * KP + cc * 16) = pack8(f); }
#pragma unroll
        for (int i = 0; i < 4; ++i) { const int p = tid + NTHR * i, j = p >> 4, cc = p & 15; *(LAS u32x4_t*)(Vs + j * VP + cc * 16) = *(const u32x4_t*)(Z + (row0 + j) * ZW + ZRV + h * 128 + cc * 8); }
        __syncthreads();
        const int dt = wave & 3, vt0 = (wave >> 2) * 4;
        f32x4 acc[4];
#pragma unroll
        for (int t = 0; t < 4; ++t) acc[t] = (f32x4){0.f, 0.f, 0.f, 0.f};
#pragma unroll
        for (int ks = 0; ks < 4; ++ks) { const LAS unsigned char* ka = Ks + (32 * ks + 8 * g + (c >> 2)) * KP + 32 * dt + 8 * (c & 3);
            const s16x4 alo = vtr(ka), ahi = vtr(ka + 4 * KP); const bf16x8 af = {alo[0], alo[1], alo[2], alo[3], ahi[0], ahi[1], ahi[2], ahi[3]};
            const LAS unsigned char* vb = Vs + (32 * ks + 8 * g + (c >> 2)) * VP + 8 * (c & 3);
#pragma unroll
            for (int t = 0; t < 4; ++t) { const s16x4 lo = vtr(vb + 32 * (vt0 + t)), hi = vtr(vb + 4 * VP + 32 * (vt0 + t)); const bf16x8 bb = {lo[0], lo[1], lo[2], lo[3], hi[0], hi[1], hi[2], hi[3]};
                acc[t] = __builtin_amdgcn_mfma_f32_16x16x32_bf16(af, bb, acc[t], 0, 0, 0); } }
        float* kvp = KV + ((((size_t)b * 32 + n) * RH + h) * RDK + 16 * dt + 4 * g) * RDV + c;
#pragma unroll
        for (int r = 0; r < 4; ++r)
#pragma unroll
            for (int t = 0; t < 4; ++t) kvp[(size_t)r * RDV + 16 * (vt0 + t)] = acc[t][r];
        __syncthreads();
    }
}
}

namespace mixl {
using att::u32x4_t; using att::f32x4; using att::f32x2_t;
template <int CTRL> __device__ __forceinline__ float dppf(float v) { return __builtin_bit_cast(float, __builtin_amdgcn_update_dpp(0, __builtin_bit_cast(int, v), CTRL, 0xf, 0xf, false)); }
__device__ __forceinline__ float sum8(float v) { v += dppf<0xB1>(v); v += dppf<0x4E>(v); v += dppf<0x141>(v); return v; }
struct QkRow { float q0[8], q1[8], kv[8]; };
__device__ __forceinline__ void qk_load(const bf16* zr, QkRow& R, int lane) { ld8(zr + ZQ + lane * 8, R.q0); ld8(zr + ZQ + 512 + lane * 8, R.q1); ld8(zr + ZK + lane * 8, R.kv); }
__device__ __forceinline__ void qk_finish(bf16* zr, int row, int l, QkRow& R, const float (&g8q)[8], const float (&g8k)[8], float* out, int lane) {
    float s0 = 0.f, s1 = 0.f, s2 = 0.f;
#pragma unroll
    for (int e = 0; e < 8; ++e) { s0 += R.q0[e] * R.q0[e]; s1 += R.q1[e] * R.q1[e]; s2 += R.kv[e] * R.kv[e]; }
    const float r0 = 1.f / sqrtf(sum8(s0) * (1.f / 64.f) + EPS), r1 = 1.f / sqrtf(sum8(s1) * (1.f / 64.f) + EPS), r2 = 1.f / sqrtf(sum8(s2) * (1.f / 64.f) + EPS);
#pragma unroll
    for (int e = 0; e < 8; ++e) { R.q0[e] *= r0 * g8q[e]; R.q1[e] *= r1 * g8q[e]; if (lane < 32) R.kv[e] *= r2 * g8k[e]; }
    st8(zr + ZQ + lane * 8, R.q0); st8(zr + ZQ + 512 + lane * 8, R.q1);
    if (lane < 32) st8(zr + ZK + lane * 8, R.kv);
    float* o = nullptr;
    if (row < MP) { const int b = row >> 12, t = row & (SEQ - 1); if (t >= SEQ - WIN) o = out + (lane < 32 ? O_KP : O_VP) + (((size_t)l * NBP + b) * WIN + (t - (SEQ - WIN))) * 256 + (lane & 31) * 8; }
    else { const int sb = (row - MP) >> 3, t = (row - MP) & 7; o = out + (lane < 32 ? O_KS : O_VS) + (((size_t)l * SB + sb) * WIN + (WIN - ST + t)) * 256 + (lane & 31) * 8; }
    if (o) { *(f32x4*)o = (f32x4){R.kv[0], R.kv[1], R.kv[2], R.kv[3]}; *(f32x4*)(o + 4) = (f32x4){R.kv[4], R.kv[5], R.kv[6], R.kv[7]}; }
}
__device__ __forceinline__ void qknorm_phase(bf16* Z, int l, const float* gq, const float* gk, float* out, int gw, int NGW, int lane) {
    float g8q[8], g8k[8];
#pragma unroll
    for (int e = 0; e < 8; ++e) { g8q[e] = gq[l * 64 + (lane & 7) * 8 + e]; g8k[e] = gk[l * 64 + (lane & 7) * 8 + e]; }
    for (int row = gw; row < M; row += 2 * NGW) { const int rowb = row + NGW; const bool two = rowb < M;
        bf16* za = Z + (size_t)row * ZW; bf16* zb = Z + (size_t)(two ? rowb : row) * ZW;
        QkRow A, B; qk_load(za, A, lane); qk_load(zb, B, lane);
        asm volatile("" ::: "memory");
        qk_finish(za, row, l, A, g8q, g8k, out, lane);
        if (two) qk_finish(zb, rowb, l, B, g8q, g8k, out, lane);
    }
}
constexpr int CV_RB = 64, CV_CB = 128, CV_UR = CV_RB + CPRE, CV_NPI = (MP / CV_RB) * 8, CV_NSI = SB * 8;
struct CvItem { bool smp; int cb, b, t0, nrows; size_t rowb; };
__device__ __forceinline__ CvItem cv_item(int it) { CvItem I; I.smp = it >= CV_NPI; I.cb = it & 7; I.b = I.smp ? (it - CV_NPI) >> 3 : (it >> 3) >> 6; I.t0 = I.smp ? 0 : ((it >> 3) & 63) * CV_RB; I.nrows = I.smp ? ST : CV_RB;
    I.rowb = I.smp ? (size_t)MP + I.b * ST : (size_t)I.b * SEQ; return I; }
__device__ __forceinline__ void cv_fetch(const bf16* Z, int l, const float* sconv, const CvItem& I, u32x4_t (&raw)[3][2], int tid) {
#pragma unroll
    for (int i = 0; i < 3; ++i) { const int p = tid + NTHR * i, ur = p >> 4, c8 = p & 15, tt = I.t0 - CPRE + ur; raw[i][0] = (u32x4_t){0u, 0u, 0u, 0u}; raw[i][1] = raw[i][0];
        if (ur < I.nrows + CPRE) {
            if (tt >= 0) { const bf16* zp = Z + (I.rowb + tt) * ZW + I.cb * CV_CB + c8 * 8; raw[i][0] = *(const u32x4_t*)(zp + ZCA); }
            else if (I.smp) { const float* sp = sconv + (((size_t)l * SB + I.b) * CPRE + (CPRE + tt)) * BRW + I.cb * CV_CB + c8 * 8; raw[i][0] = *(const u32x4_t*)sp; raw[i][1] = *(const u32x4_t*)(sp + 4); } } }
}
__device__ __forceinline__ void conv_phase(LAS unsigned char* lds, const bf16* Z, int l, const float* wdw, const float* bdw, const float* sconv, float* CONVY, float* out, int bx, int G, int tid) {
    LAS float* U = (LAS float*)lds;
    auto unp = [](const u32x4_t w, float* f) { f[0] = __builtin_bit_cast(float, w.x << 16); f[1] = __builtin_bit_cast(float, w.x & 0xffff0000u); f[2] = __builtin_bit_cast(float, w.y << 16); f[3] = __builtin_bit_cast(float, w.y & 0xffff0000u);
        f[4] = __builtin_bit_cast(float, w.z << 16); f[5] = __builtin_bit_cast(float, w.z & 0xffff0000u); f[6] = __builtin_bit_cast(float, w.w << 16); f[7] = __builtin_bit_cast(float, w.w & 0xffff0000u); };
    u32x4_t raw[3][2]; f32x2_t w2[CONVK], bias2 = {0.f, 0.f}; int wcb = -1;
#pragma unroll
    for (int j = 0; j < CONVK; ++j) w2[j] = f32x2_t{0.f, 0.f};
    if (bx < CV_NPI + CV_NSI) { const CvItem I0 = cv_item(bx); cv_fetch(Z, l, sconv, I0, raw, tid); }
    for (int it = bx; it < CV_NPI + CV_NSI; it += G) {
        const CvItem I = cv_item(it);
        const int cp = tid & 63, r0 = (tid >> 6) * 8, ch = I.cb * CV_CB + 2 * cp;
        if (I.cb != wcb) { wcb = I.cb;
#pragma unroll
            for (int j = 0; j < CONVK; ++j) w2[j] = *(const f32x2_t*)(wdw + ((size_t)l * CONVK + j) * BRW + ch);
            bias2 = *(const f32x2_t*)(bdw + l * BRW + ch); }
#pragma unroll
        for (int i = 0; i < 3; ++i) { const int p = tid + NTHR * i, ur = p >> 4, c8 = p & 15, tt = I.t0 - CPRE + ur; float u[8];
            if (ur < I.nrows + CPRE) {
                if (tt >= 0) { unp(raw[i][0], u);
                    if (ur >= CPRE) { float* o = nullptr;
                        if (!I.smp) { if (tt >= SEQ - CPRE) o = out + O_CP + (((size_t)l * NBP + I.b) * CPRE + (tt - (SEQ - CPRE))) * BRW + I.cb * CV_CB + c8 * 8; }
                        else o = out + O_CS + (((size_t)l * SB + I.b) * CPRE + (CPRE - ST + tt)) * BRW + I.cb * CV_CB + c8 * 8;
                        if (o) { *(f32x4*)o = (f32x4){u[0], u[1], u[2], u[3]}; *(f32x4*)(o + 4) = (f32x4){u[4], u[5], u[6], u[7]}; } }
                } else {
                    const unsigned r0_ = raw[i][0].x, r1_ = raw[i][0].y, r2_ = raw[i][0].z, r3_ = raw[i][0].w, r4_ = raw[i][1].x, r5_ = raw[i][1].y, r6_ = raw[i][1].z, r7_ = raw[i][1].w;
                    u[0] = __builtin_bit_cast(float, r0_); u[1] = __builtin_bit_cast(float, r1_); u[2] = __builtin_bit_cast(float, r2_); u[3] = __builtin_bit_cast(float, r3_);
                    u[4] = __builtin_bit_cast(float, r4_); u[5] = __builtin_bit_cast(float, r5_); u[6] = __builtin_bit_cast(float, r6_); u[7] = __builtin_bit_cast(float, r7_); }
                *(LAS f32x4*)(U + ur * CV_CB + c8 * 8) = (f32x4){u[0], u[1], u[2], u[3]}; *(LAS f32x4*)(U + ur * CV_CB + c8 * 8 + 4) = (f32x4){u[4], u[5], u[6], u[7]}; } }
        __syncthreads();
        if (it + G < CV_NPI + CV_NSI) { const CvItem In = cv_item(it + G); cv_fetch(Z, l, sconv, In, raw, tid); }
        if (r0 < I.nrows) {
            f32x2_t u2[8 + CPRE];
#pragma unroll
            for (int k = 0; k < 8 + CPRE; ++k) u2[k] = *(const LAS f32x2_t*)(U + (r0 + k) * CV_CB + 2 * cp);
#pragma unroll
            for (int r = 0; r < 8; ++r) { f32x2_t acc = bias2;
#pragma unroll
                for (int j = 0; j < CONVK; ++j) acc = w2[j] * u2[r + j] + acc;
                if (r0 + r < I.nrows) *(f32x2_t*)(CONVY + (I.rowb + I.t0 + r0 + r) * BRW + ch) = acc; }
        }
        __syncthreads();
    }
}
template <int W> __device__ __forceinline__ void pool_run(const bf16* Z, int l, int b, int t0, int cch, bf16* ZP, float* out) {
    const size_t rowb = (size_t)b * SEQ; u32x4_t rw[23];
#pragma unroll
    for (int k = 16 - W; k < 23; ++k) { const int tt = t0 - 15 + k; rw[k] = (u32x4_t){0u, 0u, 0u, 0u}; if (tt >= 0) rw[k] = *(const u32x4_t*)(Z + (rowb + tt) * ZW + ZPL + cch); }
    float S[8];
#pragma unroll
    for (int e = 0; e < 8; ++e) S[e] = 0.f;
    auto unp = [](const u32x4_t w, float* f) { f[0] = __builtin_bit_cast(float, w.x << 16); f[1] = __builtin_bit_cast(float, w.x & 0xffff0000u); f[2] = __builtin_bit_cast(float, w.y << 16); f[3] = __builtin_bit_cast(float, w.y & 0xffff0000u);
        f[4] = __builtin_bit_cast(float, w.z << 16); f[5] = __builtin_bit_cast(float, w.z & 0xffff0000u); f[6] = __builtin_bit_cast(float, w.w << 16); f[7] = __builtin_bit_cast(float, w.w & 0xffff0000u); };
#pragma unroll
    for (int k = 16 - W; k < 15; ++k) { float f[8]; unp(rw[k], f);
#pragma unroll
        for (int e = 0; e < 8; ++e) S[e] += f[e]; }
#pragma unroll
    for (int r = 0; r < 8; ++r) { const int t = t0 + r; float u[8], o[8], f[8]; unp(rw[15 + r], u);
        const float inv = 1.f / (float)((t + 1) < W ? (t + 1) : W);
#pragma unroll
        for (int e = 0; e < 8; ++e) { S[e] += u[e]; o[e] = S[e] * inv - u[e]; }
        st8(ZP + (rowb + t) * BRW + cch, o);
        if (t >= SEQ - PPAD) { float* so = out + O_PP + (((size_t)l * NBP + b) * PPAD + (t - (SEQ - PPAD))) * BRW + cch; *(f32x4*)so = (f32x4){u[0], u[1], u[2], u[3]}; *(f32x4*)(so + 4) = (f32x4){u[4], u[5], u[6], u[7]}; }
        unp(rw[15 + r - W + 1], f);
#pragma unroll
        for (int e = 0; e < 8; ++e) S[e] -= f[e]; }
}
template <int W> __device__ __forceinline__ void pool_run_s(const bf16* Z, int l, int b, int cch, const float* spool, bf16* ZP, float* out) {
    const size_t rowb = (size_t)MP + b * ST; const float* sp = spool + (((size_t)l * SB + b) * PPAD) * BRW + cch;
    f32x4 pf[W - 1][2]; u32x4_t rw[ST];
#pragma unroll
    for (int k = 0; k < W - 1; ++k) { pf[k][0] = *(const f32x4*)(sp + (size_t)(PPAD - (W - 1) + k) * BRW); pf[k][1] = *(const f32x4*)(sp + (size_t)(PPAD - (W - 1) + k) * BRW + 4); }
#pragma unroll
    for (int t = 0; t < ST; ++t) rw[t] = *(const u32x4_t*)(Z + (rowb + t) * ZW + ZPL + cch);
    auto unp = [](const u32x4_t w, float* f) { f[0] = __builtin_bit_cast(float, w.x << 16); f[1] = __builtin_bit_cast(float, w.x & 0xffff0000u); f[2] = __builtin_bit_cast(float, w.y << 16); f[3] = __builtin_bit_cast(float, w.y & 0xffff0000u);
        f[4] = __builtin_bit_cast(float, w.z << 16); f[5] = __builtin_bit_cast(float, w.z & 0xffff0000u); f[6] = __builtin_bit_cast(float, w.w << 16); f[7] = __builtin_bit_cast(float, w.w & 0xffff0000u); };
    float S[8];
#pragma unroll
    for (int e = 0; e < 8; ++e) S[e] = 0.f;
#pragma unroll
    for (int k = 0; k < W - 1; ++k) { S[0] += pf[k][0].x; S[1] += pf[k][0].y; S[2] += pf[k][0].z; S[3] += pf[k][0].w; S[4] += pf[k][1].x; S[5] += pf[k][1].y; S[6] += pf[k][1].z; S[7] += pf[k][1].w; }
    const float inv = 1.f / (float)W;
#pragma unroll
    for (int t = 0; t < ST; ++t) { float u[8], o[8], f[8]; unp(rw[t], u);
#pragma unroll
        for (int e = 0; e < 8; ++e) { S[e] += u[e]; o[e] = S[e] * inv - u[e]; }
        st8(ZP + (rowb + t) * BRW + cch, o);
        float* so = out + O_PS + (((size_t)l * SB + b) * PPAD + (PPAD - ST + t)) * BRW + cch; *(f32x4*)so = (f32x4){u[0], u[1], u[2], u[3]}; *(f32x4*)(so + 4) = (f32x4){u[4], u[5], u[6], u[7]};
        const int tt = t - W + 1;
        if (tt >= 0) unp(rw[tt >= 0 ? tt : 0], f);
        else { const int k = tt + W - 1 >= 0 ? tt + W - 1 : 0; f[0] = pf[k][0].x; f[1] = pf[k][0].y; f[2] = pf[k][0].z; f[3] = pf[k][0].w; f[4] = pf[k][1].x; f[5] = pf[k][1].y; f[6] = pf[k][1].z; f[7] = pf[k][1].w; }
#pragma unroll
        for (int e = 0; e < 8; ++e) S[e] -= f[e]; }
}
__device__ __forceinline__ void pool_phase(const bf16* Z, int l, const float* spool, bf16* ZP, float* out, int gw, int NGW, int lane, int gt, int NGT) {
    for (int wi = gw; wi < (MP / 8 / 2) * 4; wi += NGW) { const int cg = wi & 3, grp = (wi >> 2) * 2 + (lane >> 5), cch = (cg * 32 + (lane & 31)) * 8, b = grp >> 9, t0 = (grp & 511) * 8;
        if (cg == 0) pool_run<2>(Z, l, b, t0, cch, ZP, out); else if (cg == 1) pool_run<4>(Z, l, b, t0, cch, ZP, out); else if (cg == 2) pool_run<8>(Z, l, b, t0, cch, ZP, out); else pool_run<16>(Z, l, b, t0, cch, ZP, out); }
    for (int wi = gw; wi < (SB / 2) * 4; wi += NGW) { const int cg = wi & 3, b = (wi >> 2) * 2 + (lane >> 5), cch = (cg * 32 + (lane & 31)) * 8;
        if (cg == 0) pool_run_s<2>(Z, l, b, cch, spool, ZP, out); else if (cg == 1) pool_run_s<4>(Z, l, b, cch, spool, ZP, out); else if (cg == 2) pool_run_s<8>(Z, l, b, cch, spool, ZP, out); else pool_run_s<16>(Z, l, b, cch, spool, ZP, out); }
}
__device__ __forceinline__ void retout_s_phase(const bf16* Z, int l, const float* sret, const float* gret, bf16* Y3, int gw, int NGW, int lane) {
    for (int it = gw; it < MS * RH; it += NGW) { int h = __builtin_amdgcn_readfirstlane(it & 7); asm volatile("" : "+s"(h));
        const int rs = it >> 3, sb = rs >> 3, i = rs & 7; const size_t row = (size_t)MP + rs, row0 = (size_t)MP + sb * ST;
        const float lg = ret_logg(h);
        const bf16* qp = Z + row * ZW + ZRQ + h * 64;
        const float* S = sret + (((size_t)l * SB + sb) * RH + h) * RDK * RDV;
        float o0 = 0.f, o1 = 0.f;
#pragma unroll 16
        for (int d = 0; d < 64; ++d) { const float qd = bf2f(qp[d]); o0 += qd * S[(size_t)d * RDV + lane]; o1 += qd * S[(size_t)d * RDV + lane + 64]; }
        const float cf = FEXP(lg * (float)(i + 1)); o0 *= cf; o1 *= cf;
        const float ql = bf2f(qp[lane]);
        for (int j = 0; j <= i; ++j) { const bf16* zj = Z + (row0 + j) * ZW; const float sc = wave_sum(ql * bf2f(zj[ZRK + h * 64 + lane])) * 0.125f * FEXP(lg * (float)(i - j));
            o0 += sc * bf2f(zj[ZRV + h * 128 + lane]); o1 += sc * bf2f(zj[ZRV + h * 128 + lane + 64]); }
        const float mean = wave_sum(o0 + o1) * (1.f / 128.f); const float d0 = o0 - mean, d1 = o1 - mean;
        const float rstd = 1.f / sqrtf(wave_sum(d0 * d0 + d1 * d1) * (1.f / 128.f) + EPS);
        const float* g = gret + l * BRW + h * 128; const bf16* rg = Z + row * ZW + ZRG + h * 128; bf16* y = Y3 + row * BRW + h * 128;
        y[lane] = f2bf(d0 * rstd * g[lane] * bf2f(rg[lane])); y[lane + 64] = f2bf(d1 * rstd * g[lane + 64] * bf2f(rg[lane + 64]));
    }
}
}
struct AdaOrder { int G, c; const char* A; const char* B;
    __device__ __forceinline__ bool next(int i, pg8::Unit& u) const { const int Lx = i * G + c; if (Lx >= DEPTH * (ADAW / 256)) return false;
        u.r = Lx / (ADAW / 256); u.pn = Lx % (ADAW / 256); u.pm = 0; u.ks = 0; u.nt = DM / 64; u.a = A; u.b = B + ((size_t)u.r * ADAW + (size_t)u.pn * 256) * DM * 2; return true; } };
struct PoolOrder { int G, c; const char* A; const char* B;
                __device__ __forceinline__ bool next(int i, pg8::Unit& u) const { const int Lx = i * G + c; if (Lx >= (M / 256) * 4) return false;
                    u.pm = Lx >> 2; u.pn = Lx & 3; u.r = 0; u.ks = 0; u.nt = 256 / 64; u.a = A + ((size_t)u.pm * 256 * BRW + (size_t)u.pn * 256) * 2; u.b = B + (size_t)u.pn * 256 * 256 * 2; return true; } };
__device__ __forceinline__ unsigned long long ld_ptr(volatile LAS unsigned* p) { const unsigned lo = __builtin_amdgcn_readfirstlane(p[0]), hi = __builtin_amdgcn_readfirstlane(p[1]); return ((unsigned long long)hi << 32) | lo; }
constexpr int NPL = 12;
constexpr int PH_TOTAL = 2 + DEPTH * NPL + 1;
constexpr int KS_BR = 2, KS_OUT = 8, KS_M1 = 4, KS_M2 = 16;
struct Args { const float* in[N_IN]; float* out; unsigned char* ws; int ph_lo, ph_hi; };
static_assert(sizeof(Args) == N_IN * 8 + 8 + 8 + 8, "Args has no padding");

__global__ void __launch_bounds__(NTHR, 2) fwd(Args args) {
    extern __shared__ __attribute__((aligned(16))) unsigned char lds[];
    LAS unsigned char* L0 = (LAS unsigned char*)lds;
    volatile LAS unsigned* MISC = (volatile LAS unsigned*)(L0 + MISC_OFF);
    const int G = gridDim.x, bx = blockIdx.x, wave0 = __builtin_amdgcn_readfirstlane(threadIdx.x >> 6);
    unsigned char* ws0 = args.ws;
    for (int u = threadIdx.x; u < (LDS_BYTES - LDSCTL_OFF) / 4; u += NTHR) ((LAS unsigned*)(L0 + LDSCTL_OFF))[u] = 0u;
    __syncthreads();
    if (threadIdx.x <= N_IN) ((LAS unsigned long long*)(L0 + INTAB_OFF))[threadIdx.x] = threadIdx.x < N_IN ? (unsigned long long)args.in[threadIdx.x < N_IN ? threadIdx.x : 0] : (unsigned long long)args.out;
    __syncthreads();
#if MK_ONE_LAUNCH
    XcdBarrier bar = xcd_barrier_post((unsigned*)(ws0 + WS_CTL) + CW_BAR, MISC + 8);
#define GRID_BAR() xcd_barrier(bar)
#else
#define GRID_BAR() do {} while (0)
#endif
    const int lo = args.ph_lo, hi = args.ph_hi;
#ifndef PH_MASK
#define PH_MASK 0x7FFF
#endif
#ifndef PROBE_MASK
#define PROBE_MASK 0
#endif
#define PROBE_BEGIN(bit) unsigned long long pr_t0 = 0; if ((PROBE_MASK >> (bit)) & 1) pr_t0 = __builtin_amdgcn_s_memrealtime()
#define PROBE_END(bit) do { if ((PROBE_MASK >> (bit)) & 1) { __syncthreads(); const unsigned long long t1 = __builtin_amdgcn_s_memrealtime(); while (__builtin_amdgcn_s_memrealtime() - t1 < t1 - pr_t0) __builtin_amdgcn_s_sleep(8); } } while (0)
#define IN(k) (lo <= (k) && (k) < hi)
#define SEAM(k) do { if (IN((k) + 1)) GRID_BAR(); } while (0)
#define INP(i)  ((const float*)(GAS const float*)ld_ptr((volatile LAS unsigned*)(L + INTAB_OFF) + 2 * (i)))
#define P_OUT   ((float*)(GAS float*)ld_ptr((volatile LAS unsigned*)(L + INTAB_OFF) + 2 * N_IN))
#define WIN_T   ((bf16*)(ws + WS_WIN))
#define WBR_T   ((bf16*)(ws + WS_WBR))
#define WOUT_T  ((bf16*)(ws + WS_WOUT))
#define WM1_T   ((bf16*)(ws + WS_WM1))
#define WM2_T   ((bf16*)(ws + WS_WM2))
#define WPOOL_T ((bf16*)(ws + WS_WPOOL))
#define WADA_T  ((bf16*)(ws + WS_WADA))
#define SC      ((bf16*)(ws + WS_SC))
#define ADA     ((float*)(ws + WS_ADA))
#define H       ((bf16*)(ws + WS_H))
#define Z       ((bf16*)(ws + WS_Z))
#define Y       ((bf16*)(ws + WS_Y))
#define ZP      ((bf16*)(ws + WS_ZP))
#define CONVY   ((float*)(ws + WS_CONVY))
#define ORAW    ((float*)(ws + WS_ORAW))
#define KV      ((float*)(ws + WS_KV))
#define SPREV   ((float*)(ws + WS_SPREV))
#define MACC    ((float*)(ws + WS_MACC))
#define MERGED  ((bf16*)(ws + WS_MERGED))
#define X1      ((float*)(ws + WS_X1))
#define X       ((float*)(ws + WS_X))
#define HID     ((bf16*)(ws + WS_HID))
#define SLAB    ((float*)(ws + WS_SLAB))
#define TIDS() int lane; asm volatile("v_mbcnt_lo_u32_b32 %0, -1, 0\n\tv_mbcnt_hi_u32_b32 %0, -1, %0" : "=v"(lane)); GAS unsigned char* wsg = (GAS unsigned char*)ws0; asm volatile("" : "+s"(wsg)); unsigned char* ws = (unsigned char*)wsg; LAS unsigned char* L = L0; asm volatile("" : "+s"(L)); const int wave = wave0, tid = wave0 * 64 + lane; const int gw = bx * NWAVES + wave, NGW = G * NWAVES; const int gt = bx * NTHR + tid, NGT = G * NTHR; (void)lane; (void)gw; (void)NGW; (void)gt; (void)NGT
#define LAYER_PTRS() const float* ada = ADA + (size_t)l * NROWB * ADAW; const float* xinP = l == 0 ? INP(I_XP) : X; const float* xinS = l == 0 ? INP(I_XS) : X + (size_t)MP * DM; float* xout = l == DEPTH - 1 ? P_OUT : X; (void)ada; (void)xinP; (void)xinS; (void)xout
    if ((PH_MASK >> 12 & 1) && IN(0)) { TIDS(); PROBE_BEGIN(12);
        transpose_run<DM, ZW, true>(INP(I_WIN), WIN_T, DEPTH, gw, NGW, lane);
        transpose_run<BRW, DM>(INP(I_WBR), WBR_T, DEPTH * 4, gw, NGW, lane);
        transpose_run<DM, DM>(INP(I_WOUT), WOUT_T, DEPTH, gw, NGW, lane);
        transpose_run<DM, DFF>(INP(I_WM1), WM1_T, DEPTH, gw, NGW, lane);
        transpose_run<DFF, DM>(INP(I_WM2), WM2_T, DEPTH, gw, NGW, lane);
        transpose_run<256, 256>(INP(I_WPOOL), WPOOL_T, DEPTH * 4, gw, NGW, lane);
        adad::phase(INP(I_CP), INP(I_CS), INP(I_WADA), INP(I_BADA), ADA, L + RING_OFF, bx, G, wave, lane, tid);
        PROBE_END(12); SEAM(0);
    }
    for (int l = 0; l < DEPTH; ++l) {
        const int pb = 2 + l * NPL;
        if ((PH_MASK >> 0 & 1) && IN(pb + 0)) { TIDS(); LAYER_PTRS(); PROBE_BEGIN(0);
            for (int rs = bx; rs < MS; rs += G) { const int row = MP + rs; const float* ar = ada + (size_t)row_cond(row) * ADAW;
                if (l == 0) norm_row_block<0>(xinS + (size_t)rs * DM, nullptr, nullptr, 0, nullptr, INP(I_G1) + l * DM, ar + DM, ar, H + (size_t)row * DM, (LAS float*)(L + RING_OFF), tid, wave);
                else norm_row_block<KS_M2>(X1 + (size_t)row * DM, ar - (size_t)NROWB * ADAW + 5 * DM, SLAB + (size_t)rs * DM, (size_t)MS * DM, X + (size_t)row * DM, INP(I_G1) + l * DM, ar + DM, ar, H + (size_t)row * DM, (LAS float*)(L + RING_OFF), tid, wave); }
            f32x4 gm[8], shv[8]; int curc = row_cond(gw < MP ? gw : 0); { const float* ar = ada + (size_t)curc * ADAW; load_mod(INP(I_G1) + l * DM, ar + DM, ar, gm, shv, lane); }
            for (int row = gw; row < MP; row += 2 * NGW) { const int rowb = row + NGW; const bool pair = rowb < MP && row_cond(rowb) == row_cond(row);
                for (int k = 0; k < 2; ++k) { const int r = k ? rowb : row; if (k && (pair || rowb >= MP)) break; const int cond = row_cond(r); const float* ar = ada + (size_t)cond * ADAW;
                    if (cond != curc) { load_mod(INP(I_G1) + l * DM, ar + DM, ar, gm, shv, lane); curc = cond; }
                    if (pair) norm_row2(xinP + (size_t)row * DM, xinP + (size_t)rowb * DM, gm, shv, H + (size_t)row * DM, H + (size_t)rowb * DM, lane);
                    else norm_row(xinP + (size_t)r * DM, gm, shv, H + (size_t)r * DM, lane); } }
            PROBE_END(0); SEAM(pb + 0);
        }
        if ((PH_MASK >> 1 & 1) && IN(pb + 1)) { TIDS(); LAYER_PTRS(); PROBE_BEGIN(1);
            pg8::StaticOrder S; S.init(H, WIN_T + (size_t)l * ZW * DM, M / 256, ZW / 256, DM, DM, DM, G, bx);
            pg8::EpiZ E{Z};
            pg8::gemm_phase<pg8::EpiZ, pg8::StaticOrder>(L + RING_OFF, pg8::Dims{DM, DM, DM}, S, E, tid);
            PROBE_END(1); SEAM(pb + 1);
        }
        if ((PH_MASK >> 2 & 1) && IN(pb + 2)) { TIDS(); LAYER_PTRS(); PROBE_BEGIN(2);
            mixl::qknorm_phase(Z, l, INP(I_GQ), INP(I_GK), P_OUT, gw, NGW, lane);
            for (int i = gt; i < N_SHIFT_ITEMS; i += NGT) shift_item(l, i, INP(I_CK), INP(I_CV), INP(I_SCONV), INP(I_SPOOL), P_OUT);
            mixl::conv_phase(L + RING_OFF, Z, l, INP(I_WDW), INP(I_BDW), INP(I_SCONV), CONVY, P_OUT, bx, G, tid);
            mixl::pool_phase(Z, l, INP(I_SPOOL), ZP, P_OUT, gw, NGW, lane, gt, NGT);
            ret::kv_phase(L + RING_OFF, Z, KV, bx, G, tid, lane, wave);
            for (int i = gt; i < SB * RH * RDK * 32; i += NGT) { const int v4 = i & 31, d = (i >> 5) & 63, h = (i >> 11) & 7, sb = i >> 14; retstate_s_item(Z, l, sb, h, d, v4, INP(I_SRET), P_OUT); }
            PROBE_END(2); SEAM(pb + 2);
        }
        if ((PH_MASK >> 3 & 1) && IN(pb + 3)) { TIDS(); LAYER_PTRS(); PROBE_BEGIN(3);
            att::phase(L + RING_OFF, Z, l, INP(I_SINK), INP(I_CK), INP(I_CV), Y, bx, G, tid, lane, wave);
            for (int i = gt; i < NBP * RH * RDK * 32; i += NGT) { const int v4 = i & 31, d = (i >> 5) & 63, b = i >> 14; int h = (i >> 11) & 7;
                const size_t o0 = (((size_t)b * 32 * RH + h) * RDK + d) * RDV + v4 * 4, cs = (size_t)RH * RDK * RDV; f32x4 kvv[32];
#pragma unroll
                for (int n = 0; n < 32; ++n) kvv[n] = *(const f32x4*)(KV + o0 + n * cs);
                const float gc = FEXP(ret_logg(h) * 128.f); float z0 = 0.f; asm volatile("" : "+v"(z0)); f32x4 sacc = {z0, z0, z0, z0};
#pragma unroll
                for (int n = 0; n < 32; ++n) { *(f32x4*)(SPREV + o0 + n * cs) = sacc; sacc = sacc * gc + kvv[n]; }
                *(f32x4*)(P_OUT + O_RP + ((((size_t)l * NBP + b) * RH + h) * RDK + d) * RDV + v4 * 4) = sacc; }
            { f32x4 gv4[4], bv4[4];
#pragma unroll
              for (int j = 0; j < 4; ++j) { gv4[j] = ((const f32x4*)(INP(I_GCLN) + l * BRW))[lane + 64 * j]; bv4[j] = ((const f32x4*)(INP(I_BCLN) + l * BRW))[lane + 64 * j]; }
              for (int row = gw; row < M; row += NGW) convln_row(CONVY + (size_t)row * BRW, gv4, bv4, Y + (size_t)1 * M * BRW + (size_t)row * BRW, lane); }
            PROBE_END(3); SEAM(pb + 3);
        }
        if ((PH_MASK >> 4 & 1) && IN(pb + 4)) { TIDS(); LAYER_PTRS(); PROBE_BEGIN(4);
            mixl::retout_s_phase(Z, l, INP(I_SRET), INP(I_GRET), Y + (size_t)3 * M * BRW, gw, NGW, lane);
            ret::out_phase(L + RING_OFF, Z, l, SPREV, INP(I_GRET), Y + (size_t)3 * M * BRW, bx, G, tid, lane, wave);
            PoolOrder S{G, bx, (const char*)ZP, (const char*)(WPOOL_T + (size_t)l * 4 * 256 * 256)};
            pg8::EpiPool E{Y + (size_t)2 * M * BRW, INP(I_SPOOLS), l};
            pg8::gemm_phase<pg8::EpiPool, PoolOrder>(L + RING_OFF, pg8::Dims{BRW, 256, 256}, S, E, tid);
            PROBE_END(4); SEAM(pb + 4);
        }
        if ((PH_MASK >> 5 & 1) && IN(pb + 5)) { TIDS(); LAYER_PTRS(); PROBE_BEGIN(5);
            pg8::SplitOrder S{DM / 256, G, bx, 4, BRW / 64, KS_BR, BRW / 64 / KS_BR, (const char*)Y, (const char*)(WBR_T + (size_t)l * 4 * DM * BRW), (size_t)256 * BRW * 2, (size_t)256 * BRW * 2, (size_t)M * BRW * 2, (size_t)DM * BRW * 2};
            pg8::EpiBr E{Z, MERGED, SLAB, KS_BR};
            pg8::gemm_phase<pg8::EpiBr, pg8::SplitOrder>(L + RING_OFF, pg8::Dims{BRW, BRW, BRW}, S, E, tid);
            PROBE_END(5); SEAM(pb + 5);
        }
        if ((PH_MASK >> 6 & 1) && IN(pb + 6)) { TIDS(); LAYER_PTRS(); PROBE_BEGIN(6);
            for (int i = gt; i < MS * DM / 8; i += NGT) { float a[8];
#pragma unroll
                for (int e = 0; e < 8; ++e) a[e] = 0.f;
#pragma unroll
                for (int p = 0; p < 4 * KS_BR; ++p) { const f32x4 v0 = *(const f32x4*)(SLAB + (size_t)p * MS * DM + (size_t)i * 8), v1 = *(const f32x4*)(SLAB + (size_t)p * MS * DM + (size_t)i * 8 + 4);
                    a[0] += v0.x; a[1] += v0.y; a[2] += v0.z; a[3] += v0.w; a[4] += v1.x; a[5] += v1.y; a[6] += v1.z; a[7] += v1.w; }
                st8(MERGED + (size_t)MP * DM + (size_t)i * 8, a); }
            PROBE_END(6); SEAM(pb + 6);
        }
        if ((PH_MASK >> 7 & 1) && IN(pb + 7)) { TIDS(); LAYER_PTRS(); PROBE_BEGIN(7);
            pg8::SplitOrder S{DM / 256, G, bx, 1, DM / 64, KS_OUT, DM / 64 / KS_OUT, (const char*)MERGED, (const char*)(WOUT_T + (size_t)l * DM * DM), (size_t)256 * DM * 2, (size_t)256 * DM * 2, 0, 0};
            pg8::EpiRes E{xinP, xinS, X1, ada + 2 * DM, SLAB};
            pg8::gemm_phase<pg8::EpiRes, pg8::SplitOrder>(L + RING_OFF, pg8::Dims{DM, DM, DM}, S, E, tid);
            PROBE_END(7); SEAM(pb + 7);
        }
        if ((PH_MASK >> 8 & 1) && IN(pb + 8)) { TIDS(); LAYER_PTRS(); PROBE_BEGIN(8);
            for (int rs = bx; rs < MS; rs += G) { const int row = MP + rs; const float* ar = ada + (size_t)row_cond(row) * ADAW;
                norm_row_block<KS_OUT>(xinS + (size_t)rs * DM, ar + 2 * DM, SLAB + (size_t)rs * DM, (size_t)MS * DM, X1 + (size_t)row * DM, INP(I_G2) + l * DM, ar + 4 * DM, ar + 3 * DM, H + (size_t)row * DM, (LAS float*)(L + RING_OFF), tid, wave); }
            f32x4 gm[8], shv[8]; int curc = row_cond(gw < MP ? gw : 0); { const float* ar = ada + (size_t)curc * ADAW; load_mod(INP(I_G2) + l * DM, ar + 4 * DM, ar + 3 * DM, gm, shv, lane); }
            for (int row = gw; row < MP; row += 2 * NGW) { const int rowb = row + NGW; const bool pair = rowb < MP && row_cond(rowb) == row_cond(row);
                for (int k = 0; k < 2; ++k) { const int r = k ? rowb : row; if (k && (pair || rowb >= MP)) break; const int cond = row_cond(r); const float* ar = ada + (size_t)cond * ADAW;
                    if (cond != curc) { load_mod(INP(I_G2) + l * DM, ar + 4 * DM, ar + 3 * DM, gm, shv, lane); curc = cond; }
                    if (pair) norm_row2(X1 + (size_t)row * DM, X1 + (size_t)rowb * DM, gm, shv, H + (size_t)row * DM, H + (size_t)rowb * DM, lane);
                    else norm_row(X1 + (size_t)r * DM, gm, shv, H + (size_t)r * DM, lane); } }
            PROBE_END(8); SEAM(pb + 8);
        }
        if ((PH_MASK >> 9 & 1) && IN(pb + 9)) { TIDS(); LAYER_PTRS(); PROBE_BEGIN(9);
            pg8::SplitOrder S{DFF / 256, G, bx, 1, DM / 64, KS_M1, DM / 64 / KS_M1, (const char*)H, (const char*)(WM1_T + (size_t)l * DFF * DM), (size_t)256 * DM * 2, (size_t)256 * DM * 2, 0, 0};
            pg8::EpiMlp1 E{HID, SLAB};
            pg8::gemm_phase<pg8::EpiMlp1, pg8::SplitOrder>(L + RING_OFF, pg8::Dims{DM, DM, DM}, S, E, tid);
            PROBE_END(9); SEAM(pb + 9);
        }
        if ((PH_MASK >> 10 & 1) && IN(pb + 10)) { TIDS(); LAYER_PTRS(); PROBE_BEGIN(10);
            for (int i = gt; i < MS * DFF / 8; i += NGT) { float a[8];
#pragma unroll
                for (int e = 0; e < 8; ++e) a[e] = 0.f;
#pragma unroll
                for (int p = 0; p < KS_M1; ++p) { const f32x4 v0 = *(const f32x4*)(SLAB + (size_t)p * MS * DFF + (size_t)i * 8), v1 = *(const f32x4*)(SLAB + (size_t)p * MS * DFF + (size_t)i * 8 + 4);
                    a[0] += v0.x; a[1] += v0.y; a[2] += v0.z; a[3] += v0.w; a[4] += v1.x; a[5] += v1.y; a[6] += v1.z; a[7] += v1.w; }
#pragma unroll
                for (int e = 0; e < 8; ++e) { const float t = fmaxf(a[e], 0.f); a[e] = t * t; }
                st8(HID + (size_t)MP * DFF + (size_t)i * 8, a); }
            PROBE_END(10); SEAM(pb + 10);
        }
        if ((PH_MASK >> 11 & 1) && IN(pb + 11)) { TIDS(); LAYER_PTRS(); PROBE_BEGIN(11);
            pg8::SplitOrder S{DM / 256, G, bx, 1, DFF / 64, KS_M2, DFF / 64 / KS_M2, (const char*)HID, (const char*)(WM2_T + (size_t)l * DM * DFF), (size_t)256 * DFF * 2, (size_t)256 * DFF * 2, 0, 0};
            pg8::EpiRes E{X1, X1 + (size_t)MP * DM, xout, ada + 5 * DM, SLAB};
            pg8::gemm_phase<pg8::EpiRes, pg8::SplitOrder>(L + RING_OFF, pg8::Dims{DFF, DFF, DFF}, S, E, tid);
            PROBE_END(11); SEAM(pb + 11);
        }
    }
    if ((PH_MASK >> 14 & 1) && IN(PH_TOTAL - 1)) { TIDS(); PROBE_BEGIN(14);
        const float* ada = ADA + (size_t)(DEPTH - 1) * NROWB * ADAW; float* yo = P_OUT + O_YS;
        for (int i = gt; i < MS * DM / 4; i += NGT) { const int row = i / (DM / 4), c4 = i % (DM / 4); const float* gp = ada + (size_t)(NBP + (row >> 3)) * ADAW + 5 * DM;
            f32x4 a = {0.f, 0.f, 0.f, 0.f};
#pragma unroll
            for (int p = 0; p < KS_M2; ++p) a += *(const f32x4*)(SLAB + (size_t)p * MS * DM + (size_t)i * 4);
            *(f32x4*)(yo + (size_t)i * 4) = *(const f32x4*)(X1 + (size_t)(MP + row) * DM + c4 * 4) + *(const f32x4*)(gp + c4 * 4) * a; }
        PROBE_END(14);
    }
#undef IN
#undef SEAM
}

extern "C" void kernel_launch(void* const* d_in, const int* in_sizes, int n_in, void* d_out, int out_size, void* d_ws, size_t ws_size, hipStream_t stream) {
    static int grid = 0;
    if (grid == 0) {
        if (n_in != N_IN || (size_t)out_size != O_END || ws_size < WS_END) { fprintf(stderr, "kernel_launch: unexpected shapes: n_in %d out %d ws %zu (need %zu)\n", n_in, out_size, ws_size, (size_t)WS_END); grid = -1; return; }
        int dev = 0, cus = 0, per_cu = 0;
        if (hipGetDevice(&dev) != hipSuccess || hipDeviceGetAttribute(&cus, hipDeviceAttributeMultiprocessorCount, dev) != hipSuccess) { grid = -1; return; }
        if (hipFuncSetAttribute((const void*)fwd, hipFuncAttributeMaxDynamicSharedMemorySize, LDS_BYTES) != hipSuccess) { fprintf(stderr, "kernel_launch: hipFuncSetAttribute failed\n"); grid = -1; return; }
        if (hipOccupancyMaxActiveBlocksPerMultiprocessor(&per_cu, (const void*)fwd, NTHR, LDS_BYTES) != hipSuccess || per_cu < 1) fprintf(stderr, "kernel_launch: occupancy query says %d\n", per_cu);
        (void)hipGetLastError();
        grid = cus;
    }
    if (grid < 0) return;
    (void)hipMemsetAsync((char*)d_ws + WS_CTL, 0, CTL_ZERO_BYTES, stream);
    Args a{};
    for (int i = 0; i < N_IN; ++i) a.in[i] = (const float*)d_in[i];
    a.out = (float*)d_out; a.ws = (unsigned char*)d_ws;
#if MK_ONE_LAUNCH
    a.ph_lo = 0; a.ph_hi = PH_TOTAL;
    hipLaunchKernelGGL(fwd, dim3(grid), dim3(NTHR), LDS_BYTES, stream, a);
#else
    for (int p = 0; p < PH_TOTAL; ++p) { a.ph_lo = p; a.ph_hi = p + 1; hipLaunchKernelGGL(fwd, dim3(grid), dim3(NTHR), LDS_BYTES, stream, a); }
#endif
}
#endif
```

```cpp
#ifndef HOST_TEST_ONLY
#include <hip/hip_runtime.h>
#endif
#include <cstdio>
#include <cstdint>
#include <cmath>

#ifndef MK_ONE_LAUNCH
#define MK_ONE_LAUNCH 1
#endif

#define HD __host__ __device__ __forceinline__
typedef unsigned short bf16;
HD float bf2f(bf16 b) { return __builtin_bit_cast(float, ((unsigned)b) << 16); }
HD bf16 f2bf(float f) { unsigned u = __builtin_bit_cast(unsigned, f); return (bf16)((u + 0x7fffu + ((u >> 16) & 1u)) >> 16); }

HD void ld8(const bf16* p, float* f) { const uint4 w = *(const uint4*)p;
    f[0] = __builtin_bit_cast(float, w.x << 16); f[1] = __builtin_bit_cast(float, w.x & 0xffff0000u); f[2] = __builtin_bit_cast(float, w.y << 16); f[3] = __builtin_bit_cast(float, w.y & 0xffff0000u);
    f[4] = __builtin_bit_cast(float, w.z << 16); f[5] = __builtin_bit_cast(float, w.z & 0xffff0000u); f[6] = __builtin_bit_cast(float, w.w << 16); f[7] = __builtin_bit_cast(float, w.w & 0xffff0000u); }
HD void st8(bf16* p, const float* f) { uint4 w; w.x = (unsigned)f2bf(f[0]) | ((unsigned)f2bf(f[1]) << 16); w.y = (unsigned)f2bf(f[2]) | ((unsigned)f2bf(f[3]) << 16);
    w.z = (unsigned)f2bf(f[4]) | ((unsigned)f2bf(f[5]) << 16); w.w = (unsigned)f2bf(f[6]) | ((unsigned)f2bf(f[7]) << 16); *(uint4*)p = w; }
constexpr int DM = 2048, SEQ = 4096, NBP = 2, MP = NBP * SEQ, SB = 32, ST = 8, MS = SB * ST, M = MP + MS, DEPTH = 4;
constexpr int NROWB = NBP + SB;
constexpr int NH = 16, HDIM = 64, NKV = 4, WIN = 128, BRW = 1024, CONVK = 31, CPRE = 30, PPAD = 15, RH = 8, RDK = 64, RDV = 128, DFF = 8192;
constexpr int ZW = 15872, ZQ = 0, ZK = 1024, ZV = 1280, ZCA = 1536, ZCG = 2560, ZPL = 3584, ZRQ = 4608, ZRK = 5120, ZRV = 5632, ZRG = 6656, ZGT = 7680;
constexpr int ADAW = 6 * DM;
constexpr float EPS = 1e-6f;
constexpr size_t O_YP = 0, O_YS = O_YP + (size_t)MP * DM, O_KP = O_YS + (size_t)MS * DM, O_VP = O_KP + (size_t)DEPTH * NBP * WIN * 256,
    O_CP = O_VP + (size_t)DEPTH * NBP * WIN * 256, O_PP = O_CP + (size_t)DEPTH * NBP * CPRE * BRW, O_RP = O_PP + (size_t)DEPTH * NBP * PPAD * BRW,
    O_KS = O_RP + (size_t)DEPTH * NBP * RH * RDK * RDV, O_VS = O_KS + (size_t)DEPTH * SB * WIN * 256, O_CS = O_VS + (size_t)DEPTH * SB * WIN * 256,
    O_PS = O_CS + (size_t)DEPTH * SB * CPRE * BRW, O_RS = O_PS + (size_t)DEPTH * SB * PPAD * BRW, O_END = O_RS + (size_t)DEPTH * SB * RH * RDK * RDV;
static_assert(O_END == 41394176, "output size");
enum { I_XP = 0, I_XS, I_CP, I_CS, I_CK, I_CV, I_SCONV, I_SPOOL, I_SRET, I_WADA, I_BADA, I_G1, I_G2, I_WIN, I_GQ, I_GK, I_SINK, I_WDW, I_BDW, I_GCLN, I_BCLN,
       I_WPOOL, I_SPOOLS, I_GRET, I_WBR, I_WOUT, I_WM1, I_WM2, N_IN };

HD bool row_is_s(int row) { return row >= MP; }
HD int row_cond(int row) { return row < MP ? (row >> 12) : NBP + ((row - MP) >> 3); }

#if defined(__HIP_DEVICE_COMPILE__)
#define FEXP(x) __expf(x)
#else
#define FEXP(x) expf(x)
#endif
#if defined(__HIP_DEVICE_COMPILE__)
HD float sigmoidf_(float x) { return __builtin_amdgcn_rcpf(1.f + __expf(-x)); }
#else
HD float sigmoidf_(float x) { return 1.f / (1.f + FEXP(-x)); }
#endif
HD float ret_logg(int h) { const float x = __builtin_bit_cast(float, (unsigned)(127 - 5 - h) << 23); return -x * (1.f + x * (0.5f + x * (0.33333334f + x * (0.25f + x * 0.2f)))); }

HD void qknorm_item(bf16* Z, int l, int row, int slot, const float* gq, const float* gk, float* out) {
    const int col = slot < 16 ? ZQ + slot * 64 : (slot < 20 ? ZK + (slot - 16) * 64 : ZV + (slot - 20) * 64);
    bf16* p = Z + (size_t)row * ZW + col;
    float v[64];
#pragma unroll
    for (int i = 0; i < 64; i += 8) ld8(p + i, v + i);
    if (slot < 20) {
        float ss = 0.f;
#pragma unroll
        for (int i = 0; i < 64; ++i) ss += v[i] * v[i];
        const float r = 1.f / sqrtf(ss * (1.f / 64.f) + EPS);
        const float* g = (slot < 16 ? gq : gk) + l * 64;
#pragma unroll
        for (int i = 0; i < 64; ++i) v[i] = v[i] * r * g[i];
#pragma unroll
        for (int i = 0; i < 64; i += 8) st8(p + i, v + i);
    }
    if (slot >= 16) {
        const int kvh = (slot - 16) & 3; const bool isv = slot >= 20;
        float* o = nullptr;
        if (!row_is_s(row)) { const int b = row >> 12, t = row & (SEQ - 1);
            if (t >= SEQ - WIN) o = out + (isv ? O_VP : O_KP) + ((((size_t)l * NBP + b) * WIN + (t - (SEQ - WIN))) * NKV + kvh) * 64;
        } else { const int sb = (row - MP) >> 3, t = (row - MP) & 7;
            o = out + (isv ? O_VS : O_KS) + ((((size_t)l * SB + sb) * WIN + (WIN - ST + t)) * NKV + kvh) * 64; }
        if (o) {
#pragma unroll
            for (int i = 0; i < 64; ++i) o[i] = v[i];
        }
    }
}
HD void shift_addr(int l, int idx, const float* ck, const float* cv, const float* sconv, const float* spool, float* out, const float*& src, float*& dst) {
    constexpr int NKVS = SB * (WIN - ST) * 64, NCV = SB * (CPRE - ST) * 256, NPL = SB * (PPAD - ST) * 256;
    if (idx < 2 * NKVS) { const bool isv = idx >= NKVS; const int i = isv ? idx - NKVS : idx; const int sb = i / ((WIN - ST) * 64), rem = i % ((WIN - ST) * 64);
        src = (isv ? cv : ck) + (((size_t)l * SB + sb) * WIN + ST) * 256 + (size_t)rem * 4; dst = out + (isv ? O_VS : O_KS) + (((size_t)l * SB + sb) * WIN) * 256 + (size_t)rem * 4;
    } else if (idx < 2 * NKVS + NCV) { const int i = idx - 2 * NKVS; const int sb = i / ((CPRE - ST) * 256), rem = i % ((CPRE - ST) * 256);
        src = sconv + (((size_t)l * SB + sb) * CPRE + ST) * BRW + (size_t)rem * 4; dst = out + O_CS + (((size_t)l * SB + sb) * CPRE) * BRW + (size_t)rem * 4;
    } else { const int i = idx - 2 * NKVS - NCV; const int sb = i / ((PPAD - ST) * 256), rem = i % ((PPAD - ST) * 256);
        src = spool + (((size_t)l * SB + sb) * PPAD + ST) * BRW + (size_t)rem * 4; dst = out + O_PS + (((size_t)l * SB + sb) * PPAD) * BRW + (size_t)rem * 4; }
}
HD void shift_item(int l, int idx, const float* ck, const float* cv, const float* sconv, const float* spool, float* out) {
    const float* src; float* dst; shift_addr(l, idx, ck, cv, sconv, spool, out, src, dst);
    dst[0] = src[0]; dst[1] = src[1]; dst[2] = src[2]; dst[3] = src[3];
}
constexpr int N_SHIFT_ITEMS = 2 * SB * (WIN - ST) * 64 + SB * (CPRE - ST) * 256 + SB * (PPAD - ST) * 256;

HD float glu_at(const bf16* Z, int row, int c) { const bf16* p = Z + (size_t)row * ZW; return bf2f(p[ZCA + c]) * sigmoidf_(bf2f(p[ZCG + c])); }
HD void conv_item(const bf16* Z, int l, int row, int c, const float* wdw, const float* bdw, const float* sconv, float* CONVY, float* out) {
    float acc = bdw[l * BRW + c];
    const float* w = wdw + (size_t)l * CONVK * BRW + c;
    if (!row_is_s(row)) { const int b = row >> 12, t = row & (SEQ - 1);
        for (int j = 0; j < CONVK; ++j) { const int tt = t - CPRE + j; if (tt >= 0) acc += w[(size_t)j * BRW] * glu_at(Z, b * SEQ + tt, c); }
        if (t >= SEQ - CPRE) out[O_CP + (((size_t)l * NBP + b) * CPRE + (t - (SEQ - CPRE))) * BRW + c] = glu_at(Z, row, c);
    } else { const int sb = (row - MP) >> 3, t = (row - MP) & 7;
        for (int j = 0; j < CONVK; ++j) { const int tt = t - CPRE + j;
            const float u = tt >= 0 ? glu_at(Z, MP + sb * ST + tt, c) : sconv[(((size_t)l * SB + sb) * CPRE + (CPRE + tt)) * BRW + c];
            acc += w[(size_t)j * BRW] * u; }
        out[O_CS + (((size_t)l * SB + sb) * CPRE + (CPRE - ST + t)) * BRW + c] = glu_at(Z, row, c);
    }
    CONVY[(size_t)row * BRW + c] = acc;
}
HD void pool_item(const bf16* Z, int l, int row, int c, const float* spool, bf16* ZP, float* out) {
    const int g = c >> 8, w = 2 << g;
    const float u0 = bf2f(Z[(size_t)row * ZW + ZPL + c]);
    float sum = 0.f, cnt;
    if (!row_is_s(row)) { const int b = row >> 12, t = row & (SEQ - 1);
        for (int i = 0; i < w; ++i) if (t - i >= 0) sum += bf2f(Z[(size_t)(b * SEQ + t - i) * ZW + ZPL + c]);
        cnt = (float)((t + 1) < w ? (t + 1) : w);
        if (t >= SEQ - PPAD) out[O_PP + (((size_t)l * NBP + b) * PPAD + (t - (SEQ - PPAD))) * BRW + c] = u0;
    } else { const int sb = (row - MP) >> 3, t = (row - MP) & 7;
        for (int i = 0; i < w; ++i) { const int tt = t - i;
            sum += tt >= 0 ? bf2f(Z[(size_t)(MP + sb * ST + tt) * ZW + ZPL + c]) : spool[(((size_t)l * SB + sb) * PPAD + (PPAD + tt)) * BRW + c]; }
        cnt = (float)w;
        out[O_PS + (((size_t)l * SB + sb) * PPAD + (PPAD - ST + t)) * BRW + c] = u0;
    }
    ZP[(size_t)row * BRW + c] = f2bf(sum / cnt - u0);
}
HD void retkv_item(const bf16* Z, float* KV, int b, int n, int h, int d, int v4) {
    const float lg = ret_logg(h);
    float a0 = 0.f, a1 = 0.f, a2 = 0.f, a3 = 0.f;
    for (int j = 0; j < 128; ++j) { const bf16* p = Z + (size_t)(b * SEQ + n * 128 + j) * ZW;
        const float kd = bf2f(p[ZRK + h * 64 + d]) * 0.125f * FEXP(lg * (float)(127 - j));
        const bf16* pv = p + ZRV + h * 128 + v4 * 4;
        a0 += kd * bf2f(pv[0]); a1 += kd * bf2f(pv[1]); a2 += kd * bf2f(pv[2]); a3 += kd * bf2f(pv[3]); }
    float* o = KV + ((((size_t)b * 32 + n) * RH + h) * RDK + d) * RDV + v4 * 4;
    o[0] = a0; o[1] = a1; o[2] = a2; o[3] = a3;
}
HD void retstate_s_item(const bf16* Z, int l, int sb, int h, int d, int v4, const float* sret, float* out) {
    const float lg = ret_logg(h);
    const size_t so = ((((size_t)l * SB + sb) * RH + h) * RDK + d) * RDV + v4 * 4;
    const float gc = FEXP(lg * (float)ST);
    float a0 = gc * sret[so], a1 = gc * sret[so + 1], a2 = gc * sret[so + 2], a3 = gc * sret[so + 3];
#pragma unroll
    for (int j = 0; j < ST; ++j) { const bf16* p = Z + (size_t)(MP + sb * ST + j) * ZW;
        const float kd = bf2f(p[ZRK + h * 64 + d]) * 0.125f * FEXP(lg * (float)(ST - 1 - j));
        const bf16* pv = p + ZRV + h * 128 + v4 * 4;
        a0 += kd * bf2f(pv[0]); a1 += kd * bf2f(pv[1]); a2 += kd * bf2f(pv[2]); a3 += kd * bf2f(pv[3]); }
    float* o = out + O_RS + so; o[0] = a0; o[1] = a1; o[2] = a2; o[3] = a3;
}
HD void retscan_item(const float* KV, float* SPREV, int l, int b, int h, int d, int v4, float* out) {
    const float gc = FEXP(ret_logg(h) * 128.f);
    float s0 = 0.f, s1 = 0.f, s2 = 0.f, s3 = 0.f;
    for (int n = 0; n < 32; ++n) { const size_t o = ((((size_t)b * 32 + n) * RH + h) * RDK + d) * RDV + v4 * 4;
        SPREV[o] = s0; SPREV[o + 1] = s1; SPREV[o + 2] = s2; SPREV[o + 3] = s3;
        s0 = gc * s0 + KV[o]; s1 = gc * s1 + KV[o + 1]; s2 = gc * s2 + KV[o + 2]; s3 = gc * s3 + KV[o + 3]; }
    float* oo = out + O_RP + ((((size_t)l * NBP + b) * RH + h) * RDK + d) * RDV + v4 * 4;
    oo[0] = s0; oo[1] = s1; oo[2] = s2; oo[3] = s3;
}
HD void attn_item(const bf16* Z, int l, int row, int hq, const float* sinks, const float* ck, const float* cv, bf16* Y0) {
    const int kvh = hq >> 2; const float slope = exp2f(-0.5f * (float)(hq + 1));
    float q[64];
    { const bf16* p = Z + (size_t)row * ZW + ZQ + hq * 64;
#pragma unroll
      for (int i = 0; i < 64; i += 8) ld8(p + i, q + i);
#pragma unroll
      for (int i = 0; i < 64; ++i) q[i] *= 0.125f; }
    float m = sinks[l * NH + hq], lsum = 1.f;
    float o[64];
#pragma unroll
    for (int i = 0; i < 64; ++i) o[i] = 0.f;
    const bool smp = row_is_s(row);
    const int b = smp ? ((row - MP) >> 3) : (row >> 12), t = smp ? ((row - MP) & 7) : (row & (SEQ - 1));
    const int lo = smp ? t : (t - WIN > 0 ? t - WIN : 0), hi = smp ? WIN + t : t;
    for (int j = lo; j <= hi; ++j) {
        const int dist = smp ? (WIN + t - j) : (t - j);
        const bool cache = smp && j < WIN;
        const size_t zrow = (size_t)(smp ? (MP + b * ST + (j - WIN)) : (b * SEQ + j)) * ZW;
        const size_t crow = ((((size_t)l * SB + b) * WIN + j) * NKV + kvh) * 64;
        float s = 0.f;
        if (cache) { const float* kp = ck + crow;
#pragma unroll
            for (int i = 0; i < 64; ++i) s += q[i] * kp[i];
        } else { const bf16* kp = Z + zrow + ZK + kvh * 64;
#pragma unroll
            for (int i = 0; i < 64; i += 8) { float f[8]; ld8(kp + i, f);
#pragma unroll
                for (int e = 0; e < 8; ++e) s += q[i + e] * f[e]; } }
        s -= slope * (float)dist;
        if (s > m) { const float corr = FEXP(m - s); lsum *= corr;
#pragma unroll
            for (int i = 0; i < 64; ++i) o[i] *= corr;
            m = s; }
        const float p = FEXP(s - m); lsum += p;
        if (cache) { const float* vp = cv + crow;
#pragma unroll
            for (int i = 0; i < 64; ++i) o[i] += p * vp[i];
        } else { const bf16* vp = Z + zrow + ZV + kvh * 64;
#pragma unroll
            for (int i = 0; i < 64; i += 8) { float f[8]; ld8(vp + i, f);
#pragma unroll
                for (int e = 0; e < 8; ++e) o[i + e] += p * f[e]; } }
    }
    const float inv = 1.f / lsum;
    bf16* y = Y0 + (size_t)row * BRW + hq * 64;
#pragma unroll
    for (int i = 0; i < 64; ++i) o[i] *= inv;
#pragma unroll
    for (int i = 0; i < 64; i += 8) st8(y + i, o + i);
}
HD void retout_item(const bf16* Z, int l, int row, int h, const float* SPREV, const float* sret, const float* gret, float* ORAW, bf16* Y3) {
    const float lg = ret_logg(h);
    const bool smp = row_is_s(row);
    const int b = smp ? ((row - MP) >> 3) : (row >> 12), t = smp ? ((row - MP) & 7) : (row & (SEQ - 1));
    const int i = smp ? t : (t & 127), n = smp ? 0 : (t >> 7);
    const int row0 = smp ? (MP + b * ST) : (b * SEQ + n * 128);
    const float* S = smp ? sret + (((size_t)l * SB + b) * RH + h) * RDK * RDV : SPREV + (((size_t)b * 32 + n) * RH + h) * RDK * RDV;
    float q[64];
    { const bf16* p = Z + (size_t)row * ZW + ZRQ + h * 64;
#pragma unroll
      for (int d = 0; d < 64; d += 8) ld8(p + d, q + d); }
    float* oraw = ORAW + (size_t)row * BRW + h * 128;
    float sum = 0.f;
    for (int half = 0; half < 2; ++half) {
        float o[64];
#pragma unroll
        for (int v = 0; v < 64; ++v) o[v] = 0.f;
        for (int j = 0; j <= i; ++j) { const bf16* p = Z + (size_t)(row0 + j) * ZW;
            const bf16* kp = p + ZRK + h * 64; float s = 0.f;
#pragma unroll
            for (int d = 0; d < 64; d += 8) { float f[8]; ld8(kp + d, f);
#pragma unroll
                for (int e = 0; e < 8; ++e) s += q[d + e] * f[e]; }
            s *= 0.125f * FEXP(lg * (float)(i - j));
            const bf16* vp = p + ZRV + h * 128 + half * 64;
#pragma unroll
            for (int v = 0; v < 64; v += 8) { float f[8]; ld8(vp + v, f);
#pragma unroll
                for (int e = 0; e < 8; ++e) o[v + e] += s * f[e]; } }
        const float cf = FEXP(lg * (float)(i + 1));
        const bf16* qp = Z + (size_t)row * ZW + ZRQ + h * 64;
        for (int d = 0; d < 64; ++d) { const float qd = bf2f(qp[d]) * cf; const float* sp = S + (size_t)d * RDV + half * 64;
#pragma unroll
            for (int v = 0; v < 64; ++v) o[v] += qd * sp[v]; }
#pragma unroll
        for (int v = 0; v < 64; ++v) { oraw[half * 64 + v] = o[v]; sum += o[v]; }
    }
    const float mean = sum * (1.f / 128.f);
    float var = 0.f;
    for (int v = 0; v < 128; ++v) { const float d = oraw[v] - mean; var += d * d; }
    const float rstd = 1.f / sqrtf(var * (1.f / 128.f) + EPS);
    const float* g = gret + l * BRW + h * 128;
    const bf16* rg = Z + (size_t)row * ZW + ZRG + h * 128;
    bf16* y = Y3 + (size_t)row * BRW + h * 128;
    for (int v = 0; v < 128; ++v) y[v] = f2bf((oraw[v] - mean) * rstd * g[v] * bf2f(rg[v]));
}

#if !defined(HOST_TEST_ONLY)
namespace pg8 {
#define PG8_LAS __attribute__((address_space(3)))
typedef short bf16x8 __attribute__((ext_vector_type(8)));
typedef float f32x4 __attribute__((ext_vector_type(4)));
typedef float f32x2 __attribute__((ext_vector_type(2)));
typedef unsigned u32x4 __attribute__((ext_vector_type(4)));
typedef unsigned u32x2 __attribute__((ext_vector_type(2)));
constexpr int BM = 256, BK = 64, HALF = 128, HTB = HALF * BK * 2, STAGE_BYTES = 8 * HTB, NXCD = 8, WGM = 8;

__host__ __device__ __forceinline__ int lds_byte(int r, int c) { const int st = (r >> 4) * 2 + (c >> 5), rr = r & 15, cc = c & 31, ob = rr * 64 + cc * 2; return st * 1024 + (ob ^ (((ob >> 9) & 1) << 5)); }
__host__ __device__ __forceinline__ void stage_rc(int b, int& R, int& C) { const int st = b / 1024, sb = b % 1024, swz = sb ^ (((sb >> 9) & 1) << 5); R = (st >> 1) * 16 + swz / 64; C = (st & 1) * 32 + (swz % 64) / 2; }
__host__ __device__ __forceinline__ int perm32(int rho) { const int n = rho >> 4, i = rho & 15; return 8 * (i >> 2) + 4 * n + (i & 3); }

struct Unit { int pm, pn, r, ks, nt; const char* a; const char* b; };
struct Dims { int lda, ldb, K; };

__host__ __device__ __forceinline__ void tile_of(int L, int nM, int nN, int& pm, int& pn) {
    const int nwg = nM * nN; int wgid = L; { const int q = nwg / NXCD, r = nwg % NXCD, xcd = wgid % NXCD, off = wgid / NXCD; wgid = (xcd < r ? xcd * (q + 1) : r * (q + 1) + (xcd - r) * q) + off; }
    const int nig = WGM * nN, gid = wgid / nig, fm = gid * WGM, gsz = (nM - fm) < WGM ? (nM - fm) : WGM;
    pm = fm + ((wgid % nig) % gsz); pn = (wgid % nig) / gsz;
}
struct StaticOrder {
    int nM, nN, nwg, G, c, nt; const char* A; const char* B; size_t ta, tb;
    __device__ __forceinline__ void init(const bf16* A_, const bf16* B_, int nM_, int nN_, int lda, int ldb, int K, int G_, int c_) { A = (const char*)A_; B = (const char*)B_; nM = nM_; nN = nN_; nwg = nM * nN; G = G_; c = c_; nt = K / BK; ta = (size_t)BM * lda * 2; tb = (size_t)BM * ldb * 2; }
    __device__ __forceinline__ bool next(int i, Unit& u) const {
        const long L = (long)i * G + c; if (L >= nwg) return false;
        tile_of((int)L, nM, nN, u.pm, u.pn); u.r = 0; u.ks = 0; u.nt = nt; u.a = A + (size_t)u.pm * ta; u.b = B + (size_t)u.pn * tb; return true;
    }
};


struct SplitOrder {
    int nN, G, c, RPT, ntP, KS, ntS; const char* A; const char* B; size_t ta, tb, sAr, sBr;
    __device__ __forceinline__ bool next(int i, Unit& u) const {
        const int nP = (MP / BM) * nN, Pc = c < nP ? (nP - c + G - 1) / G : 0;
        if (i < Pc * RPT) { const int tl = (i / RPT) * G + c; tile_of(tl, MP / BM, nN, u.pm, u.pn); u.r = i % RPT; u.ks = 0; u.nt = ntP;
            u.a = A + (size_t)u.r * sAr + (size_t)u.pm * ta; u.b = B + (size_t)u.r * sBr + (size_t)u.pn * tb; return true; }
        const int su = (i - Pc * RPT) * G + c; if (su >= nN * RPT * KS) return false;
        u.pm = MP / BM; u.pn = su / (RPT * KS); u.r = (su / KS) % RPT; u.ks = su % KS; u.nt = ntS;
        u.a = A + (size_t)u.r * sAr + (size_t)u.pm * ta + (size_t)u.ks * ntS * (BK * 2); u.b = B + (size_t)u.r * sBr + (size_t)u.pn * tb + (size_t)u.ks * ntS * (BK * 2); return true;
    }
};

__device__ __forceinline__ unsigned cvt_pk_bf16(float lo, float hi) { unsigned r; asm volatile("v_cvt_pk_bf16_f32 %0, %1, %2" : "=v"(r) : "v"(lo), "v"(hi)); return r; }

template <class Epi, class Sched, bool ALIGN_EPI = true, bool SP2 = true>
__device__ __forceinline__ void gemm_phase(PG8_LAS unsigned char* lds, const Dims g, const Sched& S, const Epi& E, const int tid) {
    const int wid = __builtin_amdgcn_readfirstlane(tid >> 6), lane = tid & 63, wr = wid >> 2, wc = wid & 3, fr = lane & 15, fq = lane >> 4;
    unsigned voffA[2], voffB[2];
#pragma unroll
    for (int i = 0; i < 2; ++i) { int R, C; stage_rc(tid * 16 + i * 8192, R, C); const int Rb = Epi::PERM ? ((R & ~31) + perm32(R & 31)) : R;
        voffA[i] = (unsigned)(R * g.lda + C) * 2u; voffB[i] = (unsigned)(Rb * g.ldb + C) * 2u; }
    const size_t kstep = (size_t)(BK * 2);
    const size_t hstepA = (size_t)HALF * g.lda * 2, hstepB = (size_t)HALF * g.ldb * 2;
    const unsigned ldsw = (unsigned)wid * 1024u;
    const int aoff = lds_byte(wr * 64 + fr, fq * 8), boff = lds_byte(wc * 32 + fr, fq * 8);
#define PG8_SA(b, h) (((b) * 2 + (h)) * HTB)
#define PG8_SB(b, h) ((4 + (b) * 2 + (h)) * HTB)
#define PG8_STAGE(bufoff, gbase, voff) do { _Pragma("unroll") for (int _i = 0; _i < 2; ++_i) \
        __builtin_amdgcn_global_load_lds((const unsigned*)((const char*)(gbase) + (voff)[_i]), (PG8_LAS unsigned*)(lds + (bufoff) + ldsw + _i * 8192), 16, 0, 0); } while (0)
#define PG8_LDA(dst, b, h) do { _Pragma("unroll") for (int m = 0; m < 4; ++m) _Pragma("unroll") for (int k = 0; k < 2; ++k) dst[m][k] = *(const PG8_LAS bf16x8*)(lds + PG8_SA(b, h) + aoff + m * 2048 + k * 1024); } while (0)
#define PG8_LDB(dst, b, h) do { _Pragma("unroll") for (int n = 0; n < 2; ++n) _Pragma("unroll") for (int k = 0; k < 2; ++k) dst[n][k] = *(const PG8_LAS bf16x8*)(lds + PG8_SB(b, h) + boff + n * 2048 + k * 1024); } while (0)
#define PG8_MMA(ai, bj, At, Bt) do { __builtin_amdgcn_s_setprio(1); _Pragma("unroll") for (int m = 0; m < 4; ++m) _Pragma("unroll") for (int n = 0; n < 2; ++n) _Pragma("unroll") for (int k = 0; k < 2; ++k) \
        acc[ai][bj][m][n] = __builtin_amdgcn_mfma_f32_16x16x32_bf16(Bt[n][k], At[m][k], acc[ai][bj][m][n], 0, 0, 0); __builtin_amdgcn_s_setprio(0); } while (0)
#define PG8_WAIT_V(n) asm volatile("s_waitcnt vmcnt(" #n ")" ::: "memory")
#define PG8_WAIT_L(n) asm volatile("s_waitcnt lgkmcnt(" #n ")" ::: "memory")
#define PG8_BAR __builtin_amdgcn_s_barrier()
#define PG8_SCHED __builtin_amdgcn_sched_barrier(0)
    Unit cur, nxt; int ui = 0;
    if (!S.next(0, cur)) return;
    f32x4 acc[2][2][4][2];
#pragma unroll
    for (int a = 0; a < 2; ++a)
#pragma unroll
        for (int b = 0; b < 2; ++b)
#pragma unroll
            for (int m = 0; m < 4; ++m)
#pragma unroll
                for (int n = 0; n < 2; ++n) acc[a][b][m][n] = (f32x4){0.f, 0.f, 0.f, 0.f};
    bf16x8 At[4][2], B0[2][2], B1[2][2];
    const char* cA = cur.a; const char* cB = cur.b;
    if constexpr (SP2) {
        PG8_STAGE(PG8_SB(0, 0), cB, voffB); PG8_STAGE(PG8_SB(0, 1), cB + hstepB, voffB); PG8_STAGE(PG8_SA(0, 0), cA, voffA); PG8_STAGE(PG8_SA(0, 1), cA + hstepA, voffA);
        if (wr == 1) PG8_BAR;
        PG8_WAIT_V(2); PG8_BAR;
        PG8_STAGE(PG8_SB(1, 0), cB + kstep, voffB); PG8_STAGE(PG8_SA(1, 0), cA + kstep, voffA); PG8_STAGE(PG8_SB(1, 1), cB + hstepB + kstep, voffB);
        PG8_WAIT_V(6); PG8_BAR;
    } else {
        PG8_STAGE(PG8_SB(0, 0), cB, voffB); PG8_STAGE(PG8_SA(0, 0), cA, voffA); PG8_STAGE(PG8_SB(0, 1), cB + hstepB, voffB); PG8_STAGE(PG8_SA(0, 1), cA + hstepA, voffA);
        if (wr == 1) PG8_BAR;
        PG8_WAIT_V(4); PG8_BAR;
        PG8_STAGE(PG8_SB(1, 0), cB + kstep, voffB); PG8_STAGE(PG8_SA(1, 0), cA + kstep, voffA); PG8_STAGE(PG8_SB(1, 1), cB + hstepB + kstep, voffB);
        PG8_WAIT_V(6); PG8_BAR;
    }
    for (;;) {
        const bool has_next = S.next(ui + 1, nxt);
        const char* nA = has_next ? nxt.a : cA; const char* nB = has_next ? nxt.b : cB;
        const int nt = cur.nt;
        for (int t = 0; t < nt; t += 2) {
            const bool last = (t == nt - 2);
            const char* a1 = cA + (size_t)(t + 1) * kstep;
            const char* a2 = last ? nA : cA + (size_t)(t + 2) * kstep; const char* b2 = last ? nB : cB + (size_t)(t + 2) * kstep;
            const char* a3 = a2 + kstep; const char* b3 = b2 + kstep;
            if constexpr (SP2) {
            PG8_LDB(B0, 0, 0); PG8_LDB(B1, 0, 1); PG8_SCHED; PG8_LDA(At, 0, 0); PG8_STAGE(PG8_SA(1, 1), a1 + hstepA, voffA);
            PG8_WAIT_V(8); PG8_WAIT_L(0); PG8_BAR; PG8_MMA(0, 0, At, B0); PG8_MMA(0, 1, At, B1); PG8_BAR; PG8_SCHED;
            PG8_LDA(At, 0, 1); PG8_STAGE(PG8_SB(0, 0), b2, voffB); PG8_STAGE(PG8_SB(0, 1), b2 + hstepB, voffB); PG8_STAGE(PG8_SA(0, 0), a2, voffA);
            PG8_WAIT_V(8); PG8_WAIT_L(0); PG8_BAR; PG8_MMA(1, 0, At, B0); PG8_MMA(1, 1, At, B1); PG8_BAR; PG8_SCHED;
            PG8_LDB(B0, 1, 0); PG8_LDB(B1, 1, 1); PG8_SCHED; PG8_LDA(At, 1, 0); PG8_STAGE(PG8_SA(0, 1), a2 + hstepA, voffA);
            PG8_WAIT_V(8); PG8_WAIT_L(0); PG8_BAR; PG8_MMA(0, 0, At, B0); PG8_MMA(0, 1, At, B1); PG8_BAR; PG8_SCHED;
            PG8_LDA(At, 1, 1); PG8_STAGE(PG8_SB(1, 0), b3, voffB); PG8_STAGE(PG8_SB(1, 1), b3 + hstepB, voffB); PG8_STAGE(PG8_SA(1, 0), a3, voffA);
            PG8_WAIT_V(8); PG8_WAIT_L(0); PG8_BAR; PG8_MMA(1, 0, At, B0); PG8_MMA(1, 1, At, B1); PG8_BAR; PG8_SCHED;
            } else {
            PG8_LDB(B0, 0, 0); PG8_SCHED; PG8_LDA(At, 0, 0); PG8_STAGE(PG8_SA(1, 1), a1 + hstepA, voffA);
            PG8_WAIT_L(8); PG8_BAR; PG8_WAIT_L(0); PG8_MMA(0, 0, At, B0); PG8_BAR; PG8_SCHED;
            PG8_LDB(B1, 0, 1); PG8_STAGE(PG8_SB(0, 0), b2, voffB);
            PG8_BAR; PG8_WAIT_L(0); PG8_MMA(0, 1, At, B1); PG8_BAR;
            PG8_LDA(At, 0, 1); PG8_STAGE(PG8_SA(0, 0), a2, voffA);
            PG8_BAR; PG8_WAIT_L(0); PG8_MMA(1, 0, At, B0); PG8_BAR; PG8_SCHED;
            PG8_STAGE(PG8_SB(0, 1), b2 + hstepB, voffB);
            PG8_WAIT_V(6); PG8_BAR; PG8_MMA(1, 1, At, B1); PG8_BAR;
            PG8_LDB(B0, 1, 0); PG8_SCHED; PG8_LDA(At, 1, 0); PG8_STAGE(PG8_SA(0, 1), a2 + hstepA, voffA);
            PG8_WAIT_L(8); PG8_BAR; PG8_WAIT_L(0); PG8_MMA(0, 0, At, B0); PG8_BAR; PG8_SCHED;
            PG8_LDB(B1, 1, 1); PG8_STAGE(PG8_SB(1, 0), b3, voffB);
            PG8_BAR; PG8_WAIT_L(0); PG8_MMA(0, 1, At, B1); PG8_BAR;
            PG8_LDA(At, 1, 1); PG8_STAGE(PG8_SA(1, 0), a3, voffA);
            PG8_BAR; PG8_WAIT_L(0); PG8_MMA(1, 0, At, B0); PG8_BAR; PG8_SCHED;
            PG8_STAGE(PG8_SB(1, 1), b3 + hstepB, voffB);
            PG8_WAIT_V(6); PG8_BAR; PG8_MMA(1, 1, At, B1); PG8_BAR;
            }
        }
        if constexpr (ALIGN_EPI) { if (wr == 0) PG8_BAR; }
        bool keep; { int ln; asm volatile("v_mbcnt_lo_u32_b32 %0, -1, 0\n\tv_mbcnt_hi_u32_b32 %0, -1, %0" : "=v"(ln)); keep = E(acc, cur, wr, wc, ln & 15, ln >> 4); }
        if (!has_next) break;
        if (!keep)
#pragma unroll
        for (int a = 0; a < 2; ++a)
#pragma unroll
            for (int b = 0; b < 2; ++b)
#pragma unroll
                for (int m = 0; m < 4; ++m)
#pragma unroll
                    for (int n = 0; n < 2; ++n) acc[a][b][m][n] = (f32x4){0.f, 0.f, 0.f, 0.f};
        cur = nxt; cA = nA; cB = nB; ++ui;
        if constexpr (ALIGN_EPI) { if (wr == 1) PG8_BAR; }
    }
    PG8_WAIT_V(0);
    if constexpr (!ALIGN_EPI) { if (wr == 0) PG8_BAR; }
    PG8_BAR;
#undef PG8_SA
#undef PG8_SB
#undef PG8_STAGE
#undef PG8_LDA
#undef PG8_LDB
#undef PG8_MMA
#undef PG8_WAIT_V
#undef PG8_WAIT_L
#undef PG8_BAR
#undef PG8_SCHED
}

__device__ __forceinline__ float fsigmoid(float x) { return __builtin_amdgcn_rcpf(1.f + __expf(-x)); }
struct EpiZ {
    static constexpr bool PERM = true;
    bf16* Z;
    __device__ __forceinline__ bool operator()(f32x4 (&acc)[2][2][4][2], const Unit& u, int wr, int wc, int fr, int fq) const {
        const int row0 = u.pm * BM + wr * 64 + fr, col0 = u.pn * BM + wc * 32 + 8 * fq;
        const int ty = u.pn >= 30 ? 2 : (u.pn >= 26 ? 1 : 0);
        if (u.pn >= 6 && u.pn < 14) {
            const int colg = ZCA + (u.pn - 6) * 128 + wc * 32 + 8 * fq;
#pragma unroll
            for (int ai = 0; ai < 2; ++ai)
#pragma unroll
                for (int m = 0; m < 4; ++m) { f32x4 a0 = acc[ai][0][m][0], a1 = acc[ai][0][m][1]; const f32x4 g0 = acc[ai][1][m][0], g1 = acc[ai][1][m][1];
#pragma unroll
                    for (int j = 0; j < 4; ++j) { a0[j] = a0[j] * fsigmoid(g0[j]); a1[j] = a1[j] * fsigmoid(g1[j]); }
                    u32x4 w; w.x = cvt_pk_bf16(a0[0], a0[1]); w.y = cvt_pk_bf16(a0[2], a0[3]); w.z = cvt_pk_bf16(a1[0], a1[1]); w.w = cvt_pk_bf16(a1[2], a1[3]);
                    *(u32x4*)(Z + (size_t)(row0 + ai * HALF + m * 16) * ZW + colg) = w; }
            return false;
        }
#pragma unroll
        for (int ai = 0; ai < 2; ++ai)
#pragma unroll
            for (int m = 0; m < 4; ++m) { bf16* rowp = Z + (size_t)(row0 + ai * HALF + m * 16) * ZW + col0;
#pragma unroll
                for (int bj = 0; bj < 2; ++bj) { f32x4 v0 = acc[ai][bj][m][0], v1 = acc[ai][bj][m][1];
                    if (ty == 2) {
#pragma unroll
                        for (int j = 0; j < 4; ++j) { v0[j] = fsigmoid(v0[j]); v1[j] = fsigmoid(v1[j]); } }
                    else if (ty == 1) {
#pragma unroll
                        for (int j = 0; j < 4; ++j) { v0[j] = v0[j] * fsigmoid(v0[j]); v1[j] = v1[j] * fsigmoid(v1[j]); } }
                    u32x4 w; w.x = cvt_pk_bf16(v0[0], v0[1]); w.y = cvt_pk_bf16(v0[2], v0[3]); w.z = cvt_pk_bf16(v1[0], v1[1]); w.w = cvt_pk_bf16(v1[2], v1[3]);
                    *(u32x4*)(rowp + bj * HALF) = w; } }
        return false;
    }
};
struct EpiMlp1 {
    static constexpr bool PERM = true;
    bf16* O; float* SLAB;
    __device__ __forceinline__ bool operator()(f32x4 (&acc)[2][2][4][2], const Unit& u, int wr, int wc, int fr, int fq) const {
        const int row0 = u.pm * BM + wr * 64 + fr, col0 = u.pn * BM + wc * 32 + 8 * fq;
        if (u.pm == MP / BM) { float* sl = SLAB + ((size_t)u.ks * BM + wr * 64 + fr) * DFF + col0;
#pragma unroll
            for (int ai = 0; ai < 2; ++ai)
#pragma unroll
                for (int m = 0; m < 4; ++m)
#pragma unroll
                    for (int bj = 0; bj < 2; ++bj) { float* p = sl + (size_t)(ai * HALF + m * 16) * DFF + bj * HALF; *(f32x4*)p = acc[ai][bj][m][0]; *(f32x4*)(p + 4) = acc[ai][bj][m][1]; }
            return false; }
#pragma unroll
        for (int ai = 0; ai < 2; ++ai)
#pragma unroll
            for (int m = 0; m < 4; ++m) { bf16* rowp = O + (size_t)(row0 + ai * HALF + m * 16) * DFF + col0;
#pragma unroll
                for (int bj = 0; bj < 2; ++bj) { f32x4 v0 = acc[ai][bj][m][0], v1 = acc[ai][bj][m][1];
#pragma unroll
                    for (int j = 0; j < 4; ++j) { const float a = fmaxf(v0[j], 0.f), b = fmaxf(v1[j], 0.f); v0[j] = a * a; v1[j] = b * b; }
                    u32x4 w; w.x = cvt_pk_bf16(v0[0], v0[1]); w.y = cvt_pk_bf16(v0[2], v0[3]); w.z = cvt_pk_bf16(v1[0], v1[1]); w.w = cvt_pk_bf16(v1[2], v1[3]);
                    *(u32x4*)(rowp + bj * HALF) = w; } }
        return false;
    }
};
struct EpiPool {
    static constexpr bool PERM = true;
    bf16* Y2; const float* spb; int l;
    __device__ __forceinline__ bool operator()(f32x4 (&acc)[2][2][4][2], const Unit& u, int wr, int wc, int fr, int fq) const {
        const int row0 = u.pm * BM + wr * 64 + fr, col0 = u.pn * BM + wc * 32 + 8 * fq;
        int le = l; asm volatile("" : "+s"(le)); const float* sp = spb + le * BRW;
        f32x4 s[2][2];
#pragma unroll
        for (int bj = 0; bj < 2; ++bj)
#pragma unroll
            for (int n = 0; n < 2; ++n) s[bj][n] = *(const f32x4*)(sp + col0 + bj * HALF + 4 * n);
#pragma unroll
        for (int ai = 0; ai < 2; ++ai)
#pragma unroll
            for (int m = 0; m < 4; ++m) { bf16* rowp = Y2 + (size_t)(row0 + ai * HALF + m * 16) * BRW + col0;
#pragma unroll
                for (int bj = 0; bj < 2; ++bj) { const f32x4 v0 = acc[ai][bj][m][0] * s[bj][0], v1 = acc[ai][bj][m][1] * s[bj][1];
                    u32x4 w; w.x = cvt_pk_bf16(v0[0], v0[1]); w.y = cvt_pk_bf16(v0[2], v0[3]); w.z = cvt_pk_bf16(v1[0], v1[1]); w.w = cvt_pk_bf16(v1[2], v1[3]);
                    *(u32x4*)(rowp + bj * HALF) = w; } }
        return false;
    }
};
struct EpiAda {
    static constexpr bool PERM = false;
    float* ADA; const float* bada;
    __device__ __forceinline__ bool operator()(f32x4 (&acc)[2][2][4][2], const Unit& u, int wr, int wc, int fr, int fq) const {
        if (wr != 0) return false;
        const int col0 = u.pn * BM + wc * 32 + 4 * fq;
#pragma unroll
        for (int m = 0; m < 3; ++m) { const int row = m * 16 + fr;
            if (row < NROWB) {
#pragma unroll
                for (int bj = 0; bj < 2; ++bj)
#pragma unroll
                    for (int n = 0; n < 2; ++n) { const int c = col0 + bj * HALF + n * 16; const f32x4 bv = *(const f32x4*)(bada + (size_t)u.r * ADAW + c);
                        *(f32x4*)(ADA + ((size_t)u.r * NROWB + row) * ADAW + c) = acc[0][bj][m][n] + bv; } } }
        return false;
    }
};
struct EpiBr {
    static constexpr bool PERM = true;
    const bf16* Z; bf16* MERGED; float* SLAB; int KS;
    static __device__ __forceinline__ void unp8(const u32x4 gw, f32x4& g0, f32x4& g1) { const float T = 8.6736174e-19f;
        g0[0] = fmaxf(__builtin_bit_cast(float, gw.x << 16), T); g0[1] = fmaxf(__builtin_bit_cast(float, gw.x & 0xffff0000u), T); g0[2] = fmaxf(__builtin_bit_cast(float, gw.y << 16), T); g0[3] = fmaxf(__builtin_bit_cast(float, gw.y & 0xffff0000u), T);
        g1[0] = fmaxf(__builtin_bit_cast(float, gw.z << 16), T); g1[1] = fmaxf(__builtin_bit_cast(float, gw.z & 0xffff0000u), T); g1[2] = fmaxf(__builtin_bit_cast(float, gw.w << 16), T); g1[3] = fmaxf(__builtin_bit_cast(float, gw.w & 0xffff0000u), T); }
    __device__ __forceinline__ bool operator()(f32x4 (&acc)[2][2][4][2], const Unit& u, int wr, int wc, int fr, int fq) const {
        const int row0 = u.pm * BM + wr * 64 + fr, col0 = u.pn * BM + wc * 32 + 8 * fq;
        const int r = u.r; const bool smp = u.pm == MP / BM;
        const bf16* gbase = Z + (size_t)row0 * ZW + ZGT + r * DM + col0;
#pragma unroll
        for (int ai = 0; ai < 2; ++ai) {
            u32x4 ga[4][2], gb[4][2];
#pragma unroll
            for (int m = 0; m < 4; ++m)
#pragma unroll
                for (int bj = 0; bj < 2; ++bj) { const bf16* gp = gbase + (size_t)(ai * HALF + m * 16) * ZW + bj * HALF; ga[m][bj] = *(const u32x4*)gp; gb[m][bj] = *(const u32x4*)(gp + DM); }
            asm volatile("" ::: "memory");
#pragma unroll
            for (int m = 0; m < 4; ++m)
#pragma unroll
                for (int bj = 0; bj < 2; ++bj) { const size_t row = (size_t)(row0 + ai * HALF + m * 16); const int c = col0 + bj * HALF;
                    f32x4 g0, g1; unp8(ga[m][bj], g0, g1);
                    if (smp) { float* sp = SLAB + ((size_t)(r * KS + u.ks) * BM + (row - MP)) * DM + c; *(f32x4*)sp = acc[ai][bj][m][0] * g0; *(f32x4*)(sp + 4) = acc[ai][bj][m][1] * g1; }
                    else if (r < 3) { f32x4 n0, n1; unp8(gb[m][bj], n0, n1);
#pragma unroll
                        for (int j = 0; j < 4; ++j) { acc[ai][bj][m][0][j] *= g0[j] * __builtin_amdgcn_rcpf(n0[j]); acc[ai][bj][m][1][j] *= g1[j] * __builtin_amdgcn_rcpf(n1[j]); } }
                    else { const f32x4 v0 = acc[ai][bj][m][0] * g0, v1 = acc[ai][bj][m][1] * g1;
                        u32x4 w; w.x = cvt_pk_bf16(v0[0], v0[1]); w.y = cvt_pk_bf16(v0[2], v0[3]); w.z = cvt_pk_bf16(v1[0], v1[1]); w.w = cvt_pk_bf16(v1[2], v1[3]);
                        *(u32x4*)(MERGED + row * DM + c) = w; } }
        }
        return !smp && r < 3;
    }
};
struct EpiRes {
    static constexpr bool PERM = false;
    const float* baseP; const float* baseS; float* out; const float* gate; float* SLAB;
    __device__ __forceinline__ bool operator()(f32x4 (&acc)[2][2][4][2], const Unit& u, int wr, int wc, int fr, int fq) const {
        const int rl0 = wr * 64 + fr, col0 = u.pn * BM + wc * 32 + 4 * fq;
        const bool smp = u.pm >= MP / BM;
        if (smp) { float* sl = SLAB + ((size_t)u.ks * BM + rl0) * DM + col0;
#pragma unroll
            for (int ai = 0; ai < 2; ++ai)
#pragma unroll
                for (int m = 0; m < 4; ++m)
#pragma unroll
                    for (int bj = 0; bj < 2; ++bj)
#pragma unroll
                        for (int n = 0; n < 2; ++n) *(f32x4*)(sl + (size_t)(ai * HALF + m * 16) * DM + bj * HALF + n * 16) = acc[ai][bj][m][n];
            return false; }
        const float* base = baseP + (size_t)u.pm * BM * DM + (size_t)rl0 * DM + col0;
        float* o = out + (size_t)u.pm * BM * DM + (size_t)rl0 * DM + col0;
        const float* gp = gate + (size_t)(u.pm >> 4) * ADAW + col0;
        f32x4 gv[2][2];
#pragma unroll
        for (int bj = 0; bj < 2; ++bj)
#pragma unroll
            for (int n = 0; n < 2; ++n) gv[bj][n] = *(const f32x4*)(gp + bj * HALF + n * 16);
#pragma unroll
        for (int ai = 0; ai < 2; ++ai) {
            f32x4 bs[4][2][2];
#pragma unroll
            for (int m = 0; m < 4; ++m)
#pragma unroll
                for (int bj = 0; bj < 2; ++bj)
#pragma unroll
                    for (int n = 0; n < 2; ++n) bs[m][bj][n] = *(const f32x4*)(base + (size_t)(ai * HALF + m * 16) * DM + bj * HALF + n * 16);
            asm volatile("" ::: "memory");
#pragma unroll
            for (int m = 0; m < 4; ++m)
#pragma unroll
                for (int bj = 0; bj < 2; ++bj)
#pragma unroll
                    for (int n = 0; n < 2; ++n) *(f32x4*)(o + (size_t)(ai * HALF + m * 16) * DM + bj * HALF + n * 16) = bs[m][bj][n] + gv[bj][n] * acc[ai][bj][m][n];
        }
        return false;
    }
};
}

constexpr int NWAVES = 8, NTHR = NWAVES * 64;
constexpr size_t MiB = 1u << 20;
constexpr size_t al1(size_t x) { return (x + MiB - 1) / MiB * MiB; }
constexpr size_t WS_CTL = 0, CTL_ZERO_BYTES = 1 * MiB;
constexpr size_t WS_WIN = WS_CTL + CTL_ZERO_BYTES;
constexpr size_t WS_WBR = WS_WIN + al1((size_t)DEPTH * ZW * DM * 2);
constexpr size_t WS_WOUT = WS_WBR + al1((size_t)DEPTH * 4 * DM * BRW * 2);
constexpr size_t WS_WM1 = WS_WOUT + al1((size_t)DEPTH * DM * DM * 2);
constexpr size_t WS_WM2 = WS_WM1 + al1((size_t)DEPTH * DFF * DM * 2);
constexpr size_t WS_WPOOL = WS_WM2 + al1((size_t)DEPTH * DFF * DM * 2);
constexpr size_t WS_WADA = WS_WPOOL + al1((size_t)DEPTH * 4 * 256 * 256 * 2);
constexpr size_t WS_SC = WS_WADA + al1((size_t)DEPTH * ADAW * DM * 2);
constexpr size_t WS_ADA = WS_SC + al1((size_t)256 * DM * 2);
constexpr size_t WS_H = WS_ADA + al1((size_t)DEPTH * NROWB * ADAW * 4);
constexpr size_t WS_Z = WS_H + al1((size_t)M * DM * 2);
constexpr size_t WS_Y = WS_Z + al1((size_t)M * ZW * 2);
constexpr size_t WS_ZP = WS_Y + al1((size_t)4 * M * BRW * 2);
constexpr size_t WS_CONVY = WS_ZP + al1((size_t)M * BRW * 2);
constexpr size_t WS_ORAW = WS_CONVY + al1((size_t)M * BRW * 4);
constexpr size_t WS_KV = WS_ORAW + al1((size_t)M * BRW * 4);
constexpr size_t WS_SPREV = WS_KV + al1((size_t)NBP * 32 * RH * RDK * RDV * 4);
constexpr size_t WS_MACC = WS_SPREV + al1((size_t)NBP * 32 * RH * RDK * RDV * 4);
constexpr size_t WS_MERGED = WS_MACC + al1((size_t)M * DM * 4);
constexpr size_t WS_X1 = WS_MERGED + al1((size_t)M * DM * 2);
constexpr size_t WS_X = WS_X1 + al1((size_t)M * DM * 4);
constexpr size_t WS_HID = WS_X + al1((size_t)M * DM * 4);
constexpr size_t WS_SLAB = WS_HID + al1((size_t)M * DFF * 2);
constexpr size_t WS_END = WS_SLAB + al1((size_t)16 * MS * DM * 4);
constexpr int CW_BAR = 4096;
constexpr int RING_OFF = 0, RING_BYTES = 131072, LDSCTL_OFF = RING_BYTES, MISC_OFF = LDSCTL_OFF + 320, INTAB_OFF = MISC_OFF + 128, LDS_BYTES = 147456;

#define GAS __attribute__((address_space(1)))
#define LAS __attribute__((address_space(3)))
typedef unsigned v4u __attribute__((ext_vector_type(4)));
typedef float f32x4 __attribute__((ext_vector_type(4)));
typedef GAS unsigned gu32;
#define RLX_AGENT __ATOMIC_RELAXED, __HIP_MEMORY_SCOPE_AGENT
#define LDS_WAIT() asm volatile("s_waitcnt lgkmcnt(0)" ::: "memory")
__device__ __forceinline__ unsigned pk2(float lo, float hi) { return (unsigned)f2bf(lo) | ((unsigned)f2bf(hi) << 16); }

#define XB_TMO      128
#define XB_XCNT(j)  (256  + 64 * (j))
#define XB_XSUB(j)  (1280 + 64 * (j))
#define XB_XGEN(j)  (2304 + 64 * (j))
#define XB_TOP      3328
#define XB_TOPGEN   3392
#define XCD_BAR_WORDS 3456
#define XB_SPIN_CAP (1u << 18)
__device__ __forceinline__ unsigned xb_ld(unsigned* p)              { return __hip_atomic_load(p, __ATOMIC_RELAXED, __HIP_MEMORY_SCOPE_AGENT); }
__device__ __forceinline__ unsigned xb_add(unsigned* p, unsigned v) { return __hip_atomic_fetch_add(p, v, __ATOMIC_RELAXED, __HIP_MEMORY_SCOPE_AGENT); }
__device__ __forceinline__ unsigned xb_xcc_id() { return (unsigned)__builtin_amdgcn_s_getreg((3 << 11) | 20) & 0xFu; }
#define XB_SPIN(cond, bar) do { unsigned _sp = 0; while (cond) { __builtin_amdgcn_s_sleep(1); \
    if ((++_sp & 255u) == 0u) { if (xb_ld(&(bar)[XB_TMO])) break; if (_sp > XB_SPIN_CAP) { atomicAdd(&(bar)[XB_TMO], 1u); break; } } } } while (0)
struct XcdBarrier { unsigned* bar; unsigned x; volatile LAS unsigned* st; };
__device__ __forceinline__ XcdBarrier xcd_barrier_post(unsigned* bar, volatile LAS unsigned* st) {
    XcdBarrier b; b.bar = bar; b.x = xb_xcc_id(); b.st = st;
    if (threadIdx.x == 0) (void)xb_add(&bar[XB_XCNT(b.x)], 1u);
    return b;
}
__device__ __forceinline__ void xcd_barrier_complete(unsigned* bar, unsigned x, unsigned& nloc, unsigned& nx) {
    const unsigned G = gridDim.x * gridDim.y * gridDim.z;
    unsigned sum, cnt, mine, sp = 0u;
    for (;;) {
        sum = 0u; cnt = 0u; mine = 0u;
#pragma unroll
        for (unsigned j = 0; j < 16; ++j) { const unsigned c = xb_ld(&bar[XB_XCNT(j)]); sum += c; cnt += (c > 0u) ? 1u : 0u; mine = (j == x) ? c : mine; }
        if (sum == G) break;
        __builtin_amdgcn_s_sleep(1);
        if ((++sp & 255u) == 0u) { if (xb_ld(&bar[XB_TMO])) break; if (sp > XB_SPIN_CAP) { atomicAdd(&bar[XB_TMO], 1u); break; } }
    }
    nloc = mine > 0u ? mine : 1u; nx = cnt > 0u ? cnt : 1u;
}
__device__ __forceinline__ void xcd_barrier(const XcdBarrier& b) {
    asm volatile("s_waitcnt vmcnt(0)" ::: "memory");
    __syncthreads();
    if (threadIdx.x == 0) {
        unsigned* bar = b.bar;
        __builtin_amdgcn_s_waitcnt(0);
        unsigned nloc = b.st[0], nx = b.st[1];
        if (nloc == 0u) { xcd_barrier_complete(bar, b.x, nloc, nx); b.st[0] = nloc; b.st[1] = nx; }
        const unsigned old = xb_add(&bar[XB_XSUB(b.x)], 1u);
        const unsigned gen = old / nloc;
        if (old + 1u == (gen + 1u) * nloc) {
            __builtin_amdgcn_fence(__ATOMIC_RELEASE, "agent");
            asm volatile("s_waitcnt vmcnt(0)" ::: "memory");
            const unsigned og = xb_add(&bar[XB_TOP], 1u);
            const unsigned tg = og / nx;
            if (og + 1u == (tg + 1u) * nx) xb_add(&bar[XB_TOPGEN], 1u);
            else XB_SPIN(xb_ld(&bar[XB_TOPGEN]) == tg, bar);
            __builtin_amdgcn_fence(__ATOMIC_ACQUIRE, "agent");
            xb_add(&bar[XB_XGEN(b.x)], 1u);
            asm volatile("s_waitcnt vmcnt(0)" ::: "memory");
        } else {
            XB_SPIN(xb_ld(&bar[XB_XGEN(b.x)]) == gen, bar);
            __builtin_amdgcn_fence(__ATOMIC_ACQUIRE, "agent");
            asm volatile("s_waitcnt vmcnt(0)" ::: "memory");
        }
    }
    __syncthreads();
}

template <int CTRL> __device__ __forceinline__ float dpp_f(float v) { return __builtin_bit_cast(float, __builtin_amdgcn_update_dpp(0, __builtin_bit_cast(int, v), CTRL, 0xf, 0xf, false)); }
__device__ __forceinline__ float wave_sum(float v) {
    v += dpp_f<0xB1>(v);
    v += dpp_f<0x4E>(v);
    v += dpp_f<0x141>(v);
    v += dpp_f<0x140>(v);
    v += __builtin_bit_cast(float, __builtin_amdgcn_ds_swizzle(__builtin_bit_cast(int, v), 0x401F));
    return __builtin_bit_cast(float, __builtin_amdgcn_readlane(__builtin_bit_cast(int, v), 0)) + __builtin_bit_cast(float, __builtin_amdgcn_readlane(__builtin_bit_cast(int, v), 32));
}
typedef float tr_f32x4 __attribute__((ext_vector_type(4)));
#define TR_LOAD(V, P) _Pragma("unroll") for (int j = 0; j < 8; ++j) V[j] = __builtin_nontemporal_load((const GAS tr_f32x4*)((P) + (size_t)j * N))
#define TR_STORE(V, Q) _Pragma("unroll") for (int i = 0; i < 4; ++i) { v4u o; o.x = pk2(V[0][i], V[1][i]); o.y = pk2(V[2][i], V[3][i]); o.z = pk2(V[4][i], V[5][i]); o.w = pk2(V[6][i], V[7][i]); __builtin_nontemporal_store(o, (GAS v4u*)((Q) + (size_t)i * K)); }
template <int K, int N, bool GLUPERM = false>
__device__ __forceinline__ void transpose_run(const float* W, bf16* T, int nmat, int gw, int NGW, int lane) {
    constexpr int NB = N / 32, IPM = (K / 64) * NB; const int total = nmat * IPM;
    const unsigned lo_p = (unsigned)(8 * (lane >> 3)) * N + 4 * (lane & 7), lo_q = (unsigned)(4 * (lane & 7)) * K + 8 * (lane >> 3);
    auto addr = [&](int it, const float*& p, bf16*& q) { it = it < total ? it : total - 1; const int mi = it / IPM, r = it % IPM, kb = r / NB, nb = r % NB;
        p = W + ((size_t)mi * K * N + (size_t)(64 * kb) * N + 32 * nb) + lo_p;
        int n0 = 32 * nb;
        if (GLUPERM) { if (n0 >= ZCA && n0 < ZCA + BRW) { const int c = n0 - ZCA; n0 = ZCA + 256 * (c >> 7) + (c & 127); } else if (n0 >= ZCG && n0 < ZCG + BRW) { const int c = n0 - ZCG; n0 = ZCA + 256 * (c >> 7) + 128 + (c & 127); } }
        q = T + ((size_t)mi * K * N + (size_t)n0 * K + 64 * kb) + lo_q; };
    int it = gw; if (it >= total) return;
    tr_f32x4 va[8], vb[8]; const float *pa, *pb; bf16 *qa, *qb;
    addr(it, pa, qa); TR_LOAD(va, pa);
    for (;;) {
        const int i1 = it + NGW; addr(i1, pb, qb); TR_LOAD(vb, pb);
        asm volatile("" ::: "memory"); TR_STORE(va, qa); asm volatile("" ::: "memory");
        if (i1 >= total) break;
        const int i2 = i1 + NGW; addr(i2, pa, qa); TR_LOAD(va, pa);
        asm volatile("" ::: "memory"); TR_STORE(vb, qb); asm volatile("" ::: "memory");
        if (i2 >= total) break;
        it = i2; }
}
__device__ __forceinline__ void load_mod(const float* g, const float* sc, const float* shp, f32x4 (&gm)[8], f32x4 (&sh)[8], int lane) {
#pragma unroll
    for (int j = 0; j < 8; ++j) { gm[j] = ((const f32x4*)g)[lane + 64 * j] * (((const f32x4*)sc)[lane + 64 * j] + 1.f); sh[j] = ((const f32x4*)shp)[lane + 64 * j]; }
}
__device__ __forceinline__ void norm_store(const f32x4 (&v)[8], float ss, const f32x4 (&gm)[8], const f32x4 (&sh)[8], bf16* orow, int lane) {
    const float rstd = 1.f / sqrtf(wave_sum(ss) * (1.f / DM) + EPS);
#pragma unroll
    for (int j = 0; j < 8; ++j) { const f32x4 y = v[j] * rstd * gm[j] + sh[j];
        ((unsigned long long*)orow)[lane + 64 * j] = (unsigned long long)pk2(y.x, y.y) | ((unsigned long long)pk2(y.z, y.w) << 32); }
}
__device__ __forceinline__ void norm_row2(const float* xa, const float* xb, const f32x4 (&gm)[8], const f32x4 (&sh)[8], bf16* oa, bf16* ob, int lane) {
    f32x4 va[8], vb[8]; float sa = 0.f, sb = 0.f;
#pragma unroll
    for (int j = 0; j < 8; ++j) { va[j] = ((const f32x4*)xa)[lane + 64 * j]; vb[j] = ((const f32x4*)xb)[lane + 64 * j]; }
#pragma unroll
    for (int j = 0; j < 8; ++j) { sa += (va[j].x * va[j].x + va[j].y * va[j].y) + (va[j].z * va[j].z + va[j].w * va[j].w); sb += (vb[j].x * vb[j].x + vb[j].y * vb[j].y) + (vb[j].z * vb[j].z + vb[j].w * vb[j].w); }
    norm_store(va, sa, gm, sh, oa, lane); norm_store(vb, sb, gm, sh, ob, lane);
}
__device__ __forceinline__ void norm_row(const float* xrow, const f32x4 (&gm)[8], const f32x4 (&sh)[8], bf16* orow, int lane) {
    f32x4 v[8]; float ss = 0.f;
#pragma unroll
    for (int j = 0; j < 8; ++j) { v[j] = ((const f32x4*)xrow)[lane + 64 * j]; ss += (v[j].x * v[j].x + v[j].y * v[j].y) + (v[j].z * v[j].z + v[j].w * v[j].w); }
    norm_store(v, ss, gm, sh, orow, lane);
}
template <int NP> __device__ __forceinline__ void norm_row_block(const float* base, const float* gate, const float* slab, size_t ps, float* xdst, const float* g, const float* sc, const float* shp, bf16* orow, LAS float* red, int tid, int wave) {
    f32x4 v = ((const f32x4*)base)[tid];
    if (NP > 0) { f32x4 pv[NP > 0 ? NP : 1];
#pragma unroll
        for (int p = 0; p < NP; ++p) pv[p] = ((const f32x4*)(slab + (size_t)p * ps))[tid];
        f32x4 a = pv[0];
#pragma unroll
        for (int p = 1; p < NP; ++p) a += pv[p];
        v += ((const f32x4*)gate)[tid] * a; ((f32x4*)xdst)[tid] = v; }
    const float ws = wave_sum((v.x * v.x + v.y * v.y) + (v.z * v.z + v.w * v.w));
    if ((tid & 63) == 0) red[wave] = ws;
    __syncthreads();
    float ss = 0.f;
#pragma unroll
    for (int w = 0; w < NWAVES; ++w) ss += red[w];
    const float rstd = 1.f / sqrtf(ss * (1.f / DM) + EPS);
    const f32x4 y = v * rstd * ((const f32x4*)g)[tid] * (((const f32x4*)sc)[tid] + 1.f) + ((const f32x4*)shp)[tid];
    ((unsigned long long*)orow)[tid] = (unsigned long long)pk2(y.x, y.y) | ((unsigned long long)pk2(y.z, y.w) << 32);
    __syncthreads();
}
__device__ __forceinline__ void convln_row(const float* yrow, const f32x4 (&gv4)[4], const f32x4 (&bv4)[4], bf16* orow, int lane) {
    f32x4 v[4]; float s = 0.f;
#pragma unroll
    for (int j = 0; j < 4; ++j) { v[j] = ((const f32x4*)yrow)[lane + 64 * j]; s += (v[j].x + v[j].y) + (v[j].z + v[j].w); }
    const float mean = wave_sum(s) * (1.f / BRW); float q = 0.f;
#pragma unroll
    for (int j = 0; j < 4; ++j) { v[j] = v[j] - mean; q += (v[j].x * v[j].x + v[j].y * v[j].y) + (v[j].z * v[j].z + v[j].w * v[j].w); }
    const float rstd = 1.f / sqrtf(wave_sum(q) * (1.f / BRW) + EPS);
#pragma unroll
    for (int j = 0; j < 4; ++j) { f32x4 y = v[j] * rstd * gv4[j] + bv4[j];
        y.x = y.x * sigmoidf_(y.x); y.y = y.y * sigmoidf_(y.y); y.z = y.z * sigmoidf_(y.z); y.w = y.w * sigmoidf_(y.w);
        ((unsigned long long*)orow)[lane + 64 * j] = (unsigned long long)pk2(y.x, y.y) | ((unsigned long long)pk2(y.z, y.w) << 32); }
}


namespace att {
typedef short bf16x8 __attribute__((ext_vector_type(8)));
typedef short s16x4 __attribute__((ext_vector_type(4)));
typedef float f32x4 __attribute__((ext_vector_type(4)));
typedef float f32x2_t __attribute__((ext_vector_type(2))); typedef __bf16 bf16x2_t __attribute__((ext_vector_type(2)));
constexpr int KP = 144, NROWS = 272, K_OFF = 0, V_OFF = NROWS * KP, LDS_NEED = 2 * NROWS * KP;
__device__ __forceinline__ unsigned cvtpk(float lo, float hi) { f32x2_t v = {lo, hi}; bf16x2_t b = __builtin_convertvector(v, bf16x2_t); return __builtin_bit_cast(unsigned, b); }
__device__ __forceinline__ float red4_max(float v) {
    v = fmaxf(v, __builtin_bit_cast(float, __builtin_amdgcn_ds_swizzle(__builtin_bit_cast(int, v), 0x401F)));
    unsigned x = __builtin_bit_cast(unsigned, v), y = x; asm volatile("" : "+v"(y));
    auto rr = __builtin_amdgcn_permlane32_swap(x, y, false, false); const unsigned r0 = rr[0], r1 = rr[1];
    return fmaxf(__builtin_bit_cast(float, r0), __builtin_bit_cast(float, r1)); }
__device__ __forceinline__ float red4_sum(float v) {
    v += __builtin_bit_cast(float, __builtin_amdgcn_ds_swizzle(__builtin_bit_cast(int, v), 0x401F));
    unsigned x = __builtin_bit_cast(unsigned, v), y = x; asm volatile("" : "+v"(y));
    auto rr = __builtin_amdgcn_permlane32_swap(x, y, false, false); const unsigned r0 = rr[0], r1 = rr[1];
    return __builtin_bit_cast(float, r0) + __builtin_bit_cast(float, r1); }
__device__ __forceinline__ s16x4 vtr(const LAS unsigned char* p) { typedef short v4i16_t __attribute__((ext_vector_type(4))); return __builtin_bit_cast(s16x4, __builtin_amdgcn_ds_read_tr16_b64_v4i16((LAS v4i16_t*)p)); }

__device__ __forceinline__ void tile16(const bf16x8 qf0, const bf16x8 qf1, const LAS unsigned char* Ks, const LAS unsigned char* Vs, int kbase, int wpos0, float slope2, float sink2, bf16* Yq, int nst, int lane) {
    const int c = lane & 15, g = lane >> 4;
    f32x4 st[9];
#pragma unroll
    for (int kt = 0; kt < 9; ++kt) { const LAS unsigned char* kp = Ks + (kbase + 16 * kt + c) * KP + 16 * g;
        const bf16x8 k0 = *(const LAS bf16x8*)kp, k1 = *(const LAS bf16x8*)(kp + 64);
        f32x4 a = {0.f, 0.f, 0.f, 0.f};
        a = __builtin_amdgcn_mfma_f32_16x16x32_bf16(k0, qf0, a, 0, 0, 0); a = __builtin_amdgcn_mfma_f32_16x16x32_bf16(k1, qf1, a, 0, 0, 0); st[kt] = a; }
    float SC2 = 0.125f * 1.4426950408889634f; asm volatile("" : "+v"(SC2));
    const int dbase = 128 + c - 4 * g;
    float m = sink2;
#pragma unroll
    for (int kt = 0; kt < 9; ++kt)
#pragma unroll
        for (int r = 0; r < 4; ++r) { const int dist = dbase - r - 16 * kt, kk = 16 * kt + 4 * g + r; const bool ok = (unsigned)dist <= 128u && (wpos0 + kk) >= 0;
            const float sv = ok ? st[kt][r] * SC2 - slope2 * (float)dist : -INFINITY; st[kt][r] = sv; m = fmaxf(m, sv); }
    m = red4_max(m);
    float sum = 0.f;
#pragma unroll
    for (int kt = 0; kt < 9; ++kt)
#pragma unroll
        for (int r = 0; r < 4; ++r) { const float p = __builtin_amdgcn_exp2f(st[kt][r] - m); st[kt][r] = p; sum += p; }
    sum = red4_sum(sum) + __builtin_amdgcn_exp2f(sink2 - m);
    const float inv = 1.f / sum;
    bf16x8 pf[5];
#pragma unroll
    for (int k = 0; k < 5; ++k) { unsigned w0 = cvtpk(st[2 * k][0] * inv, st[2 * k][1] * inv), w1 = cvtpk(st[2 * k][2] * inv, st[2 * k][3] * inv), w2 = 0u, w3 = 0u;
        if (k < 4) { w2 = cvtpk(st[2 * k + 1][0] * inv, st[2 * k + 1][1] * inv); w3 = cvtpk(st[2 * k + 1][2] * inv, st[2 * k + 1][3] * inv); }
        typedef unsigned u32x4_t __attribute__((ext_vector_type(4))); const u32x4_t w = {w0, w1, w2, w3}; pf[k] = __builtin_bit_cast(bf16x8, w); }
    f32x4 o[4];
#pragma unroll
    for (int dt = 0; dt < 4; ++dt) o[dt] = (f32x4){0.f, 0.f, 0.f, 0.f};
    const LAS unsigned char* vb = Vs + (kbase + 4 * g + (c >> 2)) * KP + 8 * (c & 3);
#pragma unroll
    for (int k = 0; k < 5; ++k)
#pragma unroll
        for (int dt = 0; dt < 4; ++dt) { const s16x4 lo = vtr(vb + (32 * k) * KP + 32 * dt), hi = vtr(vb + (32 * k + 16) * KP + 32 * dt);
            const bf16x8 b = {lo[0], lo[1], lo[2], lo[3], hi[0], hi[1], hi[2], hi[3]};
            o[dt] = __builtin_amdgcn_mfma_f32_16x16x32_bf16(pf[k], b, o[dt], 0, 0, 0); }
#pragma unroll
    for (int r = 0; r < 4; ++r) if (4 * g + r < nst) {
#pragma unroll
        for (int dt = 0; dt < 4; ++dt) Yq[(size_t)(4 * g + r) * BRW + 16 * dt + c] = f2bf(o[dt][r]); }
}
typedef unsigned u32x4_t __attribute__((ext_vector_type(4)));
__device__ __forceinline__ u32x4_t pack8(const float* f) { u32x4_t w; w.x = cvtpk(f[0], f[1]); w.y = cvtpk(f[2], f[3]); w.z = cvtpk(f[4], f[5]); w.w = cvtpk(f[6], f[7]); return w; }
__device__ __forceinline__ void phase(LAS unsigned char* lds, const bf16* Z, int l, const float* sinks, const float* ck, const float* cv, bf16* Y0, int bx, int G, int tid, int lane, int wave) {
    LAS unsigned char* Ks = lds + K_OFF; LAS unsigned char* Vs = lds + V_OFF;
    const u32x4_t zero4 = {0u, 0u, 0u, 0u};
    for (int it = bx; it < NBP * 32 * NKV + SB * NKV; it += G) {
        const int kvh = it & 3;
        if (it < NBP * 32 * NKV) {
            const int b = it >> 7, qb = (it >> 2) & 31;
#pragma unroll
            for (int i = 0; i < 4; ++i) { const int p = tid + NTHR * i, sr = p >> 3, cc = p & 7; const int pos = 128 * (qb - 1) + sr;
                u32x4_t kq = zero4, vq = zero4;
                if (pos >= 0) { const bf16* zr = Z + (size_t)(b * SEQ + pos) * ZW + kvh * 64 + cc * 8; kq = *(const u32x4_t*)(zr + ZK); vq = *(const u32x4_t*)(zr + ZV); }
                *(LAS u32x4_t*)(Ks + sr * KP + cc * 16) = kq; *(LAS u32x4_t*)(Vs + sr * KP + cc * 16) = vq; }
            if (tid < 128) { const int sr = 256 + (tid >> 3), cc = tid & 7; *(LAS u32x4_t*)(Ks + sr * KP + cc * 16) = zero4; *(LAS u32x4_t*)(Vs + sr * KP + cc * 16) = zero4; }
            __syncthreads();
            const int hq = kvh * 4 + (wave >> 1), qh = wave & 1;
            const float slope2 = exp2f(-0.5f * (float)(hq + 1)) * 1.4426950408889634f, sink2 = sinks[l * NH + hq] * 1.4426950408889634f;
            const bf16* qp0 = Z + ((size_t)b * SEQ + 128 * qb + 64 * qh + (lane & 15)) * ZW + ZQ + hq * 64 + 8 * (lane >> 4);
            bf16x8 qc0 = *(const bf16x8*)qp0, qc1 = *(const bf16x8*)(qp0 + 32);
#pragma unroll 1
            for (int qt = 0; qt < 4; ++qt) { const int t1 = 64 * qh + 16 * qt; const size_t qrow0 = (size_t)b * SEQ + 128 * qb + t1;
                const bf16* qpn = qp0 + (size_t)(16 * (qt < 3 ? qt + 1 : 3)) * ZW; const bf16x8 qn0 = *(const bf16x8*)qpn, qn1 = *(const bf16x8*)(qpn + 32);
                tile16(qc0, qc1, Ks, Vs, t1, 128 * qb + t1 - 128, slope2, sink2, Y0 + qrow0 * BRW + hq * 64, 16, lane);
                qc0 = qn0; qc1 = qn1; }
        } else {
            const int sb = (it - NBP * 32 * NKV) >> 2;
#pragma unroll
            for (int i = 0; i < 3; ++i) { const int p = tid + NTHR * i, sr = p >> 3, cc = p & 7;
                if (sr < 160) { u32x4_t kq = zero4, vq = zero4;
                    if (sr < WIN) { const size_t o = ((((size_t)l * SB + sb) * WIN + sr) * NKV + kvh) * 64 + cc * 8; float f[8];
#pragma unroll
                        for (int e = 0; e < 8; ++e) f[e] = ck[o + e];
                        kq = pack8(f);
#pragma unroll
                        for (int e = 0; e < 8; ++e) f[e] = cv[o + e];
                        vq = pack8(f);
                    } else if (sr < WIN + ST) { const bf16* zr = Z + (size_t)(MP + sb * ST + (sr - WIN)) * ZW + kvh * 64 + cc * 8; kq = *(const u32x4_t*)(zr + ZK); vq = *(const u32x4_t*)(zr + ZV); }
                    *(LAS u32x4_t*)(Ks + sr * KP + cc * 16) = kq; *(LAS u32x4_t*)(Vs + sr * KP + cc * 16) = vq; } }
            __syncthreads();
            if (wave < 4) { const int hq = kvh * 4 + wave;
                const float slope2 = exp2f(-0.5f * (float)(hq + 1)) * 1.4426950408889634f, sink2 = sinks[l * NH + hq] * 1.4426950408889634f;
                const size_t qrow0 = (size_t)MP + sb * ST; const bf16* qp = Z + (qrow0 + (lane & 7)) * ZW + ZQ + hq * 64 + 8 * (lane >> 4);
                tile16(*(const bf16x8*)qp, *(const bf16x8*)(qp + 32), Ks, Vs, 0, 0, slope2, sink2, Y0 + qrow0 * BRW + hq * 64, ST, lane); }
        }
        __syncthreads();
    }
}
}

namespace adad {
using att::bf16x8; using att::f32x4; using att::cvtpk;
constexpr int NSTRIP = ADAW / 64, RW = 576, A2_OFF = 8 * RW * 16, A2_WAVE = 3 * 512;
#define ADA_LOAD(V, S) _Pragma("unroll") for (int j = 0; j < 8; ++j) V[j] = __builtin_nontemporal_load((const GAS f32x4*)(wp + (size_t)(32 * (S) + j) * ADAW))
__device__ __forceinline__ v4u silu8(f32x4 x0, f32x4 x1) { v4u o;
    o.x = cvtpk(x0.x * sigmoidf_(x0.x), x0.y * sigmoidf_(x0.y)); o.y = cvtpk(x0.z * sigmoidf_(x0.z), x0.w * sigmoidf_(x0.w));
    o.z = cvtpk(x1.x * sigmoidf_(x1.x), x1.y * sigmoidf_(x1.y)); o.w = cvtpk(x1.z * sigmoidf_(x1.z), x1.w * sigmoidf_(x1.w)); return o; }
__device__ __forceinline__ const GAS float* crow(const float* cp, const float* cs, int row) { return row < NBP ? (const GAS float*)cp + (size_t)row * DM : (const GAS float*)cs + (size_t)(row - NBP) * DM; }
__device__ __forceinline__ void phase(const float* cp, const float* cs, const float* wada, const float* bada, float* ADA, LAS unsigned char* lds, int bx, int G, int wave, int lane, int tid) {
    const int kl = 256 * wave + 8 * (lane >> 4);
    bf16x8 af[2][8];
#pragma unroll
    for (int mb = 0; mb < 2; ++mb) { const GAS float* src = crow(cp, cs, 16 * mb + (lane & 15)) + kl;
#pragma unroll
        for (int s = 0; s < 8; ++s) af[mb][s] = __builtin_bit_cast(bf16x8, silu8(*(const GAS f32x4*)(src + 32 * s), *(const GAS f32x4*)(src + 32 * s + 4))); }
    LAS unsigned char* a2 = lds + A2_OFF + wave * A2_WAVE;
    {   const GAS float* src = crow(cp, cs, 32 + (lane >> 5)) + 256 * wave + 8 * (lane & 31);
        *(LAS v4u*)(a2 + (lane >> 5) * 512 + (lane & 31) * 16) = silu8(*(const GAS f32x4*)src, *(const GAS f32x4*)(src + 4));
        if (lane < 32) { v4u z = {0u, 0u, 0u, 0u}; *(LAS v4u*)(a2 + 2 * 512 + lane * 16) = z; }
        LDS_WAIT(); asm volatile("" ::: "memory"); }
    const LAS unsigned char* a2r = a2 + ((lane & 15) < 2 ? (lane & 15) : 2) * 512 + (lane >> 4) * 16;
    LAS f32x4* red = (LAS f32x4*)lds;
    for (int g = bx; g < DEPTH * NSTRIP; g += G) { const int l = g / NSTRIP, n0 = 64 * (g % NSTRIP);
        const GAS float* wp = (const GAS float*)wada + (size_t)l * DM * ADAW + (size_t)kl * ADAW + n0 + 4 * (lane & 15);
        f32x4 acc[3][4];
#pragma unroll
        for (int mb = 0; mb < 3; ++mb)
#pragma unroll
            for (int i = 0; i < 4; ++i) acc[mb][i] = f32x4{0.f, 0.f, 0.f, 0.f};
        f32x4 v0[8], v1[8];
        ADA_LOAD(v0, 0);
#pragma unroll
        for (int s = 0; s < 8; ++s) {
            if (s < 7) { if (s & 1) { ADA_LOAD(v0, s + 1); } else { ADA_LOAD(v1, s + 1); } }
            asm volatile("" ::: "memory");
            const bf16x8 a2f = *(const LAS bf16x8*)(a2r + 64 * s);
#pragma unroll
            for (int i = 0; i < 4; ++i) { v4u w;
                if (s & 1) { w.x = cvtpk(v1[0][i], v1[1][i]); w.y = cvtpk(v1[2][i], v1[3][i]); w.z = cvtpk(v1[4][i], v1[5][i]); w.w = cvtpk(v1[6][i], v1[7][i]); }
                else       { w.x = cvtpk(v0[0][i], v0[1][i]); w.y = cvtpk(v0[2][i], v0[3][i]); w.z = cvtpk(v0[4][i], v0[5][i]); w.w = cvtpk(v0[6][i], v0[7][i]); }
                const bf16x8 bfr = __builtin_bit_cast(bf16x8, w);
                acc[0][i] = __builtin_amdgcn_mfma_f32_16x16x32_bf16(af[0][s], bfr, acc[0][i], 0, 0, 0);
                acc[1][i] = __builtin_amdgcn_mfma_f32_16x16x32_bf16(af[1][s], bfr, acc[1][i], 0, 0, 0);
                acc[2][i] = __builtin_amdgcn_mfma_f32_16x16x32_bf16(a2f, bfr, acc[2][i], 0, 0, 0); }
            asm volatile("" ::: "memory"); }
        LAS f32x4* rw = red + wave * RW;
#pragma unroll
        for (int mb = 0; mb < 2; ++mb)
#pragma unroll
            for (int i = 0; i < 4; ++i) rw[(mb * 4 + i) * 64 + lane] = acc[mb][i];
        if (lane < 16) {
#pragma unroll
            for (int i = 0; i < 4; ++i) rw[512 + i * 16 + lane] = acc[2][i]; }
        __syncthreads();
        for (int e = tid; e < RW; e += NTHR) { f32x4 t = red[e];
#pragma unroll
            for (int w = 1; w < 8; ++w) t += red[w * RW + e];
            int row0, col;
            if (e < 512) { const int mbi = e >> 6, ln = e & 63; row0 = 16 * (mbi >> 2) + 4 * (ln >> 4); col = n0 + 4 * (ln & 15) + (mbi & 3); }
            else { const int q = e - 512; row0 = 32; col = n0 + 4 * (q & 15) + (q >> 4); }
            const float bv = *((const GAS float*)bada + (size_t)l * ADAW + col);
            GAS float* o = (GAS float*)ADA + ((size_t)l * NROWB + row0) * ADAW + col;
            o[0] = t.x + bv; o[ADAW] = t.y + bv;
            if (row0 < 32) { o[2 * (size_t)ADAW] = t.z + bv; o[3 * (size_t)ADAW] = t.w + bv; } }
        __syncthreads(); }
}
}

namespace ret {
using att::bf16x8; using att::s16x4; using att::f32x4; using att::u32x4_t; using att::vtr; using att::cvtpk; using att::pack8;
constexpr int KP = 144, VP = 288, K_OFF = 0, V_OFF = 128 * KP, S_OFF = V_OFF + 128 * VP, LDS_NEED = S_OFF + 64 * VP;
template <int CTRL> __device__ __forceinline__ float dppf(float v) { return __builtin_bit_cast(float, __builtin_amdgcn_update_dpp(0, __builtin_bit_cast(int, v), CTRL, 0xf, 0xf, false)); }
__device__ __forceinline__ float sum16(float v) { v += dppf<0xB1>(v); v += dppf<0x4E>(v); v += dppf<0x141>(v); v += dppf<0x140>(v); return v; }
__device__ __forceinline__ void out_phase(LAS unsigned char* lds, const bf16* Z, int l, const float* SPREV, const float* gret, bf16* Y3, int bx, int G, int tid, int lane, int wave) {
    LAS unsigned char* Ks = lds + K_OFF; LAS unsigned char* Vs = lds + V_OFF; LAS unsigned char* Ss = lds + S_OFF;
    const int c = lane & 15, g = lane >> 4;
    for (int it = bx; it < NBP * 32 * RH; it += G) {
        const int b = it >> 8, n = (it >> 3) & 31, h = it & 7; const size_t row0 = (size_t)b * SEQ + n * 128;
#pragma unroll
        for (int i = 0; i < 2; ++i) { const int p = tid + NTHR * i, j = p >> 3, cc = p & 7; *(LAS u32x4_t*)(Ks + j * KP + cc * 16) = *(const u32x4_t*)(Z + (row0 + j) * ZW + ZRK + h * 64 + cc * 8); }
#pragma unroll
        for (int i = 0; i < 4; ++i) { const int p = tid + NTHR * i, j = p >> 4, cc = p & 15; *(LAS u32x4_t*)(Vs + j * VP + cc * 16) = *(const u32x4_t*)(Z + (row0 + j) * ZW + ZRV + h * 128 + cc * 8); }
#pragma unroll
        for (int i = 0; i < 2; ++i) { const int p = tid + NTHR * i, d = p >> 4, cc = p & 15; const float* sp = SPREV + ((((size_t)b * 32 + n) * RH + h) * RDK + d) * RDV + cc * 8; float f[8];
#pragma unroll
            for (int e = 0; e < 8; ++e) f[e] = sp[e];
            *(LAS u32x4_t*)(Ss + d * VP + cc * 16) = pack8(f); }
        __syncthreads();
        const int w = wave; const float lg2 = ret_logg(h) * 1.4426950408889634f;
        const bf16* qp = Z + (row0 + 16 * w + c) * ZW + ZRQ + h * 64 + 8 * g;
        const bf16x8 qf0 = *(const bf16x8*)qp, qf1 = *(const bf16x8*)(qp + 32);
        f32x4 o[8];
#pragma unroll
        for (int vt = 0; vt < 8; ++vt) o[vt] = (f32x4){0.f, 0.f, 0.f, 0.f};
#pragma unroll
        for (int ks = 0; ks < 2; ++ks) { const LAS unsigned char* sb = Ss + (32 * ks + 8 * g + (c >> 2)) * VP + 8 * (c & 3);
#pragma unroll
            for (int vt = 0; vt < 8; ++vt) { const s16x4 lo = vtr(sb + 32 * vt), hi = vtr(sb + 4 * VP + 32 * vt); const bf16x8 bb = {lo[0], lo[1], lo[2], lo[3], hi[0], hi[1], hi[2], hi[3]};
                o[vt] = __builtin_amdgcn_mfma_f32_16x16x32_bf16(ks ? qf1 : qf0, bb, o[vt], 0, 0, 0); } }
#pragma unroll
        for (int r = 0; r < 4; ++r) { const float cf = __builtin_amdgcn_exp2f(lg2 * (float)(16 * w + 4 * g + r + 1));
#pragma unroll
            for (int vt = 0; vt < 8; ++vt) o[vt][r] *= cf; }
        for (int ks = 0; ks <= (w >> 1); ++ks) {
            f32x4 st[2];
#pragma unroll
            for (int t = 0; t < 2; ++t) { const int jt = 2 * ks + t; f32x4 a = {0.f, 0.f, 0.f, 0.f};
                if (jt <= w) { const LAS unsigned char* kp = Ks + (16 * jt + c) * KP + 16 * g; const bf16x8 k0 = *(const LAS bf16x8*)kp, k1 = *(const LAS bf16x8*)(kp + 64);
                    a = __builtin_amdgcn_mfma_f32_16x16x32_bf16(k0, qf0, a, 0, 0, 0); a = __builtin_amdgcn_mfma_f32_16x16x32_bf16(k1, qf1, a, 0, 0, 0);
#pragma unroll
                    for (int r = 0; r < 4; ++r) { const int dij = (16 * w + c) - (16 * jt + 4 * g + r); a[r] = dij >= 0 ? a[r] * 0.125f * __builtin_amdgcn_exp2f(lg2 * (float)dij) : 0.f; } }
                st[t] = a; }
            const u32x4_t pw = {cvtpk(st[0][0], st[0][1]), cvtpk(st[0][2], st[0][3]), cvtpk(st[1][0], st[1][1]), cvtpk(st[1][2], st[1][3])}; const bf16x8 pf = __builtin_bit_cast(bf16x8, pw);
            const LAS unsigned char* vb = Vs + (32 * ks + 4 * g + (c >> 2)) * VP + 8 * (c & 3);
#pragma unroll
            for (int vt = 0; vt < 8; ++vt) { const s16x4 lo = vtr(vb + 32 * vt), hi = vtr(vb + 16 * VP + 32 * vt); const bf16x8 bb = {lo[0], lo[1], lo[2], lo[3], hi[0], hi[1], hi[2], hi[3]};
                o[vt] = __builtin_amdgcn_mfma_f32_16x16x32_bf16(pf, bb, o[vt], 0, 0, 0); }
        }
        float mean[4], rstd[4];
#pragma unroll
        for (int r = 0; r < 4; ++r) { float sm = 0.f;
#pragma unroll
            for (int vt = 0; vt < 8; ++vt) sm += o[vt][r];
            mean[r] = sum16(sm) * (1.f / 128.f); float q = 0.f;
#pragma unroll
            for (int vt = 0; vt < 8; ++vt) { const float dd = o[vt][r] - mean[r]; q += dd * dd; }
            rstd[r] = 1.f / sqrtf(sum16(q) * (1.f / 128.f) + EPS); }
        const float* gp = gret + l * BRW + h * 128 + c;
        float gv[8]; bf16 rgv[4][8];
#pragma unroll
        for (int vt = 0; vt < 8; ++vt) gv[vt] = gp[16 * vt];
#pragma unroll
        for (int r = 0; r < 4; ++r) { const bf16* rg = Z + (row0 + 16 * w + 4 * g + r) * ZW + ZRG + h * 128 + c;
#pragma unroll
            for (int vt = 0; vt < 8; ++vt) rgv[r][vt] = rg[16 * vt]; }
        asm volatile("" ::: "memory");
#pragma unroll
        for (int r = 0; r < 4; ++r) { bf16* y = Y3 + (row0 + 16 * w + 4 * g + r) * BRW + h * 128 + c;
#pragma unroll
            for (int vt = 0; vt < 8; ++vt) y[16 * vt] = f2bf((o[vt][r] - mean[r]) * rstd[r] * gv[vt] * bf2f(rgv[r][vt])); }
        __syncthreads();
    }
}

__device__ __forceinline__ void kv_phase(LAS unsigned char* lds, const bf16* Z, float* KV, int bx, int G, int tid, int lane, int wave) {
    LAS unsigned char* Ks = lds + K_OFF; LAS unsigned char* Vs = lds + V_OFF;
    const int c = lane & 15, g = lane >> 4;
    for (int it = bx; it < NBP * 32 * RH; it += G) {
        const int b = it >> 8, n = (it >> 3) & 31, h = it & 7; const size_t row0 = (size_t)b * SEQ + n * 128;
        const float lg2 = ret_logg(h) * 1.4426950408889634f;
#pragma unroll
        for (int i = 0; i < 2; ++i) { const int p = tid + NTHR * i, j = p >> 3, cc = p & 7; float f[8]; ld8(Z + (row0 + j) * ZW + ZRK + h * 64 + cc * 8, f);
            const float sc = 0.125f * __builtin_amdgcn_exp2f(lg2 * (float)(127 - j));
#pragma unroll
            for (int e = 0; e < 8; ++e) f[e] *= sc;
            *(LAS u32x4_t*)(Ks + j * KP + cc * 16) = pack8(f); }
#pragma unroll
        for (int i = 0; i < 4; ++i) { const int p = tid + NTHR * i, j = p >> 4, cc = p & 15; *(LAS u32x4_t*)(Vs + j * VP + cc * 16) = *(const u32x4_t*)(Z + (row0 + j) * ZW + ZRV + h * 128 + cc * 8); }
        __syncthreads();
        const int dt = wave & 3, vt0 = (wave >> 2) * 4;
        f32x4 acc[4];
#pragma unroll
        for (int t = 0; t < 4; ++t) acc[t] = (f32x4){0.f, 0.f, 0.f, 0.f};
#pragma unroll
        for (int ks = 0; ks < 4; ++ks) { const LAS unsigned char* ka = Ks + (32 * ks + 8 * g + (c >> 2)) * KP + 32 * dt + 8 * (c & 3);
            const s16x4 alo = vtr(ka), ahi = vtr(ka + 4 * KP); const bf16x8 af = {alo[0], alo[1], alo[2], alo[3], ahi[0], ahi[1], ahi[2], ahi[3]};
            const LAS unsigned char* vb = Vs + (32 * ks + 8 * g + (c >> 2)) * VP + 8 * (c & 3);
#pragma unroll
            for (int t = 0; t < 4; ++t) { const s16x4 lo = vtr(vb + 32 * (vt0 + t)), hi = vtr(vb + 4 * VP + 32 * (vt0 + t)); const bf16x8 bb = {lo[0], lo[1], lo[2], lo[3], hi[0], hi[1], hi[2], hi[3]};
                acc[t] = __builtin_amdgcn_mfma_f32_16x16x32_bf16(af, bb, acc[t], 0, 0, 0); } }
        float* kvp = KV + ((((size_t)b * 32 + n) * RH + h) * RDK + 16 * dt + 4 * g) * RDV + c;
#pragma unroll
        for (int r = 0; r < 4; ++r)
#pragma unroll
            for (int t = 0; t < 4; ++t) kvp[(size_t)r * RDV + 16 * (vt0 + t)] = acc[t][r];
        __syncthreads();
    }
}
}

namespace mixl {
using att::u32x4_t; using att::f32x4; using att::f32x2_t;
template <int CTRL> __device__ __forceinline__ float dppf(float v) { return __builtin_bit_cast(float, __builtin_amdgcn_update_dpp(0, __builtin_bit_cast(int, v), CTRL, 0xf, 0xf, false)); }
__device__ __forceinline__ float sum8(float v) { v += dppf<0xB1>(v); v += dppf<0x4E>(v); v += dppf<0x141>(v); return v; }
struct QkRow { float q0[8], q1[8], kv[8]; };
__device__ __forceinline__ void qk_load(const bf16* zr, QkRow& R, int lane) { ld8(zr + ZQ + lane * 8, R.q0); ld8(zr + ZQ + 512 + lane * 8, R.q1); ld8(zr + ZK + lane * 8, R.kv); }
__device__ __forceinline__ void qk_finish(bf16* zr, int row, int l, QkRow& R, const float (&g8q)[8], const float (&g8k)[8], float* out, int lane) {
    float s0 = 0.f, s1 = 0.f, s2 = 0.f;
#pragma unroll
    for (int e = 0; e < 8; ++e) { s0 += R.q0[e] * R.q0[e]; s1 += R.q1[e] * R.q1[e]; s2 += R.kv[e] * R.kv[e]; }
    const float r0 = 1.f / sqrtf(sum8(s0) * (1.f / 64.f) + EPS), r1 = 1.f / sqrtf(sum8(s1) * (1.f / 64.f) + EPS), r2 = 1.f / sqrtf(sum8(s2) * (1.f / 64.f) + EPS);
#pragma unroll
    for (int e = 0; e < 8; ++e) { R.q0[e] *= r0 * g8q[e]; R.q1[e] *= r1 * g8q[e]; if (lane < 32) R.kv[e] *= r2 * g8k[e]; }
    st8(zr + ZQ + lane * 8, R.q0); st8(zr + ZQ + 512 + lane * 8, R.q1);
    if (lane < 32) st8(zr + ZK + lane * 8, R.kv);
    float* o = nullptr;
    if (row < MP) { const int b = row >> 12, t = row & (SEQ - 1); if (t >= SEQ - WIN) o = out + (lane < 32 ? O_KP : O_VP) + (((size_t)l * NBP + b) * WIN + (t - (SEQ - WIN))) * 256 + (lane & 31) * 8; }
    else { const int sb = (row - MP) >> 3, t = (row - MP) & 7; o = out + (lane < 32 ? O_KS : O_VS) + (((size_t)l * SB + sb) * WIN + (WIN - ST + t)) * 256 + (lane & 31) * 8; }
    if (o) { *(f32x4*)o = (f32x4){R.kv[0], R.kv[1], R.kv[2], R.kv[3]}; *(f32x4*)(o + 4) = (f32x4){R.kv[4], R.kv[5], R.kv[6], R.kv[7]}; }
}
__device__ __forceinline__ void qknorm_phase(bf16* Z, int l, const float* gq, const float* gk, float* out, int gw, int NGW, int lane) {
    float g8q[8], g8k[8];
#pragma unroll
    for (int e = 0; e < 8; ++e) { g8q[e] = gq[l * 64 + (lane & 7) * 8 + e]; g8k[e] = gk[l * 64 + (lane & 7) * 8 + e]; }
    for (int row = gw; row < M; row += 2 * NGW) { const int rowb = row + NGW; const bool two = rowb < M;
        bf16* za = Z + (size_t)row * ZW; bf16* zb = Z + (size_t)(two ? rowb : row) * ZW;
        QkRow A, B; qk_load(za, A, lane); qk_load(zb, B, lane);
        asm volatile("" ::: "memory");
        qk_finish(za, row, l, A, g8q, g8k, out, lane);
        if (two) qk_finish(zb, rowb, l, B, g8q, g8k, out, lane);
    }
}
constexpr int CV_RB = 64, CV_CB = 128, CV_UR = CV_RB + CPRE, CV_NPI = (MP / CV_RB) * 8, CV_NSI = SB * 8;
struct CvItem { bool smp; int cb, b, t0, nrows; size_t rowb; };
__device__ __forceinline__ CvItem cv_item(int it) { CvItem I; I.smp = it >= CV_NPI; I.cb = it & 7; I.b = I.smp ? (it - CV_NPI) >> 3 : (it >> 3) >> 6; I.t0 = I.smp ? 0 : ((it >> 3) & 63) * CV_RB; I.nrows = I.smp ? ST : CV_RB;
    I.rowb = I.smp ? (size_t)MP + I.b * ST : (size_t)I.b * SEQ; return I; }
__device__ __forceinline__ void cv_fetch(const bf16* Z, int l, const float* sconv, const CvItem& I, u32x4_t (&raw)[3][2], int tid) {
#pragma unroll
    for (int i = 0; i < 3; ++i) { const int p = tid + NTHR * i, ur = p >> 4, c8 = p & 15, tt = I.t0 - CPRE + ur; raw[i][0] = (u32x4_t){0u, 0u, 0u, 0u}; raw[i][1] = raw[i][0];
        if (ur < I.nrows + CPRE) {
            if (tt >= 0) { const bf16* zp = Z + (I.rowb + tt) * ZW + I.cb * CV_CB + c8 * 8; raw[i][0] = *(const u32x4_t*)(zp + ZCA); }
            else if (I.smp) { const float* sp = sconv + (((size_t)l * SB + I.b) * CPRE + (CPRE + tt)) * BRW + I.cb * CV_CB + c8 * 8; raw[i][0] = *(const u32x4_t*)sp; raw[i][1] = *(const u32x4_t*)(sp + 4); } } }
}
__device__ __forceinline__ void conv_phase(LAS unsigned char* lds, const bf16* Z, int l, const float* wdw, const float* bdw, const float* sconv, float* CONVY, float* out, int bx, int G, int tid) {
    LAS float* U = (LAS float*)lds;
    auto unp = [](const u32x4_t w, float* f) { f[0] = __builtin_bit_cast(float, w.x << 16); f[1] = __builtin_bit_cast(float, w.x & 0xffff0000u); f[2] = __builtin_bit_cast(float, w.y << 16); f[3] = __builtin_bit_cast(float, w.y & 0xffff0000u);
        f[4] = __builtin_bit_cast(float, w.z << 16); f[5] = __builtin_bit_cast(float, w.z & 0xffff0000u); f[6] = __builtin_bit_cast(float, w.w << 16); f[7] = __builtin_bit_cast(float, w.w & 0xffff0000u); };
    u32x4_t raw[3][2]; f32x2_t w2[CONVK], bias2 = {0.f, 0.f}; int wcb = -1;
#pragma unroll
    for (int j = 0; j < CONVK; ++j) w2[j] = f32x2_t{0.f, 0.f};
    if (bx < CV_NPI + CV_NSI) { const CvItem I0 = cv_item(bx); cv_fetch(Z, l, sconv, I0, raw, tid); }
    for (int it = bx; it < CV_NPI + CV_NSI; it += G) {
        const CvItem I = cv_item(it);
        const int cp = tid & 63, r0 = (tid >> 6) * 8, ch = I.cb * CV_CB + 2 * cp;
        if (I.cb != wcb) { wcb = I.cb;
#pragma unroll
            for (int j = 0; j < CONVK; ++j) w2[j] = *(const f32x2_t*)(wdw + ((size_t)l * CONVK + j) * BRW + ch);
            bias2 = *(const f32x2_t*)(bdw + l * BRW + ch); }
#pragma unroll
        for (int i = 0; i < 3; ++i) { const int p = tid + NTHR * i, ur = p >> 4, c8 = p & 15, tt = I.t0 - CPRE + ur; float u[8];
            if (ur < I.nrows + CPRE) {
                if (tt >= 0) { unp(raw[i][0], u);
                    if (ur >= CPRE) { float* o = nullptr;
                        if (!I.smp) { if (tt >= SEQ - CPRE) o = out + O_CP + (((size_t)l * NBP + I.b) * CPRE + (tt - (SEQ - CPRE))) * BRW + I.cb * CV_CB + c8 * 8; }
                        else o = out + O_CS + (((size_t)l * SB + I.b) * CPRE + (CPRE - ST + tt)) * BRW + I.cb * CV_CB + c8 * 8;
                        if (o) { *(f32x4*)o = (f32x4){u[0], u[1], u[2], u[3]}; *(f32x4*)(o + 4) = (f32x4){u[4], u[5], u[6], u[7]}; } }
                } else {
                    const unsigned r0_ = raw[i][0].x, r1_ = raw[i][0].y, r2_ = raw[i][0].z, r3_ = raw[i][0].w, r4_ = raw[i][1].x, r5_ = raw[i][1].y, r6_ = raw[i][1].z, r7_ = raw[i][1].w;
                    u[0] = __builtin_bit_cast(float, r0_); u[1] = __builtin_bit_cast(float, r1_); u[2] = __builtin_bit_cast(float, r2_); u[3] = __builtin_bit_cast(float, r3_);
                    u[4] = __builtin_bit_cast(float, r4_); u[5] = __builtin_bit_cast(float, r5_); u[6] = __builtin_bit_cast(float, r6_); u[7] = __builtin_bit_cast(float, r7_); }
                *(LAS f32x4*)(U + ur * CV_CB + c8 * 8) = (f32x4){u[0], u[1], u[2], u[3]}; *(LAS f32x4*)(U + ur * CV_CB + c8 * 8 + 4) = (f32x4){u[4], u[5], u[6], u[7]}; } }
        __syncthreads();
        if (it + G < CV_NPI + CV_NSI) { const CvItem In = cv_item(it + G); cv_fetch(Z, l, sconv, In, raw, tid); }
        if (r0 < I.nrows) {
            f32x2_t u2[8 + CPRE];
#pragma unroll
            for (int k = 0; k < 8 + CPRE; ++k) u2[k] = *(const LAS f32x2_t*)(U + (r0 + k) * CV_CB + 2 * cp);
#pragma unroll
            for (int r = 0; r < 8; ++r) { f32x2_t acc = bias2;
#pragma unroll
                for (int j = 0; j < CONVK; ++j) acc = w2[j] * u2[r + j] + acc;
                if (r0 + r < I.nrows) *(f32x2_t*)(CONVY + (I.rowb + I.t0 + r0 + r) * BRW + ch) = acc; }
        }
        __syncthreads();
    }
}
template <int W> __device__ __forceinline__ void pool_run(const bf16* Z, int l, int b, int t0, int cch, bf16* ZP, float* out) {
    const size_t rowb = (size_t)b * SEQ; u32x4_t rw[23];
#pragma unroll
    for (int k = 16 - W; k < 23; ++k) { const int tt = t0 - 15 + k; rw[k] = (u32x4_t){0u, 0u, 0u, 0u}; if (tt >= 0) rw[k] = *(const u32x4_t*)(Z + (rowb + tt) * ZW + ZPL + cch); }
    float S[8];
#pragma unroll
    for (int e = 0; e < 8; ++e) S[e] = 0.f;
    auto unp = [](const u32x4_t w, float* f) { f[0] = __builtin_bit_cast(float, w.x << 16); f[1] = __builtin_bit_cast(float, w.x & 0xffff0000u); f[2] = __builtin_bit_cast(float, w.y << 16); f[3] = __builtin_bit_cast(float, w.y & 0xffff0000u);
        f[4] = __builtin_bit_cast(float, w.z << 16); f[5] = __builtin_bit_cast(float, w.z & 0xffff0000u); f[6] = __builtin_bit_cast(float, w.w << 16); f[7] = __builtin_bit_cast(float, w.w & 0xffff0000u); };
#pragma unroll
    for (int k = 16 - W; k < 15; ++k) { float f[8]; unp(rw[k], f);
#pragma unroll
        for (int e = 0; e < 8; ++e) S[e] += f[e]; }
#pragma unroll
    for (int r = 0; r < 8; ++r) { const int t = t0 + r; float u[8], o[8], f[8]; unp(rw[15 + r], u);
        const float inv = 1.f / (float)((t + 1) < W ? (t + 1) : W);
#pragma unroll
        for (int e = 0; e < 8; ++e) { S[e] += u[e]; o[e] = S[e] * inv - u[e]; }
        st8(ZP + (rowb + t) * BRW + cch, o);
        if (t >= SEQ - PPAD) { float* so = out + O_PP + (((size_t)l * NBP + b) * PPAD + (t - (SEQ - PPAD))) * BRW + cch; *(f32x4*)so = (f32x4){u[0], u[1], u[2], u[3]}; *(f32x4*)(so + 4) = (f32x4){u[4], u[5], u[6], u[7]}; }
        unp(rw[15 + r - W + 1], f);
#pragma unroll
        for (int e = 0; e < 8; ++e) S[e] -= f[e]; }
}
template <int W> __device__ __forceinline__ void pool_run_s(const bf16* Z, int l, int b, int cch, const float* spool, bf16* ZP, float* out) {
    const size_t rowb = (size_t)MP + b * ST; const float* sp = spool + (((size_t)l * SB + b) * PPAD) * BRW + cch;
    f32x4 pf[W - 1][2]; u32x4_t rw[ST];
#pragma unroll
    for (int k = 0; k < W - 1; ++k) { pf[k][0] = *(const f32x4*)(sp + (size_t)(PPAD - (W - 1) + k) * BRW); pf[k][1] = *(const f32x4*)(sp + (size_t)(PPAD - (W - 1) + k) * BRW + 4); }
#pragma unroll
    for (int t = 0; t < ST; ++t) rw[t] = *(const u32x4_t*)(Z + (rowb + t) * ZW + ZPL + cch);
    auto unp = [](const u32x4_t w, float* f) { f[0] = __builtin_bit_cast(float, w.x << 16); f[1] = __builtin_bit_cast(float, w.x & 0xffff0000u); f[2] = __builtin_bit_cast(float, w.y << 16); f[3] = __builtin_bit_cast(float, w.y & 0xffff0000u);
        f[4] = __builtin_bit_cast(float, w.z << 16); f[5] = __builtin_bit_cast(float, w.z & 0xffff0000u); f[6] = __builtin_bit_cast(float, w.w << 16); f[7] = __builtin_bit_cast(float, w.w & 0xffff0000u); };
    float S[8];
#pragma unroll
    for (int e = 0; e < 8; ++e) S[e] = 0.f;
#pragma unroll
    for (int k = 0; k < W - 1; ++k) { S[0] += pf[k][0].x; S[1] += pf[k][0].y; S[2] += pf[k][0].z; S[3] += pf[k][0].w; S[4] += pf[k][1].x; S[5] += pf[k][1].y; S[6] += pf[k][1].z; S[7] += pf[k][1].w; }
    const float inv = 1.f / (float)W;
#pragma unroll
    for (int t = 0; t < ST; ++t) { float u[8], o[8], f[8]; unp(rw[t], u);
#pragma unroll
        for (int e = 0; e < 8; ++e) { S[e] += u[e]; o[e] = S[e] * inv - u[e]; }
        st8(ZP + (rowb + t) * BRW + cch, o);
        float* so = out + O_PS + (((size_t)l * SB + b) * PPAD + (PPAD - ST + t)) * BRW + cch; *(f32x4*)so = (f32x4){u[0], u[1], u[2], u[3]}; *(f32x4*)(so + 4) = (f32x4){u[4], u[5], u[6], u[7]};
        const int tt = t - W + 1;
        if (tt >= 0) unp(rw[tt >= 0 ? tt : 0], f);
        else { const int k = tt + W - 1 >= 0 ? tt + W - 1 : 0; f[0] = pf[k][0].x; f[1] = pf[k][0].y; f[2] = pf[k][0].z; f[3] = pf[k][0].w; f[4] = pf[k][1].x; f[5] = pf[k][1].y; f[6] = pf[k][1].z; f[7] = pf[k][1].w; }
#pragma unroll
        for (int e = 0; e < 8; ++e) S[e] -= f[e]; }
}
__device__ __forceinline__ void pool_phase(const bf16* Z, int l, const float* spool, bf16* ZP, float* out, int gw, int NGW, int lane, int gt, int NGT) {
    for (int wi = gw; wi < (MP / 8 / 2) * 4; wi += NGW) { const int cg = wi & 3, grp = (wi >> 2) * 2 + (lane >> 5), cch = (cg * 32 + (lane & 31)) * 8, b = grp >> 9, t0 = (grp & 511) * 8;
        if (cg == 0) pool_run<2>(Z, l, b, t0, cch, ZP, out); else if (cg == 1) pool_run<4>(Z, l, b, t0, cch, ZP, out); else if (cg == 2) pool_run<8>(Z, l, b, t0, cch, ZP, out); else pool_run<16>(Z, l, b, t0, cch, ZP, out); }
    for (int wi = gw; wi < (SB / 2) * 4; wi += NGW) { const int cg = wi & 3, b = (wi >> 2) * 2 + (lane >> 5), cch = (cg * 32 + (lane & 31)) * 8;
        if (cg == 0) pool_run_s<2>(Z, l, b, cch, spool, ZP, out); else if (cg == 1) pool_run_s<4>(Z, l, b, cch, spool, ZP, out); else if (cg == 2) pool_run_s<8>(Z, l, b, cch, spool, ZP, out); else pool_run_s<16>(Z, l, b, cch, spool, ZP, out); }
}
__device__ __forceinline__ void retout_s_phase(const bf16* Z, int l, const float* sret, const float* gret, bf16* Y3, int gw, int NGW, int lane) {
    for (int it = gw; it < MS * RH; it += NGW) { int h = __builtin_amdgcn_readfirstlane(it & 7); asm volatile("" : "+s"(h));
        const int rs = it >> 3, sb = rs >> 3, i = rs & 7; const size_t row = (size_t)MP + rs, row0 = (size_t)MP + sb * ST;
        const float lg = ret_logg(h);
        const bf16* qp = Z + row * ZW + ZRQ + h * 64;
        const float* S = sret + (((size_t)l * SB + sb) * RH + h) * RDK * RDV;
        float o0 = 0.f, o1 = 0.f;
        const float ql = bf2f(qp[lane]);
        bf16 kj[ST], v0j[ST], v1j[ST];
#pragma unroll
        for (int j = 0; j < ST; ++j) { const bf16* zj = Z + (row0 + j) * ZW; kj[j] = zj[ZRK + h * 64 + lane]; v0j[j] = zj[ZRV + h * 128 + lane]; v1j[j] = zj[ZRV + h * 128 + lane + 64]; }
#pragma unroll
        for (int d0 = 0; d0 < 64; d0 += 32) { float sa[32], sb_[32];
#pragma unroll
            for (int d = 0; d < 32; ++d) { sa[d] = S[(size_t)(d0 + d) * RDV + lane]; sb_[d] = S[(size_t)(d0 + d) * RDV + lane + 64]; }
#pragma unroll
            for (int d = 0; d < 32; ++d) { const float qd = __builtin_bit_cast(float, __builtin_amdgcn_readlane(__builtin_bit_cast(int, ql), d0 + d)); o0 += qd * sa[d]; o1 += qd * sb_[d]; } }
        const float cf = FEXP(lg * (float)(i + 1)); o0 *= cf; o1 *= cf;
#pragma unroll
        for (int j = 0; j < ST; ++j) { const float sc = j <= i ? wave_sum(ql * bf2f(kj[j])) * 0.125f * FEXP(lg * (float)(i - j)) : 0.f;
            o0 += sc * bf2f(v0j[j]); o1 += sc * bf2f(v1j[j]); }
        const float mean = wave_sum(o0 + o1) * (1.f / 128.f); const float d0 = o0 - mean, d1 = o1 - mean;
        const float rstd = 1.f / sqrtf(wave_sum(d0 * d0 + d1 * d1) * (1.f / 128.f) + EPS);
        const float* g = gret + l * BRW + h * 128; const bf16* rg = Z + row * ZW + ZRG + h * 128; bf16* y = Y3 + row * BRW + h * 128;
        y[lane] = f2bf(d0 * rstd * g[lane] * bf2f(rg[lane])); y[lane + 64] = f2bf(d1 * rstd * g[lane + 64] * bf2f(rg[lane + 64]));
    }
}
}
struct AdaOrder { int G, c; const char* A; const char* B;
    __device__ __forceinline__ bool next(int i, pg8::Unit& u) const { const int Lx = i * G + c; if (Lx >= DEPTH * (ADAW / 256)) return false;
        u.r = Lx / (ADAW / 256); u.pn = Lx % (ADAW / 256); u.pm = 0; u.ks = 0; u.nt = DM / 64; u.a = A; u.b = B + ((size_t)u.r * ADAW + (size_t)u.pn * 256) * DM * 2; return true; } };
struct PoolOrder { int G, c; const char* A; const char* B;
                __device__ __forceinline__ bool next(int i, pg8::Unit& u) const { const int Lx = i * G + c; if (Lx >= (M / 256) * 4) return false;
                    u.pm = Lx >> 2; u.pn = Lx & 3; u.r = 0; u.ks = 0; u.nt = 256 / 64; u.a = A + ((size_t)u.pm * 256 * BRW + (size_t)u.pn * 256) * 2; u.b = B + (size_t)u.pn * 256 * 256 * 2; return true; } };
__device__ __forceinline__ unsigned long long ld_ptr(volatile LAS unsigned* p) { const unsigned lo = __builtin_amdgcn_readfirstlane(p[0]), hi = __builtin_amdgcn_readfirstlane(p[1]); return ((unsigned long long)hi << 32) | lo; }
__device__ __forceinline__ att::f32x4 retstate_s_val(const bf16* Z, int l, int sb, int h, int d, int v4, const float* sret, float* out, float*& o) {
    const float lg = ret_logg(h);
    const size_t so = ((((size_t)l * SB + sb) * RH + h) * RDK + d) * RDV + v4 * 4;
    const float gc = FEXP(lg * (float)ST);
    const att::f32x4 s4 = *(const att::f32x4*)(sret + so); float a0 = gc * s4.x, a1 = gc * s4.y, a2 = gc * s4.z, a3 = gc * s4.w;
#pragma unroll
    for (int j = 0; j < ST; ++j) { const bf16* p = Z + (size_t)(MP + sb * ST + j) * ZW;
        const float kd = bf2f(p[ZRK + h * 64 + d]) * 0.125f * FEXP(lg * (float)(ST - 1 - j));
        const bf16* pv = p + ZRV + h * 128 + v4 * 4;
        a0 += kd * bf2f(pv[0]); a1 += kd * bf2f(pv[1]); a2 += kd * bf2f(pv[2]); a3 += kd * bf2f(pv[3]); }
    o = out + O_RS + so; return att::f32x4{a0, a1, a2, a3};
}
constexpr int NPL = 12;
constexpr int PH_TOTAL = 2 + DEPTH * NPL + 1;
constexpr int KS_BR = 2, KS_OUT = 8, KS_M1 = 4, KS_M2 = 16;
struct Args { const float* in[N_IN]; float* out; unsigned char* ws; int ph_lo, ph_hi; };
static_assert(sizeof(Args) == N_IN * 8 + 8 + 8 + 8, "Args has no padding");

__global__ void __launch_bounds__(NTHR, 2) fwd(Args args) {
    extern __shared__ __attribute__((aligned(16))) unsigned char lds[];
    LAS unsigned char* L0 = (LAS unsigned char*)lds;
    volatile LAS unsigned* MISC = (volatile LAS unsigned*)(L0 + MISC_OFF);
    const int G = gridDim.x, bx = blockIdx.x, wave0 = __builtin_amdgcn_readfirstlane(threadIdx.x >> 6);
    unsigned char* ws0 = args.ws;
    for (int u = threadIdx.x; u < (LDS_BYTES - LDSCTL_OFF) / 4; u += NTHR) ((LAS unsigned*)(L0 + LDSCTL_OFF))[u] = 0u;
    __syncthreads();
    if (threadIdx.x <= N_IN) ((LAS unsigned long long*)(L0 + INTAB_OFF))[threadIdx.x] = threadIdx.x < N_IN ? (unsigned long long)args.in[threadIdx.x < N_IN ? threadIdx.x : 0] : (unsigned long long)args.out;
    __syncthreads();
#if MK_ONE_LAUNCH
    XcdBarrier bar = xcd_barrier_post((unsigned*)(ws0 + WS_CTL) + CW_BAR, MISC + 8);
#define GRID_BAR() xcd_barrier(bar)
#else
#define GRID_BAR() do {} while (0)
#endif
    const int lo = args.ph_lo, hi = args.ph_hi;
#ifndef PH_MASK
#define PH_MASK 0x7FFF
#endif
#ifndef PROBE_MASK
#define PROBE_MASK 0
#endif
#define PROBE_BEGIN(bit) unsigned long long pr_t0 = 0; if ((PROBE_MASK >> (bit)) & 1) pr_t0 = __builtin_amdgcn_s_memrealtime()
#define PROBE_END(bit) do { if ((PROBE_MASK >> (bit)) & 1) { __syncthreads(); const unsigned long long t1 = __builtin_amdgcn_s_memrealtime(); while (__builtin_amdgcn_s_memrealtime() - t1 < t1 - pr_t0) __builtin_amdgcn_s_sleep(8); } } while (0)
#define TAIL_FILL(nsub, N, ...) do { const int f0_ = (nsub) < G ? (nsub) : 0; if (bx >= f0_) for (int i = (bx - f0_) * NTHR + tid; i < (N); i += (G - f0_) * NTHR) { __VA_ARGS__; } } while (0)
#define IN(k) (lo <= (k) && (k) < hi)
#define SEAM(k) do { if (IN((k) + 1)) GRID_BAR(); } while (0)
#define INP(i)  ((const float*)(GAS const float*)ld_ptr((volatile LAS unsigned*)(L + INTAB_OFF) + 2 * (i)))
#define P_OUT   ((float*)(GAS float*)ld_ptr((volatile LAS unsigned*)(L + INTAB_OFF) + 2 * N_IN))
#define WIN_T   ((bf16*)(ws + WS_WIN))
#define WBR_T   ((bf16*)(ws + WS_WBR))
#define WOUT_T  ((bf16*)(ws + WS_WOUT))
#define WM1_T   ((bf16*)(ws + WS_WM1))
#define WM2_T   ((bf16*)(ws + WS_WM2))
#define WPOOL_T ((bf16*)(ws + WS_WPOOL))
#define WADA_T  ((bf16*)(ws + WS_WADA))
#define SC      ((bf16*)(ws + WS_SC))
#define ADA     ((float*)(ws + WS_ADA))
#define H       ((bf16*)(ws + WS_H))
#define Z       ((bf16*)(ws + WS_Z))
#define Y       ((bf16*)(ws + WS_Y))
#define ZP      ((bf16*)(ws + WS_ZP))
#define CONVY   ((float*)(ws + WS_CONVY))
#define ORAW    ((float*)(ws + WS_ORAW))
#define KV      ((float*)(ws + WS_KV))
#define SPREV   ((float*)(ws + WS_SPREV))
#define MACC    ((float*)(ws + WS_MACC))
#define MERGED  ((bf16*)(ws + WS_MERGED))
#define X1      ((float*)(ws + WS_X1))
#define X       ((float*)(ws + WS_X))
#define HID     ((bf16*)(ws + WS_HID))
#define SLAB    ((float*)(ws + WS_SLAB))
#define TIDS() int lane; asm volatile("v_mbcnt_lo_u32_b32 %0, -1, 0\n\tv_mbcnt_hi_u32_b32 %0, -1, %0" : "=v"(lane)); GAS unsigned char* wsg = (GAS unsigned char*)ws0; asm volatile("" : "+s"(wsg)); unsigned char* ws = (unsigned char*)wsg; LAS unsigned char* L = L0; asm volatile("" : "+s"(L)); const int wave = wave0, tid = wave0 * 64 + lane; const int gw = bx * NWAVES + wave, NGW = G * NWAVES; const int gt = bx * NTHR + tid, NGT = G * NTHR; (void)lane; (void)gw; (void)NGW; (void)gt; (void)NGT
#define LAYER_PTRS() const float* ada = ADA + (size_t)l * NROWB * ADAW; const float* xinP = l == 0 ? INP(I_XP) : X; const float* xinS = l == 0 ? INP(I_XS) : X + (size_t)MP * DM; float* xout = l == DEPTH - 1 ? P_OUT : X; (void)ada; (void)xinP; (void)xinS; (void)xout
    if ((PH_MASK >> 12 & 1) && IN(0)) { TIDS(); PROBE_BEGIN(12);
        transpose_run<DM, ZW, true>(INP(I_WIN), WIN_T, DEPTH, gw, NGW, lane);
        transpose_run<BRW, DM>(INP(I_WBR), WBR_T, DEPTH * 4, gw, NGW, lane);
        transpose_run<DM, DM>(INP(I_WOUT), WOUT_T, DEPTH, gw, NGW, lane);
        transpose_run<DM, DFF>(INP(I_WM1), WM1_T, DEPTH, gw, NGW, lane);
        transpose_run<DFF, DM>(INP(I_WM2), WM2_T, DEPTH, gw, NGW, lane);
        transpose_run<256, 256>(INP(I_WPOOL), WPOOL_T, DEPTH * 4, gw, NGW, lane);
        adad::phase(INP(I_CP), INP(I_CS), INP(I_WADA), INP(I_BADA), ADA, L + RING_OFF, bx, G, wave, lane, tid);
        PROBE_END(12); SEAM(0);
    }
    for (int l = 0; l < DEPTH; ++l) {
        const int pb = 2 + l * NPL;
        if ((PH_MASK >> 0 & 1) && IN(pb + 0)) { TIDS(); LAYER_PTRS(); PROBE_BEGIN(0);
            for (int rs = bx; rs < MS; rs += G) { const int row = MP + rs; const float* ar = ada + (size_t)row_cond(row) * ADAW;
                if (l == 0) norm_row_block<0>(xinS + (size_t)rs * DM, nullptr, nullptr, 0, nullptr, INP(I_G1) + l * DM, ar + DM, ar, H + (size_t)row * DM, (LAS float*)(L + RING_OFF), tid, wave);
                else norm_row_block<KS_M2>(X1 + (size_t)row * DM, ar - (size_t)NROWB * ADAW + 5 * DM, SLAB + (size_t)rs * DM, (size_t)MS * DM, X + (size_t)row * DM, INP(I_G1) + l * DM, ar + DM, ar, H + (size_t)row * DM, (LAS float*)(L + RING_OFF), tid, wave); }
            f32x4 gm[8], shv[8]; int curc = row_cond(gw < MP ? gw : 0); { const float* ar = ada + (size_t)curc * ADAW; load_mod(INP(I_G1) + l * DM, ar + DM, ar, gm, shv, lane); }
            for (int row = gw; row < MP; row += 2 * NGW) { const int rowb = row + NGW; const bool pair = rowb < MP && row_cond(rowb) == row_cond(row);
                for (int k = 0; k < 2; ++k) { const int r = k ? rowb : row; if (k && (pair || rowb >= MP)) break; const int cond = row_cond(r); const float* ar = ada + (size_t)cond * ADAW;
                    if (cond != curc) { load_mod(INP(I_G1) + l * DM, ar + DM, ar, gm, shv, lane); curc = cond; }
                    if (pair) norm_row2(xinP + (size_t)row * DM, xinP + (size_t)rowb * DM, gm, shv, H + (size_t)row * DM, H + (size_t)rowb * DM, lane);
                    else norm_row(xinP + (size_t)r * DM, gm, shv, H + (size_t)r * DM, lane); } }
            PROBE_END(0); SEAM(pb + 0);
        }
        if ((PH_MASK >> 1 & 1) && IN(pb + 1)) { TIDS(); LAYER_PTRS(); PROBE_BEGIN(1);
            pg8::StaticOrder S; S.init(H, WIN_T + (size_t)l * ZW * DM, M / 256, ZW / 256, DM, DM, DM, G, bx);
            pg8::EpiZ E{Z};
            pg8::gemm_phase<pg8::EpiZ, pg8::StaticOrder>(L + RING_OFF, pg8::Dims{DM, DM, DM}, S, E, tid);
            PROBE_END(1); SEAM(pb + 1);
        }
        if ((PH_MASK >> 2 & 1) && IN(pb + 2)) { TIDS(); LAYER_PTRS(); PROBE_BEGIN(2);
            mixl::qknorm_phase(Z, l, INP(I_GQ), INP(I_GK), P_OUT, gw, NGW, lane);
            mixl::conv_phase(L + RING_OFF, Z, l, INP(I_WDW), INP(I_BDW), INP(I_SCONV), CONVY, P_OUT, bx, G, tid);
            mixl::pool_phase(Z, l, INP(I_SPOOL), ZP, P_OUT, gw, NGW, lane, gt, NGT);
            ret::kv_phase(L + RING_OFF, Z, KV, bx, G, tid, lane, wave);
            PROBE_END(2); SEAM(pb + 2);
        }
        if ((PH_MASK >> 3 & 1) && IN(pb + 3)) { TIDS(); LAYER_PTRS(); PROBE_BEGIN(3);
            att::phase(L + RING_OFF, Z, l, INP(I_SINK), INP(I_CK), INP(I_CV), Y, bx, G, tid, lane, wave);
            for (int i = gt; i < NBP * RH * RDK * 32; i += NGT) { const int v4 = i & 31, d = (i >> 5) & 63, b = i >> 14; int h = (i >> 11) & 7;
                const size_t o0 = (((size_t)b * 32 * RH + h) * RDK + d) * RDV + v4 * 4, cs = (size_t)RH * RDK * RDV; f32x4 kvv[32];
#pragma unroll
                for (int n = 0; n < 32; ++n) kvv[n] = *(const f32x4*)(KV + o0 + n * cs);
                const float gc = FEXP(ret_logg(h) * 128.f); float z0 = 0.f; asm volatile("" : "+v"(z0)); f32x4 sacc = {z0, z0, z0, z0};
#pragma unroll
                for (int n = 0; n < 32; ++n) { *(f32x4*)(SPREV + o0 + n * cs) = sacc; sacc = sacc * gc + kvv[n]; }
                *(f32x4*)(P_OUT + O_RP + ((((size_t)l * NBP + b) * RH + h) * RDK + d) * RDV + v4 * 4) = sacc; }
            { f32x4 gv4[4], bv4[4];
#pragma unroll
              for (int j = 0; j < 4; ++j) { gv4[j] = ((const f32x4*)(INP(I_GCLN) + l * BRW))[lane + 64 * j]; bv4[j] = ((const f32x4*)(INP(I_BCLN) + l * BRW))[lane + 64 * j]; }
              for (int row = gw; row < M; row += NGW) convln_row(CONVY + (size_t)row * BRW, gv4, bv4, Y + (size_t)1 * M * BRW + (size_t)row * BRW, lane); }
            PROBE_END(3); SEAM(pb + 3);
        }
        if ((PH_MASK >> 4 & 1) && IN(pb + 4)) { TIDS(); LAYER_PTRS(); PROBE_BEGIN(4);
            mixl::retout_s_phase(Z, l, INP(I_SRET), INP(I_GRET), Y + (size_t)3 * M * BRW, gw, NGW, lane);
            ret::out_phase(L + RING_OFF, Z, l, SPREV, INP(I_GRET), Y + (size_t)3 * M * BRW, bx, G, tid, lane, wave);
            PoolOrder S{G, bx, (const char*)ZP, (const char*)(WPOOL_T + (size_t)l * 4 * 256 * 256)};
            pg8::EpiPool E{Y + (size_t)2 * M * BRW, INP(I_SPOOLS), l};
            pg8::gemm_phase<pg8::EpiPool, PoolOrder>(L + RING_OFF, pg8::Dims{BRW, 256, 256}, S, E, tid);
            PROBE_END(4); SEAM(pb + 4);
        }
        if ((PH_MASK >> 5 & 1) && IN(pb + 5)) { TIDS(); LAYER_PTRS(); PROBE_BEGIN(5);
            pg8::SplitOrder S{DM / 256, G, bx, 4, BRW / 64, KS_BR, BRW / 64 / KS_BR, (const char*)Y, (const char*)(WBR_T + (size_t)l * 4 * DM * BRW), (size_t)256 * BRW * 2, (size_t)256 * BRW * 2, (size_t)M * BRW * 2, (size_t)DM * BRW * 2};
            pg8::EpiBr E{Z, MERGED, SLAB, KS_BR};
            pg8::gemm_phase<pg8::EpiBr, pg8::SplitOrder>(L + RING_OFF, pg8::Dims{BRW, BRW, BRW}, S, E, tid);
            PROBE_END(5); SEAM(pb + 5);
        }
        if ((PH_MASK >> 6 & 1) && IN(pb + 6)) { TIDS(); LAYER_PTRS(); PROBE_BEGIN(6);
            for (int i = gt; i < MS * DM / 8; i += NGT) { float a[8];
#pragma unroll
                for (int e = 0; e < 8; ++e) a[e] = 0.f;
#pragma unroll
                for (int p = 0; p < 4 * KS_BR; ++p) { const f32x4 v0 = *(const f32x4*)(SLAB + (size_t)p * MS * DM + (size_t)i * 8), v1 = *(const f32x4*)(SLAB + (size_t)p * MS * DM + (size_t)i * 8 + 4);
                    a[0] += v0.x; a[1] += v0.y; a[2] += v0.z; a[3] += v0.w; a[4] += v1.x; a[5] += v1.y; a[6] += v1.z; a[7] += v1.w; }
                st8(MERGED + (size_t)MP * DM + (size_t)i * 8, a); }
            PROBE_END(6); SEAM(pb + 6);
        }
        if ((PH_MASK >> 7 & 1) && IN(pb + 7)) { TIDS(); LAYER_PTRS(); PROBE_BEGIN(7);
            pg8::SplitOrder S{DM / 256, G, bx, 1, DM / 64, KS_OUT, DM / 64 / KS_OUT, (const char*)MERGED, (const char*)(WOUT_T + (size_t)l * DM * DM), (size_t)256 * DM * 2, (size_t)256 * DM * 2, 0, 0};
            pg8::EpiRes E{xinP, xinS, X1, ada + 2 * DM, SLAB};
            pg8::gemm_phase<pg8::EpiRes, pg8::SplitOrder>(L + RING_OFF, pg8::Dims{DM, DM, DM}, S, E, tid);
            PROBE_END(7); SEAM(pb + 7);
        }
        if ((PH_MASK >> 8 & 1) && IN(pb + 8)) { TIDS(); LAYER_PTRS(); PROBE_BEGIN(8);
            for (int rs = bx; rs < MS; rs += G) { const int row = MP + rs; const float* ar = ada + (size_t)row_cond(row) * ADAW;
                norm_row_block<KS_OUT>(xinS + (size_t)rs * DM, ar + 2 * DM, SLAB + (size_t)rs * DM, (size_t)MS * DM, X1 + (size_t)row * DM, INP(I_G2) + l * DM, ar + 4 * DM, ar + 3 * DM, H + (size_t)row * DM, (LAS float*)(L + RING_OFF), tid, wave); }
            f32x4 gm[8], shv[8]; int curc = row_cond(gw < MP ? gw : 0); { const float* ar = ada + (size_t)curc * ADAW; load_mod(INP(I_G2) + l * DM, ar + 4 * DM, ar + 3 * DM, gm, shv, lane); }
            for (int row = gw; row < MP; row += 2 * NGW) { const int rowb = row + NGW; const bool pair = rowb < MP && row_cond(rowb) == row_cond(row);
                for (int k = 0; k < 2; ++k) { const int r = k ? rowb : row; if (k && (pair || rowb >= MP)) break; const int cond = row_cond(r); const float* ar = ada + (size_t)cond * ADAW;
                    if (cond != curc) { load_mod(INP(I_G2) + l * DM, ar + 4 * DM, ar + 3 * DM, gm, shv, lane); curc = cond; }
                    if (pair) norm_row2(X1 + (size_t)row * DM, X1 + (size_t)rowb * DM, gm, shv, H + (size_t)row * DM, H + (size_t)rowb * DM, lane);
                    else norm_row(X1 + (size_t)r * DM, gm, shv, H + (size_t)r * DM, lane); } }
            PROBE_END(8); SEAM(pb + 8);
        }
        if ((PH_MASK >> 9 & 1) && IN(pb + 9)) { TIDS(); LAYER_PTRS(); PROBE_BEGIN(9);
            pg8::SplitOrder S{DFF / 256, G, bx, 1, DM / 64, KS_M1, DM / 64 / KS_M1, (const char*)H, (const char*)(WM1_T + (size_t)l * DFF * DM), (size_t)256 * DM * 2, (size_t)256 * DM * 2, 0, 0};
            pg8::EpiMlp1 E{HID, SLAB};
            pg8::gemm_phase<pg8::EpiMlp1, pg8::SplitOrder>(L + RING_OFF, pg8::Dims{DM, DM, DM}, S, E, tid);
            {
                const int f0 = (DFF / 256) * KS_M1 < G ? (DFF / 256) * KS_M1 : 0;
                if (bx >= f0) { const int st = (G - f0) * NTHR;
                    for (int i0 = (bx - f0) * NTHR + tid; i0 < N_SHIFT_ITEMS; i0 += 4 * st) { f32x4 v[4]; float* dp[4];
#pragma unroll
                        for (int u = 0; u < 4; ++u) { const int idx = i0 + u * st; dp[u] = nullptr; v[u] = f32x4{0.f, 0.f, 0.f, 0.f};
                            if (idx < N_SHIFT_ITEMS) { const float* sp; shift_addr(l, idx, INP(I_CK), INP(I_CV), INP(I_SCONV), INP(I_SPOOL), P_OUT, sp, dp[u]); v[u] = *(const f32x4*)sp; } }
                        asm volatile("" ::: "memory");
#pragma unroll
                        for (int u = 0; u < 4; ++u) if (dp[u]) *(f32x4*)dp[u] = v[u]; } } }
            PROBE_END(9); SEAM(pb + 9);
        }
        if ((PH_MASK >> 10 & 1) && IN(pb + 10)) { TIDS(); LAYER_PTRS(); PROBE_BEGIN(10);
            for (int i = gt; i < MS * DFF / 8; i += NGT) { float a[8];
#pragma unroll
                for (int e = 0; e < 8; ++e) a[e] = 0.f;
#pragma unroll
                for (int p = 0; p < KS_M1; ++p) { const f32x4 v0 = *(const f32x4*)(SLAB + (size_t)p * MS * DFF + (size_t)i * 8), v1 = *(const f32x4*)(SLAB + (size_t)p * MS * DFF + (size_t)i * 8 + 4);
                    a[0] += v0.x; a[1] += v0.y; a[2] += v0.z; a[3] += v0.w; a[4] += v1.x; a[5] += v1.y; a[6] += v1.z; a[7] += v1.w; }
#pragma unroll
                for (int e = 0; e < 8; ++e) { const float t = fmaxf(a[e], 0.f); a[e] = t * t; }
                st8(HID + (size_t)MP * DFF + (size_t)i * 8, a); }
            PROBE_END(10); SEAM(pb + 10);
        }
        if ((PH_MASK >> 11 & 1) && IN(pb + 11)) { TIDS(); LAYER_PTRS(); PROBE_BEGIN(11);
            pg8::SplitOrder S{DM / 256, G, bx, 1, DFF / 64, KS_M2, DFF / 64 / KS_M2, (const char*)HID, (const char*)(WM2_T + (size_t)l * DM * DFF), (size_t)256 * DFF * 2, (size_t)256 * DFF * 2, 0, 0};
            pg8::EpiRes E{X1, X1 + (size_t)MP * DM, xout, ada + 5 * DM, SLAB};
            pg8::gemm_phase<pg8::EpiRes, pg8::SplitOrder>(L + RING_OFF, pg8::Dims{DFF, DFF, DFF}, S, E, tid);
            {
                const int f0 = (DM / 256) * KS_M2 < G ? (DM / 256) * KS_M2 : 0; constexpr int NI = SB * RH * RDK * 32;
                if (bx >= f0) { const int st = (G - f0) * NTHR;
                    for (int i0 = (bx - f0) * NTHR + tid; i0 < NI; i0 += 2 * st) { f32x4 r[2]; float* op[2];
#pragma unroll
                        for (int u = 0; u < 2; ++u) { const int i = i0 + u * st; op[u] = nullptr; r[u] = f32x4{0.f, 0.f, 0.f, 0.f};
                            if (i < NI) { const int v4 = i & 31, d = (i >> 5) & 63, h = (i >> 11) & 7, sb = i >> 14; r[u] = retstate_s_val(Z, l, sb, h, d, v4, INP(I_SRET), P_OUT, op[u]); } }
                        asm volatile("" ::: "memory");
#pragma unroll
                        for (int u = 0; u < 2; ++u) if (op[u]) *(f32x4*)op[u] = r[u]; } } }
            PROBE_END(11); SEAM(pb + 11);
        }
    }
    if ((PH_MASK >> 14 & 1) && IN(PH_TOTAL - 1)) { TIDS(); PROBE_BEGIN(14);
        const float* ada = ADA + (size_t)(DEPTH - 1) * NROWB * ADAW; float* yo = P_OUT + O_YS;
        for (int i = gt; i < MS * DM / 4; i += NGT) { const int row = i / (DM / 4), c4 = i % (DM / 4); const float* gp = ada + (size_t)(NBP + (row >> 3)) * ADAW + 5 * DM;
            f32x4 a = {0.f, 0.f, 0.f, 0.f};
#pragma unroll
            for (int p = 0; p < KS_M2; ++p) a += *(const f32x4*)(SLAB + (size_t)p * MS * DM + (size_t)i * 4);
            *(f32x4*)(yo + (size_t)i * 4) = *(const f32x4*)(X1 + (size_t)(MP + row) * DM + c4 * 4) + *(const f32x4*)(gp + c4 * 4) * a; }
        PROBE_END(14);
    }
#undef IN
#undef SEAM
}

extern "C" void kernel_launch(void* const* d_in, const int* in_sizes, int n_in, void* d_out, int out_size, void* d_ws, size_t ws_size, hipStream_t stream) {
    static int grid = 0;
    if (grid == 0) {
        if (n_in != N_IN || (size_t)out_size != O_END || ws_size < WS_END) { fprintf(stderr, "kernel_launch: unexpected shapes: n_in %d out %d ws %zu (need %zu)\n", n_in, out_size, ws_size, (size_t)WS_END); grid = -1; return; }
        int dev = 0, cus = 0, per_cu = 0;
        if (hipGetDevice(&dev) != hipSuccess || hipDeviceGetAttribute(&cus, hipDeviceAttributeMultiprocessorCount, dev) != hipSuccess) { grid = -1; return; }
        if (hipFuncSetAttribute((const void*)fwd, hipFuncAttributeMaxDynamicSharedMemorySize, LDS_BYTES) != hipSuccess) { fprintf(stderr, "kernel_launch: hipFuncSetAttribute failed\n"); grid = -1; return; }
        if (hipOccupancyMaxActiveBlocksPerMultiprocessor(&per_cu, (const void*)fwd, NTHR, LDS_BYTES) != hipSuccess || per_cu < 1) fprintf(stderr, "kernel_launch: occupancy query says %d\n", per_cu);
        (void)hipGetLastError();
        grid = cus;
    }
    if (grid < 0) return;
    (void)hipMemsetAsync((char*)d_ws + WS_CTL, 0, CTL_ZERO_BYTES, stream);
    Args a{};
    for (int i = 0; i < N_IN; ++i) a.in[i] = (const float*)d_in[i];
    a.out = (float*)d_out; a.ws = (unsigned char*)d_ws;
#if MK_ONE_LAUNCH
    a.ph_lo = 0; a.ph_hi = PH_TOTAL;
    hipLaunchKernelGGL(fwd, dim3(grid), dim3(NTHR), LDS_BYTES, stream, a);
#else
    for (int p = 0; p < PH_TOTAL; ++p) { a.ph_lo = p; a.ph_hi = p + 1; hipLaunchKernelGGL(fwd, dim3(grid), dim3(NTHR), LDS_BYTES, stream, a); }
#endif
}
#endif
```

```cpp
#ifndef HOST_TEST_ONLY
#include <hip/hip_runtime.h>
#endif
#include <cstdio>
#include <cstdint>
#include <cmath>

#ifndef MK_ONE_LAUNCH
#define MK_ONE_LAUNCH 1
#endif

#define HD __host__ __device__ __forceinline__
typedef unsigned short bf16;
HD float bf2f(bf16 b) { return __builtin_bit_cast(float, ((unsigned)b) << 16); }
HD bf16 f2bf(float f) { unsigned u = __builtin_bit_cast(unsigned, f); return (bf16)((u + 0x7fffu + ((u >> 16) & 1u)) >> 16); }

HD void ld8(const bf16* p, float* f) { const uint4 w = *(const uint4*)p;
    f[0] = __builtin_bit_cast(float, w.x << 16); f[1] = __builtin_bit_cast(float, w.x & 0xffff0000u); f[2] = __builtin_bit_cast(float, w.y << 16); f[3] = __builtin_bit_cast(float, w.y & 0xffff0000u);
    f[4] = __builtin_bit_cast(float, w.z << 16); f[5] = __builtin_bit_cast(float, w.z & 0xffff0000u); f[6] = __builtin_bit_cast(float, w.w << 16); f[7] = __builtin_bit_cast(float, w.w & 0xffff0000u); }
HD void st8(bf16* p, const float* f) { uint4 w; w.x = (unsigned)f2bf(f[0]) | ((unsigned)f2bf(f[1]) << 16); w.y = (unsigned)f2bf(f[2]) | ((unsigned)f2bf(f[3]) << 16);
    w.z = (unsigned)f2bf(f[4]) | ((unsigned)f2bf(f[5]) << 16); w.w = (unsigned)f2bf(f[6]) | ((unsigned)f2bf(f[7]) << 16); *(uint4*)p = w; }
constexpr int DM = 2048, SEQ = 4096, NBP = 2, MP = NBP * SEQ, SB = 32, ST = 8, MS = SB * ST, M = MP + MS, DEPTH = 4;
constexpr int NROWB = NBP + SB;
constexpr int NH = 16, HDIM = 64, NKV = 4, WIN = 128, BRW = 1024, CONVK = 31, CPRE = 30, PPAD = 15, RH = 8, RDK = 64, RDV = 128, DFF = 8192;
constexpr int ZW = 15872, ZQ = 0, ZK = 1024, ZV = 1280, ZCA = 1536, ZCG = 2560, ZPL = 3584, ZRQ = 4608, ZRK = 5120, ZRV = 5632, ZRG = 6656, ZGT = 7680;
constexpr int ADAW = 6 * DM;
constexpr float EPS = 1e-6f;
constexpr size_t O_YP = 0, O_YS = O_YP + (size_t)MP * DM, O_KP = O_YS + (size_t)MS * DM, O_VP = O_KP + (size_t)DEPTH * NBP * WIN * 256,
    O_CP = O_VP + (size_t)DEPTH * NBP * WIN * 256, O_PP = O_CP + (size_t)DEPTH * NBP * CPRE * BRW, O_RP = O_PP + (size_t)DEPTH * NBP * PPAD * BRW,
    O_KS = O_RP + (size_t)DEPTH * NBP * RH * RDK * RDV, O_VS = O_KS + (size_t)DEPTH * SB * WIN * 256, O_CS = O_VS + (size_t)DEPTH * SB * WIN * 256,
    O_PS = O_CS + (size_t)DEPTH * SB * CPRE * BRW, O_RS = O_PS + (size_t)DEPTH * SB * PPAD * BRW, O_END = O_RS + (size_t)DEPTH * SB * RH * RDK * RDV;
static_assert(O_END == 41394176, "output size");
enum { I_XP = 0, I_XS, I_CP, I_CS, I_CK, I_CV, I_SCONV, I_SPOOL, I_SRET, I_WADA, I_BADA, I_G1, I_G2, I_WIN, I_GQ, I_GK, I_SINK, I_WDW, I_BDW, I_GCLN, I_BCLN,
       I_WPOOL, I_SPOOLS, I_GRET, I_WBR, I_WOUT, I_WM1, I_WM2, N_IN };

HD bool row_is_s(int row) { return row >= MP; }
HD int row_cond(int row) { return row < MP ? (row >> 12) : NBP + ((row - MP) >> 3); }

#if defined(__HIP_DEVICE_COMPILE__)
#define FEXP(x) __expf(x)
#else
#define FEXP(x) expf(x)
#endif
#if defined(__HIP_DEVICE_COMPILE__)
HD float sigmoidf_(float x) { return __builtin_amdgcn_rcpf(1.f + __expf(-x)); }
#else
HD float sigmoidf_(float x) { return 1.f / (1.f + FEXP(-x)); }
#endif
HD float ret_logg(int h) { const float x = __builtin_bit_cast(float, (unsigned)(127 - 5 - h) << 23); return -x * (1.f + x * (0.5f + x * (0.33333334f + x * (0.25f + x * 0.2f)))); }

HD void qknorm_item(bf16* Z, int l, int row, int slot, const float* gq, const float* gk, float* out) {
    const int col = slot < 16 ? ZQ + slot * 64 : (slot < 20 ? ZK + (slot - 16) * 64 : ZV + (slot - 20) * 64);
    bf16* p = Z + (size_t)row * ZW + col;
    float v[64];
#pragma unroll
    for (int i = 0; i < 64; i += 8) ld8(p + i, v + i);
    if (slot < 20) {
        float ss = 0.f;
#pragma unroll
        for (int i = 0; i < 64; ++i) ss += v[i] * v[i];
        const float r = 1.f / sqrtf(ss * (1.f / 64.f) + EPS);
        const float* g = (slot < 16 ? gq : gk) + l * 64;
#pragma unroll
        for (int i = 0; i < 64; ++i) v[i] = v[i] * r * g[i];
#pragma unroll
        for (int i = 0; i < 64; i += 8) st8(p + i, v + i);
    }
    if (slot >= 16) {
        const int kvh = (slot - 16) & 3; const bool isv = slot >= 20;
        float* o = nullptr;
        if (!row_is_s(row)) { const int b = row >> 12, t = row & (SEQ - 1);
            if (t >= SEQ - WIN) o = out + (isv ? O_VP : O_KP) + ((((size_t)l * NBP + b) * WIN + (t - (SEQ - WIN))) * NKV + kvh) * 64;
        } else { const int sb = (row - MP) >> 3, t = (row - MP) & 7;
            o = out + (isv ? O_VS : O_KS) + ((((size_t)l * SB + sb) * WIN + (WIN - ST + t)) * NKV + kvh) * 64; }
        if (o) {
#pragma unroll
            for (int i = 0; i < 64; ++i) o[i] = v[i];
        }
    }
}
HD void shift_addr(int l, int idx, const float* ck, const float* cv, const float* sconv, const float* spool, float* out, const float*& src, float*& dst) {
    constexpr int NKVS = SB * (WIN - ST) * 64, NCV = SB * (CPRE - ST) * 256, NPL = SB * (PPAD - ST) * 256;
    if (idx < 2 * NKVS) { const bool isv = idx >= NKVS; const int i = isv ? idx - NKVS : idx; const int sb = i / ((WIN - ST) * 64), rem = i % ((WIN - ST) * 64);
        src = (isv ? cv : ck) + (((size_t)l * SB + sb) * WIN + ST) * 256 + (size_t)rem * 4; dst = out + (isv ? O_VS : O_KS) + (((size_t)l * SB + sb) * WIN) * 256 + (size_t)rem * 4;
    } else if (idx < 2 * NKVS + NCV) { const int i = idx - 2 * NKVS; const int sb = i / ((CPRE - ST) * 256), rem = i % ((CPRE - ST) * 256);
        src = sconv + (((size_t)l * SB + sb) * CPRE + ST) * BRW + (size_t)rem * 4; dst = out + O_CS + (((size_t)l * SB + sb) * CPRE) * BRW + (size_t)rem * 4;
    } else { const int i = idx - 2 * NKVS - NCV; const int sb = i / ((PPAD - ST) * 256), rem = i % ((PPAD - ST) * 256);
        src = spool + (((size_t)l * SB + sb) * PPAD + ST) * BRW + (size_t)rem * 4; dst = out + O_PS + (((size_t)l * SB + sb) * PPAD) * BRW + (size_t)rem * 4; }
}
HD void shift_item(int l, int idx, const float* ck, const float* cv, const float* sconv, const float* spool, float* out) {
    const float* src; float* dst; shift_addr(l, idx, ck, cv, sconv, spool, out, src, dst);
    dst[0] = src[0]; dst[1] = src[1]; dst[2] = src[2]; dst[3] = src[3];
}
constexpr int N_SHIFT_ITEMS = 2 * SB * (WIN - ST) * 64 + SB * (CPRE - ST) * 256 + SB * (PPAD - ST) * 256;

HD float glu_at(const bf16* Z, int row, int c) { const bf16* p = Z + (size_t)row * ZW; return bf2f(p[ZCA + c]) * sigmoidf_(bf2f(p[ZCG + c])); }
HD void conv_item(const bf16* Z, int l, int row, int c, const float* wdw, const float* bdw, const float* sconv, float* CONVY, float* out) {
    float acc = bdw[l * BRW + c];
    const float* w = wdw + (size_t)l * CONVK * BRW + c;
    if (!row_is_s(row)) { const int b = row >> 12, t = row & (SEQ - 1);
        for (int j = 0; j < CONVK; ++j) { const int tt = t - CPRE + j; if (tt >= 0) acc += w[(size_t)j * BRW] * glu_at(Z, b * SEQ + tt, c); }
        if (t >= SEQ - CPRE) out[O_CP + (((size_t)l * NBP + b) * CPRE + (t - (SEQ - CPRE))) * BRW + c] = glu_at(Z, row, c);
    } else { const int sb = (row - MP) >> 3, t = (row - MP) & 7;
        for (int j = 0; j < CONVK; ++j) { const int tt = t - CPRE + j;
            const float u = tt >= 0 ? glu_at(Z, MP + sb * ST + tt, c) : sconv[(((size_t)l * SB + sb) * CPRE + (CPRE + tt)) * BRW + c];
            acc += w[(size_t)j * BRW] * u; }
        out[O_CS + (((size_t)l * SB + sb) * CPRE + (CPRE - ST + t)) * BRW + c] = glu_at(Z, row, c);
    }
    CONVY[(size_t)row * BRW + c] = acc;
}
HD void pool_item(const bf16* Z, int l, int row, int c, const float* spool, bf16* ZP, float* out) {
    const int g = c >> 8, w = 2 << g;
    const float u0 = bf2f(Z[(size_t)row * ZW + ZPL + c]);
    float sum = 0.f, cnt;
    if (!row_is_s(row)) { const int b = row >> 12, t = row & (SEQ - 1);
        for (int i = 0; i < w; ++i) if (t - i >= 0) sum += bf2f(Z[(size_t)(b * SEQ + t - i) * ZW + ZPL + c]);
        cnt = (float)((t + 1) < w ? (t + 1) : w);
        if (t >= SEQ - PPAD) out[O_PP + (((size_t)l * NBP + b) * PPAD + (t - (SEQ - PPAD))) * BRW + c] = u0;
    } else { const int sb = (row - MP) >> 3, t = (row - MP) & 7;
        for (int i = 0; i < w; ++i) { const int tt = t - i;
            sum += tt >= 0 ? bf2f(Z[(size_t)(MP + sb * ST + tt) * ZW + ZPL + c]) : spool[(((size_t)l * SB + sb) * PPAD + (PPAD + tt)) * BRW + c]; }
        cnt = (float)w;
        out[O_PS + (((size_t)l * SB + sb) * PPAD + (PPAD - ST + t)) * BRW + c] = u0;
    }
    ZP[(size_t)row * BRW + c] = f2bf(sum / cnt - u0);
}
HD void retkv_item(const bf16* Z, float* KV, int b, int n, int h, int d, int v4) {
    const float lg = ret_logg(h);
    float a0 = 0.f, a1 = 0.f, a2 = 0.f, a3 = 0.f;
    for (int j = 0; j < 128; ++j) { const bf16* p = Z + (size_t)(b * SEQ + n * 128 + j) * ZW;
        const float kd = bf2f(p[ZRK + h * 64 + d]) * 0.125f * FEXP(lg * (float)(127 - j));
        const bf16* pv = p + ZRV + h * 128 + v4 * 4;
        a0 += kd * bf2f(pv[0]); a1 += kd * bf2f(pv[1]); a2 += kd * bf2f(pv[2]); a3 += kd * bf2f(pv[3]); }
    float* o = KV + ((((size_t)b * 32 + n) * RH + h) * RDK + d) * RDV + v4 * 4;
    o[0] = a0; o[1] = a1; o[2] = a2; o[3] = a3;
}
HD void retstate_s_item(const bf16* Z, int l, int sb, int h, int d, int v4, const float* sret, float* out) {
    const float lg = ret_logg(h);
    const size_t so = ((((size_t)l * SB + sb) * RH + h) * RDK + d) * RDV + v4 * 4;
    const float gc = FEXP(lg * (float)ST);
    float a0 = gc * sret[so], a1 = gc * sret[so + 1], a2 = gc * sret[so + 2], a3 = gc * sret[so + 3];
#pragma unroll
    for (int j = 0; j < ST; ++j) { const bf16* p = Z + (size_t)(MP + sb * ST + j) * ZW;
        const float kd = bf2f(p[ZRK + h * 64 + d]) * 0.125f * FEXP(lg * (float)(ST - 1 - j));
        const bf16* pv = p + ZRV + h * 128 + v4 * 4;
        a0 += kd * bf2f(pv[0]); a1 += kd * bf2f(pv[1]); a2 += kd * bf2f(pv[2]); a3 += kd * bf2f(pv[3]); }
    float* o = out + O_RS + so; o[0] = a0; o[1] = a1; o[2] = a2; o[3] = a3;
}
HD void retscan_item(const float* KV, float* SPREV, int l, int b, int h, int d, int v4, float* out) {
    const float gc = FEXP(ret_logg(h) * 128.f);
    float s0 = 0.f, s1 = 0.f, s2 = 0.f, s3 = 0.f;
    for (int n = 0; n < 32; ++n) { const size_t o = ((((size_t)b * 32 + n) * RH + h) * RDK + d) * RDV + v4 * 4;
        SPREV[o] = s0; SPREV[o + 1] = s1; SPREV[o + 2] = s2; SPREV[o + 3] = s3;
        s0 = gc * s0 + KV[o]; s1 = gc * s1 + KV[o + 1]; s2 = gc * s2 + KV[o + 2]; s3 = gc * s3 + KV[o + 3]; }
    float* oo = out + O_RP + ((((size_t)l * NBP + b) * RH + h) * RDK + d) * RDV + v4 * 4;
    oo[0] = s0; oo[1] = s1; oo[2] = s2; oo[3] = s3;
}
HD void attn_item(const bf16* Z, int l, int row, int hq, const float* sinks, const float* ck, const float* cv, bf16* Y0) {
    const int kvh = hq >> 2; const float slope = exp2f(-0.5f * (float)(hq + 1));
    float q[64];
    { const bf16* p = Z + (size_t)row * ZW + ZQ + hq * 64;
#pragma unroll
      for (int i = 0; i < 64; i += 8) ld8(p + i, q + i);
#pragma unroll
      for (int i = 0; i < 64; ++i) q[i] *= 0.125f; }
    float m = sinks[l * NH + hq], lsum = 1.f;
    float o[64];
#pragma unroll
    for (int i = 0; i < 64; ++i) o[i] = 0.f;
    const bool smp = row_is_s(row);
    const int b = smp ? ((row - MP) >> 3) : (row >> 12), t = smp ? ((row - MP) & 7) : (row & (SEQ - 1));
    const int lo = smp ? t : (t - WIN > 0 ? t - WIN : 0), hi = smp ? WIN + t : t;
    for (int j = lo; j <= hi; ++j) {
        const int dist = smp ? (WIN + t - j) : (t - j);
        const bool cache = smp && j < WIN;
        const size_t zrow = (size_t)(smp ? (MP + b * ST + (j - WIN)) : (b * SEQ + j)) * ZW;
        const size_t crow = ((((size_t)l * SB + b) * WIN + j) * NKV + kvh) * 64;
        float s = 0.f;
        if (cache) { const float* kp = ck + crow;
#pragma unroll
            for (int i = 0; i < 64; ++i) s += q[i] * kp[i];
        } else { const bf16* kp = Z + zrow + ZK + kvh * 64;
#pragma unroll
            for (int i = 0; i < 64; i += 8) { float f[8]; ld8(kp + i, f);
#pragma unroll
                for (int e = 0; e < 8; ++e) s += q[i + e] * f[e]; } }
        s -= slope * (float)dist;
        if (s > m) { const float corr = FEXP(m - s); lsum *= corr;
#pragma unroll
            for (int i = 0; i < 64; ++i) o[i] *= corr;
            m = s; }
        const float p = FEXP(s - m); lsum += p;
        if (cache) { const float* vp = cv + crow;
#pragma unroll
            for (int i = 0; i < 64; ++i) o[i] += p * vp[i];
        } else { const bf16* vp = Z + zrow + ZV + kvh * 64;
#pragma unroll
            for (int i = 0; i < 64; i += 8) { float f[8]; ld8(vp + i, f);
#pragma unroll
                for (int e = 0; e < 8; ++e) o[i + e] += p * f[e]; } }
    }
    const float inv = 1.f / lsum;
    bf16* y = Y0 + (size_t)row * BRW + hq * 64;
#pragma unroll
    for (int i = 0; i < 64; ++i) o[i] *= inv;
#pragma unroll
    for (int i = 0; i < 64; i += 8) st8(y + i, o + i);
}
HD void retout_item(const bf16* Z, int l, int row, int h, const float* SPREV, const float* sret, const float* gret, float* ORAW, bf16* Y3) {
    const float lg = ret_logg(h);
    const bool smp = row_is_s(row);
    const int b = smp ? ((row - MP) >> 3) : (row >> 12), t = smp ? ((row - MP) & 7) : (row & (SEQ - 1));
    const int i = smp ? t : (t & 127), n = smp ? 0 : (t >> 7);
    const int row0 = smp ? (MP + b * ST) : (b * SEQ + n * 128);
    const float* S = smp ? sret + (((size_t)l * SB + b) * RH + h) * RDK * RDV : SPREV + (((size_t)b * 32 + n) * RH + h) * RDK * RDV;
    float q[64];
    { const bf16* p = Z + (size_t)row * ZW + ZRQ + h * 64;
#pragma unroll
      for (int d = 0; d < 64; d += 8) ld8(p + d, q + d); }
    float* oraw = ORAW + (size_t)row * BRW + h * 128;
    float sum = 0.f;
    for (int half = 0; half < 2; ++half) {
        float o[64];
#pragma unroll
        for (int v = 0; v < 64; ++v) o[v] = 0.f;
        for (int j = 0; j <= i; ++j) { const bf16* p = Z + (size_t)(row0 + j) * ZW;
            const bf16* kp = p + ZRK + h * 64; float s = 0.f;
#pragma unroll
            for (int d = 0; d < 64; d += 8) { float f[8]; ld8(kp + d, f);
#pragma unroll
                for (int e = 0; e < 8; ++e) s += q[d + e] * f[e]; }
            s *= 0.125f * FEXP(lg * (float)(i - j));
            const bf16* vp = p + ZRV + h * 128 + half * 64;
#pragma unroll
            for (int v = 0; v < 64; v += 8) { float f[8]; ld8(vp + v, f);
#pragma unroll
                for (int e = 0; e < 8; ++e) o[v + e] += s * f[e]; } }
        const float cf = FEXP(lg * (float)(i + 1));
        const bf16* qp = Z + (size_t)row * ZW + ZRQ + h * 64;
        for (int d = 0; d < 64; ++d) { const float qd = bf2f(qp[d]) * cf; const float* sp = S + (size_t)d * RDV + half * 64;
#pragma unroll
            for (int v = 0; v < 64; ++v) o[v] += qd * sp[v]; }
#pragma unroll
        for (int v = 0; v < 64; ++v) { oraw[half * 64 + v] = o[v]; sum += o[v]; }
    }
    const float mean = sum * (1.f / 128.f);
    float var = 0.f;
    for (int v = 0; v < 128; ++v) { const float d = oraw[v] - mean; var += d * d; }
    const float rstd = 1.f / sqrtf(var * (1.f / 128.f) + EPS);
    const float* g = gret + l * BRW + h * 128;
    const bf16* rg = Z + (size_t)row * ZW + ZRG + h * 128;
    bf16* y = Y3 + (size_t)row * BRW + h * 128;
    for (int v = 0; v < 128; ++v) y[v] = f2bf((oraw[v] - mean) * rstd * g[v] * bf2f(rg[v]));
}

#if !defined(HOST_TEST_ONLY)
namespace pg8 {
#define PG8_LAS __attribute__((address_space(3)))
typedef short bf16x8 __attribute__((ext_vector_type(8)));
typedef float f32x4 __attribute__((ext_vector_type(4)));
typedef float f32x2 __attribute__((ext_vector_type(2)));
typedef unsigned u32x4 __attribute__((ext_vector_type(4)));
typedef unsigned u32x2 __attribute__((ext_vector_type(2)));
constexpr int BM = 256, BK = 64, HALF = 128, HTB = HALF * BK * 2, STAGE_BYTES = 8 * HTB, NXCD = 8, WGM = 8;

__host__ __device__ __forceinline__ int lds_byte(int r, int c) { const int st = (r >> 4) * 2 + (c >> 5), rr = r & 15, cc = c & 31, ob = rr * 64 + cc * 2; return st * 1024 + (ob ^ (((ob >> 9) & 1) << 5)); }
__host__ __device__ __forceinline__ void stage_rc(int b, int& R, int& C) { const int st = b / 1024, sb = b % 1024, swz = sb ^ (((sb >> 9) & 1) << 5); R = (st >> 1) * 16 + swz / 64; C = (st & 1) * 32 + (swz % 64) / 2; }
__host__ __device__ __forceinline__ int perm32(int rho) { const int n = rho >> 4, i = rho & 15; return 8 * (i >> 2) + 4 * n + (i & 3); }

struct Unit { int pm, pn, r, ks, nt; const char* a; const char* b; };
struct Dims { int lda, ldb, K; };

__host__ __device__ __forceinline__ void tile_of(int L, int nM, int nN, int& pm, int& pn) {
    const int nwg = nM * nN; int wgid = L; { const int q = nwg / NXCD, r = nwg % NXCD, xcd = wgid % NXCD, off = wgid / NXCD; wgid = (xcd < r ? xcd * (q + 1) : r * (q + 1) + (xcd - r) * q) + off; }
    const int nig = WGM * nN, gid = wgid / nig, fm = gid * WGM, gsz = (nM - fm) < WGM ? (nM - fm) : WGM;
    pm = fm + ((wgid % nig) % gsz); pn = (wgid % nig) / gsz;
}
struct StaticOrder {
    int nM, nN, nwg, G, c, nt; const char* A; const char* B; size_t ta, tb;
    __device__ __forceinline__ void init(const bf16* A_, const bf16* B_, int nM_, int nN_, int lda, int ldb, int K, int G_, int c_) { A = (const char*)A_; B = (const char*)B_; nM = nM_; nN = nN_; nwg = nM * nN; G = G_; c = c_; nt = K / BK; ta = (size_t)BM * lda * 2; tb = (size_t)BM * ldb * 2; }
    __device__ __forceinline__ bool next(int i, Unit& u) const {
        const long L = (long)i * G + c; if (L >= nwg) return false;
        tile_of((int)L, nM, nN, u.pm, u.pn); u.r = 0; u.ks = 0; u.nt = nt; u.a = A + (size_t)u.pm * ta; u.b = B + (size_t)u.pn * tb; return true;
    }
};


struct SplitOrder {
    int nN, G, c, RPT, ntP, KS, ntS; const char* A; const char* B; size_t ta, tb, sAr, sBr;
    __device__ __forceinline__ bool next(int i, Unit& u) const {
        const int nP = (MP / BM) * nN, Pc = c < nP ? (nP - c + G - 1) / G : 0;
        if (i < Pc * RPT) { const int tl = (i / RPT) * G + c; tile_of(tl, MP / BM, nN, u.pm, u.pn); u.r = i % RPT; u.ks = 0; u.nt = ntP;
            u.a = A + (size_t)u.r * sAr + (size_t)u.pm * ta; u.b = B + (size_t)u.r * sBr + (size_t)u.pn * tb; return true; }
        const int su = (i - Pc * RPT) * G + c; if (su >= nN * RPT * KS) return false;
        u.pm = MP / BM; u.pn = su / (RPT * KS); u.r = (su / KS) % RPT; u.ks = su % KS; u.nt = ntS;
        u.a = A + (size_t)u.r * sAr + (size_t)u.pm * ta + (size_t)u.ks * ntS * (BK * 2); u.b = B + (size_t)u.r * sBr + (size_t)u.pn * tb + (size_t)u.ks * ntS * (BK * 2); return true;
    }
};

__device__ __forceinline__ unsigned cvt_pk_bf16(float lo, float hi) { unsigned r; asm volatile("v_cvt_pk_bf16_f32 %0, %1, %2" : "=v"(r) : "v"(lo), "v"(hi)); return r; }

template <class Epi, class Sched, bool ALIGN_EPI = true, bool SP2 = true>
__device__ __forceinline__ void gemm_phase(PG8_LAS unsigned char* lds, const Dims g, const Sched& S, const Epi& E, const int tid) {
    const int wid = __builtin_amdgcn_readfirstlane(tid >> 6), lane = tid & 63, wr = wid >> 2, wc = wid & 3, fr = lane & 15, fq = lane >> 4;
    unsigned voffA[2], voffB[2];
#pragma unroll
    for (int i = 0; i < 2; ++i) { int R, C; stage_rc(tid * 16 + i * 8192, R, C); const int Rb = Epi::PERM ? ((R & ~31) + perm32(R & 31)) : R;
        voffA[i] = (unsigned)(R * g.lda + C) * 2u; voffB[i] = (unsigned)(Rb * g.ldb + C) * 2u; }
    const size_t kstep = (size_t)(BK * 2);
    const size_t hstepA = (size_t)HALF * g.lda * 2, hstepB = (size_t)HALF * g.ldb * 2;
    const unsigned ldsw = (unsigned)wid * 1024u;
    const int aoff = lds_byte(wr * 64 + fr, fq * 8), boff = lds_byte(wc * 32 + fr, fq * 8);
#define PG8_SA(b, h) (((b) * 2 + (h)) * HTB)
#define PG8_SB(b, h) ((4 + (b) * 2 + (h)) * HTB)
#define PG8_STAGE(bufoff, gbase, voff) do { _Pragma("unroll") for (int _i = 0; _i < 2; ++_i) \
        __builtin_amdgcn_global_load_lds((const unsigned*)((const char*)(gbase) + (voff)[_i]), (PG8_LAS unsigned*)(lds + (bufoff) + ldsw + _i * 8192), 16, 0, 0); } while (0)
#define PG8_LDA(dst, b, h) do { _Pragma("unroll") for (int m = 0; m < 4; ++m) _Pragma("unroll") for (int k = 0; k < 2; ++k) dst[m][k] = *(const PG8_LAS bf16x8*)(lds + PG8_SA(b, h) + aoff + m * 2048 + k * 1024); } while (0)
#define PG8_LDB(dst, b, h) do { _Pragma("unroll") for (int n = 0; n < 2; ++n) _Pragma("unroll") for (int k = 0; k < 2; ++k) dst[n][k] = *(const PG8_LAS bf16x8*)(lds + PG8_SB(b, h) + boff + n * 2048 + k * 1024); } while (0)
#define PG8_MMA(ai, bj, At, Bt) do { __builtin_amdgcn_s_setprio(1); _Pragma("unroll") for (int m = 0; m < 4; ++m) _Pragma("unroll") for (int n = 0; n < 2; ++n) _Pragma("unroll") for (int k = 0; k < 2; ++k) \
        acc[ai][bj][m][n] = __builtin_amdgcn_mfma_f32_16x16x32_bf16(Bt[n][k], At[m][k], acc[ai][bj][m][n], 0, 0, 0); __builtin_amdgcn_s_setprio(0); } while (0)
#define PG8_WAIT_V(n) asm volatile("s_waitcnt vmcnt(" #n ")" ::: "memory")
#define PG8_WAIT_L(n) asm volatile("s_waitcnt lgkmcnt(" #n ")" ::: "memory")
#define PG8_BAR __builtin_amdgcn_s_barrier()
#define PG8_SCHED __builtin_amdgcn_sched_barrier(0)
    Unit cur, nxt; int ui = 0;
    if (!S.next(0, cur)) return;
    f32x4 acc[2][2][4][2];
#pragma unroll
    for (int a = 0; a < 2; ++a)
#pragma unroll
        for (int b = 0; b < 2; ++b)
#pragma unroll
            for (int m = 0; m < 4; ++m)
#pragma unroll
                for (int n = 0; n < 2; ++n) acc[a][b][m][n] = (f32x4){0.f, 0.f, 0.f, 0.f};
    bf16x8 At[4][2], B0[2][2], B1[2][2];
    const char* cA = cur.a; const char* cB = cur.b;
    if constexpr (SP2) {
        PG8_STAGE(PG8_SB(0, 0), cB, voffB); PG8_STAGE(PG8_SB(0, 1), cB + hstepB, voffB); PG8_STAGE(PG8_SA(0, 0), cA, voffA); PG8_STAGE(PG8_SA(0, 1), cA + hstepA, voffA);
        if (wr == 1) PG8_BAR;
        PG8_WAIT_V(2); PG8_BAR;
        PG8_STAGE(PG8_SB(1, 0), cB + kstep, voffB); PG8_STAGE(PG8_SA(1, 0), cA + kstep, voffA); PG8_STAGE(PG8_SB(1, 1), cB + hstepB + kstep, voffB);
        PG8_WAIT_V(6); PG8_BAR;
    } else {
        PG8_STAGE(PG8_SB(0, 0), cB, voffB); PG8_STAGE(PG8_SA(0, 0), cA, voffA); PG8_STAGE(PG8_SB(0, 1), cB + hstepB, voffB); PG8_STAGE(PG8_SA(0, 1), cA + hstepA, voffA);
        if (wr == 1) PG8_BAR;
        PG8_WAIT_V(4); PG8_BAR;
        PG8_STAGE(PG8_SB(1, 0), cB + kstep, voffB); PG8_STAGE(PG8_SA(1, 0), cA + kstep, voffA); PG8_STAGE(PG8_SB(1, 1), cB + hstepB + kstep, voffB);
        PG8_WAIT_V(6); PG8_BAR;
    }
    for (;;) {
        const bool has_next = S.next(ui + 1, nxt);
        const char* nA = has_next ? nxt.a : cA; const char* nB = has_next ? nxt.b : cB;
        const int nt = cur.nt;
        for (int t = 0; t < nt; t += 2) {
            const bool last = (t == nt - 2);
            const char* a1 = cA + (size_t)(t + 1) * kstep;
            const char* a2 = last ? nA : cA + (size_t)(t + 2) * kstep; const char* b2 = last ? nB : cB + (size_t)(t + 2) * kstep;
            const char* a3 = a2 + kstep; const char* b3 = b2 + kstep;
            if constexpr (SP2) {
            PG8_LDB(B0, 0, 0); PG8_LDB(B1, 0, 1); PG8_SCHED; PG8_LDA(At, 0, 0); PG8_STAGE(PG8_SA(1, 1), a1 + hstepA, voffA);
            PG8_WAIT_V(8); PG8_WAIT_L(0); PG8_BAR; PG8_MMA(0, 0, At, B0); PG8_MMA(0, 1, At, B1); PG8_BAR; PG8_SCHED;
            PG8_LDA(At, 0, 1); PG8_STAGE(PG8_SB(0, 0), b2, voffB); PG8_STAGE(PG8_SB(0, 1), b2 + hstepB, voffB); PG8_STAGE(PG8_SA(0, 0), a2, voffA);
            PG8_WAIT_V(8); PG8_WAIT_L(0); PG8_BAR; PG8_MMA(1, 0, At, B0); PG8_MMA(1, 1, At, B1); PG8_BAR; PG8_SCHED;
            PG8_LDB(B0, 1, 0); PG8_LDB(B1, 1, 1); PG8_SCHED; PG8_LDA(At, 1, 0); PG8_STAGE(PG8_SA(0, 1), a2 + hstepA, voffA);
            PG8_WAIT_V(8); PG8_WAIT_L(0); PG8_BAR; PG8_MMA(0, 0, At, B0); PG8_MMA(0, 1, At, B1); PG8_BAR; PG8_SCHED;
            PG8_LDA(At, 1, 1); PG8_STAGE(PG8_SB(1, 0), b3, voffB); PG8_STAGE(PG8_SB(1, 1), b3 + hstepB, voffB); PG8_STAGE(PG8_SA(1, 0), a3, voffA);
            PG8_WAIT_V(8); PG8_WAIT_L(0); PG8_BAR; PG8_MMA(1, 0, At, B0); PG8_MMA(1, 1, At, B1); PG8_BAR; PG8_SCHED;
            } else {
            PG8_LDB(B0, 0, 0); PG8_SCHED; PG8_LDA(At, 0, 0); PG8_STAGE(PG8_SA(1, 1), a1 + hstepA, voffA);
            PG8_WAIT_L(8); PG8_BAR; PG8_WAIT_L(0); PG8_MMA(0, 0, At, B0); PG8_BAR; PG8_SCHED;
            PG8_LDB(B1, 0, 1); PG8_STAGE(PG8_SB(0, 0), b2, voffB);
            PG8_BAR; PG8_WAIT_L(0); PG8_MMA(0, 1, At, B1); PG8_BAR;
            PG8_LDA(At, 0, 1); PG8_STAGE(PG8_SA(0, 0), a2, voffA);
            PG8_BAR; PG8_WAIT_L(0); PG8_MMA(1, 0, At, B0); PG8_BAR; PG8_SCHED;
            PG8_STAGE(PG8_SB(0, 1), b2 + hstepB, voffB);
            PG8_WAIT_V(6); PG8_BAR; PG8_MMA(1, 1, At, B1); PG8_BAR;
            PG8_LDB(B0, 1, 0); PG8_SCHED; PG8_LDA(At, 1, 0); PG8_STAGE(PG8_SA(0, 1), a2 + hstepA, voffA);
            PG8_WAIT_L(8); PG8_BAR; PG8_WAIT_L(0); PG8_MMA(0, 0, At, B0); PG8_BAR; PG8_SCHED;
            PG8_LDB(B1, 1, 1); PG8_STAGE(PG8_SB(1, 0), b3, voffB);
            PG8_BAR; PG8_WAIT_L(0); PG8_MMA(0, 1, At, B1); PG8_BAR;
            PG8_LDA(At, 1, 1); PG8_STAGE(PG8_SA(1, 0), a3, voffA);
            PG8_BAR; PG8_WAIT_L(0); PG8_MMA(1, 0, At, B0); PG8_BAR; PG8_SCHED;
            PG8_STAGE(PG8_SB(1, 1), b3 + hstepB, voffB);
            PG8_WAIT_V(6); PG8_BAR; PG8_MMA(1, 1, At, B1); PG8_BAR;
            }
        }
        if constexpr (ALIGN_EPI) { if (wr == 0) PG8_BAR; }
        bool keep; { int ln; asm volatile("v_mbcnt_lo_u32_b32 %0, -1, 0\n\tv_mbcnt_hi_u32_b32 %0, -1, %0" : "=v"(ln)); keep = E(acc, cur, wr, wc, ln & 15, ln >> 4); }
        if (!has_next) break;
        if (!keep)
#pragma unroll
        for (int a = 0; a < 2; ++a)
#pragma unroll
            for (int b = 0; b < 2; ++b)
#pragma unroll
                for (int m = 0; m < 4; ++m)
#pragma unroll
                    for (int n = 0; n < 2; ++n) acc[a][b][m][n] = (f32x4){0.f, 0.f, 0.f, 0.f};
        cur = nxt; cA = nA; cB = nB; ++ui;
        if constexpr (ALIGN_EPI) { if (wr == 1) PG8_BAR; }
    }
    PG8_WAIT_V(0);
    if constexpr (!ALIGN_EPI) { if (wr == 0) PG8_BAR; }
    PG8_BAR;
#undef PG8_SA
#undef PG8_SB
#undef PG8_STAGE
#undef PG8_LDA
#undef PG8_LDB
#undef PG8_MMA
#undef PG8_WAIT_V
#undef PG8_WAIT_L
#undef PG8_BAR
#undef PG8_SCHED
}

__device__ __forceinline__ float fsigmoid(float x) { return __builtin_amdgcn_rcpf(1.f + __expf(-x)); }
struct EpiZ {
    static constexpr bool PERM = true;
    bf16* Z;
    __device__ __forceinline__ bool operator()(f32x4 (&acc)[2][2][4][2], const Unit& u, int wr, int wc, int fr, int fq) const {
        const int row0 = u.pm * BM + wr * 64 + fr, col0 = u.pn * BM + wc * 32 + 8 * fq;
        const int ty = u.pn >= 30 ? 2 : (u.pn >= 26 ? 1 : 0);
        if (u.pn >= 6 && u.pn < 14) {
            const int colg = ZCA + (u.pn - 6) * 128 + wc * 32 + 8 * fq;
#pragma unroll
            for (int ai = 0; ai < 2; ++ai)
#pragma unroll
                for (int m = 0; m < 4; ++m) { f32x4 a0 = acc[ai][0][m][0], a1 = acc[ai][0][m][1]; const f32x4 g0 = acc[ai][1][m][0], g1 = acc[ai][1][m][1];
#pragma unroll
                    for (int j = 0; j < 4; ++j) { a0[j] = a0[j] * fsigmoid(g0[j]); a1[j] = a1[j] * fsigmoid(g1[j]); }
                    u32x4 w; w.x = cvt_pk_bf16(a0[0], a0[1]); w.y = cvt_pk_bf16(a0[2], a0[3]); w.z = cvt_pk_bf16(a1[0], a1[1]); w.w = cvt_pk_bf16(a1[2], a1[3]);
                    *(u32x4*)(Z + (size_t)(row0 + ai * HALF + m * 16) * ZW + colg) = w; }
            return false;
        }
#pragma unroll
        for (int ai = 0; ai < 2; ++ai)
#pragma unroll
            for (int m = 0; m < 4; ++m) { bf16* rowp = Z + (size_t)(row0 + ai * HALF + m * 16) * ZW + col0;
#pragma unroll
                for (int bj = 0; bj < 2; ++bj) { f32x4 v0 = acc[ai][bj][m][0], v1 = acc[ai][bj][m][1];
                    if (ty == 2) {
#pragma unroll
                        for (int j = 0; j < 4; ++j) { v0[j] = fsigmoid(v0[j]); v1[j] = fsigmoid(v1[j]); } }
                    else if (ty == 1) {
#pragma unroll
                        for (int j = 0; j < 4; ++j) { v0[j] = v0[j] * fsigmoid(v0[j]); v1[j] = v1[j] * fsigmoid(v1[j]); } }
                    u32x4 w; w.x = cvt_pk_bf16(v0[0], v0[1]); w.y = cvt_pk_bf16(v0[2], v0[3]); w.z = cvt_pk_bf16(v1[0], v1[1]); w.w = cvt_pk_bf16(v1[2], v1[3]);
                    *(u32x4*)(rowp + bj * HALF) = w; } }
        return false;
    }
};
struct EpiMlp1 {
    static constexpr bool PERM = true;
    bf16* O; float* SLAB;
    __device__ __forceinline__ bool operator()(f32x4 (&acc)[2][2][4][2], const Unit& u, int wr, int wc, int fr, int fq) const {
        const int row0 = u.pm * BM + wr * 64 + fr, col0 = u.pn * BM + wc * 32 + 8 * fq;
        if (u.pm == MP / BM) { float* sl = SLAB + ((size_t)u.ks * BM + wr * 64 + fr) * DFF + col0;
#pragma unroll
            for (int ai = 0; ai < 2; ++ai)
#pragma unroll
                for (int m = 0; m < 4; ++m)
#pragma unroll
                    for (int bj = 0; bj < 2; ++bj) { float* p = sl + (size_t)(ai * HALF + m * 16) * DFF + bj * HALF; *(f32x4*)p = acc[ai][bj][m][0]; *(f32x4*)(p + 4) = acc[ai][bj][m][1]; }
            return false; }
#pragma unroll
        for (int ai = 0; ai < 2; ++ai)
#pragma unroll
            for (int m = 0; m < 4; ++m) { bf16* rowp = O + (size_t)(row0 + ai * HALF + m * 16) * DFF + col0;
#pragma unroll
                for (int bj = 0; bj < 2; ++bj) { f32x4 v0 = acc[ai][bj][m][0], v1 = acc[ai][bj][m][1];
#pragma unroll
                    for (int j = 0; j < 4; ++j) { const float a = fmaxf(v0[j], 0.f), b = fmaxf(v1[j], 0.f); v0[j] = a * a; v1[j] = b * b; }
                    u32x4 w; w.x = cvt_pk_bf16(v0[0], v0[1]); w.y = cvt_pk_bf16(v0[2], v0[3]); w.z = cvt_pk_bf16(v1[0], v1[1]); w.w = cvt_pk_bf16(v1[2], v1[3]);
                    *(u32x4*)(rowp + bj * HALF) = w; } }
        return false;
    }
};
struct EpiPool {
    static constexpr bool PERM = true;
    bf16* Y2; const float* spb; int l;
    __device__ __forceinline__ bool operator()(f32x4 (&acc)[2][2][4][2], const Unit& u, int wr, int wc, int fr, int fq) const {
        const int row0 = u.pm * BM + wr * 64 + fr, col0 = u.pn * BM + wc * 32 + 8 * fq;
        int le = l; asm volatile("" : "+s"(le)); const float* sp = spb + le * BRW;
        f32x4 s[2][2];
#pragma unroll
        for (int bj = 0; bj < 2; ++bj)
#pragma unroll
            for (int n = 0; n < 2; ++n) s[bj][n] = *(const f32x4*)(sp + col0 + bj * HALF + 4 * n);
#pragma unroll
        for (int ai = 0; ai < 2; ++ai)
#pragma unroll
            for (int m = 0; m < 4; ++m) { bf16* rowp = Y2 + (size_t)(row0 + ai * HALF + m * 16) * BRW + col0;
#pragma unroll
                for (int bj = 0; bj < 2; ++bj) { const f32x4 v0 = acc[ai][bj][m][0] * s[bj][0], v1 = acc[ai][bj][m][1] * s[bj][1];
                    u32x4 w; w.x = cvt_pk_bf16(v0[0], v0[1]); w.y = cvt_pk_bf16(v0[2], v0[3]); w.z = cvt_pk_bf16(v1[0], v1[1]); w.w = cvt_pk_bf16(v1[2], v1[3]);
                    *(u32x4*)(rowp + bj * HALF) = w; } }
        return false;
    }
};
struct EpiAda {
    static constexpr bool PERM = false;
    float* ADA; const float* bada;
    __device__ __forceinline__ bool operator()(f32x4 (&acc)[2][2][4][2], const Unit& u, int wr, int wc, int fr, int fq) const {
        if (wr != 0) return false;
        const int col0 = u.pn * BM + wc * 32 + 4 * fq;
#pragma unroll
        for (int m = 0; m < 3; ++m) { const int row = m * 16 + fr;
            if (row < NROWB) {
#pragma unroll
                for (int bj = 0; bj < 2; ++bj)
#pragma unroll
                    for (int n = 0; n < 2; ++n) { const int c = col0 + bj * HALF + n * 16; const f32x4 bv = *(const f32x4*)(bada + (size_t)u.r * ADAW + c);
                        *(f32x4*)(ADA + ((size_t)u.r * NROWB + row) * ADAW + c) = acc[0][bj][m][n] + bv; } } }
        return false;
    }
};
struct EpiBr {
    static constexpr bool PERM = true;
    const bf16* Z; bf16* MERGED; float* SLAB; int KS;
    static __device__ __forceinline__ void unp8(const u32x4 gw, f32x4& g0, f32x4& g1) { const float T = 8.6736174e-19f;
        g0[0] = fmaxf(__builtin_bit_cast(float, gw.x << 16), T); g0[1] = fmaxf(__builtin_bit_cast(float, gw.x & 0xffff0000u), T); g0[2] = fmaxf(__builtin_bit_cast(float, gw.y << 16), T); g0[3] = fmaxf(__builtin_bit_cast(float, gw.y & 0xffff0000u), T);
        g1[0] = fmaxf(__builtin_bit_cast(float, gw.z << 16), T); g1[1] = fmaxf(__builtin_bit_cast(float, gw.z & 0xffff0000u), T); g1[2] = fmaxf(__builtin_bit_cast(float, gw.w << 16), T); g1[3] = fmaxf(__builtin_bit_cast(float, gw.w & 0xffff0000u), T); }
    __device__ __forceinline__ bool operator()(f32x4 (&acc)[2][2][4][2], const Unit& u, int wr, int wc, int fr, int fq) const {
        const int row0 = u.pm * BM + wr * 64 + fr, col0 = u.pn * BM + wc * 32 + 8 * fq;
        const int r = u.r; const bool smp = u.pm == MP / BM;
        const bf16* gbase = Z + (size_t)row0 * ZW + ZGT + r * DM + col0;
#pragma unroll
        for (int ai = 0; ai < 2; ++ai) {
            u32x4 ga[4][2], gb[4][2];
#pragma unroll
            for (int m = 0; m < 4; ++m)
#pragma unroll
                for (int bj = 0; bj < 2; ++bj) { const bf16* gp = gbase + (size_t)(ai * HALF + m * 16) * ZW + bj * HALF; ga[m][bj] = *(const u32x4*)gp; gb[m][bj] = *(const u32x4*)(gp + DM); }
            asm volatile("" ::: "memory");
#pragma unroll
            for (int m = 0; m < 4; ++m)
#pragma unroll
                for (int bj = 0; bj < 2; ++bj) { const size_t row = (size_t)(row0 + ai * HALF + m * 16); const int c = col0 + bj * HALF;
                    f32x4 g0, g1; unp8(ga[m][bj], g0, g1);
                    if (smp) { float* sp = SLAB + ((size_t)(r * KS + u.ks) * BM + (row - MP)) * DM + c; *(f32x4*)sp = acc[ai][bj][m][0] * g0; *(f32x4*)(sp + 4) = acc[ai][bj][m][1] * g1; }
                    else if (r < 3) { f32x4 n0, n1; unp8(gb[m][bj], n0, n1);
#pragma unroll
                        for (int j = 0; j < 4; ++j) { acc[ai][bj][m][0][j] *= g0[j] * __builtin_amdgcn_rcpf(n0[j]); acc[ai][bj][m][1][j] *= g1[j] * __builtin_amdgcn_rcpf(n1[j]); } }
                    else { const f32x4 v0 = acc[ai][bj][m][0] * g0, v1 = acc[ai][bj][m][1] * g1;
                        u32x4 w; w.x = cvt_pk_bf16(v0[0], v0[1]); w.y = cvt_pk_bf16(v0[2], v0[3]); w.z = cvt_pk_bf16(v1[0], v1[1]); w.w = cvt_pk_bf16(v1[2], v1[3]);
                        *(u32x4*)(MERGED + row * DM + c) = w; } }
        }
        return !smp && r < 3;
    }
};
struct EpiRes {
    static constexpr bool PERM = true;
    const void* baseP; void* out; bool baseBf, outBf; const float* gate; float* SLAB;
    __device__ __forceinline__ bool operator()(f32x4 (&acc)[2][2][4][2], const Unit& u, int wr, int wc, int fr, int fq) const {
        const int rl0 = wr * 64 + fr, col0 = u.pn * BM + wc * 32 + 8 * fq;
        const bool smp = u.pm >= MP / BM;
        if (smp) { float* sl = SLAB + ((size_t)u.ks * BM + rl0) * DM + col0;
#pragma unroll
            for (int ai = 0; ai < 2; ++ai)
#pragma unroll
                for (int m = 0; m < 4; ++m)
#pragma unroll
                    for (int bj = 0; bj < 2; ++bj)
#pragma unroll
                        for (int n = 0; n < 2; ++n) *(f32x4*)(sl + (size_t)(ai * HALF + m * 16) * DM + bj * HALF + n * 4) = acc[ai][bj][m][n];
            return false; }
        const size_t e0 = (size_t)u.pm * BM * DM + (size_t)rl0 * DM + col0;
        const float* gp = gate + (size_t)(u.pm >> 4) * ADAW + col0;
        f32x4 gv[2][2];
#pragma unroll
        for (int bj = 0; bj < 2; ++bj)
#pragma unroll
            for (int n = 0; n < 2; ++n) gv[bj][n] = *(const f32x4*)(gp + bj * HALF + n * 4);
#pragma unroll
        for (int ai = 0; ai < 2; ++ai) {
            f32x4 bs[4][2][2];
            if (baseBf) {
#pragma unroll
                for (int m = 0; m < 4; ++m)
#pragma unroll
                    for (int bj = 0; bj < 2; ++bj) { const u32x4 w = *(const u32x4*)((const bf16*)baseP + e0 + (size_t)(ai * HALF + m * 16) * DM + bj * HALF); const unsigned w0 = w.x, w1 = w.y, w2 = w.z, w3 = w.w;
                        bs[m][bj][0] = f32x4{__builtin_bit_cast(float, w0 << 16), __builtin_bit_cast(float, w0 & 0xffff0000u), __builtin_bit_cast(float, w1 << 16), __builtin_bit_cast(float, w1 & 0xffff0000u)};
                        bs[m][bj][1] = f32x4{__builtin_bit_cast(float, w2 << 16), __builtin_bit_cast(float, w2 & 0xffff0000u), __builtin_bit_cast(float, w3 << 16), __builtin_bit_cast(float, w3 & 0xffff0000u)}; }
            } else {
#pragma unroll
                for (int m = 0; m < 4; ++m)
#pragma unroll
                    for (int bj = 0; bj < 2; ++bj)
#pragma unroll
                        for (int n = 0; n < 2; ++n) bs[m][bj][n] = *(const f32x4*)((const float*)baseP + e0 + (size_t)(ai * HALF + m * 16) * DM + bj * HALF + n * 4);
            }
            asm volatile("" ::: "memory");
#pragma unroll
            for (int m = 0; m < 4; ++m)
#pragma unroll
                for (int bj = 0; bj < 2; ++bj) { const f32x4 y0 = bs[m][bj][0] + gv[bj][0] * acc[ai][bj][m][0], y1 = bs[m][bj][1] + gv[bj][1] * acc[ai][bj][m][1];
                    if (outBf) { u32x4 w; w.x = cvt_pk_bf16(y0[0], y0[1]); w.y = cvt_pk_bf16(y0[2], y0[3]); w.z = cvt_pk_bf16(y1[0], y1[1]); w.w = cvt_pk_bf16(y1[2], y1[3]);
                        *(u32x4*)((bf16*)out + e0 + (size_t)(ai * HALF + m * 16) * DM + bj * HALF) = w; }
                    else { float* o = (float*)out + e0 + (size_t)(ai * HALF + m * 16) * DM + bj * HALF; *(f32x4*)o = y0; *(f32x4*)(o + 4) = y1; } }
        }
        return false;
    }
};
}

constexpr int NWAVES = 8, NTHR = NWAVES * 64;
constexpr size_t MiB = 1u << 20;
constexpr size_t al1(size_t x) { return (x + MiB - 1) / MiB * MiB; }
constexpr size_t WS_CTL = 0, CTL_ZERO_BYTES = 1 * MiB;
constexpr size_t WS_WIN = WS_CTL + CTL_ZERO_BYTES;
constexpr size_t WS_WBR = WS_WIN + al1((size_t)DEPTH * ZW * DM * 2);
constexpr size_t WS_WOUT = WS_WBR + al1((size_t)DEPTH * 4 * DM * BRW * 2);
constexpr size_t WS_WM1 = WS_WOUT + al1((size_t)DEPTH * DM * DM * 2);
constexpr size_t WS_WM2 = WS_WM1 + al1((size_t)DEPTH * DFF * DM * 2);
constexpr size_t WS_WPOOL = WS_WM2 + al1((size_t)DEPTH * DFF * DM * 2);
constexpr size_t WS_WADA = WS_WPOOL + al1((size_t)DEPTH * 4 * 256 * 256 * 2);
constexpr size_t WS_SC = WS_WADA + al1((size_t)DEPTH * ADAW * DM * 2);
constexpr size_t WS_ADA = WS_SC + al1((size_t)256 * DM * 2);
constexpr size_t WS_H = WS_ADA + al1((size_t)DEPTH * NROWB * ADAW * 4);
constexpr size_t WS_Z = WS_H + al1((size_t)M * DM * 2);
constexpr size_t WS_Y = WS_Z + al1((size_t)M * ZW * 2);
constexpr size_t WS_ZP = WS_Y + al1((size_t)4 * M * BRW * 2);
constexpr size_t WS_CONVY = WS_ZP + al1((size_t)M * BRW * 2);
constexpr size_t WS_ORAW = WS_CONVY + al1((size_t)M * BRW * 4);
constexpr size_t WS_KV = WS_ORAW + al1((size_t)M * BRW * 4);
constexpr size_t WS_SPREV = WS_KV + al1((size_t)NBP * 32 * RH * RDK * RDV * 4);
constexpr size_t WS_MACC = WS_SPREV + al1((size_t)NBP * 32 * RH * RDK * RDV * 4);
constexpr size_t WS_MERGED = WS_MACC + al1((size_t)M * DM * 4);
constexpr size_t WS_X1 = WS_MERGED + al1((size_t)M * DM * 2);
constexpr size_t WS_X = WS_X1 + al1((size_t)M * DM * 4);
constexpr size_t WS_HID = WS_X + al1((size_t)M * DM * 4);
constexpr size_t WS_SLAB = WS_HID + al1((size_t)M * DFF * 2);
constexpr size_t WS_END = WS_SLAB + al1((size_t)16 * MS * DM * 4);
constexpr int CW_BAR = 4096;
constexpr int RING_OFF = 0, RING_BYTES = 131072, LDSCTL_OFF = RING_BYTES, MISC_OFF = LDSCTL_OFF + 320, INTAB_OFF = MISC_OFF + 128, LDS_BYTES = 147456;

#define GAS __attribute__((address_space(1)))
#define LAS __attribute__((address_space(3)))
typedef unsigned v4u __attribute__((ext_vector_type(4)));
typedef float f32x4 __attribute__((ext_vector_type(4)));
typedef GAS unsigned gu32;
#define RLX_AGENT __ATOMIC_RELAXED, __HIP_MEMORY_SCOPE_AGENT
#define LDS_WAIT() asm volatile("s_waitcnt lgkmcnt(0)" ::: "memory")
__device__ __forceinline__ unsigned pk2(float lo, float hi) { return (unsigned)f2bf(lo) | ((unsigned)f2bf(hi) << 16); }

#define XB_TMO      128
#define XB_XCNT(j)  (256  + 64 * (j))
#define XB_XSUB(j)  (1280 + 64 * (j))
#define XB_XGEN(j)  (2304 + 64 * (j))
#define XB_TOP      3328
#define XB_TOPGEN   3392
#define XCD_BAR_WORDS 3456
#define XB_SPIN_CAP (1u << 18)
__device__ __forceinline__ unsigned xb_ld(unsigned* p)              { return __hip_atomic_load(p, __ATOMIC_RELAXED, __HIP_MEMORY_SCOPE_AGENT); }
__device__ __forceinline__ unsigned xb_add(unsigned* p, unsigned v) { return __hip_atomic_fetch_add(p, v, __ATOMIC_RELAXED, __HIP_MEMORY_SCOPE_AGENT); }
__device__ __forceinline__ unsigned xb_xcc_id() { return (unsigned)__builtin_amdgcn_s_getreg((3 << 11) | 20) & 0xFu; }
#define XB_SPIN(cond, bar) do { unsigned _sp = 0; while (cond) { __builtin_amdgcn_s_sleep(1); \
    if ((++_sp & 255u) == 0u) { if (xb_ld(&(bar)[XB_TMO])) break; if (_sp > XB_SPIN_CAP) { atomicAdd(&(bar)[XB_TMO], 1u); break; } } } } while (0)
struct XcdBarrier { unsigned* bar; unsigned x; volatile LAS unsigned* st; };
__device__ __forceinline__ XcdBarrier xcd_barrier_post(unsigned* bar, volatile LAS unsigned* st) {
    XcdBarrier b; b.bar = bar; b.x = xb_xcc_id(); b.st = st;
    if (threadIdx.x == 0) (void)xb_add(&bar[XB_XCNT(b.x)], 1u);
    return b;
}
__device__ __forceinline__ void xcd_barrier_complete(unsigned* bar, unsigned x, unsigned& nloc, unsigned& nx) {
    const unsigned G = gridDim.x * gridDim.y * gridDim.z;
    unsigned sum, cnt, mine, sp = 0u;
    for (;;) {
        sum = 0u; cnt = 0u; mine = 0u;
#pragma unroll
        for (unsigned j = 0; j < 16; ++j) { const unsigned c = xb_ld(&bar[XB_XCNT(j)]); sum += c; cnt += (c > 0u) ? 1u : 0u; mine = (j == x) ? c : mine; }
        if (sum == G) break;
        __builtin_amdgcn_s_sleep(1);
        if ((++sp & 255u) == 0u) { if (xb_ld(&bar[XB_TMO])) break; if (sp > XB_SPIN_CAP) { atomicAdd(&bar[XB_TMO], 1u); break; } }
    }
    nloc = mine > 0u ? mine : 1u; nx = cnt > 0u ? cnt : 1u;
}
__device__ __forceinline__ void xcd_barrier(const XcdBarrier& b) {
    asm volatile("s_waitcnt vmcnt(0)" ::: "memory");
    __syncthreads();
    if (threadIdx.x == 0) {
        unsigned* bar = b.bar;
        __builtin_amdgcn_s_waitcnt(0);
        unsigned nloc = b.st[0], nx = b.st[1];
        if (nloc == 0u) { xcd_barrier_complete(bar, b.x, nloc, nx); b.st[0] = nloc; b.st[1] = nx; }
        const unsigned old = xb_add(&bar[XB_XSUB(b.x)], 1u);
        const unsigned gen = old / nloc;
        if (old + 1u == (gen + 1u) * nloc) {
            __builtin_amdgcn_fence(__ATOMIC_RELEASE, "agent");
            asm volatile("s_waitcnt vmcnt(0)" ::: "memory");
            const unsigned og = xb_add(&bar[XB_TOP], 1u);
            const unsigned tg = og / nx;
            if (og + 1u == (tg + 1u) * nx) xb_add(&bar[XB_TOPGEN], 1u);
            else XB_SPIN(xb_ld(&bar[XB_TOPGEN]) == tg, bar);
            __builtin_amdgcn_fence(__ATOMIC_ACQUIRE, "agent");
            xb_add(&bar[XB_XGEN(b.x)], 1u);
            asm volatile("s_waitcnt vmcnt(0)" ::: "memory");
        } else {
            XB_SPIN(xb_ld(&bar[XB_XGEN(b.x)]) == gen, bar);
            __builtin_amdgcn_fence(__ATOMIC_ACQUIRE, "agent");
            asm volatile("s_waitcnt vmcnt(0)" ::: "memory");
        }
    }
    __syncthreads();
}

template <int CTRL> __device__ __forceinline__ float dpp_f(float v) { return __builtin_bit_cast(float, __builtin_amdgcn_update_dpp(0, __builtin_bit_cast(int, v), CTRL, 0xf, 0xf, false)); }
__device__ __forceinline__ float wave_sum(float v) {
    v += dpp_f<0xB1>(v);
    v += dpp_f<0x4E>(v);
    v += dpp_f<0x141>(v);
    v += dpp_f<0x140>(v);
    v += __builtin_bit_cast(float, __builtin_amdgcn_ds_swizzle(__builtin_bit_cast(int, v), 0x401F));
    return __builtin_bit_cast(float, __builtin_amdgcn_readlane(__builtin_bit_cast(int, v), 0)) + __builtin_bit_cast(float, __builtin_amdgcn_readlane(__builtin_bit_cast(int, v), 32));
}
typedef float tr_f32x4 __attribute__((ext_vector_type(4)));
#define TR_LOAD(V, P) _Pragma("unroll") for (int j = 0; j < 8; ++j) V[j] = __builtin_nontemporal_load((const GAS tr_f32x4*)((P) + (size_t)j * N))
#define TR_STORE(V, Q) _Pragma("unroll") for (int i = 0; i < 4; ++i) { v4u o; o.x = pk2(V[0][i], V[1][i]); o.y = pk2(V[2][i], V[3][i]); o.z = pk2(V[4][i], V[5][i]); o.w = pk2(V[6][i], V[7][i]); __builtin_nontemporal_store(o, (GAS v4u*)((Q) + (size_t)i * K)); }
template <int K, int N, bool GLUPERM = false>
__device__ __forceinline__ void transpose_run(const float* W, bf16* T, int nmat, int gw, int NGW, int lane) {
    constexpr int NB = N / 32, IPM = (K / 64) * NB; const int total = nmat * IPM;
    const unsigned lo_p = (unsigned)(8 * (lane >> 3)) * N + 4 * (lane & 7), lo_q = (unsigned)(4 * (lane & 7)) * K + 8 * (lane >> 3);
    auto addr = [&](int it, const float*& p, bf16*& q) { it = it < total ? it : total - 1; const int mi = it / IPM, r = it % IPM, kb = r / NB, nb = r % NB;
        p = W + ((size_t)mi * K * N + (size_t)(64 * kb) * N + 32 * nb) + lo_p;
        int n0 = 32 * nb;
        if (GLUPERM) { if (n0 >= ZCA && n0 < ZCA + BRW) { const int c = n0 - ZCA; n0 = ZCA + 256 * (c >> 7) + (c & 127); } else if (n0 >= ZCG && n0 < ZCG + BRW) { const int c = n0 - ZCG; n0 = ZCA + 256 * (c >> 7) + 128 + (c & 127); } }
        q = T + ((size_t)mi * K * N + (size_t)n0 * K + 64 * kb) + lo_q; };
    int it = gw; if (it >= total) return;
    tr_f32x4 va[8], vb[8]; const float *pa, *pb; bf16 *qa, *qb;
    addr(it, pa, qa); TR_LOAD(va, pa);
    for (;;) {
        const int i1 = it + NGW; addr(i1, pb, qb); TR_LOAD(vb, pb);
        asm volatile("" ::: "memory"); TR_STORE(va, qa); asm volatile("" ::: "memory");
        if (i1 >= total) break;
        const int i2 = i1 + NGW; addr(i2, pa, qa); TR_LOAD(va, pa);
        asm volatile("" ::: "memory"); TR_STORE(vb, qb); asm volatile("" ::: "memory");
        if (i2 >= total) break;
        it = i2; }
}
__device__ __forceinline__ void load_mod(const float* g, const float* sc, const float* shp, f32x4 (&gm)[8], f32x4 (&sh)[8], int lane) {
#pragma unroll
    for (int jj = 0; jj < 4; ++jj)
#pragma unroll
        for (int e = 0; e < 2; ++e) { const int q = 2 * (lane + 64 * jj) + e; gm[2 * jj + e] = ((const f32x4*)g)[q] * (((const f32x4*)sc)[q] + 1.f); sh[2 * jj + e] = ((const f32x4*)shp)[q]; }
}
template <bool BF> __device__ __forceinline__ void load_row8(const void* x, f32x4 (&v)[8], int lane) {
#pragma unroll
    for (int jj = 0; jj < 4; ++jj) {
        if (BF) { const v4u w = ((const v4u*)x)[lane + 64 * jj]; const unsigned w0 = w.x, w1 = w.y, w2 = w.z, w3 = w.w;
            v[2 * jj] = f32x4{__builtin_bit_cast(float, w0 << 16), __builtin_bit_cast(float, w0 & 0xffff0000u), __builtin_bit_cast(float, w1 << 16), __builtin_bit_cast(float, w1 & 0xffff0000u)};
            v[2 * jj + 1] = f32x4{__builtin_bit_cast(float, w2 << 16), __builtin_bit_cast(float, w2 & 0xffff0000u), __builtin_bit_cast(float, w3 << 16), __builtin_bit_cast(float, w3 & 0xffff0000u)}; }
        else { v[2 * jj] = ((const f32x4*)x)[2 * (lane + 64 * jj)]; v[2 * jj + 1] = ((const f32x4*)x)[2 * (lane + 64 * jj) + 1]; } }
}
__device__ __forceinline__ float sumsq8(const f32x4 (&v)[8]) { float s = 0.f;
#pragma unroll
    for (int j = 0; j < 8; ++j) s += (v[j].x * v[j].x + v[j].y * v[j].y) + (v[j].z * v[j].z + v[j].w * v[j].w);
    return s; }
__device__ __forceinline__ void norm_store(const f32x4 (&v)[8], float ss, const f32x4 (&gm)[8], const f32x4 (&sh)[8], bf16* orow, int lane) {
    const float rstd = 1.f / sqrtf(wave_sum(ss) * (1.f / DM) + EPS);
#pragma unroll
    for (int jj = 0; jj < 4; ++jj) { const f32x4 y0 = v[2 * jj] * rstd * gm[2 * jj] + sh[2 * jj], y1 = v[2 * jj + 1] * rstd * gm[2 * jj + 1] + sh[2 * jj + 1];
        v4u o; o.x = pk2(y0.x, y0.y); o.y = pk2(y0.z, y0.w); o.z = pk2(y1.x, y1.y); o.w = pk2(y1.z, y1.w);
        ((v4u*)orow)[lane + 64 * jj] = o; }
}
template <bool BF> __device__ __forceinline__ void norm_row2(const void* xa, const void* xb, const f32x4 (&gm)[8], const f32x4 (&sh)[8], bf16* oa, bf16* ob, int lane) {
    f32x4 va[8], vb[8]; load_row8<BF>(xa, va, lane); load_row8<BF>(xb, vb, lane);
    const float sa = sumsq8(va), sb = sumsq8(vb);
    norm_store(va, sa, gm, sh, oa, lane); norm_store(vb, sb, gm, sh, ob, lane);
}
template <bool BF> __device__ __forceinline__ void norm_row(const void* xrow, const f32x4 (&gm)[8], const f32x4 (&sh)[8], bf16* orow, int lane) {
    f32x4 v[8]; load_row8<BF>(xrow, v, lane);
    norm_store(v, sumsq8(v), gm, sh, orow, lane);
}
template <int NP> __device__ __forceinline__ void norm_row_block(const float* base, const float* gate, const float* slab, size_t ps, float* xdst, const float* g, const float* sc, const float* shp, bf16* orow, LAS float* red, int tid, int wave) {
    f32x4 v = ((const f32x4*)base)[tid];
    if (NP > 0) { f32x4 pv[NP > 0 ? NP : 1];
#pragma unroll
        for (int p = 0; p < NP; ++p) pv[p] = ((const f32x4*)(slab + (size_t)p * ps))[tid];
        f32x4 a = pv[0];
#pragma unroll
        for (int p = 1; p < NP; ++p) a += pv[p];
        v += ((const f32x4*)gate)[tid] * a; ((f32x4*)xdst)[tid] = v; }
    const float ws = wave_sum((v.x * v.x + v.y * v.y) + (v.z * v.z + v.w * v.w));
    if ((tid & 63) == 0) red[wave] = ws;
    __syncthreads();
    float ss = 0.f;
#pragma unroll
    for (int w = 0; w < NWAVES; ++w) ss += red[w];
    const float rstd = 1.f / sqrtf(ss * (1.f / DM) + EPS);
    const f32x4 y = v * rstd * ((const f32x4*)g)[tid] * (((const f32x4*)sc)[tid] + 1.f) + ((const f32x4*)shp)[tid];
    ((unsigned long long*)orow)[tid] = (unsigned long long)pk2(y.x, y.y) | ((unsigned long long)pk2(y.z, y.w) << 32);
    __syncthreads();
}
__device__ __forceinline__ void convln_row(const float* yrow, const f32x4 (&gv4)[4], const f32x4 (&bv4)[4], bf16* orow, int lane) {
    f32x4 v[4]; float s = 0.f;
#pragma unroll
    for (int j = 0; j < 4; ++j) { v[j] = ((const f32x4*)yrow)[lane + 64 * j]; s += (v[j].x + v[j].y) + (v[j].z + v[j].w); }
    const float mean = wave_sum(s) * (1.f / BRW); float q = 0.f;
#pragma unroll
    for (int j = 0; j < 4; ++j) { v[j] = v[j] - mean; q += (v[j].x * v[j].x + v[j].y * v[j].y) + (v[j].z * v[j].z + v[j].w * v[j].w); }
    const float rstd = 1.f / sqrtf(wave_sum(q) * (1.f / BRW) + EPS);
#pragma unroll
    for (int j = 0; j < 4; ++j) { f32x4 y = v[j] * rstd * gv4[j] + bv4[j];
        y.x = y.x * sigmoidf_(y.x); y.y = y.y * sigmoidf_(y.y); y.z = y.z * sigmoidf_(y.z); y.w = y.w * sigmoidf_(y.w);
        ((unsigned long long*)orow)[lane + 64 * j] = (unsigned long long)pk2(y.x, y.y) | ((unsigned long long)pk2(y.z, y.w) << 32); }
}


namespace att {
typedef short bf16x8 __attribute__((ext_vector_type(8)));
typedef short s16x4 __attribute__((ext_vector_type(4)));
typedef float f32x4 __attribute__((ext_vector_type(4)));
typedef float f32x2_t __attribute__((ext_vector_type(2))); typedef __bf16 bf16x2_t __attribute__((ext_vector_type(2)));
constexpr int KP = 144, NROWS = 272, K_OFF = 0, V_OFF = NROWS * KP, LDS_NEED = 2 * NROWS * KP;
__device__ __forceinline__ unsigned cvtpk(float lo, float hi) { f32x2_t v = {lo, hi}; bf16x2_t b = __builtin_convertvector(v, bf16x2_t); return __builtin_bit_cast(unsigned, b); }
__device__ __forceinline__ float red4_max(float v) {
    v = fmaxf(v, __builtin_bit_cast(float, __builtin_amdgcn_ds_swizzle(__builtin_bit_cast(int, v), 0x401F)));
    unsigned x = __builtin_bit_cast(unsigned, v), y = x; asm volatile("" : "+v"(y));
    auto rr = __builtin_amdgcn_permlane32_swap(x, y, false, false); const unsigned r0 = rr[0], r1 = rr[1];
    return fmaxf(__builtin_bit_cast(float, r0), __builtin_bit_cast(float, r1)); }
__device__ __forceinline__ float red4_sum(float v) {
    v += __builtin_bit_cast(float, __builtin_amdgcn_ds_swizzle(__builtin_bit_cast(int, v), 0x401F));
    unsigned x = __builtin_bit_cast(unsigned, v), y = x; asm volatile("" : "+v"(y));
    auto rr = __builtin_amdgcn_permlane32_swap(x, y, false, false); const unsigned r0 = rr[0], r1 = rr[1];
    return __builtin_bit_cast(float, r0) + __builtin_bit_cast(float, r1); }
__device__ __forceinline__ s16x4 vtr(const LAS unsigned char* p) { typedef short v4i16_t __attribute__((ext_vector_type(4))); return __builtin_bit_cast(s16x4, __builtin_amdgcn_ds_read_tr16_b64_v4i16((LAS v4i16_t*)p)); }

__device__ __forceinline__ void tile16(const bf16x8 qf0, const bf16x8 qf1, const LAS unsigned char* Ks, const LAS unsigned char* Vs, int kbase, int wpos0, float slope2, float sink2, bf16* Yq, int nst, int lane) {
    const int c = lane & 15, g = lane >> 4;
    f32x4 st[9];
#pragma unroll
    for (int kt = 0; kt < 9; ++kt) { const LAS unsigned char* kp = Ks + (kbase + 16 * kt + c) * KP + 16 * g;
        const bf16x8 k0 = *(const LAS bf16x8*)kp, k1 = *(const LAS bf16x8*)(kp + 64);
        f32x4 a = {0.f, 0.f, 0.f, 0.f};
        a = __builtin_amdgcn_mfma_f32_16x16x32_bf16(k0, qf0, a, 0, 0, 0); a = __builtin_amdgcn_mfma_f32_16x16x32_bf16(k1, qf1, a, 0, 0, 0); st[kt] = a; }
    float SC2 = 0.125f * 1.4426950408889634f; asm volatile("" : "+v"(SC2));
    const int dbase = 128 + c - 4 * g;
    float m = sink2;
#pragma unroll
    for (int kt = 0; kt < 9; ++kt)
#pragma unroll
        for (int r = 0; r < 4; ++r) { const int dist = dbase - r - 16 * kt, kk = 16 * kt + 4 * g + r; const bool ok = (unsigned)dist <= 128u && (wpos0 + kk) >= 0;
            const float sv = ok ? st[kt][r] * SC2 - slope2 * (float)dist : -INFINITY; st[kt][r] = sv; m = fmaxf(m, sv); }
    m = red4_max(m);
    float sum = 0.f;
#pragma unroll
    for (int kt = 0; kt < 9; ++kt)
#pragma unroll
        for (int r = 0; r < 4; ++r) { const float p = __builtin_amdgcn_exp2f(st[kt][r] - m); st[kt][r] = p; sum += p; }
    sum = red4_sum(sum) + __builtin_amdgcn_exp2f(sink2 - m);
    const float inv = 1.f / sum;
    bf16x8 pf[5];
#pragma unroll
    for (int k = 0; k < 5; ++k) { unsigned w0 = cvtpk(st[2 * k][0] * inv, st[2 * k][1] * inv), w1 = cvtpk(st[2 * k][2] * inv, st[2 * k][3] * inv), w2 = 0u, w3 = 0u;
        if (k < 4) { w2 = cvtpk(st[2 * k + 1][0] * inv, st[2 * k + 1][1] * inv); w3 = cvtpk(st[2 * k + 1][2] * inv, st[2 * k + 1][3] * inv); }
        typedef unsigned u32x4_t __attribute__((ext_vector_type(4))); const u32x4_t w = {w0, w1, w2, w3}; pf[k] = __builtin_bit_cast(bf16x8, w); }
    f32x4 o[4];
#pragma unroll
    for (int dt = 0; dt < 4; ++dt) o[dt] = (f32x4){0.f, 0.f, 0.f, 0.f};
    const LAS unsigned char* vb = Vs + (kbase + 4 * g + (c >> 2)) * KP + 8 * (c & 3);
#pragma unroll
    for (int k = 0; k < 5; ++k)
#pragma unroll
        for (int dt = 0; dt < 4; ++dt) { const s16x4 lo = vtr(vb + (32 * k) * KP + 32 * dt), hi = vtr(vb + (32 * k + 16) * KP + 32 * dt);
            const bf16x8 b = {lo[0], lo[1], lo[2], lo[3], hi[0], hi[1], hi[2], hi[3]};
            o[dt] = __builtin_amdgcn_mfma_f32_16x16x32_bf16(pf[k], b, o[dt], 0, 0, 0); }
#pragma unroll
    for (int r = 0; r < 4; ++r) if (4 * g + r < nst) {
#pragma unroll
        for (int dt = 0; dt < 4; ++dt) Yq[(size_t)(4 * g + r) * BRW + 16 * dt + c] = f2bf(o[dt][r]); }
}
typedef unsigned u32x4_t __attribute__((ext_vector_type(4)));
__device__ __forceinline__ u32x4_t pack8(const float* f) { u32x4_t w; w.x = cvtpk(f[0], f[1]); w.y = cvtpk(f[2], f[3]); w.z = cvtpk(f[4], f[5]); w.w = cvtpk(f[6], f[7]); return w; }
__device__ __forceinline__ void phase(LAS unsigned char* lds, const bf16* Z, int l, const float* sinks, const float* ck, const float* cv, bf16* Y0, int bx, int G, int tid, int lane, int wave) {
    LAS unsigned char* Ks = lds + K_OFF; LAS unsigned char* Vs = lds + V_OFF;
    const u32x4_t zero4 = {0u, 0u, 0u, 0u};
    for (int it = bx; it < NBP * 32 * NKV + SB * NKV; it += G) {
        const int kvh = it & 3;
        if (it < NBP * 32 * NKV) {
            const int b = it >> 7, qb = (it >> 2) & 31;
#pragma unroll
            for (int i = 0; i < 4; ++i) { const int p = tid + NTHR * i, sr = p >> 3, cc = p & 7; const int pos = 128 * (qb - 1) + sr;
                u32x4_t kq = zero4, vq = zero4;
                if (pos >= 0) { const bf16* zr = Z + (size_t)(b * SEQ + pos) * ZW + kvh * 64 + cc * 8; kq = *(const u32x4_t*)(zr + ZK); vq = *(const u32x4_t*)(zr + ZV); }
                *(LAS u32x4_t*)(Ks + sr * KP + cc * 16) = kq; *(LAS u32x4_t*)(Vs + sr * KP + cc * 16) = vq; }
            if (tid < 128) { const int sr = 256 + (tid >> 3), cc = tid & 7; *(LAS u32x4_t*)(Ks + sr * KP + cc * 16) = zero4; *(LAS u32x4_t*)(Vs + sr * KP + cc * 16) = zero4; }
            __syncthreads();
            const int hq = kvh * 4 + (wave >> 1), qh = wave & 1;
            const float slope2 = exp2f(-0.5f * (float)(hq + 1)) * 1.4426950408889634f, sink2 = sinks[l * NH + hq] * 1.4426950408889634f;
            const bf16* qp0 = Z + ((size_t)b * SEQ + 128 * qb + 64 * qh + (lane & 15)) * ZW + ZQ + hq * 64 + 8 * (lane >> 4);
            bf16x8 qc0 = *(const bf16x8*)qp0, qc1 = *(const bf16x8*)(qp0 + 32);
#pragma unroll 1
            for (int qt = 0; qt < 4; ++qt) { const int t1 = 64 * qh + 16 * qt; const size_t qrow0 = (size_t)b * SEQ + 128 * qb + t1;
                const bf16* qpn = qp0 + (size_t)(16 * (qt < 3 ? qt + 1 : 3)) * ZW; const bf16x8 qn0 = *(const bf16x8*)qpn, qn1 = *(const bf16x8*)(qpn + 32);
                tile16(qc0, qc1, Ks, Vs, t1, 128 * qb + t1 - 128, slope2, sink2, Y0 + qrow0 * BRW + hq * 64, 16, lane);
                qc0 = qn0; qc1 = qn1; }
        } else {
            const int sb = (it - NBP * 32 * NKV) >> 2;
#pragma unroll
            for (int i = 0; i < 3; ++i) { const int p = tid + NTHR * i, sr = p >> 3, cc = p & 7;
                if (sr < 160) { u32x4_t kq = zero4, vq = zero4;
                    if (sr < WIN) { const size_t o = ((((size_t)l * SB + sb) * WIN + sr) * NKV + kvh) * 64 + cc * 8; float f[8];
#pragma unroll
                        for (int e = 0; e < 8; ++e) f[e] = ck[o + e];
                        kq = pack8(f);
#pragma unroll
                        for (int e = 0; e < 8; ++e) f[e] = cv[o + e];
                        vq = pack8(f);
                    } else if (sr < WIN + ST) { const bf16* zr = Z + (size_t)(MP + sb * ST + (sr - WIN)) * ZW + kvh * 64 + cc * 8; kq = *(const u32x4_t*)(zr + ZK); vq = *(const u32x4_t*)(zr + ZV); }
                    *(LAS u32x4_t*)(Ks + sr * KP + cc * 16) = kq; *(LAS u32x4_t*)(Vs + sr * KP + cc * 16) = vq; } }
            __syncthreads();
            if (wave < 4) { const int hq = kvh * 4 + wave;
                const float slope2 = exp2f(-0.5f * (float)(hq + 1)) * 1.4426950408889634f, sink2 = sinks[l * NH + hq] * 1.4426950408889634f;
                const size_t qrow0 = (size_t)MP + sb * ST; const bf16* qp = Z + (qrow0 + (lane & 7)) * ZW + ZQ + hq * 64 + 8 * (lane >> 4);
                tile16(*(const bf16x8*)qp, *(const bf16x8*)(qp + 32), Ks, Vs, 0, 0, slope2, sink2, Y0 + qrow0 * BRW + hq * 64, ST, lane); }
        }
        __syncthreads();
    }
}
}

namespace adad {
using att::bf16x8; using att::f32x4; using att::cvtpk;
constexpr int NSTRIP = ADAW / 64, RW = 576, A2_OFF = 8 * RW * 16, A2_WAVE = 3 * 512;
#define ADA_LOAD(V, S) _Pragma("unroll") for (int j = 0; j < 8; ++j) V[j] = __builtin_nontemporal_load((const GAS f32x4*)(wp + (size_t)(32 * (S) + j) * ADAW))
__device__ __forceinline__ v4u silu8(f32x4 x0, f32x4 x1) { v4u o;
    o.x = cvtpk(x0.x * sigmoidf_(x0.x), x0.y * sigmoidf_(x0.y)); o.y = cvtpk(x0.z * sigmoidf_(x0.z), x0.w * sigmoidf_(x0.w));
    o.z = cvtpk(x1.x * sigmoidf_(x1.x), x1.y * sigmoidf_(x1.y)); o.w = cvtpk(x1.z * sigmoidf_(x1.z), x1.w * sigmoidf_(x1.w)); return o; }
__device__ __forceinline__ const GAS float* crow(const float* cp, const float* cs, int row) { return row < NBP ? (const GAS float*)cp + (size_t)row * DM : (const GAS float*)cs + (size_t)(row - NBP) * DM; }
__device__ __forceinline__ void phase(const float* cp, const float* cs, const float* wada, const float* bada, float* ADA, LAS unsigned char* lds, int bx, int G, int wave, int lane, int tid) {
    const int kl = 256 * wave + 8 * (lane >> 4);
    bf16x8 af[2][8];
#pragma unroll
    for (int mb = 0; mb < 2; ++mb) { const GAS float* src = crow(cp, cs, 16 * mb + (lane & 15)) + kl;
#pragma unroll
        for (int s = 0; s < 8; ++s) af[mb][s] = __builtin_bit_cast(bf16x8, silu8(*(const GAS f32x4*)(src + 32 * s), *(const GAS f32x4*)(src + 32 * s + 4))); }
    LAS unsigned char* a2 = lds + A2_OFF + wave * A2_WAVE;
    {   const GAS float* src = crow(cp, cs, 32 + (lane >> 5)) + 256 * wave + 8 * (lane & 31);
        *(LAS v4u*)(a2 + (lane >> 5) * 512 + (lane & 31) * 16) = silu8(*(const GAS f32x4*)src, *(const GAS f32x4*)(src + 4));
        if (lane < 32) { v4u z = {0u, 0u, 0u, 0u}; *(LAS v4u*)(a2 + 2 * 512 + lane * 16) = z; }
        LDS_WAIT(); asm volatile("" ::: "memory"); }
    const LAS unsigned char* a2r = a2 + ((lane & 15) < 2 ? (lane & 15) : 2) * 512 + (lane >> 4) * 16;
    LAS f32x4* red = (LAS f32x4*)lds;
    for (int g = bx; g < DEPTH * NSTRIP; g += G) { const int l = g / NSTRIP, n0 = 64 * (g % NSTRIP);
        const GAS float* wp = (const GAS float*)wada + (size_t)l * DM * ADAW + (size_t)kl * ADAW + n0 + 4 * (lane & 15);
        f32x4 acc[3][4];
#pragma unroll
        for (int mb = 0; mb < 3; ++mb)
#pragma unroll
            for (int i = 0; i < 4; ++i) acc[mb][i] = f32x4{0.f, 0.f, 0.f, 0.f};
        f32x4 v0[8], v1[8];
        ADA_LOAD(v0, 0);
#pragma unroll
        for (int s = 0; s < 8; ++s) {
            if (s < 7) { if (s & 1) { ADA_LOAD(v0, s + 1); } else { ADA_LOAD(v1, s + 1); } }
            asm volatile("" ::: "memory");
            const bf16x8 a2f = *(const LAS bf16x8*)(a2r + 64 * s);
#pragma unroll
            for (int i = 0; i < 4; ++i) { v4u w;
                if (s & 1) { w.x = cvtpk(v1[0][i], v1[1][i]); w.y = cvtpk(v1[2][i], v1[3][i]); w.z = cvtpk(v1[4][i], v1[5][i]); w.w = cvtpk(v1[6][i], v1[7][i]); }
                else       { w.x = cvtpk(v0[0][i], v0[1][i]); w.y = cvtpk(v0[2][i], v0[3][i]); w.z = cvtpk(v0[4][i], v0[5][i]); w.w = cvtpk(v0[6][i], v0[7][i]); }
                const bf16x8 bfr = __builtin_bit_cast(bf16x8, w);
                acc[0][i] = __builtin_amdgcn_mfma_f32_16x16x32_bf16(af[0][s], bfr, acc[0][i], 0, 0, 0);
                acc[1][i] = __builtin_amdgcn_mfma_f32_16x16x32_bf16(af[1][s], bfr, acc[1][i], 0, 0, 0);
                acc[2][i] = __builtin_amdgcn_mfma_f32_16x16x32_bf16(a2f, bfr, acc[2][i], 0, 0, 0); }
            asm volatile("" ::: "memory"); }
        LAS f32x4* rw = red + wave * RW;
#pragma unroll
        for (int mb = 0; mb < 2; ++mb)
#pragma unroll
            for (int i = 0; i < 4; ++i) rw[(mb * 4 + i) * 64 + lane] = acc[mb][i];
        if (lane < 16) {
#pragma unroll
            for (int i = 0; i < 4; ++i) rw[512 + i * 16 + lane] = acc[2][i]; }
        __syncthreads();
        for (int e = tid; e < RW; e += NTHR) { f32x4 t = red[e];
#pragma unroll
            for (int w = 1; w < 8; ++w) t += red[w * RW + e];
            int row0, col;
            if (e < 512) { const int mbi = e >> 6, ln = e & 63; row0 = 16 * (mbi >> 2) + 4 * (ln >> 4); col = n0 + 4 * (ln & 15) + (mbi & 3); }
            else { const int q = e - 512; row0 = 32; col = n0 + 4 * (q & 15) + (q >> 4); }
            const float bv = *((const GAS float*)bada + (size_t)l * ADAW + col);
            GAS float* o = (GAS float*)ADA + ((size_t)l * NROWB + row0) * ADAW + col;
            o[0] = t.x + bv; o[ADAW] = t.y + bv;
            if (row0 < 32) { o[2 * (size_t)ADAW] = t.z + bv; o[3 * (size_t)ADAW] = t.w + bv; } }
        __syncthreads(); }
}
}

namespace ret {
using att::bf16x8; using att::s16x4; using att::f32x4; using att::u32x4_t; using att::vtr; using att::cvtpk; using att::pack8;
constexpr int KP = 144, VP = 288, K_OFF = 0, V_OFF = 128 * KP, S_OFF = V_OFF + 128 * VP, LDS_NEED = S_OFF + 64 * VP;
template <int CTRL> __device__ __forceinline__ float dppf(float v) { return __builtin_bit_cast(float, __builtin_amdgcn_update_dpp(0, __builtin_bit_cast(int, v), CTRL, 0xf, 0xf, false)); }
__device__ __forceinline__ float sum16(float v) { v += dppf<0xB1>(v); v += dppf<0x4E>(v); v += dppf<0x141>(v); v += dppf<0x140>(v); return v; }
__device__ __forceinline__ void out_phase(LAS unsigned char* lds, const bf16* Z, int l, const float* SPREV, const float* gret, bf16* Y3, int bx, int G, int tid, int lane, int wave) {
    LAS unsigned char* Ks = lds + K_OFF; LAS unsigned char* Vs = lds + V_OFF; LAS unsigned char* Ss = lds + S_OFF;
    const int c = lane & 15, g = lane >> 4;
    for (int it = bx; it < NBP * 32 * RH; it += G) {
        const int b = it >> 8, n = (it >> 3) & 31, h = it & 7; const size_t row0 = (size_t)b * SEQ + n * 128;
#pragma unroll
        for (int i = 0; i < 2; ++i) { const int p = tid + NTHR * i, j = p >> 3, cc = p & 7; *(LAS u32x4_t*)(Ks + j * KP + cc * 16) = *(const u32x4_t*)(Z + (row0 + j) * ZW + ZRK + h * 64 + cc * 8); }
#pragma unroll
        for (int i = 0; i < 4; ++i) { const int p = tid + NTHR * i, j = p >> 4, cc = p & 15; *(LAS u32x4_t*)(Vs + j * VP + cc * 16) = *(const u32x4_t*)(Z + (row0 + j) * ZW + ZRV + h * 128 + cc * 8); }
#pragma unroll
        for (int i = 0; i < 2; ++i) { const int p = tid + NTHR * i, d = p >> 4, cc = p & 15; const float* sp = SPREV + ((((size_t)b * 32 + n) * RH + h) * RDK + d) * RDV + cc * 8; float f[8];
#pragma unroll
            for (int e = 0; e < 8; ++e) f[e] = sp[e];
            *(LAS u32x4_t*)(Ss + d * VP + cc * 16) = pack8(f); }
        __syncthreads();
        const int w = wave; const float lg2 = ret_logg(h) * 1.4426950408889634f;
        const bf16* qp = Z + (row0 + 16 * w + c) * ZW + ZRQ + h * 64 + 8 * g;
        const bf16x8 qf0 = *(const bf16x8*)qp, qf1 = *(const bf16x8*)(qp + 32);
        f32x4 o[8];
#pragma unroll
        for (int vt = 0; vt < 8; ++vt) o[vt] = (f32x4){0.f, 0.f, 0.f, 0.f};
#pragma unroll
        for (int ks = 0; ks < 2; ++ks) { const LAS unsigned char* sb = Ss + (32 * ks + 8 * g + (c >> 2)) * VP + 8 * (c & 3);
#pragma unroll
            for (int vt = 0; vt < 8; ++vt) { const s16x4 lo = vtr(sb + 32 * vt), hi = vtr(sb + 4 * VP + 32 * vt); const bf16x8 bb = {lo[0], lo[1], lo[2], lo[3], hi[0], hi[1], hi[2], hi[3]};
                o[vt] = __builtin_amdgcn_mfma_f32_16x16x32_bf16(ks ? qf1 : qf0, bb, o[vt], 0, 0, 0); } }
#pragma unroll
        for (int r = 0; r < 4; ++r) { const float cf = __builtin_amdgcn_exp2f(lg2 * (float)(16 * w + 4 * g + r + 1));
#pragma unroll
            for (int vt = 0; vt < 8; ++vt) o[vt][r] *= cf; }
        for (int ks = 0; ks <= (w >> 1); ++ks) {
            f32x4 st[2];
#pragma unroll
            for (int t = 0; t < 2; ++t) { const int jt = 2 * ks + t; f32x4 a = {0.f, 0.f, 0.f, 0.f};
                if (jt <= w) { const LAS unsigned char* kp = Ks + (16 * jt + c) * KP + 16 * g; const bf16x8 k0 = *(const LAS bf16x8*)kp, k1 = *(const LAS bf16x8*)(kp + 64);
                    a = __builtin_amdgcn_mfma_f32_16x16x32_bf16(k0, qf0, a, 0, 0, 0); a = __builtin_amdgcn_mfma_f32_16x16x32_bf16(k1, qf1, a, 0, 0, 0);
#pragma unroll
                    for (int r = 0; r < 4; ++r) { const int dij = (16 * w + c) - (16 * jt + 4 * g + r); a[r] = dij >= 0 ? a[r] * 0.125f * __builtin_amdgcn_exp2f(lg2 * (float)dij) : 0.f; } }
                st[t] = a; }
            const u32x4_t pw = {cvtpk(st[0][0], st[0][1]), cvtpk(st[0][2], st[0][3]), cvtpk(st[1][0], st[1][1]), cvtpk(st[1][2], st[1][3])}; const bf16x8 pf = __builtin_bit_cast(bf16x8, pw);
            const LAS unsigned char* vb = Vs + (32 * ks + 4 * g + (c >> 2)) * VP + 8 * (c & 3);
#pragma unroll
            for (int vt = 0; vt < 8; ++vt) { const s16x4 lo = vtr(vb + 32 * vt), hi = vtr(vb + 16 * VP + 32 * vt); const bf16x8 bb = {lo[0], lo[1], lo[2], lo[3], hi[0], hi[1], hi[2], hi[3]};
                o[vt] = __builtin_amdgcn_mfma_f32_16x16x32_bf16(pf, bb, o[vt], 0, 0, 0); }
        }
        float mean[4], rstd[4];
#pragma unroll
        for (int r = 0; r < 4; ++r) { float sm = 0.f;
#pragma unroll
            for (int vt = 0; vt < 8; ++vt) sm += o[vt][r];
            mean[r] = sum16(sm) * (1.f / 128.f); float q = 0.f;
#pragma unroll
            for (int vt = 0; vt < 8; ++vt) { const float dd = o[vt][r] - mean[r]; q += dd * dd; }
            rstd[r] = 1.f / sqrtf(sum16(q) * (1.f / 128.f) + EPS); }
        const float* gp = gret + l * BRW + h * 128 + c;
        float gv[8]; bf16 rgv[4][8];
#pragma unroll
        for (int vt = 0; vt < 8; ++vt) gv[vt] = gp[16 * vt];
#pragma unroll
        for (int r = 0; r < 4; ++r) { const bf16* rg = Z + (row0 + 16 * w + 4 * g + r) * ZW + ZRG + h * 128 + c;
#pragma unroll
            for (int vt = 0; vt < 8; ++vt) rgv[r][vt] = rg[16 * vt]; }
        asm volatile("" ::: "memory");
#pragma unroll
        for (int r = 0; r < 4; ++r) { bf16* y = Y3 + (row0 + 16 * w + 4 * g + r) * BRW + h * 128 + c;
#pragma unroll
            for (int vt = 0; vt < 8; ++vt) y[16 * vt] = f2bf((o[vt][r] - mean[r]) * rstd[r] * gv[vt] * bf2f(rgv[r][vt])); }
        __syncthreads();
    }
}

__device__ __forceinline__ void kv_phase(LAS unsigned char* lds, const bf16* Z, float* KV, int bx, int G, int tid, int lane, int wave) {
    LAS unsigned char* Ks = lds + K_OFF; LAS unsigned char* Vs = lds + V_OFF;
    const int c = lane & 15, g = lane >> 4;
    for (int it = bx; it < NBP * 32 * RH; it += G) {
        const int b = it >> 8, n = (it >> 3) & 31, h = it & 7; const size_t row0 = (size_t)b * SEQ + n * 128;
        const float lg2 = ret_logg(h) * 1.4426950408889634f;
#pragma unroll
        for (int i = 0; i < 2; ++i) { const int p = tid + NTHR * i, j = p >> 3, cc = p & 7; float f[8]; ld8(Z + (row0 + j) * ZW + ZRK + h * 64 + cc * 8, f);
            const float sc = 0.125f * __builtin_amdgcn_exp2f(lg2 * (float)(127 - j));
#pragma unroll
            for (int e = 0; e < 8; ++e) f[e] *= sc;
            *(LAS u32x4_t*)(Ks + j * KP + cc * 16) = pack8(f); }
#pragma unroll
        for (int i = 0; i < 4; ++i) { const int p = tid + NTHR * i, j = p >> 4, cc = p & 15; *(LAS u32x4_t*)(Vs + j * VP + cc * 16) = *(const u32x4_t*)(Z + (row0 + j) * ZW + ZRV + h * 128 + cc * 8); }
        __syncthreads();
        const int dt = wave & 3, vt0 = (wave >> 2) * 4;
        f32x4 acc[4];
#pragma unroll
        for (int t = 0; t < 4; ++t) acc[t] = (f32x4){0.f, 0.f, 0.f, 0.f};
#pragma unroll
        for (int ks = 0; ks < 4; ++ks) { const LAS unsigned char* ka = Ks + (32 * ks + 8 * g + (c >> 2)) * KP + 32 * dt + 8 * (c & 3);
            const s16x4 alo = vtr(ka), ahi = vtr(ka + 4 * KP); const bf16x8 af = {alo[0], alo[1], alo[2], alo[3], ahi[0], ahi[1], ahi[2], ahi[3]};
            const LAS unsigned char* vb = Vs + (32 * ks + 8 * g + (c >> 2)) * VP + 8 * (c & 3);
#pragma unroll
            for (int t = 0; t < 4; ++t) { const s16x4 lo = vtr(vb + 32 * (vt0 + t)), hi = vtr(vb + 4 * VP + 32 * (vt0 + t)); const bf16x8 bb = {lo[0], lo[1], lo[2], lo[3], hi[0], hi[1], hi[2], hi[3]};
                acc[t] = __builtin_amdgcn_mfma_f32_16x16x32_bf16(af, bb, acc[t], 0, 0, 0); } }
        float* kvp = KV + ((((size_t)b * 32 + n) * RH + h) * RDK + 16 * dt + 4 * g) * RDV + c;
#pragma unroll
        for (int r = 0; r < 4; ++r)
#pragma unroll
            for (int t = 0; t < 4; ++t) kvp[(size_t)r * RDV + 16 * (vt0 + t)] = acc[t][r];
        __syncthreads();
    }
}
}

namespace mixl {
using att::u32x4_t; using att::f32x4; using att::f32x2_t;
template <int CTRL> __device__ __forceinline__ float dppf(float v) { return __builtin_bit_cast(float, __builtin_amdgcn_update_dpp(0, __builtin_bit_cast(int, v), CTRL, 0xf, 0xf, false)); }
__device__ __forceinline__ float sum8(float v) { v += dppf<0xB1>(v); v += dppf<0x4E>(v); v += dppf<0x141>(v); return v; }
struct QkRow { float q0[8], q1[8], kv[8]; };
__device__ __forceinline__ void qk_load(const bf16* zr, QkRow& R, int lane) { ld8(zr + ZQ + lane * 8, R.q0); ld8(zr + ZQ + 512 + lane * 8, R.q1); ld8(zr + ZK + lane * 8, R.kv); }
__device__ __forceinline__ void qk_finish(bf16* zr, int row, int l, QkRow& R, const float (&g8q)[8], const float (&g8k)[8], float* out, int lane) {
    float s0 = 0.f, s1 = 0.f, s2 = 0.f;
#pragma unroll
    for (int e = 0; e < 8; ++e) { s0 += R.q0[e] * R.q0[e]; s1 += R.q1[e] * R.q1[e]; s2 += R.kv[e] * R.kv[e]; }
    const float r0 = 1.f / sqrtf(sum8(s0) * (1.f / 64.f) + EPS), r1 = 1.f / sqrtf(sum8(s1) * (1.f / 64.f) + EPS), r2 = 1.f / sqrtf(sum8(s2) * (1.f / 64.f) + EPS);
#pragma unroll
    for (int e = 0; e < 8; ++e) { R.q0[e] *= r0 * g8q[e]; R.q1[e] *= r1 * g8q[e]; if (lane < 32) R.kv[e] *= r2 * g8k[e]; }
    st8(zr + ZQ + lane * 8, R.q0); st8(zr + ZQ + 512 + lane * 8, R.q1);
    if (lane < 32) st8(zr + ZK + lane * 8, R.kv);
    float* o = nullptr;
    if (row < MP) { const int b = row >> 12, t = row & (SEQ - 1); if (t >= SEQ - WIN) o = out + (lane < 32 ? O_KP : O_VP) + (((size_t)l * NBP + b) * WIN + (t - (SEQ - WIN))) * 256 + (lane & 31) * 8; }
    else { const int sb = (row - MP) >> 3, t = (row - MP) & 7; o = out + (lane < 32 ? O_KS : O_VS) + (((size_t)l * SB + sb) * WIN + (WIN - ST + t)) * 256 + (lane & 31) * 8; }
    if (o) { *(f32x4*)o = (f32x4){R.kv[0], R.kv[1], R.kv[2], R.kv[3]}; *(f32x4*)(o + 4) = (f32x4){R.kv[4], R.kv[5], R.kv[6], R.kv[7]}; }
}
__device__ __forceinline__ void qknorm_phase(bf16* Z, int l, const float* gq, const float* gk, float* out, int gw, int NGW, int lane) {
    float g8q[8], g8k[8];
#pragma unroll
    for (int e = 0; e < 8; ++e) { g8q[e] = gq[l * 64 + (lane & 7) * 8 + e]; g8k[e] = gk[l * 64 + (lane & 7) * 8 + e]; }
    for (int row = gw; row < M; row += 2 * NGW) { const int rowb = row + NGW; const bool two = rowb < M;
        bf16* za = Z + (size_t)row * ZW; bf16* zb = Z + (size_t)(two ? rowb : row) * ZW;
        QkRow A, B; qk_load(za, A, lane); qk_load(zb, B, lane);
        asm volatile("" ::: "memory");
        qk_finish(za, row, l, A, g8q, g8k, out, lane);
        if (two) qk_finish(zb, rowb, l, B, g8q, g8k, out, lane);
    }
}
constexpr int CV_RB = 64, CV_CB = 128, CV_UR = CV_RB + CPRE, CV_NPI = (MP / CV_RB) * 8, CV_NSI = SB * 8;
struct CvItem { bool smp; int cb, b, t0, nrows; size_t rowb; };
__device__ __forceinline__ CvItem cv_item(int it) { CvItem I; I.smp = it >= CV_NPI; I.cb = it & 7; I.b = I.smp ? (it - CV_NPI) >> 3 : (it >> 3) >> 6; I.t0 = I.smp ? 0 : ((it >> 3) & 63) * CV_RB; I.nrows = I.smp ? ST : CV_RB;
    I.rowb = I.smp ? (size_t)MP + I.b * ST : (size_t)I.b * SEQ; return I; }
__device__ __forceinline__ void cv_fetch(const bf16* Z, int l, const float* sconv, const CvItem& I, u32x4_t (&raw)[3][2], int tid) {
#pragma unroll
    for (int i = 0; i < 3; ++i) { const int p = tid + NTHR * i, ur = p >> 4, c8 = p & 15, tt = I.t0 - CPRE + ur; raw[i][0] = (u32x4_t){0u, 0u, 0u, 0u}; raw[i][1] = raw[i][0];
        if (ur < I.nrows + CPRE) {
            if (tt >= 0) { const bf16* zp = Z + (I.rowb + tt) * ZW + I.cb * CV_CB + c8 * 8; raw[i][0] = *(const u32x4_t*)(zp + ZCA); }
            else if (I.smp) { const float* sp = sconv + (((size_t)l * SB + I.b) * CPRE + (CPRE + tt)) * BRW + I.cb * CV_CB + c8 * 8; raw[i][0] = *(const u32x4_t*)sp; raw[i][1] = *(const u32x4_t*)(sp + 4); } } }
}
__device__ __forceinline__ void conv_phase(LAS unsigned char* lds, const bf16* Z, int l, const float* wdw, const float* bdw, const float* sconv, float* CONVY, float* out, int bx, int G, int tid) {
    LAS float* U = (LAS float*)lds;
    auto unp = [](const u32x4_t w, float* f) { f[0] = __builtin_bit_cast(float, w.x << 16); f[1] = __builtin_bit_cast(float, w.x & 0xffff0000u); f[2] = __builtin_bit_cast(float, w.y << 16); f[3] = __builtin_bit_cast(float, w.y & 0xffff0000u);
        f[4] = __builtin_bit_cast(float, w.z << 16); f[5] = __builtin_bit_cast(float, w.z & 0xffff0000u); f[6] = __builtin_bit_cast(float, w.w << 16); f[7] = __builtin_bit_cast(float, w.w & 0xffff0000u); };
    u32x4_t raw[3][2]; f32x2_t w2[CONVK], bias2 = {0.f, 0.f}; int wcb = -1;
#pragma unroll
    for (int j = 0; j < CONVK; ++j) w2[j] = f32x2_t{0.f, 0.f};
    if (bx < CV_NPI + CV_NSI) { const CvItem I0 = cv_item(bx); cv_fetch(Z, l, sconv, I0, raw, tid); }
    for (int it = bx; it < CV_NPI + CV_NSI; it += G) {
        const CvItem I = cv_item(it);
        const int cp = tid & 63, r0 = (tid >> 6) * 8, ch = I.cb * CV_CB + 2 * cp;
        if (I.cb != wcb) { wcb = I.cb;
#pragma unroll
            for (int j = 0; j < CONVK; ++j) w2[j] = *(const f32x2_t*)(wdw + ((size_t)l * CONVK + j) * BRW + ch);
            bias2 = *(const f32x2_t*)(bdw + l * BRW + ch); }
#pragma unroll
        for (int i = 0; i < 3; ++i) { const int p = tid + NTHR * i, ur = p >> 4, c8 = p & 15, tt = I.t0 - CPRE + ur; float u[8];
            if (ur < I.nrows + CPRE) {
                if (tt >= 0) { unp(raw[i][0], u);
                    if (ur >= CPRE) { float* o = nullptr;
                        if (!I.smp) { if (tt >= SEQ - CPRE) o = out + O_CP + (((size_t)l * NBP + I.b) * CPRE + (tt - (SEQ - CPRE))) * BRW + I.cb * CV_CB + c8 * 8; }
                        else o = out + O_CS + (((size_t)l * SB + I.b) * CPRE + (CPRE - ST + tt)) * BRW + I.cb * CV_CB + c8 * 8;
                        if (o) { *(f32x4*)o = (f32x4){u[0], u[1], u[2], u[3]}; *(f32x4*)(o + 4) = (f32x4){u[4], u[5], u[6], u[7]}; } }
                } else {
                    const unsigned r0_ = raw[i][0].x, r1_ = raw[i][0].y, r2_ = raw[i][0].z, r3_ = raw[i][0].w, r4_ = raw[i][1].x, r5_ = raw[i][1].y, r6_ = raw[i][1].z, r7_ = raw[i][1].w;
                    u[0] = __builtin_bit_cast(float, r0_); u[1] = __builtin_bit_cast(float, r1_); u[2] = __builtin_bit_cast(float, r2_); u[3] = __builtin_bit_cast(float, r3_);
                    u[4] = __builtin_bit_cast(float, r4_); u[5] = __builtin_bit_cast(float, r5_); u[6] = __builtin_bit_cast(float, r6_); u[7] = __builtin_bit_cast(float, r7_); }
                *(LAS f32x4*)(U + ur * CV_CB + c8 * 8) = (f32x4){u[0], u[1], u[2], u[3]}; *(LAS f32x4*)(U + ur * CV_CB + c8 * 8 + 4) = (f32x4){u[4], u[5], u[6], u[7]}; } }
        __syncthreads();
        if (it + G < CV_NPI + CV_NSI) { const CvItem In = cv_item(it + G); cv_fetch(Z, l, sconv, In, raw, tid); }
        if (r0 < I.nrows) {
            f32x2_t u2[8 + CPRE];
#pragma unroll
            for (int k = 0; k < 8 + CPRE; ++k) u2[k] = *(const LAS f32x2_t*)(U + (r0 + k) * CV_CB + 2 * cp);
#pragma unroll
            for (int r = 0; r < 8; ++r) { f32x2_t acc = bias2;
#pragma unroll
                for (int j = 0; j < CONVK; ++j) acc = w2[j] * u2[r + j] + acc;
                if (r0 + r < I.nrows) *(f32x2_t*)(CONVY + (I.rowb + I.t0 + r0 + r) * BRW + ch) = acc; }
        }
        __syncthreads();
    }
}
template <int W> __device__ __forceinline__ void pool_run(const bf16* Z, int l, int b, int t0, int cch, bf16* ZP, float* out) {
    const size_t rowb = (size_t)b * SEQ; u32x4_t rw[23];
#pragma unroll
    for (int k = 16 - W; k < 23; ++k) { const int tt = t0 - 15 + k; rw[k] = (u32x4_t){0u, 0u, 0u, 0u}; if (tt >= 0) rw[k] = *(const u32x4_t*)(Z + (rowb + tt) * ZW + ZPL + cch); }
    float S[8];
#pragma unroll
    for (int e = 0; e < 8; ++e) S[e] = 0.f;
    auto unp = [](const u32x4_t w, float* f) { f[0] = __builtin_bit_cast(float, w.x << 16); f[1] = __builtin_bit_cast(float, w.x & 0xffff0000u); f[2] = __builtin_bit_cast(float, w.y << 16); f[3] = __builtin_bit_cast(float, w.y & 0xffff0000u);
        f[4] = __builtin_bit_cast(float, w.z << 16); f[5] = __builtin_bit_cast(float, w.z & 0xffff0000u); f[6] = __builtin_bit_cast(float, w.w << 16); f[7] = __builtin_bit_cast(float, w.w & 0xffff0000u); };
#pragma unroll
    for (int k = 16 - W; k < 15; ++k) { float f[8]; unp(rw[k], f);
#pragma unroll
        for (int e = 0; e < 8; ++e) S[e] += f[e]; }
#pragma unroll
    for (int r = 0; r < 8; ++r) { const int t = t0 + r; float u[8], o[8], f[8]; unp(rw[15 + r], u);
        const float inv = 1.f / (float)((t + 1) < W ? (t + 1) : W);
#pragma unroll
        for (int e = 0; e < 8; ++e) { S[e] += u[e]; o[e] = S[e] * inv - u[e]; }
        st8(ZP + (rowb + t) * BRW + cch, o);
        if (t >= SEQ - PPAD) { float* so = out + O_PP + (((size_t)l * NBP + b) * PPAD + (t - (SEQ - PPAD))) * BRW + cch; *(f32x4*)so = (f32x4){u[0], u[1], u[2], u[3]}; *(f32x4*)(so + 4) = (f32x4){u[4], u[5], u[6], u[7]}; }
        unp(rw[15 + r - W + 1], f);
#pragma unroll
        for (int e = 0; e < 8; ++e) S[e] -= f[e]; }
}
template <int W> __device__ __forceinline__ void pool_run_s(const bf16* Z, int l, int b, int cch, const float* spool, bf16* ZP, float* out) {
    const size_t rowb = (size_t)MP + b * ST; const float* sp = spool + (((size_t)l * SB + b) * PPAD) * BRW + cch;
    f32x4 pf[W - 1][2]; u32x4_t rw[ST];
#pragma unroll
    for (int k = 0; k < W - 1; ++k) { pf[k][0] = *(const f32x4*)(sp + (size_t)(PPAD - (W - 1) + k) * BRW); pf[k][1] = *(const f32x4*)(sp + (size_t)(PPAD - (W - 1) + k) * BRW + 4); }
#pragma unroll
    for (int t = 0; t < ST; ++t) rw[t] = *(const u32x4_t*)(Z + (rowb + t) * ZW + ZPL + cch);
    auto unp = [](const u32x4_t w, float* f) { f[0] = __builtin_bit_cast(float, w.x << 16); f[1] = __builtin_bit_cast(float, w.x & 0xffff0000u); f[2] = __builtin_bit_cast(float, w.y << 16); f[3] = __builtin_bit_cast(float, w.y & 0xffff0000u);
        f[4] = __builtin_bit_cast(float, w.z << 16); f[5] = __builtin_bit_cast(float, w.z & 0xffff0000u); f[6] = __builtin_bit_cast(float, w.w << 16); f[7] = __builtin_bit_cast(float, w.w & 0xffff0000u); };
    float S[8];
#pragma unroll
    for (int e = 0; e < 8; ++e) S[e] = 0.f;
#pragma unroll
    for (int k = 0; k < W - 1; ++k) { S[0] += pf[k][0].x; S[1] += pf[k][0].y; S[2] += pf[k][0].z; S[3] += pf[k][0].w; S[4] += pf[k][1].x; S[5] += pf[k][1].y; S[6] += pf[k][1].z; S[7] += pf[k][1].w; }
    const float inv = 1.f / (float)W;
#pragma unroll
    for (int t = 0; t < ST; ++t) { float u[8], o[8], f[8]; unp(rw[t], u);
#pragma unroll
        for (int e = 0; e < 8; ++e) { S[e] += u[e]; o[e] = S[e] * inv - u[e]; }
        st8(ZP + (rowb + t) * BRW + cch, o);
        float* so = out + O_PS + (((size_t)l * SB + b) * PPAD + (PPAD - ST + t)) * BRW + cch; *(f32x4*)so = (f32x4){u[0], u[1], u[2], u[3]}; *(f32x4*)(so + 4) = (f32x4){u[4], u[5], u[6], u[7]};
        const int tt = t - W + 1;
        if (tt >= 0) unp(rw[tt >= 0 ? tt : 0], f);
        else { const int k = tt + W - 1 >= 0 ? tt + W - 1 : 0; f[0] = pf[k][0].x; f[1] = pf[k][0].y; f[2] = pf[k][0].z; f[3] = pf[k][0].w; f[4] = pf[k][1].x; f[5] = pf[k][1].y; f[6] = pf[k][1].z; f[7] = pf[k][1].w; }
#pragma unroll
        for (int e = 0; e < 8; ++e) S[e] -= f[e]; }
}
__device__ __forceinline__ void pool_phase(const bf16* Z, int l, const float* spool, bf16* ZP, float* out, int gw, int NGW, int lane, int gt, int NGT) {
    for (int wi = gw; wi < (MP / 8 / 2) * 4; wi += NGW) { const int cg = wi & 3, grp = (wi >> 2) * 2 + (lane >> 5), cch = (cg * 32 + (lane & 31)) * 8, b = grp >> 9, t0 = (grp & 511) * 8;
        if (cg == 0) pool_run<2>(Z, l, b, t0, cch, ZP, out); else if (cg == 1) pool_run<4>(Z, l, b, t0, cch, ZP, out); else if (cg == 2) pool_run<8>(Z, l, b, t0, cch, ZP, out); else pool_run<16>(Z, l, b, t0, cch, ZP, out); }
    for (int wi = gw; wi < (SB / 2) * 4; wi += NGW) { const int cg = wi & 3, b = (wi >> 2) * 2 + (lane >> 5), cch = (cg * 32 + (lane & 31)) * 8;
        if (cg == 0) pool_run_s<2>(Z, l, b, cch, spool, ZP, out); else if (cg == 1) pool_run_s<4>(Z, l, b, cch, spool, ZP, out); else if (cg == 2) pool_run_s<8>(Z, l, b, cch, spool, ZP, out); else pool_run_s<16>(Z, l, b, cch, spool, ZP, out); }
}
__device__ __forceinline__ void retout_s_phase(const bf16* Z, int l, const float* sret, const float* gret, bf16* Y3, int gw, int NGW, int lane) {
    for (int it = gw; it < MS * RH; it += NGW) { int h = __builtin_amdgcn_readfirstlane(it & 7); asm volatile("" : "+s"(h));
        const int rs = it >> 3, sb = rs >> 3, i = rs & 7; const size_t row = (size_t)MP + rs, row0 = (size_t)MP + sb * ST;
        const float lg = ret_logg(h);
        const bf16* qp = Z + row * ZW + ZRQ + h * 64;
        const float* S = sret + (((size_t)l * SB + sb) * RH + h) * RDK * RDV;
        float o0 = 0.f, o1 = 0.f;
        const float ql = bf2f(qp[lane]);
        bf16 kj[ST], v0j[ST], v1j[ST];
#pragma unroll
        for (int j = 0; j < ST; ++j) { const bf16* zj = Z + (row0 + j) * ZW; kj[j] = zj[ZRK + h * 64 + lane]; v0j[j] = zj[ZRV + h * 128 + lane]; v1j[j] = zj[ZRV + h * 128 + lane + 64]; }
#pragma unroll
        for (int d0 = 0; d0 < 64; d0 += 32) { float sa[32], sb_[32];
#pragma unroll
            for (int d = 0; d < 32; ++d) { sa[d] = S[(size_t)(d0 + d) * RDV + lane]; sb_[d] = S[(size_t)(d0 + d) * RDV + lane + 64]; }
#pragma unroll
            for (int d = 0; d < 32; ++d) { const float qd = __builtin_bit_cast(float, __builtin_amdgcn_readlane(__builtin_bit_cast(int, ql), d0 + d)); o0 += qd * sa[d]; o1 += qd * sb_[d]; } }
        const float cf = FEXP(lg * (float)(i + 1)); o0 *= cf; o1 *= cf;
#pragma unroll
        for (int j = 0; j < ST; ++j) { const float sc = j <= i ? wave_sum(ql * bf2f(kj[j])) * 0.125f * FEXP(lg * (float)(i - j)) : 0.f;
            o0 += sc * bf2f(v0j[j]); o1 += sc * bf2f(v1j[j]); }
        const float mean = wave_sum(o0 + o1) * (1.f / 128.f); const float d0 = o0 - mean, d1 = o1 - mean;
        const float rstd = 1.f / sqrtf(wave_sum(d0 * d0 + d1 * d1) * (1.f / 128.f) + EPS);
        const float* g = gret + l * BRW + h * 128; const bf16* rg = Z + row * ZW + ZRG + h * 128; bf16* y = Y3 + row * BRW + h * 128;
        y[lane] = f2bf(d0 * rstd * g[lane] * bf2f(rg[lane])); y[lane + 64] = f2bf(d1 * rstd * g[lane + 64] * bf2f(rg[lane + 64]));
    }
}
}
struct AdaOrder { int G, c; const char* A; const char* B;
    __device__ __forceinline__ bool next(int i, pg8::Unit& u) const { const int Lx = i * G + c; if (Lx >= DEPTH * (ADAW / 256)) return false;
        u.r = Lx / (ADAW / 256); u.pn = Lx % (ADAW / 256); u.pm = 0; u.ks = 0; u.nt = DM / 64; u.a = A; u.b = B + ((size_t)u.r * ADAW + (size_t)u.pn * 256) * DM * 2; return true; } };
struct PoolOrder { int G, c; const char* A; const char* B;
                __device__ __forceinline__ bool next(int i, pg8::Unit& u) const { const int Lx = i * G + c; if (Lx >= (M / 256) * 4) return false;
                    u.pm = Lx >> 2; u.pn = Lx & 3; u.r = 0; u.ks = 0; u.nt = 256 / 64; u.a = A + ((size_t)u.pm * 256 * BRW + (size_t)u.pn * 256) * 2; u.b = B + (size_t)u.pn * 256 * 256 * 2; return true; } };
__device__ __forceinline__ unsigned long long ld_ptr(volatile LAS unsigned* p) { const unsigned lo = __builtin_amdgcn_readfirstlane(p[0]), hi = __builtin_amdgcn_readfirstlane(p[1]); return ((unsigned long long)hi << 32) | lo; }
__device__ __forceinline__ att::f32x4 retstate_s_val(const bf16* Z, int l, int sb, int h, int d, int v4, const float* sret, float* out, float*& o) {
    const float lg = ret_logg(h);
    const size_t so = ((((size_t)l * SB + sb) * RH + h) * RDK + d) * RDV + v4 * 4;
    const float gc = FEXP(lg * (float)ST);
    const att::f32x4 s4 = *(const att::f32x4*)(sret + so); float a0 = gc * s4.x, a1 = gc * s4.y, a2 = gc * s4.z, a3 = gc * s4.w;
#pragma unroll
    for (int j = 0; j < ST; ++j) { const bf16* p = Z + (size_t)(MP + sb * ST + j) * ZW;
        const float kd = bf2f(p[ZRK + h * 64 + d]) * 0.125f * FEXP(lg * (float)(ST - 1 - j));
        const bf16* pv = p + ZRV + h * 128 + v4 * 4;
        a0 += kd * bf2f(pv[0]); a1 += kd * bf2f(pv[1]); a2 += kd * bf2f(pv[2]); a3 += kd * bf2f(pv[3]); }
    o = out + O_RS + so; return att::f32x4{a0, a1, a2, a3};
}
constexpr int NPL = 12;
constexpr int PH_TOTAL = 2 + DEPTH * NPL + 1;
constexpr int KS_BR = 2, KS_OUT = 8, KS_M1 = 4, KS_M2 = 16;
struct Args { const float* in[N_IN]; float* out; unsigned char* ws; int ph_lo, ph_hi; };
static_assert(sizeof(Args) == N_IN * 8 + 8 + 8 + 8, "Args has no padding");

__global__ void __launch_bounds__(NTHR, 2) fwd(Args args) {
    extern __shared__ __attribute__((aligned(16))) unsigned char lds[];
    LAS unsigned char* L0 = (LAS unsigned char*)lds;
    volatile LAS unsigned* MISC = (volatile LAS unsigned*)(L0 + MISC_OFF);
    const int G = gridDim.x, bx = blockIdx.x, wave0 = __builtin_amdgcn_readfirstlane(threadIdx.x >> 6);
    unsigned char* ws0 = args.ws;
    for (int u = threadIdx.x; u < (LDS_BYTES - LDSCTL_OFF) / 4; u += NTHR) ((LAS unsigned*)(L0 + LDSCTL_OFF))[u] = 0u;
    __syncthreads();
    if (threadIdx.x <= N_IN) ((LAS unsigned long long*)(L0 + INTAB_OFF))[threadIdx.x] = threadIdx.x < N_IN ? (unsigned long long)args.in[threadIdx.x < N_IN ? threadIdx.x : 0] : (unsigned long long)args.out;
    __syncthreads();
#if MK_ONE_LAUNCH
    XcdBarrier bar = xcd_barrier_post((unsigned*)(ws0 + WS_CTL) + CW_BAR, MISC + 8);
#define GRID_BAR() xcd_barrier(bar)
#else
#define GRID_BAR() do {} while (0)
#endif
    const int lo = args.ph_lo, hi = args.ph_hi;
#ifndef PH_MASK
#define PH_MASK 0x7FFF
#endif
#ifndef PROBE_MASK
#define PROBE_MASK 0
#endif
#define PROBE_BEGIN(bit) unsigned long long pr_t0 = 0; if ((PROBE_MASK >> (bit)) & 1) pr_t0 = __builtin_amdgcn_s_memrealtime()
#define PROBE_END(bit) do { if ((PROBE_MASK >> (bit)) & 1) { __syncthreads(); const unsigned long long t1 = __builtin_amdgcn_s_memrealtime(); while (__builtin_amdgcn_s_memrealtime() - t1 < t1 - pr_t0) __builtin_amdgcn_s_sleep(8); } } while (0)
#define TAIL_FILL(nsub, N, ...) do { const int f0_ = (nsub) < G ? (nsub) : 0; if (bx >= f0_) for (int i = (bx - f0_) * NTHR + tid; i < (N); i += (G - f0_) * NTHR) { __VA_ARGS__; } } while (0)
#define IN(k) (lo <= (k) && (k) < hi)
#define SEAM(k) do { if (IN((k) + 1)) GRID_BAR(); } while (0)
#define INP(i)  ((const float*)(GAS const float*)ld_ptr((volatile LAS unsigned*)(L + INTAB_OFF) + 2 * (i)))
#define P_OUT   ((float*)(GAS float*)ld_ptr((volatile LAS unsigned*)(L + INTAB_OFF) + 2 * N_IN))
#define WIN_T   ((bf16*)(ws + WS_WIN))
#define WBR_T   ((bf16*)(ws + WS_WBR))
#define WOUT_T  ((bf16*)(ws + WS_WOUT))
#define WM1_T   ((bf16*)(ws + WS_WM1))
#define WM2_T   ((bf16*)(ws + WS_WM2))
#define WPOOL_T ((bf16*)(ws + WS_WPOOL))
#define WADA_T  ((bf16*)(ws + WS_WADA))
#define SC      ((bf16*)(ws + WS_SC))
#define ADA     ((float*)(ws + WS_ADA))
#define H       ((bf16*)(ws + WS_H))
#define Z       ((bf16*)(ws + WS_Z))
#define Y       ((bf16*)(ws + WS_Y))
#define ZP      ((bf16*)(ws + WS_ZP))
#define CONVY   ((float*)(ws + WS_CONVY))
#define ORAW    ((float*)(ws + WS_ORAW))
#define KV      ((float*)(ws + WS_KV))
#define SPREV   ((float*)(ws + WS_SPREV))
#define MACC    ((float*)(ws + WS_MACC))
#define MERGED  ((bf16*)(ws + WS_MERGED))
#define X1      ((float*)(ws + WS_X1))
#define X       ((float*)(ws + WS_X))
#define X1B     ((bf16*)(ws + WS_X1))
#define XB      ((bf16*)(ws + WS_X))
#define HID     ((bf16*)(ws + WS_HID))
#define SLAB    ((float*)(ws + WS_SLAB))
#define TIDS() int lane; asm volatile("v_mbcnt_lo_u32_b32 %0, -1, 0\n\tv_mbcnt_hi_u32_b32 %0, -1, %0" : "=v"(lane)); GAS unsigned char* wsg = (GAS unsigned char*)ws0; asm volatile("" : "+s"(wsg)); unsigned char* ws = (unsigned char*)wsg; LAS unsigned char* L = L0; asm volatile("" : "+s"(L)); const int wave = wave0, tid = wave0 * 64 + lane; const int gw = bx * NWAVES + wave, NGW = G * NWAVES; const int gt = bx * NTHR + tid, NGT = G * NTHR; (void)lane; (void)gw; (void)NGW; (void)gt; (void)NGT
#define LAYER_PTRS() const float* ada = ADA + (size_t)l * NROWB * ADAW; const float* xinP = l == 0 ? INP(I_XP) : X; const float* xinS = l == 0 ? INP(I_XS) : X + (size_t)MP * DM; float* xout = l == DEPTH - 1 ? P_OUT : X; (void)ada; (void)xinP; (void)xinS; (void)xout
    if ((PH_MASK >> 12 & 1) && IN(0)) { TIDS(); PROBE_BEGIN(12);
        transpose_run<DM, ZW, true>(INP(I_WIN), WIN_T, DEPTH, gw, NGW, lane);
        transpose_run<BRW, DM>(INP(I_WBR), WBR_T, DEPTH * 4, gw, NGW, lane);
        transpose_run<DM, DM>(INP(I_WOUT), WOUT_T, DEPTH, gw, NGW, lane);
        transpose_run<DM, DFF>(INP(I_WM1), WM1_T, DEPTH, gw, NGW, lane);
        transpose_run<DFF, DM>(INP(I_WM2), WM2_T, DEPTH, gw, NGW, lane);
        transpose_run<256, 256>(INP(I_WPOOL), WPOOL_T, DEPTH * 4, gw, NGW, lane);
        adad::phase(INP(I_CP), INP(I_CS), INP(I_WADA), INP(I_BADA), ADA, L + RING_OFF, bx, G, wave, lane, tid);
        PROBE_END(12); SEAM(0);
    }
    for (int l = 0; l < DEPTH; ++l) {
        const int pb = 2 + l * NPL;
        if ((PH_MASK >> 0 & 1) && IN(pb + 0)) { TIDS(); LAYER_PTRS(); PROBE_BEGIN(0);
            for (int rs = bx; rs < MS; rs += G) { const int row = MP + rs; const float* ar = ada + (size_t)row_cond(row) * ADAW;
                if (l == 0) norm_row_block<0>(xinS + (size_t)rs * DM, nullptr, nullptr, 0, nullptr, INP(I_G1) + l * DM, ar + DM, ar, H + (size_t)row * DM, (LAS float*)(L + RING_OFF), tid, wave);
                else norm_row_block<KS_M2>(X1 + (size_t)row * DM, ar - (size_t)NROWB * ADAW + 5 * DM, SLAB + (size_t)rs * DM, (size_t)MS * DM, X + (size_t)row * DM, INP(I_G1) + l * DM, ar + DM, ar, H + (size_t)row * DM, (LAS float*)(L + RING_OFF), tid, wave); }
            f32x4 gm[8], shv[8]; int curc = row_cond(gw < MP ? gw : 0); { const float* ar = ada + (size_t)curc * ADAW; load_mod(INP(I_G1) + l * DM, ar + DM, ar, gm, shv, lane); }
            for (int row = gw; row < MP; row += 2 * NGW) { const int rowb = row + NGW; const bool pair = rowb < MP && row_cond(rowb) == row_cond(row);
                for (int k = 0; k < 2; ++k) { const int r = k ? rowb : row; if (k && (pair || rowb >= MP)) break; const int cond = row_cond(r); const float* ar = ada + (size_t)cond * ADAW;
                    if (cond != curc) { load_mod(INP(I_G1) + l * DM, ar + DM, ar, gm, shv, lane); curc = cond; }
                    if (l == 0) { const float* xin = INP(I_XP);
                        if (pair) norm_row2<false>(xin + (size_t)row * DM, xin + (size_t)rowb * DM, gm, shv, H + (size_t)row * DM, H + (size_t)rowb * DM, lane);
                        else norm_row<false>(xin + (size_t)r * DM, gm, shv, H + (size_t)r * DM, lane); }
                    else {
                        if (pair) norm_row2<true>(XB + (size_t)row * DM, XB + (size_t)rowb * DM, gm, shv, H + (size_t)row * DM, H + (size_t)rowb * DM, lane);
                        else norm_row<true>(XB + (size_t)r * DM, gm, shv, H + (size_t)r * DM, lane); } } }
            PROBE_END(0); SEAM(pb + 0);
        }
        if ((PH_MASK >> 1 & 1) && IN(pb + 1)) { TIDS(); LAYER_PTRS(); PROBE_BEGIN(1);
            pg8::StaticOrder S; S.init(H, WIN_T + (size_t)l * ZW * DM, M / 256, ZW / 256, DM, DM, DM, G, bx);
            pg8::EpiZ E{Z};
            pg8::gemm_phase<pg8::EpiZ, pg8::StaticOrder>(L + RING_OFF, pg8::Dims{DM, DM, DM}, S, E, tid);
            PROBE_END(1); SEAM(pb + 1);
        }
        if ((PH_MASK >> 2 & 1) && IN(pb + 2)) { TIDS(); LAYER_PTRS(); PROBE_BEGIN(2);
            mixl::qknorm_phase(Z, l, INP(I_GQ), INP(I_GK), P_OUT, gw, NGW, lane);
            mixl::conv_phase(L + RING_OFF, Z, l, INP(I_WDW), INP(I_BDW), INP(I_SCONV), CONVY, P_OUT, bx, G, tid);
            mixl::pool_phase(Z, l, INP(I_SPOOL), ZP, P_OUT, gw, NGW, lane, gt, NGT);
            ret::kv_phase(L + RING_OFF, Z, KV, bx, G, tid, lane, wave);
            PROBE_END(2); SEAM(pb + 2);
        }
        if ((PH_MASK >> 3 & 1) && IN(pb + 3)) { TIDS(); LAYER_PTRS(); PROBE_BEGIN(3);
            att::phase(L + RING_OFF, Z, l, INP(I_SINK), INP(I_CK), INP(I_CV), Y, bx, G, tid, lane, wave);
            for (int i = gt; i < NBP * RH * RDK * 32; i += NGT) { const int v4 = i & 31, d = (i >> 5) & 63, b = i >> 14; int h = (i >> 11) & 7;
                const size_t o0 = (((size_t)b * 32 * RH + h) * RDK + d) * RDV + v4 * 4, cs = (size_t)RH * RDK * RDV; f32x4 kvv[32];
#pragma unroll
                for (int n = 0; n < 32; ++n) kvv[n] = *(const f32x4*)(KV + o0 + n * cs);
                const float gc = FEXP(ret_logg(h) * 128.f); float z0 = 0.f; asm volatile("" : "+v"(z0)); f32x4 sacc = {z0, z0, z0, z0};
#pragma unroll
                for (int n = 0; n < 32; ++n) { *(f32x4*)(SPREV + o0 + n * cs) = sacc; sacc = sacc * gc + kvv[n]; }
                *(f32x4*)(P_OUT + O_RP + ((((size_t)l * NBP + b) * RH + h) * RDK + d) * RDV + v4 * 4) = sacc; }
            { f32x4 gv4[4], bv4[4];
#pragma unroll
              for (int j = 0; j < 4; ++j) { gv4[j] = ((const f32x4*)(INP(I_GCLN) + l * BRW))[lane + 64 * j]; bv4[j] = ((const f32x4*)(INP(I_BCLN) + l * BRW))[lane + 64 * j]; }
              for (int row = gw; row < M; row += NGW) convln_row(CONVY + (size_t)row * BRW, gv4, bv4, Y + (size_t)1 * M * BRW + (size_t)row * BRW, lane); }
            PROBE_END(3); SEAM(pb + 3);
        }
        if ((PH_MASK >> 4 & 1) && IN(pb + 4)) { TIDS(); LAYER_PTRS(); PROBE_BEGIN(4);
            mixl::retout_s_phase(Z, l, INP(I_SRET), INP(I_GRET), Y + (size_t)3 * M * BRW, gw, NGW, lane);
            ret::out_phase(L + RING_OFF, Z, l, SPREV, INP(I_GRET), Y + (size_t)3 * M * BRW, bx, G, tid, lane, wave);
            PoolOrder S{G, bx, (const char*)ZP, (const char*)(WPOOL_T + (size_t)l * 4 * 256 * 256)};
            pg8::EpiPool E{Y + (size_t)2 * M * BRW, INP(I_SPOOLS), l};
            pg8::gemm_phase<pg8::EpiPool, PoolOrder>(L + RING_OFF, pg8::Dims{BRW, 256, 256}, S, E, tid);
            PROBE_END(4); SEAM(pb + 4);
        }
        if ((PH_MASK >> 5 & 1) && IN(pb + 5)) { TIDS(); LAYER_PTRS(); PROBE_BEGIN(5);
            pg8::SplitOrder S{DM / 256, G, bx, 4, BRW / 64, KS_BR, BRW / 64 / KS_BR, (const char*)Y, (const char*)(WBR_T + (size_t)l * 4 * DM * BRW), (size_t)256 * BRW * 2, (size_t)256 * BRW * 2, (size_t)M * BRW * 2, (size_t)DM * BRW * 2};
            pg8::EpiBr E{Z, MERGED, SLAB, KS_BR};
            pg8::gemm_phase<pg8::EpiBr, pg8::SplitOrder>(L + RING_OFF, pg8::Dims{BRW, BRW, BRW}, S, E, tid);
            PROBE_END(5); SEAM(pb + 5);
        }
        if ((PH_MASK >> 6 & 1) && IN(pb + 6)) { TIDS(); LAYER_PTRS(); PROBE_BEGIN(6);
            for (int i = gt; i < MS * DM / 8; i += NGT) { float a[8];
#pragma unroll
                for (int e = 0; e < 8; ++e) a[e] = 0.f;
#pragma unroll
                for (int p = 0; p < 4 * KS_BR; ++p) { const f32x4 v0 = *(const f32x4*)(SLAB + (size_t)p * MS * DM + (size_t)i * 8), v1 = *(const f32x4*)(SLAB + (size_t)p * MS * DM + (size_t)i * 8 + 4);
                    a[0] += v0.x; a[1] += v0.y; a[2] += v0.z; a[3] += v0.w; a[4] += v1.x; a[5] += v1.y; a[6] += v1.z; a[7] += v1.w; }
                st8(MERGED + (size_t)MP * DM + (size_t)i * 8, a); }
            PROBE_END(6); SEAM(pb + 6);
        }
        if ((PH_MASK >> 7 & 1) && IN(pb + 7)) { TIDS(); LAYER_PTRS(); PROBE_BEGIN(7);
            pg8::SplitOrder S{DM / 256, G, bx, 1, DM / 64, KS_OUT, DM / 64 / KS_OUT, (const char*)MERGED, (const char*)(WOUT_T + (size_t)l * DM * DM), (size_t)256 * DM * 2, (size_t)256 * DM * 2, 0, 0};
            pg8::EpiRes E{l == 0 ? (const void*)INP(I_XP) : (const void*)XB, (void*)X1B, l != 0, true, ada + 2 * DM, SLAB};
            pg8::gemm_phase<pg8::EpiRes, pg8::SplitOrder>(L + RING_OFF, pg8::Dims{DM, DM, DM}, S, E, tid);
            PROBE_END(7); SEAM(pb + 7);
        }
        if ((PH_MASK >> 8 & 1) && IN(pb + 8)) { TIDS(); LAYER_PTRS(); PROBE_BEGIN(8);
            for (int rs = bx; rs < MS; rs += G) { const int row = MP + rs; const float* ar = ada + (size_t)row_cond(row) * ADAW;
                norm_row_block<KS_OUT>(xinS + (size_t)rs * DM, ar + 2 * DM, SLAB + (size_t)rs * DM, (size_t)MS * DM, X1 + (size_t)row * DM, INP(I_G2) + l * DM, ar + 4 * DM, ar + 3 * DM, H + (size_t)row * DM, (LAS float*)(L + RING_OFF), tid, wave); }
            f32x4 gm[8], shv[8]; int curc = row_cond(gw < MP ? gw : 0); { const float* ar = ada + (size_t)curc * ADAW; load_mod(INP(I_G2) + l * DM, ar + 4 * DM, ar + 3 * DM, gm, shv, lane); }
            for (int row = gw; row < MP; row += 2 * NGW) { const int rowb = row + NGW; const bool pair = rowb < MP && row_cond(rowb) == row_cond(row);
                for (int k = 0; k < 2; ++k) { const int r = k ? rowb : row; if (k && (pair || rowb >= MP)) break; const int cond = row_cond(r); const float* ar = ada + (size_t)cond * ADAW;
                    if (cond != curc) { load_mod(INP(I_G2) + l * DM, ar + 4 * DM, ar + 3 * DM, gm, shv, lane); curc = cond; }
                    if (pair) norm_row2<true>(X1B + (size_t)row * DM, X1B + (size_t)rowb * DM, gm, shv, H + (size_t)row * DM, H + (size_t)rowb * DM, lane);
                    else norm_row<true>(X1B + (size_t)r * DM, gm, shv, H + (size_t)r * DM, lane); } }
            PROBE_END(8); SEAM(pb + 8);
        }
        if ((PH_MASK >> 9 & 1) && IN(pb + 9)) { TIDS(); LAYER_PTRS(); PROBE_BEGIN(9);
            pg8::SplitOrder S{DFF / 256, G, bx, 1, DM / 64, KS_M1, DM / 64 / KS_M1, (const char*)H, (const char*)(WM1_T + (size_t)l * DFF * DM), (size_t)256 * DM * 2, (size_t)256 * DM * 2, 0, 0};
            pg8::EpiMlp1 E{HID, SLAB};
            pg8::gemm_phase<pg8::EpiMlp1, pg8::SplitOrder>(L + RING_OFF, pg8::Dims{DM, DM, DM}, S, E, tid);
            {
                const int f0 = (DFF / 256) * KS_M1 < G ? (DFF / 256) * KS_M1 : 0;
                if (bx >= f0) { const int st = (G - f0) * NTHR;
                    for (int i0 = (bx - f0) * NTHR + tid; i0 < N_SHIFT_ITEMS; i0 += 4 * st) { f32x4 v[4]; float* dp[4];
#pragma unroll
                        for (int u = 0; u < 4; ++u) { const int idx = i0 + u * st; dp[u] = nullptr; v[u] = f32x4{0.f, 0.f, 0.f, 0.f};
                            if (idx < N_SHIFT_ITEMS) { const float* sp; shift_addr(l, idx, INP(I_CK), INP(I_CV), INP(I_SCONV), INP(I_SPOOL), P_OUT, sp, dp[u]); v[u] = *(const f32x4*)sp; } }
                        asm volatile("" ::: "memory");
#pragma unroll
                        for (int u = 0; u < 4; ++u) if (dp[u]) *(f32x4*)dp[u] = v[u]; } } }
            PROBE_END(9); SEAM(pb + 9);
        }
        if ((PH_MASK >> 10 & 1) && IN(pb + 10)) { TIDS(); LAYER_PTRS(); PROBE_BEGIN(10);
            for (int i = gt; i < MS * DFF / 8; i += NGT) { float a[8];
#pragma unroll
                for (int e = 0; e < 8; ++e) a[e] = 0.f;
#pragma unroll
                for (int p = 0; p < KS_M1; ++p) { const f32x4 v0 = *(const f32x4*)(SLAB + (size_t)p * MS * DFF + (size_t)i * 8), v1 = *(const f32x4*)(SLAB + (size_t)p * MS * DFF + (size_t)i * 8 + 4);
                    a[0] += v0.x; a[1] += v0.y; a[2] += v0.z; a[3] += v0.w; a[4] += v1.x; a[5] += v1.y; a[6] += v1.z; a[7] += v1.w; }
#pragma unroll
                for (int e = 0; e < 8; ++e) { const float t = fmaxf(a[e], 0.f); a[e] = t * t; }
                st8(HID + (size_t)MP * DFF + (size_t)i * 8, a); }
            PROBE_END(10); SEAM(pb + 10);
        }
        if ((PH_MASK >> 11 & 1) && IN(pb + 11)) { TIDS(); LAYER_PTRS(); PROBE_BEGIN(11);
            pg8::SplitOrder S{DM / 256, G, bx, 1, DFF / 64, KS_M2, DFF / 64 / KS_M2, (const char*)HID, (const char*)(WM2_T + (size_t)l * DM * DFF), (size_t)256 * DFF * 2, (size_t)256 * DFF * 2, 0, 0};
            pg8::EpiRes E{(const void*)X1B, l == DEPTH - 1 ? (void*)P_OUT : (void*)XB, true, l != DEPTH - 1, ada + 5 * DM, SLAB};
            pg8::gemm_phase<pg8::EpiRes, pg8::SplitOrder>(L + RING_OFF, pg8::Dims{DFF, DFF, DFF}, S, E, tid);
            {
                const int f0 = (DM / 256) * KS_M2 < G ? (DM / 256) * KS_M2 : 0; constexpr int NI = SB * RH * RDK * 32;
                if (bx >= f0) { const int st = (G - f0) * NTHR;
                    for (int i0 = (bx - f0) * NTHR + tid; i0 < NI; i0 += 2 * st) { f32x4 r[2]; float* op[2];
#pragma unroll
                        for (int u = 0; u < 2; ++u) { const int i = i0 + u * st; op[u] = nullptr; r[u] = f32x4{0.f, 0.f, 0.f, 0.f};
                            if (i < NI) { const int v4 = i & 31, d = (i >> 5) & 63, h = (i >> 11) & 7, sb = i >> 14; r[u] = retstate_s_val(Z, l, sb, h, d, v4, INP(I_SRET), P_OUT, op[u]); } }
                        asm volatile("" ::: "memory");
#pragma unroll
                        for (int u = 0; u < 2; ++u) if (op[u]) *(f32x4*)op[u] = r[u]; } } }
            PROBE_END(11); SEAM(pb + 11);
        }
    }
    if ((PH_MASK >> 14 & 1) && IN(PH_TOTAL - 1)) { TIDS(); PROBE_BEGIN(14);
        const float* ada = ADA + (size_t)(DEPTH - 1) * NROWB * ADAW; float* yo = P_OUT + O_YS;
        for (int i = gt; i < MS * DM / 4; i += NGT) { const int row = i / (DM / 4), c4 = i % (DM / 4); const float* gp = ada + (size_t)(NBP + (row >> 3)) * ADAW + 5 * DM;
            f32x4 a = {0.f, 0.f, 0.f, 0.f};
#pragma unroll
            for (int p = 0; p < KS_M2; ++p) a += *(const f32x4*)(SLAB + (size_t)p * MS * DM + (size_t)i * 4);
            *(f32x4*)(yo + (size_t)i * 4) = *(const f32x4*)(X1 + (size_t)(MP + row) * DM + c4 * 4) + *(const f32x4*)(gp + c4 * 4) * a; }
        PROBE_END(14);
    }
#undef IN
#undef SEAM
}

extern "C" void kernel_launch(void* const* d_in, const int* in_sizes, int n_in, void* d_out, int out_size, void* d_ws, size_t ws_size, hipStream_t stream) {
    static int grid = 0;
    if (grid == 0) {
        if (n_in != N_IN || (size_t)out_size != O_END || ws_size < WS_END) { fprintf(stderr, "kernel_launch: unexpected shapes: n_in %d out %d ws %zu (need %zu)\n", n_in, out_size, ws_size, (size_t)WS_END); grid = -1; return; }
        int dev = 0, cus = 0, per_cu = 0;
        if (hipGetDevice(&dev) != hipSuccess || hipDeviceGetAttribute(&cus, hipDeviceAttributeMultiprocessorCount, dev) != hipSuccess) { grid = -1; return; }
        if (hipFuncSetAttribute((const void*)fwd, hipFuncAttributeMaxDynamicSharedMemorySize, LDS_BYTES) != hipSuccess) { fprintf(stderr, "kernel_launch: hipFuncSetAttribute failed\n"); grid = -1; return; }
        if (hipOccupancyMaxActiveBlocksPerMultiprocessor(&per_cu, (const void*)fwd, NTHR, LDS_BYTES) != hipSuccess || per_cu < 1) fprintf(stderr, "kernel_launch: occupancy query says %d\n", per_cu);
        (void)hipGetLastError();
        grid = cus;
    }
    if (grid < 0) return;
    (void)hipMemsetAsync((char*)d_ws + WS_CTL, 0, CTL_ZERO_BYTES, stream);
    Args a{};
    for (int i = 0; i < N_IN; ++i) a.in[i] = (const float*)d_in[i];
    a.out = (float*)d_out; a.ws = (unsigned char*)d_ws;
#if MK_ONE_LAUNCH
    a.ph_lo = 0; a.ph_hi = PH_TOTAL;
    hipLaunchKernelGGL(fwd, dim3(grid), dim3(NTHR), LDS_BYTES, stream, a);
#else
    for (int p = 0; p < PH_TOTAL; ++p) { a.ph_lo = p; a.ph_hi = p + 1; hipLaunchKernelGGL(fwd, dim3(grid), dim3(NTHR), LDS_BYTES, stream, a); }
#endif
}
#endif
```

```cpp
#ifndef HOST_TEST_ONLY
#include <hip/hip_runtime.h>
#endif
#include <cstdio>
#include <cstdint>
#include <cmath>

#ifndef MK_ONE_LAUNCH
#define MK_ONE_LAUNCH 1
#endif

#define HD __host__ __device__ __forceinline__
typedef unsigned short bf16;
HD float bf2f(bf16 b) { return __builtin_bit_cast(float, ((unsigned)b) << 16); }
HD bf16 f2bf(float f) { unsigned u = __builtin_bit_cast(unsigned, f); return (bf16)((u + 0x7fffu + ((u >> 16) & 1u)) >> 16); }

HD void ld8(const bf16* p, float* f) { const uint4 w = *(const uint4*)p;
    f[0] = __builtin_bit_cast(float, w.x << 16); f[1] = __builtin_bit_cast(float, w.x & 0xffff0000u); f[2] = __builtin_bit_cast(float, w.y << 16); f[3] = __builtin_bit_cast(float, w.y & 0xffff0000u);
    f[4] = __builtin_bit_cast(float, w.z << 16); f[5] = __builtin_bit_cast(float, w.z & 0xffff0000u); f[6] = __builtin_bit_cast(float, w.w << 16); f[7] = __builtin_bit_cast(float, w.w & 0xffff0000u); }
HD void st8(bf16* p, const float* f) { uint4 w; w.x = (unsigned)f2bf(f[0]) | ((unsigned)f2bf(f[1]) << 16); w.y = (unsigned)f2bf(f[2]) | ((unsigned)f2bf(f[3]) << 16);
    w.z = (unsigned)f2bf(f[4]) | ((unsigned)f2bf(f[5]) << 16); w.w = (unsigned)f2bf(f[6]) | ((unsigned)f2bf(f[7]) << 16); *(uint4*)p = w; }
constexpr int DM = 2048, SEQ = 4096, NBP = 2, MP = NBP * SEQ, SB = 32, ST = 8, MS = SB * ST, M = MP + MS, DEPTH = 4;
constexpr int NROWB = NBP + SB;
constexpr int NH = 16, HDIM = 64, NKV = 4, WIN = 128, BRW = 1024, CONVK = 31, CPRE = 30, PPAD = 15, RH = 8, RDK = 64, RDV = 128, DFF = 8192;
constexpr int ZW = 15872, ZQ = 0, ZK = 1024, ZV = 1280, ZCA = 1536, ZCG = 2560, ZPL = 3584, ZRQ = 4608, ZRK = 5120, ZRV = 5632, ZRG = 6656, ZGT = 7680;
constexpr int ADAW = 6 * DM;
constexpr float EPS = 1e-6f;
constexpr size_t O_YP = 0, O_YS = O_YP + (size_t)MP * DM, O_KP = O_YS + (size_t)MS * DM, O_VP = O_KP + (size_t)DEPTH * NBP * WIN * 256,
    O_CP = O_VP + (size_t)DEPTH * NBP * WIN * 256, O_PP = O_CP + (size_t)DEPTH * NBP * CPRE * BRW, O_RP = O_PP + (size_t)DEPTH * NBP * PPAD * BRW,
    O_KS = O_RP + (size_t)DEPTH * NBP * RH * RDK * RDV, O_VS = O_KS + (size_t)DEPTH * SB * WIN * 256, O_CS = O_VS + (size_t)DEPTH * SB * WIN * 256,
    O_PS = O_CS + (size_t)DEPTH * SB * CPRE * BRW, O_RS = O_PS + (size_t)DEPTH * SB * PPAD * BRW, O_END = O_RS + (size_t)DEPTH * SB * RH * RDK * RDV;
static_assert(O_END == 41394176, "output size");
enum { I_XP = 0, I_XS, I_CP, I_CS, I_CK, I_CV, I_SCONV, I_SPOOL, I_SRET, I_WADA, I_BADA, I_G1, I_G2, I_WIN, I_GQ, I_GK, I_SINK, I_WDW, I_BDW, I_GCLN, I_BCLN,
       I_WPOOL, I_SPOOLS, I_GRET, I_WBR, I_WOUT, I_WM1, I_WM2, N_IN };

HD bool row_is_s(int row) { return row >= MP; }
HD int row_cond(int row) { return row < MP ? (row >> 12) : NBP + ((row - MP) >> 3); }

#if defined(__HIP_DEVICE_COMPILE__)
#define FEXP(x) __expf(x)
#else
#define FEXP(x) expf(x)
#endif
#if defined(__HIP_DEVICE_COMPILE__)
HD float sigmoidf_(float x) { return __builtin_amdgcn_rcpf(1.f + __expf(-x)); }
#else
HD float sigmoidf_(float x) { return 1.f / (1.f + FEXP(-x)); }
#endif
HD float ret_logg(int h) { const float x = __builtin_bit_cast(float, (unsigned)(127 - 5 - h) << 23); return -x * (1.f + x * (0.5f + x * (0.33333334f + x * (0.25f + x * 0.2f)))); }

HD void qknorm_item(bf16* Z, int l, int row, int slot, const float* gq, const float* gk, float* out) {
    const int col = slot < 16 ? ZQ + slot * 64 : (slot < 20 ? ZK + (slot - 16) * 64 : ZV + (slot - 20) * 64);
    bf16* p = Z + (size_t)row * ZW + col;
    float v[64];
#pragma unroll
    for (int i = 0; i < 64; i += 8) ld8(p + i, v + i);
    if (slot < 20) {
        float ss = 0.f;
#pragma unroll
        for (int i = 0; i < 64; ++i) ss += v[i] * v[i];
        const float r = 1.f / sqrtf(ss * (1.f / 64.f) + EPS);
        const float* g = (slot < 16 ? gq : gk) + l * 64;
#pragma unroll
        for (int i = 0; i < 64; ++i) v[i] = v[i] * r * g[i];
#pragma unroll
        for (int i = 0; i < 64; i += 8) st8(p + i, v + i);
    }
    if (slot >= 16) {
        const int kvh = (slot - 16) & 3; const bool isv = slot >= 20;
        float* o = nullptr;
        if (!row_is_s(row)) { const int b = row >> 12, t = row & (SEQ - 1);
            if (t >= SEQ - WIN) o = out + (isv ? O_VP : O_KP) + ((((size_t)l * NBP + b) * WIN + (t - (SEQ - WIN))) * NKV + kvh) * 64;
        } else { const int sb = (row - MP) >> 3, t = (row - MP) & 7;
            o = out + (isv ? O_VS : O_KS) + ((((size_t)l * SB + sb) * WIN + (WIN - ST + t)) * NKV + kvh) * 64; }
        if (o) {
#pragma unroll
            for (int i = 0; i < 64; ++i) o[i] = v[i];
        }
    }
}
HD void shift_addr(int l, int idx, const float* ck, const float* cv, const float* sconv, const float* spool, float* out, const float*& src, float*& dst) {
    constexpr int NKVS = SB * (WIN - ST) * 64, NCV = SB * (CPRE - ST) * 256, NPL = SB * (PPAD - ST) * 256;
    if (idx < 2 * NKVS) { const bool isv = idx >= NKVS; const int i = isv ? idx - NKVS : idx; const int sb = i / ((WIN - ST) * 64), rem = i % ((WIN - ST) * 64);
        src = (isv ? cv : ck) + (((size_t)l * SB + sb) * WIN + ST) * 256 + (size_t)rem * 4; dst = out + (isv ? O_VS : O_KS) + (((size_t)l * SB + sb) * WIN) * 256 + (size_t)rem * 4;
    } else if (idx < 2 * NKVS + NCV) { const int i = idx - 2 * NKVS; const int sb = i / ((CPRE - ST) * 256), rem = i % ((CPRE - ST) * 256);
        src = sconv + (((size_t)l * SB + sb) * CPRE + ST) * BRW + (size_t)rem * 4; dst = out + O_CS + (((size_t)l * SB + sb) * CPRE) * BRW + (size_t)rem * 4;
    } else { const int i = idx - 2 * NKVS - NCV; const int sb = i / ((PPAD - ST) * 256), rem = i % ((PPAD - ST) * 256);
        src = spool + (((size_t)l * SB + sb) * PPAD + ST) * BRW + (size_t)rem * 4; dst = out + O_PS + (((size_t)l * SB + sb) * PPAD) * BRW + (size_t)rem * 4; }
}
HD void shift_item(int l, int idx, const float* ck, const float* cv, const float* sconv, const float* spool, float* out) {
    const float* src; float* dst; shift_addr(l, idx, ck, cv, sconv, spool, out, src, dst);
    dst[0] = src[0]; dst[1] = src[1]; dst[2] = src[2]; dst[3] = src[3];
}
constexpr int N_SHIFT_ITEMS = 2 * SB * (WIN - ST) * 64 + SB * (CPRE - ST) * 256 + SB * (PPAD - ST) * 256;

HD float glu_at(const bf16* Z, int row, int c) { const bf16* p = Z + (size_t)row * ZW; return bf2f(p[ZCA + c]) * sigmoidf_(bf2f(p[ZCG + c])); }
HD void conv_item(const bf16* Z, int l, int row, int c, const float* wdw, const float* bdw, const float* sconv, float* CONVY, float* out) {
    float acc = bdw[l * BRW + c];
    const float* w = wdw + (size_t)l * CONVK * BRW + c;
    if (!row_is_s(row)) { const int b = row >> 12, t = row & (SEQ - 1);
        for (int j = 0; j < CONVK; ++j) { const int tt = t - CPRE + j; if (tt >= 0) acc += w[(size_t)j * BRW] * glu_at(Z, b * SEQ + tt, c); }
        if (t >= SEQ - CPRE) out[O_CP + (((size_t)l * NBP + b) * CPRE + (t - (SEQ - CPRE))) * BRW + c] = glu_at(Z, row, c);
    } else { const int sb = (row - MP) >> 3, t = (row - MP) & 7;
        for (int j = 0; j < CONVK; ++j) { const int tt = t - CPRE + j;
            const float u = tt >= 0 ? glu_at(Z, MP + sb * ST + tt, c) : sconv[(((size_t)l * SB + sb) * CPRE + (CPRE + tt)) * BRW + c];
            acc += w[(size_t)j * BRW] * u; }
        out[O_CS + (((size_t)l * SB + sb) * CPRE + (CPRE - ST + t)) * BRW + c] = glu_at(Z, row, c);
    }
    CONVY[(size_t)row * BRW + c] = acc;
}
HD void pool_item(const bf16* Z, int l, int row, int c, const float* spool, bf16* ZP, float* out) {
    const int g = c >> 8, w = 2 << g;
    const float u0 = bf2f(Z[(size_t)row * ZW + ZPL + c]);
    float sum = 0.f, cnt;
    if (!row_is_s(row)) { const int b = row >> 12, t = row & (SEQ - 1);
        for (int i = 0; i < w; ++i) if (t - i >= 0) sum += bf2f(Z[(size_t)(b * SEQ + t - i) * ZW + ZPL + c]);
        cnt = (float)((t + 1) < w ? (t + 1) : w);
        if (t >= SEQ - PPAD) out[O_PP + (((size_t)l * NBP + b) * PPAD + (t - (SEQ - PPAD))) * BRW + c] = u0;
    } else { const int sb = (row - MP) >> 3, t = (row - MP) & 7;
        for (int i = 0; i < w; ++i) { const int tt = t - i;
            sum += tt >= 0 ? bf2f(Z[(size_t)(MP + sb * ST + tt) * ZW + ZPL + c]) : spool[(((size_t)l * SB + sb) * PPAD + (PPAD + tt)) * BRW + c]; }
        cnt = (float)w;
        out[O_PS + (((size_t)l * SB + sb) * PPAD + (PPAD - ST + t)) * BRW + c] = u0;
    }
    ZP[(size_t)row * BRW + c] = f2bf(sum / cnt - u0);
}
HD void retkv_item(const bf16* Z, float* KV, int b, int n, int h, int d, int v4) {
    const float lg = ret_logg(h);
    float a0 = 0.f, a1 = 0.f, a2 = 0.f, a3 = 0.f;
    for (int j = 0; j < 128; ++j) { const bf16* p = Z + (size_t)(b * SEQ + n * 128 + j) * ZW;
        const float kd = bf2f(p[ZRK + h * 64 + d]) * 0.125f * FEXP(lg * (float)(127 - j));
        const bf16* pv = p + ZRV + h * 128 + v4 * 4;
        a0 += kd * bf2f(pv[0]); a1 += kd * bf2f(pv[1]); a2 += kd * bf2f(pv[2]); a3 += kd * bf2f(pv[3]); }
    float* o = KV + ((((size_t)b * 32 + n) * RH + h) * RDK + d) * RDV + v4 * 4;
    o[0] = a0; o[1] = a1; o[2] = a2; o[3] = a3;
}
HD void retstate_s_item(const bf16* Z, int l, int sb, int h, int d, int v4, const float* sret, float* out) {
    const float lg = ret_logg(h);
    const size_t so = ((((size_t)l * SB + sb) * RH + h) * RDK + d) * RDV + v4 * 4;
    const float gc = FEXP(lg * (float)ST);
    float a0 = gc * sret[so], a1 = gc * sret[so + 1], a2 = gc * sret[so + 2], a3 = gc * sret[so + 3];
#pragma unroll
    for (int j = 0; j < ST; ++j) { const bf16* p = Z + (size_t)(MP + sb * ST + j) * ZW;
        const float kd = bf2f(p[ZRK + h * 64 + d]) * 0.125f * FEXP(lg * (float)(ST - 1 - j));
        const bf16* pv = p + ZRV + h * 128 + v4 * 4;
        a0 += kd * bf2f(pv[0]); a1 += kd * bf2f(pv[1]); a2 += kd * bf2f(pv[2]); a3 += kd * bf2f(pv[3]); }
    float* o = out + O_RS + so; o[0] = a0; o[1] = a1; o[2] = a2; o[3] = a3;
}
HD void retscan_item(const float* KV, float* SPREV, int l, int b, int h, int d, int v4, float* out) {
    const float gc = FEXP(ret_logg(h) * 128.f);
    float s0 = 0.f, s1 = 0.f, s2 = 0.f, s3 = 0.f;
    for (int n = 0; n < 32; ++n) { const size_t o = ((((size_t)b * 32 + n) * RH + h) * RDK + d) * RDV + v4 * 4;
        SPREV[o] = s0; SPREV[o + 1] = s1; SPREV[o + 2] = s2; SPREV[o + 3] = s3;
        s0 = gc * s0 + KV[o]; s1 = gc * s1 + KV[o + 1]; s2 = gc * s2 + KV[o + 2]; s3 = gc * s3 + KV[o + 3]; }
    float* oo = out + O_RP + ((((size_t)l * NBP + b) * RH + h) * RDK + d) * RDV + v4 * 4;
    oo[0] = s0; oo[1] = s1; oo[2] = s2; oo[3] = s3;
}
HD void attn_item(const bf16* Z, int l, int row, int hq, const float* sinks, const float* ck, const float* cv, bf16* Y0) {
    const int kvh = hq >> 2; const float slope = exp2f(-0.5f * (float)(hq + 1));
    float q[64];
    { const bf16* p = Z + (size_t)row * ZW + ZQ + hq * 64;
#pragma unroll
      for (int i = 0; i < 64; i += 8) ld8(p + i, q + i);
#pragma unroll
      for (int i = 0; i < 64; ++i) q[i] *= 0.125f; }
    float m = sinks[l * NH + hq], lsum = 1.f;
    float o[64];
#pragma unroll
    for (int i = 0; i < 64; ++i) o[i] = 0.f;
    const bool smp = row_is_s(row);
    const int b = smp ? ((row - MP) >> 3) : (row >> 12), t = smp ? ((row - MP) & 7) : (row & (SEQ - 1));
    const int lo = smp ? t : (t - WIN > 0 ? t - WIN : 0), hi = smp ? WIN + t : t;
    for (int j = lo; j <= hi; ++j) {
        const int dist = smp ? (WIN + t - j) : (t - j);
        const bool cache = smp && j < WIN;
        const size_t zrow = (size_t)(smp ? (MP + b * ST + (j - WIN)) : (b * SEQ + j)) * ZW;
        const size_t crow = ((((size_t)l * SB + b) * WIN + j) * NKV + kvh) * 64;
        float s = 0.f;
        if (cache) { const float* kp = ck + crow;
#pragma unroll
            for (int i = 0; i < 64; ++i) s += q[i] * kp[i];
        } else { const bf16* kp = Z + zrow + ZK + kvh * 64;
#pragma unroll
            for (int i = 0; i < 64; i += 8) { float f[8]; ld8(kp + i, f);
#pragma unroll
                for (int e = 0; e < 8; ++e) s += q[i + e] * f[e]; } }
        s -= slope * (float)dist;
        if (s > m) { const float corr = FEXP(m - s); lsum *= corr;
#pragma unroll
            for (int i = 0; i < 64; ++i) o[i] *= corr;
            m = s; }
        const float p = FEXP(s - m); lsum += p;
        if (cache) { const float* vp = cv + crow;
#pragma unroll
            for (int i = 0; i < 64; ++i) o[i] += p * vp[i];
        } else { const bf16* vp = Z + zrow + ZV + kvh * 64;
#pragma unroll
            for (int i = 0; i < 64; i += 8) { float f[8]; ld8(vp + i, f);
#pragma unroll
                for (int e = 0; e < 8; ++e) o[i + e] += p * f[e]; } }
    }
    const float inv = 1.f / lsum;
    bf16* y = Y0 + (size_t)row * BRW + hq * 64;
#pragma unroll
    for (int i = 0; i < 64; ++i) o[i] *= inv;
#pragma unroll
    for (int i = 0; i < 64; i += 8) st8(y + i, o + i);
}
HD void retout_item(const bf16* Z, int l, int row, int h, const float* SPREV, const float* sret, const float* gret, float* ORAW, bf16* Y3) {
    const float lg = ret_logg(h);
    const bool smp = row_is_s(row);
    const int b = smp ? ((row - MP) >> 3) : (row >> 12), t = smp ? ((row - MP) & 7) : (row & (SEQ - 1));
    const int i = smp ? t : (t & 127), n = smp ? 0 : (t >> 7);
    const int row0 = smp ? (MP + b * ST) : (b * SEQ + n * 128);
    const float* S = smp ? sret + (((size_t)l * SB + b) * RH + h) * RDK * RDV : SPREV + (((size_t)b * 32 + n) * RH + h) * RDK * RDV;
    float q[64];
    { const bf16* p = Z + (size_t)row * ZW + ZRQ + h * 64;
#pragma unroll
      for (int d = 0; d < 64; d += 8) ld8(p + d, q + d); }
    float* oraw = ORAW + (size_t)row * BRW + h * 128;
    float sum = 0.f;
    for (int half = 0; half < 2; ++half) {
        float o[64];
#pragma unroll
        for (int v = 0; v < 64; ++v) o[v] = 0.f;
        for (int j = 0; j <= i; ++j) { const bf16* p = Z + (size_t)(row0 + j) * ZW;
            const bf16* kp = p + ZRK + h * 64; float s = 0.f;
#pragma unroll
            for (int d = 0; d < 64; d += 8) { float f[8]; ld8(kp + d, f);
#pragma unroll
                for (int e = 0; e < 8; ++e) s += q[d + e] * f[e]; }
            s *= 0.125f * FEXP(lg * (float)(i - j));
            const bf16* vp = p + ZRV + h * 128 + half * 64;
#pragma unroll
            for (int v = 0; v < 64; v += 8) { float f[8]; ld8(vp + v, f);
#pragma unroll
                for (int e = 0; e < 8; ++e) o[v + e] += s * f[e]; } }
        const float cf = FEXP(lg * (float)(i + 1));
        const bf16* qp = Z + (size_t)row * ZW + ZRQ + h * 64;
        for (int d = 0; d < 64; ++d) { const float qd = bf2f(qp[d]) * cf; const float* sp = S + (size_t)d * RDV + half * 64;
#pragma unroll
            for (int v = 0; v < 64; ++v) o[v] += qd * sp[v]; }
#pragma unroll
        for (int v = 0; v < 64; ++v) { oraw[half * 64 + v] = o[v]; sum += o[v]; }
    }
    const float mean = sum * (1.f / 128.f);
    float var = 0.f;
    for (int v = 0; v < 128; ++v) { const float d = oraw[v] - mean; var += d * d; }
    const float rstd = 1.f / sqrtf(var * (1.f / 128.f) + EPS);
    const float* g = gret + l * BRW + h * 128;
    const bf16* rg = Z + (size_t)row * ZW + ZRG + h * 128;
    bf16* y = Y3 + (size_t)row * BRW + h * 128;
    for (int v = 0; v < 128; ++v) y[v] = f2bf((oraw[v] - mean) * rstd * g[v] * bf2f(rg[v]));
}

#if !defined(HOST_TEST_ONLY)
namespace pg8 {
#define PG8_LAS __attribute__((address_space(3)))
typedef short bf16x8 __attribute__((ext_vector_type(8)));
typedef float f32x4 __attribute__((ext_vector_type(4)));
typedef float f32x2 __attribute__((ext_vector_type(2)));
typedef unsigned u32x4 __attribute__((ext_vector_type(4)));
typedef unsigned u32x2 __attribute__((ext_vector_type(2)));
constexpr int BM = 256, BK = 64, HALF = 128, HTB = HALF * BK * 2, STAGE_BYTES = 8 * HTB, NXCD = 8, WGM = 8;

__host__ __device__ __forceinline__ int lds_byte(int r, int c) { const int st = (r >> 4) * 2 + (c >> 5), rr = r & 15, cc = c & 31, ob = rr * 64 + cc * 2; return st * 1024 + (ob ^ (((ob >> 9) & 1) << 5)); }
__host__ __device__ __forceinline__ void stage_rc(int b, int& R, int& C) { const int st = b / 1024, sb = b % 1024, swz = sb ^ (((sb >> 9) & 1) << 5); R = (st >> 1) * 16 + swz / 64; C = (st & 1) * 32 + (swz % 64) / 2; }
__host__ __device__ __forceinline__ int perm32(int rho) { const int n = rho >> 4, i = rho & 15; return 8 * (i >> 2) + 4 * n + (i & 3); }

struct Unit { int pm, pn, r, ks, nt; const char* a; const char* b; };
struct Dims { int lda, ldb, K; };

__host__ __device__ __forceinline__ void tile_of(int L, int nM, int nN, int& pm, int& pn) {
    const int nwg = nM * nN; int wgid = L; { const int q = nwg / NXCD, r = nwg % NXCD, xcd = wgid % NXCD, off = wgid / NXCD; wgid = (xcd < r ? xcd * (q + 1) : r * (q + 1) + (xcd - r) * q) + off; }
    const int nig = WGM * nN, gid = wgid / nig, fm = gid * WGM, gsz = (nM - fm) < WGM ? (nM - fm) : WGM;
    pm = fm + ((wgid % nig) % gsz); pn = (wgid % nig) / gsz;
}
struct StaticOrder {
    int nM, nN, nwg, G, c, nt; const char* A; const char* B; size_t ta, tb;
    __device__ __forceinline__ void init(const bf16* A_, const bf16* B_, int nM_, int nN_, int lda, int ldb, int K, int G_, int c_) { A = (const char*)A_; B = (const char*)B_; nM = nM_; nN = nN_; nwg = nM * nN; G = G_; c = c_; nt = K / BK; ta = (size_t)BM * lda * 2; tb = (size_t)BM * ldb * 2; }
    __device__ __forceinline__ bool next(int i, Unit& u) const {
        const long L = (long)i * G + c; if (L >= nwg) return false;
        tile_of((int)L, nM, nN, u.pm, u.pn); u.r = 0; u.ks = 0; u.nt = nt; u.a = A + (size_t)u.pm * ta; u.b = B + (size_t)u.pn * tb; return true;
    }
};


struct SplitOrder {
    int nN, G, c, RPT, ntP, KS, ntS; const char* A; const char* B; size_t ta, tb, sAr, sBr;
    __device__ __forceinline__ bool next(int i, Unit& u) const {
        const int nP = (MP / BM) * nN, Pc = c < nP ? (nP - c + G - 1) / G : 0;
        if (i < Pc * RPT) { const int tl = (i / RPT) * G + c; tile_of(tl, MP / BM, nN, u.pm, u.pn); u.r = i % RPT; u.ks = 0; u.nt = ntP;
            u.a = A + (size_t)u.r * sAr + (size_t)u.pm * ta; u.b = B + (size_t)u.r * sBr + (size_t)u.pn * tb; return true; }
        const int su = (i - Pc * RPT) * G + c; if (su >= nN * RPT * KS) return false;
        u.pm = MP / BM; u.pn = su / (RPT * KS); u.r = (su / KS) % RPT; u.ks = su % KS; u.nt = ntS;
        u.a = A + (size_t)u.r * sAr + (size_t)u.pm * ta + (size_t)u.ks * ntS * (BK * 2); u.b = B + (size_t)u.r * sBr + (size_t)u.pn * tb + (size_t)u.ks * ntS * (BK * 2); return true;
    }
};

__device__ __forceinline__ unsigned cvt_pk_bf16(float lo, float hi) { unsigned r; asm volatile("v_cvt_pk_bf16_f32 %0, %1, %2" : "=v"(r) : "v"(lo), "v"(hi)); return r; }

template <class Epi, class Sched, bool ALIGN_EPI = true, bool SP2 = true>
__device__ __forceinline__ void gemm_phase(PG8_LAS unsigned char* lds, const Dims g, const Sched& S, const Epi& E, const int tid) {
    const int wid = __builtin_amdgcn_readfirstlane(tid >> 6), lane = tid & 63, wr = wid >> 2, wc = wid & 3, fr = lane & 15, fq = lane >> 4;
    unsigned voffA[2], voffB[2];
#pragma unroll
    for (int i = 0; i < 2; ++i) { int R, C; stage_rc(tid * 16 + i * 8192, R, C); const int Rb = Epi::PERM ? ((R & ~31) + perm32(R & 31)) : R;
        voffA[i] = (unsigned)(R * g.lda + C) * 2u; voffB[i] = (unsigned)(Rb * g.ldb + C) * 2u; }
    const size_t kstep = (size_t)(BK * 2);
    const size_t hstepA = (size_t)HALF * g.lda * 2, hstepB = (size_t)HALF * g.ldb * 2;
    const unsigned ldsw = (unsigned)wid * 1024u;
    const int aoff = lds_byte(wr * 64 + fr, fq * 8), boff = lds_byte(wc * 32 + fr, fq * 8);
#define PG8_SA(b, h) (((b) * 2 + (h)) * HTB)
#define PG8_SB(b, h) ((4 + (b) * 2 + (h)) * HTB)
#define PG8_STAGE(bufoff, gbase, voff) do { _Pragma("unroll") for (int _i = 0; _i < 2; ++_i) \
        __builtin_amdgcn_global_load_lds((const unsigned*)((const char*)(gbase) + (voff)[_i]), (PG8_LAS unsigned*)(lds + (bufoff) + ldsw + _i * 8192), 16, 0, 0); } while (0)
#define PG8_LDA(dst, b, h) do { _Pragma("unroll") for (int m = 0; m < 4; ++m) _Pragma("unroll") for (int k = 0; k < 2; ++k) dst[m][k] = *(const PG8_LAS bf16x8*)(lds + PG8_SA(b, h) + aoff + m * 2048 + k * 1024); } while (0)
#define PG8_LDB(dst, b, h) do { _Pragma("unroll") for (int n = 0; n < 2; ++n) _Pragma("unroll") for (int k = 0; k < 2; ++k) dst[n][k] = *(const PG8_LAS bf16x8*)(lds + PG8_SB(b, h) + boff + n * 2048 + k * 1024); } while (0)
#define PG8_MMA(ai, bj, At, Bt) do { __builtin_amdgcn_s_setprio(1); _Pragma("unroll") for (int m = 0; m < 4; ++m) _Pragma("unroll") for (int n = 0; n < 2; ++n) _Pragma("unroll") for (int k = 0; k < 2; ++k) \
        acc[ai][bj][m][n] = __builtin_amdgcn_mfma_f32_16x16x32_bf16(Bt[n][k], At[m][k], acc[ai][bj][m][n], 0, 0, 0); __builtin_amdgcn_s_setprio(0); } while (0)
#define PG8_WAIT_V(n) asm volatile("s_waitcnt vmcnt(" #n ")" ::: "memory")
#define PG8_WAIT_L(n) asm volatile("s_waitcnt lgkmcnt(" #n ")" ::: "memory")
#define PG8_BAR __builtin_amdgcn_s_barrier()
#define PG8_SCHED __builtin_amdgcn_sched_barrier(0)
    Unit cur, nxt; int ui = 0;
    if (!S.next(0, cur)) return;
    f32x4 acc[2][2][4][2];
#pragma unroll
    for (int a = 0; a < 2; ++a)
#pragma unroll
        for (int b = 0; b < 2; ++b)
#pragma unroll
            for (int m = 0; m < 4; ++m)
#pragma unroll
                for (int n = 0; n < 2; ++n) acc[a][b][m][n] = (f32x4){0.f, 0.f, 0.f, 0.f};
    bf16x8 At[4][2], B0[2][2], B1[2][2];
    const char* cA = cur.a; const char* cB = cur.b;
    if constexpr (SP2) {
        PG8_STAGE(PG8_SB(0, 0), cB, voffB); PG8_STAGE(PG8_SB(0, 1), cB + hstepB, voffB); PG8_STAGE(PG8_SA(0, 0), cA, voffA); PG8_STAGE(PG8_SA(0, 1), cA + hstepA, voffA);
        if (wr == 1) PG8_BAR;
        PG8_WAIT_V(2); PG8_BAR;
        PG8_STAGE(PG8_SB(1, 0), cB + kstep, voffB); PG8_STAGE(PG8_SA(1, 0), cA + kstep, voffA); PG8_STAGE(PG8_SB(1, 1), cB + hstepB + kstep, voffB);
        PG8_WAIT_V(6); PG8_BAR;
    } else {
        PG8_STAGE(PG8_SB(0, 0), cB, voffB); PG8_STAGE(PG8_SA(0, 0), cA, voffA); PG8_STAGE(PG8_SB(0, 1), cB + hstepB, voffB); PG8_STAGE(PG8_SA(0, 1), cA + hstepA, voffA);
        if (wr == 1) PG8_BAR;
        PG8_WAIT_V(4); PG8_BAR;
        PG8_STAGE(PG8_SB(1, 0), cB + kstep, voffB); PG8_STAGE(PG8_SA(1, 0), cA + kstep, voffA); PG8_STAGE(PG8_SB(1, 1), cB + hstepB + kstep, voffB);
        PG8_WAIT_V(6); PG8_BAR;
    }
    for (;;) {
        const bool has_next = S.next(ui + 1, nxt);
        const char* nA = has_next ? nxt.a : cA; const char* nB = has_next ? nxt.b : cB;
        const int nt = cur.nt;
        for (int t = 0; t < nt; t += 2) {
            const bool last = (t == nt - 2);
            const char* a1 = cA + (size_t)(t + 1) * kstep;
            const char* a2 = last ? nA : cA + (size_t)(t + 2) * kstep; const char* b2 = last ? nB : cB + (size_t)(t + 2) * kstep;
            const char* a3 = a2 + kstep; const char* b3 = b2 + kstep;
            if constexpr (SP2) {
            PG8_LDB(B0, 0, 0); PG8_LDB(B1, 0, 1); PG8_SCHED; PG8_LDA(At, 0, 0); PG8_STAGE(PG8_SA(1, 1), a1 + hstepA, voffA);
            PG8_WAIT_V(8); PG8_WAIT_L(0); PG8_BAR; PG8_MMA(0, 0, At, B0); PG8_MMA(0, 1, At, B1); PG8_BAR; PG8_SCHED;
            PG8_LDA(At, 0, 1); PG8_STAGE(PG8_SB(0, 0), b2, voffB); PG8_STAGE(PG8_SB(0, 1), b2 + hstepB, voffB); PG8_STAGE(PG8_SA(0, 0), a2, voffA);
            PG8_WAIT_V(8); PG8_WAIT_L(0); PG8_BAR; PG8_MMA(1, 0, At, B0); PG8_MMA(1, 1, At, B1); PG8_BAR; PG8_SCHED;
            PG8_LDB(B0, 1, 0); PG8_LDB(B1, 1, 1); PG8_SCHED; PG8_LDA(At, 1, 0); PG8_STAGE(PG8_SA(0, 1), a2 + hstepA, voffA);
            PG8_WAIT_V(8); PG8_WAIT_L(0); PG8_BAR; PG8_MMA(0, 0, At, B0); PG8_MMA(0, 1, At, B1); PG8_BAR; PG8_SCHED;
            PG8_LDA(At, 1, 1); PG8_STAGE(PG8_SB(1, 0), b3, voffB); PG8_STAGE(PG8_SB(1, 1), b3 + hstepB, voffB); PG8_STAGE(PG8_SA(1, 0), a3, voffA);
            PG8_WAIT_V(8); PG8_WAIT_L(0); PG8_BAR; PG8_MMA(1, 0, At, B0); PG8_MMA(1, 1, At, B1); PG8_BAR; PG8_SCHED;
            } else {
            PG8_LDB(B0, 0, 0); PG8_SCHED; PG8_LDA(At, 0, 0); PG8_STAGE(PG8_SA(1, 1), a1 + hstepA, voffA);
            PG8_WAIT_L(8); PG8_BAR; PG8_WAIT_L(0); PG8_MMA(0, 0, At, B0); PG8_BAR; PG8_SCHED;
            PG8_LDB(B1, 0, 1); PG8_STAGE(PG8_SB(0, 0), b2, voffB);
            PG8_BAR; PG8_WAIT_L(0); PG8_MMA(0, 1, At, B1); PG8_BAR;
            PG8_LDA(At, 0, 1); PG8_STAGE(PG8_SA(0, 0), a2, voffA);
            PG8_BAR; PG8_WAIT_L(0); PG8_MMA(1, 0, At, B0); PG8_BAR; PG8_SCHED;
            PG8_STAGE(PG8_SB(0, 1), b2 + hstepB, voffB);
            PG8_WAIT_V(6); PG8_BAR; PG8_MMA(1, 1, At, B1); PG8_BAR;
            PG8_LDB(B0, 1, 0); PG8_SCHED; PG8_LDA(At, 1, 0); PG8_STAGE(PG8_SA(0, 1), a2 + hstepA, voffA);
            PG8_WAIT_L(8); PG8_BAR; PG8_WAIT_L(0); PG8_MMA(0, 0, At, B0); PG8_BAR; PG8_SCHED;
            PG8_LDB(B1, 1, 1); PG8_STAGE(PG8_SB(1, 0), b3, voffB);
            PG8_BAR; PG8_WAIT_L(0); PG8_MMA(0, 1, At, B1); PG8_BAR;
            PG8_LDA(At, 1, 1); PG8_STAGE(PG8_SA(1, 0), a3, voffA);
            PG8_BAR; PG8_WAIT_L(0); PG8_MMA(1, 0, At, B0); PG8_BAR; PG8_SCHED;
            PG8_STAGE(PG8_SB(1, 1), b3 + hstepB, voffB);
            PG8_WAIT_V(6); PG8_BAR; PG8_MMA(1, 1, At, B1); PG8_BAR;
            }
        }
        if constexpr (ALIGN_EPI) { if (wr == 0) PG8_BAR; }
        bool keep; { int ln; asm volatile("v_mbcnt_lo_u32_b32 %0, -1, 0\n\tv_mbcnt_hi_u32_b32 %0, -1, %0" : "=v"(ln)); keep = E(acc, cur, wr, wc, ln & 15, ln >> 4); }
        if (!has_next) break;
        if (!keep)
#pragma unroll
        for (int a = 0; a < 2; ++a)
#pragma unroll
            for (int b = 0; b < 2; ++b)
#pragma unroll
                for (int m = 0; m < 4; ++m)
#pragma unroll
                    for (int n = 0; n < 2; ++n) acc[a][b][m][n] = (f32x4){0.f, 0.f, 0.f, 0.f};
        cur = nxt; cA = nA; cB = nB; ++ui;
        if constexpr (ALIGN_EPI) { if (wr == 1) PG8_BAR; }
    }
    PG8_WAIT_V(0);
    if constexpr (!ALIGN_EPI) { if (wr == 0) PG8_BAR; }
    PG8_BAR;
#undef PG8_SA
#undef PG8_SB
#undef PG8_STAGE
#undef PG8_LDA
#undef PG8_LDB
#undef PG8_MMA
#undef PG8_WAIT_V
#undef PG8_WAIT_L
#undef PG8_BAR
#undef PG8_SCHED
}

__device__ __forceinline__ float fsigmoid(float x) { return __builtin_amdgcn_rcpf(1.f + __expf(-x)); }
struct EpiZ {
    static constexpr bool PERM = true;
    bf16* Z;
    __device__ __forceinline__ bool operator()(f32x4 (&acc)[2][2][4][2], const Unit& u, int wr, int wc, int fr, int fq) const {
        const int row0 = u.pm * BM + wr * 64 + fr, col0 = u.pn * BM + wc * 32 + 8 * fq;
        const int ty = u.pn >= 30 ? 2 : (u.pn >= 26 ? 1 : 0);
        if (u.pn >= 6 && u.pn < 14) {
            const int colg = ZCA + (u.pn - 6) * 128 + wc * 32 + 8 * fq;
#pragma unroll
            for (int ai = 0; ai < 2; ++ai)
#pragma unroll
                for (int m = 0; m < 4; ++m) { f32x4 a0 = acc[ai][0][m][0], a1 = acc[ai][0][m][1]; const f32x4 g0 = acc[ai][1][m][0], g1 = acc[ai][1][m][1];
#pragma unroll
                    for (int j = 0; j < 4; ++j) { a0[j] = a0[j] * fsigmoid(g0[j]); a1[j] = a1[j] * fsigmoid(g1[j]); }
                    u32x4 w; w.x = cvt_pk_bf16(a0[0], a0[1]); w.y = cvt_pk_bf16(a0[2], a0[3]); w.z = cvt_pk_bf16(a1[0], a1[1]); w.w = cvt_pk_bf16(a1[2], a1[3]);
                    *(u32x4*)(Z + (size_t)(row0 + ai * HALF + m * 16) * ZW + colg) = w; }
            return false;
        }
#pragma unroll
        for (int ai = 0; ai < 2; ++ai)
#pragma unroll
            for (int m = 0; m < 4; ++m) { bf16* rowp = Z + (size_t)(row0 + ai * HALF + m * 16) * ZW + col0;
#pragma unroll
                for (int bj = 0; bj < 2; ++bj) { f32x4 v0 = acc[ai][bj][m][0], v1 = acc[ai][bj][m][1];
                    if (ty == 2) {
#pragma unroll
                        for (int j = 0; j < 4; ++j) { v0[j] = fsigmoid(v0[j]); v1[j] = fsigmoid(v1[j]); } }
                    else if (ty == 1) {
#pragma unroll
                        for (int j = 0; j < 4; ++j) { v0[j] = v0[j] * fsigmoid(v0[j]); v1[j] = v1[j] * fsigmoid(v1[j]); } }
                    u32x4 w; w.x = cvt_pk_bf16(v0[0], v0[1]); w.y = cvt_pk_bf16(v0[2], v0[3]); w.z = cvt_pk_bf16(v1[0], v1[1]); w.w = cvt_pk_bf16(v1[2], v1[3]);
                    *(u32x4*)(rowp + bj * HALF) = w; } }
        return false;
    }
};
struct EpiMlp1 {
    static constexpr bool PERM = true;
    bf16* O; float* SLAB;
    __device__ __forceinline__ bool operator()(f32x4 (&acc)[2][2][4][2], const Unit& u, int wr, int wc, int fr, int fq) const {
        const int row0 = u.pm * BM + wr * 64 + fr, col0 = u.pn * BM + wc * 32 + 8 * fq;
        if (u.pm == MP / BM) { float* sl = SLAB + ((size_t)u.ks * BM + wr * 64 + fr) * DFF + col0;
#pragma unroll
            for (int ai = 0; ai < 2; ++ai)
#pragma unroll
                for (int m = 0; m < 4; ++m)
#pragma unroll
                    for (int bj = 0; bj < 2; ++bj) { float* p = sl + (size_t)(ai * HALF + m * 16) * DFF + bj * HALF; *(f32x4*)p = acc[ai][bj][m][0]; *(f32x4*)(p + 4) = acc[ai][bj][m][1]; }
            return false; }
#pragma unroll
        for (int ai = 0; ai < 2; ++ai)
#pragma unroll
            for (int m = 0; m < 4; ++m) { bf16* rowp = O + (size_t)(row0 + ai * HALF + m * 16) * DFF + col0;
#pragma unroll
                for (int bj = 0; bj < 2; ++bj) { f32x4 v0 = acc[ai][bj][m][0], v1 = acc[ai][bj][m][1];
#pragma unroll
                    for (int j = 0; j < 4; ++j) { const float a = fmaxf(v0[j], 0.f), b = fmaxf(v1[j], 0.f); v0[j] = a * a; v1[j] = b * b; }
                    u32x4 w; w.x = cvt_pk_bf16(v0[0], v0[1]); w.y = cvt_pk_bf16(v0[2], v0[3]); w.z = cvt_pk_bf16(v1[0], v1[1]); w.w = cvt_pk_bf16(v1[2], v1[3]);
                    *(u32x4*)(rowp + bj * HALF) = w; } }
        return false;
    }
};
struct EpiPool {
    static constexpr bool PERM = true;
    bf16* Y2; const float* spb; int l;
    __device__ __forceinline__ bool operator()(f32x4 (&acc)[2][2][4][2], const Unit& u, int wr, int wc, int fr, int fq) const {
        const int row0 = u.pm * BM + wr * 64 + fr, col0 = u.pn * BM + wc * 32 + 8 * fq;
        int le = l; asm volatile("" : "+s"(le)); const float* sp = spb + le * BRW;
        f32x4 s[2][2];
#pragma unroll
        for (int bj = 0; bj < 2; ++bj)
#pragma unroll
            for (int n = 0; n < 2; ++n) s[bj][n] = *(const f32x4*)(sp + col0 + bj * HALF + 4 * n);
#pragma unroll
        for (int ai = 0; ai < 2; ++ai)
#pragma unroll
            for (int m = 0; m < 4; ++m) { bf16* rowp = Y2 + (size_t)(row0 + ai * HALF + m * 16) * BRW + col0;
#pragma unroll
                for (int bj = 0; bj < 2; ++bj) { const f32x4 v0 = acc[ai][bj][m][0] * s[bj][0], v1 = acc[ai][bj][m][1] * s[bj][1];
                    u32x4 w; w.x = cvt_pk_bf16(v0[0], v0[1]); w.y = cvt_pk_bf16(v0[2], v0[3]); w.z = cvt_pk_bf16(v1[0], v1[1]); w.w = cvt_pk_bf16(v1[2], v1[3]);
                    *(u32x4*)(rowp + bj * HALF) = w; } }
        return false;
    }
};
struct EpiAda {
    static constexpr bool PERM = false;
    float* ADA; const float* bada;
    __device__ __forceinline__ bool operator()(f32x4 (&acc)[2][2][4][2], const Unit& u, int wr, int wc, int fr, int fq) const {
        if (wr != 0) return false;
        const int col0 = u.pn * BM + wc * 32 + 4 * fq;
#pragma unroll
        for (int m = 0; m < 3; ++m) { const int row = m * 16 + fr;
            if (row < NROWB) {
#pragma unroll
                for (int bj = 0; bj < 2; ++bj)
#pragma unroll
                    for (int n = 0; n < 2; ++n) { const int c = col0 + bj * HALF + n * 16; const f32x4 bv = *(const f32x4*)(bada + (size_t)u.r * ADAW + c);
                        *(f32x4*)(ADA + ((size_t)u.r * NROWB + row) * ADAW + c) = acc[0][bj][m][n] + bv; } } }
        return false;
    }
};
struct EpiBr {
    static constexpr bool PERM = true;
    const bf16* Z; bf16* MERGED; float* SLAB; int KS;
    static __device__ __forceinline__ void unp8(const u32x4 gw, f32x4& g0, f32x4& g1) { const float T = 8.6736174e-19f;
        g0[0] = fmaxf(__builtin_bit_cast(float, gw.x << 16), T); g0[1] = fmaxf(__builtin_bit_cast(float, gw.x & 0xffff0000u), T); g0[2] = fmaxf(__builtin_bit_cast(float, gw.y << 16), T); g0[3] = fmaxf(__builtin_bit_cast(float, gw.y & 0xffff0000u), T);
        g1[0] = fmaxf(__builtin_bit_cast(float, gw.z << 16), T); g1[1] = fmaxf(__builtin_bit_cast(float, gw.z & 0xffff0000u), T); g1[2] = fmaxf(__builtin_bit_cast(float, gw.w << 16), T); g1[3] = fmaxf(__builtin_bit_cast(float, gw.w & 0xffff0000u), T); }
    __device__ __forceinline__ bool operator()(f32x4 (&acc)[2][2][4][2], const Unit& u, int wr, int wc, int fr, int fq) const {
        const int row0 = u.pm * BM + wr * 64 + fr, col0 = u.pn * BM + wc * 32 + 8 * fq;
        const int r = u.r; const bool smp = u.pm == MP / BM;
        const bf16* gbase = Z + (size_t)row0 * ZW + ZGT + r * DM + col0;
#pragma unroll
        for (int ai = 0; ai < 2; ++ai) {
            u32x4 ga[4][2], gb[4][2];
#pragma unroll
            for (int m = 0; m < 4; ++m)
#pragma unroll
                for (int bj = 0; bj < 2; ++bj) { const bf16* gp = gbase + (size_t)(ai * HALF + m * 16) * ZW + bj * HALF; ga[m][bj] = *(const u32x4*)gp; gb[m][bj] = *(const u32x4*)(gp + DM); }
            asm volatile("" ::: "memory");
#pragma unroll
            for (int m = 0; m < 4; ++m)
#pragma unroll
                for (int bj = 0; bj < 2; ++bj) { const size_t row = (size_t)(row0 + ai * HALF + m * 16); const int c = col0 + bj * HALF;
                    f32x4 g0, g1; unp8(ga[m][bj], g0, g1);
                    if (smp) { float* sp = SLAB + ((size_t)(r * KS + u.ks) * BM + (row - MP)) * DM + c; *(f32x4*)sp = acc[ai][bj][m][0] * g0; *(f32x4*)(sp + 4) = acc[ai][bj][m][1] * g1; }
                    else if (r < 3) { f32x4 n0, n1; unp8(gb[m][bj], n0, n1);
#pragma unroll
                        for (int j = 0; j < 4; ++j) { acc[ai][bj][m][0][j] *= g0[j] * __builtin_amdgcn_rcpf(n0[j]); acc[ai][bj][m][1][j] *= g1[j] * __builtin_amdgcn_rcpf(n1[j]); } }
                    else { const f32x4 v0 = acc[ai][bj][m][0] * g0, v1 = acc[ai][bj][m][1] * g1;
                        u32x4 w; w.x = cvt_pk_bf16(v0[0], v0[1]); w.y = cvt_pk_bf16(v0[2], v0[3]); w.z = cvt_pk_bf16(v1[0], v1[1]); w.w = cvt_pk_bf16(v1[2], v1[3]);
                        *(u32x4*)(MERGED + row * DM + c) = w; } }
        }
        return !smp && r < 3;
    }
};
struct EpiRes {
    static constexpr bool PERM = true;
    const void* baseP; void* out; bool baseBf, outBf; const float* gate; float* SLAB;
    __device__ __forceinline__ bool operator()(f32x4 (&acc)[2][2][4][2], const Unit& u, int wr, int wc, int fr, int fq) const {
        const int rl0 = wr * 64 + fr, col0 = u.pn * BM + wc * 32 + 8 * fq;
        const bool smp = u.pm >= MP / BM;
        if (smp) { float* sl = SLAB + ((size_t)u.ks * BM + rl0) * DM + col0;
#pragma unroll
            for (int ai = 0; ai < 2; ++ai)
#pragma unroll
                for (int m = 0; m < 4; ++m)
#pragma unroll
                    for (int bj = 0; bj < 2; ++bj)
#pragma unroll
                        for (int n = 0; n < 2; ++n) *(f32x4*)(sl + (size_t)(ai * HALF + m * 16) * DM + bj * HALF + n * 4) = acc[ai][bj][m][n];
            return false; }
        const size_t e0 = (size_t)u.pm * BM * DM + (size_t)rl0 * DM + col0;
        const float* gp = gate + (size_t)(u.pm >> 4) * ADAW + col0;
        f32x4 gv[2][2];
#pragma unroll
        for (int bj = 0; bj < 2; ++bj)
#pragma unroll
            for (int n = 0; n < 2; ++n) gv[bj][n] = *(const f32x4*)(gp + bj * HALF + n * 4);
#pragma unroll
        for (int ai = 0; ai < 2; ++ai) {
            f32x4 bs[4][2][2];
            if (baseBf) {
#pragma unroll
                for (int m = 0; m < 4; ++m)
#pragma unroll
                    for (int bj = 0; bj < 2; ++bj) { const u32x4 w = *(const u32x4*)((const bf16*)baseP + e0 + (size_t)(ai * HALF + m * 16) * DM + bj * HALF); const unsigned w0 = w.x, w1 = w.y, w2 = w.z, w3 = w.w;
                        bs[m][bj][0] = f32x4{__builtin_bit_cast(float, w0 << 16), __builtin_bit_cast(float, w0 & 0xffff0000u), __builtin_bit_cast(float, w1 << 16), __builtin_bit_cast(float, w1 & 0xffff0000u)};
                        bs[m][bj][1] = f32x4{__builtin_bit_cast(float, w2 << 16), __builtin_bit_cast(float, w2 & 0xffff0000u), __builtin_bit_cast(float, w3 << 16), __builtin_bit_cast(float, w3 & 0xffff0000u)}; }
            } else {
#pragma unroll
                for (int m = 0; m < 4; ++m)
#pragma unroll
                    for (int bj = 0; bj < 2; ++bj)
#pragma unroll
                        for (int n = 0; n < 2; ++n) bs[m][bj][n] = *(const f32x4*)((const float*)baseP + e0 + (size_t)(ai * HALF + m * 16) * DM + bj * HALF + n * 4);
            }
            asm volatile("" ::: "memory");
#pragma unroll
            for (int m = 0; m < 4; ++m)
#pragma unroll
                for (int bj = 0; bj < 2; ++bj) { const f32x4 y0 = bs[m][bj][0] + gv[bj][0] * acc[ai][bj][m][0], y1 = bs[m][bj][1] + gv[bj][1] * acc[ai][bj][m][1];
                    if (outBf) { u32x4 w; w.x = cvt_pk_bf16(y0[0], y0[1]); w.y = cvt_pk_bf16(y0[2], y0[3]); w.z = cvt_pk_bf16(y1[0], y1[1]); w.w = cvt_pk_bf16(y1[2], y1[3]);
                        *(u32x4*)((bf16*)out + e0 + (size_t)(ai * HALF + m * 16) * DM + bj * HALF) = w; }
                    else { float* o = (float*)out + e0 + (size_t)(ai * HALF + m * 16) * DM + bj * HALF; *(f32x4*)o = y0; *(f32x4*)(o + 4) = y1; } }
        }
        return false;
    }
};
}

constexpr int NWAVES = 8, NTHR = NWAVES * 64;
constexpr size_t MiB = 1u << 20;
constexpr size_t al1(size_t x) { return (x + MiB - 1) / MiB * MiB; }
constexpr size_t WS_CTL = 0, CTL_ZERO_BYTES = 1 * MiB;
constexpr size_t WS_WIN = WS_CTL + CTL_ZERO_BYTES;
constexpr size_t WS_WBR = WS_WIN + al1((size_t)DEPTH * ZW * DM * 2);
constexpr size_t WS_WOUT = WS_WBR + al1((size_t)DEPTH * 4 * DM * BRW * 2);
constexpr size_t WS_WM1 = WS_WOUT + al1((size_t)DEPTH * DM * DM * 2);
constexpr size_t WS_WM2 = WS_WM1 + al1((size_t)DEPTH * DFF * DM * 2);
constexpr size_t WS_WPOOL = WS_WM2 + al1((size_t)DEPTH * DFF * DM * 2);
constexpr size_t WS_WADA = WS_WPOOL + al1((size_t)DEPTH * 4 * 256 * 256 * 2);
constexpr size_t WS_SC = WS_WADA + al1((size_t)DEPTH * ADAW * DM * 2);
constexpr size_t WS_ADA = WS_SC + al1((size_t)256 * DM * 2);
constexpr size_t WS_H = WS_ADA + al1((size_t)DEPTH * NROWB * ADAW * 4);
constexpr size_t WS_Z = WS_H + al1((size_t)M * DM * 2);
constexpr size_t WS_Y = WS_Z + al1((size_t)M * ZW * 2);
constexpr size_t WS_ZP = WS_Y + al1((size_t)4 * M * BRW * 2);
constexpr size_t WS_CONVY = WS_ZP + al1((size_t)M * BRW * 2);
constexpr size_t WS_ORAW = WS_CONVY + al1((size_t)M * BRW * 4);
constexpr size_t WS_KV = WS_ORAW + al1((size_t)M * BRW * 4);
constexpr size_t WS_SPREV = WS_KV + al1((size_t)NBP * 32 * RH * RDK * RDV * 4);
constexpr size_t WS_MACC = WS_SPREV + al1((size_t)NBP * 32 * RH * RDK * RDV * 4);
constexpr size_t WS_MERGED = WS_MACC + al1((size_t)M * DM * 4);
constexpr size_t WS_X1 = WS_MERGED + al1((size_t)M * DM * 2);
constexpr size_t WS_X = WS_X1 + al1((size_t)M * DM * 4);
constexpr size_t WS_HID = WS_X + al1((size_t)M * DM * 4);
constexpr size_t WS_SLAB = WS_HID + al1((size_t)M * DFF * 2);
constexpr size_t WS_END = WS_SLAB + al1((size_t)16 * MS * DM * 4);
constexpr int CW_BAR = 4096;
constexpr int RING_OFF = 0, RING_BYTES = 131072, LDSCTL_OFF = RING_BYTES, MISC_OFF = LDSCTL_OFF + 320, INTAB_OFF = MISC_OFF + 128, LDS_BYTES = 147456;

#define GAS __attribute__((address_space(1)))
#define LAS __attribute__((address_space(3)))
typedef unsigned v4u __attribute__((ext_vector_type(4)));
typedef float f32x4 __attribute__((ext_vector_type(4)));
typedef GAS unsigned gu32;
#define RLX_AGENT __ATOMIC_RELAXED, __HIP_MEMORY_SCOPE_AGENT
#define LDS_WAIT() asm volatile("s_waitcnt lgkmcnt(0)" ::: "memory")
__device__ __forceinline__ unsigned pk2(float lo, float hi) { return (unsigned)f2bf(lo) | ((unsigned)f2bf(hi) << 16); }

#define XB_TMO      128
#define XB_XCNT(j)  (256  + 64 * (j))
#define XB_XSUB(j)  (1280 + 64 * (j))
#define XB_XGEN(j)  (2304 + 64 * (j))
#define XB_TOP      3328
#define XB_TOPGEN   3392
#define XCD_BAR_WORDS 3456
#define XB_SPIN_CAP (1u << 18)
__device__ __forceinline__ unsigned xb_ld(unsigned* p)              { return __hip_atomic_load(p, __ATOMIC_RELAXED, __HIP_MEMORY_SCOPE_AGENT); }
__device__ __forceinline__ unsigned xb_add(unsigned* p, unsigned v) { return __hip_atomic_fetch_add(p, v, __ATOMIC_RELAXED, __HIP_MEMORY_SCOPE_AGENT); }
__device__ __forceinline__ unsigned xb_xcc_id() { return (unsigned)__builtin_amdgcn_s_getreg((3 << 11) | 20) & 0xFu; }
#define XB_SPIN(cond, bar) do { unsigned _sp = 0; while (cond) { __builtin_amdgcn_s_sleep(1); \
    if ((++_sp & 255u) == 0u) { if (xb_ld(&(bar)[XB_TMO])) break; if (_sp > XB_SPIN_CAP) { atomicAdd(&(bar)[XB_TMO], 1u); break; } } } } while (0)
struct XcdBarrier { unsigned* bar; unsigned x; volatile LAS unsigned* st; };
__device__ __forceinline__ XcdBarrier xcd_barrier_post(unsigned* bar, volatile LAS unsigned* st) {
    XcdBarrier b; b.bar = bar; b.x = xb_xcc_id(); b.st = st;
    if (threadIdx.x == 0) (void)xb_add(&bar[XB_XCNT(b.x)], 1u);
    return b;
}
__device__ __forceinline__ void xcd_barrier_complete(unsigned* bar, unsigned x, unsigned& nloc, unsigned& nx) {
    const unsigned G = gridDim.x * gridDim.y * gridDim.z;
    unsigned sum, cnt, mine, sp = 0u;
    for (;;) {
        sum = 0u; cnt = 0u; mine = 0u;
#pragma unroll
        for (unsigned j = 0; j < 16; ++j) { const unsigned c = xb_ld(&bar[XB_XCNT(j)]); sum += c; cnt += (c > 0u) ? 1u : 0u; mine = (j == x) ? c : mine; }
        if (sum == G) break;
        __builtin_amdgcn_s_sleep(1);
        if ((++sp & 255u) == 0u) { if (xb_ld(&bar[XB_TMO])) break; if (sp > XB_SPIN_CAP) { atomicAdd(&bar[XB_TMO], 1u); break; } }
    }
    nloc = mine > 0u ? mine : 1u; nx = cnt > 0u ? cnt : 1u;
}
__device__ __forceinline__ void xcd_barrier(const XcdBarrier& b) {
    asm volatile("s_waitcnt vmcnt(0)" ::: "memory");
    __syncthreads();
    if (threadIdx.x == 0) {
        unsigned* bar = b.bar;
        __builtin_amdgcn_s_waitcnt(0);
        unsigned nloc = b.st[0], nx = b.st[1];
        if (nloc == 0u) { xcd_barrier_complete(bar, b.x, nloc, nx); b.st[0] = nloc; b.st[1] = nx; }
        const unsigned old = xb_add(&bar[XB_XSUB(b.x)], 1u);
        const unsigned gen = old / nloc;
        if (old + 1u == (gen + 1u) * nloc) {
            __builtin_amdgcn_fence(__ATOMIC_RELEASE, "agent");
            asm volatile("s_waitcnt vmcnt(0)" ::: "memory");
            const unsigned og = xb_add(&bar[XB_TOP], 1u);
            const unsigned tg = og / nx;
            if (og + 1u == (tg + 1u) * nx) xb_add(&bar[XB_TOPGEN], 1u);
            else XB_SPIN(xb_ld(&bar[XB_TOPGEN]) == tg, bar);
            __builtin_amdgcn_fence(__ATOMIC_ACQUIRE, "agent");
            xb_add(&bar[XB_XGEN(b.x)], 1u);
            asm volatile("s_waitcnt vmcnt(0)" ::: "memory");
        } else {
            XB_SPIN(xb_ld(&bar[XB_XGEN(b.x)]) == gen, bar);
            __builtin_amdgcn_fence(__ATOMIC_ACQUIRE, "agent");
            asm volatile("s_waitcnt vmcnt(0)" ::: "memory");
        }
    }
    __syncthreads();
}

template <int CTRL> __device__ __forceinline__ float dpp_f(float v) { return __builtin_bit_cast(float, __builtin_amdgcn_update_dpp(0, __builtin_bit_cast(int, v), CTRL, 0xf, 0xf, false)); }
__device__ __forceinline__ float wave_sum(float v) {
    v += dpp_f<0xB1>(v);
    v += dpp_f<0x4E>(v);
    v += dpp_f<0x141>(v);
    v += dpp_f<0x140>(v);
    v += __builtin_bit_cast(float, __builtin_amdgcn_ds_swizzle(__builtin_bit_cast(int, v), 0x401F));
    return __builtin_bit_cast(float, __builtin_amdgcn_readlane(__builtin_bit_cast(int, v), 0)) + __builtin_bit_cast(float, __builtin_amdgcn_readlane(__builtin_bit_cast(int, v), 32));
}
typedef float tr_f32x4 __attribute__((ext_vector_type(4)));
#define TR_LOAD(V, P) _Pragma("unroll") for (int j = 0; j < 8; ++j) V[j] = __builtin_nontemporal_load((const GAS tr_f32x4*)((P) + (size_t)j * N))
#define TR_STORE(V, Q) _Pragma("unroll") for (int i = 0; i < 4; ++i) { v4u o; o.x = pk2(V[0][i], V[1][i]); o.y = pk2(V[2][i], V[3][i]); o.z = pk2(V[4][i], V[5][i]); o.w = pk2(V[6][i], V[7][i]); __builtin_nontemporal_store(o, (GAS v4u*)((Q) + (size_t)i * K)); }
template <int K, int N, bool GLUPERM = false>
__device__ __forceinline__ void transpose_run(const float* W, bf16* T, int nmat, int gw, int NGW, int lane) {
    constexpr int NB = N / 32, IPM = (K / 64) * NB; const int total = nmat * IPM;
    const unsigned lo_p = (unsigned)(8 * (lane >> 3)) * N + 4 * (lane & 7), lo_q = (unsigned)(4 * (lane & 7)) * K + 8 * (lane >> 3);
    auto addr = [&](int it, const float*& p, bf16*& q) { it = it < total ? it : total - 1; const int mi = it / IPM, r = it % IPM, kb = r / NB, nb = r % NB;
        p = W + ((size_t)mi * K * N + (size_t)(64 * kb) * N + 32 * nb) + lo_p;
        int n0 = 32 * nb;
        if (GLUPERM) { if (n0 >= ZCA && n0 < ZCA + BRW) { const int c = n0 - ZCA; n0 = ZCA + 256 * (c >> 7) + (c & 127); } else if (n0 >= ZCG && n0 < ZCG + BRW) { const int c = n0 - ZCG; n0 = ZCA + 256 * (c >> 7) + 128 + (c & 127); } }
        q = T + ((size_t)mi * K * N + (size_t)n0 * K + 64 * kb) + lo_q; };
    int it = gw; if (it >= total) return;
    tr_f32x4 va[8], vb[8]; const float *pa, *pb; bf16 *qa, *qb;
    addr(it, pa, qa); TR_LOAD(va, pa);
    for (;;) {
        const int i1 = it + NGW; addr(i1, pb, qb); TR_LOAD(vb, pb);
        asm volatile("" ::: "memory"); TR_STORE(va, qa); asm volatile("" ::: "memory");
        if (i1 >= total) break;
        const int i2 = i1 + NGW; addr(i2, pa, qa); TR_LOAD(va, pa);
        asm volatile("" ::: "memory"); TR_STORE(vb, qb); asm volatile("" ::: "memory");
        if (i2 >= total) break;
        it = i2; }
}
__device__ __forceinline__ void load_mod(const float* g, const float* sc, const float* shp, f32x4 (&gm)[8], f32x4 (&sh)[8], int lane) {
#pragma unroll
    for (int jj = 0; jj < 4; ++jj)
#pragma unroll
        for (int e = 0; e < 2; ++e) { const int q = 2 * (lane + 64 * jj) + e; gm[2 * jj + e] = ((const f32x4*)g)[q] * (((const f32x4*)sc)[q] + 1.f); sh[2 * jj + e] = ((const f32x4*)shp)[q]; }
}
template <bool BF> __device__ __forceinline__ void load_row8(const void* x, f32x4 (&v)[8], int lane) {
#pragma unroll
    for (int jj = 0; jj < 4; ++jj) {
        if (BF) { const v4u w = ((const v4u*)x)[lane + 64 * jj]; const unsigned w0 = w.x, w1 = w.y, w2 = w.z, w3 = w.w;
            v[2 * jj] = f32x4{__builtin_bit_cast(float, w0 << 16), __builtin_bit_cast(float, w0 & 0xffff0000u), __builtin_bit_cast(float, w1 << 16), __builtin_bit_cast(float, w1 & 0xffff0000u)};
            v[2 * jj + 1] = f32x4{__builtin_bit_cast(float, w2 << 16), __builtin_bit_cast(float, w2 & 0xffff0000u), __builtin_bit_cast(float, w3 << 16), __builtin_bit_cast(float, w3 & 0xffff0000u)}; }
        else { v[2 * jj] = ((const f32x4*)x)[2 * (lane + 64 * jj)]; v[2 * jj + 1] = ((const f32x4*)x)[2 * (lane + 64 * jj) + 1]; } }
}
__device__ __forceinline__ float sumsq8(const f32x4 (&v)[8]) { float s = 0.f;
#pragma unroll
    for (int j = 0; j < 8; ++j) s += (v[j].x * v[j].x + v[j].y * v[j].y) + (v[j].z * v[j].z + v[j].w * v[j].w);
    return s; }
__device__ __forceinline__ void norm_store(const f32x4 (&v)[8], float ss, const f32x4 (&gm)[8], const f32x4 (&sh)[8], bf16* orow, int lane) {
    const float rstd = 1.f / sqrtf(wave_sum(ss) * (1.f / DM) + EPS);
#pragma unroll
    for (int jj = 0; jj < 4; ++jj) { const f32x4 y0 = v[2 * jj] * rstd * gm[2 * jj] + sh[2 * jj], y1 = v[2 * jj + 1] * rstd * gm[2 * jj + 1] + sh[2 * jj + 1];
        v4u o; o.x = pk2(y0.x, y0.y); o.y = pk2(y0.z, y0.w); o.z = pk2(y1.x, y1.y); o.w = pk2(y1.z, y1.w);
        ((v4u*)orow)[lane + 64 * jj] = o; }
}
template <bool BF> __device__ __forceinline__ void norm_row2(const void* xa, const void* xb, const f32x4 (&gm)[8], const f32x4 (&sh)[8], bf16* oa, bf16* ob, int lane) {
    f32x4 va[8], vb[8]; load_row8<BF>(xa, va, lane); load_row8<BF>(xb, vb, lane);
    const float sa = sumsq8(va), sb = sumsq8(vb);
    norm_store(va, sa, gm, sh, oa, lane); norm_store(vb, sb, gm, sh, ob, lane);
}
template <bool BF> __device__ __forceinline__ void norm_row(const void* xrow, const f32x4 (&gm)[8], const f32x4 (&sh)[8], bf16* orow, int lane) {
    f32x4 v[8]; load_row8<BF>(xrow, v, lane);
    norm_store(v, sumsq8(v), gm, sh, orow, lane);
}
template <int NP> __device__ __forceinline__ void norm_row_block(const float* base, const float* gate, const float* slab, size_t ps, float* xdst, const float* g, const float* sc, const float* shp, bf16* orow, LAS float* red, int tid, int wave) {
    f32x4 v = ((const f32x4*)base)[tid];
    if (NP > 0) { f32x4 pv[NP > 0 ? NP : 1];
#pragma unroll
        for (int p = 0; p < NP; ++p) pv[p] = ((const f32x4*)(slab + (size_t)p * ps))[tid];
        f32x4 a = pv[0];
#pragma unroll
        for (int p = 1; p < NP; ++p) a += pv[p];
        v += ((const f32x4*)gate)[tid] * a; ((f32x4*)xdst)[tid] = v; }
    const float ws = wave_sum((v.x * v.x + v.y * v.y) + (v.z * v.z + v.w * v.w));
    if ((tid & 63) == 0) red[wave] = ws;
    __syncthreads();
    float ss = 0.f;
#pragma unroll
    for (int w = 0; w < NWAVES; ++w) ss += red[w];
    const float rstd = 1.f / sqrtf(ss * (1.f / DM) + EPS);
    const f32x4 y = v * rstd * ((const f32x4*)g)[tid] * (((const f32x4*)sc)[tid] + 1.f) + ((const f32x4*)shp)[tid];
    ((unsigned long long*)orow)[tid] = (unsigned long long)pk2(y.x, y.y) | ((unsigned long long)pk2(y.z, y.w) << 32);
    __syncthreads();
}
template <int NR> __device__ __forceinline__ void convln_rows(const bf16* const (&yrow)[NR], const f32x4 (&gv4)[4], const f32x4 (&bv4)[4], bf16* const (&orow)[NR], int lane) {
    f32x4 v[NR][4]; float s[NR];
#pragma unroll
    for (int r = 0; r < NR; ++r)
#pragma unroll
        for (int jj = 0; jj < 2; ++jj) { const v4u w = ((const v4u*)yrow[r])[lane + 64 * jj]; const unsigned w0 = w.x, w1 = w.y, w2 = w.z, w3 = w.w;
            v[r][2 * jj] = f32x4{__builtin_bit_cast(float, w0 << 16), __builtin_bit_cast(float, w0 & 0xffff0000u), __builtin_bit_cast(float, w1 << 16), __builtin_bit_cast(float, w1 & 0xffff0000u)};
            v[r][2 * jj + 1] = f32x4{__builtin_bit_cast(float, w2 << 16), __builtin_bit_cast(float, w2 & 0xffff0000u), __builtin_bit_cast(float, w3 << 16), __builtin_bit_cast(float, w3 & 0xffff0000u)}; }
#pragma unroll
    for (int r = 0; r < NR; ++r) { s[r] = 0.f;
#pragma unroll
        for (int j = 0; j < 4; ++j) s[r] += (v[r][j].x + v[r][j].y) + (v[r][j].z + v[r][j].w); }
#pragma unroll
    for (int r = 0; r < NR; ++r) { const float mean = wave_sum(s[r]) * (1.f / BRW); float q = 0.f;
#pragma unroll
        for (int j = 0; j < 4; ++j) { v[r][j] = v[r][j] - mean; q += (v[r][j].x * v[r][j].x + v[r][j].y * v[r][j].y) + (v[r][j].z * v[r][j].z + v[r][j].w * v[r][j].w); }
        s[r] = q; }
#pragma unroll
    for (int r = 0; r < NR; ++r) { const float rstd = 1.f / sqrtf(wave_sum(s[r]) * (1.f / BRW) + EPS);
#pragma unroll
        for (int jj = 0; jj < 2; ++jj) { f32x4 y0 = v[r][2 * jj] * rstd * gv4[2 * jj] + bv4[2 * jj], y1 = v[r][2 * jj + 1] * rstd * gv4[2 * jj + 1] + bv4[2 * jj + 1];
            y0.x = y0.x * sigmoidf_(y0.x); y0.y = y0.y * sigmoidf_(y0.y); y0.z = y0.z * sigmoidf_(y0.z); y0.w = y0.w * sigmoidf_(y0.w);
            y1.x = y1.x * sigmoidf_(y1.x); y1.y = y1.y * sigmoidf_(y1.y); y1.z = y1.z * sigmoidf_(y1.z); y1.w = y1.w * sigmoidf_(y1.w);
            v4u o; o.x = pk2(y0.x, y0.y); o.y = pk2(y0.z, y0.w); o.z = pk2(y1.x, y1.y); o.w = pk2(y1.z, y1.w);
            ((v4u*)orow[r])[lane + 64 * jj] = o; } }
}


namespace att {
typedef short bf16x8 __attribute__((ext_vector_type(8)));
typedef short s16x4 __attribute__((ext_vector_type(4)));
typedef float f32x4 __attribute__((ext_vector_type(4)));
typedef float f32x2_t __attribute__((ext_vector_type(2))); typedef __bf16 bf16x2_t __attribute__((ext_vector_type(2)));
constexpr int KP = 144, NROWS = 272, K_OFF = 0, V_OFF = NROWS * KP, LDS_NEED = 2 * NROWS * KP;
__device__ __forceinline__ unsigned cvtpk(float lo, float hi) { f32x2_t v = {lo, hi}; bf16x2_t b = __builtin_convertvector(v, bf16x2_t); return __builtin_bit_cast(unsigned, b); }
__device__ __forceinline__ float red4_max(float v) {
    v = fmaxf(v, __builtin_bit_cast(float, __builtin_amdgcn_ds_swizzle(__builtin_bit_cast(int, v), 0x401F)));
    unsigned x = __builtin_bit_cast(unsigned, v), y = x; asm volatile("" : "+v"(y));
    auto rr = __builtin_amdgcn_permlane32_swap(x, y, false, false); const unsigned r0 = rr[0], r1 = rr[1];
    return fmaxf(__builtin_bit_cast(float, r0), __builtin_bit_cast(float, r1)); }
__device__ __forceinline__ float red4_sum(float v) {
    v += __builtin_bit_cast(float, __builtin_amdgcn_ds_swizzle(__builtin_bit_cast(int, v), 0x401F));
    unsigned x = __builtin_bit_cast(unsigned, v), y = x; asm volatile("" : "+v"(y));
    auto rr = __builtin_amdgcn_permlane32_swap(x, y, false, false); const unsigned r0 = rr[0], r1 = rr[1];
    return __builtin_bit_cast(float, r0) + __builtin_bit_cast(float, r1); }
__device__ __forceinline__ s16x4 vtr(const LAS unsigned char* p) { typedef short v4i16_t __attribute__((ext_vector_type(4))); return __builtin_bit_cast(s16x4, __builtin_amdgcn_ds_read_tr16_b64_v4i16((LAS v4i16_t*)p)); }

__device__ __forceinline__ void tile16(const bf16x8 qf0, const bf16x8 qf1, const LAS unsigned char* Ks, const LAS unsigned char* Vs, int kbase, int wpos0, float slope2, float sink2, bf16* Yq, int nst, int lane) {
    const int c = lane & 15, g = lane >> 4;
    f32x4 st[9];
#pragma unroll
    for (int kt = 0; kt < 9; ++kt) { const LAS unsigned char* kp = Ks + (kbase + 16 * kt + c) * KP + 16 * g;
        const bf16x8 k0 = *(const LAS bf16x8*)kp, k1 = *(const LAS bf16x8*)(kp + 64);
        f32x4 a = {0.f, 0.f, 0.f, 0.f};
        a = __builtin_amdgcn_mfma_f32_16x16x32_bf16(k0, qf0, a, 0, 0, 0); a = __builtin_amdgcn_mfma_f32_16x16x32_bf16(k1, qf1, a, 0, 0, 0); st[kt] = a; }
    float SC2 = 0.125f * 1.4426950408889634f; asm volatile("" : "+v"(SC2));
    const int dbase = 128 + c - 4 * g;
    float m = sink2;
#pragma unroll
    for (int kt = 0; kt < 9; ++kt)
#pragma unroll
        for (int r = 0; r < 4; ++r) { const int dist = dbase - r - 16 * kt, kk = 16 * kt + 4 * g + r; const bool ok = (unsigned)dist <= 128u && (wpos0 + kk) >= 0;
            const float sv = ok ? st[kt][r] * SC2 - slope2 * (float)dist : -INFINITY; st[kt][r] = sv; m = fmaxf(m, sv); }
    m = red4_max(m);
    float sum = 0.f;
#pragma unroll
    for (int kt = 0; kt < 9; ++kt)
#pragma unroll
        for (int r = 0; r < 4; ++r) { const float p = __builtin_amdgcn_exp2f(st[kt][r] - m); st[kt][r] = p; sum += p; }
    sum = red4_sum(sum) + __builtin_amdgcn_exp2f(sink2 - m);
    const float inv = 1.f / sum;
    bf16x8 pf[5];
#pragma unroll
    for (int k = 0; k < 5; ++k) { unsigned w0 = cvtpk(st[2 * k][0] * inv, st[2 * k][1] * inv), w1 = cvtpk(st[2 * k][2] * inv, st[2 * k][3] * inv), w2 = 0u, w3 = 0u;
        if (k < 4) { w2 = cvtpk(st[2 * k + 1][0] * inv, st[2 * k + 1][1] * inv); w3 = cvtpk(st[2 * k + 1][2] * inv, st[2 * k + 1][3] * inv); }
        typedef unsigned u32x4_t __attribute__((ext_vector_type(4))); const u32x4_t w = {w0, w1, w2, w3}; pf[k] = __builtin_bit_cast(bf16x8, w); }
    f32x4 o[4];
#pragma unroll
    for (int dt = 0; dt < 4; ++dt) o[dt] = (f32x4){0.f, 0.f, 0.f, 0.f};
    const LAS unsigned char* vb = Vs + (kbase + 4 * g + (c >> 2)) * KP + 8 * (c & 3);
#pragma unroll
    for (int k = 0; k < 5; ++k)
#pragma unroll
        for (int dt = 0; dt < 4; ++dt) { const s16x4 lo = vtr(vb + (32 * k) * KP + 32 * dt), hi = vtr(vb + (32 * k + 16) * KP + 32 * dt);
            const bf16x8 b = {lo[0], lo[1], lo[2], lo[3], hi[0], hi[1], hi[2], hi[3]};
            o[dt] = __builtin_amdgcn_mfma_f32_16x16x32_bf16(pf[k], b, o[dt], 0, 0, 0); }
#pragma unroll
    for (int r = 0; r < 4; ++r) if (4 * g + r < nst) {
#pragma unroll
        for (int dt = 0; dt < 4; ++dt) Yq[(size_t)(4 * g + r) * BRW + 16 * dt + c] = f2bf(o[dt][r]); }
}
typedef unsigned u32x4_t __attribute__((ext_vector_type(4)));
__device__ __forceinline__ u32x4_t pack8(const float* f) { u32x4_t w; w.x = cvtpk(f[0], f[1]); w.y = cvtpk(f[2], f[3]); w.z = cvtpk(f[4], f[5]); w.w = cvtpk(f[6], f[7]); return w; }
__device__ __forceinline__ void phase(LAS unsigned char* lds, const bf16* Z, int l, const float* sinks, const float* ck, const float* cv, bf16* Y0, int bx, int G, int tid, int lane, int wave) {
    LAS unsigned char* Ks = lds + K_OFF; LAS unsigned char* Vs = lds + V_OFF;
    const u32x4_t zero4 = {0u, 0u, 0u, 0u};
    for (int it = bx; it < NBP * 32 * NKV + SB * NKV; it += G) {
        const int kvh = it & 3;
        if (it < NBP * 32 * NKV) {
            const int b = it >> 7, qb = (it >> 2) & 31;
#pragma unroll
            for (int i = 0; i < 4; ++i) { const int p = tid + NTHR * i, sr = p >> 3, cc = p & 7; const int pos = 128 * (qb - 1) + sr;
                u32x4_t kq = zero4, vq = zero4;
                if (pos >= 0) { const bf16* zr = Z + (size_t)(b * SEQ + pos) * ZW + kvh * 64 + cc * 8; kq = *(const u32x4_t*)(zr + ZK); vq = *(const u32x4_t*)(zr + ZV); }
                *(LAS u32x4_t*)(Ks + sr * KP + cc * 16) = kq; *(LAS u32x4_t*)(Vs + sr * KP + cc * 16) = vq; }
            if (tid < 128) { const int sr = 256 + (tid >> 3), cc = tid & 7; *(LAS u32x4_t*)(Ks + sr * KP + cc * 16) = zero4; *(LAS u32x4_t*)(Vs + sr * KP + cc * 16) = zero4; }
            __syncthreads();
            const int hq = kvh * 4 + (wave >> 1), qh = wave & 1;
            const float slope2 = exp2f(-0.5f * (float)(hq + 1)) * 1.4426950408889634f, sink2 = sinks[l * NH + hq] * 1.4426950408889634f;
            const bf16* qp0 = Z + ((size_t)b * SEQ + 128 * qb + 64 * qh + (lane & 15)) * ZW + ZQ + hq * 64 + 8 * (lane >> 4);
            bf16x8 qc0 = *(const bf16x8*)qp0, qc1 = *(const bf16x8*)(qp0 + 32);
#pragma unroll 1
            for (int qt = 0; qt < 4; ++qt) { const int t1 = 64 * qh + 16 * qt; const size_t qrow0 = (size_t)b * SEQ + 128 * qb + t1;
                const bf16* qpn = qp0 + (size_t)(16 * (qt < 3 ? qt + 1 : 3)) * ZW; const bf16x8 qn0 = *(const bf16x8*)qpn, qn1 = *(const bf16x8*)(qpn + 32);
                tile16(qc0, qc1, Ks, Vs, t1, 128 * qb + t1 - 128, slope2, sink2, Y0 + qrow0 * BRW + hq * 64, 16, lane);
                qc0 = qn0; qc1 = qn1; }
        } else {
            const int sb = (it - NBP * 32 * NKV) >> 2;
#pragma unroll
            for (int i = 0; i < 3; ++i) { const int p = tid + NTHR * i, sr = p >> 3, cc = p & 7;
                if (sr < 160) { u32x4_t kq = zero4, vq = zero4;
                    if (sr < WIN) { const size_t o = ((((size_t)l * SB + sb) * WIN + sr) * NKV + kvh) * 64 + cc * 8; float f[8];
#pragma unroll
                        for (int e = 0; e < 8; ++e) f[e] = ck[o + e];
                        kq = pack8(f);
#pragma unroll
                        for (int e = 0; e < 8; ++e) f[e] = cv[o + e];
                        vq = pack8(f);
                    } else if (sr < WIN + ST) { const bf16* zr = Z + (size_t)(MP + sb * ST + (sr - WIN)) * ZW + kvh * 64 + cc * 8; kq = *(const u32x4_t*)(zr + ZK); vq = *(const u32x4_t*)(zr + ZV); }
                    *(LAS u32x4_t*)(Ks + sr * KP + cc * 16) = kq; *(LAS u32x4_t*)(Vs + sr * KP + cc * 16) = vq; } }
            __syncthreads();
            if (wave < 4) { const int hq = kvh * 4 + wave;
                const float slope2 = exp2f(-0.5f * (float)(hq + 1)) * 1.4426950408889634f, sink2 = sinks[l * NH + hq] * 1.4426950408889634f;
                const size_t qrow0 = (size_t)MP + sb * ST; const bf16* qp = Z + (qrow0 + (lane & 7)) * ZW + ZQ + hq * 64 + 8 * (lane >> 4);
                tile16(*(const bf16x8*)qp, *(const bf16x8*)(qp + 32), Ks, Vs, 0, 0, slope2, sink2, Y0 + qrow0 * BRW + hq * 64, ST, lane); }
        }
        __syncthreads();
    }
}
}

namespace adad {
using att::bf16x8; using att::f32x4; using att::cvtpk;
constexpr int NSTRIP = ADAW / 64, RW = 576, A2_OFF = 8 * RW * 16, A2_WAVE = 3 * 512;
#define ADA_LOAD(V, S) _Pragma("unroll") for (int j = 0; j < 8; ++j) V[j] = __builtin_nontemporal_load((const GAS f32x4*)(wp + (size_t)(32 * (S) + j) * ADAW))
__device__ __forceinline__ v4u silu8(f32x4 x0, f32x4 x1) { v4u o;
    o.x = cvtpk(x0.x * sigmoidf_(x0.x), x0.y * sigmoidf_(x0.y)); o.y = cvtpk(x0.z * sigmoidf_(x0.z), x0.w * sigmoidf_(x0.w));
    o.z = cvtpk(x1.x * sigmoidf_(x1.x), x1.y * sigmoidf_(x1.y)); o.w = cvtpk(x1.z * sigmoidf_(x1.z), x1.w * sigmoidf_(x1.w)); return o; }
__device__ __forceinline__ const GAS float* crow(const float* cp, const float* cs, int row) { return row < NBP ? (const GAS float*)cp + (size_t)row * DM : (const GAS float*)cs + (size_t)(row - NBP) * DM; }
__device__ __forceinline__ void phase(const float* cp, const float* cs, const float* wada, const float* bada, float* ADA, LAS unsigned char* lds, int bx, int G, int wave, int lane, int tid) {
    const int kl = 256 * wave + 8 * (lane >> 4);
    bf16x8 af[2][8];
#pragma unroll
    for (int mb = 0; mb < 2; ++mb) { const GAS float* src = crow(cp, cs, 16 * mb + (lane & 15)) + kl;
#pragma unroll
        for (int s = 0; s < 8; ++s) af[mb][s] = __builtin_bit_cast(bf16x8, silu8(*(const GAS f32x4*)(src + 32 * s), *(const GAS f32x4*)(src + 32 * s + 4))); }
    LAS unsigned char* a2 = lds + A2_OFF + wave * A2_WAVE;
    {   const GAS float* src = crow(cp, cs, 32 + (lane >> 5)) + 256 * wave + 8 * (lane & 31);
        *(LAS v4u*)(a2 + (lane >> 5) * 512 + (lane & 31) * 16) = silu8(*(const GAS f32x4*)src, *(const GAS f32x4*)(src + 4));
        if (lane < 32) { v4u z = {0u, 0u, 0u, 0u}; *(LAS v4u*)(a2 + 2 * 512 + lane * 16) = z; }
        LDS_WAIT(); asm volatile("" ::: "memory"); }
    const LAS unsigned char* a2r = a2 + ((lane & 15) < 2 ? (lane & 15) : 2) * 512 + (lane >> 4) * 16;
    LAS f32x4* red = (LAS f32x4*)lds;
    for (int g = bx; g < DEPTH * NSTRIP; g += G) { const int l = g / NSTRIP, n0 = 64 * (g % NSTRIP);
        const GAS float* wp = (const GAS float*)wada + (size_t)l * DM * ADAW + (size_t)kl * ADAW + n0 + 4 * (lane & 15);
        f32x4 acc[3][4];
#pragma unroll
        for (int mb = 0; mb < 3; ++mb)
#pragma unroll
            for (int i = 0; i < 4; ++i) acc[mb][i] = f32x4{0.f, 0.f, 0.f, 0.f};
        f32x4 v0[8], v1[8];
        ADA_LOAD(v0, 0);
#pragma unroll
        for (int s = 0; s < 8; ++s) {
            if (s < 7) { if (s & 1) { ADA_LOAD(v0, s + 1); } else { ADA_LOAD(v1, s + 1); } }
            asm volatile("" ::: "memory");
            const bf16x8 a2f = *(const LAS bf16x8*)(a2r + 64 * s);
#pragma unroll
            for (int i = 0; i < 4; ++i) { v4u w;
                if (s & 1) { w.x = cvtpk(v1[0][i], v1[1][i]); w.y = cvtpk(v1[2][i], v1[3][i]); w.z = cvtpk(v1[4][i], v1[5][i]); w.w = cvtpk(v1[6][i], v1[7][i]); }
                else       { w.x = cvtpk(v0[0][i], v0[1][i]); w.y = cvtpk(v0[2][i], v0[3][i]); w.z = cvtpk(v0[4][i], v0[5][i]); w.w = cvtpk(v0[6][i], v0[7][i]); }
                const bf16x8 bfr = __builtin_bit_cast(bf16x8, w);
                acc[0][i] = __builtin_amdgcn_mfma_f32_16x16x32_bf16(af[0][s], bfr, acc[0][i], 0, 0, 0);
                acc[1][i] = __builtin_amdgcn_mfma_f32_16x16x32_bf16(af[1][s], bfr, acc[1][i], 0, 0, 0);
                acc[2][i] = __builtin_amdgcn_mfma_f32_16x16x32_bf16(a2f, bfr, acc[2][i], 0, 0, 0); }
            asm volatile("" ::: "memory"); }
        LAS f32x4* rw = red + wave * RW;
#pragma unroll
        for (int mb = 0; mb < 2; ++mb)
#pragma unroll
            for (int i = 0; i < 4; ++i) rw[(mb * 4 + i) * 64 + lane] = acc[mb][i];
        if (lane < 16) {
#pragma unroll
            for (int i = 0; i < 4; ++i) rw[512 + i * 16 + lane] = acc[2][i]; }
        __syncthreads();
        for (int e = tid; e < RW; e += NTHR) { f32x4 t = red[e];
#pragma unroll
            for (int w = 1; w < 8; ++w) t += red[w * RW + e];
            int row0, col;
            if (e < 512) { const int mbi = e >> 6, ln = e & 63; row0 = 16 * (mbi >> 2) + 4 * (ln >> 4); col = n0 + 4 * (ln & 15) + (mbi & 3); }
            else { const int q = e - 512; row0 = 32; col = n0 + 4 * (q & 15) + (q >> 4); }
            const float bv = *((const GAS float*)bada + (size_t)l * ADAW + col);
            GAS float* o = (GAS float*)ADA + ((size_t)l * NROWB + row0) * ADAW + col;
            o[0] = t.x + bv; o[ADAW] = t.y + bv;
            if (row0 < 32) { o[2 * (size_t)ADAW] = t.z + bv; o[3 * (size_t)ADAW] = t.w + bv; } }
        __syncthreads(); }
}
}

namespace ret {
using att::bf16x8; using att::s16x4; using att::f32x4; using att::u32x4_t; using att::vtr; using att::cvtpk; using att::pack8;
constexpr int KP = 144, VP = 288, K_OFF = 0, V_OFF = 128 * KP, S_OFF = V_OFF + 128 * VP, LDS_NEED = S_OFF + 64 * VP;
template <int CTRL> __device__ __forceinline__ float dppf(float v) { return __builtin_bit_cast(float, __builtin_amdgcn_update_dpp(0, __builtin_bit_cast(int, v), CTRL, 0xf, 0xf, false)); }
__device__ __forceinline__ float sum16(float v) { v += dppf<0xB1>(v); v += dppf<0x4E>(v); v += dppf<0x141>(v); v += dppf<0x140>(v); return v; }
__device__ __forceinline__ void out_phase(LAS unsigned char* lds, const bf16* Z, int l, const float* SPREV, const float* gret, bf16* Y3, int bx, int G, int tid, int lane, int wave) {
    LAS unsigned char* Ks = lds + K_OFF; LAS unsigned char* Vs = lds + V_OFF; LAS unsigned char* Ss = lds + S_OFF;
    const int c = lane & 15, g = lane >> 4;
    for (int it = bx; it < NBP * 32 * RH; it += G) {
        const int b = it >> 8, n = (it >> 3) & 31, h = it & 7; const size_t row0 = (size_t)b * SEQ + n * 128;
#pragma unroll
        for (int i = 0; i < 2; ++i) { const int p = tid + NTHR * i, j = p >> 3, cc = p & 7; *(LAS u32x4_t*)(Ks + j * KP + cc * 16) = *(const u32x4_t*)(Z + (row0 + j) * ZW + ZRK + h * 64 + cc * 8); }
#pragma unroll
        for (int i = 0; i < 4; ++i) { const int p = tid + NTHR * i, j = p >> 4, cc = p & 15; *(LAS u32x4_t*)(Vs + j * VP + cc * 16) = *(const u32x4_t*)(Z + (row0 + j) * ZW + ZRV + h * 128 + cc * 8); }
#pragma unroll
        for (int i = 0; i < 2; ++i) { const int p = tid + NTHR * i, d = p >> 4, cc = p & 15; const float* sp = SPREV + ((((size_t)b * 32 + n) * RH + h) * RDK + d) * RDV + cc * 8; float f[8];
#pragma unroll
            for (int e = 0; e < 8; ++e) f[e] = sp[e];
            *(LAS u32x4_t*)(Ss + d * VP + cc * 16) = pack8(f); }
        __syncthreads();
        const int w = wave; const float lg2 = ret_logg(h) * 1.4426950408889634f;
        const bf16* qp = Z + (row0 + 16 * w + c) * ZW + ZRQ + h * 64 + 8 * g;
        const bf16x8 qf0 = *(const bf16x8*)qp, qf1 = *(const bf16x8*)(qp + 32);
        f32x4 o[8];
#pragma unroll
        for (int vt = 0; vt < 8; ++vt) o[vt] = (f32x4){0.f, 0.f, 0.f, 0.f};
#pragma unroll
        for (int ks = 0; ks < 2; ++ks) { const LAS unsigned char* sb = Ss + (32 * ks + 8 * g + (c >> 2)) * VP + 8 * (c & 3);
#pragma unroll
            for (int vt = 0; vt < 8; ++vt) { const s16x4 lo = vtr(sb + 32 * vt), hi = vtr(sb + 4 * VP + 32 * vt); const bf16x8 bb = {lo[0], lo[1], lo[2], lo[3], hi[0], hi[1], hi[2], hi[3]};
                o[vt] = __builtin_amdgcn_mfma_f32_16x16x32_bf16(ks ? qf1 : qf0, bb, o[vt], 0, 0, 0); } }
#pragma unroll
        for (int r = 0; r < 4; ++r) { const float cf = __builtin_amdgcn_exp2f(lg2 * (float)(16 * w + 4 * g + r + 1));
#pragma unroll
            for (int vt = 0; vt < 8; ++vt) o[vt][r] *= cf; }
        for (int ks = 0; ks <= (w >> 1); ++ks) {
            f32x4 st[2];
#pragma unroll
            for (int t = 0; t < 2; ++t) { const int jt = 2 * ks + t; f32x4 a = {0.f, 0.f, 0.f, 0.f};
                if (jt <= w) { const LAS unsigned char* kp = Ks + (16 * jt + c) * KP + 16 * g; const bf16x8 k0 = *(const LAS bf16x8*)kp, k1 = *(const LAS bf16x8*)(kp + 64);
                    a = __builtin_amdgcn_mfma_f32_16x16x32_bf16(k0, qf0, a, 0, 0, 0); a = __builtin_amdgcn_mfma_f32_16x16x32_bf16(k1, qf1, a, 0, 0, 0);
#pragma unroll
                    for (int r = 0; r < 4; ++r) { const int dij = (16 * w + c) - (16 * jt + 4 * g + r); a[r] = dij >= 0 ? a[r] * 0.125f * __builtin_amdgcn_exp2f(lg2 * (float)dij) : 0.f; } }
                st[t] = a; }
            const u32x4_t pw = {cvtpk(st[0][0], st[0][1]), cvtpk(st[0][2], st[0][3]), cvtpk(st[1][0], st[1][1]), cvtpk(st[1][2], st[1][3])}; const bf16x8 pf = __builtin_bit_cast(bf16x8, pw);
            const LAS unsigned char* vb = Vs + (32 * ks + 4 * g + (c >> 2)) * VP + 8 * (c & 3);
#pragma unroll
            for (int vt = 0; vt < 8; ++vt) { const s16x4 lo = vtr(vb + 32 * vt), hi = vtr(vb + 16 * VP + 32 * vt); const bf16x8 bb = {lo[0], lo[1], lo[2], lo[3], hi[0], hi[1], hi[2], hi[3]};
                o[vt] = __builtin_amdgcn_mfma_f32_16x16x32_bf16(pf, bb, o[vt], 0, 0, 0); }
        }
        float mean[4], rstd[4];
#pragma unroll
        for (int r = 0; r < 4; ++r) { float sm = 0.f;
#pragma unroll
            for (int vt = 0; vt < 8; ++vt) sm += o[vt][r];
            mean[r] = sum16(sm) * (1.f / 128.f); float q = 0.f;
#pragma unroll
            for (int vt = 0; vt < 8; ++vt) { const float dd = o[vt][r] - mean[r]; q += dd * dd; }
            rstd[r] = 1.f / sqrtf(sum16(q) * (1.f / 128.f) + EPS); }
        const float* gp = gret + l * BRW + h * 128 + c;
        float gv[8]; bf16 rgv[4][8];
#pragma unroll
        for (int vt = 0; vt < 8; ++vt) gv[vt] = gp[16 * vt];
#pragma unroll
        for (int r = 0; r < 4; ++r) { const bf16* rg = Z + (row0 + 16 * w + 4 * g + r) * ZW + ZRG + h * 128 + c;
#pragma unroll
            for (int vt = 0; vt < 8; ++vt) rgv[r][vt] = rg[16 * vt]; }
        asm volatile("" ::: "memory");
#pragma unroll
        for (int r = 0; r < 4; ++r) { bf16* y = Y3 + (row0 + 16 * w + 4 * g + r) * BRW + h * 128 + c;
#pragma unroll
            for (int vt = 0; vt < 8; ++vt) y[16 * vt] = f2bf((o[vt][r] - mean[r]) * rstd[r] * gv[vt] * bf2f(rgv[r][vt])); }
        __syncthreads();
    }
}

__device__ __forceinline__ void kv_phase(LAS unsigned char* lds, const bf16* Z, float* KV, int bx, int G, int tid, int lane, int wave) {
    LAS unsigned char* Ks = lds + K_OFF; LAS unsigned char* Vs = lds + V_OFF;
    const int c = lane & 15, g = lane >> 4;
    for (int it = bx; it < NBP * 32 * RH; it += G) {
        const int b = it >> 8, n = (it >> 3) & 31, h = it & 7; const size_t row0 = (size_t)b * SEQ + n * 128;
        const float lg2 = ret_logg(h) * 1.4426950408889634f;
#pragma unroll
        for (int i = 0; i < 2; ++i) { const int p = tid + NTHR * i, j = p >> 3, cc = p & 7; float f[8]; ld8(Z + (row0 + j) * ZW + ZRK + h * 64 + cc * 8, f);
            const float sc = 0.125f * __builtin_amdgcn_exp2f(lg2 * (float)(127 - j));
#pragma unroll
            for (int e = 0; e < 8; ++e) f[e] *= sc;
            *(LAS u32x4_t*)(Ks + j * KP + cc * 16) = pack8(f); }
#pragma unroll
        for (int i = 0; i < 4; ++i) { const int p = tid + NTHR * i, j = p >> 4, cc = p & 15; *(LAS u32x4_t*)(Vs + j * VP + cc * 16) = *(const u32x4_t*)(Z + (row0 + j) * ZW + ZRV + h * 128 + cc * 8); }
        __syncthreads();
        const int dt = wave & 3, vt0 = (wave >> 2) * 4;
        f32x4 acc[4];
#pragma unroll
        for (int t = 0; t < 4; ++t) acc[t] = (f32x4){0.f, 0.f, 0.f, 0.f};
#pragma unroll
        for (int ks = 0; ks < 4; ++ks) { const LAS unsigned char* ka = Ks + (32 * ks + 8 * g + (c >> 2)) * KP + 32 * dt + 8 * (c & 3);
            const s16x4 alo = vtr(ka), ahi = vtr(ka + 4 * KP); const bf16x8 af = {alo[0], alo[1], alo[2], alo[3], ahi[0], ahi[1], ahi[2], ahi[3]};
            const LAS unsigned char* vb = Vs + (32 * ks + 8 * g + (c >> 2)) * VP + 8 * (c & 3);
#pragma unroll
            for (int t = 0; t < 4; ++t) { const s16x4 lo = vtr(vb + 32 * (vt0 + t)), hi = vtr(vb + 4 * VP + 32 * (vt0 + t)); const bf16x8 bb = {lo[0], lo[1], lo[2], lo[3], hi[0], hi[1], hi[2], hi[3]};
                acc[t] = __builtin_amdgcn_mfma_f32_16x16x32_bf16(af, bb, acc[t], 0, 0, 0); } }
        float* kvp = KV + ((((size_t)b * 32 + n) * RH + h) * RDK + 16 * dt + 4 * g) * RDV + c;
#pragma unroll
        for (int r = 0; r < 4; ++r)
#pragma unroll
            for (int t = 0; t < 4; ++t) kvp[(size_t)r * RDV + 16 * (vt0 + t)] = acc[t][r];
        __syncthreads();
    }
}
}

namespace mixl {
using att::u32x4_t; using att::f32x4; using att::f32x2_t;
template <int CTRL> __device__ __forceinline__ float dppf(float v) { return __builtin_bit_cast(float, __builtin_amdgcn_update_dpp(0, __builtin_bit_cast(int, v), CTRL, 0xf, 0xf, false)); }
__device__ __forceinline__ float sum8(float v) { v += dppf<0xB1>(v); v += dppf<0x4E>(v); v += dppf<0x141>(v); return v; }
struct QkRow { float q0[8], q1[8], kv[8]; };
__device__ __forceinline__ void qk_load(const bf16* zr, QkRow& R, int lane) { ld8(zr + ZQ + lane * 8, R.q0); ld8(zr + ZQ + 512 + lane * 8, R.q1); ld8(zr + ZK + lane * 8, R.kv); }
__device__ __forceinline__ void qk_finish(bf16* zr, int row, int l, QkRow& R, const float (&g8q)[8], const float (&g8k)[8], float* out, int lane) {
    float s0 = 0.f, s1 = 0.f, s2 = 0.f;
#pragma unroll
    for (int e = 0; e < 8; ++e) { s0 += R.q0[e] * R.q0[e]; s1 += R.q1[e] * R.q1[e]; s2 += R.kv[e] * R.kv[e]; }
    const float r0 = 1.f / sqrtf(sum8(s0) * (1.f / 64.f) + EPS), r1 = 1.f / sqrtf(sum8(s1) * (1.f / 64.f) + EPS), r2 = 1.f / sqrtf(sum8(s2) * (1.f / 64.f) + EPS);
#pragma unroll
    for (int e = 0; e < 8; ++e) { R.q0[e] *= r0 * g8q[e]; R.q1[e] *= r1 * g8q[e]; if (lane < 32) R.kv[e] *= r2 * g8k[e]; }
    st8(zr + ZQ + lane * 8, R.q0); st8(zr + ZQ + 512 + lane * 8, R.q1);
    if (lane < 32) st8(zr + ZK + lane * 8, R.kv);
    float* o = nullptr;
    if (row < MP) { const int b = row >> 12, t = row & (SEQ - 1); if (t >= SEQ - WIN) o = out + (lane < 32 ? O_KP : O_VP) + (((size_t)l * NBP + b) * WIN + (t - (SEQ - WIN))) * 256 + (lane & 31) * 8; }
    else { const int sb = (row - MP) >> 3, t = (row - MP) & 7; o = out + (lane < 32 ? O_KS : O_VS) + (((size_t)l * SB + sb) * WIN + (WIN - ST + t)) * 256 + (lane & 31) * 8; }
    if (o) { *(f32x4*)o = (f32x4){R.kv[0], R.kv[1], R.kv[2], R.kv[3]}; *(f32x4*)(o + 4) = (f32x4){R.kv[4], R.kv[5], R.kv[6], R.kv[7]}; }
}
__device__ __forceinline__ void qknorm_phase(bf16* Z, int l, const float* gq, const float* gk, float* out, int gw, int NGW, int lane) {
    float g8q[8], g8k[8];
#pragma unroll
    for (int e = 0; e < 8; ++e) { g8q[e] = gq[l * 64 + (lane & 7) * 8 + e]; g8k[e] = gk[l * 64 + (lane & 7) * 8 + e]; }
    for (int row = gw; row < M; row += 2 * NGW) { const int rowb = row + NGW; const bool two = rowb < M;
        bf16* za = Z + (size_t)row * ZW; bf16* zb = Z + (size_t)(two ? rowb : row) * ZW;
        QkRow A, B; qk_load(za, A, lane); qk_load(zb, B, lane);
        asm volatile("" ::: "memory");
        qk_finish(za, row, l, A, g8q, g8k, out, lane);
        if (two) qk_finish(zb, rowb, l, B, g8q, g8k, out, lane);
    }
}
constexpr int CV_RB = 64, CV_CB = 128, CV_UR = CV_RB + CPRE, CV_NPI = (MP / CV_RB) * 8, CV_NSI = SB * 8;
struct CvItem { bool smp; int cb, b, t0, nrows; size_t rowb; };
__device__ __forceinline__ CvItem cv_item(int it) { CvItem I; I.smp = it >= CV_NPI; I.cb = it & 7; I.b = I.smp ? (it - CV_NPI) >> 3 : (it >> 3) >> 6; I.t0 = I.smp ? 0 : ((it >> 3) & 63) * CV_RB; I.nrows = I.smp ? ST : CV_RB;
    I.rowb = I.smp ? (size_t)MP + I.b * ST : (size_t)I.b * SEQ; return I; }
__device__ __forceinline__ void cv_fetch(const bf16* Z, int l, const float* sconv, const CvItem& I, u32x4_t (&raw)[3][2], int tid) {
#pragma unroll
    for (int i = 0; i < 3; ++i) { const int p = tid + NTHR * i, ur = p >> 4, c8 = p & 15, tt = I.t0 - CPRE + ur; raw[i][0] = (u32x4_t){0u, 0u, 0u, 0u}; raw[i][1] = raw[i][0];
        if (ur < I.nrows + CPRE) {
            if (tt >= 0) { const bf16* zp = Z + (I.rowb + tt) * ZW + I.cb * CV_CB + c8 * 8; raw[i][0] = *(const u32x4_t*)(zp + ZCA); }
            else if (I.smp) { const float* sp = sconv + (((size_t)l * SB + I.b) * CPRE + (CPRE + tt)) * BRW + I.cb * CV_CB + c8 * 8; raw[i][0] = *(const u32x4_t*)sp; raw[i][1] = *(const u32x4_t*)(sp + 4); } } }
}
__device__ __forceinline__ void conv_phase(LAS unsigned char* lds, const bf16* Z, int l, const float* wdw, const float* bdw, const float* sconv, bf16* CONVY, float* out, int bx, int G, int tid) {
    LAS float* U = (LAS float*)lds;
    auto unp = [](const u32x4_t w, float* f) { f[0] = __builtin_bit_cast(float, w.x << 16); f[1] = __builtin_bit_cast(float, w.x & 0xffff0000u); f[2] = __builtin_bit_cast(float, w.y << 16); f[3] = __builtin_bit_cast(float, w.y & 0xffff0000u);
        f[4] = __builtin_bit_cast(float, w.z << 16); f[5] = __builtin_bit_cast(float, w.z & 0xffff0000u); f[6] = __builtin_bit_cast(float, w.w << 16); f[7] = __builtin_bit_cast(float, w.w & 0xffff0000u); };
    u32x4_t raw[3][2]; f32x2_t w2[CONVK], bias2 = {0.f, 0.f}; int wcb = -1;
#pragma unroll
    for (int j = 0; j < CONVK; ++j) w2[j] = f32x2_t{0.f, 0.f};
    if (bx < CV_NPI + CV_NSI) { const CvItem I0 = cv_item(bx); cv_fetch(Z, l, sconv, I0, raw, tid); }
    for (int it = bx; it < CV_NPI + CV_NSI; it += G) {
        const CvItem I = cv_item(it);
        const int cp = tid & 63, r0 = (tid >> 6) * 8, ch = I.cb * CV_CB + 2 * cp;
        if (I.cb != wcb) { wcb = I.cb;
#pragma unroll
            for (int j = 0; j < CONVK; ++j) w2[j] = *(const f32x2_t*)(wdw + ((size_t)l * CONVK + j) * BRW + ch);
            bias2 = *(const f32x2_t*)(bdw + l * BRW + ch); }
#pragma unroll
        for (int i = 0; i < 3; ++i) { const int p = tid + NTHR * i, ur = p >> 4, c8 = p & 15, tt = I.t0 - CPRE + ur; float u[8];
            if (ur < I.nrows + CPRE) {
                if (tt >= 0) { unp(raw[i][0], u);
                    if (ur >= CPRE) { float* o = nullptr;
                        if (!I.smp) { if (tt >= SEQ - CPRE) o = out + O_CP + (((size_t)l * NBP + I.b) * CPRE + (tt - (SEQ - CPRE))) * BRW + I.cb * CV_CB + c8 * 8; }
                        else o = out + O_CS + (((size_t)l * SB + I.b) * CPRE + (CPRE - ST + tt)) * BRW + I.cb * CV_CB + c8 * 8;
                        if (o) { *(f32x4*)o = (f32x4){u[0], u[1], u[2], u[3]}; *(f32x4*)(o + 4) = (f32x4){u[4], u[5], u[6], u[7]}; } }
                } else {
                    const unsigned r0_ = raw[i][0].x, r1_ = raw[i][0].y, r2_ = raw[i][0].z, r3_ = raw[i][0].w, r4_ = raw[i][1].x, r5_ = raw[i][1].y, r6_ = raw[i][1].z, r7_ = raw[i][1].w;
                    u[0] = __builtin_bit_cast(float, r0_); u[1] = __builtin_bit_cast(float, r1_); u[2] = __builtin_bit_cast(float, r2_); u[3] = __builtin_bit_cast(float, r3_);
                    u[4] = __builtin_bit_cast(float, r4_); u[5] = __builtin_bit_cast(float, r5_); u[6] = __builtin_bit_cast(float, r6_); u[7] = __builtin_bit_cast(float, r7_); }
                *(LAS f32x4*)(U + ur * CV_CB + c8 * 8) = (f32x4){u[0], u[1], u[2], u[3]}; *(LAS f32x4*)(U + ur * CV_CB + c8 * 8 + 4) = (f32x4){u[4], u[5], u[6], u[7]}; } }
        __syncthreads();
        if (it + G < CV_NPI + CV_NSI) { const CvItem In = cv_item(it + G); cv_fetch(Z, l, sconv, In, raw, tid); }
        if (r0 < I.nrows) {
            f32x2_t u2[8 + CPRE];
#pragma unroll
            for (int k = 0; k < 8 + CPRE; ++k) u2[k] = *(const LAS f32x2_t*)(U + (r0 + k) * CV_CB + 2 * cp);
#pragma unroll
            for (int r = 0; r < 8; ++r) { f32x2_t acc = bias2;
#pragma unroll
                for (int j = 0; j < CONVK; ++j) acc = w2[j] * u2[r + j] + acc;
                if (r0 + r < I.nrows) *(unsigned*)(CONVY + (I.rowb + I.t0 + r0 + r) * BRW + ch) = pk2(acc.x, acc.y); }
        }
        __syncthreads();
    }
}
template <int W> __device__ __forceinline__ void pool_run(const bf16* Z, int l, int b, int t0, int cch, bf16* ZP, float* out) {
    const size_t rowb = (size_t)b * SEQ; u32x4_t rw[23];
#pragma unroll
    for (int k = 16 - W; k < 23; ++k) { const int tt = t0 - 15 + k; rw[k] = (u32x4_t){0u, 0u, 0u, 0u}; if (tt >= 0) rw[k] = *(const u32x4_t*)(Z + (rowb + tt) * ZW + ZPL + cch); }
    float S[8];
#pragma unroll
    for (int e = 0; e < 8; ++e) S[e] = 0.f;
    auto unp = [](const u32x4_t w, float* f) { f[0] = __builtin_bit_cast(float, w.x << 16); f[1] = __builtin_bit_cast(float, w.x & 0xffff0000u); f[2] = __builtin_bit_cast(float, w.y << 16); f[3] = __builtin_bit_cast(float, w.y & 0xffff0000u);
        f[4] = __builtin_bit_cast(float, w.z << 16); f[5] = __builtin_bit_cast(float, w.z & 0xffff0000u); f[6] = __builtin_bit_cast(float, w.w << 16); f[7] = __builtin_bit_cast(float, w.w & 0xffff0000u); };
#pragma unroll
    for (int k = 16 - W; k < 15; ++k) { float f[8]; unp(rw[k], f);
#pragma unroll
        for (int e = 0; e < 8; ++e) S[e] += f[e]; }
#pragma unroll
    for (int r = 0; r < 8; ++r) { const int t = t0 + r; float u[8], o[8], f[8]; unp(rw[15 + r], u);
        const float inv = 1.f / (float)((t + 1) < W ? (t + 1) : W);
#pragma unroll
        for (int e = 0; e < 8; ++e) { S[e] += u[e]; o[e] = S[e] * inv - u[e]; }
        st8(ZP + (rowb + t) * BRW + cch, o);
        if (t >= SEQ - PPAD) { float* so = out + O_PP + (((size_t)l * NBP + b) * PPAD + (t - (SEQ - PPAD))) * BRW + cch; *(f32x4*)so = (f32x4){u[0], u[1], u[2], u[3]}; *(f32x4*)(so + 4) = (f32x4){u[4], u[5], u[6], u[7]}; }
        unp(rw[15 + r - W + 1], f);
#pragma unroll
        for (int e = 0; e < 8; ++e) S[e] -= f[e]; }
}
template <int W> __device__ __forceinline__ void pool_run_s(const bf16* Z, int l, int b, int cch, const float* spool, bf16* ZP, float* out) {
    const size_t rowb = (size_t)MP + b * ST; const float* sp = spool + (((size_t)l * SB + b) * PPAD) * BRW + cch;
    f32x4 pf[W - 1][2]; u32x4_t rw[ST];
#pragma unroll
    for (int k = 0; k < W - 1; ++k) { pf[k][0] = *(const f32x4*)(sp + (size_t)(PPAD - (W - 1) + k) * BRW); pf[k][1] = *(const f32x4*)(sp + (size_t)(PPAD - (W - 1) + k) * BRW + 4); }
#pragma unroll
    for (int t = 0; t < ST; ++t) rw[t] = *(const u32x4_t*)(Z + (rowb + t) * ZW + ZPL + cch);
    auto unp = [](const u32x4_t w, float* f) { f[0] = __builtin_bit_cast(float, w.x << 16); f[1] = __builtin_bit_cast(float, w.x & 0xffff0000u); f[2] = __builtin_bit_cast(float, w.y << 16); f[3] = __builtin_bit_cast(float, w.y & 0xffff0000u);
        f[4] = __builtin_bit_cast(float, w.z << 16); f[5] = __builtin_bit_cast(float, w.z & 0xffff0000u); f[6] = __builtin_bit_cast(float, w.w << 16); f[7] = __builtin_bit_cast(float, w.w & 0xffff0000u); };
    float S[8];
#pragma unroll
    for (int e = 0; e < 8; ++e) S[e] = 0.f;
#pragma unroll
    for (int k = 0; k < W - 1; ++k) { S[0] += pf[k][0].x; S[1] += pf[k][0].y; S[2] += pf[k][0].z; S[3] += pf[k][0].w; S[4] += pf[k][1].x; S[5] += pf[k][1].y; S[6] += pf[k][1].z; S[7] += pf[k][1].w; }
    const float inv = 1.f / (float)W;
#pragma unroll
    for (int t = 0; t < ST; ++t) { float u[8], o[8], f[8]; unp(rw[t], u);
#pragma unroll
        for (int e = 0; e < 8; ++e) { S[e] += u[e]; o[e] = S[e] * inv - u[e]; }
        st8(ZP + (rowb + t) * BRW + cch, o);
        float* so = out + O_PS + (((size_t)l * SB + b) * PPAD + (PPAD - ST + t)) * BRW + cch; *(f32x4*)so = (f32x4){u[0], u[1], u[2], u[3]}; *(f32x4*)(so + 4) = (f32x4){u[4], u[5], u[6], u[7]};
        const int tt = t - W + 1;
        if (tt >= 0) unp(rw[tt >= 0 ? tt : 0], f);
        else { const int k = tt + W - 1 >= 0 ? tt + W - 1 : 0; f[0] = pf[k][0].x; f[1] = pf[k][0].y; f[2] = pf[k][0].z; f[3] = pf[k][0].w; f[4] = pf[k][1].x; f[5] = pf[k][1].y; f[6] = pf[k][1].z; f[7] = pf[k][1].w; }
#pragma unroll
        for (int e = 0; e < 8; ++e) S[e] -= f[e]; }
}
__device__ __forceinline__ void pool_phase(const bf16* Z, int l, const float* spool, bf16* ZP, float* out, int gw, int NGW, int lane, int gt, int NGT) {
    for (int wi = gw; wi < (MP / 8 / 2) * 4; wi += NGW) { const int cg = wi & 3, grp = (wi >> 2) * 2 + (lane >> 5), cch = (cg * 32 + (lane & 31)) * 8, b = grp >> 9, t0 = (grp & 511) * 8;
        if (cg == 0) pool_run<2>(Z, l, b, t0, cch, ZP, out); else if (cg == 1) pool_run<4>(Z, l, b, t0, cch, ZP, out); else if (cg == 2) pool_run<8>(Z, l, b, t0, cch, ZP, out); else pool_run<16>(Z, l, b, t0, cch, ZP, out); }
    for (int wi = gw; wi < (SB / 2) * 4; wi += NGW) { const int cg = wi & 3, b = (wi >> 2) * 2 + (lane >> 5), cch = (cg * 32 + (lane & 31)) * 8;
        if (cg == 0) pool_run_s<2>(Z, l, b, cch, spool, ZP, out); else if (cg == 1) pool_run_s<4>(Z, l, b, cch, spool, ZP, out); else if (cg == 2) pool_run_s<8>(Z, l, b, cch, spool, ZP, out); else pool_run_s<16>(Z, l, b, cch, spool, ZP, out); }
}
__device__ __forceinline__ void retout_s_phase(const bf16* Z, int l, const float* sret, const float* gret, bf16* Y3, int gw, int NGW, int lane) {
    for (int it = gw; it < MS * RH; it += NGW) { int h = __builtin_amdgcn_readfirstlane(it & 7); asm volatile("" : "+s"(h));
        const int rs = it >> 3, sb = rs >> 3, i = rs & 7; const size_t row = (size_t)MP + rs, row0 = (size_t)MP + sb * ST;
        const float lg = ret_logg(h);
        const bf16* qp = Z + row * ZW + ZRQ + h * 64;
        const float* S = sret + (((size_t)l * SB + sb) * RH + h) * RDK * RDV;
        float o0 = 0.f, o1 = 0.f;
        const float ql = bf2f(qp[lane]);
        bf16 kj[ST], v0j[ST], v1j[ST];
#pragma unroll
        for (int j = 0; j < ST; ++j) { const bf16* zj = Z + (row0 + j) * ZW; kj[j] = zj[ZRK + h * 64 + lane]; v0j[j] = zj[ZRV + h * 128 + lane]; v1j[j] = zj[ZRV + h * 128 + lane + 64]; }
#pragma unroll
        for (int d0 = 0; d0 < 64; d0 += 32) { float sa[32], sb_[32];
#pragma unroll
            for (int d = 0; d < 32; ++d) { sa[d] = S[(size_t)(d0 + d) * RDV + lane]; sb_[d] = S[(size_t)(d0 + d) * RDV + lane + 64]; }
#pragma unroll
            for (int d = 0; d < 32; ++d) { const float qd = __builtin_bit_cast(float, __builtin_amdgcn_readlane(__builtin_bit_cast(int, ql), d0 + d)); o0 += qd * sa[d]; o1 += qd * sb_[d]; } }
        const float cf = FEXP(lg * (float)(i + 1)); o0 *= cf; o1 *= cf;
#pragma unroll
        for (int j = 0; j < ST; ++j) { const float sc = j <= i ? wave_sum(ql * bf2f(kj[j])) * 0.125f * FEXP(lg * (float)(i - j)) : 0.f;
            o0 += sc * bf2f(v0j[j]); o1 += sc * bf2f(v1j[j]); }
        const float mean = wave_sum(o0 + o1) * (1.f / 128.f); const float d0 = o0 - mean, d1 = o1 - mean;
        const float rstd = 1.f / sqrtf(wave_sum(d0 * d0 + d1 * d1) * (1.f / 128.f) + EPS);
        const float* g = gret + l * BRW + h * 128; const bf16* rg = Z + row * ZW + ZRG + h * 128; bf16* y = Y3 + row * BRW + h * 128;
        y[lane] = f2bf(d0 * rstd * g[lane] * bf2f(rg[lane])); y[lane + 64] = f2bf(d1 * rstd * g[lane + 64] * bf2f(rg[lane + 64]));
    }
}
}
struct AdaOrder { int G, c; const char* A; const char* B;
    __device__ __forceinline__ bool next(int i, pg8::Unit& u) const { const int Lx = i * G + c; if (Lx >= DEPTH * (ADAW / 256)) return false;
        u.r = Lx / (ADAW / 256); u.pn = Lx % (ADAW / 256); u.pm = 0; u.ks = 0; u.nt = DM / 64; u.a = A; u.b = B + ((size_t)u.r * ADAW + (size_t)u.pn * 256) * DM * 2; return true; } };
struct PoolOrder { int G, c; const char* A; const char* B;
                __device__ __forceinline__ bool next(int i, pg8::Unit& u) const { const int Lx = i * G + c; if (Lx >= (M / 256) * 4) return false;
                    u.pm = Lx >> 2; u.pn = Lx & 3; u.r = 0; u.ks = 0; u.nt = 256 / 64; u.a = A + ((size_t)u.pm * 256 * BRW + (size_t)u.pn * 256) * 2; u.b = B + (size_t)u.pn * 256 * 256 * 2; return true; } };
__device__ __forceinline__ unsigned long long ld_ptr(volatile LAS unsigned* p) { const unsigned lo = __builtin_amdgcn_readfirstlane(p[0]), hi = __builtin_amdgcn_readfirstlane(p[1]); return ((unsigned long long)hi << 32) | lo; }
__device__ __forceinline__ att::f32x4 retstate_s_val(const bf16* Z, int l, int sb, int h, int d, int v4, const float* sret, float* out, float*& o) {
    const float lg = ret_logg(h);
    const size_t so = ((((size_t)l * SB + sb) * RH + h) * RDK + d) * RDV + v4 * 4;
    const float gc = FEXP(lg * (float)ST);
    const att::f32x4 s4 = *(const att::f32x4*)(sret + so); float a0 = gc * s4.x, a1 = gc * s4.y, a2 = gc * s4.z, a3 = gc * s4.w;
#pragma unroll
    for (int j = 0; j < ST; ++j) { const bf16* p = Z + (size_t)(MP + sb * ST + j) * ZW;
        const float kd = bf2f(p[ZRK + h * 64 + d]) * 0.125f * FEXP(lg * (float)(ST - 1 - j));
        const bf16* pv = p + ZRV + h * 128 + v4 * 4;
        a0 += kd * bf2f(pv[0]); a1 += kd * bf2f(pv[1]); a2 += kd * bf2f(pv[2]); a3 += kd * bf2f(pv[3]); }
    o = out + O_RS + so; return att::f32x4{a0, a1, a2, a3};
}
constexpr int NPL = 12;
constexpr int PH_TOTAL = 2 + DEPTH * NPL + 1;
constexpr int KS_BR = 2, KS_OUT = 8, KS_M1 = 4, KS_M2 = 16;
struct Args { const float* in[N_IN]; float* out; unsigned char* ws; int ph_lo, ph_hi; };
static_assert(sizeof(Args) == N_IN * 8 + 8 + 8 + 8, "Args has no padding");

__global__ void __launch_bounds__(NTHR, 2) fwd(Args args) {
    extern __shared__ __attribute__((aligned(16))) unsigned char lds[];
    LAS unsigned char* L0 = (LAS unsigned char*)lds;
    volatile LAS unsigned* MISC = (volatile LAS unsigned*)(L0 + MISC_OFF);
    const int G = gridDim.x, bx = blockIdx.x, wave0 = __builtin_amdgcn_readfirstlane(threadIdx.x >> 6);
    unsigned char* ws0 = args.ws;
    for (int u = threadIdx.x; u < (LDS_BYTES - LDSCTL_OFF) / 4; u += NTHR) ((LAS unsigned*)(L0 + LDSCTL_OFF))[u] = 0u;
    __syncthreads();
    if (threadIdx.x <= N_IN) ((LAS unsigned long long*)(L0 + INTAB_OFF))[threadIdx.x] = threadIdx.x < N_IN ? (unsigned long long)args.in[threadIdx.x < N_IN ? threadIdx.x : 0] : (unsigned long long)args.out;
    __syncthreads();
#if MK_ONE_LAUNCH
    XcdBarrier bar = xcd_barrier_post((unsigned*)(ws0 + WS_CTL) + CW_BAR, MISC + 8);
#define GRID_BAR() xcd_barrier(bar)
#else
#define GRID_BAR() do {} while (0)
#endif
    const int lo = args.ph_lo, hi = args.ph_hi;
#ifndef PH_MASK
#define PH_MASK 0x7FFF
#endif
#ifndef PROBE_MASK
#define PROBE_MASK 0
#endif
#define PROBE_BEGIN(bit) unsigned long long pr_t0 = 0; if ((PROBE_MASK >> (bit)) & 1) pr_t0 = __builtin_amdgcn_s_memrealtime()
#define PROBE_END(bit) do { if ((PROBE_MASK >> (bit)) & 1) { __syncthreads(); const unsigned long long t1 = __builtin_amdgcn_s_memrealtime(); while (__builtin_amdgcn_s_memrealtime() - t1 < t1 - pr_t0) __builtin_amdgcn_s_sleep(8); } } while (0)
#define TAIL_FILL(nsub, N, ...) do { const int f0_ = (nsub) < G ? (nsub) : 0; if (bx >= f0_) for (int i = (bx - f0_) * NTHR + tid; i < (N); i += (G - f0_) * NTHR) { __VA_ARGS__; } } while (0)
#define IN(k) (lo <= (k) && (k) < hi)
#define SEAM(k) do { if (IN((k) + 1)) GRID_BAR(); } while (0)
#define INP(i)  ((const float*)(GAS const float*)ld_ptr((volatile LAS unsigned*)(L + INTAB_OFF) + 2 * (i)))
#define P_OUT   ((float*)(GAS float*)ld_ptr((volatile LAS unsigned*)(L + INTAB_OFF) + 2 * N_IN))
#define WIN_T   ((bf16*)(ws + WS_WIN))
#define WBR_T   ((bf16*)(ws + WS_WBR))
#define WOUT_T  ((bf16*)(ws + WS_WOUT))
#define WM1_T   ((bf16*)(ws + WS_WM1))
#define WM2_T   ((bf16*)(ws + WS_WM2))
#define WPOOL_T ((bf16*)(ws + WS_WPOOL))
#define WADA_T  ((bf16*)(ws + WS_WADA))
#define SC      ((bf16*)(ws + WS_SC))
#define ADA     ((float*)(ws + WS_ADA))
#define H       ((bf16*)(ws + WS_H))
#define Z       ((bf16*)(ws + WS_Z))
#define Y       ((bf16*)(ws + WS_Y))
#define ZP      ((bf16*)(ws + WS_ZP))
#define CONVY   ((bf16*)(ws + WS_CONVY))
#define ORAW    ((float*)(ws + WS_ORAW))
#define KV      ((float*)(ws + WS_KV))
#define SPREV   ((float*)(ws + WS_SPREV))
#define MACC    ((float*)(ws + WS_MACC))
#define MERGED  ((bf16*)(ws + WS_MERGED))
#define X1      ((float*)(ws + WS_X1))
#define X       ((float*)(ws + WS_X))
#define X1B     ((bf16*)(ws + WS_X1))
#define XB      ((bf16*)(ws + WS_X))
#define HID     ((bf16*)(ws + WS_HID))
#define SLAB    ((float*)(ws + WS_SLAB))
#define TIDS() int lane; asm volatile("v_mbcnt_lo_u32_b32 %0, -1, 0\n\tv_mbcnt_hi_u32_b32 %0, -1, %0" : "=v"(lane)); GAS unsigned char* wsg = (GAS unsigned char*)ws0; asm volatile("" : "+s"(wsg)); unsigned char* ws = (unsigned char*)wsg; LAS unsigned char* L = L0; asm volatile("" : "+s"(L)); const int wave = wave0, tid = wave0 * 64 + lane; const int gw = bx * NWAVES + wave, NGW = G * NWAVES; const int gt = bx * NTHR + tid, NGT = G * NTHR; (void)lane; (void)gw; (void)NGW; (void)gt; (void)NGT
#define LAYER_PTRS() const float* ada = ADA + (size_t)l * NROWB * ADAW; const float* xinP = l == 0 ? INP(I_XP) : X; const float* xinS = l == 0 ? INP(I_XS) : X + (size_t)MP * DM; float* xout = l == DEPTH - 1 ? P_OUT : X; (void)ada; (void)xinP; (void)xinS; (void)xout
    if ((PH_MASK >> 12 & 1) && IN(0)) { TIDS(); PROBE_BEGIN(12);
        transpose_run<DM, ZW, true>(INP(I_WIN), WIN_T, DEPTH, gw, NGW, lane);
        transpose_run<BRW, DM>(INP(I_WBR), WBR_T, DEPTH * 4, gw, NGW, lane);
        transpose_run<DM, DM>(INP(I_WOUT), WOUT_T, DEPTH, gw, NGW, lane);
        transpose_run<DM, DFF>(INP(I_WM1), WM1_T, DEPTH, gw, NGW, lane);
        transpose_run<DFF, DM>(INP(I_WM2), WM2_T, DEPTH, gw, NGW, lane);
        transpose_run<256, 256>(INP(I_WPOOL), WPOOL_T, DEPTH * 4, gw, NGW, lane);
        adad::phase(INP(I_CP), INP(I_CS), INP(I_WADA), INP(I_BADA), ADA, L + RING_OFF, bx, G, wave, lane, tid);
        PROBE_END(12); SEAM(0);
    }
    for (int l = 0; l < DEPTH; ++l) {
        const int pb = 2 + l * NPL;
        if ((PH_MASK >> 0 & 1) && IN(pb + 0)) { TIDS(); LAYER_PTRS(); PROBE_BEGIN(0);
            for (int rs = bx; rs < MS; rs += G) { const int row = MP + rs; const float* ar = ada + (size_t)row_cond(row) * ADAW;
                if (l == 0) norm_row_block<0>(xinS + (size_t)rs * DM, nullptr, nullptr, 0, nullptr, INP(I_G1) + l * DM, ar + DM, ar, H + (size_t)row * DM, (LAS float*)(L + RING_OFF), tid, wave);
                else norm_row_block<KS_M2>(X1 + (size_t)row * DM, ar - (size_t)NROWB * ADAW + 5 * DM, SLAB + (size_t)rs * DM, (size_t)MS * DM, X + (size_t)row * DM, INP(I_G1) + l * DM, ar + DM, ar, H + (size_t)row * DM, (LAS float*)(L + RING_OFF), tid, wave); }
            f32x4 gm[8], shv[8]; int curc = row_cond(gw < MP ? gw : 0); { const float* ar = ada + (size_t)curc * ADAW; load_mod(INP(I_G1) + l * DM, ar + DM, ar, gm, shv, lane); }
            for (int row = gw; row < MP; row += 2 * NGW) { const int rowb = row + NGW; const bool pair = rowb < MP && row_cond(rowb) == row_cond(row);
                for (int k = 0; k < 2; ++k) { const int r = k ? rowb : row; if (k && (pair || rowb >= MP)) break; const int cond = row_cond(r); const float* ar = ada + (size_t)cond * ADAW;
                    if (cond != curc) { load_mod(INP(I_G1) + l * DM, ar + DM, ar, gm, shv, lane); curc = cond; }
                    if (l == 0) { const float* xin = INP(I_XP);
                        if (pair) norm_row2<false>(xin + (size_t)row * DM, xin + (size_t)rowb * DM, gm, shv, H + (size_t)row * DM, H + (size_t)rowb * DM, lane);
                        else norm_row<false>(xin + (size_t)r * DM, gm, shv, H + (size_t)r * DM, lane); }
                    else {
                        if (pair) norm_row2<true>(XB + (size_t)row * DM, XB + (size_t)rowb * DM, gm, shv, H + (size_t)row * DM, H + (size_t)rowb * DM, lane);
                        else norm_row<true>(XB + (size_t)r * DM, gm, shv, H + (size_t)r * DM, lane); } } }
            PROBE_END(0); SEAM(pb + 0);
        }
        if ((PH_MASK >> 1 & 1) && IN(pb + 1)) { TIDS(); LAYER_PTRS(); PROBE_BEGIN(1);
            pg8::StaticOrder S; S.init(H, WIN_T + (size_t)l * ZW * DM, M / 256, ZW / 256, DM, DM, DM, G, bx);
            pg8::EpiZ E{Z};
            pg8::gemm_phase<pg8::EpiZ, pg8::StaticOrder>(L + RING_OFF, pg8::Dims{DM, DM, DM}, S, E, tid);
            PROBE_END(1); SEAM(pb + 1);
        }
        if ((PH_MASK >> 2 & 1) && IN(pb + 2)) { TIDS(); LAYER_PTRS(); PROBE_BEGIN(2);
            mixl::qknorm_phase(Z, l, INP(I_GQ), INP(I_GK), P_OUT, gw, NGW, lane);
            mixl::conv_phase(L + RING_OFF, Z, l, INP(I_WDW), INP(I_BDW), INP(I_SCONV), CONVY, P_OUT, bx, G, tid);
            mixl::pool_phase(Z, l, INP(I_SPOOL), ZP, P_OUT, gw, NGW, lane, gt, NGT);
            ret::kv_phase(L + RING_OFF, Z, KV, bx, G, tid, lane, wave);
            PROBE_END(2); SEAM(pb + 2);
        }
        if ((PH_MASK >> 3 & 1) && IN(pb + 3)) { TIDS(); LAYER_PTRS(); PROBE_BEGIN(3);
            att::phase(L + RING_OFF, Z, l, INP(I_SINK), INP(I_CK), INP(I_CV), Y, bx, G, tid, lane, wave);
            for (int i = gt; i < NBP * RH * RDK * 32; i += NGT) { const int v4 = i & 31, d = (i >> 5) & 63, b = i >> 14; int h = (i >> 11) & 7;
                const size_t o0 = (((size_t)b * 32 * RH + h) * RDK + d) * RDV + v4 * 4, cs = (size_t)RH * RDK * RDV; f32x4 kvv[32];
#pragma unroll
                for (int n = 0; n < 32; ++n) kvv[n] = *(const f32x4*)(KV + o0 + n * cs);
                const float gc = FEXP(ret_logg(h) * 128.f); float z0 = 0.f; asm volatile("" : "+v"(z0)); f32x4 sacc = {z0, z0, z0, z0};
#pragma unroll
                for (int n = 0; n < 32; ++n) { *(f32x4*)(SPREV + o0 + n * cs) = sacc; sacc = sacc * gc + kvv[n]; }
                *(f32x4*)(P_OUT + O_RP + ((((size_t)l * NBP + b) * RH + h) * RDK + d) * RDV + v4 * 4) = sacc; }
            { f32x4 gv4[4], bv4[4];
#pragma unroll
              for (int j = 0; j < 4; ++j) { const int q = 2 * (lane + 64 * (j >> 1)) + (j & 1); gv4[j] = ((const f32x4*)(INP(I_GCLN) + l * BRW))[q]; bv4[j] = ((const f32x4*)(INP(I_BCLN) + l * BRW))[q]; }
              bf16* const Y1 = Y + (size_t)1 * M * BRW;
              for (int row = gw; row < M; row += 2 * NGW) { const int rowb = row + NGW;
                  if (rowb < M) { const bf16* const yr[2] = {CONVY + (size_t)row * BRW, CONVY + (size_t)rowb * BRW}; bf16* const orr[2] = {Y1 + (size_t)row * BRW, Y1 + (size_t)rowb * BRW}; convln_rows<2>(yr, gv4, bv4, orr, lane); }
                  else { const bf16* const yr[1] = {CONVY + (size_t)row * BRW}; bf16* const orr[1] = {Y1 + (size_t)row * BRW}; convln_rows<1>(yr, gv4, bv4, orr, lane); } } }
            PROBE_END(3); SEAM(pb + 3);
        }
        if ((PH_MASK >> 4 & 1) && IN(pb + 4)) { TIDS(); LAYER_PTRS(); PROBE_BEGIN(4);
            mixl::retout_s_phase(Z, l, INP(I_SRET), INP(I_GRET), Y + (size_t)3 * M * BRW, gw, NGW, lane);
            ret::out_phase(L + RING_OFF, Z, l, SPREV, INP(I_GRET), Y + (size_t)3 * M * BRW, bx, G, tid, lane, wave);
            PoolOrder S{G, bx, (const char*)ZP, (const char*)(WPOOL_T + (size_t)l * 4 * 256 * 256)};
            pg8::EpiPool E{Y + (size_t)2 * M * BRW, INP(I_SPOOLS), l};
            pg8::gemm_phase<pg8::EpiPool, PoolOrder>(L + RING_OFF, pg8::Dims{BRW, 256, 256}, S, E, tid);
            PROBE_END(4); SEAM(pb + 4);
        }
        if ((PH_MASK >> 5 & 1) && IN(pb + 5)) { TIDS(); LAYER_PTRS(); PROBE_BEGIN(5);
            pg8::SplitOrder S{DM / 256, G, bx, 4, BRW / 64, KS_BR, BRW / 64 / KS_BR, (const char*)Y, (const char*)(WBR_T + (size_t)l * 4 * DM * BRW), (size_t)256 * BRW * 2, (size_t)256 * BRW * 2, (size_t)M * BRW * 2, (size_t)DM * BRW * 2};
            pg8::EpiBr E{Z, MERGED, SLAB, KS_BR};
            pg8::gemm_phase<pg8::EpiBr, pg8::SplitOrder>(L + RING_OFF, pg8::Dims{BRW, BRW, BRW}, S, E, tid);
            PROBE_END(5); SEAM(pb + 5);
        }
        if ((PH_MASK >> 6 & 1) && IN(pb + 6)) { TIDS(); LAYER_PTRS(); PROBE_BEGIN(6);
            for (int i = gt; i < MS * DM / 8; i += NGT) { float a[8];
#pragma unroll
                for (int e = 0; e < 8; ++e) a[e] = 0.f;
#pragma unroll
                for (int p = 0; p < 4 * KS_BR; ++p) { const f32x4 v0 = *(const f32x4*)(SLAB + (size_t)p * MS * DM + (size_t)i * 8), v1 = *(const f32x4*)(SLAB + (size_t)p * MS * DM + (size_t)i * 8 + 4);
                    a[0] += v0.x; a[1] += v0.y; a[2] += v0.z; a[3] += v0.w; a[4] += v1.x; a[5] += v1.y; a[6] += v1.z; a[7] += v1.w; }
                st8(MERGED + (size_t)MP * DM + (size_t)i * 8, a); }
            PROBE_END(6); SEAM(pb + 6);
        }
        if ((PH_MASK >> 7 & 1) && IN(pb + 7)) { TIDS(); LAYER_PTRS(); PROBE_BEGIN(7);
            pg8::SplitOrder S{DM / 256, G, bx, 1, DM / 64, KS_OUT, DM / 64 / KS_OUT, (const char*)MERGED, (const char*)(WOUT_T + (size_t)l * DM * DM), (size_t)256 * DM * 2, (size_t)256 * DM * 2, 0, 0};
            pg8::EpiRes E{l == 0 ? (const void*)INP(I_XP) : (const void*)XB, (void*)X1B, l != 0, true, ada + 2 * DM, SLAB};
            pg8::gemm_phase<pg8::EpiRes, pg8::SplitOrder>(L + RING_OFF, pg8::Dims{DM, DM, DM}, S, E, tid);
            PROBE_END(7); SEAM(pb + 7);
        }
        if ((PH_MASK >> 8 & 1) && IN(pb + 8)) { TIDS(); LAYER_PTRS(); PROBE_BEGIN(8);
            for (int rs = bx; rs < MS; rs += G) { const int row = MP + rs; const float* ar = ada + (size_t)row_cond(row) * ADAW;
                norm_row_block<KS_OUT>(xinS + (size_t)rs * DM, ar + 2 * DM, SLAB + (size_t)rs * DM, (size_t)MS * DM, X1 + (size_t)row * DM, INP(I_G2) + l * DM, ar + 4 * DM, ar + 3 * DM, H + (size_t)row * DM, (LAS float*)(L + RING_OFF), tid, wave); }
            f32x4 gm[8], shv[8]; int curc = row_cond(gw < MP ? gw : 0); { const float* ar = ada + (size_t)curc * ADAW; load_mod(INP(I_G2) + l * DM, ar + 4 * DM, ar + 3 * DM, gm, shv, lane); }
            for (int row = gw; row < MP; row += 2 * NGW) { const int rowb = row + NGW; const bool pair = rowb < MP && row_cond(rowb) == row_cond(row);
                for (int k = 0; k < 2; ++k) { const int r = k ? rowb : row; if (k && (pair || rowb >= MP)) break; const int cond = row_cond(r); const float* ar = ada + (size_t)cond * ADAW;
                    if (cond != curc) { load_mod(INP(I_G2) + l * DM, ar + 4 * DM, ar + 3 * DM, gm, shv, lane); curc = cond; }
                    if (pair) norm_row2<true>(X1B + (size_t)row * DM, X1B + (size_t)rowb * DM, gm, shv, H + (size_t)row * DM, H + (size_t)rowb * DM, lane);
                    else norm_row<true>(X1B + (size_t)r * DM, gm, shv, H + (size_t)r * DM, lane); } }
            PROBE_END(8); SEAM(pb + 8);
        }
        if ((PH_MASK >> 9 & 1) && IN(pb + 9)) { TIDS(); LAYER_PTRS(); PROBE_BEGIN(9);
            pg8::SplitOrder S{DFF / 256, G, bx, 1, DM / 64, KS_M1, DM / 64 / KS_M1, (const char*)H, (const char*)(WM1_T + (size_t)l * DFF * DM), (size_t)256 * DM * 2, (size_t)256 * DM * 2, 0, 0};
            pg8::EpiMlp1 E{HID, SLAB};
            pg8::gemm_phase<pg8::EpiMlp1, pg8::SplitOrder>(L + RING_OFF, pg8::Dims{DM, DM, DM}, S, E, tid);
            {
                const int f0 = (DFF / 256) * KS_M1 < G ? (DFF / 256) * KS_M1 : 0;
                if (bx >= f0) { const int st = (G - f0) * NTHR;
                    for (int i0 = (bx - f0) * NTHR + tid; i0 < N_SHIFT_ITEMS; i0 += 4 * st) { f32x4 v[4]; float* dp[4];
#pragma unroll
                        for (int u = 0; u < 4; ++u) { const int idx = i0 + u * st; dp[u] = nullptr; v[u] = f32x4{0.f, 0.f, 0.f, 0.f};
                            if (idx < N_SHIFT_ITEMS) { const float* sp; shift_addr(l, idx, INP(I_CK), INP(I_CV), INP(I_SCONV), INP(I_SPOOL), P_OUT, sp, dp[u]); v[u] = *(const f32x4*)sp; } }
                        asm volatile("" ::: "memory");
#pragma unroll
                        for (int u = 0; u < 4; ++u) if (dp[u]) *(f32x4*)dp[u] = v[u]; } } }
            PROBE_END(9); SEAM(pb + 9);
        }
        if ((PH_MASK >> 10 & 1) && IN(pb + 10)) { TIDS(); LAYER_PTRS(); PROBE_BEGIN(10);
            for (int i = gt; i < MS * DFF / 8; i += NGT) { float a[8];
#pragma unroll
                for (int e = 0; e < 8; ++e) a[e] = 0.f;
#pragma unroll
                for (int p = 0; p < KS_M1; ++p) { const f32x4 v0 = *(const f32x4*)(SLAB + (size_t)p * MS * DFF + (size_t)i * 8), v1 = *(const f32x4*)(SLAB + (size_t)p * MS * DFF + (size_t)i * 8 + 4);
                    a[0] += v0.x; a[1] += v0.y; a[2] += v0.z; a[3] += v0.w; a[4] += v1.x; a[5] += v1.y; a[6] += v1.z; a[7] += v1.w; }
#pragma unroll
                for (int e = 0; e < 8; ++e) { const float t = fmaxf(a[e], 0.f); a[e] = t * t; }
                st8(HID + (size_t)MP * DFF + (size_t)i * 8, a); }
            PROBE_END(10); SEAM(pb + 10);
        }
        if ((PH_MASK >> 11 & 1) && IN(pb + 11)) { TIDS(); LAYER_PTRS(); PROBE_BEGIN(11);
            pg8::SplitOrder S{DM / 256, G, bx, 1, DFF / 64, KS_M2, DFF / 64 / KS_M2, (const char*)HID, (const char*)(WM2_T + (size_t)l * DM * DFF), (size_t)256 * DFF * 2, (size_t)256 * DFF * 2, 0, 0};
            pg8::EpiRes E{(const void*)X1B, l == DEPTH - 1 ? (void*)P_OUT : (void*)XB, true, l != DEPTH - 1, ada + 5 * DM, SLAB};
            pg8::gemm_phase<pg8::EpiRes, pg8::SplitOrder>(L + RING_OFF, pg8::Dims{DFF, DFF, DFF}, S, E, tid);
            {
                const int f0 = (DM / 256) * KS_M2 < G ? (DM / 256) * KS_M2 : 0; constexpr int NI = SB * RH * RDK * 32;
                if (bx >= f0) { const int st = (G - f0) * NTHR;
                    for (int i0 = (bx - f0) * NTHR + tid; i0 < NI; i0 += 2 * st) { f32x4 r[2]; float* op[2];
#pragma unroll
                        for (int u = 0; u < 2; ++u) { const int i = i0 + u * st; op[u] = nullptr; r[u] = f32x4{0.f, 0.f, 0.f, 0.f};
                            if (i < NI) { const int v4 = i & 31, d = (i >> 5) & 63, h = (i >> 11) & 7, sb = i >> 14; r[u] = retstate_s_val(Z, l, sb, h, d, v4, INP(I_SRET), P_OUT, op[u]); } }
                        asm volatile("" ::: "memory");
#pragma unroll
                        for (int u = 0; u < 2; ++u) if (op[u]) *(f32x4*)op[u] = r[u]; } } }
            PROBE_END(11); SEAM(pb + 11);
        }
    }
    if ((PH_MASK >> 14 & 1) && IN(PH_TOTAL - 1)) { TIDS(); PROBE_BEGIN(14);
        const float* ada = ADA + (size_t)(DEPTH - 1) * NROWB * ADAW; float* yo = P_OUT + O_YS;
        for (int i = gt; i < MS * DM / 4; i += NGT) { const int row = i / (DM / 4), c4 = i % (DM / 4); const float* gp = ada + (size_t)(NBP + (row >> 3)) * ADAW + 5 * DM;
            f32x4 a = {0.f, 0.f, 0.f, 0.f};
#pragma unroll
            for (int p = 0; p < KS_M2; ++p) a += *(const f32x4*)(SLAB + (size_t)p * MS * DM + (size_t)i * 4);
            *(f32x4*)(yo + (size_t)i * 4) = *(const f32x4*)(X1 + (size_t)(MP + row) * DM + c4 * 4) + *(const f32x4*)(gp + c4 * 4) * a; }
        PROBE_END(14);
    }
#undef IN
#undef SEAM
}

extern "C" void kernel_launch(void* const* d_in, const int* in_sizes, int n_in, void* d_out, int out_size, void* d_ws, size_t ws_size, hipStream_t stream) {
    static int grid = 0;
    if (grid == 0) {
        if (n_in != N_IN || (size_t)out_size != O_END || ws_size < WS_END) { fprintf(stderr, "kernel_launch: unexpected shapes: n_in %d out %d ws %zu (need %zu)\n", n_in, out_size, ws_size, (size_t)WS_END); grid = -1; return; }
        int dev = 0, cus = 0, per_cu = 0;
        if (hipGetDevice(&dev) != hipSuccess || hipDeviceGetAttribute(&cus, hipDeviceAttributeMultiprocessorCount, dev) != hipSuccess) { grid = -1; return; }
        if (hipFuncSetAttribute((const void*)fwd, hipFuncAttributeMaxDynamicSharedMemorySize, LDS_BYTES) != hipSuccess) { fprintf(stderr, "kernel_launch: hipFuncSetAttribute failed\n"); grid = -1; return; }
        if (hipOccupancyMaxActiveBlocksPerMultiprocessor(&per_cu, (const void*)fwd, NTHR, LDS_BYTES) != hipSuccess || per_cu < 1) fprintf(stderr, "kernel_launch: occupancy query says %d\n", per_cu);
        (void)hipGetLastError();
        grid = cus;
    }
    if (grid < 0) return;
    (void)hipMemsetAsync((char*)d_ws + WS_CTL, 0, CTL_ZERO_BYTES, stream);
    Args a{};
    for (int i = 0; i < N_IN; ++i) a.in[i] = (const float*)d_in[i];
    a.out = (float*)d_out; a.ws = (unsigned char*)d_ws;
#if MK_ONE_LAUNCH
    a.ph_lo = 0; a.ph_hi = PH_TOTAL;
    hipLaunchKernelGGL(fwd, dim3(grid), dim3(NTHR), LDS_BYTES, stream, a);
#else
    for (int p = 0; p < PH_TOTAL; ++p) { a.ph_lo = p; a.ph_hi = p + 1; hipLaunchKernelGGL(fwd, dim3(grid), dim3(NTHR), LDS_BYTES, stream, a); }
#endif
}
#endif
```

```cpp
#ifndef HOST_TEST_ONLY
#include <hip/hip_runtime.h>
#endif
#include <cstdio>
#include <cstdint>
#include <cmath>

#ifndef MK_ONE_LAUNCH
#define MK_ONE_LAUNCH 1
#endif

#define HD __host__ __device__ __forceinline__
typedef unsigned short bf16;
HD float bf2f(bf16 b) { return __builtin_bit_cast(float, ((unsigned)b) << 16); }
HD bf16 f2bf(float f) { unsigned u = __builtin_bit_cast(unsigned, f); return (bf16)((u + 0x7fffu + ((u >> 16) & 1u)) >> 16); }

HD void ld8(const bf16* p, float* f) { const uint4 w = *(const uint4*)p;
    f[0] = __builtin_bit_cast(float, w.x << 16); f[1] = __builtin_bit_cast(float, w.x & 0xffff0000u); f[2] = __builtin_bit_cast(float, w.y << 16); f[3] = __builtin_bit_cast(float, w.y & 0xffff0000u);
    f[4] = __builtin_bit_cast(float, w.z << 16); f[5] = __builtin_bit_cast(float, w.z & 0xffff0000u); f[6] = __builtin_bit_cast(float, w.w << 16); f[7] = __builtin_bit_cast(float, w.w & 0xffff0000u); }
HD void st8(bf16* p, const float* f) { uint4 w; w.x = (unsigned)f2bf(f[0]) | ((unsigned)f2bf(f[1]) << 16); w.y = (unsigned)f2bf(f[2]) | ((unsigned)f2bf(f[3]) << 16);
    w.z = (unsigned)f2bf(f[4]) | ((unsigned)f2bf(f[5]) << 16); w.w = (unsigned)f2bf(f[6]) | ((unsigned)f2bf(f[7]) << 16); *(uint4*)p = w; }
constexpr int DM = 2048, SEQ = 4096, NBP = 2, MP = NBP * SEQ, SB = 32, ST = 8, MS = SB * ST, M = MP + MS, DEPTH = 4;
constexpr int NROWB = NBP + SB;
constexpr int NH = 16, HDIM = 64, NKV = 4, WIN = 128, BRW = 1024, CONVK = 31, CPRE = 30, PPAD = 15, RH = 8, RDK = 64, RDV = 128, DFF = 8192;
constexpr int ZW = 15872, ZQ = 0, ZK = 1024, ZV = 1280, ZCA = 1536, ZCG = 2560, ZPL = 3584, ZRQ = 4608, ZRK = 5120, ZRV = 5632, ZRG = 6656, ZGT = 7680;
constexpr int ADAW = 6 * DM;
constexpr float EPS = 1e-6f;
constexpr size_t O_YP = 0, O_YS = O_YP + (size_t)MP * DM, O_KP = O_YS + (size_t)MS * DM, O_VP = O_KP + (size_t)DEPTH * NBP * WIN * 256,
    O_CP = O_VP + (size_t)DEPTH * NBP * WIN * 256, O_PP = O_CP + (size_t)DEPTH * NBP * CPRE * BRW, O_RP = O_PP + (size_t)DEPTH * NBP * PPAD * BRW,
    O_KS = O_RP + (size_t)DEPTH * NBP * RH * RDK * RDV, O_VS = O_KS + (size_t)DEPTH * SB * WIN * 256, O_CS = O_VS + (size_t)DEPTH * SB * WIN * 256,
    O_PS = O_CS + (size_t)DEPTH * SB * CPRE * BRW, O_RS = O_PS + (size_t)DEPTH * SB * PPAD * BRW, O_END = O_RS + (size_t)DEPTH * SB * RH * RDK * RDV;
static_assert(O_END == 41394176, "output size");
enum { I_XP = 0, I_XS, I_CP, I_CS, I_CK, I_CV, I_SCONV, I_SPOOL, I_SRET, I_WADA, I_BADA, I_G1, I_G2, I_WIN, I_GQ, I_GK, I_SINK, I_WDW, I_BDW, I_GCLN, I_BCLN,
       I_WPOOL, I_SPOOLS, I_GRET, I_WBR, I_WOUT, I_WM1, I_WM2, N_IN };

HD bool row_is_s(int row) { return row >= MP; }
HD int row_cond(int row) { return row < MP ? (row >> 12) : NBP + ((row - MP) >> 3); }

#if defined(__HIP_DEVICE_COMPILE__)
#define FEXP(x) __expf(x)
#else
#define FEXP(x) expf(x)
#endif
#if defined(__HIP_DEVICE_COMPILE__)
HD float sigmoidf_(float x) { return __builtin_amdgcn_rcpf(1.f + __expf(-x)); }
#else
HD float sigmoidf_(float x) { return 1.f / (1.f + FEXP(-x)); }
#endif
HD float ret_logg(int h) { const float x = __builtin_bit_cast(float, (unsigned)(127 - 5 - h) << 23); return -x * (1.f + x * (0.5f + x * (0.33333334f + x * (0.25f + x * 0.2f)))); }

HD void qknorm_item(bf16* Z, int l, int row, int slot, const float* gq, const float* gk, float* out) {
    const int col = slot < 16 ? ZQ + slot * 64 : (slot < 20 ? ZK + (slot - 16) * 64 : ZV + (slot - 20) * 64);
    bf16* p = Z + (size_t)row * ZW + col;
    float v[64];
#pragma unroll
    for (int i = 0; i < 64; i += 8) ld8(p + i, v + i);
    if (slot < 20) {
        float ss = 0.f;
#pragma unroll
        for (int i = 0; i < 64; ++i) ss += v[i] * v[i];
        const float r = 1.f / sqrtf(ss * (1.f / 64.f) + EPS);
        const float* g = (slot < 16 ? gq : gk) + l * 64;
#pragma unroll
        for (int i = 0; i < 64; ++i) v[i] = v[i] * r * g[i];
#pragma unroll
        for (int i = 0; i < 64; i += 8) st8(p + i, v + i);
    }
    if (slot >= 16) {
        const int kvh = (slot - 16) & 3; const bool isv = slot >= 20;
        float* o = nullptr;
        if (!row_is_s(row)) { const int b = row >> 12, t = row & (SEQ - 1);
            if (t >= SEQ - WIN) o = out + (isv ? O_VP : O_KP) + ((((size_t)l * NBP + b) * WIN + (t - (SEQ - WIN))) * NKV + kvh) * 64;
        } else { const int sb = (row - MP) >> 3, t = (row - MP) & 7;
            o = out + (isv ? O_VS : O_KS) + ((((size_t)l * SB + sb) * WIN + (WIN - ST + t)) * NKV + kvh) * 64; }
        if (o) {
#pragma unroll
            for (int i = 0; i < 64; ++i) o[i] = v[i];
        }
    }
}
HD void shift_addr(int l, int idx, const float* ck, const float* cv, const float* sconv, const float* spool, float* out, const float*& src, float*& dst) {
    constexpr int NKVS = SB * (WIN - ST) * 64, NCV = SB * (CPRE - ST) * 256, NPL = SB * (PPAD - ST) * 256;
    if (idx < 2 * NKVS) { const bool isv = idx >= NKVS; const int i = isv ? idx - NKVS : idx; const int sb = i / ((WIN - ST) * 64), rem = i % ((WIN - ST) * 64);
        src = (isv ? cv : ck) + (((size_t)l * SB + sb) * WIN + ST) * 256 + (size_t)rem * 4; dst = out + (isv ? O_VS : O_KS) + (((size_t)l * SB + sb) * WIN) * 256 + (size_t)rem * 4;
    } else if (idx < 2 * NKVS + NCV) { const int i = idx - 2 * NKVS; const int sb = i / ((CPRE - ST) * 256), rem = i % ((CPRE - ST) * 256);
        src = sconv + (((size_t)l * SB + sb) * CPRE + ST) * BRW + (size_t)rem * 4; dst = out + O_CS + (((size_t)l * SB + sb) * CPRE) * BRW + (size_t)rem * 4;
    } else { const int i = idx - 2 * NKVS - NCV; const int sb = i / ((PPAD - ST) * 256), rem = i % ((PPAD - ST) * 256);
        src = spool + (((size_t)l * SB + sb) * PPAD + ST) * BRW + (size_t)rem * 4; dst = out + O_PS + (((size_t)l * SB + sb) * PPAD) * BRW + (size_t)rem * 4; }
}
HD void shift_item(int l, int idx, const float* ck, const float* cv, const float* sconv, const float* spool, float* out) {
    const float* src; float* dst; shift_addr(l, idx, ck, cv, sconv, spool, out, src, dst);
    dst[0] = src[0]; dst[1] = src[1]; dst[2] = src[2]; dst[3] = src[3];
}
constexpr int N_SHIFT_ITEMS = 2 * SB * (WIN - ST) * 64 + SB * (CPRE - ST) * 256 + SB * (PPAD - ST) * 256;

HD float glu_at(const bf16* Z, int row, int c) { const bf16* p = Z + (size_t)row * ZW; return bf2f(p[ZCA + c]) * sigmoidf_(bf2f(p[ZCG + c])); }
HD void conv_item(const bf16* Z, int l, int row, int c, const float* wdw, const float* bdw, const float* sconv, float* CONVY, float* out) {
    float acc = bdw[l * BRW + c];
    const float* w = wdw + (size_t)l * CONVK * BRW + c;
    if (!row_is_s(row)) { const int b = row >> 12, t = row & (SEQ - 1);
        for (int j = 0; j < CONVK; ++j) { const int tt = t - CPRE + j; if (tt >= 0) acc += w[(size_t)j * BRW] * glu_at(Z, b * SEQ + tt, c); }
        if (t >= SEQ - CPRE) out[O_CP + (((size_t)l * NBP + b) * CPRE + (t - (SEQ - CPRE))) * BRW + c] = glu_at(Z, row, c);
    } else { const int sb = (row - MP) >> 3, t = (row - MP) & 7;
        for (int j = 0; j < CONVK; ++j) { const int tt = t - CPRE + j;
            const float u = tt >= 0 ? glu_at(Z, MP + sb * ST + tt, c) : sconv[(((size_t)l * SB + sb) * CPRE + (CPRE + tt)) * BRW + c];
            acc += w[(size_t)j * BRW] * u; }
        out[O_CS + (((size_t)l * SB + sb) * CPRE + (CPRE - ST + t)) * BRW + c] = glu_at(Z, row, c);
    }
    CONVY[(size_t)row * BRW + c] = acc;
}
HD void pool_item(const bf16* Z, int l, int row, int c, const float* spool, bf16* ZP, float* out) {
    const int g = c >> 8, w = 2 << g;
    const float u0 = bf2f(Z[(size_t)row * ZW + ZPL + c]);
    float sum = 0.f, cnt;
    if (!row_is_s(row)) { const int b = row >> 12, t = row & (SEQ - 1);
        for (int i = 0; i < w; ++i) if (t - i >= 0) sum += bf2f(Z[(size_t)(b * SEQ + t - i) * ZW + ZPL + c]);
        cnt = (float)((t + 1) < w ? (t + 1) : w);
        if (t >= SEQ - PPAD) out[O_PP + (((size_t)l * NBP + b) * PPAD + (t - (SEQ - PPAD))) * BRW + c] = u0;
    } else { const int sb = (row - MP) >> 3, t = (row - MP) & 7;
        for (int i = 0; i < w; ++i) { const int tt = t - i;
            sum += tt >= 0 ? bf2f(Z[(size_t)(MP + sb * ST + tt) * ZW + ZPL + c]) : spool[(((size_t)l * SB + sb) * PPAD + (PPAD + tt)) * BRW + c]; }
        cnt = (float)w;
        out[O_PS + (((size_t)l * SB + sb) * PPAD + (PPAD - ST + t)) * BRW + c] = u0;
    }
    ZP[(size_t)row * BRW + c] = f2bf(sum / cnt - u0);
}
HD void retkv_item(const bf16* Z, float* KV, int b, int n, int h, int d, int v4) {
    const float lg = ret_logg(h);
    float a0 = 0.f, a1 = 0.f, a2 = 0.f, a3 = 0.f;
    for (int j = 0; j < 128; ++j) { const bf16* p = Z + (size_t)(b * SEQ + n * 128 + j) * ZW;
        const float kd = bf2f(p[ZRK + h * 64 + d]) * 0.125f * FEXP(lg * (float)(127 - j));
        const bf16* pv = p + ZRV + h * 128 + v4 * 4;
        a0 += kd * bf2f(pv[0]); a1 += kd * bf2f(pv[1]); a2 += kd * bf2f(pv[2]); a3 += kd * bf2f(pv[3]); }
    float* o = KV + ((((size_t)b * 32 + n) * RH + h) * RDK + d) * RDV + v4 * 4;
    o[0] = a0; o[1] = a1; o[2] = a2; o[3] = a3;
}
HD void retstate_s_item(const bf16* Z, int l, int sb, int h, int d, int v4, const float* sret, float* out) {
    const float lg = ret_logg(h);
    const size_t so = ((((size_t)l * SB + sb) * RH + h) * RDK + d) * RDV + v4 * 4;
    const float gc = FEXP(lg * (float)ST);
    float a0 = gc * sret[so], a1 = gc * sret[so + 1], a2 = gc * sret[so + 2], a3 = gc * sret[so + 3];
#pragma unroll
    for (int j = 0; j < ST; ++j) { const bf16* p = Z + (size_t)(MP + sb * ST + j) * ZW;
        const float kd = bf2f(p[ZRK + h * 64 + d]) * 0.125f * FEXP(lg * (float)(ST - 1 - j));
        const bf16* pv = p + ZRV + h * 128 + v4 * 4;
        a0 += kd * bf2f(pv[0]); a1 += kd * bf2f(pv[1]); a2 += kd * bf2f(pv[2]); a3 += kd * bf2f(pv[3]); }
    float* o = out + O_RS + so; o[0] = a0; o[1] = a1; o[2] = a2; o[3] = a3;
}
HD void retscan_item(const float* KV, float* SPREV, int l, int b, int h, int d, int v4, float* out) {
    const float gc = FEXP(ret_logg(h) * 128.f);
    float s0 = 0.f, s1 = 0.f, s2 = 0.f, s3 = 0.f;
    for (int n = 0; n < 32; ++n) { const size_t o = ((((size_t)b * 32 + n) * RH + h) * RDK + d) * RDV + v4 * 4;
        SPREV[o] = s0; SPREV[o + 1] = s1; SPREV[o + 2] = s2; SPREV[o + 3] = s3;
        s0 = gc * s0 + KV[o]; s1 = gc * s1 + KV[o + 1]; s2 = gc * s2 + KV[o + 2]; s3 = gc * s3 + KV[o + 3]; }
    float* oo = out + O_RP + ((((size_t)l * NBP + b) * RH + h) * RDK + d) * RDV + v4 * 4;
    oo[0] = s0; oo[1] = s1; oo[2] = s2; oo[3] = s3;
}
HD void attn_item(const bf16* Z, int l, int row, int hq, const float* sinks, const float* ck, const float* cv, bf16* Y0) {
    const int kvh = hq >> 2; const float slope = exp2f(-0.5f * (float)(hq + 1));
    float q[64];
    { const bf16* p = Z + (size_t)row * ZW + ZQ + hq * 64;
#pragma unroll
      for (int i = 0; i < 64; i += 8) ld8(p + i, q + i);
#pragma unroll
      for (int i = 0; i < 64; ++i) q[i] *= 0.125f; }
    float m = sinks[l * NH + hq], lsum = 1.f;
    float o[64];
#pragma unroll
    for (int i = 0; i < 64; ++i) o[i] = 0.f;
    const bool smp = row_is_s(row);
    const int b = smp ? ((row - MP) >> 3) : (row >> 12), t = smp ? ((row - MP) & 7) : (row & (SEQ - 1));
    const int lo = smp ? t : (t - WIN > 0 ? t - WIN : 0), hi = smp ? WIN + t : t;
    for (int j = lo; j <= hi; ++j) {
        const int dist = smp ? (WIN + t - j) : (t - j);
        const bool cache = smp && j < WIN;
        const size_t zrow = (size_t)(smp ? (MP + b * ST + (j - WIN)) : (b * SEQ + j)) * ZW;
        const size_t crow = ((((size_t)l * SB + b) * WIN + j) * NKV + kvh) * 64;
        float s = 0.f;
        if (cache) { const float* kp = ck + crow;
#pragma unroll
            for (int i = 0; i < 64; ++i) s += q[i] * kp[i];
        } else { const bf16* kp = Z + zrow + ZK + kvh * 64;
#pragma unroll
            for (int i = 0; i < 64; i += 8) { float f[8]; ld8(kp + i, f);
#pragma unroll
                for (int e = 0; e < 8; ++e) s += q[i + e] * f[e]; } }
        s -= slope * (float)dist;
        if (s > m) { const float corr = FEXP(m - s); lsum *= corr;
#pragma unroll
            for (int i = 0; i < 64; ++i) o[i] *= corr;
            m = s; }
        const float p = FEXP(s - m); lsum += p;
        if (cache) { const float* vp = cv + crow;
#pragma unroll
            for (int i = 0; i < 64; ++i) o[i] += p * vp[i];
        } else { const bf16* vp = Z + zrow + ZV + kvh * 64;
#pragma unroll
            for (int i = 0; i < 64; i += 8) { float f[8]; ld8(vp + i, f);
#pragma unroll
                for (int e = 0; e < 8; ++e) o[i + e] += p * f[e]; } }
    }
    const float inv = 1.f / lsum;
    bf16* y = Y0 + (size_t)row * BRW + hq * 64;
#pragma unroll
    for (int i = 0; i < 64; ++i) o[i] *= inv;
#pragma unroll
    for (int i = 0; i < 64; i += 8) st8(y + i, o + i);
}
HD void retout_item(const bf16* Z, int l, int row, int h, const float* SPREV, const float* sret, const float* gret, float* ORAW, bf16* Y3) {
    const float lg = ret_logg(h);
    const bool smp = row_is_s(row);
    const int b = smp ? ((row - MP) >> 3) : (row >> 12), t = smp ? ((row - MP) & 7) : (row & (SEQ - 1));
    const int i = smp ? t : (t & 127), n = smp ? 0 : (t >> 7);
    const int row0 = smp ? (MP + b * ST) : (b * SEQ + n * 128);
    const float* S = smp ? sret + (((size_t)l * SB + b) * RH + h) * RDK * RDV : SPREV + (((size_t)b * 32 + n) * RH + h) * RDK * RDV;
    float q[64];
    { const bf16* p = Z + (size_t)row * ZW + ZRQ + h * 64;
#pragma unroll
      for (int d = 0; d < 64; d += 8) ld8(p + d, q + d); }
    float* oraw = ORAW + (size_t)row * BRW + h * 128;
    float sum = 0.f;
    for (int half = 0; half < 2; ++half) {
        float o[64];
#pragma unroll
        for (int v = 0; v < 64; ++v) o[v] = 0.f;
        for (int j = 0; j <= i; ++j) { const bf16* p = Z + (size_t)(row0 + j) * ZW;
            const bf16* kp = p + ZRK + h * 64; float s = 0.f;
#pragma unroll
            for (int d = 0; d < 64; d += 8) { float f[8]; ld8(kp + d, f);
#pragma unroll
                for (int e = 0; e < 8; ++e) s += q[d + e] * f[e]; }
            s *= 0.125f * FEXP(lg * (float)(i - j));
            const bf16* vp = p + ZRV + h * 128 + half * 64;
#pragma unroll
            for (int v = 0; v < 64; v += 8) { float f[8]; ld8(vp + v, f);
#pragma unroll
                for (int e = 0; e < 8; ++e) o[v + e] += s * f[e]; } }
        const float cf = FEXP(lg * (float)(i + 1));
        const bf16* qp = Z + (size_t)row * ZW + ZRQ + h * 64;
        for (int d = 0; d < 64; ++d) { const float qd = bf2f(qp[d]) * cf; const float* sp = S + (size_t)d * RDV + half * 64;
#pragma unroll
            for (int v = 0; v < 64; ++v) o[v] += qd * sp[v]; }
#pragma unroll
        for (int v = 0; v < 64; ++v) { oraw[half * 64 + v] = o[v]; sum += o[v]; }
    }
    const float mean = sum * (1.f / 128.f);
    float var = 0.f;
    for (int v = 0; v < 128; ++v) { const float d = oraw[v] - mean; var += d * d; }
    const float rstd = 1.f / sqrtf(var * (1.f / 128.f) + EPS);
    const float* g = gret + l * BRW + h * 128;
    const bf16* rg = Z + (size_t)row * ZW + ZRG + h * 128;
    bf16* y = Y3 + (size_t)row * BRW + h * 128;
    for (int v = 0; v < 128; ++v) y[v] = f2bf((oraw[v] - mean) * rstd * g[v] * bf2f(rg[v]));
}

#if !defined(HOST_TEST_ONLY)
namespace pg8 {
#define PG8_LAS __attribute__((address_space(3)))
typedef short bf16x8 __attribute__((ext_vector_type(8)));
typedef float f32x4 __attribute__((ext_vector_type(4)));
typedef float f32x2 __attribute__((ext_vector_type(2)));
typedef unsigned u32x4 __attribute__((ext_vector_type(4)));
typedef unsigned u32x2 __attribute__((ext_vector_type(2)));
constexpr int BM = 256, BK = 64, HALF = 128, HTB = HALF * BK * 2, STAGE_BYTES = 8 * HTB, NXCD = 8, WGM = 8;

__host__ __device__ __forceinline__ int lds_byte(int r, int c) { const int st = (r >> 4) * 2 + (c >> 5), rr = r & 15, cc = c & 31, ob = rr * 64 + cc * 2; return st * 1024 + (ob ^ (((ob >> 9) & 1) << 5)); }
__host__ __device__ __forceinline__ void stage_rc(int b, int& R, int& C) { const int st = b / 1024, sb = b % 1024, swz = sb ^ (((sb >> 9) & 1) << 5); R = (st >> 1) * 16 + swz / 64; C = (st & 1) * 32 + (swz % 64) / 2; }
__host__ __device__ __forceinline__ int perm32(int rho) { const int n = rho >> 4, i = rho & 15; return 8 * (i >> 2) + 4 * n + (i & 3); }

struct Unit { int pm, pn, r, ks, nt; const char* a; const char* b; };
struct Dims { int lda, ldb, K; };

__host__ __device__ __forceinline__ void tile_of(int L, int nM, int nN, int& pm, int& pn) {
    const int nwg = nM * nN; int wgid = L; { const int q = nwg / NXCD, r = nwg % NXCD, xcd = wgid % NXCD, off = wgid / NXCD; wgid = (xcd < r ? xcd * (q + 1) : r * (q + 1) + (xcd - r) * q) + off; }
    const int nig = WGM * nN, gid = wgid / nig, fm = gid * WGM, gsz = (nM - fm) < WGM ? (nM - fm) : WGM;
    pm = fm + ((wgid % nig) % gsz); pn = (wgid % nig) / gsz;
}
struct StaticOrder {
    int nM, nN, nwg, G, c, nt; const char* A; const char* B; size_t ta, tb;
    __device__ __forceinline__ void init(const bf16* A_, const bf16* B_, int nM_, int nN_, int lda, int ldb, int K, int G_, int c_) { A = (const char*)A_; B = (const char*)B_; nM = nM_; nN = nN_; nwg = nM * nN; G = G_; c = c_; nt = K / BK; ta = (size_t)BM * lda * 2; tb = (size_t)BM * ldb * 2; }
    __device__ __forceinline__ bool next(int i, Unit& u) const {
        const long L = (long)i * G + c; if (L >= nwg) return false;
        tile_of((int)L, nM, nN, u.pm, u.pn); u.r = 0; u.ks = 0; u.nt = nt; u.a = A + (size_t)u.pm * ta; u.b = B + (size_t)u.pn * tb; return true;
    }
};


struct SplitOrder {
    int nN, G, c, RPT, ntP, KS, ntS; const char* A; const char* B; size_t ta, tb, sAr, sBr;
    __device__ __forceinline__ bool next(int i, Unit& u) const {
        const int nP = (MP / BM) * nN, Pc = c < nP ? (nP - c + G - 1) / G : 0;
        if (i < Pc * RPT) { const int tl = (i / RPT) * G + c; tile_of(tl, MP / BM, nN, u.pm, u.pn); u.r = i % RPT; u.ks = 0; u.nt = ntP;
            u.a = A + (size_t)u.r * sAr + (size_t)u.pm * ta; u.b = B + (size_t)u.r * sBr + (size_t)u.pn * tb; return true; }
        const int su = (i - Pc * RPT) * G + c; if (su >= nN * RPT * KS) return false;
        u.pm = MP / BM; u.pn = su / (RPT * KS); u.r = (su / KS) % RPT; u.ks = su % KS; u.nt = ntS;
        u.a = A + (size_t)u.r * sAr + (size_t)u.pm * ta + (size_t)u.ks * ntS * (BK * 2); u.b = B + (size_t)u.r * sBr + (size_t)u.pn * tb + (size_t)u.ks * ntS * (BK * 2); return true;
    }
};

__device__ __forceinline__ unsigned cvt_pk_bf16(float lo, float hi) { unsigned r; asm volatile("v_cvt_pk_bf16_f32 %0, %1, %2" : "=v"(r) : "v"(lo), "v"(hi)); return r; }

template <class Epi, class Sched, bool ALIGN_EPI = true, bool SP2 = true>
__device__ __forceinline__ void gemm_phase(PG8_LAS unsigned char* lds, const Dims g, const Sched& S, const Epi& E, const int tid) {
    const int wid = __builtin_amdgcn_readfirstlane(tid >> 6), lane = tid & 63, wr = wid >> 2, wc = wid & 3, fr = lane & 15, fq = lane >> 4;
    unsigned voffA[2], voffB[2];
#pragma unroll
    for (int i = 0; i < 2; ++i) { int R, C; stage_rc(tid * 16 + i * 8192, R, C); const int Rb = Epi::PERM ? ((R & ~31) + perm32(R & 31)) : R;
        voffA[i] = (unsigned)(R * g.lda + C) * 2u; voffB[i] = (unsigned)(Rb * g.ldb + C) * 2u; }
    const size_t kstep = (size_t)(BK * 2);
    const size_t hstepA = (size_t)HALF * g.lda * 2, hstepB = (size_t)HALF * g.ldb * 2;
    const unsigned ldsw = (unsigned)wid * 1024u;
    const int aoff = lds_byte(wr * 64 + fr, fq * 8), boff = lds_byte(wc * 32 + fr, fq * 8);
#define PG8_SA(b, h) (((b) * 2 + (h)) * HTB)
#define PG8_SB(b, h) ((4 + (b) * 2 + (h)) * HTB)
#define PG8_STAGE(bufoff, gbase, voff) do { _Pragma("unroll") for (int _i = 0; _i < 2; ++_i) \
        __builtin_amdgcn_global_load_lds((const unsigned*)((const char*)(gbase) + (voff)[_i]), (PG8_LAS unsigned*)(lds + (bufoff) + ldsw + _i * 8192), 16, 0, 0); } while (0)
#define PG8_LDA(dst, b, h) do { _Pragma("unroll") for (int m = 0; m < 4; ++m) _Pragma("unroll") for (int k = 0; k < 2; ++k) dst[m][k] = *(const PG8_LAS bf16x8*)(lds + PG8_SA(b, h) + aoff + m * 2048 + k * 1024); } while (0)
#define PG8_LDB(dst, b, h) do { _Pragma("unroll") for (int n = 0; n < 2; ++n) _Pragma("unroll") for (int k = 0; k < 2; ++k) dst[n][k] = *(const PG8_LAS bf16x8*)(lds + PG8_SB(b, h) + boff + n * 2048 + k * 1024); } while (0)
#define PG8_MMA(ai, bj, At, Bt) do { __builtin_amdgcn_s_setprio(1); _Pragma("unroll") for (int m = 0; m < 4; ++m) _Pragma("unroll") for (int n = 0; n < 2; ++n) _Pragma("unroll") for (int k = 0; k < 2; ++k) \
        acc[ai][bj][m][n] = __builtin_amdgcn_mfma_f32_16x16x32_bf16(Bt[n][k], At[m][k], acc[ai][bj][m][n], 0, 0, 0); __builtin_amdgcn_s_setprio(0); } while (0)
#define PG8_WAIT_V(n) asm volatile("s_waitcnt vmcnt(" #n ")" ::: "memory")
#define PG8_WAIT_L(n) asm volatile("s_waitcnt lgkmcnt(" #n ")" ::: "memory")
#define PG8_BAR __builtin_amdgcn_s_barrier()
#define PG8_SCHED __builtin_amdgcn_sched_barrier(0)
    Unit cur, nxt; int ui = 0;
    if (!S.next(0, cur)) return;
    f32x4 acc[2][2][4][2];
#pragma unroll
    for (int a = 0; a < 2; ++a)
#pragma unroll
        for (int b = 0; b < 2; ++b)
#pragma unroll
            for (int m = 0; m < 4; ++m)
#pragma unroll
                for (int n = 0; n < 2; ++n) acc[a][b][m][n] = (f32x4){0.f, 0.f, 0.f, 0.f};
    bf16x8 At[4][2], B0[2][2], B1[2][2];
    const char* cA = cur.a; const char* cB = cur.b;
    if constexpr (SP2) {
        PG8_STAGE(PG8_SB(0, 0), cB, voffB); PG8_STAGE(PG8_SB(0, 1), cB + hstepB, voffB); PG8_STAGE(PG8_SA(0, 0), cA, voffA); PG8_STAGE(PG8_SA(0, 1), cA + hstepA, voffA);
        if (wr == 1) PG8_BAR;
        PG8_WAIT_V(2); PG8_BAR;
        PG8_STAGE(PG8_SB(1, 0), cB + kstep, voffB); PG8_STAGE(PG8_SA(1, 0), cA + kstep, voffA); PG8_STAGE(PG8_SB(1, 1), cB + hstepB + kstep, voffB);
        PG8_WAIT_V(6); PG8_BAR;
    } else {
        PG8_STAGE(PG8_SB(0, 0), cB, voffB); PG8_STAGE(PG8_SA(0, 0), cA, voffA); PG8_STAGE(PG8_SB(0, 1), cB + hstepB, voffB); PG8_STAGE(PG8_SA(0, 1), cA + hstepA, voffA);
        if (wr == 1) PG8_BAR;
        PG8_WAIT_V(4); PG8_BAR;
        PG8_STAGE(PG8_SB(1, 0), cB + kstep, voffB); PG8_STAGE(PG8_SA(1, 0), cA + kstep, voffA); PG8_STAGE(PG8_SB(1, 1), cB + hstepB + kstep, voffB);
        PG8_WAIT_V(6); PG8_BAR;
    }
    for (;;) {
        const bool has_next = S.next(ui + 1, nxt);
        const char* nA = has_next ? nxt.a : cA; const char* nB = has_next ? nxt.b : cB;
        const int nt = cur.nt;
        for (int t = 0; t < nt; t += 2) {
            const bool last = (t == nt - 2);
            const char* a1 = cA + (size_t)(t + 1) * kstep;
            const char* a2 = last ? nA : cA + (size_t)(t + 2) * kstep; const char* b2 = last ? nB : cB + (size_t)(t + 2) * kstep;
            const char* a3 = a2 + kstep; const char* b3 = b2 + kstep;
            if constexpr (SP2) {
            PG8_LDB(B0, 0, 0); PG8_LDB(B1, 0, 1); PG8_SCHED; PG8_LDA(At, 0, 0); PG8_STAGE(PG8_SA(1, 1), a1 + hstepA, voffA);
            PG8_WAIT_V(8); PG8_WAIT_L(0); PG8_BAR; PG8_MMA(0, 0, At, B0); PG8_MMA(0, 1, At, B1); PG8_BAR; PG8_SCHED;
            PG8_LDA(At, 0, 1); PG8_STAGE(PG8_SB(0, 0), b2, voffB); PG8_STAGE(PG8_SB(0, 1), b2 + hstepB, voffB); PG8_STAGE(PG8_SA(0, 0), a2, voffA);
            PG8_WAIT_V(8); PG8_WAIT_L(0); PG8_BAR; PG8_MMA(1, 0, At, B0); PG8_MMA(1, 1, At, B1); PG8_BAR; PG8_SCHED;
            PG8_LDB(B0, 1, 0); PG8_LDB(B1, 1, 1); PG8_SCHED; PG8_LDA(At, 1, 0); PG8_STAGE(PG8_SA(0, 1), a2 + hstepA, voffA);
            PG8_WAIT_V(8); PG8_WAIT_L(0); PG8_BAR; PG8_MMA(0, 0, At, B0); PG8_MMA(0, 1, At, B1); PG8_BAR; PG8_SCHED;
            PG8_LDA(At, 1, 1); PG8_STAGE(PG8_SB(1, 0), b3, voffB); PG8_STAGE(PG8_SB(1, 1), b3 + hstepB, voffB); PG8_STAGE(PG8_SA(1, 0), a3, voffA);
            PG8_WAIT_V(8); PG8_WAIT_L(0); PG8_BAR; PG8_MMA(1, 0, At, B0); PG8_MMA(1, 1, At, B1); PG8_BAR; PG8_SCHED;
            } else {
            PG8_LDB(B0, 0, 0); PG8_SCHED; PG8_LDA(At, 0, 0); PG8_STAGE(PG8_SA(1, 1), a1 + hstepA, voffA);
            PG8_WAIT_L(8); PG8_BAR; PG8_WAIT_L(0); PG8_MMA(0, 0, At, B0); PG8_BAR; PG8_SCHED;
            PG8_LDB(B1, 0, 1); PG8_STAGE(PG8_SB(0, 0), b2, voffB);
            PG8_BAR; PG8_WAIT_L(0); PG8_MMA(0, 1, At, B1); PG8_BAR;
            PG8_LDA(At, 0, 1); PG8_STAGE(PG8_SA(0, 0), a2, voffA);
            PG8_BAR; PG8_WAIT_L(0); PG8_MMA(1, 0, At, B0); PG8_BAR; PG8_SCHED;
            PG8_STAGE(PG8_SB(0, 1), b2 + hstepB, voffB);
            PG8_WAIT_V(6); PG8_BAR; PG8_MMA(1, 1, At, B1); PG8_BAR;
            PG8_LDB(B0, 1, 0); PG8_SCHED; PG8_LDA(At, 1, 0); PG8_STAGE(PG8_SA(0, 1), a2 + hstepA, voffA);
            PG8_WAIT_L(8); PG8_BAR; PG8_WAIT_L(0); PG8_MMA(0, 0, At, B0); PG8_BAR; PG8_SCHED;
            PG8_LDB(B1, 1, 1); PG8_STAGE(PG8_SB(1, 0), b3, voffB);
            PG8_BAR; PG8_WAIT_L(0); PG8_MMA(0, 1, At, B1); PG8_BAR;
            PG8_LDA(At, 1, 1); PG8_STAGE(PG8_SA(1, 0), a3, voffA);
            PG8_BAR; PG8_WAIT_L(0); PG8_MMA(1, 0, At, B0); PG8_BAR; PG8_SCHED;
            PG8_STAGE(PG8_SB(1, 1), b3 + hstepB, voffB);
            PG8_WAIT_V(6); PG8_BAR; PG8_MMA(1, 1, At, B1); PG8_BAR;
            }
        }
        if constexpr (ALIGN_EPI) { if (wr == 0) PG8_BAR; }
        bool keep; { int ln; asm volatile("v_mbcnt_lo_u32_b32 %0, -1, 0\n\tv_mbcnt_hi_u32_b32 %0, -1, %0" : "=v"(ln)); keep = E(acc, cur, wr, wc, ln & 15, ln >> 4); }
        if (!has_next) break;
        if (!keep)
#pragma unroll
        for (int a = 0; a < 2; ++a)
#pragma unroll
            for (int b = 0; b < 2; ++b)
#pragma unroll
                for (int m = 0; m < 4; ++m)
#pragma unroll
                    for (int n = 0; n < 2; ++n) acc[a][b][m][n] = (f32x4){0.f, 0.f, 0.f, 0.f};
        cur = nxt; cA = nA; cB = nB; ++ui;
        if constexpr (ALIGN_EPI) { if (wr == 1) PG8_BAR; }
    }
    PG8_WAIT_V(0);
    if constexpr (!ALIGN_EPI) { if (wr == 0) PG8_BAR; }
    PG8_BAR;
#undef PG8_SA
#undef PG8_SB
#undef PG8_STAGE
#undef PG8_LDA
#undef PG8_LDB
#undef PG8_MMA
#undef PG8_WAIT_V
#undef PG8_WAIT_L
#undef PG8_BAR
#undef PG8_SCHED
}

__device__ __forceinline__ float fsigmoid(float x) { return __builtin_amdgcn_rcpf(1.f + __expf(-x)); }
struct EpiZ {
    static constexpr bool PERM = true;
    bf16* Z;
    __device__ __forceinline__ bool operator()(f32x4 (&acc)[2][2][4][2], const Unit& u, int wr, int wc, int fr, int fq) const {
        const int row0 = u.pm * BM + wr * 64 + fr, col0 = u.pn * BM + wc * 32 + 8 * fq;
        const int ty = u.pn >= 30 ? 2 : (u.pn >= 26 ? 1 : 0);
        if (u.pn >= 6 && u.pn < 14) {
            const int colg = ZCA + (u.pn - 6) * 128 + wc * 32 + 8 * fq;
#pragma unroll
            for (int ai = 0; ai < 2; ++ai)
#pragma unroll
                for (int m = 0; m < 4; ++m) { f32x4 a0 = acc[ai][0][m][0], a1 = acc[ai][0][m][1]; const f32x4 g0 = acc[ai][1][m][0], g1 = acc[ai][1][m][1];
#pragma unroll
                    for (int j = 0; j < 4; ++j) { a0[j] = a0[j] * fsigmoid(g0[j]); a1[j] = a1[j] * fsigmoid(g1[j]); }
                    u32x4 w; w.x = cvt_pk_bf16(a0[0], a0[1]); w.y = cvt_pk_bf16(a0[2], a0[3]); w.z = cvt_pk_bf16(a1[0], a1[1]); w.w = cvt_pk_bf16(a1[2], a1[3]);
                    *(u32x4*)(Z + (size_t)(row0 + ai * HALF + m * 16) * ZW + colg) = w; }
            return false;
        }
#pragma unroll
        for (int ai = 0; ai < 2; ++ai)
#pragma unroll
            for (int m = 0; m < 4; ++m) { bf16* rowp = Z + (size_t)(row0 + ai * HALF + m * 16) * ZW + col0;
#pragma unroll
                for (int bj = 0; bj < 2; ++bj) { f32x4 v0 = acc[ai][bj][m][0], v1 = acc[ai][bj][m][1];
                    if (ty == 2) {
#pragma unroll
                        for (int j = 0; j < 4; ++j) { v0[j] = fsigmoid(v0[j]); v1[j] = fsigmoid(v1[j]); } }
                    else if (ty == 1) {
#pragma unroll
                        for (int j = 0; j < 4; ++j) { v0[j] = v0[j] * fsigmoid(v0[j]); v1[j] = v1[j] * fsigmoid(v1[j]); } }
                    u32x4 w; w.x = cvt_pk_bf16(v0[0], v0[1]); w.y = cvt_pk_bf16(v0[2], v0[3]); w.z = cvt_pk_bf16(v1[0], v1[1]); w.w = cvt_pk_bf16(v1[2], v1[3]);
                    *(u32x4*)(rowp + bj * HALF) = w; } }
        return false;
    }
};
struct EpiMlp1 {
    static constexpr bool PERM = true;
    bf16* O; float* SLAB;
    __device__ __forceinline__ bool operator()(f32x4 (&acc)[2][2][4][2], const Unit& u, int wr, int wc, int fr, int fq) const {
        const int row0 = u.pm * BM + wr * 64 + fr, col0 = u.pn * BM + wc * 32 + 8 * fq;
        if (u.pm == MP / BM) { float* sl = SLAB + ((size_t)u.ks * BM + wr * 64 + fr) * DFF + col0;
#pragma unroll
            for (int ai = 0; ai < 2; ++ai)
#pragma unroll
                for (int m = 0; m < 4; ++m)
#pragma unroll
                    for (int bj = 0; bj < 2; ++bj) { float* p = sl + (size_t)(ai * HALF + m * 16) * DFF + bj * HALF; *(f32x4*)p = acc[ai][bj][m][0]; *(f32x4*)(p + 4) = acc[ai][bj][m][1]; }
            return false; }
#pragma unroll
        for (int ai = 0; ai < 2; ++ai)
#pragma unroll
            for (int m = 0; m < 4; ++m) { bf16* rowp = O + (size_t)(row0 + ai * HALF + m * 16) * DFF + col0;
#pragma unroll
                for (int bj = 0; bj < 2; ++bj) { f32x4 v0 = acc[ai][bj][m][0], v1 = acc[ai][bj][m][1];
#pragma unroll
                    for (int j = 0; j < 4; ++j) { const float a = fmaxf(v0[j], 0.f), b = fmaxf(v1[j], 0.f); v0[j] = a * a; v1[j] = b * b; }
                    u32x4 w; w.x = cvt_pk_bf16(v0[0], v0[1]); w.y = cvt_pk_bf16(v0[2], v0[3]); w.z = cvt_pk_bf16(v1[0], v1[1]); w.w = cvt_pk_bf16(v1[2], v1[3]);
                    *(u32x4*)(rowp + bj * HALF) = w; } }
        return false;
    }
};
struct EpiPool {
    static constexpr bool PERM = true;
    bf16* Y2; const float* spb; int l;
    __device__ __forceinline__ bool operator()(f32x4 (&acc)[2][2][4][2], const Unit& u, int wr, int wc, int fr, int fq) const {
        const int row0 = u.pm * BM + wr * 64 + fr, col0 = u.pn * BM + wc * 32 + 8 * fq;
        int le = l; asm volatile("" : "+s"(le)); const float* sp = spb + le * BRW;
        f32x4 s[2][2];
#pragma unroll
        for (int bj = 0; bj < 2; ++bj)
#pragma unroll
            for (int n = 0; n < 2; ++n) s[bj][n] = *(const f32x4*)(sp + col0 + bj * HALF + 4 * n);
#pragma unroll
        for (int ai = 0; ai < 2; ++ai)
#pragma unroll
            for (int m = 0; m < 4; ++m) { bf16* rowp = Y2 + (size_t)(row0 + ai * HALF + m * 16) * BRW + col0;
#pragma unroll
                for (int bj = 0; bj < 2; ++bj) { const f32x4 v0 = acc[ai][bj][m][0] * s[bj][0], v1 = acc[ai][bj][m][1] * s[bj][1];
                    u32x4 w; w.x = cvt_pk_bf16(v0[0], v0[1]); w.y = cvt_pk_bf16(v0[2], v0[3]); w.z = cvt_pk_bf16(v1[0], v1[1]); w.w = cvt_pk_bf16(v1[2], v1[3]);
                    *(u32x4*)(rowp + bj * HALF) = w; } }
        return false;
    }
};
struct EpiAda {
    static constexpr bool PERM = false;
    float* ADA; const float* bada;
    __device__ __forceinline__ bool operator()(f32x4 (&acc)[2][2][4][2], const Unit& u, int wr, int wc, int fr, int fq) const {
        if (wr != 0) return false;
        const int col0 = u.pn * BM + wc * 32 + 4 * fq;
#pragma unroll
        for (int m = 0; m < 3; ++m) { const int row = m * 16 + fr;
            if (row < NROWB) {
#pragma unroll
                for (int bj = 0; bj < 2; ++bj)
#pragma unroll
                    for (int n = 0; n < 2; ++n) { const int c = col0 + bj * HALF + n * 16; const f32x4 bv = *(const f32x4*)(bada + (size_t)u.r * ADAW + c);
                        *(f32x4*)(ADA + ((size_t)u.r * NROWB + row) * ADAW + c) = acc[0][bj][m][n] + bv; } } }
        return false;
    }
};
struct EpiBr {
    static constexpr bool PERM = true;
    const bf16* Z; bf16* MERGED; float* SLAB; int KS;
    static __device__ __forceinline__ void unp8(const u32x4 gw, f32x4& g0, f32x4& g1) { const float T = 8.6736174e-19f;
        g0[0] = fmaxf(__builtin_bit_cast(float, gw.x << 16), T); g0[1] = fmaxf(__builtin_bit_cast(float, gw.x & 0xffff0000u), T); g0[2] = fmaxf(__builtin_bit_cast(float, gw.y << 16), T); g0[3] = fmaxf(__builtin_bit_cast(float, gw.y & 0xffff0000u), T);
        g1[0] = fmaxf(__builtin_bit_cast(float, gw.z << 16), T); g1[1] = fmaxf(__builtin_bit_cast(float, gw.z & 0xffff0000u), T); g1[2] = fmaxf(__builtin_bit_cast(float, gw.w << 16), T); g1[3] = fmaxf(__builtin_bit_cast(float, gw.w & 0xffff0000u), T); }
    __device__ __forceinline__ bool operator()(f32x4 (&acc)[2][2][4][2], const Unit& u, int wr, int wc, int fr, int fq) const {
        const int row0 = u.pm * BM + wr * 64 + fr, col0 = u.pn * BM + wc * 32 + 8 * fq;
        const int r = u.r; const bool smp = u.pm == MP / BM;
        const bf16* gbase = Z + (size_t)row0 * ZW + ZGT + r * DM + col0;
#pragma unroll
        for (int ai = 0; ai < 2; ++ai) {
            u32x4 ga[4][2], gb[4][2];
#pragma unroll
            for (int m = 0; m < 4; ++m)
#pragma unroll
                for (int bj = 0; bj < 2; ++bj) { const bf16* gp = gbase + (size_t)(ai * HALF + m * 16) * ZW + bj * HALF; ga[m][bj] = *(const u32x4*)gp; gb[m][bj] = *(const u32x4*)(gp + DM); }
            asm volatile("" ::: "memory");
#pragma unroll
            for (int m = 0; m < 4; ++m)
#pragma unroll
                for (int bj = 0; bj < 2; ++bj) { const size_t row = (size_t)(row0 + ai * HALF + m * 16); const int c = col0 + bj * HALF;
                    f32x4 g0, g1; unp8(ga[m][bj], g0, g1);
                    if (smp) { float* sp = SLAB + ((size_t)(r * KS + u.ks) * BM + (row - MP)) * DM + c; *(f32x4*)sp = acc[ai][bj][m][0] * g0; *(f32x4*)(sp + 4) = acc[ai][bj][m][1] * g1; }
                    else if (r < 3) { f32x4 n0, n1; unp8(gb[m][bj], n0, n1);
#pragma unroll
                        for (int j = 0; j < 4; ++j) { acc[ai][bj][m][0][j] *= g0[j] * __builtin_amdgcn_rcpf(n0[j]); acc[ai][bj][m][1][j] *= g1[j] * __builtin_amdgcn_rcpf(n1[j]); } }
                    else { const f32x4 v0 = acc[ai][bj][m][0] * g0, v1 = acc[ai][bj][m][1] * g1;
                        u32x4 w; w.x = cvt_pk_bf16(v0[0], v0[1]); w.y = cvt_pk_bf16(v0[2], v0[3]); w.z = cvt_pk_bf16(v1[0], v1[1]); w.w = cvt_pk_bf16(v1[2], v1[3]);
                        *(u32x4*)(MERGED + row * DM + c) = w; } }
        }
        return !smp && r < 3;
    }
};
struct EpiRes {
    static constexpr bool PERM = true;
    const void* baseP; void* out; bool baseBf, outBf; const float* gate; float* SLAB;
    __device__ __forceinline__ bool operator()(f32x4 (&acc)[2][2][4][2], const Unit& u, int wr, int wc, int fr, int fq) const {
        const int rl0 = wr * 64 + fr, col0 = u.pn * BM + wc * 32 + 8 * fq;
        const bool smp = u.pm >= MP / BM;
        if (smp) { float* sl = SLAB + ((size_t)u.ks * BM + rl0) * DM + col0;
#pragma unroll
            for (int ai = 0; ai < 2; ++ai)
#pragma unroll
                for (int m = 0; m < 4; ++m)
#pragma unroll
                    for (int bj = 0; bj < 2; ++bj)
#pragma unroll
                        for (int n = 0; n < 2; ++n) *(f32x4*)(sl + (size_t)(ai * HALF + m * 16) * DM + bj * HALF + n * 4) = acc[ai][bj][m][n];
            return false; }
        const size_t e0 = (size_t)u.pm * BM * DM + (size_t)rl0 * DM + col0;
        const float* gp = gate + (size_t)(u.pm >> 4) * ADAW + col0;
        f32x4 gv[2][2];
#pragma unroll
        for (int bj = 0; bj < 2; ++bj)
#pragma unroll
            for (int n = 0; n < 2; ++n) gv[bj][n] = *(const f32x4*)(gp + bj * HALF + n * 4);
#pragma unroll
        for (int ai = 0; ai < 2; ++ai) {
            f32x4 bs[4][2][2];
            if (baseBf) {
#pragma unroll
                for (int m = 0; m < 4; ++m)
#pragma unroll
                    for (int bj = 0; bj < 2; ++bj) { const u32x4 w = *(const u32x4*)((const bf16*)baseP + e0 + (size_t)(ai * HALF + m * 16) * DM + bj * HALF); const unsigned w0 = w.x, w1 = w.y, w2 = w.z, w3 = w.w;
                        bs[m][bj][0] = f32x4{__builtin_bit_cast(float, w0 << 16), __builtin_bit_cast(float, w0 & 0xffff0000u), __builtin_bit_cast(float, w1 << 16), __builtin_bit_cast(float, w1 & 0xffff0000u)};
                        bs[m][bj][1] = f32x4{__builtin_bit_cast(float, w2 << 16), __builtin_bit_cast(float, w2 & 0xffff0000u), __builtin_bit_cast(float, w3 << 16), __builtin_bit_cast(float, w3 & 0xffff0000u)}; }
            } else {
#pragma unroll
                for (int m = 0; m < 4; ++m)
#pragma unroll
                    for (int bj = 0; bj < 2; ++bj)
#pragma unroll
                        for (int n = 0; n < 2; ++n) bs[m][bj][n] = *(const f32x4*)((const float*)baseP + e0 + (size_t)(ai * HALF + m * 16) * DM + bj * HALF + n * 4);
            }
            asm volatile("" ::: "memory");
#pragma unroll
            for (int m = 0; m < 4; ++m)
#pragma unroll
                for (int bj = 0; bj < 2; ++bj) { const f32x4 y0 = bs[m][bj][0] + gv[bj][0] * acc[ai][bj][m][0], y1 = bs[m][bj][1] + gv[bj][1] * acc[ai][bj][m][1];
                    if (outBf) { u32x4 w; w.x = cvt_pk_bf16(y0[0], y0[1]); w.y = cvt_pk_bf16(y0[2], y0[3]); w.z = cvt_pk_bf16(y1[0], y1[1]); w.w = cvt_pk_bf16(y1[2], y1[3]);
                        *(u32x4*)((bf16*)out + e0 + (size_t)(ai * HALF + m * 16) * DM + bj * HALF) = w; }
                    else { float* o = (float*)out + e0 + (size_t)(ai * HALF + m * 16) * DM + bj * HALF; *(f32x4*)o = y0; *(f32x4*)(o + 4) = y1; } }
        }
        return false;
    }
};
}

constexpr int NWAVES = 8, NTHR = NWAVES * 64;
constexpr size_t MiB = 1u << 20;
constexpr size_t al1(size_t x) { return (x + MiB - 1) / MiB * MiB; }
constexpr size_t WS_CTL = 0, CTL_ZERO_BYTES = 1 * MiB;
constexpr size_t WS_WIN = WS_CTL + CTL_ZERO_BYTES;
constexpr size_t WS_WBR = WS_WIN + al1((size_t)DEPTH * ZW * DM * 2);
constexpr size_t WS_WOUT = WS_WBR + al1((size_t)DEPTH * 4 * DM * BRW * 2);
constexpr size_t WS_WM1 = WS_WOUT + al1((size_t)DEPTH * DM * DM * 2);
constexpr size_t WS_WM2 = WS_WM1 + al1((size_t)DEPTH * DFF * DM * 2);
constexpr size_t WS_WPOOL = WS_WM2 + al1((size_t)DEPTH * DFF * DM * 2);
constexpr size_t WS_WADA = WS_WPOOL + al1((size_t)DEPTH * 4 * 256 * 256 * 2);
constexpr size_t WS_SC = WS_WADA + al1((size_t)DEPTH * ADAW * DM * 2);
constexpr size_t WS_ADA = WS_SC + al1((size_t)256 * DM * 2);
constexpr size_t WS_H = WS_ADA + al1((size_t)DEPTH * NROWB * ADAW * 4);
constexpr size_t WS_Z = WS_H + al1((size_t)M * DM * 2);
constexpr size_t WS_Y = WS_Z + al1((size_t)M * ZW * 2);
constexpr size_t WS_ZP = WS_Y + al1((size_t)4 * M * BRW * 2);
constexpr size_t WS_CONVY = WS_ZP + al1((size_t)M * BRW * 2);
constexpr size_t WS_ORAW = WS_CONVY + al1((size_t)M * BRW * 4);
constexpr size_t WS_KV = WS_ORAW + al1((size_t)M * BRW * 4);
constexpr size_t WS_SPREV = WS_KV + al1((size_t)NBP * 32 * RH * RDK * RDV * 4);
constexpr size_t WS_MACC = WS_SPREV + al1((size_t)NBP * 32 * RH * RDK * RDV * 4);
constexpr size_t WS_MERGED = WS_MACC + al1((size_t)M * DM * 4);
constexpr size_t WS_X1 = WS_MERGED + al1((size_t)M * DM * 2);
constexpr size_t WS_X = WS_X1 + al1((size_t)M * DM * 4);
constexpr size_t WS_HID = WS_X + al1((size_t)M * DM * 4);
constexpr size_t WS_SLAB = WS_HID + al1((size_t)M * DFF * 2);
constexpr size_t WS_END = WS_SLAB + al1((size_t)16 * MS * DM * 4);
constexpr int CW_BAR = 4096;
constexpr int RING_OFF = 0, RING_BYTES = 131072, LDSCTL_OFF = RING_BYTES, MISC_OFF = LDSCTL_OFF + 320, INTAB_OFF = MISC_OFF + 128, LDS_BYTES = 147456;

#define GAS __attribute__((address_space(1)))
#define LAS __attribute__((address_space(3)))
typedef unsigned v4u __attribute__((ext_vector_type(4)));
typedef float f32x4 __attribute__((ext_vector_type(4)));
typedef GAS unsigned gu32;
#define RLX_AGENT __ATOMIC_RELAXED, __HIP_MEMORY_SCOPE_AGENT
#define LDS_WAIT() asm volatile("s_waitcnt lgkmcnt(0)" ::: "memory")
__device__ __forceinline__ unsigned pk2(float lo, float hi) { return (unsigned)f2bf(lo) | ((unsigned)f2bf(hi) << 16); }

#define XB_TMO      128
#define XB_XCNT(j)  (256  + 64 * (j))
#define XB_XSUB(j)  (1280 + 64 * (j))
#define XB_XGEN(j)  (2304 + 64 * (j))
#define XB_TOP      3328
#define XB_TOPGEN   3392
#define XCD_BAR_WORDS 3456
#define XB_SPIN_CAP (1u << 18)
__device__ __forceinline__ unsigned xb_ld(unsigned* p)              { return __hip_atomic_load(p, __ATOMIC_RELAXED, __HIP_MEMORY_SCOPE_AGENT); }
__device__ __forceinline__ unsigned xb_add(unsigned* p, unsigned v) { return __hip_atomic_fetch_add(p, v, __ATOMIC_RELAXED, __HIP_MEMORY_SCOPE_AGENT); }
__device__ __forceinline__ unsigned xb_xcc_id() { return (unsigned)__builtin_amdgcn_s_getreg((3 << 11) | 20) & 0xFu; }
#define XB_SPIN(cond, bar) do { unsigned _sp = 0; while (cond) { __builtin_amdgcn_s_sleep(1); \
    if ((++_sp & 255u) == 0u) { if (xb_ld(&(bar)[XB_TMO])) break; if (_sp > XB_SPIN_CAP) { atomicAdd(&(bar)[XB_TMO], 1u); break; } } } } while (0)
struct XcdBarrier { unsigned* bar; unsigned x; volatile LAS unsigned* st; };
__device__ __forceinline__ XcdBarrier xcd_barrier_post(unsigned* bar, volatile LAS unsigned* st) {
    XcdBarrier b; b.bar = bar; b.x = xb_xcc_id(); b.st = st;
    if (threadIdx.x == 0) (void)xb_add(&bar[XB_XCNT(b.x)], 1u);
    return b;
}
__device__ __forceinline__ void xcd_barrier_complete(unsigned* bar, unsigned x, unsigned& nloc, unsigned& nx) {
    const unsigned G = gridDim.x * gridDim.y * gridDim.z;
    unsigned sum, cnt, mine, sp = 0u;
    for (;;) {
        sum = 0u; cnt = 0u; mine = 0u;
#pragma unroll
        for (unsigned j = 0; j < 16; ++j) { const unsigned c = xb_ld(&bar[XB_XCNT(j)]); sum += c; cnt += (c > 0u) ? 1u : 0u; mine = (j == x) ? c : mine; }
        if (sum == G) break;
        __builtin_amdgcn_s_sleep(1);
        if ((++sp & 255u) == 0u) { if (xb_ld(&bar[XB_TMO])) break; if (sp > XB_SPIN_CAP) { atomicAdd(&bar[XB_TMO], 1u); break; } }
    }
    nloc = mine > 0u ? mine : 1u; nx = cnt > 0u ? cnt : 1u;
}
__device__ __forceinline__ void xcd_barrier(const XcdBarrier& b) {
    asm volatile("s_waitcnt vmcnt(0)" ::: "memory");
    __syncthreads();
    if (threadIdx.x == 0) {
        unsigned* bar = b.bar;
        __builtin_amdgcn_s_waitcnt(0);
        unsigned nloc = b.st[0], nx = b.st[1];
        if (nloc == 0u) { xcd_barrier_complete(bar, b.x, nloc, nx); b.st[0] = nloc; b.st[1] = nx; }
        const unsigned old = xb_add(&bar[XB_XSUB(b.x)], 1u);
        const unsigned gen = old / nloc;
        if (old + 1u == (gen + 1u) * nloc) {
            __builtin_amdgcn_fence(__ATOMIC_RELEASE, "agent");
            asm volatile("s_waitcnt vmcnt(0)" ::: "memory");
            const unsigned og = xb_add(&bar[XB_TOP], 1u);
            const unsigned tg = og / nx;
            if (og + 1u == (tg + 1u) * nx) xb_add(&bar[XB_TOPGEN], 1u);
            else XB_SPIN(xb_ld(&bar[XB_TOPGEN]) == tg, bar);
            __builtin_amdgcn_fence(__ATOMIC_ACQUIRE, "agent");
            xb_add(&bar[XB_XGEN(b.x)], 1u);
            asm volatile("s_waitcnt vmcnt(0)" ::: "memory");
        } else {
            XB_SPIN(xb_ld(&bar[XB_XGEN(b.x)]) == gen, bar);
            __builtin_amdgcn_fence(__ATOMIC_ACQUIRE, "agent");
            asm volatile("s_waitcnt vmcnt(0)" ::: "memory");
        }
    }
    __syncthreads();
}

template <int CTRL> __device__ __forceinline__ float dpp_f(float v) { return __builtin_bit_cast(float, __builtin_amdgcn_update_dpp(0, __builtin_bit_cast(int, v), CTRL, 0xf, 0xf, false)); }
__device__ __forceinline__ float wave_sum(float v) {
    v += dpp_f<0xB1>(v);
    v += dpp_f<0x4E>(v);
    v += dpp_f<0x141>(v);
    v += dpp_f<0x140>(v);
    v += __builtin_bit_cast(float, __builtin_amdgcn_ds_swizzle(__builtin_bit_cast(int, v), 0x401F));
    return __builtin_bit_cast(float, __builtin_amdgcn_readlane(__builtin_bit_cast(int, v), 0)) + __builtin_bit_cast(float, __builtin_amdgcn_readlane(__builtin_bit_cast(int, v), 32));
}
typedef float tr_f32x4 __attribute__((ext_vector_type(4)));
#define TR_LOAD(V, P) _Pragma("unroll") for (int j = 0; j < 8; ++j) V[j] = __builtin_nontemporal_load((const GAS tr_f32x4*)((P) + (size_t)j * N))
#define TR_STORE(V, Q) _Pragma("unroll") for (int i = 0; i < 4; ++i) { v4u o; o.x = pk2(V[0][i], V[1][i]); o.y = pk2(V[2][i], V[3][i]); o.z = pk2(V[4][i], V[5][i]); o.w = pk2(V[6][i], V[7][i]); __builtin_nontemporal_store(o, (GAS v4u*)((Q) + (size_t)i * K)); }
template <int K, int N, bool GLUPERM = false>
__device__ __forceinline__ void transpose_run(const float* W, bf16* T, int nmat, int gw, int NGW, int lane, int i0 = 0, int i1 = -1) {
    constexpr int NB = N / 32, IPM = (K / 64) * NB; const int total = nmat * IPM, end = i1 < 0 ? total : i1;
    const unsigned lo_p = (unsigned)(8 * (lane >> 3)) * N + 4 * (lane & 7), lo_q = (unsigned)(4 * (lane & 7)) * K + 8 * (lane >> 3);
    auto addr = [&](int it, const float*& p, bf16*& q) { it = it < total ? it : total - 1; const int mi = it / IPM, r = it % IPM, kb = r / NB, nb = r % NB;
        p = W + ((size_t)mi * K * N + (size_t)(64 * kb) * N + 32 * nb) + lo_p;
        int n0 = 32 * nb;
        if (GLUPERM) { if (n0 >= ZCA && n0 < ZCA + BRW) { const int c = n0 - ZCA; n0 = ZCA + 256 * (c >> 7) + (c & 127); } else if (n0 >= ZCG && n0 < ZCG + BRW) { const int c = n0 - ZCG; n0 = ZCA + 256 * (c >> 7) + 128 + (c & 127); } }
        q = T + ((size_t)mi * K * N + (size_t)n0 * K + 64 * kb) + lo_q; };
    int it = i0 + gw; if (it >= end) return;
    tr_f32x4 va[8], vb[8]; const float *pa, *pb; bf16 *qa, *qb;
    addr(it, pa, qa); TR_LOAD(va, pa);
    for (;;) {
        const int j1 = it + NGW; addr(j1, pb, qb); TR_LOAD(vb, pb);
        asm volatile("" ::: "memory"); TR_STORE(va, qa); asm volatile("" ::: "memory");
        if (j1 >= end) break;
        const int j2 = j1 + NGW; addr(j2, pa, qa); TR_LOAD(va, pa);
        asm volatile("" ::: "memory"); TR_STORE(vb, qb); asm volatile("" ::: "memory");
        if (j2 >= end) break;
        it = j2; }
}
__device__ __forceinline__ void load_mod(const float* g, const float* sc, const float* shp, f32x4 (&gm)[8], f32x4 (&sh)[8], int lane) {
#pragma unroll
    for (int jj = 0; jj < 4; ++jj)
#pragma unroll
        for (int e = 0; e < 2; ++e) { const int q = 2 * (lane + 64 * jj) + e; gm[2 * jj + e] = ((const f32x4*)g)[q] * (((const f32x4*)sc)[q] + 1.f); sh[2 * jj + e] = ((const f32x4*)shp)[q]; }
}
template <bool BF> __device__ __forceinline__ void load_row8(const void* x, f32x4 (&v)[8], int lane) {
#pragma unroll
    for (int jj = 0; jj < 4; ++jj) {
        if (BF) { const v4u w = ((const v4u*)x)[lane + 64 * jj]; const unsigned w0 = w.x, w1 = w.y, w2 = w.z, w3 = w.w;
            v[2 * jj] = f32x4{__builtin_bit_cast(float, w0 << 16), __builtin_bit_cast(float, w0 & 0xffff0000u), __builtin_bit_cast(float, w1 << 16), __builtin_bit_cast(float, w1 & 0xffff0000u)};
            v[2 * jj + 1] = f32x4{__builtin_bit_cast(float, w2 << 16), __builtin_bit_cast(float, w2 & 0xffff0000u), __builtin_bit_cast(float, w3 << 16), __builtin_bit_cast(float, w3 & 0xffff0000u)}; }
        else { v[2 * jj] = ((const f32x4*)x)[2 * (lane + 64 * jj)]; v[2 * jj + 1] = ((const f32x4*)x)[2 * (lane + 64 * jj) + 1]; } }
}
__device__ __forceinline__ float sumsq8(const f32x4 (&v)[8]) { float s = 0.f;
#pragma unroll
    for (int j = 0; j < 8; ++j) s += (v[j].x * v[j].x + v[j].y * v[j].y) + (v[j].z * v[j].z + v[j].w * v[j].w);
    return s; }
__device__ __forceinline__ void norm_store(const f32x4 (&v)[8], float ss, const f32x4 (&gm)[8], const f32x4 (&sh)[8], bf16* orow, int lane) {
    const float rstd = 1.f / sqrtf(wave_sum(ss) * (1.f / DM) + EPS);
#pragma unroll
    for (int jj = 0; jj < 4; ++jj) { const f32x4 y0 = v[2 * jj] * rstd * gm[2 * jj] + sh[2 * jj], y1 = v[2 * jj + 1] * rstd * gm[2 * jj + 1] + sh[2 * jj + 1];
        v4u o; o.x = pk2(y0.x, y0.y); o.y = pk2(y0.z, y0.w); o.z = pk2(y1.x, y1.y); o.w = pk2(y1.z, y1.w);
        ((v4u*)orow)[lane + 64 * jj] = o; }
}
template <bool BF> __device__ __forceinline__ void norm_row2(const void* xa, const void* xb, const f32x4 (&gm)[8], const f32x4 (&sh)[8], bf16* oa, bf16* ob, int lane) {
    f32x4 va[8], vb[8]; load_row8<BF>(xa, va, lane); load_row8<BF>(xb, vb, lane);
    const float sa = sumsq8(va), sb = sumsq8(vb);
    norm_store(va, sa, gm, sh, oa, lane); norm_store(vb, sb, gm, sh, ob, lane);
}
template <bool BF> __device__ __forceinline__ void norm_row(const void* xrow, const f32x4 (&gm)[8], const f32x4 (&sh)[8], bf16* orow, int lane) {
    f32x4 v[8]; load_row8<BF>(xrow, v, lane);
    norm_store(v, sumsq8(v), gm, sh, orow, lane);
}
template <int NP> __device__ __forceinline__ void norm_row_block(const float* base, const float* gate, const float* slab, size_t ps, float* xdst, const float* g, const float* sc, const float* shp, bf16* orow, LAS float* red, int tid, int wave) {
    f32x4 v = ((const f32x4*)base)[tid];
    if (NP > 0) { f32x4 pv[NP > 0 ? NP : 1];
#pragma unroll
        for (int p = 0; p < NP; ++p) pv[p] = ((const f32x4*)(slab + (size_t)p * ps))[tid];
        f32x4 a = pv[0];
#pragma unroll
        for (int p = 1; p < NP; ++p) a += pv[p];
        v += ((const f32x4*)gate)[tid] * a; ((f32x4*)xdst)[tid] = v; }
    const float ws = wave_sum((v.x * v.x + v.y * v.y) + (v.z * v.z + v.w * v.w));
    if ((tid & 63) == 0) red[wave] = ws;
    __syncthreads();
    float ss = 0.f;
#pragma unroll
    for (int w = 0; w < NWAVES; ++w) ss += red[w];
    const float rstd = 1.f / sqrtf(ss * (1.f / DM) + EPS);
    const f32x4 y = v * rstd * ((const f32x4*)g)[tid] * (((const f32x4*)sc)[tid] + 1.f) + ((const f32x4*)shp)[tid];
    ((unsigned long long*)orow)[tid] = (unsigned long long)pk2(y.x, y.y) | ((unsigned long long)pk2(y.z, y.w) << 32);
    __syncthreads();
}
template <int NR> __device__ __forceinline__ void convln_rows(const bf16* const (&yrow)[NR], const f32x4 (&gv4)[4], const f32x4 (&bv4)[4], bf16* const (&orow)[NR], int lane) {
    f32x4 v[NR][4]; float s[NR];
#pragma unroll
    for (int r = 0; r < NR; ++r)
#pragma unroll
        for (int jj = 0; jj < 2; ++jj) { const v4u w = ((const v4u*)yrow[r])[lane + 64 * jj]; const unsigned w0 = w.x, w1 = w.y, w2 = w.z, w3 = w.w;
            v[r][2 * jj] = f32x4{__builtin_bit_cast(float, w0 << 16), __builtin_bit_cast(float, w0 & 0xffff0000u), __builtin_bit_cast(float, w1 << 16), __builtin_bit_cast(float, w1 & 0xffff0000u)};
            v[r][2 * jj + 1] = f32x4{__builtin_bit_cast(float, w2 << 16), __builtin_bit_cast(float, w2 & 0xffff0000u), __builtin_bit_cast(float, w3 << 16), __builtin_bit_cast(float, w3 & 0xffff0000u)}; }
#pragma unroll
    for (int r = 0; r < NR; ++r) { s[r] = 0.f;
#pragma unroll
        for (int j = 0; j < 4; ++j) s[r] += (v[r][j].x + v[r][j].y) + (v[r][j].z + v[r][j].w); }
#pragma unroll
    for (int r = 0; r < NR; ++r) { const float mean = wave_sum(s[r]) * (1.f / BRW); float q = 0.f;
#pragma unroll
        for (int j = 0; j < 4; ++j) { v[r][j] = v[r][j] - mean; q += (v[r][j].x * v[r][j].x + v[r][j].y * v[r][j].y) + (v[r][j].z * v[r][j].z + v[r][j].w * v[r][j].w); }
        s[r] = q; }
#pragma unroll
    for (int r = 0; r < NR; ++r) { const float rstd = 1.f / sqrtf(wave_sum(s[r]) * (1.f / BRW) + EPS);
#pragma unroll
        for (int jj = 0; jj < 2; ++jj) { f32x4 y0 = v[r][2 * jj] * rstd * gv4[2 * jj] + bv4[2 * jj], y1 = v[r][2 * jj + 1] * rstd * gv4[2 * jj + 1] + bv4[2 * jj + 1];
            y0.x = y0.x * sigmoidf_(y0.x); y0.y = y0.y * sigmoidf_(y0.y); y0.z = y0.z * sigmoidf_(y0.z); y0.w = y0.w * sigmoidf_(y0.w);
            y1.x = y1.x * sigmoidf_(y1.x); y1.y = y1.y * sigmoidf_(y1.y); y1.z = y1.z * sigmoidf_(y1.z); y1.w = y1.w * sigmoidf_(y1.w);
            v4u o; o.x = pk2(y0.x, y0.y); o.y = pk2(y0.z, y0.w); o.z = pk2(y1.x, y1.y); o.w = pk2(y1.z, y1.w);
            ((v4u*)orow[r])[lane + 64 * jj] = o; } }
}


namespace att {
typedef short bf16x8 __attribute__((ext_vector_type(8)));
typedef short s16x4 __attribute__((ext_vector_type(4)));
typedef float f32x4 __attribute__((ext_vector_type(4)));
typedef float f32x2_t __attribute__((ext_vector_type(2))); typedef __bf16 bf16x2_t __attribute__((ext_vector_type(2)));
constexpr int KP = 144, NROWS = 272, K_OFF = 0, V_OFF = NROWS * KP, LDS_NEED = 2 * NROWS * KP;
__device__ __forceinline__ unsigned cvtpk(float lo, float hi) { f32x2_t v = {lo, hi}; bf16x2_t b = __builtin_convertvector(v, bf16x2_t); return __builtin_bit_cast(unsigned, b); }
__device__ __forceinline__ float red4_max(float v) {
    v = fmaxf(v, __builtin_bit_cast(float, __builtin_amdgcn_ds_swizzle(__builtin_bit_cast(int, v), 0x401F)));
    unsigned x = __builtin_bit_cast(unsigned, v), y = x; asm volatile("" : "+v"(y));
    auto rr = __builtin_amdgcn_permlane32_swap(x, y, false, false); const unsigned r0 = rr[0], r1 = rr[1];
    return fmaxf(__builtin_bit_cast(float, r0), __builtin_bit_cast(float, r1)); }
__device__ __forceinline__ float red4_sum(float v) {
    v += __builtin_bit_cast(float, __builtin_amdgcn_ds_swizzle(__builtin_bit_cast(int, v), 0x401F));
    unsigned x = __builtin_bit_cast(unsigned, v), y = x; asm volatile("" : "+v"(y));
    auto rr = __builtin_amdgcn_permlane32_swap(x, y, false, false); const unsigned r0 = rr[0], r1 = rr[1];
    return __builtin_bit_cast(float, r0) + __builtin_bit_cast(float, r1); }
__device__ __forceinline__ s16x4 vtr(const LAS unsigned char* p) { typedef short v4i16_t __attribute__((ext_vector_type(4))); return __builtin_bit_cast(s16x4, __builtin_amdgcn_ds_read_tr16_b64_v4i16((LAS v4i16_t*)p)); }

__device__ __forceinline__ void tile16(const bf16x8 qf0, const bf16x8 qf1, const LAS unsigned char* Ks, const LAS unsigned char* Vs, int kbase, int wpos0, float slope2, float sink2, bf16* Yq, int nst, int lane) {
    const int c = lane & 15, g = lane >> 4;
    f32x4 st[9];
#pragma unroll
    for (int kt = 0; kt < 9; ++kt) { const LAS unsigned char* kp = Ks + (kbase + 16 * kt + c) * KP + 16 * g;
        const bf16x8 k0 = *(const LAS bf16x8*)kp, k1 = *(const LAS bf16x8*)(kp + 64);
        f32x4 a = {0.f, 0.f, 0.f, 0.f};
        a = __builtin_amdgcn_mfma_f32_16x16x32_bf16(k0, qf0, a, 0, 0, 0); a = __builtin_amdgcn_mfma_f32_16x16x32_bf16(k1, qf1, a, 0, 0, 0); st[kt] = a; }
    float SC2 = 0.125f * 1.4426950408889634f; asm volatile("" : "+v"(SC2));
    const int dbase = 128 + c - 4 * g;
    float m = sink2;
#pragma unroll
    for (int kt = 0; kt < 9; ++kt)
#pragma unroll
        for (int r = 0; r < 4; ++r) { const int dist = dbase - r - 16 * kt, kk = 16 * kt + 4 * g + r; const bool ok = (unsigned)dist <= 128u && (wpos0 + kk) >= 0;
            const float sv = ok ? st[kt][r] * SC2 - slope2 * (float)dist : -INFINITY; st[kt][r] = sv; m = fmaxf(m, sv); }
    m = red4_max(m);
    float sum = 0.f;
#pragma unroll
    for (int kt = 0; kt < 9; ++kt)
#pragma unroll
        for (int r = 0; r < 4; ++r) { const float p = __builtin_amdgcn_exp2f(st[kt][r] - m); st[kt][r] = p; sum += p; }
    sum = red4_sum(sum) + __builtin_amdgcn_exp2f(sink2 - m);
    const float inv = 1.f / sum;
    bf16x8 pf[5];
    unsigned zpad = 0u; asm volatile("" : "+v"(zpad));
#pragma unroll
    for (int k = 0; k < 5; ++k) { unsigned w0 = cvtpk(st[2 * k][0] * inv, st[2 * k][1] * inv), w1 = cvtpk(st[2 * k][2] * inv, st[2 * k][3] * inv), w2 = zpad, w3 = zpad;
        if (k < 4) { w2 = cvtpk(st[2 * k + 1][0] * inv, st[2 * k + 1][1] * inv); w3 = cvtpk(st[2 * k + 1][2] * inv, st[2 * k + 1][3] * inv); }
        typedef unsigned u32x4_t __attribute__((ext_vector_type(4))); const u32x4_t w = {w0, w1, w2, w3}; pf[k] = __builtin_bit_cast(bf16x8, w); }
    f32x4 o[4];
#pragma unroll
    for (int dt = 0; dt < 4; ++dt) o[dt] = (f32x4){0.f, 0.f, 0.f, 0.f};
    const LAS unsigned char* vb = Vs + (kbase + 4 * g + (c >> 2)) * KP + 8 * (c & 3);
#pragma unroll
    for (int k = 0; k < 5; ++k)
#pragma unroll
        for (int dt = 0; dt < 4; ++dt) { const s16x4 lo = vtr(vb + (32 * k) * KP + 32 * dt), hi = vtr(vb + (32 * k + 16) * KP + 32 * dt);
            const bf16x8 b = {lo[0], lo[1], lo[2], lo[3], hi[0], hi[1], hi[2], hi[3]};
            o[dt] = __builtin_amdgcn_mfma_f32_16x16x32_bf16(pf[k], b, o[dt], 0, 0, 0); }
#pragma unroll
    for (int r = 0; r < 4; ++r) if (4 * g + r < nst) {
#pragma unroll
        for (int dt = 0; dt < 4; ++dt) Yq[(size_t)(4 * g + r) * BRW + 16 * dt + c] = f2bf(o[dt][r]); }
}
typedef unsigned u32x4_t __attribute__((ext_vector_type(4)));
__device__ __forceinline__ u32x4_t pack8(const float* f) { u32x4_t w; w.x = cvtpk(f[0], f[1]); w.y = cvtpk(f[2], f[3]); w.z = cvtpk(f[4], f[5]); w.w = cvtpk(f[6], f[7]); return w; }
__device__ __forceinline__ void phase(LAS unsigned char* lds, const bf16* Z, int l, const float* sinks, const float* ck, const float* cv, bf16* Y0, int bx, int G, int tid, int lane, int wave) {
    LAS unsigned char* Ks = lds + K_OFF; LAS unsigned char* Vs = lds + V_OFF;
    const u32x4_t zero4 = {0u, 0u, 0u, 0u};
    for (int it = bx; it < NBP * 32 * NKV + SB * NKV; it += G) {
        const int kvh = it & 3;
        if (it < NBP * 32 * NKV) {
            const int b = it >> 7, qb = (it >> 2) & 31;
#pragma unroll
            for (int i = 0; i < 4; ++i) { const int p = tid + NTHR * i, sr = p >> 3, cc = p & 7; const int pos = 128 * (qb - 1) + sr;
                u32x4_t kq = zero4, vq = zero4;
                if (pos >= 0) { const bf16* zr = Z + (size_t)(b * SEQ + pos) * ZW + kvh * 64 + cc * 8; kq = *(const u32x4_t*)(zr + ZK); vq = *(const u32x4_t*)(zr + ZV); }
                *(LAS u32x4_t*)(Ks + sr * KP + cc * 16) = kq; *(LAS u32x4_t*)(Vs + sr * KP + cc * 16) = vq; }
            if (tid < 128) { const int sr = 256 + (tid >> 3), cc = tid & 7; *(LAS u32x4_t*)(Ks + sr * KP + cc * 16) = zero4; *(LAS u32x4_t*)(Vs + sr * KP + cc * 16) = zero4; }
            __syncthreads();
            const int hq = kvh * 4 + (wave >> 1), qh = wave & 1;
            const float slope2 = exp2f(-0.5f * (float)(hq + 1)) * 1.4426950408889634f, sink2 = sinks[l * NH + hq] * 1.4426950408889634f;
            const bf16* qp0 = Z + ((size_t)b * SEQ + 128 * qb + 64 * qh + (lane & 15)) * ZW + ZQ + hq * 64 + 8 * (lane >> 4);
            bf16x8 qc0 = *(const bf16x8*)qp0, qc1 = *(const bf16x8*)(qp0 + 32);
#pragma unroll 1
            for (int qt = 0; qt < 4; ++qt) { const int t1 = 64 * qh + 16 * qt; const size_t qrow0 = (size_t)b * SEQ + 128 * qb + t1;
                const bf16* qpn = qp0 + (size_t)(16 * (qt < 3 ? qt + 1 : 3)) * ZW; const bf16x8 qn0 = *(const bf16x8*)qpn, qn1 = *(const bf16x8*)(qpn + 32);
                tile16(qc0, qc1, Ks, Vs, t1, 128 * qb + t1 - 128, slope2, sink2, Y0 + qrow0 * BRW + hq * 64, 16, lane);
                qc0 = qn0; qc1 = qn1; }
        } else {
            const int sb = (it - NBP * 32 * NKV) >> 2;
#pragma unroll
            for (int i = 0; i < 3; ++i) { const int p = tid + NTHR * i, sr = p >> 3, cc = p & 7;
                if (sr < 160) { u32x4_t kq = zero4, vq = zero4;
                    if (sr < WIN) { const size_t o = ((((size_t)l * SB + sb) * WIN + sr) * NKV + kvh) * 64 + cc * 8; float f[8];
#pragma unroll
                        for (int e = 0; e < 8; ++e) f[e] = ck[o + e];
                        kq = pack8(f);
#pragma unroll
                        for (int e = 0; e < 8; ++e) f[e] = cv[o + e];
                        vq = pack8(f);
                    } else if (sr < WIN + ST) { const bf16* zr = Z + (size_t)(MP + sb * ST + (sr - WIN)) * ZW + kvh * 64 + cc * 8; kq = *(const u32x4_t*)(zr + ZK); vq = *(const u32x4_t*)(zr + ZV); }
                    *(LAS u32x4_t*)(Ks + sr * KP + cc * 16) = kq; *(LAS u32x4_t*)(Vs + sr * KP + cc * 16) = vq; } }
            __syncthreads();
            if (wave < 4) { const int hq = kvh * 4 + wave;
                const float slope2 = exp2f(-0.5f * (float)(hq + 1)) * 1.4426950408889634f, sink2 = sinks[l * NH + hq] * 1.4426950408889634f;
                const size_t qrow0 = (size_t)MP + sb * ST; const bf16* qp = Z + (qrow0 + (lane & 7)) * ZW + ZQ + hq * 64 + 8 * (lane >> 4);
                tile16(*(const bf16x8*)qp, *(const bf16x8*)(qp + 32), Ks, Vs, 0, 0, slope2, sink2, Y0 + qrow0 * BRW + hq * 64, ST, lane); }
        }
        __syncthreads();
    }
}
}

namespace adad {
using att::bf16x8; using att::f32x4; using att::cvtpk;
constexpr int NSTRIP = ADAW / 64, RW = 576, A2_OFF = 8 * RW * 16, A2_WAVE = 3 * 512;
#define ADA_LOAD(V, S) _Pragma("unroll") for (int j = 0; j < 8; ++j) V[j] = __builtin_nontemporal_load((const GAS f32x4*)(wp + (size_t)(32 * (S) + j) * ADAW))
__device__ __forceinline__ v4u silu8(f32x4 x0, f32x4 x1) { v4u o;
    o.x = cvtpk(x0.x * sigmoidf_(x0.x), x0.y * sigmoidf_(x0.y)); o.y = cvtpk(x0.z * sigmoidf_(x0.z), x0.w * sigmoidf_(x0.w));
    o.z = cvtpk(x1.x * sigmoidf_(x1.x), x1.y * sigmoidf_(x1.y)); o.w = cvtpk(x1.z * sigmoidf_(x1.z), x1.w * sigmoidf_(x1.w)); return o; }
__device__ __forceinline__ const GAS float* crow(const float* cp, const float* cs, int row) { return row < NBP ? (const GAS float*)cp + (size_t)row * DM : (const GAS float*)cs + (size_t)(row - NBP) * DM; }
__device__ __forceinline__ void phase(const float* cp, const float* cs, const float* wada, const float* bada, float* ADA, LAS unsigned char* lds, int bx, int G, int wave, int lane, int tid) {
    const int kl = 256 * wave + 8 * (lane >> 4);
    bf16x8 af[2][8];
#pragma unroll
    for (int mb = 0; mb < 2; ++mb) { const GAS float* src = crow(cp, cs, 16 * mb + (lane & 15)) + kl;
#pragma unroll
        for (int s = 0; s < 8; ++s) af[mb][s] = __builtin_bit_cast(bf16x8, silu8(*(const GAS f32x4*)(src + 32 * s), *(const GAS f32x4*)(src + 32 * s + 4))); }
    LAS unsigned char* a2 = lds + A2_OFF + wave * A2_WAVE;
    {   const GAS float* src = crow(cp, cs, 32 + (lane >> 5)) + 256 * wave + 8 * (lane & 31);
        *(LAS v4u*)(a2 + (lane >> 5) * 512 + (lane & 31) * 16) = silu8(*(const GAS f32x4*)src, *(const GAS f32x4*)(src + 4));
        if (lane < 32) { v4u z = {0u, 0u, 0u, 0u}; *(LAS v4u*)(a2 + 2 * 512 + lane * 16) = z; }
        LDS_WAIT(); asm volatile("" ::: "memory"); }
    const LAS unsigned char* a2r = a2 + ((lane & 15) < 2 ? (lane & 15) : 2) * 512 + (lane >> 4) * 16;
    LAS f32x4* red = (LAS f32x4*)lds;
    for (int g = bx; g < DEPTH * NSTRIP; g += G) { const int l = g / NSTRIP, n0 = 64 * (g % NSTRIP);
        const GAS float* wp = (const GAS float*)wada + (size_t)l * DM * ADAW + (size_t)kl * ADAW + n0 + 4 * (lane & 15);
        f32x4 acc[3][4];
#pragma unroll
        for (int mb = 0; mb < 3; ++mb)
#pragma unroll
            for (int i = 0; i < 4; ++i) acc[mb][i] = f32x4{0.f, 0.f, 0.f, 0.f};
        f32x4 v0[8], v1[8];
        ADA_LOAD(v0, 0);
#pragma unroll
        for (int s = 0; s < 8; ++s) {
            if (s < 7) { if (s & 1) { ADA_LOAD(v0, s + 1); } else { ADA_LOAD(v1, s + 1); } }
            asm volatile("" ::: "memory");
            const bf16x8 a2f = *(const LAS bf16x8*)(a2r + 64 * s);
#pragma unroll
            for (int i = 0; i < 4; ++i) { v4u w;
                if (s & 1) { w.x = cvtpk(v1[0][i], v1[1][i]); w.y = cvtpk(v1[2][i], v1[3][i]); w.z = cvtpk(v1[4][i], v1[5][i]); w.w = cvtpk(v1[6][i], v1[7][i]); }
                else       { w.x = cvtpk(v0[0][i], v0[1][i]); w.y = cvtpk(v0[2][i], v0[3][i]); w.z = cvtpk(v0[4][i], v0[5][i]); w.w = cvtpk(v0[6][i], v0[7][i]); }
                const bf16x8 bfr = __builtin_bit_cast(bf16x8, w);
                acc[0][i] = __builtin_amdgcn_mfma_f32_16x16x32_bf16(af[0][s], bfr, acc[0][i], 0, 0, 0);
                acc[1][i] = __builtin_amdgcn_mfma_f32_16x16x32_bf16(af[1][s], bfr, acc[1][i], 0, 0, 0);
                acc[2][i] = __builtin_amdgcn_mfma_f32_16x16x32_bf16(a2f, bfr, acc[2][i], 0, 0, 0); }
            asm volatile("" ::: "memory"); }
        LAS f32x4* rw = red + wave * RW;
#pragma unroll
        for (int mb = 0; mb < 2; ++mb)
#pragma unroll
            for (int i = 0; i < 4; ++i) rw[(mb * 4 + i) * 64 + lane] = acc[mb][i];
        if (lane < 16) {
#pragma unroll
            for (int i = 0; i < 4; ++i) rw[512 + i * 16 + lane] = acc[2][i]; }
        __syncthreads();
        for (int e = tid; e < RW; e += NTHR) { f32x4 t = red[e];
#pragma unroll
            for (int w = 1; w < 8; ++w) t += red[w * RW + e];
            int row0, col;
            if (e < 512) { const int mbi = e >> 6, ln = e & 63; row0 = 16 * (mbi >> 2) + 4 * (ln >> 4); col = n0 + 4 * (ln & 15) + (mbi & 3); }
            else { const int q = e - 512; row0 = 32; col = n0 + 4 * (q & 15) + (q >> 4); }
            const float bv = *((const GAS float*)bada + (size_t)l * ADAW + col);
            GAS float* o = (GAS float*)ADA + ((size_t)l * NROWB + row0) * ADAW + col;
            o[0] = t.x + bv; o[ADAW] = t.y + bv;
            if (row0 < 32) { o[2 * (size_t)ADAW] = t.z + bv; o[3 * (size_t)ADAW] = t.w + bv; } }
        __syncthreads(); }
}
}

namespace ret {
using att::bf16x8; using att::s16x4; using att::f32x4; using att::u32x4_t; using att::vtr; using att::cvtpk; using att::pack8;
constexpr int KP = 144, VP = 288, K_OFF = 0, V_OFF = 128 * KP, S_OFF = V_OFF + 128 * VP, LDS_NEED = S_OFF + 64 * VP;
template <int CTRL> __device__ __forceinline__ float dppf(float v) { return __builtin_bit_cast(float, __builtin_amdgcn_update_dpp(0, __builtin_bit_cast(int, v), CTRL, 0xf, 0xf, false)); }
__device__ __forceinline__ float sum16(float v) { v += dppf<0xB1>(v); v += dppf<0x4E>(v); v += dppf<0x141>(v); v += dppf<0x140>(v); return v; }
__device__ __forceinline__ void out_phase(LAS unsigned char* lds, const bf16* Z, int l, const float* SPREV, const float* gret, bf16* Y3, int bx, int G, int tid, int lane, int wave) {
    LAS unsigned char* Ks = lds + K_OFF; LAS unsigned char* Vs = lds + V_OFF; LAS unsigned char* Ss = lds + S_OFF;
    const int c = lane & 15, g = lane >> 4;
    for (int it = bx; it < NBP * 32 * RH; it += G) {
        const int b = it >> 8, n = (it >> 3) & 31, h = it & 7; const size_t row0 = (size_t)b * SEQ + n * 128;
#pragma unroll
        for (int i = 0; i < 2; ++i) { const int p = tid + NTHR * i, j = p >> 3, cc = p & 7; *(LAS u32x4_t*)(Ks + j * KP + cc * 16) = *(const u32x4_t*)(Z + (row0 + j) * ZW + ZRK + h * 64 + cc * 8); }
#pragma unroll
        for (int i = 0; i < 4; ++i) { const int p = tid + NTHR * i, j = p >> 4, cc = p & 15; *(LAS u32x4_t*)(Vs + j * VP + cc * 16) = *(const u32x4_t*)(Z + (row0 + j) * ZW + ZRV + h * 128 + cc * 8); }
#pragma unroll
        for (int i = 0; i < 2; ++i) { const int p = tid + NTHR * i, d = p >> 4, cc = p & 15; const float* sp = SPREV + ((((size_t)b * 32 + n) * RH + h) * RDK + d) * RDV + cc * 8; float f[8];
#pragma unroll
            for (int e = 0; e < 8; ++e) f[e] = sp[e];
            *(LAS u32x4_t*)(Ss + d * VP + cc * 16) = pack8(f); }
        __syncthreads();
        const int w = wave; const float lg2 = ret_logg(h) * 1.4426950408889634f;
        const bf16* qp = Z + (row0 + 16 * w + c) * ZW + ZRQ + h * 64 + 8 * g;
        const bf16x8 qf0 = *(const bf16x8*)qp, qf1 = *(const bf16x8*)(qp + 32);
        f32x4 o[8];
#pragma unroll
        for (int vt = 0; vt < 8; ++vt) o[vt] = (f32x4){0.f, 0.f, 0.f, 0.f};
#pragma unroll
        for (int ks = 0; ks < 2; ++ks) { const LAS unsigned char* sb = Ss + (32 * ks + 8 * g + (c >> 2)) * VP + 8 * (c & 3);
#pragma unroll
            for (int vt = 0; vt < 8; ++vt) { const s16x4 lo = vtr(sb + 32 * vt), hi = vtr(sb + 4 * VP + 32 * vt); const bf16x8 bb = {lo[0], lo[1], lo[2], lo[3], hi[0], hi[1], hi[2], hi[3]};
                o[vt] = __builtin_amdgcn_mfma_f32_16x16x32_bf16(ks ? qf1 : qf0, bb, o[vt], 0, 0, 0); } }
#pragma unroll
        for (int r = 0; r < 4; ++r) { const float cf = __builtin_amdgcn_exp2f(lg2 * (float)(16 * w + 4 * g + r + 1));
#pragma unroll
            for (int vt = 0; vt < 8; ++vt) o[vt][r] *= cf; }
        for (int ks = 0; ks <= (w >> 1); ++ks) {
            f32x4 st[2];
#pragma unroll
            for (int t = 0; t < 2; ++t) { const int jt = 2 * ks + t; f32x4 a = {0.f, 0.f, 0.f, 0.f};
                if (jt <= w) { const LAS unsigned char* kp = Ks + (16 * jt + c) * KP + 16 * g; const bf16x8 k0 = *(const LAS bf16x8*)kp, k1 = *(const LAS bf16x8*)(kp + 64);
                    a = __builtin_amdgcn_mfma_f32_16x16x32_bf16(k0, qf0, a, 0, 0, 0); a = __builtin_amdgcn_mfma_f32_16x16x32_bf16(k1, qf1, a, 0, 0, 0);
#pragma unroll
                    for (int r = 0; r < 4; ++r) { const int dij = (16 * w + c) - (16 * jt + 4 * g + r); a[r] = dij >= 0 ? a[r] * 0.125f * __builtin_amdgcn_exp2f(lg2 * (float)dij) : 0.f; } }
                st[t] = a; }
            const u32x4_t pw = {cvtpk(st[0][0], st[0][1]), cvtpk(st[0][2], st[0][3]), cvtpk(st[1][0], st[1][1]), cvtpk(st[1][2], st[1][3])}; const bf16x8 pf = __builtin_bit_cast(bf16x8, pw);
            const LAS unsigned char* vb = Vs + (32 * ks + 4 * g + (c >> 2)) * VP + 8 * (c & 3);
#pragma unroll
            for (int vt = 0; vt < 8; ++vt) { const s16x4 lo = vtr(vb + 32 * vt), hi = vtr(vb + 16 * VP + 32 * vt); const bf16x8 bb = {lo[0], lo[1], lo[2], lo[3], hi[0], hi[1], hi[2], hi[3]};
                o[vt] = __builtin_amdgcn_mfma_f32_16x16x32_bf16(pf, bb, o[vt], 0, 0, 0); }
        }
        float mean[4], rstd[4];
#pragma unroll
        for (int r = 0; r < 4; ++r) { float sm = 0.f;
#pragma unroll
            for (int vt = 0; vt < 8; ++vt) sm += o[vt][r];
            mean[r] = sum16(sm) * (1.f / 128.f); float q = 0.f;
#pragma unroll
            for (int vt = 0; vt < 8; ++vt) { const float dd = o[vt][r] - mean[r]; q += dd * dd; }
            rstd[r] = 1.f / sqrtf(sum16(q) * (1.f / 128.f) + EPS); }
        const float* gp = gret + l * BRW + h * 128 + c;
        float gv[8]; bf16 rgv[4][8];
#pragma unroll
        for (int vt = 0; vt < 8; ++vt) gv[vt] = gp[16 * vt];
#pragma unroll
        for (int r = 0; r < 4; ++r) { const bf16* rg = Z + (row0 + 16 * w + 4 * g + r) * ZW + ZRG + h * 128 + c;
#pragma unroll
            for (int vt = 0; vt < 8; ++vt) rgv[r][vt] = rg[16 * vt]; }
        asm volatile("" ::: "memory");
#pragma unroll
        for (int r = 0; r < 4; ++r) { bf16* y = Y3 + (row0 + 16 * w + 4 * g + r) * BRW + h * 128 + c;
#pragma unroll
            for (int vt = 0; vt < 8; ++vt) y[16 * vt] = f2bf((o[vt][r] - mean[r]) * rstd[r] * gv[vt] * bf2f(rgv[r][vt])); }
        __syncthreads();
    }
}

__device__ __forceinline__ void kv_phase(LAS unsigned char* lds, const bf16* Z, float* KV, int bx, int G, int tid, int lane, int wave) {
    LAS unsigned char* Ks = lds + K_OFF; LAS unsigned char* Vs = lds + V_OFF;
    const int c = lane & 15, g = lane >> 4;
    for (int it = bx; it < NBP * 32 * RH; it += G) {
        const int b = it >> 8, n = (it >> 3) & 31, h = it & 7; const size_t row0 = (size_t)b * SEQ + n * 128;
        const float lg2 = ret_logg(h) * 1.4426950408889634f;
#pragma unroll
        for (int i = 0; i < 2; ++i) { const int p = tid + NTHR * i, j = p >> 3, cc = p & 7; float f[8]; ld8(Z + (row0 + j) * ZW + ZRK + h * 64 + cc * 8, f);
            const float sc = 0.125f * __builtin_amdgcn_exp2f(lg2 * (float)(127 - j));
#pragma unroll
            for (int e = 0; e < 8; ++e) f[e] *= sc;
            *(LAS u32x4_t*)(Ks + j * KP + cc * 16) = pack8(f); }
#pragma unroll
        for (int i = 0; i < 4; ++i) { const int p = tid + NTHR * i, j = p >> 4, cc = p & 15; *(LAS u32x4_t*)(Vs + j * VP + cc * 16) = *(const u32x4_t*)(Z + (row0 + j) * ZW + ZRV + h * 128 + cc * 8); }
        __syncthreads();
        const int dt = wave & 3, vt0 = (wave >> 2) * 4;
        f32x4 acc[4];
#pragma unroll
        for (int t = 0; t < 4; ++t) acc[t] = (f32x4){0.f, 0.f, 0.f, 0.f};
#pragma unroll
        for (int ks = 0; ks < 4; ++ks) { const LAS unsigned char* ka = Ks + (32 * ks + 8 * g + (c >> 2)) * KP + 32 * dt + 8 * (c & 3);
            const s16x4 alo = vtr(ka), ahi = vtr(ka + 4 * KP); const bf16x8 af = {alo[0], alo[1], alo[2], alo[3], ahi[0], ahi[1], ahi[2], ahi[3]};
            const LAS unsigned char* vb = Vs + (32 * ks + 8 * g + (c >> 2)) * VP + 8 * (c & 3);
#pragma unroll
            for (int t = 0; t < 4; ++t) { const s16x4 lo = vtr(vb + 32 * (vt0 + t)), hi = vtr(vb + 4 * VP + 32 * (vt0 + t)); const bf16x8 bb = {lo[0], lo[1], lo[2], lo[3], hi[0], hi[1], hi[2], hi[3]};
                acc[t] = __builtin_amdgcn_mfma_f32_16x16x32_bf16(af, bb, acc[t], 0, 0, 0); } }
        float* kvp = KV + ((((size_t)b * 32 + n) * RH + h) * RDK + 16 * dt + 4 * g) * RDV + c;
#pragma unroll
        for (int r = 0; r < 4; ++r)
#pragma unroll
            for (int t = 0; t < 4; ++t) kvp[(size_t)r * RDV + 16 * (vt0 + t)] = acc[t][r];
        __syncthreads();
    }
}
}

namespace mixl {
using att::u32x4_t; using att::f32x4; using att::f32x2_t;
template <int CTRL> __device__ __forceinline__ float dppf(float v) { return __builtin_bit_cast(float, __builtin_amdgcn_update_dpp(0, __builtin_bit_cast(int, v), CTRL, 0xf, 0xf, false)); }
__device__ __forceinline__ float sum8(float v) { v += dppf<0xB1>(v); v += dppf<0x4E>(v); v += dppf<0x141>(v); return v; }
struct QkRow { float q0[8], q1[8], kv[8]; };
__device__ __forceinline__ void qk_load(const bf16* zr, QkRow& R, int lane) { ld8(zr + ZQ + lane * 8, R.q0); ld8(zr + ZQ + 512 + lane * 8, R.q1); ld8(zr + ZK + lane * 8, R.kv); }
__device__ __forceinline__ void qk_finish(bf16* zr, int row, int l, QkRow& R, const float (&g8q)[8], const float (&g8k)[8], float* out, int lane) {
    float s0 = 0.f, s1 = 0.f, s2 = 0.f;
#pragma unroll
    for (int e = 0; e < 8; ++e) { s0 += R.q0[e] * R.q0[e]; s1 += R.q1[e] * R.q1[e]; s2 += R.kv[e] * R.kv[e]; }
    const float r0 = 1.f / sqrtf(sum8(s0) * (1.f / 64.f) + EPS), r1 = 1.f / sqrtf(sum8(s1) * (1.f / 64.f) + EPS), r2 = 1.f / sqrtf(sum8(s2) * (1.f / 64.f) + EPS);
#pragma unroll
    for (int e = 0; e < 8; ++e) { R.q0[e] *= r0 * g8q[e]; R.q1[e] *= r1 * g8q[e]; if (lane < 32) R.kv[e] *= r2 * g8k[e]; }
    st8(zr + ZQ + lane * 8, R.q0); st8(zr + ZQ + 512 + lane * 8, R.q1);
    if (lane < 32) st8(zr + ZK + lane * 8, R.kv);
    float* o = nullptr;
    if (row < MP) { const int b = row >> 12, t = row & (SEQ - 1); if (t >= SEQ - WIN) o = out + (lane < 32 ? O_KP : O_VP) + (((size_t)l * NBP + b) * WIN + (t - (SEQ - WIN))) * 256 + (lane & 31) * 8; }
    else { const int sb = (row - MP) >> 3, t = (row - MP) & 7; o = out + (lane < 32 ? O_KS : O_VS) + (((size_t)l * SB + sb) * WIN + (WIN - ST + t)) * 256 + (lane & 31) * 8; }
    if (o) { *(f32x4*)o = (f32x4){R.kv[0], R.kv[1], R.kv[2], R.kv[3]}; *(f32x4*)(o + 4) = (f32x4){R.kv[4], R.kv[5], R.kv[6], R.kv[7]}; }
}
__device__ __forceinline__ void qknorm_phase(bf16* Z, int l, const float* gq, const float* gk, float* out, int gw, int NGW, int lane) {
    float g8q[8], g8k[8];
#pragma unroll
    for (int e = 0; e < 8; ++e) { g8q[e] = gq[l * 64 + (lane & 7) * 8 + e]; g8k[e] = gk[l * 64 + (lane & 7) * 8 + e]; }
    for (int row = gw; row < M; row += 2 * NGW) { const int rowb = row + NGW; const bool two = rowb < M;
        bf16* za = Z + (size_t)row * ZW; bf16* zb = Z + (size_t)(two ? rowb : row) * ZW;
        QkRow A, B; qk_load(za, A, lane); qk_load(zb, B, lane);
        asm volatile("" ::: "memory");
        qk_finish(za, row, l, A, g8q, g8k, out, lane);
        if (two) qk_finish(zb, rowb, l, B, g8q, g8k, out, lane);
    }
}
constexpr int CV_RB = 64, CV_CB = 128, CV_UR = CV_RB + CPRE, CV_NPI = (MP / CV_RB) * 8, CV_NSI = SB * 8;
struct CvItem { bool smp; int cb, b, t0, nrows; size_t rowb; };
__device__ __forceinline__ CvItem cv_item(int it) { CvItem I; I.smp = it >= CV_NPI; I.cb = it & 7; I.b = I.smp ? (it - CV_NPI) >> 3 : (it >> 3) >> 6; I.t0 = I.smp ? 0 : ((it >> 3) & 63) * CV_RB; I.nrows = I.smp ? ST : CV_RB;
    I.rowb = I.smp ? (size_t)MP + I.b * ST : (size_t)I.b * SEQ; return I; }
__device__ __forceinline__ void cv_fetch(const bf16* Z, int l, const float* sconv, const CvItem& I, u32x4_t (&raw)[3][2], int tid) {
#pragma unroll
    for (int i = 0; i < 3; ++i) { const int p = tid + NTHR * i, ur = p >> 4, c8 = p & 15, tt = I.t0 - CPRE + ur; raw[i][0] = (u32x4_t){0u, 0u, 0u, 0u}; raw[i][1] = raw[i][0];
        if (ur < I.nrows + CPRE) {
            if (tt >= 0) { const bf16* zp = Z + (I.rowb + tt) * ZW + I.cb * CV_CB + c8 * 8; raw[i][0] = *(const u32x4_t*)(zp + ZCA); }
            else if (I.smp) { const float* sp = sconv + (((size_t)l * SB + I.b) * CPRE + (CPRE + tt)) * BRW + I.cb * CV_CB + c8 * 8; raw[i][0] = *(const u32x4_t*)sp; raw[i][1] = *(const u32x4_t*)(sp + 4); } } }
}
__device__ __forceinline__ void conv_phase(LAS unsigned char* lds, const bf16* Z, int l, const float* wdw, const float* bdw, const float* sconv, bf16* CONVY, float* out, int bx, int G, int tid) {
    LAS float* U = (LAS float*)lds;
    auto unp = [](const u32x4_t w, float* f) { f[0] = __builtin_bit_cast(float, w.x << 16); f[1] = __builtin_bit_cast(float, w.x & 0xffff0000u); f[2] = __builtin_bit_cast(float, w.y << 16); f[3] = __builtin_bit_cast(float, w.y & 0xffff0000u);
        f[4] = __builtin_bit_cast(float, w.z << 16); f[5] = __builtin_bit_cast(float, w.z & 0xffff0000u); f[6] = __builtin_bit_cast(float, w.w << 16); f[7] = __builtin_bit_cast(float, w.w & 0xffff0000u); };
    u32x4_t raw[3][2]; f32x2_t w2[CONVK], bias2 = {0.f, 0.f}; int wcb = -1;
#pragma unroll
    for (int j = 0; j < CONVK; ++j) w2[j] = f32x2_t{0.f, 0.f};
    if (bx < CV_NPI + CV_NSI) { const CvItem I0 = cv_item(bx); cv_fetch(Z, l, sconv, I0, raw, tid); }
    for (int it = bx; it < CV_NPI + CV_NSI; it += G) {
        const CvItem I = cv_item(it);
        const int cp = tid & 63, r0 = (tid >> 6) * 8, ch = I.cb * CV_CB + 2 * cp;
        if (I.cb != wcb) { wcb = I.cb;
#pragma unroll
            for (int j = 0; j < CONVK; ++j) w2[j] = *(const f32x2_t*)(wdw + ((size_t)l * CONVK + j) * BRW + ch);
            bias2 = *(const f32x2_t*)(bdw + l * BRW + ch); }
#pragma unroll
        for (int i = 0; i < 3; ++i) { const int p = tid + NTHR * i, ur = p >> 4, c8 = p & 15, tt = I.t0 - CPRE + ur; float u[8];
            if (ur < I.nrows + CPRE) {
                if (tt >= 0) { unp(raw[i][0], u);
                    if (ur >= CPRE) { float* o = nullptr;
                        if (!I.smp) { if (tt >= SEQ - CPRE) o = out + O_CP + (((size_t)l * NBP + I.b) * CPRE + (tt - (SEQ - CPRE))) * BRW + I.cb * CV_CB + c8 * 8; }
                        else o = out + O_CS + (((size_t)l * SB + I.b) * CPRE + (CPRE - ST + tt)) * BRW + I.cb * CV_CB + c8 * 8;
                        if (o) { *(f32x4*)o = (f32x4){u[0], u[1], u[2], u[3]}; *(f32x4*)(o + 4) = (f32x4){u[4], u[5], u[6], u[7]}; } }
                } else {
                    const unsigned r0_ = raw[i][0].x, r1_ = raw[i][0].y, r2_ = raw[i][0].z, r3_ = raw[i][0].w, r4_ = raw[i][1].x, r5_ = raw[i][1].y, r6_ = raw[i][1].z, r7_ = raw[i][1].w;
                    u[0] = __builtin_bit_cast(float, r0_); u[1] = __builtin_bit_cast(float, r1_); u[2] = __builtin_bit_cast(float, r2_); u[3] = __builtin_bit_cast(float, r3_);
                    u[4] = __builtin_bit_cast(float, r4_); u[5] = __builtin_bit_cast(float, r5_); u[6] = __builtin_bit_cast(float, r6_); u[7] = __builtin_bit_cast(float, r7_); }
                *(LAS f32x4*)(U + ur * CV_CB + c8 * 8) = (f32x4){u[0], u[1], u[2], u[3]}; *(LAS f32x4*)(U + ur * CV_CB + c8 * 8 + 4) = (f32x4){u[4], u[5], u[6], u[7]}; } }
        __syncthreads();
        if (it + G < CV_NPI + CV_NSI) { const CvItem In = cv_item(it + G); cv_fetch(Z, l, sconv, In, raw, tid); }
        if (r0 < I.nrows) {
            f32x2_t u2[8 + CPRE];
#pragma unroll
            for (int k = 0; k < 8 + CPRE; ++k) u2[k] = *(const LAS f32x2_t*)(U + (r0 + k) * CV_CB + 2 * cp);
#pragma unroll
            for (int r = 0; r < 8; ++r) { f32x2_t acc = bias2;
#pragma unroll
                for (int j = 0; j < CONVK; ++j) acc = w2[j] * u2[r + j] + acc;
                if (r0 + r < I.nrows) *(unsigned*)(CONVY + (I.rowb + I.t0 + r0 + r) * BRW + ch) = pk2(acc.x, acc.y); }
        }
        __syncthreads();
    }
}
template <int W> __device__ __forceinline__ void pool_run(const bf16* Z, int l, int b, int t0, int cch, bf16* ZP, float* out) {
    const size_t rowb = (size_t)b * SEQ; u32x4_t rw[23];
#pragma unroll
    for (int k = 16 - W; k < 23; ++k) { const int tt = t0 - 15 + k; rw[k] = (u32x4_t){0u, 0u, 0u, 0u}; if (tt >= 0) rw[k] = *(const u32x4_t*)(Z + (rowb + tt) * ZW + ZPL + cch); }
    float S[8];
#pragma unroll
    for (int e = 0; e < 8; ++e) S[e] = 0.f;
    auto unp = [](const u32x4_t w, float* f) { f[0] = __builtin_bit_cast(float, w.x << 16); f[1] = __builtin_bit_cast(float, w.x & 0xffff0000u); f[2] = __builtin_bit_cast(float, w.y << 16); f[3] = __builtin_bit_cast(float, w.y & 0xffff0000u);
        f[4] = __builtin_bit_cast(float, w.z << 16); f[5] = __builtin_bit_cast(float, w.z & 0xffff0000u); f[6] = __builtin_bit_cast(float, w.w << 16); f[7] = __builtin_bit_cast(float, w.w & 0xffff0000u); };
#pragma unroll
    for (int k = 16 - W; k < 15; ++k) { float f[8]; unp(rw[k], f);
#pragma unroll
        for (int e = 0; e < 8; ++e) S[e] += f[e]; }
#pragma unroll
    for (int r = 0; r < 8; ++r) { const int t = t0 + r; float u[8], o[8], f[8]; unp(rw[15 + r], u);
        const float inv = 1.f / (float)((t + 1) < W ? (t + 1) : W);
#pragma unroll
        for (int e = 0; e < 8; ++e) { S[e] += u[e]; o[e] = S[e] * inv - u[e]; }
        st8(ZP + (rowb + t) * BRW + cch, o);
        if (t >= SEQ - PPAD) { float* so = out + O_PP + (((size_t)l * NBP + b) * PPAD + (t - (SEQ - PPAD))) * BRW + cch; *(f32x4*)so = (f32x4){u[0], u[1], u[2], u[3]}; *(f32x4*)(so + 4) = (f32x4){u[4], u[5], u[6], u[7]}; }
        unp(rw[15 + r - W + 1], f);
#pragma unroll
        for (int e = 0; e < 8; ++e) S[e] -= f[e]; }
}
template <int W> __device__ __forceinline__ void pool_run_s(const bf16* Z, int l, int b, int cch, const float* spool, bf16* ZP, float* out) {
    const size_t rowb = (size_t)MP + b * ST; const float* sp = spool + (((size_t)l * SB + b) * PPAD) * BRW + cch;
    f32x4 pf[W - 1][2]; u32x4_t rw[ST];
#pragma unroll
    for (int k = 0; k < W - 1; ++k) { pf[k][0] = *(const f32x4*)(sp + (size_t)(PPAD - (W - 1) + k) * BRW); pf[k][1] = *(const f32x4*)(sp + (size_t)(PPAD - (W - 1) + k) * BRW + 4); }
#pragma unroll
    for (int t = 0; t < ST; ++t) rw[t] = *(const u32x4_t*)(Z + (rowb + t) * ZW + ZPL + cch);
    auto unp = [](const u32x4_t w, float* f) { f[0] = __builtin_bit_cast(float, w.x << 16); f[1] = __builtin_bit_cast(float, w.x & 0xffff0000u); f[2] = __builtin_bit_cast(float, w.y << 16); f[3] = __builtin_bit_cast(float, w.y & 0xffff0000u);
        f[4] = __builtin_bit_cast(float, w.z << 16); f[5] = __builtin_bit_cast(float, w.z & 0xffff0000u); f[6] = __builtin_bit_cast(float, w.w << 16); f[7] = __builtin_bit_cast(float, w.w & 0xffff0000u); };
    float S[8];
#pragma unroll
    for (int e = 0; e < 8; ++e) S[e] = 0.f;
#pragma unroll
    for (int k = 0; k < W - 1; ++k) { S[0] += pf[k][0].x; S[1] += pf[k][0].y; S[2] += pf[k][0].z; S[3] += pf[k][0].w; S[4] += pf[k][1].x; S[5] += pf[k][1].y; S[6] += pf[k][1].z; S[7] += pf[k][1].w; }
    const float inv = 1.f / (float)W;
#pragma unroll
    for (int t = 0; t < ST; ++t) { float u[8], o[8], f[8]; unp(rw[t], u);
#pragma unroll
        for (int e = 0; e < 8; ++e) { S[e] += u[e]; o[e] = S[e] * inv - u[e]; }
        st8(ZP + (rowb + t) * BRW + cch, o);
        float* so = out + O_PS + (((size_t)l * SB + b) * PPAD + (PPAD - ST + t)) * BRW + cch; *(f32x4*)so = (f32x4){u[0], u[1], u[2], u[3]}; *(f32x4*)(so + 4) = (f32x4){u[4], u[5], u[6], u[7]};
        const int tt = t - W + 1;
        if (tt >= 0) unp(rw[tt >= 0 ? tt : 0], f);
        else { const int k = tt + W - 1 >= 0 ? tt + W - 1 : 0; f[0] = pf[k][0].x; f[1] = pf[k][0].y; f[2] = pf[k][0].z; f[3] = pf[k][0].w; f[4] = pf[k][1].x; f[5] = pf[k][1].y; f[6] = pf[k][1].z; f[7] = pf[k][1].w; }
#pragma unroll
        for (int e = 0; e < 8; ++e) S[e] -= f[e]; }
}
__device__ __forceinline__ void pool_phase(const bf16* Z, int l, const float* spool, bf16* ZP, float* out, int gw, int NGW, int lane, int gt, int NGT) {
    for (int wi = gw; wi < (MP / 8 / 2) * 4; wi += NGW) { const int cg = wi & 3, grp = (wi >> 2) * 2 + (lane >> 5), cch = (cg * 32 + (lane & 31)) * 8, b = grp >> 9, t0 = (grp & 511) * 8;
        if (cg == 0) pool_run<2>(Z, l, b, t0, cch, ZP, out); else if (cg == 1) pool_run<4>(Z, l, b, t0, cch, ZP, out); else if (cg == 2) pool_run<8>(Z, l, b, t0, cch, ZP, out); else pool_run<16>(Z, l, b, t0, cch, ZP, out); }
    for (int wi = gw; wi < (SB / 2) * 4; wi += NGW) { const int cg = wi & 3, b = (wi >> 2) * 2 + (lane >> 5), cch = (cg * 32 + (lane & 31)) * 8;
        if (cg == 0) pool_run_s<2>(Z, l, b, cch, spool, ZP, out); else if (cg == 1) pool_run_s<4>(Z, l, b, cch, spool, ZP, out); else if (cg == 2) pool_run_s<8>(Z, l, b, cch, spool, ZP, out); else pool_run_s<16>(Z, l, b, cch, spool, ZP, out); }
}
__device__ __forceinline__ void retout_s_phase(const bf16* Z, int l, const float* sret, const float* gret, bf16* Y3, int gw, int NGW, int lane) {
    for (int it = gw; it < MS * RH; it += NGW) { int h = __builtin_amdgcn_readfirstlane(it & 7); asm volatile("" : "+s"(h));
        const int rs = it >> 3, sb = rs >> 3, i = rs & 7; const size_t row = (size_t)MP + rs, row0 = (size_t)MP + sb * ST;
        const float lg = ret_logg(h);
        const bf16* qp = Z + row * ZW + ZRQ + h * 64;
        const float* S = sret + (((size_t)l * SB + sb) * RH + h) * RDK * RDV;
        float o0 = 0.f, o1 = 0.f;
        const float ql = bf2f(qp[lane]);
        bf16 kj[ST], v0j[ST], v1j[ST];
#pragma unroll
        for (int j = 0; j < ST; ++j) { const bf16* zj = Z + (row0 + j) * ZW; kj[j] = zj[ZRK + h * 64 + lane]; v0j[j] = zj[ZRV + h * 128 + lane]; v1j[j] = zj[ZRV + h * 128 + lane + 64]; }
#pragma unroll
        for (int d0 = 0; d0 < 64; d0 += 32) { float sa[32], sb_[32];
#pragma unroll
            for (int d = 0; d < 32; ++d) { sa[d] = S[(size_t)(d0 + d) * RDV + lane]; sb_[d] = S[(size_t)(d0 + d) * RDV + lane + 64]; }
#pragma unroll
            for (int d = 0; d < 32; ++d) { const float qd = __builtin_bit_cast(float, __builtin_amdgcn_readlane(__builtin_bit_cast(int, ql), d0 + d)); o0 += qd * sa[d]; o1 += qd * sb_[d]; } }
        const float cf = FEXP(lg * (float)(i + 1)); o0 *= cf; o1 *= cf;
#pragma unroll
        for (int j = 0; j < ST; ++j) { const float sc = j <= i ? wave_sum(ql * bf2f(kj[j])) * 0.125f * FEXP(lg * (float)(i - j)) : 0.f;
            o0 += sc * bf2f(v0j[j]); o1 += sc * bf2f(v1j[j]); }
        const float mean = wave_sum(o0 + o1) * (1.f / 128.f); const float d0 = o0 - mean, d1 = o1 - mean;
        const float rstd = 1.f / sqrtf(wave_sum(d0 * d0 + d1 * d1) * (1.f / 128.f) + EPS);
        const float* g = gret + l * BRW + h * 128; const bf16* rg = Z + row * ZW + ZRG + h * 128; bf16* y = Y3 + row * BRW + h * 128;
        y[lane] = f2bf(d0 * rstd * g[lane] * bf2f(rg[lane])); y[lane + 64] = f2bf(d1 * rstd * g[lane + 64] * bf2f(rg[lane + 64]));
    }
}
}
struct AdaOrder { int G, c; const char* A; const char* B;
    __device__ __forceinline__ bool next(int i, pg8::Unit& u) const { const int Lx = i * G + c; if (Lx >= DEPTH * (ADAW / 256)) return false;
        u.r = Lx / (ADAW / 256); u.pn = Lx % (ADAW / 256); u.pm = 0; u.ks = 0; u.nt = DM / 64; u.a = A; u.b = B + ((size_t)u.r * ADAW + (size_t)u.pn * 256) * DM * 2; return true; } };
struct PoolOrder { int G, c; const char* A; const char* B;
                __device__ __forceinline__ bool next(int i, pg8::Unit& u) const { const int Lx = i * G + c; if (Lx >= (M / 256) * 4) return false;
                    u.pm = Lx >> 2; u.pn = Lx & 3; u.r = 0; u.ks = 0; u.nt = 256 / 64; u.a = A + ((size_t)u.pm * 256 * BRW + (size_t)u.pn * 256) * 2; u.b = B + (size_t)u.pn * 256 * 256 * 2; return true; } };
__device__ __forceinline__ unsigned long long ld_ptr(volatile LAS unsigned* p) { const unsigned lo = __builtin_amdgcn_readfirstlane(p[0]), hi = __builtin_amdgcn_readfirstlane(p[1]); return ((unsigned long long)hi << 32) | lo; }
__device__ __forceinline__ att::f32x4 retstate_s_val(const bf16* Z, int l, int sb, int h, int d, int v4, const float* sret, float* out, float*& o) {
    const float lg = ret_logg(h);
    const size_t so = ((((size_t)l * SB + sb) * RH + h) * RDK + d) * RDV + v4 * 4;
    const float gc = FEXP(lg * (float)ST);
    const att::f32x4 s4 = *(const att::f32x4*)(sret + so); float a0 = gc * s4.x, a1 = gc * s4.y, a2 = gc * s4.z, a3 = gc * s4.w;
#pragma unroll
    for (int j = 0; j < ST; ++j) { const bf16* p = Z + (size_t)(MP + sb * ST + j) * ZW;
        const float kd = bf2f(p[ZRK + h * 64 + d]) * 0.125f * FEXP(lg * (float)(ST - 1 - j));
        const bf16* pv = p + ZRV + h * 128 + v4 * 4;
        a0 += kd * bf2f(pv[0]); a1 += kd * bf2f(pv[1]); a2 += kd * bf2f(pv[2]); a3 += kd * bf2f(pv[3]); }
    o = out + O_RS + so; return att::f32x4{a0, a1, a2, a3};
}
constexpr int NPL = 12;
constexpr int PH_TOTAL = 2 + DEPTH * NPL + 1;
constexpr int KS_BR = 2, KS_OUT = 8, KS_M1 = 4, KS_M2 = 16;
struct Args { const float* in[N_IN]; float* out; unsigned char* ws; int ph_lo, ph_hi; };
static_assert(sizeof(Args) == N_IN * 8 + 8 + 8 + 8, "Args has no padding");

__global__ void __launch_bounds__(NTHR, 2) fwd(Args args) {
    extern __shared__ __attribute__((aligned(16))) unsigned char lds[];
    LAS unsigned char* L0 = (LAS unsigned char*)lds;
    volatile LAS unsigned* MISC = (volatile LAS unsigned*)(L0 + MISC_OFF);
    const int G = gridDim.x, bx = blockIdx.x, wave0 = __builtin_amdgcn_readfirstlane(threadIdx.x >> 6);
    unsigned char* ws0 = args.ws;
    for (int u = threadIdx.x; u < (LDS_BYTES - LDSCTL_OFF) / 4; u += NTHR) ((LAS unsigned*)(L0 + LDSCTL_OFF))[u] = 0u;
    __syncthreads();
    if (threadIdx.x <= N_IN) ((LAS unsigned long long*)(L0 + INTAB_OFF))[threadIdx.x] = threadIdx.x < N_IN ? (unsigned long long)args.in[threadIdx.x < N_IN ? threadIdx.x : 0] : (unsigned long long)args.out;
    __syncthreads();
#if MK_ONE_LAUNCH
    XcdBarrier bar = xcd_barrier_post((unsigned*)(ws0 + WS_CTL) + CW_BAR, MISC + 8);
#define GRID_BAR() xcd_barrier(bar)
#else
#define GRID_BAR() do {} while (0)
#endif
    const int lo = args.ph_lo, hi = args.ph_hi;
#ifndef PH_MASK
#define PH_MASK 0x7FFF
#endif
#ifndef PROBE_MASK
#define PROBE_MASK 0
#endif
#define PROBE_BEGIN(bit) unsigned long long pr_t0 = 0; if ((PROBE_MASK >> (bit)) & 1) pr_t0 = __builtin_amdgcn_s_memrealtime()
#define PROBE_END(bit) do { if ((PROBE_MASK >> (bit)) & 1) { __syncthreads(); const unsigned long long t1 = __builtin_amdgcn_s_memrealtime(); while (__builtin_amdgcn_s_memrealtime() - t1 < t1 - pr_t0) __builtin_amdgcn_s_sleep(8); } } while (0)
#define TAIL_FILL(nsub, N, ...) do { const int f0_ = (nsub) < G ? (nsub) : 0; if (bx >= f0_) for (int i = (bx - f0_) * NTHR + tid; i < (N); i += (G - f0_) * NTHR) { __VA_ARGS__; } } while (0)
#define TAIL_LANE() int ln; asm volatile("v_mbcnt_lo_u32_b32 %0, -1, 0\n\tv_mbcnt_hi_u32_b32 %0, -1, %0" : "=v"(ln)); const int tid2 = wave0 * 64 + ln
#define TAIL_WAVES(nsub) TAIL_LANE(); const int f0_ = (nsub) < G ? (nsub) : 0; const bool filler = bx >= f0_; const int fw = (bx - f0_) * NWAVES + wave0, NFW = (G - f0_) * NWAVES; (void)tid2
    constexpr int WIN_ITEMS = (DM / 64) * (ZW / 32);
#define IN(k) (lo <= (k) && (k) < hi)
#define SEAM(k) do { if (IN((k) + 1)) GRID_BAR(); } while (0)
#define INP(i)  ((const float*)(GAS const float*)ld_ptr((volatile LAS unsigned*)(L + INTAB_OFF) + 2 * (i)))
#define P_OUT   ((float*)(GAS float*)ld_ptr((volatile LAS unsigned*)(L + INTAB_OFF) + 2 * N_IN))
#define WIN_T   ((bf16*)(ws + WS_WIN))
#define WBR_T   ((bf16*)(ws + WS_WBR))
#define WOUT_T  ((bf16*)(ws + WS_WOUT))
#define WM1_T   ((bf16*)(ws + WS_WM1))
#define WM2_T   ((bf16*)(ws + WS_WM2))
#define WPOOL_T ((bf16*)(ws + WS_WPOOL))
#define WADA_T  ((bf16*)(ws + WS_WADA))
#define SC      ((bf16*)(ws + WS_SC))
#define ADA     ((float*)(ws + WS_ADA))
#define H       ((bf16*)(ws + WS_H))
#define Z       ((bf16*)(ws + WS_Z))
#define Y       ((bf16*)(ws + WS_Y))
#define ZP      ((bf16*)(ws + WS_ZP))
#define CONVY   ((bf16*)(ws + WS_CONVY))
#define ORAW    ((float*)(ws + WS_ORAW))
#define KV      ((float*)(ws + WS_KV))
#define SPREV   ((float*)(ws + WS_SPREV))
#define MACC    ((float*)(ws + WS_MACC))
#define MERGED  ((bf16*)(ws + WS_MERGED))
#define X1      ((float*)(ws + WS_X1))
#define X       ((float*)(ws + WS_X))
#define X1B     ((bf16*)(ws + WS_X1))
#define XB      ((bf16*)(ws + WS_X))
#define HID     ((bf16*)(ws + WS_HID))
#define SLAB    ((float*)(ws + WS_SLAB))
#define TIDS() int lane; asm volatile("v_mbcnt_lo_u32_b32 %0, -1, 0\n\tv_mbcnt_hi_u32_b32 %0, -1, %0" : "=v"(lane)); GAS unsigned char* wsg = (GAS unsigned char*)ws0; asm volatile("" : "+s"(wsg)); unsigned char* ws = (unsigned char*)wsg; LAS unsigned char* L = L0; asm volatile("" : "+s"(L)); const int wave = wave0, tid = wave0 * 64 + lane; const int gw = bx * NWAVES + wave, NGW = G * NWAVES; const int gt = bx * NTHR + tid, NGT = G * NTHR; (void)lane; (void)gw; (void)NGW; (void)gt; (void)NGT
#define LAYER_PTRS() const float* ada = ADA + (size_t)l * NROWB * ADAW; const float* xinP = l == 0 ? INP(I_XP) : X; const float* xinS = l == 0 ? INP(I_XS) : X + (size_t)MP * DM; float* xout = l == DEPTH - 1 ? P_OUT : X; (void)ada; (void)xinP; (void)xinS; (void)xout
    if ((PH_MASK >> 12 & 1) && IN(0)) { TIDS(); PROBE_BEGIN(12);
        transpose_run<DM, ZW, true>(INP(I_WIN), WIN_T, 1, gw, NGW, lane);
        transpose_run<BRW, DM>(INP(I_WBR), WBR_T, DEPTH * 4, gw, NGW, lane);
        transpose_run<256, 256>(INP(I_WPOOL), WPOOL_T, DEPTH * 4, gw, NGW, lane);
        adad::phase(INP(I_CP), INP(I_CS), INP(I_WADA), INP(I_BADA), ADA, L + RING_OFF, bx, G, wave, lane, tid);
        PROBE_END(12); SEAM(0);
    }
    for (int l = 0; l < DEPTH; ++l) {
        const int pb = 2 + l * NPL;
        if ((PH_MASK >> 0 & 1) && IN(pb + 0)) { TIDS(); LAYER_PTRS(); PROBE_BEGIN(0);
            for (int rs = bx; rs < MS; rs += G) { const int row = MP + rs; const float* ar = ada + (size_t)row_cond(row) * ADAW;
                if (l == 0) norm_row_block<0>(xinS + (size_t)rs * DM, nullptr, nullptr, 0, nullptr, INP(I_G1) + l * DM, ar + DM, ar, H + (size_t)row * DM, (LAS float*)(L + RING_OFF), tid, wave);
                else norm_row_block<KS_M2>(X1 + (size_t)row * DM, ar - (size_t)NROWB * ADAW + 5 * DM, SLAB + (size_t)rs * DM, (size_t)MS * DM, X + (size_t)row * DM, INP(I_G1) + l * DM, ar + DM, ar, H + (size_t)row * DM, (LAS float*)(L + RING_OFF), tid, wave); }
            f32x4 gm[8], shv[8]; int curc = row_cond(gw < MP ? gw : 0); { const float* ar = ada + (size_t)curc * ADAW; load_mod(INP(I_G1) + l * DM, ar + DM, ar, gm, shv, lane); }
            for (int row = gw; row < MP; row += 2 * NGW) { const int rowb = row + NGW; const bool pair = rowb < MP && row_cond(rowb) == row_cond(row);
                for (int k = 0; k < 2; ++k) { const int r = k ? rowb : row; if (k && (pair || rowb >= MP)) break; const int cond = row_cond(r); const float* ar = ada + (size_t)cond * ADAW;
                    if (cond != curc) { load_mod(INP(I_G1) + l * DM, ar + DM, ar, gm, shv, lane); curc = cond; }
                    if (l == 0) { const float* xin = INP(I_XP);
                        if (pair) norm_row2<false>(xin + (size_t)row * DM, xin + (size_t)rowb * DM, gm, shv, H + (size_t)row * DM, H + (size_t)rowb * DM, lane);
                        else norm_row<false>(xin + (size_t)r * DM, gm, shv, H + (size_t)r * DM, lane); }
                    else {
                        if (pair) norm_row2<true>(XB + (size_t)row * DM, XB + (size_t)rowb * DM, gm, shv, H + (size_t)row * DM, H + (size_t)rowb * DM, lane);
                        else norm_row<true>(XB + (size_t)r * DM, gm, shv, H + (size_t)r * DM, lane); } } }
            PROBE_END(0); SEAM(pb + 0);
        }
        if ((PH_MASK >> 1 & 1) && IN(pb + 1)) { TIDS(); LAYER_PTRS(); PROBE_BEGIN(1);
            pg8::StaticOrder S; S.init(H, WIN_T + (size_t)l * ZW * DM, M / 256, ZW / 256, DM, DM, DM, G, bx);
            pg8::EpiZ E{Z};
            pg8::gemm_phase<pg8::EpiZ, pg8::StaticOrder>(L + RING_OFF, pg8::Dims{DM, DM, DM}, S, E, tid);
            PROBE_END(1); SEAM(pb + 1);
        }
        if ((PH_MASK >> 2 & 1) && IN(pb + 2)) { TIDS(); LAYER_PTRS(); PROBE_BEGIN(2);
            mixl::qknorm_phase(Z, l, INP(I_GQ), INP(I_GK), P_OUT, gw, NGW, lane);
            mixl::conv_phase(L + RING_OFF, Z, l, INP(I_WDW), INP(I_BDW), INP(I_SCONV), CONVY, P_OUT, bx, G, tid);
            mixl::pool_phase(Z, l, INP(I_SPOOL), ZP, P_OUT, gw, NGW, lane, gt, NGT);
            ret::kv_phase(L + RING_OFF, Z, KV, bx, G, tid, lane, wave);
            PROBE_END(2); SEAM(pb + 2);
        }
        if ((PH_MASK >> 3 & 1) && IN(pb + 3)) { TIDS(); LAYER_PTRS(); PROBE_BEGIN(3);
            att::phase(L + RING_OFF, Z, l, INP(I_SINK), INP(I_CK), INP(I_CV), Y, bx, G, tid, lane, wave);
            for (int i = gt; i < NBP * RH * RDK * 32; i += NGT) { const int v4 = i & 31, d = (i >> 5) & 63, b = i >> 14; int h = (i >> 11) & 7;
                const size_t o0 = (((size_t)b * 32 * RH + h) * RDK + d) * RDV + v4 * 4, cs = (size_t)RH * RDK * RDV; f32x4 kvv[32];
#pragma unroll
                for (int n = 0; n < 32; ++n) kvv[n] = *(const f32x4*)(KV + o0 + n * cs);
                const float gc = FEXP(ret_logg(h) * 128.f); float z0 = 0.f; asm volatile("" : "+v"(z0)); f32x4 sacc = {z0, z0, z0, z0};
#pragma unroll
                for (int n = 0; n < 32; ++n) { *(f32x4*)(SPREV + o0 + n * cs) = sacc; sacc = sacc * gc + kvv[n]; }
                *(f32x4*)(P_OUT + O_RP + ((((size_t)l * NBP + b) * RH + h) * RDK + d) * RDV + v4 * 4) = sacc; }
            { f32x4 gv4[4], bv4[4];
#pragma unroll
              for (int j = 0; j < 4; ++j) { const int q = 2 * (lane + 64 * (j >> 1)) + (j & 1); gv4[j] = ((const f32x4*)(INP(I_GCLN) + l * BRW))[q]; bv4[j] = ((const f32x4*)(INP(I_BCLN) + l * BRW))[q]; }
              bf16* const Y1 = Y + (size_t)1 * M * BRW;
              for (int row = gw; row < M; row += 2 * NGW) { const int rowb = row + NGW;
                  if (rowb < M) { const bf16* const yr[2] = {CONVY + (size_t)row * BRW, CONVY + (size_t)rowb * BRW}; bf16* const orr[2] = {Y1 + (size_t)row * BRW, Y1 + (size_t)rowb * BRW}; convln_rows<2>(yr, gv4, bv4, orr, lane); }
                  else { const bf16* const yr[1] = {CONVY + (size_t)row * BRW}; bf16* const orr[1] = {Y1 + (size_t)row * BRW}; convln_rows<1>(yr, gv4, bv4, orr, lane); } } }
            PROBE_END(3); SEAM(pb + 3);
        }
        if ((PH_MASK >> 4 & 1) && IN(pb + 4)) { TIDS(); LAYER_PTRS(); PROBE_BEGIN(4);
            mixl::retout_s_phase(Z, l, INP(I_SRET), INP(I_GRET), Y + (size_t)3 * M * BRW, gw, NGW, lane);
            ret::out_phase(L + RING_OFF, Z, l, SPREV, INP(I_GRET), Y + (size_t)3 * M * BRW, bx, G, tid, lane, wave);
            PoolOrder S{G, bx, (const char*)ZP, (const char*)(WPOOL_T + (size_t)l * 4 * 256 * 256)};
            pg8::EpiPool E{Y + (size_t)2 * M * BRW, INP(I_SPOOLS), l};
            pg8::gemm_phase<pg8::EpiPool, PoolOrder>(L + RING_OFF, pg8::Dims{BRW, 256, 256}, S, E, tid);
            PROBE_END(4); SEAM(pb + 4);
        }
        if ((PH_MASK >> 5 & 1) && IN(pb + 5)) { TIDS(); LAYER_PTRS(); PROBE_BEGIN(5);
            pg8::SplitOrder S{DM / 256, G, bx, 4, BRW / 64, KS_BR, BRW / 64 / KS_BR, (const char*)Y, (const char*)(WBR_T + (size_t)l * 4 * DM * BRW), (size_t)256 * BRW * 2, (size_t)256 * BRW * 2, (size_t)M * BRW * 2, (size_t)DM * BRW * 2};
            pg8::EpiBr E{Z, MERGED, SLAB, KS_BR};
            pg8::gemm_phase<pg8::EpiBr, pg8::SplitOrder>(L + RING_OFF, pg8::Dims{BRW, BRW, BRW}, S, E, tid);
            {   TAIL_WAVES((DM / 256) * 4 * KS_BR);
                if (filler) { transpose_run<DM, DM>(INP(I_WOUT) + (size_t)l * DM * DM, WOUT_T + (size_t)l * DM * DM, 1, fw, NFW, ln);
                              transpose_run<DM, DFF>(INP(I_WM1) + (size_t)l * DM * DFF, WM1_T + (size_t)l * DFF * DM, 1, fw, NFW, ln); } }
            PROBE_END(5); SEAM(pb + 5);
        }
        if ((PH_MASK >> 6 & 1) && IN(pb + 6)) { TIDS(); LAYER_PTRS(); PROBE_BEGIN(6);
            for (int i = gt; i < MS * DM / 8; i += NGT) { float a[8];
#pragma unroll
                for (int e = 0; e < 8; ++e) a[e] = 0.f;
#pragma unroll
                for (int p = 0; p < 4 * KS_BR; ++p) { const f32x4 v0 = *(const f32x4*)(SLAB + (size_t)p * MS * DM + (size_t)i * 8), v1 = *(const f32x4*)(SLAB + (size_t)p * MS * DM + (size_t)i * 8 + 4);
                    a[0] += v0.x; a[1] += v0.y; a[2] += v0.z; a[3] += v0.w; a[4] += v1.x; a[5] += v1.y; a[6] += v1.z; a[7] += v1.w; }
                st8(MERGED + (size_t)MP * DM + (size_t)i * 8, a); }
            PROBE_END(6); SEAM(pb + 6);
        }
        if ((PH_MASK >> 7 & 1) && IN(pb + 7)) { TIDS(); LAYER_PTRS(); PROBE_BEGIN(7);
            pg8::SplitOrder S{DM / 256, G, bx, 1, DM / 64, KS_OUT, DM / 64 / KS_OUT, (const char*)MERGED, (const char*)(WOUT_T + (size_t)l * DM * DM), (size_t)256 * DM * 2, (size_t)256 * DM * 2, 0, 0};
            pg8::EpiRes E{l == 0 ? (const void*)INP(I_XP) : (const void*)XB, (void*)X1B, l != 0, true, ada + 2 * DM, SLAB};
            pg8::gemm_phase<pg8::EpiRes, pg8::SplitOrder>(L + RING_OFF, pg8::Dims{DM, DM, DM}, S, E, tid);
            {   TAIL_WAVES((DM / 256) * KS_OUT);
                if (filler) transpose_run<DFF, DM>(INP(I_WM2) + (size_t)l * DFF * DM, WM2_T + (size_t)l * DM * DFF, 1, fw, NFW, ln); }
            PROBE_END(7); SEAM(pb + 7);
        }
        if ((PH_MASK >> 8 & 1) && IN(pb + 8)) { TIDS(); LAYER_PTRS(); PROBE_BEGIN(8);
            for (int rs = bx; rs < MS; rs += G) { const int row = MP + rs; const float* ar = ada + (size_t)row_cond(row) * ADAW;
                norm_row_block<KS_OUT>(xinS + (size_t)rs * DM, ar + 2 * DM, SLAB + (size_t)rs * DM, (size_t)MS * DM, X1 + (size_t)row * DM, INP(I_G2) + l * DM, ar + 4 * DM, ar + 3 * DM, H + (size_t)row * DM, (LAS float*)(L + RING_OFF), tid, wave); }
            f32x4 gm[8], shv[8]; int curc = row_cond(gw < MP ? gw : 0); { const float* ar = ada + (size_t)curc * ADAW; load_mod(INP(I_G2) + l * DM, ar + 4 * DM, ar + 3 * DM, gm, shv, lane); }
            for (int row = gw; row < MP; row += 2 * NGW) { const int rowb = row + NGW; const bool pair = rowb < MP && row_cond(rowb) == row_cond(row);
                for (int k = 0; k < 2; ++k) { const int r = k ? rowb : row; if (k && (pair || rowb >= MP)) break; const int cond = row_cond(r); const float* ar = ada + (size_t)cond * ADAW;
                    if (cond != curc) { load_mod(INP(I_G2) + l * DM, ar + 4 * DM, ar + 3 * DM, gm, shv, lane); curc = cond; }
                    if (pair) norm_row2<true>(X1B + (size_t)row * DM, X1B + (size_t)rowb * DM, gm, shv, H + (size_t)row * DM, H + (size_t)rowb * DM, lane);
                    else norm_row<true>(X1B + (size_t)r * DM, gm, shv, H + (size_t)r * DM, lane); } }
            PROBE_END(8); SEAM(pb + 8);
        }
        if ((PH_MASK >> 9 & 1) && IN(pb + 9)) { TIDS(); LAYER_PTRS(); PROBE_BEGIN(9);
            pg8::SplitOrder S{DFF / 256, G, bx, 1, DM / 64, KS_M1, DM / 64 / KS_M1, (const char*)H, (const char*)(WM1_T + (size_t)l * DFF * DM), (size_t)256 * DM * 2, (size_t)256 * DM * 2, 0, 0};
            pg8::EpiMlp1 E{HID, SLAB};
            pg8::gemm_phase<pg8::EpiMlp1, pg8::SplitOrder>(L + RING_OFF, pg8::Dims{DM, DM, DM}, S, E, tid);
            {
                TAIL_LANE(); const int f0 = (DFF / 256) * KS_M1 < G ? (DFF / 256) * KS_M1 : 0;
                if (bx >= f0) { const int st = (G - f0) * NTHR;
                    float zf = 0.f; asm volatile("" : "+v"(zf));
                    for (int i0 = (bx - f0) * NTHR + tid2; i0 < N_SHIFT_ITEMS; i0 += 4 * st) { f32x4 v[4]; float* dp[4];
#pragma unroll
                        for (int u = 0; u < 4; ++u) { const int idx = i0 + u * st; dp[u] = nullptr; v[u] = f32x4{zf, zf, zf, zf};
                            if (idx < N_SHIFT_ITEMS) { const float* sp; shift_addr(l, idx, INP(I_CK), INP(I_CV), INP(I_SCONV), INP(I_SPOOL), P_OUT, sp, dp[u]); v[u] = *(const f32x4*)sp; } }
                        asm volatile("" ::: "memory");
#pragma unroll
                        for (int u = 0; u < 4; ++u) if (dp[u]) *(f32x4*)dp[u] = v[u]; }
                    int l1 = l + 1; asm volatile("" : "+s"(l1));
                    if (l1 < DEPTH) transpose_run<DM, ZW, true>(INP(I_WIN) + (size_t)l1 * DM * ZW, WIN_T + (size_t)l1 * ZW * DM, 1, (bx - f0) * NWAVES + wave0, (G - f0) * NWAVES, ln, 0, WIN_ITEMS / 2); } }
            PROBE_END(9); SEAM(pb + 9);
        }
        if ((PH_MASK >> 10 & 1) && IN(pb + 10)) { TIDS(); LAYER_PTRS(); PROBE_BEGIN(10);
            for (int i = gt; i < MS * DFF / 8; i += NGT) { float a[8];
#pragma unroll
                for (int e = 0; e < 8; ++e) a[e] = 0.f;
#pragma unroll
                for (int p = 0; p < KS_M1; ++p) { const f32x4 v0 = *(const f32x4*)(SLAB + (size_t)p * MS * DFF + (size_t)i * 8), v1 = *(const f32x4*)(SLAB + (size_t)p * MS * DFF + (size_t)i * 8 + 4);
                    a[0] += v0.x; a[1] += v0.y; a[2] += v0.z; a[3] += v0.w; a[4] += v1.x; a[5] += v1.y; a[6] += v1.z; a[7] += v1.w; }
#pragma unroll
                for (int e = 0; e < 8; ++e) { const float t = fmaxf(a[e], 0.f); a[e] = t * t; }
                st8(HID + (size_t)MP * DFF + (size_t)i * 8, a); }
            PROBE_END(10); SEAM(pb + 10);
        }
        if ((PH_MASK >> 11 & 1) && IN(pb + 11)) { TIDS(); LAYER_PTRS(); PROBE_BEGIN(11);
            pg8::SplitOrder S{DM / 256, G, bx, 1, DFF / 64, KS_M2, DFF / 64 / KS_M2, (const char*)HID, (const char*)(WM2_T + (size_t)l * DM * DFF), (size_t)256 * DFF * 2, (size_t)256 * DFF * 2, 0, 0};
            pg8::EpiRes E{(const void*)X1B, l == DEPTH - 1 ? (void*)P_OUT : (void*)XB, true, l != DEPTH - 1, ada + 5 * DM, SLAB};
            pg8::gemm_phase<pg8::EpiRes, pg8::SplitOrder>(L + RING_OFF, pg8::Dims{DFF, DFF, DFF}, S, E, tid);
            {
                TAIL_LANE(); const int f0 = (DM / 256) * KS_M2 < G ? (DM / 256) * KS_M2 : 0; constexpr int NI = SB * RH * RDK * 32;
                if (bx >= f0) { const int st = (G - f0) * NTHR;
                    float zf = 0.f; asm volatile("" : "+v"(zf));
                    for (int i0 = (bx - f0) * NTHR + tid2; i0 < NI; i0 += 2 * st) { f32x4 r[2]; float* op[2];
#pragma unroll
                        for (int u = 0; u < 2; ++u) { const int i = i0 + u * st; op[u] = nullptr; r[u] = f32x4{zf, zf, zf, zf};
                            if (i < NI) { const int v4 = i & 31, d = (i >> 5) & 63, h = (i >> 11) & 7, sb = i >> 14; r[u] = retstate_s_val(Z, l, sb, h, d, v4, INP(I_SRET), P_OUT, op[u]); } }
                        asm volatile("" ::: "memory");
#pragma unroll
                        for (int u = 0; u < 2; ++u) if (op[u]) *(f32x4*)op[u] = r[u]; }
                    int l1 = l + 1; asm volatile("" : "+s"(l1));
                    if (l1 < DEPTH) transpose_run<DM, ZW, true>(INP(I_WIN) + (size_t)l1 * DM * ZW, WIN_T + (size_t)l1 * ZW * DM, 1, (bx - f0) * NWAVES + wave0, (G - f0) * NWAVES, ln, WIN_ITEMS / 2, WIN_ITEMS); } }
            PROBE_END(11); SEAM(pb + 11);
        }
    }
    if ((PH_MASK >> 14 & 1) && IN(PH_TOTAL - 1)) { TIDS(); PROBE_BEGIN(14);
        const float* ada = ADA + (size_t)(DEPTH - 1) * NROWB * ADAW; float* yo = P_OUT + O_YS;
        for (int i = gt; i < MS * DM / 4; i += NGT) { const int row = i / (DM / 4), c4 = i % (DM / 4); const float* gp = ada + (size_t)(NBP + (row >> 3)) * ADAW + 5 * DM;
            f32x4 a = {0.f, 0.f, 0.f, 0.f};
#pragma unroll
            for (int p = 0; p < KS_M2; ++p) a += *(const f32x4*)(SLAB + (size_t)p * MS * DM + (size_t)i * 4);
            *(f32x4*)(yo + (size_t)i * 4) = *(const f32x4*)(X1 + (size_t)(MP + row) * DM + c4 * 4) + *(const f32x4*)(gp + c4 * 4) * a; }
        PROBE_END(14);
    }
#undef IN
#undef SEAM
}

extern "C" void kernel_launch(void* const* d_in, const int* in_sizes, int n_in, void* d_out, int out_size, void* d_ws, size_t ws_size, hipStream_t stream) {
    static int grid = 0;
    if (grid == 0) {
        if (n_in != N_IN || (size_t)out_size != O_END || ws_size < WS_END) { fprintf(stderr, "kernel_launch: unexpected shapes: n_in %d out %d ws %zu (need %zu)\n", n_in, out_size, ws_size, (size_t)WS_END); grid = -1; return; }
        int dev = 0, cus = 0, per_cu = 0;
        if (hipGetDevice(&dev) != hipSuccess || hipDeviceGetAttribute(&cus, hipDeviceAttributeMultiprocessorCount, dev) != hipSuccess) { grid = -1; return; }
        if (hipFuncSetAttribute((const void*)fwd, hipFuncAttributeMaxDynamicSharedMemorySize, LDS_BYTES) != hipSuccess) { fprintf(stderr, "kernel_launch: hipFuncSetAttribute failed\n"); grid = -1; return; }
        if (hipOccupancyMaxActiveBlocksPerMultiprocessor(&per_cu, (const void*)fwd, NTHR, LDS_BYTES) != hipSuccess || per_cu < 1) fprintf(stderr, "kernel_launch: occupancy query says %d\n", per_cu);
        (void)hipGetLastError();
        grid = cus;
    }
    if (grid < 0) return;
    (void)hipMemsetAsync((char*)d_ws + WS_CTL, 0, CTL_ZERO_BYTES, stream);
    Args a{};
    for (int i = 0; i < N_IN; ++i) a.in[i] = (const float*)d_in[i];
    a.out = (float*)d_out; a.ws = (unsigned char*)d_ws;
#if MK_ONE_LAUNCH
    a.ph_lo = 0; a.ph_hi = PH_TOTAL;
    hipLaunchKernelGGL(fwd, dim3(grid), dim3(NTHR), LDS_BYTES, stream, a);
#else
    for (int p = 0; p < PH_TOTAL; ++p) { a.ph_lo = p; a.ph_hi = p + 1; hipLaunchKernelGGL(fwd, dim3(grid), dim3(NTHR), LDS_BYTES, stream, a); }
#endif
}
#endif
```

```cpp
#ifndef HOST_TEST_ONLY
#include <hip/hip_runtime.h>
#endif
#include <cstdio>
#include <cstdint>
#include <cmath>

#ifndef MK_ONE_LAUNCH
#define MK_ONE_LAUNCH 1
#endif

#define HD __host__ __device__ __forceinline__
typedef unsigned short bf16;
HD float bf2f(bf16 b) { return __builtin_bit_cast(float, ((unsigned)b) << 16); }
HD bf16 f2bf(float f) { unsigned u = __builtin_bit_cast(unsigned, f); return (bf16)((u + 0x7fffu + ((u >> 16) & 1u)) >> 16); }

HD void ld8(const bf16* p, float* f) { const uint4 w = *(const uint4*)p;
    f[0] = __builtin_bit_cast(float, w.x << 16); f[1] = __builtin_bit_cast(float, w.x & 0xffff0000u); f[2] = __builtin_bit_cast(float, w.y << 16); f[3] = __builtin_bit_cast(float, w.y & 0xffff0000u);
    f[4] = __builtin_bit_cast(float, w.z << 16); f[5] = __builtin_bit_cast(float, w.z & 0xffff0000u); f[6] = __builtin_bit_cast(float, w.w << 16); f[7] = __builtin_bit_cast(float, w.w & 0xffff0000u); }
HD void st8(bf16* p, const float* f) { uint4 w; w.x = (unsigned)f2bf(f[0]) | ((unsigned)f2bf(f[1]) << 16); w.y = (unsigned)f2bf(f[2]) | ((unsigned)f2bf(f[3]) << 16);
    w.z = (unsigned)f2bf(f[4]) | ((unsigned)f2bf(f[5]) << 16); w.w = (unsigned)f2bf(f[6]) | ((unsigned)f2bf(f[7]) << 16); *(uint4*)p = w; }
constexpr int DM = 2048, SEQ = 4096, NBP = 2, MP = NBP * SEQ, SB = 32, ST = 8, MS = SB * ST, M = MP + MS, DEPTH = 4;
constexpr int NROWB = NBP + SB;
constexpr int NH = 16, HDIM = 64, NKV = 4, WIN = 128, BRW = 1024, CONVK = 31, CPRE = 30, PPAD = 15, RH = 8, RDK = 64, RDV = 128, DFF = 8192;
constexpr int ZW = 15872, ZQ = 0, ZK = 1024, ZV = 1280, ZCA = 1536, ZCG = 2560, ZPL = 3584, ZRQ = 4608, ZRK = 5120, ZRV = 5632, ZRG = 6656, ZGT = 7680;
constexpr int ADAW = 6 * DM;
constexpr float EPS = 1e-6f;
constexpr size_t O_YP = 0, O_YS = O_YP + (size_t)MP * DM, O_KP = O_YS + (size_t)MS * DM, O_VP = O_KP + (size_t)DEPTH * NBP * WIN * 256,
    O_CP = O_VP + (size_t)DEPTH * NBP * WIN * 256, O_PP = O_CP + (size_t)DEPTH * NBP * CPRE * BRW, O_RP = O_PP + (size_t)DEPTH * NBP * PPAD * BRW,
    O_KS = O_RP + (size_t)DEPTH * NBP * RH * RDK * RDV, O_VS = O_KS + (size_t)DEPTH * SB * WIN * 256, O_CS = O_VS + (size_t)DEPTH * SB * WIN * 256,
    O_PS = O_CS + (size_t)DEPTH * SB * CPRE * BRW, O_RS = O_PS + (size_t)DEPTH * SB * PPAD * BRW, O_END = O_RS + (size_t)DEPTH * SB * RH * RDK * RDV;
static_assert(O_END == 41394176, "output size");
enum { I_XP = 0, I_XS, I_CP, I_CS, I_CK, I_CV, I_SCONV, I_SPOOL, I_SRET, I_WADA, I_BADA, I_G1, I_G2, I_WIN, I_GQ, I_GK, I_SINK, I_WDW, I_BDW, I_GCLN, I_BCLN,
       I_WPOOL, I_SPOOLS, I_GRET, I_WBR, I_WOUT, I_WM1, I_WM2, N_IN };

HD bool row_is_s(int row) { return row >= MP; }
HD int row_cond(int row) { return row < MP ? (row >> 12) : NBP + ((row - MP) >> 3); }

#if defined(__HIP_DEVICE_COMPILE__)
#define FEXP(x) __expf(x)
#else
#define FEXP(x) expf(x)
#endif
#if defined(__HIP_DEVICE_COMPILE__)
HD float sigmoidf_(float x) { return __builtin_amdgcn_rcpf(1.f + __expf(-x)); }
#else
HD float sigmoidf_(float x) { return 1.f / (1.f + FEXP(-x)); }
#endif
HD float ret_logg(int h) { const float x = __builtin_bit_cast(float, (unsigned)(127 - 5 - h) << 23); return -x * (1.f + x * (0.5f + x * (0.33333334f + x * (0.25f + x * 0.2f)))); }

HD void qknorm_item(bf16* Z, int l, int row, int slot, const float* gq, const float* gk, float* out) {
    const int col = slot < 16 ? ZQ + slot * 64 : (slot < 20 ? ZK + (slot - 16) * 64 : ZV + (slot - 20) * 64);
    bf16* p = Z + (size_t)row * ZW + col;
    float v[64];
#pragma unroll
    for (int i = 0; i < 64; i += 8) ld8(p + i, v + i);
    if (slot < 20) {
        float ss = 0.f;
#pragma unroll
        for (int i = 0; i < 64; ++i) ss += v[i] * v[i];
        const float r = 1.f / sqrtf(ss * (1.f / 64.f) + EPS);
        const float* g = (slot < 16 ? gq : gk) + l * 64;
#pragma unroll
        for (int i = 0; i < 64; ++i) v[i] = v[i] * r * g[i];
#pragma unroll
        for (int i = 0; i < 64; i += 8) st8(p + i, v + i);
    }
    if (slot >= 16) {
        const int kvh = (slot - 16) & 3; const bool isv = slot >= 20;
        float* o = nullptr;
        if (!row_is_s(row)) { const int b = row >> 12, t = row & (SEQ - 1);
            if (t >= SEQ - WIN) o = out + (isv ? O_VP : O_KP) + ((((size_t)l * NBP + b) * WIN + (t - (SEQ - WIN))) * NKV + kvh) * 64;
        } else { const int sb = (row - MP) >> 3, t = (row - MP) & 7;
            o = out + (isv ? O_VS : O_KS) + ((((size_t)l * SB + sb) * WIN + (WIN - ST + t)) * NKV + kvh) * 64; }
        if (o) {
#pragma unroll
            for (int i = 0; i < 64; ++i) o[i] = v[i];
        }
    }
}
HD void shift_addr(int l, int idx, const float* ck, const float* cv, const float* sconv, const float* spool, float* out, const float*& src, float*& dst) {
    constexpr int NKVS = SB * (WIN - ST) * 64, NCV = SB * (CPRE - ST) * 256, NPL = SB * (PPAD - ST) * 256;
    if (idx < 2 * NKVS) { const bool isv = idx >= NKVS; const int i = isv ? idx - NKVS : idx; const int sb = i / ((WIN - ST) * 64), rem = i % ((WIN - ST) * 64);
        src = (isv ? cv : ck) + (((size_t)l * SB + sb) * WIN + ST) * 256 + (size_t)rem * 4; dst = out + (isv ? O_VS : O_KS) + (((size_t)l * SB + sb) * WIN) * 256 + (size_t)rem * 4;
    } else if (idx < 2 * NKVS + NCV) { const int i = idx - 2 * NKVS; const int sb = i / ((CPRE - ST) * 256), rem = i % ((CPRE - ST) * 256);
        src = sconv + (((size_t)l * SB + sb) * CPRE + ST) * BRW + (size_t)rem * 4; dst = out + O_CS + (((size_t)l * SB + sb) * CPRE) * BRW + (size_t)rem * 4;
    } else { const int i = idx - 2 * NKVS - NCV; const int sb = i / ((PPAD - ST) * 256), rem = i % ((PPAD - ST) * 256);
        src = spool + (((size_t)l * SB + sb) * PPAD + ST) * BRW + (size_t)rem * 4; dst = out + O_PS + (((size_t)l * SB + sb) * PPAD) * BRW + (size_t)rem * 4; }
}
HD void shift_item(int l, int idx, const float* ck, const float* cv, const float* sconv, const float* spool, float* out) {
    const float* src; float* dst; shift_addr(l, idx, ck, cv, sconv, spool, out, src, dst);
    dst[0] = src[0]; dst[1] = src[1]; dst[2] = src[2]; dst[3] = src[3];
}
constexpr int N_SHIFT_ITEMS = 2 * SB * (WIN - ST) * 64 + SB * (CPRE - ST) * 256 + SB * (PPAD - ST) * 256;

HD float glu_at(const bf16* Z, int row, int c) { const bf16* p = Z + (size_t)row * ZW; return bf2f(p[ZCA + c]) * sigmoidf_(bf2f(p[ZCG + c])); }
HD void conv_item(const bf16* Z, int l, int row, int c, const float* wdw, const float* bdw, const float* sconv, float* CONVY, float* out) {
    float acc = bdw[l * BRW + c];
    const float* w = wdw + (size_t)l * CONVK * BRW + c;
    if (!row_is_s(row)) { const int b = row >> 12, t = row & (SEQ - 1);
        for (int j = 0; j < CONVK; ++j) { const int tt = t - CPRE + j; if (tt >= 0) acc += w[(size_t)j * BRW] * glu_at(Z, b * SEQ + tt, c); }
        if (t >= SEQ - CPRE) out[O_CP + (((size_t)l * NBP + b) * CPRE + (t - (SEQ - CPRE))) * BRW + c] = glu_at(Z, row, c);
    } else { const int sb = (row - MP) >> 3, t = (row - MP) & 7;
        for (int j = 0; j < CONVK; ++j) { const int tt = t - CPRE + j;
            const float u = tt >= 0 ? glu_at(Z, MP + sb * ST + tt, c) : sconv[(((size_t)l * SB + sb) * CPRE + (CPRE + tt)) * BRW + c];
            acc += w[(size_t)j * BRW] * u; }
        out[O_CS + (((size_t)l * SB + sb) * CPRE + (CPRE - ST + t)) * BRW + c] = glu_at(Z, row, c);
    }
    CONVY[(size_t)row * BRW + c] = acc;
}
HD void pool_item(const bf16* Z, int l, int row, int c, const float* spool, bf16* ZP, float* out) {
    const int g = c >> 8, w = 2 << g;
    const float u0 = bf2f(Z[(size_t)row * ZW + ZPL + c]);
    float sum = 0.f, cnt;
    if (!row_is_s(row)) { const int b = row >> 12, t = row & (SEQ - 1);
        for (int i = 0; i < w; ++i) if (t - i >= 0) sum += bf2f(Z[(size_t)(b * SEQ + t - i) * ZW + ZPL + c]);
        cnt = (float)((t + 1) < w ? (t + 1) : w);
        if (t >= SEQ - PPAD) out[O_PP + (((size_t)l * NBP + b) * PPAD + (t - (SEQ - PPAD))) * BRW + c] = u0;
    } else { const int sb = (row - MP) >> 3, t = (row - MP) & 7;
        for (int i = 0; i < w; ++i) { const int tt = t - i;
            sum += tt >= 0 ? bf2f(Z[(size_t)(MP + sb * ST + tt) * ZW + ZPL + c]) : spool[(((size_t)l * SB + sb) * PPAD + (PPAD + tt)) * BRW + c]; }
        cnt = (float)w;
        out[O_PS + (((size_t)l * SB + sb) * PPAD + (PPAD - ST + t)) * BRW + c] = u0;
    }
    ZP[(size_t)row * BRW + c] = f2bf(sum / cnt - u0);
}
HD void retkv_item(const bf16* Z, float* KV, int b, int n, int h, int d, int v4) {
    const float lg = ret_logg(h);
    float a0 = 0.f, a1 = 0.f, a2 = 0.f, a3 = 0.f;
    for (int j = 0; j < 128; ++j) { const bf16* p = Z + (size_t)(b * SEQ + n * 128 + j) * ZW;
        const float kd = bf2f(p[ZRK + h * 64 + d]) * 0.125f * FEXP(lg * (float)(127 - j));
        const bf16* pv = p + ZRV + h * 128 + v4 * 4;
        a0 += kd * bf2f(pv[0]); a1 += kd * bf2f(pv[1]); a2 += kd * bf2f(pv[2]); a3 += kd * bf2f(pv[3]); }
    float* o = KV + ((((size_t)b * 32 + n) * RH + h) * RDK + d) * RDV + v4 * 4;
    o[0] = a0; o[1] = a1; o[2] = a2; o[3] = a3;
}
HD void retstate_s_item(const bf16* Z, int l, int sb, int h, int d, int v4, const float* sret, float* out) {
    const float lg = ret_logg(h);
    const size_t so = ((((size_t)l * SB + sb) * RH + h) * RDK + d) * RDV + v4 * 4;
    const float gc = FEXP(lg * (float)ST);
    float a0 = gc * sret[so], a1 = gc * sret[so + 1], a2 = gc * sret[so + 2], a3 = gc * sret[so + 3];
#pragma unroll
    for (int j = 0; j < ST; ++j) { const bf16* p = Z + (size_t)(MP + sb * ST + j) * ZW;
        const float kd = bf2f(p[ZRK + h * 64 + d]) * 0.125f * FEXP(lg * (float)(ST - 1 - j));
        const bf16* pv = p + ZRV + h * 128 + v4 * 4;
        a0 += kd * bf2f(pv[0]); a1 += kd * bf2f(pv[1]); a2 += kd * bf2f(pv[2]); a3 += kd * bf2f(pv[3]); }
    float* o = out + O_RS + so; o[0] = a0; o[1] = a1; o[2] = a2; o[3] = a3;
}
HD void retscan_item(const float* KV, float* SPREV, int l, int b, int h, int d, int v4, float* out) {
    const float gc = FEXP(ret_logg(h) * 128.f);
    float s0 = 0.f, s1 = 0.f, s2 = 0.f, s3 = 0.f;
    for (int n = 0; n < 32; ++n) { const size_t o = ((((size_t)b * 32 + n) * RH + h) * RDK + d) * RDV + v4 * 4;
        SPREV[o] = s0; SPREV[o + 1] = s1; SPREV[o + 2] = s2; SPREV[o + 3] = s3;
        s0 = gc * s0 + KV[o]; s1 = gc * s1 + KV[o + 1]; s2 = gc * s2 + KV[o + 2]; s3 = gc * s3 + KV[o + 3]; }
    float* oo = out + O_RP + ((((size_t)l * NBP + b) * RH + h) * RDK + d) * RDV + v4 * 4;
    oo[0] = s0; oo[1] = s1; oo[2] = s2; oo[3] = s3;
}
HD void attn_item(const bf16* Z, int l, int row, int hq, const float* sinks, const float* ck, const float* cv, bf16* Y0) {
    const int kvh = hq >> 2; const float slope = exp2f(-0.5f * (float)(hq + 1));
    float q[64];
    { const bf16* p = Z + (size_t)row * ZW + ZQ + hq * 64;
#pragma unroll
      for (int i = 0; i < 64; i += 8) ld8(p + i, q + i);
#pragma unroll
      for (int i = 0; i < 64; ++i) q[i] *= 0.125f; }
    float m = sinks[l * NH + hq], lsum = 1.f;
    float o[64];
#pragma unroll
    for (int i = 0; i < 64; ++i) o[i] = 0.f;
    const bool smp = row_is_s(row);
    const int b = smp ? ((row - MP) >> 3) : (row >> 12), t = smp ? ((row - MP) & 7) : (row & (SEQ - 1));
    const int lo = smp ? t : (t - WIN > 0 ? t - WIN : 0), hi = smp ? WIN + t : t;
    for (int j = lo; j <= hi; ++j) {
        const int dist = smp ? (WIN + t - j) : (t - j);
        const bool cache = smp && j < WIN;
        const size_t zrow = (size_t)(smp ? (MP + b * ST + (j - WIN)) : (b * SEQ + j)) * ZW;
        const size_t crow = ((((size_t)l * SB + b) * WIN + j) * NKV + kvh) * 64;
        float s = 0.f;
        if (cache) { const float* kp = ck + crow;
#pragma unroll
            for (int i = 0; i < 64; ++i) s += q[i] * kp[i];
        } else { const bf16* kp = Z + zrow + ZK + kvh * 64;
#pragma unroll
            for (int i = 0; i < 64; i += 8) { float f[8]; ld8(kp + i, f);
#pragma unroll
                for (int e = 0; e < 8; ++e) s += q[i + e] * f[e]; } }
        s -= slope * (float)dist;
        if (s > m) { const float corr = FEXP(m - s); lsum *= corr;
#pragma unroll
            for (int i = 0; i < 64; ++i) o[i] *= corr;
            m = s; }
        const float p = FEXP(s - m); lsum += p;
        if (cache) { const float* vp = cv + crow;
#pragma unroll
            for (int i = 0; i < 64; ++i) o[i] += p * vp[i];
        } else { const bf16* vp = Z + zrow + ZV + kvh * 64;
#pragma unroll
            for (int i = 0; i < 64; i += 8) { float f[8]; ld8(vp + i, f);
#pragma unroll
                for (int e = 0; e < 8; ++e) o[i + e] += p * f[e]; } }
    }
    const float inv = 1.f / lsum;
    bf16* y = Y0 + (size_t)row * BRW + hq * 64;
#pragma unroll
    for (int i = 0; i < 64; ++i) o[i] *= inv;
#pragma unroll
    for (int i = 0; i < 64; i += 8) st8(y + i, o + i);
}
HD void retout_item(const bf16* Z, int l, int row, int h, const float* SPREV, const float* sret, const float* gret, float* ORAW, bf16* Y3) {
    const float lg = ret_logg(h);
    const bool smp = row_is_s(row);
    const int b = smp ? ((row - MP) >> 3) : (row >> 12), t = smp ? ((row - MP) & 7) : (row & (SEQ - 1));
    const int i = smp ? t : (t & 127), n = smp ? 0 : (t >> 7);
    const int row0 = smp ? (MP + b * ST) : (b * SEQ + n * 128);
    const float* S = smp ? sret + (((size_t)l * SB + b) * RH + h) * RDK * RDV : SPREV + (((size_t)b * 32 + n) * RH + h) * RDK * RDV;
    float q[64];
    { const bf16* p = Z + (size_t)row * ZW + ZRQ + h * 64;
#pragma unroll
      for (int d = 0; d < 64; d += 8) ld8(p + d, q + d); }
    float* oraw = ORAW + (size_t)row * BRW + h * 128;
    float sum = 0.f;
    for (int half = 0; half < 2; ++half) {
        float o[64];
#pragma unroll
        for (int v = 0; v < 64; ++v) o[v] = 0.f;
        for (int j = 0; j <= i; ++j) { const bf16* p = Z + (size_t)(row0 + j) * ZW;
            const bf16* kp = p + ZRK + h * 64; float s = 0.f;
#pragma unroll
            for (int d = 0; d < 64; d += 8) { float f[8]; ld8(kp + d, f);
#pragma unroll
                for (int e = 0; e < 8; ++e) s += q[d + e] * f[e]; }
            s *= 0.125f * FEXP(lg * (float)(i - j));
            const bf16* vp = p + ZRV + h * 128 + half * 64;
#pragma unroll
            for (int v = 0; v < 64; v += 8) { float f[8]; ld8(vp + v, f);
#pragma unroll
                for (int e = 0; e < 8; ++e) o[v + e] += s * f[e]; } }
        const float cf = FEXP(lg * (float)(i + 1));
        const bf16* qp = Z + (size_t)row * ZW + ZRQ + h * 64;
        for (int d = 0; d < 64; ++d) { const float qd = bf2f(qp[d]) * cf; const float* sp = S + (size_t)d * RDV + half * 64;
#pragma unroll
            for (int v = 0; v < 64; ++v) o[v] += qd * sp[v]; }
#pragma unroll
        for (int v = 0; v < 64; ++v) { oraw[half * 64 + v] = o[v]; sum += o[v]; }
    }
    const float mean = sum * (1.f / 128.f);
    float var = 0.f;
    for (int v = 0; v < 128; ++v) { const float d = oraw[v] - mean; var += d * d; }
    const float rstd = 1.f / sqrtf(var * (1.f / 128.f) + EPS);
    const float* g = gret + l * BRW + h * 128;
    const bf16* rg = Z + (size_t)row * ZW + ZRG + h * 128;
    bf16* y = Y3 + (size_t)row * BRW + h * 128;
    for (int v = 0; v < 128; ++v) y[v] = f2bf((oraw[v] - mean) * rstd * g[v] * bf2f(rg[v]));
}

#if !defined(HOST_TEST_ONLY)
namespace pg8 {
#define PG8_LAS __attribute__((address_space(3)))
typedef short bf16x8 __attribute__((ext_vector_type(8)));
typedef float f32x4 __attribute__((ext_vector_type(4)));
typedef float f32x2 __attribute__((ext_vector_type(2)));
typedef unsigned u32x4 __attribute__((ext_vector_type(4)));
typedef unsigned u32x2 __attribute__((ext_vector_type(2)));
constexpr int BM = 256, BK = 64, HALF = 128, HTB = HALF * BK * 2, STAGE_BYTES = 8 * HTB, NXCD = 8, WGM = 8;

__host__ __device__ __forceinline__ int lds_byte(int r, int c) { const int st = (r >> 4) * 2 + (c >> 5), rr = r & 15, cc = c & 31, ob = rr * 64 + cc * 2; return st * 1024 + (ob ^ (((ob >> 9) & 1) << 5)); }
__host__ __device__ __forceinline__ void stage_rc(int b, int& R, int& C) { const int st = b / 1024, sb = b % 1024, swz = sb ^ (((sb >> 9) & 1) << 5); R = (st >> 1) * 16 + swz / 64; C = (st & 1) * 32 + (swz % 64) / 2; }
__host__ __device__ __forceinline__ int perm32(int rho) { const int n = rho >> 4, i = rho & 15; return 8 * (i >> 2) + 4 * n + (i & 3); }

struct Unit { int pm, pn, r, ks, nt; const char* a; const char* b; };
struct Dims { int lda, ldb, K; };

__host__ __device__ __forceinline__ void tile_of(int L, int nM, int nN, int& pm, int& pn) {
    const int nwg = nM * nN; int wgid = L; { const int q = nwg / NXCD, r = nwg % NXCD, xcd = wgid % NXCD, off = wgid / NXCD; wgid = (xcd < r ? xcd * (q + 1) : r * (q + 1) + (xcd - r) * q) + off; }
    const int nig = WGM * nN, gid = wgid / nig, fm = gid * WGM, gsz = (nM - fm) < WGM ? (nM - fm) : WGM;
    pm = fm + ((wgid % nig) % gsz); pn = (wgid % nig) / gsz;
}
struct StaticOrder {
    int nM, nN, nwg, G, c, nt; const char* A; const char* B; size_t ta, tb;
    __device__ __forceinline__ void init(const bf16* A_, const bf16* B_, int nM_, int nN_, int lda, int ldb, int K, int G_, int c_) { A = (const char*)A_; B = (const char*)B_; nM = nM_; nN = nN_; nwg = nM * nN; G = G_; c = c_; nt = K / BK; ta = (size_t)BM * lda * 2; tb = (size_t)BM * ldb * 2; }
    __device__ __forceinline__ bool next(int i, Unit& u) const {
        const long L = (long)i * G + c; if (L >= nwg) return false;
        tile_of((int)L, nM, nN, u.pm, u.pn); u.r = 0; u.ks = 0; u.nt = nt; u.a = A + (size_t)u.pm * ta; u.b = B + (size_t)u.pn * tb; return true;
    }
};


struct SplitOrder {
    int nN, G, c, RPT, ntP, KS, ntS; const char* A; const char* B; size_t ta, tb, sAr, sBr;
    __device__ __forceinline__ bool next(int i, Unit& u) const {
        const int nP = (MP / BM) * nN, Pc = c < nP ? (nP - c + G - 1) / G : 0;
        if (i < Pc * RPT) { const int tl = (i / RPT) * G + c; tile_of(tl, MP / BM, nN, u.pm, u.pn); u.r = i % RPT; u.ks = 0; u.nt = ntP;
            u.a = A + (size_t)u.r * sAr + (size_t)u.pm * ta; u.b = B + (size_t)u.r * sBr + (size_t)u.pn * tb; return true; }
        const int su = (i - Pc * RPT) * G + c; if (su >= nN * RPT * KS) return false;
        u.pm = MP / BM; u.pn = su / (RPT * KS); u.r = (su / KS) % RPT; u.ks = su % KS; u.nt = ntS;
        u.a = A + (size_t)u.r * sAr + (size_t)u.pm * ta + (size_t)u.ks * ntS * (BK * 2); u.b = B + (size_t)u.r * sBr + (size_t)u.pn * tb + (size_t)u.ks * ntS * (BK * 2); return true;
    }
};

__device__ __forceinline__ unsigned cvt_pk_bf16(float lo, float hi) { unsigned r; asm volatile("v_cvt_pk_bf16_f32 %0, %1, %2" : "=v"(r) : "v"(lo), "v"(hi)); return r; }

template <class Epi, class Sched, bool ALIGN_EPI = true, bool SP2 = true>
__device__ __forceinline__ void gemm_phase(PG8_LAS unsigned char* lds, const Dims g, const Sched& S, const Epi& E, const int tid) {
    const int wid = __builtin_amdgcn_readfirstlane(tid >> 6), lane = tid & 63, wr = wid >> 2, wc = wid & 3, fr = lane & 15, fq = lane >> 4;
    unsigned voffA[2], voffB[2];
#pragma unroll
    for (int i = 0; i < 2; ++i) { int R, C; stage_rc(tid * 16 + i * 8192, R, C); const int Rb = Epi::PERM ? ((R & ~31) + perm32(R & 31)) : R;
        voffA[i] = (unsigned)(R * g.lda + C) * 2u; voffB[i] = (unsigned)(Rb * g.ldb + C) * 2u; }
    const size_t kstep = (size_t)(BK * 2);
    const size_t hstepA = (size_t)HALF * g.lda * 2, hstepB = (size_t)HALF * g.ldb * 2;
    const unsigned ldsw = (unsigned)wid * 1024u;
    const int aoff = lds_byte(wr * 64 + fr, fq * 8), boff = lds_byte(wc * 32 + fr, fq * 8);
#define PG8_SA(b, h) (((b) * 2 + (h)) * HTB)
#define PG8_SB(b, h) ((4 + (b) * 2 + (h)) * HTB)
#define PG8_STAGE(bufoff, gbase, voff) do { _Pragma("unroll") for (int _i = 0; _i < 2; ++_i) \
        __builtin_amdgcn_global_load_lds((const unsigned*)((const char*)(gbase) + (voff)[_i]), (PG8_LAS unsigned*)(lds + (bufoff) + ldsw + _i * 8192), 16, 0, 0); } while (0)
#define PG8_LDA(dst, b, h) do { _Pragma("unroll") for (int m = 0; m < 4; ++m) _Pragma("unroll") for (int k = 0; k < 2; ++k) dst[m][k] = *(const PG8_LAS bf16x8*)(lds + PG8_SA(b, h) + aoff + m * 2048 + k * 1024); } while (0)
#define PG8_LDB(dst, b, h) do { _Pragma("unroll") for (int n = 0; n < 2; ++n) _Pragma("unroll") for (int k = 0; k < 2; ++k) dst[n][k] = *(const PG8_LAS bf16x8*)(lds + PG8_SB(b, h) + boff + n * 2048 + k * 1024); } while (0)
#define PG8_MMA(ai, bj, At, Bt) do { __builtin_amdgcn_s_setprio(1); _Pragma("unroll") for (int m = 0; m < 4; ++m) _Pragma("unroll") for (int n = 0; n < 2; ++n) _Pragma("unroll") for (int k = 0; k < 2; ++k) \
        acc[ai][bj][m][n] = __builtin_amdgcn_mfma_f32_16x16x32_bf16(Bt[n][k], At[m][k], acc[ai][bj][m][n], 0, 0, 0); __builtin_amdgcn_s_setprio(0); } while (0)
#define PG8_WAIT_V(n) asm volatile("s_waitcnt vmcnt(" #n ")" ::: "memory")
#define PG8_WAIT_L(n) asm volatile("s_waitcnt lgkmcnt(" #n ")" ::: "memory")
#define PG8_BAR __builtin_amdgcn_s_barrier()
#define PG8_SCHED __builtin_amdgcn_sched_barrier(0)
    Unit cur, nxt; int ui = 0;
    if (!S.next(0, cur)) return;
    f32x4 acc[2][2][4][2];
#pragma unroll
    for (int a = 0; a < 2; ++a)
#pragma unroll
        for (int b = 0; b < 2; ++b)
#pragma unroll
            for (int m = 0; m < 4; ++m)
#pragma unroll
                for (int n = 0; n < 2; ++n) acc[a][b][m][n] = (f32x4){0.f, 0.f, 0.f, 0.f};
    bf16x8 At[4][2], B0[2][2], B1[2][2];
    const char* cA = cur.a; const char* cB = cur.b;
    if constexpr (SP2) {
        PG8_STAGE(PG8_SB(0, 0), cB, voffB); PG8_STAGE(PG8_SB(0, 1), cB + hstepB, voffB); PG8_STAGE(PG8_SA(0, 0), cA, voffA); PG8_STAGE(PG8_SA(0, 1), cA + hstepA, voffA);
        if (wr == 1) PG8_BAR;
        PG8_WAIT_V(2); PG8_BAR;
        PG8_STAGE(PG8_SB(1, 0), cB + kstep, voffB); PG8_STAGE(PG8_SA(1, 0), cA + kstep, voffA); PG8_STAGE(PG8_SB(1, 1), cB + hstepB + kstep, voffB);
        PG8_WAIT_V(6); PG8_BAR;
    } else {
        PG8_STAGE(PG8_SB(0, 0), cB, voffB); PG8_STAGE(PG8_SA(0, 0), cA, voffA); PG8_STAGE(PG8_SB(0, 1), cB + hstepB, voffB); PG8_STAGE(PG8_SA(0, 1), cA + hstepA, voffA);
        if (wr == 1) PG8_BAR;
        PG8_WAIT_V(4); PG8_BAR;
        PG8_STAGE(PG8_SB(1, 0), cB + kstep, voffB); PG8_STAGE(PG8_SA(1, 0), cA + kstep, voffA); PG8_STAGE(PG8_SB(1, 1), cB + hstepB + kstep, voffB);
        PG8_WAIT_V(6); PG8_BAR;
    }
    for (;;) {
        const bool has_next = S.next(ui + 1, nxt);
        const char* nA = has_next ? nxt.a : cA; const char* nB = has_next ? nxt.b : cB;
        const int nt = cur.nt;
        for (int t = 0; t < nt; t += 2) {
            const bool last = (t == nt - 2);
            const char* a1 = cA + (size_t)(t + 1) * kstep;
            const char* a2 = last ? nA : cA + (size_t)(t + 2) * kstep; const char* b2 = last ? nB : cB + (size_t)(t + 2) * kstep;
            const char* a3 = a2 + kstep; const char* b3 = b2 + kstep;
            if constexpr (SP2) {
            PG8_LDB(B0, 0, 0); PG8_LDB(B1, 0, 1); PG8_SCHED; PG8_LDA(At, 0, 0); PG8_STAGE(PG8_SA(1, 1), a1 + hstepA, voffA);
            PG8_WAIT_V(8); PG8_WAIT_L(0); PG8_BAR; PG8_MMA(0, 0, At, B0); PG8_MMA(0, 1, At, B1); PG8_BAR; PG8_SCHED;
            PG8_LDA(At, 0, 1); PG8_STAGE(PG8_SB(0, 0), b2, voffB); PG8_STAGE(PG8_SB(0, 1), b2 + hstepB, voffB); PG8_STAGE(PG8_SA(0, 0), a2, voffA);
            PG8_WAIT_V(8); PG8_WAIT_L(0); PG8_BAR; PG8_MMA(1, 0, At, B0); PG8_MMA(1, 1, At, B1); PG8_BAR; PG8_SCHED;
            PG8_LDB(B0, 1, 0); PG8_LDB(B1, 1, 1); PG8_SCHED; PG8_LDA(At, 1, 0); PG8_STAGE(PG8_SA(0, 1), a2 + hstepA, voffA);
            PG8_WAIT_V(8); PG8_WAIT_L(0); PG8_BAR; PG8_MMA(0, 0, At, B0); PG8_MMA(0, 1, At, B1); PG8_BAR; PG8_SCHED;
            PG8_LDA(At, 1, 1); PG8_STAGE(PG8_SB(1, 0), b3, voffB); PG8_STAGE(PG8_SB(1, 1), b3 + hstepB, voffB); PG8_STAGE(PG8_SA(1, 0), a3, voffA);
            PG8_WAIT_V(8); PG8_WAIT_L(0); PG8_BAR; PG8_MMA(1, 0, At, B0); PG8_MMA(1, 1, At, B1); PG8_BAR; PG8_SCHED;
            } else {
            PG8_LDB(B0, 0, 0); PG8_SCHED; PG8_LDA(At, 0, 0); PG8_STAGE(PG8_SA(1, 1), a1 + hstepA, voffA);
            PG8_WAIT_L(8); PG8_BAR; PG8_WAIT_L(0); PG8_MMA(0, 0, At, B0); PG8_BAR; PG8_SCHED;
            PG8_LDB(B1, 0, 1); PG8_STAGE(PG8_SB(0, 0), b2, voffB);
            PG8_BAR; PG8_WAIT_L(0); PG8_MMA(0, 1, At, B1); PG8_BAR;
            PG8_LDA(At, 0, 1); PG8_STAGE(PG8_SA(0, 0), a2, voffA);
            PG8_BAR; PG8_WAIT_L(0); PG8_MMA(1, 0, At, B0); PG8_BAR; PG8_SCHED;
            PG8_STAGE(PG8_SB(0, 1), b2 + hstepB, voffB);
            PG8_WAIT_V(6); PG8_BAR; PG8_MMA(1, 1, At, B1); PG8_BAR;
            PG8_LDB(B0, 1, 0); PG8_SCHED; PG8_LDA(At, 1, 0); PG8_STAGE(PG8_SA(0, 1), a2 + hstepA, voffA);
            PG8_WAIT_L(8); PG8_BAR; PG8_WAIT_L(0); PG8_MMA(0, 0, At, B0); PG8_BAR; PG8_SCHED;
            PG8_LDB(B1, 1, 1); PG8_STAGE(PG8_SB(1, 0), b3, voffB);
            PG8_BAR; PG8_WAIT_L(0); PG8_MMA(0, 1, At, B1); PG8_BAR;
            PG8_LDA(At, 1, 1); PG8_STAGE(PG8_SA(1, 0), a3, voffA);
            PG8_BAR; PG8_WAIT_L(0); PG8_MMA(1, 0, At, B0); PG8_BAR; PG8_SCHED;
            PG8_STAGE(PG8_SB(1, 1), b3 + hstepB, voffB);
            PG8_WAIT_V(6); PG8_BAR; PG8_MMA(1, 1, At, B1); PG8_BAR;
            }
        }
        if constexpr (ALIGN_EPI) { if (wr == 0) PG8_BAR; }
        bool keep; { int ln; asm volatile("v_mbcnt_lo_u32_b32 %0, -1, 0\n\tv_mbcnt_hi_u32_b32 %0, -1, %0" : "=v"(ln)); keep = E(acc, cur, wr, wc, ln & 15, ln >> 4); }
        if (!has_next) break;
        if (!keep)
#pragma unroll
        for (int a = 0; a < 2; ++a)
#pragma unroll
            for (int b = 0; b < 2; ++b)
#pragma unroll
                for (int m = 0; m < 4; ++m)
#pragma unroll
                    for (int n = 0; n < 2; ++n) acc[a][b][m][n] = (f32x4){0.f, 0.f, 0.f, 0.f};
        cur = nxt; cA = nA; cB = nB; ++ui;
        if constexpr (ALIGN_EPI) { if (wr == 1) PG8_BAR; }
    }
    PG8_WAIT_V(0);
    if constexpr (!ALIGN_EPI) { if (wr == 0) PG8_BAR; }
    PG8_BAR;
#undef PG8_SA
#undef PG8_SB
#undef PG8_STAGE
#undef PG8_LDA
#undef PG8_LDB
#undef PG8_MMA
#undef PG8_WAIT_V
#undef PG8_WAIT_L
#undef PG8_BAR
#undef PG8_SCHED
}

__device__ __forceinline__ float fsigmoid(float x) { return __builtin_amdgcn_rcpf(1.f + __expf(-x)); }
struct EpiZ {
    static constexpr bool PERM = true;
    bf16* Z;
    __device__ __forceinline__ bool operator()(f32x4 (&acc)[2][2][4][2], const Unit& u, int wr, int wc, int fr, int fq) const {
        const int row0 = u.pm * BM + wr * 64 + fr, col0 = u.pn * BM + wc * 32 + 8 * fq;
        const int ty = u.pn >= 30 ? 2 : (u.pn >= 26 ? 1 : 0);
        if (u.pn >= 6 && u.pn < 14) {
            const int colg = ZCA + (u.pn - 6) * 128 + wc * 32 + 8 * fq;
#pragma unroll
            for (int ai = 0; ai < 2; ++ai)
#pragma unroll
                for (int m = 0; m < 4; ++m) { f32x4 a0 = acc[ai][0][m][0], a1 = acc[ai][0][m][1]; const f32x4 g0 = acc[ai][1][m][0], g1 = acc[ai][1][m][1];
#pragma unroll
                    for (int j = 0; j < 4; ++j) { a0[j] = a0[j] * fsigmoid(g0[j]); a1[j] = a1[j] * fsigmoid(g1[j]); }
                    u32x4 w; w.x = cvt_pk_bf16(a0[0], a0[1]); w.y = cvt_pk_bf16(a0[2], a0[3]); w.z = cvt_pk_bf16(a1[0], a1[1]); w.w = cvt_pk_bf16(a1[2], a1[3]);
                    *(u32x4*)(Z + (size_t)(row0 + ai * HALF + m * 16) * ZW + colg) = w; }
            return false;
        }
#pragma unroll
        for (int ai = 0; ai < 2; ++ai)
#pragma unroll
            for (int m = 0; m < 4; ++m) { bf16* rowp = Z + (size_t)(row0 + ai * HALF + m * 16) * ZW + col0;
#pragma unroll
                for (int bj = 0; bj < 2; ++bj) { f32x4 v0 = acc[ai][bj][m][0], v1 = acc[ai][bj][m][1];
                    if (ty == 2) {
#pragma unroll
                        for (int j = 0; j < 4; ++j) { v0[j] = fsigmoid(v0[j]); v1[j] = fsigmoid(v1[j]); } }
                    else if (ty == 1) {
#pragma unroll
                        for (int j = 0; j < 4; ++j) { v0[j] = v0[j] * fsigmoid(v0[j]); v1[j] = v1[j] * fsigmoid(v1[j]); } }
                    u32x4 w; w.x = cvt_pk_bf16(v0[0], v0[1]); w.y = cvt_pk_bf16(v0[2], v0[3]); w.z = cvt_pk_bf16(v1[0], v1[1]); w.w = cvt_pk_bf16(v1[2], v1[3]);
                    *(u32x4*)(rowp + bj * HALF) = w; } }
        return false;
    }
};
__device__ __forceinline__ u32x4 pack8(const f32x4 a, const f32x4 b) { u32x4 w; w.x = cvt_pk_bf16(a[0], a[1]); w.y = cvt_pk_bf16(a[2], a[3]); w.z = cvt_pk_bf16(b[0], b[1]); w.w = cvt_pk_bf16(b[2], b[3]); return w; }
struct EpiMlp1 {
    static constexpr bool PERM = true;
    bf16* O; bf16* SLAB;
    __device__ __forceinline__ bool operator()(f32x4 (&acc)[2][2][4][2], const Unit& u, int wr, int wc, int fr, int fq) const {
        const int row0 = u.pm * BM + wr * 64 + fr, col0 = u.pn * BM + wc * 32 + 8 * fq;
        if (u.pm == MP / BM) { bf16* sl = SLAB + ((size_t)u.ks * BM + wr * 64 + fr) * DFF + col0;
#pragma unroll
            for (int ai = 0; ai < 2; ++ai)
#pragma unroll
                for (int m = 0; m < 4; ++m)
#pragma unroll
                    for (int bj = 0; bj < 2; ++bj) *(u32x4*)(sl + (size_t)(ai * HALF + m * 16) * DFF + bj * HALF) = pack8(acc[ai][bj][m][0], acc[ai][bj][m][1]);
            return false; }
#pragma unroll
        for (int ai = 0; ai < 2; ++ai)
#pragma unroll
            for (int m = 0; m < 4; ++m) { bf16* rowp = O + (size_t)(row0 + ai * HALF + m * 16) * DFF + col0;
#pragma unroll
                for (int bj = 0; bj < 2; ++bj) { f32x4 v0 = acc[ai][bj][m][0], v1 = acc[ai][bj][m][1];
#pragma unroll
                    for (int j = 0; j < 4; ++j) { const float a = fmaxf(v0[j], 0.f), b = fmaxf(v1[j], 0.f); v0[j] = a * a; v1[j] = b * b; }
                    u32x4 w; w.x = cvt_pk_bf16(v0[0], v0[1]); w.y = cvt_pk_bf16(v0[2], v0[3]); w.z = cvt_pk_bf16(v1[0], v1[1]); w.w = cvt_pk_bf16(v1[2], v1[3]);
                    *(u32x4*)(rowp + bj * HALF) = w; } }
        return false;
    }
};
struct EpiPool {
    static constexpr bool PERM = true;
    bf16* Y2; const float* spb; int l;
    __device__ __forceinline__ bool operator()(f32x4 (&acc)[2][2][4][2], const Unit& u, int wr, int wc, int fr, int fq) const {
        const int row0 = u.pm * BM + wr * 64 + fr, col0 = u.pn * BM + wc * 32 + 8 * fq;
        int le = l; asm volatile("" : "+s"(le)); const float* sp = spb + le * BRW;
        f32x4 s[2][2];
#pragma unroll
        for (int bj = 0; bj < 2; ++bj)
#pragma unroll
            for (int n = 0; n < 2; ++n) s[bj][n] = *(const f32x4*)(sp + col0 + bj * HALF + 4 * n);
#pragma unroll
        for (int ai = 0; ai < 2; ++ai)
#pragma unroll
            for (int m = 0; m < 4; ++m) { bf16* rowp = Y2 + (size_t)(row0 + ai * HALF + m * 16) * BRW + col0;
#pragma unroll
                for (int bj = 0; bj < 2; ++bj) { const f32x4 v0 = acc[ai][bj][m][0] * s[bj][0], v1 = acc[ai][bj][m][1] * s[bj][1];
                    u32x4 w; w.x = cvt_pk_bf16(v0[0], v0[1]); w.y = cvt_pk_bf16(v0[2], v0[3]); w.z = cvt_pk_bf16(v1[0], v1[1]); w.w = cvt_pk_bf16(v1[2], v1[3]);
                    *(u32x4*)(rowp + bj * HALF) = w; } }
        return false;
    }
};
struct EpiAda {
    static constexpr bool PERM = false;
    float* ADA; const float* bada;
    __device__ __forceinline__ bool operator()(f32x4 (&acc)[2][2][4][2], const Unit& u, int wr, int wc, int fr, int fq) const {
        if (wr != 0) return false;
        const int col0 = u.pn * BM + wc * 32 + 4 * fq;
#pragma unroll
        for (int m = 0; m < 3; ++m) { const int row = m * 16 + fr;
            if (row < NROWB) {
#pragma unroll
                for (int bj = 0; bj < 2; ++bj)
#pragma unroll
                    for (int n = 0; n < 2; ++n) { const int c = col0 + bj * HALF + n * 16; const f32x4 bv = *(const f32x4*)(bada + (size_t)u.r * ADAW + c);
                        *(f32x4*)(ADA + ((size_t)u.r * NROWB + row) * ADAW + c) = acc[0][bj][m][n] + bv; } } }
        return false;
    }
};
struct EpiBr {
    static constexpr bool PERM = true;
    const bf16* Z; bf16* MERGED; bf16* SLAB; int KS;
    static __device__ __forceinline__ void unp8(const u32x4 gw, f32x4& g0, f32x4& g1) { const float T = 8.6736174e-19f;
        g0[0] = fmaxf(__builtin_bit_cast(float, gw.x << 16), T); g0[1] = fmaxf(__builtin_bit_cast(float, gw.x & 0xffff0000u), T); g0[2] = fmaxf(__builtin_bit_cast(float, gw.y << 16), T); g0[3] = fmaxf(__builtin_bit_cast(float, gw.y & 0xffff0000u), T);
        g1[0] = fmaxf(__builtin_bit_cast(float, gw.z << 16), T); g1[1] = fmaxf(__builtin_bit_cast(float, gw.z & 0xffff0000u), T); g1[2] = fmaxf(__builtin_bit_cast(float, gw.w << 16), T); g1[3] = fmaxf(__builtin_bit_cast(float, gw.w & 0xffff0000u), T); }
    __device__ __forceinline__ bool operator()(f32x4 (&acc)[2][2][4][2], const Unit& u, int wr, int wc, int fr, int fq) const {
        const int row0 = u.pm * BM + wr * 64 + fr, col0 = u.pn * BM + wc * 32 + 8 * fq;
        const int r = u.r; const bool smp = u.pm == MP / BM;
        const bf16* gbase = Z + (size_t)row0 * ZW + ZGT + r * DM + col0;
#pragma unroll
        for (int ai = 0; ai < 2; ++ai) {
            u32x4 ga[4][2], gb[4][2];
#pragma unroll
            for (int m = 0; m < 4; ++m)
#pragma unroll
                for (int bj = 0; bj < 2; ++bj) { const bf16* gp = gbase + (size_t)(ai * HALF + m * 16) * ZW + bj * HALF; ga[m][bj] = *(const u32x4*)gp; gb[m][bj] = *(const u32x4*)(gp + DM); }
            asm volatile("" ::: "memory");
#pragma unroll
            for (int m = 0; m < 4; ++m)
#pragma unroll
                for (int bj = 0; bj < 2; ++bj) { const size_t row = (size_t)(row0 + ai * HALF + m * 16); const int c = col0 + bj * HALF;
                    f32x4 g0, g1; unp8(ga[m][bj], g0, g1);
                    if (smp) { *(u32x4*)(SLAB + ((size_t)(r * KS + u.ks) * BM + (row - MP)) * DM + c) = pack8(acc[ai][bj][m][0] * g0, acc[ai][bj][m][1] * g1); }
                    else if (r < 3) { f32x4 n0, n1; unp8(gb[m][bj], n0, n1);
#pragma unroll
                        for (int j = 0; j < 4; ++j) { acc[ai][bj][m][0][j] *= g0[j] * __builtin_amdgcn_rcpf(n0[j]); acc[ai][bj][m][1][j] *= g1[j] * __builtin_amdgcn_rcpf(n1[j]); } }
                    else { const f32x4 v0 = acc[ai][bj][m][0] * g0, v1 = acc[ai][bj][m][1] * g1;
                        u32x4 w; w.x = cvt_pk_bf16(v0[0], v0[1]); w.y = cvt_pk_bf16(v0[2], v0[3]); w.z = cvt_pk_bf16(v1[0], v1[1]); w.w = cvt_pk_bf16(v1[2], v1[3]);
                        *(u32x4*)(MERGED + row * DM + c) = w; } }
        }
        return !smp && r < 3;
    }
};
struct EpiRes {
    static constexpr bool PERM = true;
    const void* baseP; void* out; bool baseBf, outBf; const float* gate; bf16* SLAB;
    __device__ __forceinline__ bool operator()(f32x4 (&acc)[2][2][4][2], const Unit& u, int wr, int wc, int fr, int fq) const {
        const int rl0 = wr * 64 + fr, col0 = u.pn * BM + wc * 32 + 8 * fq;
        const bool smp = u.pm >= MP / BM;
        if (smp) { bf16* sl = SLAB + ((size_t)u.ks * BM + rl0) * DM + col0;
#pragma unroll
            for (int ai = 0; ai < 2; ++ai)
#pragma unroll
                for (int m = 0; m < 4; ++m)
#pragma unroll
                    for (int bj = 0; bj < 2; ++bj) *(u32x4*)(sl + (size_t)(ai * HALF + m * 16) * DM + bj * HALF) = pack8(acc[ai][bj][m][0], acc[ai][bj][m][1]);
            return false; }
        const size_t e0 = (size_t)u.pm * BM * DM + (size_t)rl0 * DM + col0;
        const float* gp = gate + (size_t)(u.pm >> 4) * ADAW + col0;
        f32x4 gv[2][2];
#pragma unroll
        for (int bj = 0; bj < 2; ++bj)
#pragma unroll
            for (int n = 0; n < 2; ++n) gv[bj][n] = *(const f32x4*)(gp + bj * HALF + n * 4);
#pragma unroll
        for (int ai = 0; ai < 2; ++ai) {
            f32x4 bs[4][2][2];
            if (baseBf) {
#pragma unroll
                for (int m = 0; m < 4; ++m)
#pragma unroll
                    for (int bj = 0; bj < 2; ++bj) { const u32x4 w = *(const u32x4*)((const bf16*)baseP + e0 + (size_t)(ai * HALF + m * 16) * DM + bj * HALF); const unsigned w0 = w.x, w1 = w.y, w2 = w.z, w3 = w.w;
                        bs[m][bj][0] = f32x4{__builtin_bit_cast(float, w0 << 16), __builtin_bit_cast(float, w0 & 0xffff0000u), __builtin_bit_cast(float, w1 << 16), __builtin_bit_cast(float, w1 & 0xffff0000u)};
                        bs[m][bj][1] = f32x4{__builtin_bit_cast(float, w2 << 16), __builtin_bit_cast(float, w2 & 0xffff0000u), __builtin_bit_cast(float, w3 << 16), __builtin_bit_cast(float, w3 & 0xffff0000u)}; }
            } else {
#pragma unroll
                for (int m = 0; m < 4; ++m)
#pragma unroll
                    for (int bj = 0; bj < 2; ++bj)
#pragma unroll
                        for (int n = 0; n < 2; ++n) bs[m][bj][n] = *(const f32x4*)((const float*)baseP + e0 + (size_t)(ai * HALF + m * 16) * DM + bj * HALF + n * 4);
            }
            asm volatile("" ::: "memory");
#pragma unroll
            for (int m = 0; m < 4; ++m)
#pragma unroll
                for (int bj = 0; bj < 2; ++bj) { const f32x4 y0 = bs[m][bj][0] + gv[bj][0] * acc[ai][bj][m][0], y1 = bs[m][bj][1] + gv[bj][1] * acc[ai][bj][m][1];
                    if (outBf) { u32x4 w; w.x = cvt_pk_bf16(y0[0], y0[1]); w.y = cvt_pk_bf16(y0[2], y0[3]); w.z = cvt_pk_bf16(y1[0], y1[1]); w.w = cvt_pk_bf16(y1[2], y1[3]);
                        *(u32x4*)((bf16*)out + e0 + (size_t)(ai * HALF + m * 16) * DM + bj * HALF) = w; }
                    else { float* o = (float*)out + e0 + (size_t)(ai * HALF + m * 16) * DM + bj * HALF; *(f32x4*)o = y0; *(f32x4*)(o + 4) = y1; } }
        }
        return false;
    }
};
}

constexpr int NWAVES = 8, NTHR = NWAVES * 64;
constexpr size_t MiB = 1u << 20;
constexpr size_t al1(size_t x) { return (x + MiB - 1) / MiB * MiB; }
constexpr size_t WS_CTL = 0, CTL_ZERO_BYTES = 1 * MiB;
constexpr size_t WS_WIN = WS_CTL + CTL_ZERO_BYTES;
constexpr size_t WS_WBR = WS_WIN + al1((size_t)DEPTH * ZW * DM * 2);
constexpr size_t WS_WOUT = WS_WBR + al1((size_t)DEPTH * 4 * DM * BRW * 2);
constexpr size_t WS_WM1 = WS_WOUT + al1((size_t)DEPTH * DM * DM * 2);
constexpr size_t WS_WM2 = WS_WM1 + al1((size_t)DEPTH * DFF * DM * 2);
constexpr size_t WS_WPOOL = WS_WM2 + al1((size_t)DEPTH * DFF * DM * 2);
constexpr size_t WS_WADA = WS_WPOOL + al1((size_t)DEPTH * 4 * 256 * 256 * 2);
constexpr size_t WS_SC = WS_WADA + al1((size_t)DEPTH * ADAW * DM * 2);
constexpr size_t WS_ADA = WS_SC + al1((size_t)256 * DM * 2);
constexpr size_t WS_H = WS_ADA + al1((size_t)DEPTH * NROWB * ADAW * 4);
constexpr size_t WS_Z = WS_H + al1((size_t)M * DM * 2);
constexpr size_t WS_Y = WS_Z + al1((size_t)M * ZW * 2);
constexpr size_t WS_ZP = WS_Y + al1((size_t)4 * M * BRW * 2);
constexpr size_t WS_CONVY = WS_ZP + al1((size_t)M * BRW * 2);
constexpr size_t WS_ORAW = WS_CONVY + al1((size_t)M * BRW * 4);
constexpr size_t WS_KV = WS_ORAW + al1((size_t)M * BRW * 4);
constexpr size_t WS_SPREV = WS_KV + al1((size_t)NBP * 32 * RH * RDK * RDV * 4);
constexpr size_t WS_MACC = WS_SPREV + al1((size_t)NBP * 32 * RH * RDK * RDV * 4);
constexpr size_t WS_MERGED = WS_MACC + al1((size_t)M * DM * 4);
constexpr size_t WS_X1 = WS_MERGED + al1((size_t)M * DM * 2);
constexpr size_t WS_X = WS_X1 + al1((size_t)M * DM * 4);
constexpr size_t WS_HID = WS_X + al1((size_t)M * DM * 4);
constexpr size_t WS_SLAB = WS_HID + al1((size_t)M * DFF * 2);
constexpr size_t WS_END = WS_SLAB + al1((size_t)16 * MS * DM * 4);
constexpr int CW_BAR = 4096;
constexpr int RING_OFF = 0, RING_BYTES = 131072, LDSCTL_OFF = RING_BYTES, MISC_OFF = LDSCTL_OFF + 320, INTAB_OFF = MISC_OFF + 128, LDS_BYTES = 147456;

#define GAS __attribute__((address_space(1)))
#define LAS __attribute__((address_space(3)))
typedef unsigned v4u __attribute__((ext_vector_type(4)));
typedef float f32x4 __attribute__((ext_vector_type(4)));
typedef GAS unsigned gu32;
#define RLX_AGENT __ATOMIC_RELAXED, __HIP_MEMORY_SCOPE_AGENT
#define LDS_WAIT() asm volatile("s_waitcnt lgkmcnt(0)" ::: "memory")
__device__ __forceinline__ unsigned pk2(float lo, float hi) { return (unsigned)f2bf(lo) | ((unsigned)f2bf(hi) << 16); }

#define XB_TMO      128
#define XB_XCNT(j)  (256  + 64 * (j))
#define XB_XSUB(j)  (1280 + 64 * (j))
#define XB_XGEN(j)  (2304 + 64 * (j))
#define XB_TOP      3328
#define XB_TOPGEN   3392
#define XCD_BAR_WORDS 3456
#define XB_SPIN_CAP (1u << 18)
__device__ __forceinline__ unsigned xb_ld(unsigned* p)              { return __hip_atomic_load(p, __ATOMIC_RELAXED, __HIP_MEMORY_SCOPE_AGENT); }
__device__ __forceinline__ unsigned xb_add(unsigned* p, unsigned v) { return __hip_atomic_fetch_add(p, v, __ATOMIC_RELAXED, __HIP_MEMORY_SCOPE_AGENT); }
__device__ __forceinline__ unsigned xb_xcc_id() { return (unsigned)__builtin_amdgcn_s_getreg((3 << 11) | 20) & 0xFu; }
#define XB_SPIN(cond, bar) do { unsigned _sp = 0; while (cond) { __builtin_amdgcn_s_sleep(1); \
    if ((++_sp & 255u) == 0u) { if (xb_ld(&(bar)[XB_TMO])) break; if (_sp > XB_SPIN_CAP) { atomicAdd(&(bar)[XB_TMO], 1u); break; } } } } while (0)
struct XcdBarrier { unsigned* bar; unsigned x; volatile LAS unsigned* st; };
__device__ __forceinline__ XcdBarrier xcd_barrier_post(unsigned* bar, volatile LAS unsigned* st) {
    XcdBarrier b; b.bar = bar; b.x = xb_xcc_id(); b.st = st;
    if (threadIdx.x == 0) (void)xb_add(&bar[XB_XCNT(b.x)], 1u);
    return b;
}
__device__ __forceinline__ void xcd_barrier_complete(unsigned* bar, unsigned x, unsigned& nloc, unsigned& nx) {
    const unsigned G = gridDim.x * gridDim.y * gridDim.z;
    unsigned sum, cnt, mine, sp = 0u;
    for (;;) {
        sum = 0u; cnt = 0u; mine = 0u;
#pragma unroll
        for (unsigned j = 0; j < 16; ++j) { const unsigned c = xb_ld(&bar[XB_XCNT(j)]); sum += c; cnt += (c > 0u) ? 1u : 0u; mine = (j == x) ? c : mine; }
        if (sum == G) break;
        __builtin_amdgcn_s_sleep(1);
        if ((++sp & 255u) == 0u) { if (xb_ld(&bar[XB_TMO])) break; if (sp > XB_SPIN_CAP) { atomicAdd(&bar[XB_TMO], 1u); break; } }
    }
    nloc = mine > 0u ? mine : 1u; nx = cnt > 0u ? cnt : 1u;
}
__device__ __forceinline__ void xcd_barrier(const XcdBarrier& b) {
    asm volatile("s_waitcnt vmcnt(0)" ::: "memory");
    __syncthreads();
    if (threadIdx.x == 0) {
        unsigned* bar = b.bar;
        __builtin_amdgcn_s_waitcnt(0);
        unsigned nloc = b.st[0], nx = b.st[1];
        if (nloc == 0u) { xcd_barrier_complete(bar, b.x, nloc, nx); b.st[0] = nloc; b.st[1] = nx; }
        const unsigned old = xb_add(&bar[XB_XSUB(b.x)], 1u);
        const unsigned gen = old / nloc;
        if (old + 1u == (gen + 1u) * nloc) {
            __builtin_amdgcn_fence(__ATOMIC_RELEASE, "agent");
            asm volatile("s_waitcnt vmcnt(0)" ::: "memory");
            const unsigned og = xb_add(&bar[XB_TOP], 1u);
            const unsigned tg = og / nx;
            if (og + 1u == (tg + 1u) * nx) xb_add(&bar[XB_TOPGEN], 1u);
            else XB_SPIN(xb_ld(&bar[XB_TOPGEN]) == tg, bar);
            __builtin_amdgcn_fence(__ATOMIC_ACQUIRE, "agent");
            xb_add(&bar[XB_XGEN(b.x)], 1u);
            asm volatile("s_waitcnt vmcnt(0)" ::: "memory");
        } else {
            XB_SPIN(xb_ld(&bar[XB_XGEN(b.x)]) == gen, bar);
            __builtin_amdgcn_fence(__ATOMIC_ACQUIRE, "agent");
            asm volatile("s_waitcnt vmcnt(0)" ::: "memory");
        }
    }
    __syncthreads();
}

template <int CTRL> __device__ __forceinline__ float dpp_f(float v) { return __builtin_bit_cast(float, __builtin_amdgcn_update_dpp(0, __builtin_bit_cast(int, v), CTRL, 0xf, 0xf, false)); }
__device__ __forceinline__ float wave_sum(float v) {
    v += dpp_f<0xB1>(v);
    v += dpp_f<0x4E>(v);
    v += dpp_f<0x141>(v);
    v += dpp_f<0x140>(v);
    v += __builtin_bit_cast(float, __builtin_amdgcn_ds_swizzle(__builtin_bit_cast(int, v), 0x401F));
    return __builtin_bit_cast(float, __builtin_amdgcn_readlane(__builtin_bit_cast(int, v), 0)) + __builtin_bit_cast(float, __builtin_amdgcn_readlane(__builtin_bit_cast(int, v), 32));
}
typedef float tr_f32x4 __attribute__((ext_vector_type(4)));
#define TR_LOAD(V, P) _Pragma("unroll") for (int j = 0; j < 8; ++j) V[j] = __builtin_nontemporal_load((const GAS tr_f32x4*)((P) + (size_t)j * N))
#define TR_STORE(V, Q) _Pragma("unroll") for (int i = 0; i < 4; ++i) { v4u o; o.x = pk2(V[0][i], V[1][i]); o.y = pk2(V[2][i], V[3][i]); o.z = pk2(V[4][i], V[5][i]); o.w = pk2(V[6][i], V[7][i]); __builtin_nontemporal_store(o, (GAS v4u*)((Q) + (size_t)i * K)); }
template <int K, int N, bool GLUPERM = false>
__device__ __forceinline__ void transpose_run(const float* W, bf16* T, int nmat, int gw, int NGW, int lane, int i0 = 0, int i1 = -1) {
    constexpr int NB = N / 32, IPM = (K / 64) * NB; const int total = nmat * IPM, end = i1 < 0 ? total : i1;
    const unsigned lo_p = (unsigned)(8 * (lane >> 3)) * N + 4 * (lane & 7), lo_q = (unsigned)(4 * (lane & 7)) * K + 8 * (lane >> 3);
    auto addr = [&](int it, const float*& p, bf16*& q) { it = it < total ? it : total - 1; const int mi = it / IPM, r = it % IPM, kb = r / NB, nb = r % NB;
        p = W + ((size_t)mi * K * N + (size_t)(64 * kb) * N + 32 * nb) + lo_p;
        int n0 = 32 * nb;
        if (GLUPERM) { if (n0 >= ZCA && n0 < ZCA + BRW) { const int c = n0 - ZCA; n0 = ZCA + 256 * (c >> 7) + (c & 127); } else if (n0 >= ZCG && n0 < ZCG + BRW) { const int c = n0 - ZCG; n0 = ZCA + 256 * (c >> 7) + 128 + (c & 127); } }
        q = T + ((size_t)mi * K * N + (size_t)n0 * K + 64 * kb) + lo_q; };
    int it = i0 + gw; if (it >= end) return;
    tr_f32x4 va[8], vb[8]; const float *pa, *pb; bf16 *qa, *qb;
    addr(it, pa, qa); TR_LOAD(va, pa);
    for (;;) {
        const int j1 = it + NGW; addr(j1, pb, qb); TR_LOAD(vb, pb);
        asm volatile("" ::: "memory"); TR_STORE(va, qa); asm volatile("" ::: "memory");
        if (j1 >= end) break;
        const int j2 = j1 + NGW; addr(j2, pa, qa); TR_LOAD(va, pa);
        asm volatile("" ::: "memory"); TR_STORE(vb, qb); asm volatile("" ::: "memory");
        if (j2 >= end) break;
        it = j2; }
}
__device__ __forceinline__ void load_mod(const float* g, const float* sc, const float* shp, f32x4 (&gm)[8], f32x4 (&sh)[8], int lane) {
#pragma unroll
    for (int jj = 0; jj < 4; ++jj)
#pragma unroll
        for (int e = 0; e < 2; ++e) { const int q = 2 * (lane + 64 * jj) + e; gm[2 * jj + e] = ((const f32x4*)g)[q] * (((const f32x4*)sc)[q] + 1.f); sh[2 * jj + e] = ((const f32x4*)shp)[q]; }
}
template <bool BF> __device__ __forceinline__ void load_row8(const void* x, f32x4 (&v)[8], int lane) {
#pragma unroll
    for (int jj = 0; jj < 4; ++jj) {
        if (BF) { const v4u w = ((const v4u*)x)[lane + 64 * jj]; const unsigned w0 = w.x, w1 = w.y, w2 = w.z, w3 = w.w;
            v[2 * jj] = f32x4{__builtin_bit_cast(float, w0 << 16), __builtin_bit_cast(float, w0 & 0xffff0000u), __builtin_bit_cast(float, w1 << 16), __builtin_bit_cast(float, w1 & 0xffff0000u)};
            v[2 * jj + 1] = f32x4{__builtin_bit_cast(float, w2 << 16), __builtin_bit_cast(float, w2 & 0xffff0000u), __builtin_bit_cast(float, w3 << 16), __builtin_bit_cast(float, w3 & 0xffff0000u)}; }
        else { v[2 * jj] = ((const f32x4*)x)[2 * (lane + 64 * jj)]; v[2 * jj + 1] = ((const f32x4*)x)[2 * (lane + 64 * jj) + 1]; } }
}
__device__ __forceinline__ float sumsq8(const f32x4 (&v)[8]) { float s = 0.f;
#pragma unroll
    for (int j = 0; j < 8; ++j) s += (v[j].x * v[j].x + v[j].y * v[j].y) + (v[j].z * v[j].z + v[j].w * v[j].w);
    return s; }
__device__ __forceinline__ void norm_store(const f32x4 (&v)[8], float ss, const f32x4 (&gm)[8], const f32x4 (&sh)[8], bf16* orow, int lane) {
    const float rstd = 1.f / sqrtf(wave_sum(ss) * (1.f / DM) + EPS);
#pragma unroll
    for (int jj = 0; jj < 4; ++jj) { const f32x4 y0 = v[2 * jj] * rstd * gm[2 * jj] + sh[2 * jj], y1 = v[2 * jj + 1] * rstd * gm[2 * jj + 1] + sh[2 * jj + 1];
        v4u o; o.x = pk2(y0.x, y0.y); o.y = pk2(y0.z, y0.w); o.z = pk2(y1.x, y1.y); o.w = pk2(y1.z, y1.w);
        ((v4u*)orow)[lane + 64 * jj] = o; }
}
template <bool BF> __device__ __forceinline__ void norm_row2(const void* xa, const void* xb, const f32x4 (&gm)[8], const f32x4 (&sh)[8], bf16* oa, bf16* ob, int lane) {
    f32x4 va[8], vb[8]; load_row8<BF>(xa, va, lane); load_row8<BF>(xb, vb, lane);
    const float sa = sumsq8(va), sb = sumsq8(vb);
    norm_store(va, sa, gm, sh, oa, lane); norm_store(vb, sb, gm, sh, ob, lane);
}
template <bool BF> __device__ __forceinline__ void norm_row(const void* xrow, const f32x4 (&gm)[8], const f32x4 (&sh)[8], bf16* orow, int lane) {
    f32x4 v[8]; load_row8<BF>(xrow, v, lane);
    norm_store(v, sumsq8(v), gm, sh, orow, lane);
}
template <int NP> __device__ __forceinline__ void norm_row_block(const float* base, const float* gate, const bf16* slab, size_t ps, float* xdst, const float* g, const float* sc, const float* shp, bf16* orow, LAS float* red, int tid, int wave) {
    f32x4 v = ((const f32x4*)base)[tid];
    if (NP > 0) { unsigned long long pv[NP > 0 ? NP : 1];
#pragma unroll
        for (int p = 0; p < NP; ++p) pv[p] = ((const unsigned long long*)(slab + (size_t)p * ps))[tid];
        f32x4 a = {0.f, 0.f, 0.f, 0.f};
#pragma unroll
        for (int p = 0; p < NP; ++p) { const unsigned lo = (unsigned)pv[p], hi = (unsigned)(pv[p] >> 32);
            a += f32x4{__builtin_bit_cast(float, lo << 16), __builtin_bit_cast(float, lo & 0xffff0000u), __builtin_bit_cast(float, hi << 16), __builtin_bit_cast(float, hi & 0xffff0000u)}; }
        v += ((const f32x4*)gate)[tid] * a; ((f32x4*)xdst)[tid] = v; }
    const float ws = wave_sum((v.x * v.x + v.y * v.y) + (v.z * v.z + v.w * v.w));
    if ((tid & 63) == 0) red[wave] = ws;
    __syncthreads();
    float ss = 0.f;
#pragma unroll
    for (int w = 0; w < NWAVES; ++w) ss += red[w];
    const float rstd = 1.f / sqrtf(ss * (1.f / DM) + EPS);
    const f32x4 y = v * rstd * ((const f32x4*)g)[tid] * (((const f32x4*)sc)[tid] + 1.f) + ((const f32x4*)shp)[tid];
    ((unsigned long long*)orow)[tid] = (unsigned long long)pk2(y.x, y.y) | ((unsigned long long)pk2(y.z, y.w) << 32);
    __syncthreads();
}
template <int NR> __device__ __forceinline__ void convln_rows(const bf16* const (&yrow)[NR], const f32x4 (&gv4)[4], const f32x4 (&bv4)[4], bf16* const (&orow)[NR], int lane) {
    f32x4 v[NR][4]; float s[NR];
#pragma unroll
    for (int r = 0; r < NR; ++r)
#pragma unroll
        for (int jj = 0; jj < 2; ++jj) { const v4u w = ((const v4u*)yrow[r])[lane + 64 * jj]; const unsigned w0 = w.x, w1 = w.y, w2 = w.z, w3 = w.w;
            v[r][2 * jj] = f32x4{__builtin_bit_cast(float, w0 << 16), __builtin_bit_cast(float, w0 & 0xffff0000u), __builtin_bit_cast(float, w1 << 16), __builtin_bit_cast(float, w1 & 0xffff0000u)};
            v[r][2 * jj + 1] = f32x4{__builtin_bit_cast(float, w2 << 16), __builtin_bit_cast(float, w2 & 0xffff0000u), __builtin_bit_cast(float, w3 << 16), __builtin_bit_cast(float, w3 & 0xffff0000u)}; }
#pragma unroll
    for (int r = 0; r < NR; ++r) { s[r] = 0.f;
#pragma unroll
        for (int j = 0; j < 4; ++j) s[r] += (v[r][j].x + v[r][j].y) + (v[r][j].z + v[r][j].w); }
#pragma unroll
    for (int r = 0; r < NR; ++r) { const float mean = wave_sum(s[r]) * (1.f / BRW); float q = 0.f;
#pragma unroll
        for (int j = 0; j < 4; ++j) { v[r][j] = v[r][j] - mean; q += (v[r][j].x * v[r][j].x + v[r][j].y * v[r][j].y) + (v[r][j].z * v[r][j].z + v[r][j].w * v[r][j].w); }
        s[r] = q; }
#pragma unroll
    for (int r = 0; r < NR; ++r) { const float rstd = 1.f / sqrtf(wave_sum(s[r]) * (1.f / BRW) + EPS);
#pragma unroll
        for (int jj = 0; jj < 2; ++jj) { f32x4 y0 = v[r][2 * jj] * rstd * gv4[2 * jj] + bv4[2 * jj], y1 = v[r][2 * jj + 1] * rstd * gv4[2 * jj + 1] + bv4[2 * jj + 1];
            y0.x = y0.x * sigmoidf_(y0.x); y0.y = y0.y * sigmoidf_(y0.y); y0.z = y0.z * sigmoidf_(y0.z); y0.w = y0.w * sigmoidf_(y0.w);
            y1.x = y1.x * sigmoidf_(y1.x); y1.y = y1.y * sigmoidf_(y1.y); y1.z = y1.z * sigmoidf_(y1.z); y1.w = y1.w * sigmoidf_(y1.w);
            v4u o; o.x = pk2(y0.x, y0.y); o.y = pk2(y0.z, y0.w); o.z = pk2(y1.x, y1.y); o.w = pk2(y1.z, y1.w);
            ((v4u*)orow[r])[lane + 64 * jj] = o; } }
}


namespace att {
typedef short bf16x8 __attribute__((ext_vector_type(8)));
typedef short s16x4 __attribute__((ext_vector_type(4)));
typedef float f32x4 __attribute__((ext_vector_type(4)));
typedef float f32x2_t __attribute__((ext_vector_type(2))); typedef __bf16 bf16x2_t __attribute__((ext_vector_type(2)));
constexpr int KP = 144, NROWS = 272, K_OFF = 0, V_OFF = NROWS * KP, LDS_NEED = 2 * NROWS * KP;
__device__ __forceinline__ unsigned cvtpk(float lo, float hi) { f32x2_t v = {lo, hi}; bf16x2_t b = __builtin_convertvector(v, bf16x2_t); return __builtin_bit_cast(unsigned, b); }
__device__ __forceinline__ float red4_max(float v) {
    v = fmaxf(v, __builtin_bit_cast(float, __builtin_amdgcn_ds_swizzle(__builtin_bit_cast(int, v), 0x401F)));
    unsigned x = __builtin_bit_cast(unsigned, v), y = x; asm volatile("" : "+v"(y));
    auto rr = __builtin_amdgcn_permlane32_swap(x, y, false, false); const unsigned r0 = rr[0], r1 = rr[1];
    return fmaxf(__builtin_bit_cast(float, r0), __builtin_bit_cast(float, r1)); }
__device__ __forceinline__ float red4_sum(float v) {
    v += __builtin_bit_cast(float, __builtin_amdgcn_ds_swizzle(__builtin_bit_cast(int, v), 0x401F));
    unsigned x = __builtin_bit_cast(unsigned, v), y = x; asm volatile("" : "+v"(y));
    auto rr = __builtin_amdgcn_permlane32_swap(x, y, false, false); const unsigned r0 = rr[0], r1 = rr[1];
    return __builtin_bit_cast(float, r0) + __builtin_bit_cast(float, r1); }
__device__ __forceinline__ s16x4 vtr(const LAS unsigned char* p) { typedef short v4i16_t __attribute__((ext_vector_type(4))); return __builtin_bit_cast(s16x4, __builtin_amdgcn_ds_read_tr16_b64_v4i16((LAS v4i16_t*)p)); }

__device__ __forceinline__ void tile16(const bf16x8 qf0, const bf16x8 qf1, const LAS unsigned char* Ks, const LAS unsigned char* Vs, int kbase, int wpos0, float slope2, float sink2, bf16* Yq, int nst, int lane) {
    const int c = lane & 15, g = lane >> 4;
    f32x4 st[9];
#pragma unroll
    for (int kt = 0; kt < 9; ++kt) { const LAS unsigned char* kp = Ks + (kbase + 16 * kt + c) * KP + 16 * g;
        const bf16x8 k0 = *(const LAS bf16x8*)kp, k1 = *(const LAS bf16x8*)(kp + 64);
        f32x4 a = {0.f, 0.f, 0.f, 0.f};
        a = __builtin_amdgcn_mfma_f32_16x16x32_bf16(k0, qf0, a, 0, 0, 0); a = __builtin_amdgcn_mfma_f32_16x16x32_bf16(k1, qf1, a, 0, 0, 0); st[kt] = a; }
    float SC2 = 0.125f * 1.4426950408889634f; asm volatile("" : "+v"(SC2));
    const int dbase = 128 + c - 4 * g;
    float m = sink2;
#pragma unroll
    for (int kt = 0; kt < 9; ++kt)
#pragma unroll
        for (int r = 0; r < 4; ++r) { const int dist = dbase - r - 16 * kt, kk = 16 * kt + 4 * g + r; const bool ok = (unsigned)dist <= 128u && (wpos0 + kk) >= 0;
            const float sv = ok ? st[kt][r] * SC2 - slope2 * (float)dist : -INFINITY; st[kt][r] = sv; m = fmaxf(m, sv); }
    m = red4_max(m);
    float sum = 0.f;
#pragma unroll
    for (int kt = 0; kt < 9; ++kt)
#pragma unroll
        for (int r = 0; r < 4; ++r) { const float p = __builtin_amdgcn_exp2f(st[kt][r] - m); st[kt][r] = p; sum += p; }
    sum = red4_sum(sum) + __builtin_amdgcn_exp2f(sink2 - m);
    const float inv = 1.f / sum;
    bf16x8 pf[5];
    unsigned zpad = 0u; asm volatile("" : "+v"(zpad));
#pragma unroll
    for (int k = 0; k < 5; ++k) { unsigned w0 = cvtpk(st[2 * k][0] * inv, st[2 * k][1] * inv), w1 = cvtpk(st[2 * k][2] * inv, st[2 * k][3] * inv), w2 = zpad, w3 = zpad;
        if (k < 4) { w2 = cvtpk(st[2 * k + 1][0] * inv, st[2 * k + 1][1] * inv); w3 = cvtpk(st[2 * k + 1][2] * inv, st[2 * k + 1][3] * inv); }
        typedef unsigned u32x4_t __attribute__((ext_vector_type(4))); const u32x4_t w = {w0, w1, w2, w3}; pf[k] = __builtin_bit_cast(bf16x8, w); }
    f32x4 o[4];
#pragma unroll
    for (int dt = 0; dt < 4; ++dt) o[dt] = (f32x4){0.f, 0.f, 0.f, 0.f};
    const LAS unsigned char* vb = Vs + (kbase + 4 * g + (c >> 2)) * KP + 8 * (c & 3);
#pragma unroll
    for (int k = 0; k < 5; ++k)
#pragma unroll
        for (int dt = 0; dt < 4; ++dt) { const s16x4 lo = vtr(vb + (32 * k) * KP + 32 * dt), hi = vtr(vb + (32 * k + 16) * KP + 32 * dt);
            const bf16x8 b = {lo[0], lo[1], lo[2], lo[3], hi[0], hi[1], hi[2], hi[3]};
            o[dt] = __builtin_amdgcn_mfma_f32_16x16x32_bf16(pf[k], b, o[dt], 0, 0, 0); }
#pragma unroll
    for (int r = 0; r < 4; ++r) if (4 * g + r < nst) {
#pragma unroll
        for (int dt = 0; dt < 4; ++dt) Yq[(size_t)(4 * g + r) * BRW + 16 * dt + c] = f2bf(o[dt][r]); }
}
typedef unsigned u32x4_t __attribute__((ext_vector_type(4)));
__device__ __forceinline__ u32x4_t pack8(const float* f) { u32x4_t w; w.x = cvtpk(f[0], f[1]); w.y = cvtpk(f[2], f[3]); w.z = cvtpk(f[4], f[5]); w.w = cvtpk(f[6], f[7]); return w; }
__device__ __forceinline__ void phase(LAS unsigned char* lds, const bf16* Z, int l, const float* sinks, const float* ck, const float* cv, bf16* Y0, int bx, int G, int tid, int lane, int wave) {
    LAS unsigned char* Ks = lds + K_OFF; LAS unsigned char* Vs = lds + V_OFF;
    const u32x4_t zero4 = {0u, 0u, 0u, 0u};
    for (int it = bx; it < NBP * 32 * NKV + SB * NKV; it += G) {
        const int kvh = it & 3;
        if (it < NBP * 32 * NKV) {
            const int b = it >> 7, qb = (it >> 2) & 31;
#pragma unroll
            for (int i = 0; i < 4; ++i) { const int p = tid + NTHR * i, sr = p >> 3, cc = p & 7; const int pos = 128 * (qb - 1) + sr;
                u32x4_t kq = zero4, vq = zero4;
                if (pos >= 0) { const bf16* zr = Z + (size_t)(b * SEQ + pos) * ZW + kvh * 64 + cc * 8; kq = *(const u32x4_t*)(zr + ZK); vq = *(const u32x4_t*)(zr + ZV); }
                *(LAS u32x4_t*)(Ks + sr * KP + cc * 16) = kq; *(LAS u32x4_t*)(Vs + sr * KP + cc * 16) = vq; }
            if (tid < 128) { const int sr = 256 + (tid >> 3), cc = tid & 7; *(LAS u32x4_t*)(Ks + sr * KP + cc * 16) = zero4; *(LAS u32x4_t*)(Vs + sr * KP + cc * 16) = zero4; }
            __syncthreads();
            const int hq = kvh * 4 + (wave >> 1), qh = wave & 1;
            const float slope2 = exp2f(-0.5f * (float)(hq + 1)) * 1.4426950408889634f, sink2 = sinks[l * NH + hq] * 1.4426950408889634f;
            const bf16* qp0 = Z + ((size_t)b * SEQ + 128 * qb + 64 * qh + (lane & 15)) * ZW + ZQ + hq * 64 + 8 * (lane >> 4);
            bf16x8 qc0 = *(const bf16x8*)qp0, qc1 = *(const bf16x8*)(qp0 + 32);
#pragma unroll 1
            for (int qt = 0; qt < 4; ++qt) { const int t1 = 64 * qh + 16 * qt; const size_t qrow0 = (size_t)b * SEQ + 128 * qb + t1;
                const bf16* qpn = qp0 + (size_t)(16 * (qt < 3 ? qt + 1 : 3)) * ZW; const bf16x8 qn0 = *(const bf16x8*)qpn, qn1 = *(const bf16x8*)(qpn + 32);
                tile16(qc0, qc1, Ks, Vs, t1, 128 * qb + t1 - 128, slope2, sink2, Y0 + qrow0 * BRW + hq * 64, 16, lane);
                qc0 = qn0; qc1 = qn1; }
        } else {
            const int sb = (it - NBP * 32 * NKV) >> 2;
#pragma unroll
            for (int i = 0; i < 3; ++i) { const int p = tid + NTHR * i, sr = p >> 3, cc = p & 7;
                if (sr < 160) { u32x4_t kq = zero4, vq = zero4;
                    if (sr < WIN) { const size_t o = ((((size_t)l * SB + sb) * WIN + sr) * NKV + kvh) * 64 + cc * 8; float f[8];
#pragma unroll
                        for (int e = 0; e < 8; ++e) f[e] = ck[o + e];
                        kq = pack8(f);
#pragma unroll
                        for (int e = 0; e < 8; ++e) f[e] = cv[o + e];
                        vq = pack8(f);
                    } else if (sr < WIN + ST) { const bf16* zr = Z + (size_t)(MP + sb * ST + (sr - WIN)) * ZW + kvh * 64 + cc * 8; kq = *(const u32x4_t*)(zr + ZK); vq = *(const u32x4_t*)(zr + ZV); }
                    *(LAS u32x4_t*)(Ks + sr * KP + cc * 16) = kq; *(LAS u32x4_t*)(Vs + sr * KP + cc * 16) = vq; } }
            __syncthreads();
            if (wave < 4) { const int hq = kvh * 4 + wave;
                const float slope2 = exp2f(-0.5f * (float)(hq + 1)) * 1.4426950408889634f, sink2 = sinks[l * NH + hq] * 1.4426950408889634f;
                const size_t qrow0 = (size_t)MP + sb * ST; const bf16* qp = Z + (qrow0 + (lane & 7)) * ZW + ZQ + hq * 64 + 8 * (lane >> 4);
                tile16(*(const bf16x8*)qp, *(const bf16x8*)(qp + 32), Ks, Vs, 0, 0, slope2, sink2, Y0 + qrow0 * BRW + hq * 64, ST, lane); }
        }
        __syncthreads();
    }
}
}

namespace adad {
using att::bf16x8; using att::f32x4; using att::cvtpk;
constexpr int NSTRIP = ADAW / 64, RW = 576, A2_OFF = 8 * RW * 16, A2_WAVE = 3 * 512;
#define ADA_LOAD(V, S) _Pragma("unroll") for (int j = 0; j < 8; ++j) V[j] = __builtin_nontemporal_load((const GAS f32x4*)(wp + (size_t)(32 * (S) + j) * ADAW))
__device__ __forceinline__ v4u silu8(f32x4 x0, f32x4 x1) { v4u o;
    o.x = cvtpk(x0.x * sigmoidf_(x0.x), x0.y * sigmoidf_(x0.y)); o.y = cvtpk(x0.z * sigmoidf_(x0.z), x0.w * sigmoidf_(x0.w));
    o.z = cvtpk(x1.x * sigmoidf_(x1.x), x1.y * sigmoidf_(x1.y)); o.w = cvtpk(x1.z * sigmoidf_(x1.z), x1.w * sigmoidf_(x1.w)); return o; }
__device__ __forceinline__ const GAS float* crow(const float* cp, const float* cs, int row) { return row < NBP ? (const GAS float*)cp + (size_t)row * DM : (const GAS float*)cs + (size_t)(row - NBP) * DM; }
__device__ __forceinline__ void phase(const float* cp, const float* cs, const float* wada, const float* bada, float* ADA, LAS unsigned char* lds, int bx, int G, int wave, int lane, int tid) {
    const int kl = 256 * wave + 8 * (lane >> 4);
    bf16x8 af[2][8];
#pragma unroll
    for (int mb = 0; mb < 2; ++mb) { const GAS float* src = crow(cp, cs, 16 * mb + (lane & 15)) + kl;
#pragma unroll
        for (int s = 0; s < 8; ++s) af[mb][s] = __builtin_bit_cast(bf16x8, silu8(*(const GAS f32x4*)(src + 32 * s), *(const GAS f32x4*)(src + 32 * s + 4))); }
    LAS unsigned char* a2 = lds + A2_OFF + wave * A2_WAVE;
    {   const GAS float* src = crow(cp, cs, 32 + (lane >> 5)) + 256 * wave + 8 * (lane & 31);
        *(LAS v4u*)(a2 + (lane >> 5) * 512 + (lane & 31) * 16) = silu8(*(const GAS f32x4*)src, *(const GAS f32x4*)(src + 4));
        if (lane < 32) { v4u z = {0u, 0u, 0u, 0u}; *(LAS v4u*)(a2 + 2 * 512 + lane * 16) = z; }
        LDS_WAIT(); asm volatile("" ::: "memory"); }
    const LAS unsigned char* a2r = a2 + ((lane & 15) < 2 ? (lane & 15) : 2) * 512 + (lane >> 4) * 16;
    LAS f32x4* red = (LAS f32x4*)lds;
    for (int g = bx; g < DEPTH * NSTRIP; g += G) { const int l = g / NSTRIP, n0 = 64 * (g % NSTRIP);
        const GAS float* wp = (const GAS float*)wada + (size_t)l * DM * ADAW + (size_t)kl * ADAW + n0 + 4 * (lane & 15);
        f32x4 acc[3][4];
#pragma unroll
        for (int mb = 0; mb < 3; ++mb)
#pragma unroll
            for (int i = 0; i < 4; ++i) acc[mb][i] = f32x4{0.f, 0.f, 0.f, 0.f};
        f32x4 v0[8], v1[8];
        ADA_LOAD(v0, 0);
#pragma unroll
        for (int s = 0; s < 8; ++s) {
            if (s < 7) { if (s & 1) { ADA_LOAD(v0, s + 1); } else { ADA_LOAD(v1, s + 1); } }
            asm volatile("" ::: "memory");
            const bf16x8 a2f = *(const LAS bf16x8*)(a2r + 64 * s);
#pragma unroll
            for (int i = 0; i < 4; ++i) { v4u w;
                if (s & 1) { w.x = cvtpk(v1[0][i], v1[1][i]); w.y = cvtpk(v1[2][i], v1[3][i]); w.z = cvtpk(v1[4][i], v1[5][i]); w.w = cvtpk(v1[6][i], v1[7][i]); }
                else       { w.x = cvtpk(v0[0][i], v0[1][i]); w.y = cvtpk(v0[2][i], v0[3][i]); w.z = cvtpk(v0[4][i], v0[5][i]); w.w = cvtpk(v0[6][i], v0[7][i]); }
                const bf16x8 bfr = __builtin_bit_cast(bf16x8, w);
                acc[0][i] = __builtin_amdgcn_mfma_f32_16x16x32_bf16(af[0][s], bfr, acc[0][i], 0, 0, 0);
                acc[1][i] = __builtin_amdgcn_mfma_f32_16x16x32_bf16(af[1][s], bfr, acc[1][i], 0, 0, 0);
                acc[2][i] = __builtin_amdgcn_mfma_f32_16x16x32_bf16(a2f, bfr, acc[2][i], 0, 0, 0); }
            asm volatile("" ::: "memory"); }
        LAS f32x4* rw = red + wave * RW;
#pragma unroll
        for (int mb = 0; mb < 2; ++mb)
#pragma unroll
            for (int i = 0; i < 4; ++i) rw[(mb * 4 + i) * 64 + lane] = acc[mb][i];
        if (lane < 16) {
#pragma unroll
            for (int i = 0; i < 4; ++i) rw[512 + i * 16 + lane] = acc[2][i]; }
        __syncthreads();
        for (int e = tid; e < RW; e += NTHR) { f32x4 t = red[e];
#pragma unroll
            for (int w = 1; w < 8; ++w) t += red[w * RW + e];
            int row0, col;
            if (e < 512) { const int mbi = e >> 6, ln = e & 63; row0 = 16 * (mbi >> 2) + 4 * (ln >> 4); col = n0 + 4 * (ln & 15) + (mbi & 3); }
            else { const int q = e - 512; row0 = 32; col = n0 + 4 * (q & 15) + (q >> 4); }
            const float bv = *((const GAS float*)bada + (size_t)l * ADAW + col);
            GAS float* o = (GAS float*)ADA + ((size_t)l * NROWB + row0) * ADAW + col;
            o[0] = t.x + bv; o[ADAW] = t.y + bv;
            if (row0 < 32) { o[2 * (size_t)ADAW] = t.z + bv; o[3 * (size_t)ADAW] = t.w + bv; } }
        __syncthreads(); }
}
}

namespace ret {
using att::bf16x8; using att::s16x4; using att::f32x4; using att::u32x4_t; using att::vtr; using att::cvtpk; using att::pack8;
constexpr int KP = 144, VP = 288, K_OFF = 0, V_OFF = 128 * KP, S_OFF = V_OFF + 128 * VP, LDS_NEED = S_OFF + 64 * VP;
template <int CTRL> __device__ __forceinline__ float dppf(float v) { return __builtin_bit_cast(float, __builtin_amdgcn_update_dpp(0, __builtin_bit_cast(int, v), CTRL, 0xf, 0xf, false)); }
__device__ __forceinline__ float sum16(float v) { v += dppf<0xB1>(v); v += dppf<0x4E>(v); v += dppf<0x141>(v); v += dppf<0x140>(v); return v; }
__device__ __forceinline__ void out_phase(LAS unsigned char* lds, const bf16* Z, int l, const float* SPREV, const float* gret, bf16* Y3, int bx, int G, int tid, int lane, int wave) {
    LAS unsigned char* Ks = lds + K_OFF; LAS unsigned char* Vs = lds + V_OFF; LAS unsigned char* Ss = lds + S_OFF;
    const int c = lane & 15, g = lane >> 4;
    for (int it = bx; it < NBP * 32 * RH; it += G) {
        const int b = it >> 8, n = (it >> 3) & 31, h = it & 7; const size_t row0 = (size_t)b * SEQ + n * 128;
#pragma unroll
        for (int i = 0; i < 2; ++i) { const int p = tid + NTHR * i, j = p >> 3, cc = p & 7; *(LAS u32x4_t*)(Ks + j * KP + cc * 16) = *(const u32x4_t*)(Z + (row0 + j) * ZW + ZRK + h * 64 + cc * 8); }
#pragma unroll
        for (int i = 0; i < 4; ++i) { const int p = tid + NTHR * i, j = p >> 4, cc = p & 15; *(LAS u32x4_t*)(Vs + j * VP + cc * 16) = *(const u32x4_t*)(Z + (row0 + j) * ZW + ZRV + h * 128 + cc * 8); }
#pragma unroll
        for (int i = 0; i < 2; ++i) { const int p = tid + NTHR * i, d = p >> 4, cc = p & 15; const float* sp = SPREV + ((((size_t)b * 32 + n) * RH + h) * RDK + d) * RDV + cc * 8; float f[8];
#pragma unroll
            for (int e = 0; e < 8; ++e) f[e] = sp[e];
            *(LAS u32x4_t*)(Ss + d * VP + cc * 16) = pack8(f); }
        __syncthreads();
        const int w = wave; const float lg2 = ret_logg(h) * 1.4426950408889634f;
        const bf16* qp = Z + (row0 + 16 * w + c) * ZW + ZRQ + h * 64 + 8 * g;
        const bf16x8 qf0 = *(const bf16x8*)qp, qf1 = *(const bf16x8*)(qp + 32);
        f32x4 o[8];
#pragma unroll
        for (int vt = 0; vt < 8; ++vt) o[vt] = (f32x4){0.f, 0.f, 0.f, 0.f};
#pragma unroll
        for (int ks = 0; ks < 2; ++ks) { const LAS unsigned char* sb = Ss + (32 * ks + 8 * g + (c >> 2)) * VP + 8 * (c & 3);
#pragma unroll
            for (int vt = 0; vt < 8; ++vt) { const s16x4 lo = vtr(sb + 32 * vt), hi = vtr(sb + 4 * VP + 32 * vt); const bf16x8 bb = {lo[0], lo[1], lo[2], lo[3], hi[0], hi[1], hi[2], hi[3]};
                o[vt] = __builtin_amdgcn_mfma_f32_16x16x32_bf16(ks ? qf1 : qf0, bb, o[vt], 0, 0, 0); } }
#pragma unroll
        for (int r = 0; r < 4; ++r) { const float cf = __builtin_amdgcn_exp2f(lg2 * (float)(16 * w + 4 * g + r + 1));
#pragma unroll
            for (int vt = 0; vt < 8; ++vt) o[vt][r] *= cf; }
        for (int ks = 0; ks <= (w >> 1); ++ks) {
            f32x4 st[2];
#pragma unroll
            for (int t = 0; t < 2; ++t) { const int jt = 2 * ks + t; f32x4 a = {0.f, 0.f, 0.f, 0.f};
                if (jt <= w) { const LAS unsigned char* kp = Ks + (16 * jt + c) * KP + 16 * g; const bf16x8 k0 = *(const LAS bf16x8*)kp, k1 = *(const LAS bf16x8*)(kp + 64);
                    a = __builtin_amdgcn_mfma_f32_16x16x32_bf16(k0, qf0, a, 0, 0, 0); a = __builtin_amdgcn_mfma_f32_16x16x32_bf16(k1, qf1, a, 0, 0, 0);
#pragma unroll
                    for (int r = 0; r < 4; ++r) { const int dij = (16 * w + c) - (16 * jt + 4 * g + r); a[r] = dij >= 0 ? a[r] * 0.125f * __builtin_amdgcn_exp2f(lg2 * (float)dij) : 0.f; } }
                st[t] = a; }
            const u32x4_t pw = {cvtpk(st[0][0], st[0][1]), cvtpk(st[0][2], st[0][3]), cvtpk(st[1][0], st[1][1]), cvtpk(st[1][2], st[1][3])}; const bf16x8 pf = __builtin_bit_cast(bf16x8, pw);
            const LAS unsigned char* vb = Vs + (32 * ks + 4 * g + (c >> 2)) * VP + 8 * (c & 3);
#pragma unroll
            for (int vt = 0; vt < 8; ++vt) { const s16x4 lo = vtr(vb + 32 * vt), hi = vtr(vb + 16 * VP + 32 * vt); const bf16x8 bb = {lo[0], lo[1], lo[2], lo[3], hi[0], hi[1], hi[2], hi[3]};
                o[vt] = __builtin_amdgcn_mfma_f32_16x16x32_bf16(pf, bb, o[vt], 0, 0, 0); }
        }
        float mean[4], rstd[4];
#pragma unroll
        for (int r = 0; r < 4; ++r) { float sm = 0.f;
#pragma unroll
            for (int vt = 0; vt < 8; ++vt) sm += o[vt][r];
            mean[r] = sum16(sm) * (1.f / 128.f); float q = 0.f;
#pragma unroll
            for (int vt = 0; vt < 8; ++vt) { const float dd = o[vt][r] - mean[r]; q += dd * dd; }
            rstd[r] = 1.f / sqrtf(sum16(q) * (1.f / 128.f) + EPS); }
        const float* gp = gret + l * BRW + h * 128 + c;
        float gv[8]; bf16 rgv[4][8];
#pragma unroll
        for (int vt = 0; vt < 8; ++vt) gv[vt] = gp[16 * vt];
#pragma unroll
        for (int r = 0; r < 4; ++r) { const bf16* rg = Z + (row0 + 16 * w + 4 * g + r) * ZW + ZRG + h * 128 + c;
#pragma unroll
            for (int vt = 0; vt < 8; ++vt) rgv[r][vt] = rg[16 * vt]; }
        asm volatile("" ::: "memory");
#pragma unroll
        for (int r = 0; r < 4; ++r) { bf16* y = Y3 + (row0 + 16 * w + 4 * g + r) * BRW + h * 128 + c;
#pragma unroll
            for (int vt = 0; vt < 8; ++vt) y[16 * vt] = f2bf((o[vt][r] - mean[r]) * rstd[r] * gv[vt] * bf2f(rgv[r][vt])); }
        __syncthreads();
    }
}

__device__ __forceinline__ void kv_phase(LAS unsigned char* lds, const bf16* Z, float* KV, int bx, int G, int tid, int lane, int wave) {
    LAS unsigned char* Ks = lds + K_OFF; LAS unsigned char* Vs = lds + V_OFF;
    const int c = lane & 15, g = lane >> 4;
    for (int it = bx; it < NBP * 32 * RH; it += G) {
        const int b = it >> 8, n = (it >> 3) & 31, h = it & 7; const size_t row0 = (size_t)b * SEQ + n * 128;
        const float lg2 = ret_logg(h) * 1.4426950408889634f;
#pragma unroll
        for (int i = 0; i < 2; ++i) { const int p = tid + NTHR * i, j = p >> 3, cc = p & 7; float f[8]; ld8(Z + (row0 + j) * ZW + ZRK + h * 64 + cc * 8, f);
            const float sc = 0.125f * __builtin_amdgcn_exp2f(lg2 * (float)(127 - j));
#pragma unroll
            for (int e = 0; e < 8; ++e) f[e] *= sc;
            *(LAS u32x4_t*)(Ks + j * KP + cc * 16) = pack8(f); }
#pragma unroll
        for (int i = 0; i < 4; ++i) { const int p = tid + NTHR * i, j = p >> 4, cc = p & 15; *(LAS u32x4_t*)(Vs + j * VP + cc * 16) = *(const u32x4_t*)(Z + (row0 + j) * ZW + ZRV + h * 128 + cc * 8); }
        __syncthreads();
        const int dt = wave & 3, vt0 = (wave >> 2) * 4;
        f32x4 acc[4];
#pragma unroll
        for (int t = 0; t < 4; ++t) acc[t] = (f32x4){0.f, 0.f, 0.f, 0.f};
#pragma unroll
        for (int ks = 0; ks < 4; ++ks) { const LAS unsigned char* ka = Ks + (32 * ks + 8 * g + (c >> 2)) * KP + 32 * dt + 8 * (c & 3);
            const s16x4 alo = vtr(ka), ahi = vtr(ka + 4 * KP); const bf16x8 af = {alo[0], alo[1], alo[2], alo[3], ahi[0], ahi[1], ahi[2], ahi[3]};
            const LAS unsigned char* vb = Vs + (32 * ks + 8 * g + (c >> 2)) * VP + 8 * (c & 3);
#pragma unroll
            for (int t = 0; t < 4; ++t) { const s16x4 lo = vtr(vb + 32 * (vt0 + t)), hi = vtr(vb + 4 * VP + 32 * (vt0 + t)); const bf16x8 bb = {lo[0], lo[1], lo[2], lo[3], hi[0], hi[1], hi[2], hi[3]};
                acc[t] = __builtin_amdgcn_mfma_f32_16x16x32_bf16(af, bb, acc[t], 0, 0, 0); } }
        float* kvp = KV + ((((size_t)b * 32 + n) * RH + h) * RDK + 16 * dt + 4 * g) * RDV + c;
#pragma unroll
        for (int r = 0; r < 4; ++r)
#pragma unroll
            for (int t = 0; t < 4; ++t) kvp[(size_t)r * RDV + 16 * (vt0 + t)] = acc[t][r];
        __syncthreads();
    }
}
}

namespace mixl {
using att::u32x4_t; using att::f32x4; using att::f32x2_t;
template <int CTRL> __device__ __forceinline__ float dppf(float v) { return __builtin_bit_cast(float, __builtin_amdgcn_update_dpp(0, __builtin_bit_cast(int, v), CTRL, 0xf, 0xf, false)); }
__device__ __forceinline__ float sum8(float v) { v += dppf<0xB1>(v); v += dppf<0x4E>(v); v += dppf<0x141>(v); return v; }
struct QkRow { float q0[8], q1[8], kv[8]; };
__device__ __forceinline__ void qk_load(const bf16* zr, QkRow& R, int lane) { ld8(zr + ZQ + lane * 8, R.q0); ld8(zr + ZQ + 512 + lane * 8, R.q1); ld8(zr + ZK + lane * 8, R.kv); }
__device__ __forceinline__ void qk_finish(bf16* zr, int row, int l, QkRow& R, const float (&g8q)[8], const float (&g8k)[8], float* out, int lane) {
    float s0 = 0.f, s1 = 0.f, s2 = 0.f;
#pragma unroll
    for (int e = 0; e < 8; ++e) { s0 += R.q0[e] * R.q0[e]; s1 += R.q1[e] * R.q1[e]; s2 += R.kv[e] * R.kv[e]; }
    const float r0 = 1.f / sqrtf(sum8(s0) * (1.f / 64.f) + EPS), r1 = 1.f / sqrtf(sum8(s1) * (1.f / 64.f) + EPS), r2 = 1.f / sqrtf(sum8(s2) * (1.f / 64.f) + EPS);
#pragma unroll
    for (int e = 0; e < 8; ++e) { R.q0[e] *= r0 * g8q[e]; R.q1[e] *= r1 * g8q[e]; if (lane < 32) R.kv[e] *= r2 * g8k[e]; }
    st8(zr + ZQ + lane * 8, R.q0); st8(zr + ZQ + 512 + lane * 8, R.q1);
    if (lane < 32) st8(zr + ZK + lane * 8, R.kv);
    float* o = nullptr;
    if (row < MP) { const int b = row >> 12, t = row & (SEQ - 1); if (t >= SEQ - WIN) o = out + (lane < 32 ? O_KP : O_VP) + (((size_t)l * NBP + b) * WIN + (t - (SEQ - WIN))) * 256 + (lane & 31) * 8; }
    else { const int sb = (row - MP) >> 3, t = (row - MP) & 7; o = out + (lane < 32 ? O_KS : O_VS) + (((size_t)l * SB + sb) * WIN + (WIN - ST + t)) * 256 + (lane & 31) * 8; }
    if (o) { *(f32x4*)o = (f32x4){R.kv[0], R.kv[1], R.kv[2], R.kv[3]}; *(f32x4*)(o + 4) = (f32x4){R.kv[4], R.kv[5], R.kv[6], R.kv[7]}; }
}
__device__ __forceinline__ void qknorm_phase(bf16* Z, int l, const float* gq, const float* gk, float* out, int gw, int NGW, int lane) {
    float g8q[8], g8k[8];
#pragma unroll
    for (int e = 0; e < 8; ++e) { g8q[e] = gq[l * 64 + (lane & 7) * 8 + e]; g8k[e] = gk[l * 64 + (lane & 7) * 8 + e]; }
    for (int row = gw; row < M; row += 2 * NGW) { const int rowb = row + NGW; const bool two = rowb < M;
        bf16* za = Z + (size_t)row * ZW; bf16* zb = Z + (size_t)(two ? rowb : row) * ZW;
        QkRow A, B; qk_load(za, A, lane); qk_load(zb, B, lane);
        asm volatile("" ::: "memory");
        qk_finish(za, row, l, A, g8q, g8k, out, lane);
        if (two) qk_finish(zb, rowb, l, B, g8q, g8k, out, lane);
    }
}
constexpr int CV_RB = 64, CV_CB = 128, CV_UR = CV_RB + CPRE, CV_NPI = (MP / CV_RB) * 8, CV_NSI = SB * 8;
struct CvItem { bool smp; int cb, b, t0, nrows; size_t rowb; };
__device__ __forceinline__ CvItem cv_item(int it) { CvItem I; I.smp = it >= CV_NPI; I.cb = it & 7; I.b = I.smp ? (it - CV_NPI) >> 3 : (it >> 3) >> 6; I.t0 = I.smp ? 0 : ((it >> 3) & 63) * CV_RB; I.nrows = I.smp ? ST : CV_RB;
    I.rowb = I.smp ? (size_t)MP + I.b * ST : (size_t)I.b * SEQ; return I; }
__device__ __forceinline__ void cv_fetch(const bf16* Z, int l, const float* sconv, const CvItem& I, u32x4_t (&raw)[3][2], int tid) {
#pragma unroll
    for (int i = 0; i < 3; ++i) { const int p = tid + NTHR * i, ur = p >> 4, c8 = p & 15, tt = I.t0 - CPRE + ur; raw[i][0] = (u32x4_t){0u, 0u, 0u, 0u}; raw[i][1] = raw[i][0];
        if (ur < I.nrows + CPRE) {
            if (tt >= 0) { const bf16* zp = Z + (I.rowb + tt) * ZW + I.cb * CV_CB + c8 * 8; raw[i][0] = *(const u32x4_t*)(zp + ZCA); }
            else if (I.smp) { const float* sp = sconv + (((size_t)l * SB + I.b) * CPRE + (CPRE + tt)) * BRW + I.cb * CV_CB + c8 * 8; raw[i][0] = *(const u32x4_t*)sp; raw[i][1] = *(const u32x4_t*)(sp + 4); } } }
}
__device__ __forceinline__ void conv_phase(LAS unsigned char* lds, const bf16* Z, int l, const float* wdw, const float* bdw, const float* sconv, bf16* CONVY, float* out, int bx, int G, int tid) {
    LAS float* U = (LAS float*)lds;
    auto unp = [](const u32x4_t w, float* f) { f[0] = __builtin_bit_cast(float, w.x << 16); f[1] = __builtin_bit_cast(float, w.x & 0xffff0000u); f[2] = __builtin_bit_cast(float, w.y << 16); f[3] = __builtin_bit_cast(float, w.y & 0xffff0000u);
        f[4] = __builtin_bit_cast(float, w.z << 16); f[5] = __builtin_bit_cast(float, w.z & 0xffff0000u); f[6] = __builtin_bit_cast(float, w.w << 16); f[7] = __builtin_bit_cast(float, w.w & 0xffff0000u); };
    u32x4_t raw[3][2]; f32x2_t w2[CONVK], bias2 = {0.f, 0.f}; int wcb = -1;
#pragma unroll
    for (int j = 0; j < CONVK; ++j) w2[j] = f32x2_t{0.f, 0.f};
    if (bx < CV_NPI + CV_NSI) { const CvItem I0 = cv_item(bx); cv_fetch(Z, l, sconv, I0, raw, tid); }
    for (int it = bx; it < CV_NPI + CV_NSI; it += G) {
        const CvItem I = cv_item(it);
        const int cp = tid & 63, r0 = (tid >> 6) * 8, ch = I.cb * CV_CB + 2 * cp;
        if (I.cb != wcb) { wcb = I.cb;
#pragma unroll
            for (int j = 0; j < CONVK; ++j) w2[j] = *(const f32x2_t*)(wdw + ((size_t)l * CONVK + j) * BRW + ch);
            bias2 = *(const f32x2_t*)(bdw + l * BRW + ch); }
#pragma unroll
        for (int i = 0; i < 3; ++i) { const int p = tid + NTHR * i, ur = p >> 4, c8 = p & 15, tt = I.t0 - CPRE + ur; float u[8];
            if (ur < I.nrows + CPRE) {
                if (tt >= 0) { unp(raw[i][0], u);
                    if (ur >= CPRE) { float* o = nullptr;
                        if (!I.smp) { if (tt >= SEQ - CPRE) o = out + O_CP + (((size_t)l * NBP + I.b) * CPRE + (tt - (SEQ - CPRE))) * BRW + I.cb * CV_CB + c8 * 8; }
                        else o = out + O_CS + (((size_t)l * SB + I.b) * CPRE + (CPRE - ST + tt)) * BRW + I.cb * CV_CB + c8 * 8;
                        if (o) { *(f32x4*)o = (f32x4){u[0], u[1], u[2], u[3]}; *(f32x4*)(o + 4) = (f32x4){u[4], u[5], u[6], u[7]}; } }
                } else {
                    const unsigned r0_ = raw[i][0].x, r1_ = raw[i][0].y, r2_ = raw[i][0].z, r3_ = raw[i][0].w, r4_ = raw[i][1].x, r5_ = raw[i][1].y, r6_ = raw[i][1].z, r7_ = raw[i][1].w;
                    u[0] = __builtin_bit_cast(float, r0_); u[1] = __builtin_bit_cast(float, r1_); u[2] = __builtin_bit_cast(float, r2_); u[3] = __builtin_bit_cast(float, r3_);
                    u[4] = __builtin_bit_cast(float, r4_); u[5] = __builtin_bit_cast(float, r5_); u[6] = __builtin_bit_cast(float, r6_); u[7] = __builtin_bit_cast(float, r7_); }
                *(LAS f32x4*)(U + ur * CV_CB + c8 * 8) = (f32x4){u[0], u[1], u[2], u[3]}; *(LAS f32x4*)(U + ur * CV_CB + c8 * 8 + 4) = (f32x4){u[4], u[5], u[6], u[7]}; } }
        __syncthreads();
        if (it + G < CV_NPI + CV_NSI) { const CvItem In = cv_item(it + G); cv_fetch(Z, l, sconv, In, raw, tid); }
        if (r0 < I.nrows) {
            f32x2_t u2[8 + CPRE];
#pragma unroll
            for (int k = 0; k < 8 + CPRE; ++k) u2[k] = *(const LAS f32x2_t*)(U + (r0 + k) * CV_CB + 2 * cp);
#pragma unroll
            for (int r = 0; r < 8; ++r) { f32x2_t acc = bias2;
#pragma unroll
                for (int j = 0; j < CONVK; ++j) acc = w2[j] * u2[r + j] + acc;
                if (r0 + r < I.nrows) *(unsigned*)(CONVY + (I.rowb + I.t0 + r0 + r) * BRW + ch) = pk2(acc.x, acc.y); }
        }
        __syncthreads();
    }
}
template <int W> __device__ __forceinline__ void pool_run(const bf16* Z, int l, int b, int t0, int cch, bf16* ZP, float* out) {
    const size_t rowb = (size_t)b * SEQ; u32x4_t rw[23];
#pragma unroll
    for (int k = 16 - W; k < 23; ++k) { const int tt = t0 - 15 + k; rw[k] = (u32x4_t){0u, 0u, 0u, 0u}; if (tt >= 0) rw[k] = *(const u32x4_t*)(Z + (rowb + tt) * ZW + ZPL + cch); }
    float S[8];
#pragma unroll
    for (int e = 0; e < 8; ++e) S[e] = 0.f;
    auto unp = [](const u32x4_t w, float* f) { f[0] = __builtin_bit_cast(float, w.x << 16); f[1] = __builtin_bit_cast(float, w.x & 0xffff0000u); f[2] = __builtin_bit_cast(float, w.y << 16); f[3] = __builtin_bit_cast(float, w.y & 0xffff0000u);
        f[4] = __builtin_bit_cast(float, w.z << 16); f[5] = __builtin_bit_cast(float, w.z & 0xffff0000u); f[6] = __builtin_bit_cast(float, w.w << 16); f[7] = __builtin_bit_cast(float, w.w & 0xffff0000u); };
#pragma unroll
    for (int k = 16 - W; k < 15; ++k) { float f[8]; unp(rw[k], f);
#pragma unroll
        for (int e = 0; e < 8; ++e) S[e] += f[e]; }
#pragma unroll
    for (int r = 0; r < 8; ++r) { const int t = t0 + r; float u[8], o[8], f[8]; unp(rw[15 + r], u);
        const float inv = 1.f / (float)((t + 1) < W ? (t + 1) : W);
#pragma unroll
        for (int e = 0; e < 8; ++e) { S[e] += u[e]; o[e] = S[e] * inv - u[e]; }
        st8(ZP + (rowb + t) * BRW + cch, o);
        if (t >= SEQ - PPAD) { float* so = out + O_PP + (((size_t)l * NBP + b) * PPAD + (t - (SEQ - PPAD))) * BRW + cch; *(f32x4*)so = (f32x4){u[0], u[1], u[2], u[3]}; *(f32x4*)(so + 4) = (f32x4){u[4], u[5], u[6], u[7]}; }
        unp(rw[15 + r - W + 1], f);
#pragma unroll
        for (int e = 0; e < 8; ++e) S[e] -= f[e]; }
}
template <int W> __device__ __forceinline__ void pool_run_s(const bf16* Z, int l, int b, int cch, const float* spool, bf16* ZP, float* out) {
    const size_t rowb = (size_t)MP + b * ST; const float* sp = spool + (((size_t)l * SB + b) * PPAD) * BRW + cch;
    f32x4 pf[W - 1][2]; u32x4_t rw[ST];
#pragma unroll
    for (int k = 0; k < W - 1; ++k) { pf[k][0] = *(const f32x4*)(sp + (size_t)(PPAD - (W - 1) + k) * BRW); pf[k][1] = *(const f32x4*)(sp + (size_t)(PPAD - (W - 1) + k) * BRW + 4); }
#pragma unroll
    for (int t = 0; t < ST; ++t) rw[t] = *(const u32x4_t*)(Z + (rowb + t) * ZW + ZPL + cch);
    auto unp = [](const u32x4_t w, float* f) { f[0] = __builtin_bit_cast(float, w.x << 16); f[1] = __builtin_bit_cast(float, w.x & 0xffff0000u); f[2] = __builtin_bit_cast(float, w.y << 16); f[3] = __builtin_bit_cast(float, w.y & 0xffff0000u);
        f[4] = __builtin_bit_cast(float, w.z << 16); f[5] = __builtin_bit_cast(float, w.z & 0xffff0000u); f[6] = __builtin_bit_cast(float, w.w << 16); f[7] = __builtin_bit_cast(float, w.w & 0xffff0000u); };
    float S[8];
#pragma unroll
    for (int e = 0; e < 8; ++e) S[e] = 0.f;
#pragma unroll
    for (int k = 0; k < W - 1; ++k) { S[0] += pf[k][0].x; S[1] += pf[k][0].y; S[2] += pf[k][0].z; S[3] += pf[k][0].w; S[4] += pf[k][1].x; S[5] += pf[k][1].y; S[6] += pf[k][1].z; S[7] += pf[k][1].w; }
    const float inv = 1.f / (float)W;
#pragma unroll
    for (int t = 0; t < ST; ++t) { float u[8], o[8], f[8]; unp(rw[t], u);
#pragma unroll
        for (int e = 0; e < 8; ++e) { S[e] += u[e]; o[e] = S[e] * inv - u[e]; }
        st8(ZP + (rowb + t) * BRW + cch, o);
        float* so = out + O_PS + (((size_t)l * SB + b) * PPAD + (PPAD - ST + t)) * BRW + cch; *(f32x4*)so = (f32x4){u[0], u[1], u[2], u[3]}; *(f32x4*)(so + 4) = (f32x4){u[4], u[5], u[6], u[7]};
        const int tt = t - W + 1;
        if (tt >= 0) unp(rw[tt >= 0 ? tt : 0], f);
        else { const int k = tt + W - 1 >= 0 ? tt + W - 1 : 0; f[0] = pf[k][0].x; f[1] = pf[k][0].y; f[2] = pf[k][0].z; f[3] = pf[k][0].w; f[4] = pf[k][1].x; f[5] = pf[k][1].y; f[6] = pf[k][1].z; f[7] = pf[k][1].w; }
#pragma unroll
        for (int e = 0; e < 8; ++e) S[e] -= f[e]; }
}
__device__ __forceinline__ void pool_phase(const bf16* Z, int l, const float* spool, bf16* ZP, float* out, int gw, int NGW, int lane, int gt, int NGT) {
    for (int wi = gw; wi < (MP / 8 / 2) * 4; wi += NGW) { const int cg = wi & 3, grp = (wi >> 2) * 2 + (lane >> 5), cch = (cg * 32 + (lane & 31)) * 8, b = grp >> 9, t0 = (grp & 511) * 8;
        if (cg == 0) pool_run<2>(Z, l, b, t0, cch, ZP, out); else if (cg == 1) pool_run<4>(Z, l, b, t0, cch, ZP, out); else if (cg == 2) pool_run<8>(Z, l, b, t0, cch, ZP, out); else pool_run<16>(Z, l, b, t0, cch, ZP, out); }
    for (int wi = gw; wi < (SB / 2) * 4; wi += NGW) { const int cg = wi & 3, b = (wi >> 2) * 2 + (lane >> 5), cch = (cg * 32 + (lane & 31)) * 8;
        if (cg == 0) pool_run_s<2>(Z, l, b, cch, spool, ZP, out); else if (cg == 1) pool_run_s<4>(Z, l, b, cch, spool, ZP, out); else if (cg == 2) pool_run_s<8>(Z, l, b, cch, spool, ZP, out); else pool_run_s<16>(Z, l, b, cch, spool, ZP, out); }
}
__device__ __forceinline__ void retout_s_phase(const bf16* Z, int l, const float* sret, const float* gret, bf16* Y3, int gw, int NGW, int lane) {
    for (int it = gw; it < MS * RH; it += NGW) { int h = __builtin_amdgcn_readfirstlane(it & 7); asm volatile("" : "+s"(h));
        const int rs = it >> 3, sb = rs >> 3, i = rs & 7; const size_t row = (size_t)MP + rs, row0 = (size_t)MP + sb * ST;
        const float lg = ret_logg(h);
        const bf16* qp = Z + row * ZW + ZRQ + h * 64;
        const float* S = sret + (((size_t)l * SB + sb) * RH + h) * RDK * RDV;
        float o0 = 0.f, o1 = 0.f;
        const float ql = bf2f(qp[lane]);
        bf16 kj[ST], v0j[ST], v1j[ST];
#pragma unroll
        for (int j = 0; j < ST; ++j) { const bf16* zj = Z + (row0 + j) * ZW; kj[j] = zj[ZRK + h * 64 + lane]; v0j[j] = zj[ZRV + h * 128 + lane]; v1j[j] = zj[ZRV + h * 128 + lane + 64]; }
#pragma unroll
        for (int d0 = 0; d0 < 64; d0 += 32) { float sa[32], sb_[32];
#pragma unroll
            for (int d = 0; d < 32; ++d) { sa[d] = S[(size_t)(d0 + d) * RDV + lane]; sb_[d] = S[(size_t)(d0 + d) * RDV + lane + 64]; }
#pragma unroll
            for (int d = 0; d < 32; ++d) { const float qd = __builtin_bit_cast(float, __builtin_amdgcn_readlane(__builtin_bit_cast(int, ql), d0 + d)); o0 += qd * sa[d]; o1 += qd * sb_[d]; } }
        const float cf = FEXP(lg * (float)(i + 1)); o0 *= cf; o1 *= cf;
#pragma unroll
        for (int j = 0; j < ST; ++j) { const float sc = j <= i ? wave_sum(ql * bf2f(kj[j])) * 0.125f * FEXP(lg * (float)(i - j)) : 0.f;
            o0 += sc * bf2f(v0j[j]); o1 += sc * bf2f(v1j[j]); }
        const float mean = wave_sum(o0 + o1) * (1.f / 128.f); const float d0 = o0 - mean, d1 = o1 - mean;
        const float rstd = 1.f / sqrtf(wave_sum(d0 * d0 + d1 * d1) * (1.f / 128.f) + EPS);
        const float* g = gret + l * BRW + h * 128; const bf16* rg = Z + row * ZW + ZRG + h * 128; bf16* y = Y3 + row * BRW + h * 128;
        y[lane] = f2bf(d0 * rstd * g[lane] * bf2f(rg[lane])); y[lane + 64] = f2bf(d1 * rstd * g[lane + 64] * bf2f(rg[lane + 64]));
    }
}
}
struct AdaOrder { int G, c; const char* A; const char* B;
    __device__ __forceinline__ bool next(int i, pg8::Unit& u) const { const int Lx = i * G + c; if (Lx >= DEPTH * (ADAW / 256)) return false;
        u.r = Lx / (ADAW / 256); u.pn = Lx % (ADAW / 256); u.pm = 0; u.ks = 0; u.nt = DM / 64; u.a = A; u.b = B + ((size_t)u.r * ADAW + (size_t)u.pn * 256) * DM * 2; return true; } };
struct PoolOrder { int G, c; const char* A; const char* B;
                __device__ __forceinline__ bool next(int i, pg8::Unit& u) const { const int Lx = i * G + c; if (Lx >= (M / 256) * 4) return false;
                    u.pm = Lx >> 2; u.pn = Lx & 3; u.r = 0; u.ks = 0; u.nt = 256 / 64; u.a = A + ((size_t)u.pm * 256 * BRW + (size_t)u.pn * 256) * 2; u.b = B + (size_t)u.pn * 256 * 256 * 2; return true; } };
__device__ __forceinline__ unsigned long long ld_ptr(volatile LAS unsigned* p) { const unsigned lo = __builtin_amdgcn_readfirstlane(p[0]), hi = __builtin_amdgcn_readfirstlane(p[1]); return ((unsigned long long)hi << 32) | lo; }
__device__ __forceinline__ att::f32x4 retstate_s_val(const bf16* Z, int l, int sb, int h, int d, int v4, const float* sret, float* out, float*& o) {
    const float lg = ret_logg(h);
    const size_t so = ((((size_t)l * SB + sb) * RH + h) * RDK + d) * RDV + v4 * 4;
    const float gc = FEXP(lg * (float)ST);
    const att::f32x4 s4 = *(const att::f32x4*)(sret + so); float a0 = gc * s4.x, a1 = gc * s4.y, a2 = gc * s4.z, a3 = gc * s4.w;
#pragma unroll
    for (int j = 0; j < ST; ++j) { const bf16* p = Z + (size_t)(MP + sb * ST + j) * ZW;
        const float kd = bf2f(p[ZRK + h * 64 + d]) * 0.125f * FEXP(lg * (float)(ST - 1 - j));
        const bf16* pv = p + ZRV + h * 128 + v4 * 4;
        a0 += kd * bf2f(pv[0]); a1 += kd * bf2f(pv[1]); a2 += kd * bf2f(pv[2]); a3 += kd * bf2f(pv[3]); }
    o = out + O_RS + so; return att::f32x4{a0, a1, a2, a3};
}
constexpr int NPL = 12;
constexpr int PH_TOTAL = 2 + DEPTH * NPL + 1;
constexpr int KS_BR = 2, KS_OUT = 8, KS_M1 = 4, KS_M2 = 16;
struct Args { const float* in[N_IN]; float* out; unsigned char* ws; int ph_lo, ph_hi; };
static_assert(sizeof(Args) == N_IN * 8 + 8 + 8 + 8, "Args has no padding");

__global__ void __launch_bounds__(NTHR, 2) fwd(Args args) {
    extern __shared__ __attribute__((aligned(16))) unsigned char lds[];
    LAS unsigned char* L0 = (LAS unsigned char*)lds;
    volatile LAS unsigned* MISC = (volatile LAS unsigned*)(L0 + MISC_OFF);
    const int G = gridDim.x, bx = blockIdx.x, wave0 = __builtin_amdgcn_readfirstlane(threadIdx.x >> 6);
    unsigned char* ws0 = args.ws;
    for (int u = threadIdx.x; u < (LDS_BYTES - LDSCTL_OFF) / 4; u += NTHR) ((LAS unsigned*)(L0 + LDSCTL_OFF))[u] = 0u;
    __syncthreads();
    if (threadIdx.x <= N_IN) ((LAS unsigned long long*)(L0 + INTAB_OFF))[threadIdx.x] = threadIdx.x < N_IN ? (unsigned long long)args.in[threadIdx.x < N_IN ? threadIdx.x : 0] : (unsigned long long)args.out;
    __syncthreads();
#if MK_ONE_LAUNCH
    XcdBarrier bar = xcd_barrier_post((unsigned*)(ws0 + WS_CTL) + CW_BAR, MISC + 8);
#define GRID_BAR() xcd_barrier(bar)
#else
#define GRID_BAR() do {} while (0)
#endif
    const int lo = args.ph_lo, hi = args.ph_hi;
#ifndef PH_MASK
#define PH_MASK 0x7FFF
#endif
#ifndef PROBE_MASK
#define PROBE_MASK 0
#endif
#define PROBE_BEGIN(bit) unsigned long long pr_t0 = 0; if ((PROBE_MASK >> (bit)) & 1) pr_t0 = __builtin_amdgcn_s_memrealtime()
#define PROBE_END(bit) do { if ((PROBE_MASK >> (bit)) & 1) { __syncthreads(); const unsigned long long t1 = __builtin_amdgcn_s_memrealtime(); while (__builtin_amdgcn_s_memrealtime() - t1 < t1 - pr_t0) __builtin_amdgcn_s_sleep(8); } } while (0)
#define TAIL_FILL(nsub, N, ...) do { const int f0_ = (nsub) < G ? (nsub) : 0; if (bx >= f0_) for (int i = (bx - f0_) * NTHR + tid; i < (N); i += (G - f0_) * NTHR) { __VA_ARGS__; } } while (0)
#define TAIL_LANE() int ln; asm volatile("v_mbcnt_lo_u32_b32 %0, -1, 0\n\tv_mbcnt_hi_u32_b32 %0, -1, %0" : "=v"(ln)); const int tid2 = wave0 * 64 + ln
#define TAIL_WAVES(nsub) TAIL_LANE(); const int f0_ = (nsub) < G ? (nsub) : 0; const bool filler = bx >= f0_; const int fw = (bx - f0_) * NWAVES + wave0, NFW = (G - f0_) * NWAVES; (void)tid2
    constexpr int WIN_ITEMS = (DM / 64) * (ZW / 32);
#define IN(k) (lo <= (k) && (k) < hi)
#define SEAM(k) do { if (IN((k) + 1)) GRID_BAR(); } while (0)
#define INP(i)  ((const float*)(GAS const float*)ld_ptr((volatile LAS unsigned*)(L + INTAB_OFF) + 2 * (i)))
#define P_OUT   ((float*)(GAS float*)ld_ptr((volatile LAS unsigned*)(L + INTAB_OFF) + 2 * N_IN))
#define WIN_T   ((bf16*)(ws + WS_WIN))
#define WBR_T   ((bf16*)(ws + WS_WBR))
#define WOUT_T  ((bf16*)(ws + WS_WOUT))
#define WM1_T   ((bf16*)(ws + WS_WM1))
#define WM2_T   ((bf16*)(ws + WS_WM2))
#define WPOOL_T ((bf16*)(ws + WS_WPOOL))
#define WADA_T  ((bf16*)(ws + WS_WADA))
#define SC      ((bf16*)(ws + WS_SC))
#define ADA     ((float*)(ws + WS_ADA))
#define H       ((bf16*)(ws + WS_H))
#define Z       ((bf16*)(ws + WS_Z))
#define Y       ((bf16*)(ws + WS_Y))
#define ZP      ((bf16*)(ws + WS_ZP))
#define CONVY   ((bf16*)(ws + WS_CONVY))
#define ORAW    ((float*)(ws + WS_ORAW))
#define KV      ((float*)(ws + WS_KV))
#define SPREV   ((float*)(ws + WS_SPREV))
#define MACC    ((float*)(ws + WS_MACC))
#define MERGED  ((bf16*)(ws + WS_MERGED))
#define X1      ((float*)(ws + WS_X1))
#define X       ((float*)(ws + WS_X))
#define X1B     ((bf16*)(ws + WS_X1))
#define XB      ((bf16*)(ws + WS_X))
#define HID     ((bf16*)(ws + WS_HID))
#define SLAB    ((bf16*)(ws + WS_SLAB))
#define TIDS() int lane; asm volatile("v_mbcnt_lo_u32_b32 %0, -1, 0\n\tv_mbcnt_hi_u32_b32 %0, -1, %0" : "=v"(lane)); GAS unsigned char* wsg = (GAS unsigned char*)ws0; asm volatile("" : "+s"(wsg)); unsigned char* ws = (unsigned char*)wsg; LAS unsigned char* L = L0; asm volatile("" : "+s"(L)); const int wave = wave0, tid = wave0 * 64 + lane; const int gw = bx * NWAVES + wave, NGW = G * NWAVES; const int gt = bx * NTHR + tid, NGT = G * NTHR; (void)lane; (void)gw; (void)NGW; (void)gt; (void)NGT
#define LAYER_PTRS() const float* ada = ADA + (size_t)l * NROWB * ADAW; const float* xinP = l == 0 ? INP(I_XP) : X; const float* xinS = l == 0 ? INP(I_XS) : X + (size_t)MP * DM; float* xout = l == DEPTH - 1 ? P_OUT : X; (void)ada; (void)xinP; (void)xinS; (void)xout
    if ((PH_MASK >> 12 & 1) && IN(0)) { TIDS(); PROBE_BEGIN(12);
        transpose_run<DM, ZW, true>(INP(I_WIN), WIN_T, 1, gw, NGW, lane);
        transpose_run<BRW, DM>(INP(I_WBR), WBR_T, DEPTH * 4, gw, NGW, lane);
        transpose_run<256, 256>(INP(I_WPOOL), WPOOL_T, DEPTH * 4, gw, NGW, lane);
        adad::phase(INP(I_CP), INP(I_CS), INP(I_WADA), INP(I_BADA), ADA, L + RING_OFF, bx, G, wave, lane, tid);
        PROBE_END(12); SEAM(0);
    }
    for (int l = 0; l < DEPTH; ++l) {
        const int pb = 2 + l * NPL;
        if ((PH_MASK >> 0 & 1) && IN(pb + 0)) { TIDS(); LAYER_PTRS(); PROBE_BEGIN(0);
            for (int rs = bx; rs < MS; rs += G) { const int row = MP + rs; const float* ar = ada + (size_t)row_cond(row) * ADAW;
                if (l == 0) norm_row_block<0>(xinS + (size_t)rs * DM, nullptr, nullptr, 0, nullptr, INP(I_G1) + l * DM, ar + DM, ar, H + (size_t)row * DM, (LAS float*)(L + RING_OFF), tid, wave);
                else norm_row_block<KS_M2>(X1 + (size_t)row * DM, ar - (size_t)NROWB * ADAW + 5 * DM, SLAB + (size_t)rs * DM, (size_t)MS * DM, X + (size_t)row * DM, INP(I_G1) + l * DM, ar + DM, ar, H + (size_t)row * DM, (LAS float*)(L + RING_OFF), tid, wave); }
            f32x4 gm[8], shv[8]; int curc = row_cond(gw < MP ? gw : 0); { const float* ar = ada + (size_t)curc * ADAW; load_mod(INP(I_G1) + l * DM, ar + DM, ar, gm, shv, lane); }
            for (int row = gw; row < MP; row += 2 * NGW) { const int rowb = row + NGW; const bool pair = rowb < MP && row_cond(rowb) == row_cond(row);
                for (int k = 0; k < 2; ++k) { const int r = k ? rowb : row; if (k && (pair || rowb >= MP)) break; const int cond = row_cond(r); const float* ar = ada + (size_t)cond * ADAW;
                    if (cond != curc) { load_mod(INP(I_G1) + l * DM, ar + DM, ar, gm, shv, lane); curc = cond; }
                    if (l == 0) { const float* xin = INP(I_XP);
                        if (pair) norm_row2<false>(xin + (size_t)row * DM, xin + (size_t)rowb * DM, gm, shv, H + (size_t)row * DM, H + (size_t)rowb * DM, lane);
                        else norm_row<false>(xin + (size_t)r * DM, gm, shv, H + (size_t)r * DM, lane); }
                    else {
                        if (pair) norm_row2<true>(XB + (size_t)row * DM, XB + (size_t)rowb * DM, gm, shv, H + (size_t)row * DM, H + (size_t)rowb * DM, lane);
                        else norm_row<true>(XB + (size_t)r * DM, gm, shv, H + (size_t)r * DM, lane); } } }
            PROBE_END(0); SEAM(pb + 0);
        }
        if ((PH_MASK >> 1 & 1) && IN(pb + 1)) { TIDS(); LAYER_PTRS(); PROBE_BEGIN(1);
            pg8::StaticOrder S; S.init(H, WIN_T + (size_t)l * ZW * DM, M / 256, ZW / 256, DM, DM, DM, G, bx);
            pg8::EpiZ E{Z};
            pg8::gemm_phase<pg8::EpiZ, pg8::StaticOrder>(L + RING_OFF, pg8::Dims{DM, DM, DM}, S, E, tid);
            PROBE_END(1); SEAM(pb + 1);
        }
        if ((PH_MASK >> 2 & 1) && IN(pb + 2)) { TIDS(); LAYER_PTRS(); PROBE_BEGIN(2);
            mixl::qknorm_phase(Z, l, INP(I_GQ), INP(I_GK), P_OUT, gw, NGW, lane);
            mixl::conv_phase(L + RING_OFF, Z, l, INP(I_WDW), INP(I_BDW), INP(I_SCONV), CONVY, P_OUT, bx, G, tid);
            mixl::pool_phase(Z, l, INP(I_SPOOL), ZP, P_OUT, gw, NGW, lane, gt, NGT);
            ret::kv_phase(L + RING_OFF, Z, KV, bx, G, tid, lane, wave);
            PROBE_END(2); SEAM(pb + 2);
        }
        if ((PH_MASK >> 3 & 1) && IN(pb + 3)) { TIDS(); LAYER_PTRS(); PROBE_BEGIN(3);
            att::phase(L + RING_OFF, Z, l, INP(I_SINK), INP(I_CK), INP(I_CV), Y, bx, G, tid, lane, wave);
            for (int i = gt; i < NBP * RH * RDK * 32; i += NGT) { const int v4 = i & 31, d = (i >> 5) & 63, b = i >> 14; int h = (i >> 11) & 7;
                const size_t o0 = (((size_t)b * 32 * RH + h) * RDK + d) * RDV + v4 * 4, cs = (size_t)RH * RDK * RDV; f32x4 kvv[32];
#pragma unroll
                for (int n = 0; n < 32; ++n) kvv[n] = *(const f32x4*)(KV + o0 + n * cs);
                const float gc = FEXP(ret_logg(h) * 128.f); float z0 = 0.f; asm volatile("" : "+v"(z0)); f32x4 sacc = {z0, z0, z0, z0};
#pragma unroll
                for (int n = 0; n < 32; ++n) { *(f32x4*)(SPREV + o0 + n * cs) = sacc; sacc = sacc * gc + kvv[n]; }
                *(f32x4*)(P_OUT + O_RP + ((((size_t)l * NBP + b) * RH + h) * RDK + d) * RDV + v4 * 4) = sacc; }
            { f32x4 gv4[4], bv4[4];
#pragma unroll
              for (int j = 0; j < 4; ++j) { const int q = 2 * (lane + 64 * (j >> 1)) + (j & 1); gv4[j] = ((const f32x4*)(INP(I_GCLN) + l * BRW))[q]; bv4[j] = ((const f32x4*)(INP(I_BCLN) + l * BRW))[q]; }
              bf16* const Y1 = Y + (size_t)1 * M * BRW;
              for (int row = gw; row < M; row += 2 * NGW) { const int rowb = row + NGW;
                  if (rowb < M) { const bf16* const yr[2] = {CONVY + (size_t)row * BRW, CONVY + (size_t)rowb * BRW}; bf16* const orr[2] = {Y1 + (size_t)row * BRW, Y1 + (size_t)rowb * BRW}; convln_rows<2>(yr, gv4, bv4, orr, lane); }
                  else { const bf16* const yr[1] = {CONVY + (size_t)row * BRW}; bf16* const orr[1] = {Y1 + (size_t)row * BRW}; convln_rows<1>(yr, gv4, bv4, orr, lane); } } }
            PROBE_END(3); SEAM(pb + 3);
        }
        if ((PH_MASK >> 4 & 1) && IN(pb + 4)) { TIDS(); LAYER_PTRS(); PROBE_BEGIN(4);
            mixl::retout_s_phase(Z, l, INP(I_SRET), INP(I_GRET), Y + (size_t)3 * M * BRW, gw, NGW, lane);
            ret::out_phase(L + RING_OFF, Z, l, SPREV, INP(I_GRET), Y + (size_t)3 * M * BRW, bx, G, tid, lane, wave);
            PoolOrder S{G, bx, (const char*)ZP, (const char*)(WPOOL_T + (size_t)l * 4 * 256 * 256)};
            pg8::EpiPool E{Y + (size_t)2 * M * BRW, INP(I_SPOOLS), l};
            pg8::gemm_phase<pg8::EpiPool, PoolOrder>(L + RING_OFF, pg8::Dims{BRW, 256, 256}, S, E, tid);
            PROBE_END(4); SEAM(pb + 4);
        }
        if ((PH_MASK >> 5 & 1) && IN(pb + 5)) { TIDS(); LAYER_PTRS(); PROBE_BEGIN(5);
            pg8::SplitOrder S{DM / 256, G, bx, 4, BRW / 64, KS_BR, BRW / 64 / KS_BR, (const char*)Y, (const char*)(WBR_T + (size_t)l * 4 * DM * BRW), (size_t)256 * BRW * 2, (size_t)256 * BRW * 2, (size_t)M * BRW * 2, (size_t)DM * BRW * 2};
            pg8::EpiBr E{Z, MERGED, SLAB, KS_BR};
            pg8::gemm_phase<pg8::EpiBr, pg8::SplitOrder>(L + RING_OFF, pg8::Dims{BRW, BRW, BRW}, S, E, tid);
            {   TAIL_WAVES((DM / 256) * 4 * KS_BR);
                if (filler) { transpose_run<DM, DM>(INP(I_WOUT) + (size_t)l * DM * DM, WOUT_T + (size_t)l * DM * DM, 1, fw, NFW, ln);
                              transpose_run<DM, DFF>(INP(I_WM1) + (size_t)l * DM * DFF, WM1_T + (size_t)l * DFF * DM, 1, fw, NFW, ln); } }
            PROBE_END(5); SEAM(pb + 5);
        }
        if ((PH_MASK >> 6 & 1) && IN(pb + 6)) { TIDS(); LAYER_PTRS(); PROBE_BEGIN(6);
            for (int i = gt; i < MS * DM / 8; i += NGT) { float a[8];
#pragma unroll
                for (int e = 0; e < 8; ++e) a[e] = 0.f;
#pragma unroll
                for (int p = 0; p < 4 * KS_BR; ++p) { float f[8]; ld8(SLAB + (size_t)p * MS * DM + (size_t)i * 8, f);
#pragma unroll
                    for (int e = 0; e < 8; ++e) a[e] += f[e]; }
                st8(MERGED + (size_t)MP * DM + (size_t)i * 8, a); }
            PROBE_END(6); SEAM(pb + 6);
        }
        if ((PH_MASK >> 7 & 1) && IN(pb + 7)) { TIDS(); LAYER_PTRS(); PROBE_BEGIN(7);
            pg8::SplitOrder S{DM / 256, G, bx, 1, DM / 64, KS_OUT, DM / 64 / KS_OUT, (const char*)MERGED, (const char*)(WOUT_T + (size_t)l * DM * DM), (size_t)256 * DM * 2, (size_t)256 * DM * 2, 0, 0};
            pg8::EpiRes E{l == 0 ? (const void*)INP(I_XP) : (const void*)XB, (void*)X1B, l != 0, true, ada + 2 * DM, SLAB};
            pg8::gemm_phase<pg8::EpiRes, pg8::SplitOrder>(L + RING_OFF, pg8::Dims{DM, DM, DM}, S, E, tid);
            {   TAIL_WAVES((DM / 256) * KS_OUT);
                if (filler) transpose_run<DFF, DM>(INP(I_WM2) + (size_t)l * DFF * DM, WM2_T + (size_t)l * DM * DFF, 1, fw, NFW, ln); }
            PROBE_END(7); SEAM(pb + 7);
        }
        if ((PH_MASK >> 8 & 1) && IN(pb + 8)) { TIDS(); LAYER_PTRS(); PROBE_BEGIN(8);
            for (int rs = bx; rs < MS; rs += G) { const int row = MP + rs; const float* ar = ada + (size_t)row_cond(row) * ADAW;
                norm_row_block<KS_OUT>(xinS + (size_t)rs * DM, ar + 2 * DM, SLAB + (size_t)rs * DM, (size_t)MS * DM, X1 + (size_t)row * DM, INP(I_G2) + l * DM, ar + 4 * DM, ar + 3 * DM, H + (size_t)row * DM, (LAS float*)(L + RING_OFF), tid, wave); }
            f32x4 gm[8], shv[8]; int curc = row_cond(gw < MP ? gw : 0); { const float* ar = ada + (size_t)curc * ADAW; load_mod(INP(I_G2) + l * DM, ar + 4 * DM, ar + 3 * DM, gm, shv, lane); }
            for (int row = gw; row < MP; row += 2 * NGW) { const int rowb = row + NGW; const bool pair = rowb < MP && row_cond(rowb) == row_cond(row);
                for (int k = 0; k < 2; ++k) { const int r = k ? rowb : row; if (k && (pair || rowb >= MP)) break; const int cond = row_cond(r); const float* ar = ada + (size_t)cond * ADAW;
                    if (cond != curc) { load_mod(INP(I_G2) + l * DM, ar + 4 * DM, ar + 3 * DM, gm, shv, lane); curc = cond; }
                    if (pair) norm_row2<true>(X1B + (size_t)row * DM, X1B + (size_t)rowb * DM, gm, shv, H + (size_t)row * DM, H + (size_t)rowb * DM, lane);
                    else norm_row<true>(X1B + (size_t)r * DM, gm, shv, H + (size_t)r * DM, lane); } }
            PROBE_END(8); SEAM(pb + 8);
        }
        if ((PH_MASK >> 9 & 1) && IN(pb + 9)) { TIDS(); LAYER_PTRS(); PROBE_BEGIN(9);
            pg8::SplitOrder S{DFF / 256, G, bx, 1, DM / 64, KS_M1, DM / 64 / KS_M1, (const char*)H, (const char*)(WM1_T + (size_t)l * DFF * DM), (size_t)256 * DM * 2, (size_t)256 * DM * 2, 0, 0};
            pg8::EpiMlp1 E{HID, SLAB};
            pg8::gemm_phase<pg8::EpiMlp1, pg8::SplitOrder>(L + RING_OFF, pg8::Dims{DM, DM, DM}, S, E, tid);
            {
                TAIL_LANE(); const int f0 = (DFF / 256) * KS_M1 < G ? (DFF / 256) * KS_M1 : 0;
                if (bx >= f0) { const int st = (G - f0) * NTHR;
                    float zf = 0.f; asm volatile("" : "+v"(zf));
                    for (int i0 = (bx - f0) * NTHR + tid2; i0 < N_SHIFT_ITEMS; i0 += 4 * st) { f32x4 v[4]; float* dp[4];
#pragma unroll
                        for (int u = 0; u < 4; ++u) { const int idx = i0 + u * st; dp[u] = nullptr; v[u] = f32x4{zf, zf, zf, zf};
                            if (idx < N_SHIFT_ITEMS) { const float* sp; shift_addr(l, idx, INP(I_CK), INP(I_CV), INP(I_SCONV), INP(I_SPOOL), P_OUT, sp, dp[u]); v[u] = *(const f32x4*)sp; } }
                        asm volatile("" ::: "memory");
#pragma unroll
                        for (int u = 0; u < 4; ++u) if (dp[u]) *(f32x4*)dp[u] = v[u]; }
                    int l1 = l + 1; asm volatile("" : "+s"(l1));
                    if (l1 < DEPTH) transpose_run<DM, ZW, true>(INP(I_WIN) + (size_t)l1 * DM * ZW, WIN_T + (size_t)l1 * ZW * DM, 1, (bx - f0) * NWAVES + wave0, (G - f0) * NWAVES, ln, 0, WIN_ITEMS / 2); } }
            PROBE_END(9); SEAM(pb + 9);
        }
        if ((PH_MASK >> 10 & 1) && IN(pb + 10)) { TIDS(); LAYER_PTRS(); PROBE_BEGIN(10);
            for (int i = gt; i < MS * DFF / 8; i += NGT) { float a[8];
#pragma unroll
                for (int e = 0; e < 8; ++e) a[e] = 0.f;
#pragma unroll
                for (int p = 0; p < KS_M1; ++p) { float f[8]; ld8(SLAB + (size_t)p * MS * DFF + (size_t)i * 8, f);
#pragma unroll
                    for (int e = 0; e < 8; ++e) a[e] += f[e]; }
#pragma unroll
                for (int e = 0; e < 8; ++e) { const float t = fmaxf(a[e], 0.f); a[e] = t * t; }
                st8(HID + (size_t)MP * DFF + (size_t)i * 8, a); }
            PROBE_END(10); SEAM(pb + 10);
        }
        if ((PH_MASK >> 11 & 1) && IN(pb + 11)) { TIDS(); LAYER_PTRS(); PROBE_BEGIN(11);
            pg8::SplitOrder S{DM / 256, G, bx, 1, DFF / 64, KS_M2, DFF / 64 / KS_M2, (const char*)HID, (const char*)(WM2_T + (size_t)l * DM * DFF), (size_t)256 * DFF * 2, (size_t)256 * DFF * 2, 0, 0};
            pg8::EpiRes E{(const void*)X1B, l == DEPTH - 1 ? (void*)P_OUT : (void*)XB, true, l != DEPTH - 1, ada + 5 * DM, SLAB};
            pg8::gemm_phase<pg8::EpiRes, pg8::SplitOrder>(L + RING_OFF, pg8::Dims{DFF, DFF, DFF}, S, E, tid);
            {
                TAIL_LANE(); const int f0 = (DM / 256) * KS_M2 < G ? (DM / 256) * KS_M2 : 0; constexpr int NI = SB * RH * RDK * 32;
                if (bx >= f0) { const int st = (G - f0) * NTHR;
                    float zf = 0.f; asm volatile("" : "+v"(zf));
                    for (int i0 = (bx - f0) * NTHR + tid2; i0 < NI; i0 += 2 * st) { f32x4 r[2]; float* op[2];
#pragma unroll
                        for (int u = 0; u < 2; ++u) { const int i = i0 + u * st; op[u] = nullptr; r[u] = f32x4{zf, zf, zf, zf};
                            if (i < NI) { const int v4 = i & 31, d = (i >> 5) & 63, h = (i >> 11) & 7, sb = i >> 14; r[u] = retstate_s_val(Z, l, sb, h, d, v4, INP(I_SRET), P_OUT, op[u]); } }
                        asm volatile("" ::: "memory");
#pragma unroll
                        for (int u = 0; u < 2; ++u) if (op[u]) *(f32x4*)op[u] = r[u]; }
                    int l1 = l + 1; asm volatile("" : "+s"(l1));
                    if (l1 < DEPTH) transpose_run<DM, ZW, true>(INP(I_WIN) + (size_t)l1 * DM * ZW, WIN_T + (size_t)l1 * ZW * DM, 1, (bx - f0) * NWAVES + wave0, (G - f0) * NWAVES, ln, WIN_ITEMS / 2, WIN_ITEMS); } }
            PROBE_END(11); SEAM(pb + 11);
        }
    }
    if ((PH_MASK >> 14 & 1) && IN(PH_TOTAL - 1)) { TIDS(); PROBE_BEGIN(14);
        const float* ada = ADA + (size_t)(DEPTH - 1) * NROWB * ADAW; float* yo = P_OUT + O_YS;
        for (int i = gt; i < MS * DM / 4; i += NGT) { const int row = i / (DM / 4), c4 = i % (DM / 4); const float* gp = ada + (size_t)(NBP + (row >> 3)) * ADAW + 5 * DM;
            f32x4 a = {0.f, 0.f, 0.f, 0.f};
#pragma unroll
            for (int p = 0; p < KS_M2; ++p) { const unsigned long long w = *(const unsigned long long*)(SLAB + (size_t)p * MS * DM + (size_t)i * 4); const unsigned lo = (unsigned)w, hi = (unsigned)(w >> 32);
                a += f32x4{__builtin_bit_cast(float, lo << 16), __builtin_bit_cast(float, lo & 0xffff0000u), __builtin_bit_cast(float, hi << 16), __builtin_bit_cast(float, hi & 0xffff0000u)}; }
            *(f32x4*)(yo + (size_t)i * 4) = *(const f32x4*)(X1 + (size_t)(MP + row) * DM + c4 * 4) + *(const f32x4*)(gp + c4 * 4) * a; }
        PROBE_END(14);
    }
#undef IN
#undef SEAM
}

extern "C" void kernel_launch(void* const* d_in, const int* in_sizes, int n_in, void* d_out, int out_size, void* d_ws, size_t ws_size, hipStream_t stream) {
    static int grid = 0;
    if (grid == 0) {
        if (n_in != N_IN || (size_t)out_size != O_END || ws_size < WS_END) { fprintf(stderr, "kernel_launch: unexpected shapes: n_in %d out %d ws %zu (need %zu)\n", n_in, out_size, ws_size, (size_t)WS_END); grid = -1; return; }
        int dev = 0, cus = 0, per_cu = 0;
        if (hipGetDevice(&dev) != hipSuccess || hipDeviceGetAttribute(&cus, hipDeviceAttributeMultiprocessorCount, dev) != hipSuccess) { grid = -1; return; }
        if (hipFuncSetAttribute((const void*)fwd, hipFuncAttributeMaxDynamicSharedMemorySize, LDS_BYTES) != hipSuccess) { fprintf(stderr, "kernel_launch: hipFuncSetAttribute failed\n"); grid = -1; return; }
        if (hipOccupancyMaxActiveBlocksPerMultiprocessor(&per_cu, (const void*)fwd, NTHR, LDS_BYTES) != hipSuccess || per_cu < 1) fprintf(stderr, "kernel_launch: occupancy query says %d\n", per_cu);
        (void)hipGetLastError();
        grid = cus;
    }
    if (grid < 0) return;
    (void)hipMemsetAsync((char*)d_ws + WS_CTL, 0, CTL_ZERO_BYTES, stream);
    Args a{};
    for (int i = 0; i < N_IN; ++i) a.in[i] = (const float*)d_in[i];
    a.out = (float*)d_out; a.ws = (unsigned char*)d_ws;
#if MK_ONE_LAUNCH
    a.ph_lo = 0; a.ph_hi = PH_TOTAL;
    hipLaunchKernelGGL(fwd, dim3(grid), dim3(NTHR), LDS_BYTES, stream, a);
#else
    for (int p = 0; p < PH_TOTAL; ++p) { a.ph_lo = p; a.ph_hi = p + 1; hipLaunchKernelGGL(fwd, dim3(grid), dim3(NTHR), LDS_BYTES, stream, a); }
#endif
}
#endif
```
